# Optimizing an MI355X kernel written in HIP

```python
import jax
import jax.numpy as jnp
from jax import lax
import numpy as np


D_MODEL = 1024
BATCH = 2
SEQ = 8192
DEPTH = 1

GRID_W = 64
CTX_LEN = 256
GLA_HEADS = 4
GLA_DK = 64
GLA_DV = 128
GLA_KEY = GLA_HEADS * GLA_DK
GLA_VAL = GLA_HEADS * GLA_DV
GLA_RANK = 16
GLA_CHUNK = 64
GATE_NORMALIZER = 16.0
POOL_WINDOWS = (2, 4, 8, 16)
POOL_GROUPS = 4
POOL_CH = 128
POOL_WIDTH = POOL_GROUPS * POOL_CH
N_BRANCHES = 2
N_EXPERTS = 16
D_EXPERT = 1024
EC_CAPACITY = 2
EPS = 1e-6
CTX_COLS = (GLA_KEY, GLA_VAL, GLA_RANK, GLA_RANK)
N_CTX_COLS = GLA_KEY + GLA_VAL + 2 * GLA_RANK
ALL_COLS = (N_CTX_COLS, GLA_KEY, GLA_VAL, POOL_WIDTH, N_BRANCHES * D_MODEL)
D_IN = N_CTX_COLS + GLA_KEY + GLA_VAL + POOL_WIDTH + N_BRANCHES * D_MODEL

kernel_name = 'hybrid_gla_pool_ecmoe_diffusion_block'


def split_cols(u, sizes):
    points, acc = [], 0
    for s in sizes[:-1]:
        acc += s
        points.append(acc)
    return jnp.split(u, points, axis=-1)


def rms_norm(x, g):
    xf = x.astype(jnp.float32)
    y = xf * lax.rsqrt(jnp.mean(xf * xf, axis=-1, keepdims=True) + EPS)
    return (y * g.astype(jnp.float32)).astype(x.dtype)


def modulate(x, g, shift, scale):
    return rms_norm(x, g) * (1 + scale) + shift


def to_heads(u, d):
    b, l, _ = u.shape
    return u.reshape(b, l, GLA_HEADS, d).transpose(0, 2, 1, 3)


def chunked(u):
    b, h, l, d = u.shape
    return u.reshape(b, h, l // GLA_CHUNK, GLA_CHUNK, d)


def gla_scan(q, k, v, log_a, h0, with_output):
    kc = chunked(k.astype(jnp.float32))
    vc = chunked(v.astype(jnp.float32))
    b = jnp.cumsum(chunked(log_a.astype(jnp.float32)), axis=3)
    b_last = b[:, :, :, -1:, :]
    kv = jnp.einsum('bhncd,bhnce->bhnde', kc * jnp.exp(b_last - b), vc)
    decay = jnp.exp(b_last[:, :, :, 0, :])

    def step(state, inp):
        dec_n, kv_n = inp
        return dec_n[..., None] * state + kv_n, state

    final, starts = lax.scan(step, h0, (jnp.moveaxis(decay, 2, 0), jnp.moveaxis(kv, 2, 0)))
    if not with_output:
        return None, final
    starts = jnp.moveaxis(starts, 0, 2)
    qc = chunked(q.astype(jnp.float32))
    inter = jnp.einsum('bhncd,bhnde->bhnce', qc * jnp.exp(b), starts)
    mid = b[:, :, :, GLA_CHUNK // 2 - 1:GLA_CHUNK // 2, :]
    scores = jnp.einsum('bhnid,bhnjd->bhnij', qc * jnp.exp(b - mid), kc * jnp.exp(mid - b))
    lower = jnp.tril(jnp.ones((GLA_CHUNK, GLA_CHUNK), dtype=bool))
    intra = jnp.einsum('bhnij,bhnje->bhnie', jnp.where(lower, scores, 0.0), vc)
    bsz, h, n, cl, dv = intra.shape
    return (inter + intra).reshape(bsz, h, n * cl, dv), final


def gla_bidirectional(q, k, v, la_f, la_b, h0_f, h0_b, with_output):
    rev = lambda u: jnp.flip(u, axis=2)
    o_f, h_f = gla_scan(q, k, v, la_f, h0_f, with_output)
    q_rev = rev(q) if with_output else None
    o_b, h_b = gla_scan(q_rev, rev(k), rev(v), rev(la_b), h0_b, with_output)
    if not with_output:
        return None, h_f, h_b
    return o_f + rev(o_b), h_f, h_b


def kv_and_decay(proj_kvd, w_decay_up, b_decay):
    k, v, r_f, r_b = split_cols(proj_kvd, CTX_COLS)
    la_f = jax.nn.log_sigmoid((r_f @ w_decay_up[0] + b_decay[0]).astype(jnp.float32)) / GATE_NORMALIZER
    la_b = jax.nn.log_sigmoid((r_b @ w_decay_up[1] + b_decay[1]).astype(jnp.float32)) / GATE_NORMALIZER
    return to_heads(k, GLA_DK), to_heads(v, GLA_DV), to_heads(la_f, GLA_DK), to_heads(la_b, GLA_DK)


def context_states(ctx, g1, shift, scale, w_in, w_decay_up, b_decay):
    h = modulate(ctx, g1, shift, scale)
    k, v, la_f, la_b = kv_and_decay(h @ w_in[:, :N_CTX_COLS], w_decay_up, b_decay)
    zero = jnp.zeros((ctx.shape[0], GLA_HEADS, GLA_DK, GLA_DV), jnp.float32)
    _, h_f, h_b = gla_bidirectional(None, k, v, la_f, la_b, zero, zero, False)
    return h_f, h_b


def box_sum(u, w, axis):
    n = u.shape[axis]
    pad = [(0, 0)] * u.ndim
    pad[axis] = (1, 0)
    cs = jnp.pad(jnp.cumsum(u, axis=axis), pad)
    pos = jnp.arange(n)
    lo = jnp.clip(pos - w // 2, 0, n)
    hi = jnp.clip(pos + w // 2, 0, n)
    s = jnp.take(cs, hi, axis=axis) - jnp.take(cs, lo, axis=axis)
    return s, (hi - lo).astype(jnp.float32)


def pool_latent(u):
    bsz, l, _ = u.shape
    rows = l // GRID_W
    ug = u.astype(jnp.float32).reshape(bsz, rows, GRID_W, POOL_GROUPS, POOL_CH)
    outs = []
    for gi, w in enumerate(POOL_WINDOWS):
        ugi = ug[:, :, :, gi, :]
        s, cnt_c = box_sum(ugi, w, 2)
        s, cnt_r = box_sum(s, w, 1)
        outs.append(s / (cnt_r[:, None] * cnt_c[None, :])[None, :, :, None] - ugi)
    return jnp.stack(outs, axis=3).reshape(bsz, l, POOL_GROUPS, POOL_CH)


def pool_context(u):
    bsz, l, _ = u.shape
    ug = u.astype(jnp.float32).reshape(bsz, l, POOL_GROUPS, POOL_CH)
    outs = []
    for gi, w in enumerate(POOL_WINDOWS):
        ugi = ug[:, :, gi, :]
        s, cnt = box_sum(ugi, w, 1)
        outs.append(s / cnt[None, :, None] - ugi)
    return jnp.stack(outs, axis=2)


def mixer_sublayer(xs, g1, shift, scale, gate, h0_f, h0_b, pool_fn, w_in, w_decay_up, b_decay,
                   gla_norm_g, w_gla_proj, pool_w, pool_scale, w_pool_proj, w_out):
    bsz, l, _ = xs.shape
    h = modulate(xs, g1, shift, scale)
    proj_kvd, q, g, pool_in, merge = split_cols(h @ w_in, ALL_COLS)
    k, v, la_f, la_b = kv_and_decay(proj_kvd, w_decay_up, b_decay)
    q = to_heads(q, GLA_DK) * (GLA_DK ** -0.5)
    o, h_f, h_b = gla_bidirectional(q, k, v, la_f, la_b, h0_f, h0_b, True)
    o = rms_norm(o, gla_norm_g).transpose(0, 2, 1, 3).reshape(bsz, l, GLA_VAL).astype(xs.dtype)
    branch_gla = (o * jax.nn.silu(g)) @ w_gla_proj
    pooled = pool_fn(pool_in)
    mixed = jnp.einsum('blgc,gcd->blgd', pooled, pool_w.astype(jnp.float32)).reshape(bsz, l, POOL_WIDTH)
    branch_pool = (mixed * pool_scale.astype(jnp.float32)).astype(xs.dtype) @ w_pool_proj
    gate_gla, gate_pool = split_cols(jax.nn.sigmoid(merge), (D_MODEL, D_MODEL))
    y = (gate_gla * branch_gla + gate_pool * branch_pool) @ w_out
    return xs + gate * y, h_f, h_b


def ec_moe(h, w_router, w_gate_e, w_up_e, w_down_e):
    l = h.shape[1]
    cap = EC_CAPACITY * l // N_EXPERTS
    aff = jax.nn.softmax((h @ w_router).astype(jnp.float32), axis=-1)
    top_aff, top_idx = lax.top_k(jnp.swapaxes(aff, 1, 2), cap)

    def per_set(hs, idx, wgt):
        xs = hs[idx]
        a = jax.nn.silu(jnp.einsum('ecd,edf->ecf', xs, w_gate_e)) * jnp.einsum('ecd,edf->ecf', xs, w_up_e)
        y = jnp.einsum('ecf,efd->ecd', a, w_down_e) * wgt[..., None].astype(hs.dtype)
        return jnp.zeros_like(hs).at[idx.reshape(-1)].add(y.reshape(-1, hs.shape[-1]))

    return jax.vmap(per_set)(h, top_idx, top_aff)


def ffn_sublayer(xs, g2, shift, scale, gate, w_router, w_gate_e, w_up_e, w_down_e):
    return xs + gate * ec_moe(modulate(xs, g2, shift, scale), w_router, w_gate_e, w_up_e, w_down_e)


def setup_inputs(seed: int = 0) -> dict:
    key = jax.random.key(seed)
    ks = jax.random.split(key, 24)
    nrm = lambda k, shape, s: jax.random.normal(k, shape, jnp.float32) * s
    return {
        'x': nrm(ks[0], (BATCH, SEQ, D_MODEL), 1.0),
        'c': nrm(ks[1], (BATCH, D_MODEL), 1.0),
        'ctx': nrm(ks[2], (BATCH, CTX_LEN, D_MODEL), 1.0),
        'c_ctx': nrm(ks[3], (D_MODEL,), 1.0),
        'ada_w': nrm(ks[4], (DEPTH, D_MODEL, 6 * D_MODEL), 0.5 * D_MODEL ** -0.5),
        'ada_b': nrm(ks[5], (DEPTH, 6 * D_MODEL), 0.02),
        'norm1_g': 1.0 + nrm(ks[6], (DEPTH, D_MODEL), 0.02),
        'norm2_g': 1.0 + nrm(ks[7], (DEPTH, D_MODEL), 0.02),
        'w_in': nrm(ks[8], (DEPTH, D_MODEL, D_IN), D_MODEL ** -0.5),
        'w_decay_up': nrm(ks[9], (DEPTH, 2, GLA_RANK, GLA_KEY), GLA_RANK ** -0.5),
        'b_decay': nrm(ks[10], (DEPTH, 2, GLA_KEY), 0.1),
        'gla_norm_g': 1.0 + nrm(ks[11], (DEPTH, GLA_DV), 0.02),
        'w_gla_proj': nrm(ks[12], (DEPTH, GLA_VAL, D_MODEL), GLA_VAL ** -0.5),
        'pool_w': nrm(ks[13], (DEPTH, POOL_GROUPS, POOL_CH, POOL_CH), POOL_CH ** -0.5),
        'pool_scale': 1.0 + nrm(ks[14], (DEPTH, POOL_WIDTH), 0.1),
        'w_pool_proj': nrm(ks[15], (DEPTH, POOL_WIDTH, D_MODEL), POOL_WIDTH ** -0.5),
        'w_out': nrm(ks[16], (DEPTH, D_MODEL, D_MODEL), D_MODEL ** -0.5),
        'w_router': nrm(ks[17], (DEPTH, D_MODEL, N_EXPERTS), D_MODEL ** -0.5),
        'w_gate_e': nrm(ks[18], (DEPTH, N_EXPERTS, D_MODEL, D_EXPERT), D_MODEL ** -0.5),
        'w_up_e': nrm(ks[19], (DEPTH, N_EXPERTS, D_MODEL, D_EXPERT), D_MODEL ** -0.5),
        'w_down_e': nrm(ks[20], (DEPTH, N_EXPERTS, D_EXPERT, D_MODEL), D_EXPERT ** -0.5),
        'final_norm_g': 1.0 + nrm(ks[21], (D_MODEL,), 0.02),
    }


def reference(x, c, ctx, c_ctx, ada_w, ada_b, norm1_g, norm2_g, w_in, w_decay_up, b_decay,
              gla_norm_g, w_gla_proj, pool_w, pool_scale, w_pool_proj, w_out, w_router,
              w_gate_e, w_up_e, w_down_e, final_norm_g):
    zero_state = jnp.zeros((ctx.shape[0], GLA_HEADS, GLA_DK, GLA_DV), jnp.float32)
    for i in range(DEPTH):
        sh1, sc1, gt1, sh2, sc2, gt2 = jnp.split((jax.nn.silu(c) @ ada_w[i] + ada_b[i])[:, None, :], 6, axis=-1)
        csh1, csc1, cgt1, csh2, csc2, cgt2 = jnp.split(jax.nn.silu(c_ctx) @ ada_w[i] + ada_b[i], 6, axis=-1)
        mix_w = (w_in[i], w_decay_up[i], b_decay[i], gla_norm_g[i], w_gla_proj[i],
                 pool_w[i], pool_scale[i], w_pool_proj[i], w_out[i])
        moe_w = (w_router[i], w_gate_e[i], w_up_e[i], w_down_e[i])
        if i == DEPTH - 1:
            h_f, h_b = context_states(ctx, norm1_g[i], csh1, csc1, w_in[i], w_decay_up[i], b_decay[i])
        else:
            ctx_mixed, h_f, h_b = mixer_sublayer(ctx, norm1_g[i], csh1, csc1, cgt1, zero_state, zero_state,
                                                 pool_context, *mix_w)
            ctx = ffn_sublayer(ctx_mixed, norm2_g[i], csh2, csc2, cgt2, *moe_w)
        x, _, _ = mixer_sublayer(x, norm1_g[i], sh1, sc1, gt1, h_f, h_b, pool_latent, *mix_w)
        x = ffn_sublayer(x, norm2_g[i], sh2, sc2, gt2, *moe_w)
    return rms_norm(x, final_norm_g)
```

```cpp
#include <hip/hip_runtime.h>
#include <cstdio>
#include <cstdint>

#define LAS __attribute__((address_space(3)))
#define GAS __attribute__((address_space(1)))
typedef unsigned short bf16;
typedef short bf16x8 __attribute__((ext_vector_type(8)));
typedef float f32x4 __attribute__((ext_vector_type(4)));
typedef float f32x2 __attribute__((ext_vector_type(2)));
typedef unsigned u32x4 __attribute__((ext_vector_type(4)));
typedef unsigned u32x2 __attribute__((ext_vector_type(2)));

#ifndef ABL_NOMOE
#define ABL_NOMOE 0
#endif
#ifndef REP_PHASE
#define REP_PHASE -1
#endif
#ifndef REP_COUNT
#define REP_COUNT 1
#endif
#ifndef MK_COOP
#define MK_COOP 1
#endif
#ifndef MK_MULTI
#define MK_MULTI 0
#endif

constexpr int D = 1024, NB = 2, SEQ = 8192, M = NB * SEQ, LC = 256, MC = NB * LC, MT = M + MC;
constexpr int DIN = 4128;
constexpr int NCH = SEQ / 64, NCHC = LC / 64, NSLOT = NCH + NCHC;
constexpr int NE = 16, CAP = 1024;
constexpr float EPS = 1e-6f;
constexpr int NWAVES = 8, NT = 512;
constexpr int NPHASE = 14;

constexpr size_t MiB = 1u << 20;
constexpr size_t WS_CTL = 0, CTL_ZERO_BYTES = 64 * 1024;
constexpr size_t WS_MOD = 1 * MiB;
constexpr size_t WS_DEC = 1 * MiB + 128 * 1024;
constexpr size_t WS_WIN = 2 * MiB, WS_WO = 10 * MiB, WS_WG = 12 * MiB, WS_WC = 13 * MiB;
constexpr size_t WS_AFF = 14 * MiB, WS_INV = 15 * MiB, WS_IDX = 16 * MiB, WS_WSEL = 16 * MiB + 256 * 1024;
constexpr size_t WS_H1 = 20 * MiB;
constexpr size_t WS_ST = 20 * MiB, WS_H2 = 20 * MiB;
constexpr size_t WS_KB = 52 * MiB, WS_VB = 61 * MiB, WS_QB = 78 * MiB, WS_SG = 86 * MiB, WS_PI = 102 * MiB, WS_RB = 118 * MiB;
constexpr size_t WS_AG = 102 * MiB;
constexpr size_t WS_SM = 121 * MiB;
constexpr size_t WS_KV = 249 * MiB;
constexpr size_t WS_PO = 282 * MiB;
constexpr size_t WS_MG = 249 * MiB;
constexpr size_t WS_WGU = 185 * MiB, WS_WD = 52 * MiB, WS_ACT = 121 * MiB, WS_YB = 185 * MiB;
constexpr size_t WS_H1F = 249 * MiB;
constexpr size_t WS_WINM = 265 * MiB;
constexpr size_t WS_XS = 68 * MiB;
constexpr size_t WS_END = 300 * MiB;
constexpr int CW_BAR = 1024;

constexpr int LDS_BYTES = 155648;
constexpr int MISC_OFF = 153600;

#define LDS_WAIT() asm volatile("s_waitcnt lgkmcnt(0)" ::: "memory")
#define VM_WAIT() asm volatile("s_waitcnt vmcnt(0)" ::: "memory")
__device__ __forceinline__ unsigned f2bf(float f) { unsigned u = __builtin_bit_cast(unsigned, f); return (u + 0x7fffu + ((u >> 16) & 1u)) >> 16; }
__device__ __forceinline__ unsigned pk2(float lo, float hi) { return f2bf(lo) | (f2bf(hi) << 16); }
__device__ __forceinline__ float bf2f(unsigned h) { return __builtin_bit_cast(float, h << 16); }
__device__ __forceinline__ float bflo(unsigned w) { return __builtin_bit_cast(float, w << 16); }
__device__ __forceinline__ float bfhi(unsigned w) { return __builtin_bit_cast(float, w & 0xffff0000u); }
__device__ __forceinline__ unsigned cvt_pk_bf16(float lo, float hi) { unsigned r; asm volatile("v_cvt_pk_bf16_f32 %0, %1, %2" : "=v"(r) : "v"(lo), "v"(hi)); return r; }
__device__ __forceinline__ unsigned pk4_fp8(float a, float b, float c, float d) { int w = 0; w = __builtin_amdgcn_cvt_pk_fp8_f32(a, b, w, false); w = __builtin_amdgcn_cvt_pk_fp8_f32(c, d, w, true); return (unsigned)w; }
__device__ __forceinline__ float wave_sum(float v) {
#pragma unroll
    for (int o = 1; o < 64; o <<= 1) v += __shfl_xor(v, o);
    return v;
}
__device__ __forceinline__ float silu_f(float x) { return x / (1.f + __expf(-x)); }
__device__ __forceinline__ float sigmoid_f(float x) { return 1.f / (1.f + __expf(-x)); }
__device__ __forceinline__ float logsig_f(float z) { return fminf(z, 0.f) - log1pf(expf(-fabsf(z))); }

#define XB_TMO      128
#define XB_XCNT(j)  (256  + 64 * (j))
#define XB_XSUB(j)  (1280 + 64 * (j))
#define XB_XGEN(j)  (2304 + 64 * (j))
#define XB_TOP      3328
#define XB_TOPGEN   3392
#define XCD_BAR_WORDS 3456
#define XB_SPIN_CAP (1u << 20)
__device__ __forceinline__ unsigned xb_ld(unsigned* p)              { return __hip_atomic_load(p, __ATOMIC_RELAXED, __HIP_MEMORY_SCOPE_AGENT); }
__device__ __forceinline__ unsigned xb_add(unsigned* p, unsigned v) { return __hip_atomic_fetch_add(p, v, __ATOMIC_RELAXED, __HIP_MEMORY_SCOPE_AGENT); }
__device__ __forceinline__ unsigned xb_xcc_id() { return (unsigned)__builtin_amdgcn_s_getreg((3 << 11) | 20) & 0xFu; }
#define XB_SPIN(cond, bar) do { unsigned _sp = 0; while (cond) { __builtin_amdgcn_s_sleep(1); \
    if ((++_sp & 255u) == 0u) { if (xb_ld(&(bar)[XB_TMO])) break; if (_sp > XB_SPIN_CAP) { atomicAdd(&(bar)[XB_TMO], 1u); break; } } } } while (0)
struct XcdBarrier { unsigned* bar; unsigned x; volatile LAS unsigned* st; };
__device__ __forceinline__ XcdBarrier xcd_barrier_post(unsigned* bar, volatile LAS unsigned* st) {
    XcdBarrier b; b.bar = bar; b.x = xb_xcc_id(); b.st = st;
    if (threadIdx.x == 0) (void)xb_add(&bar[XB_XCNT(b.x)], 1u);
    return b;
}
__device__ __forceinline__ void xcd_barrier_complete(unsigned* bar, unsigned x, unsigned& nloc, unsigned& nx) {
    const unsigned G = gridDim.x * gridDim.y * gridDim.z;
    unsigned sum, cnt, mine, sp = 0u;
    for (;;) {
        sum = 0u; cnt = 0u; mine = 0u;
#pragma unroll
        for (unsigned j = 0; j < 16; ++j) { const unsigned c = xb_ld(&bar[XB_XCNT(j)]); sum += c; cnt += (c > 0u) ? 1u : 0u; mine = (j == x) ? c : mine; }
        if (sum == G) break;
        __builtin_amdgcn_s_sleep(1);
        if ((++sp & 255u) == 0u) { if (xb_ld(&bar[XB_TMO])) break; if (sp > XB_SPIN_CAP) { atomicAdd(&bar[XB_TMO], 1u); break; } }
    }
    nloc = mine > 0u ? mine : 1u; nx = cnt > 0u ? cnt : 1u;
}
__device__ __forceinline__ void xcd_barrier(const XcdBarrier& b) {
    asm volatile("s_waitcnt vmcnt(0)" ::: "memory");
    __syncthreads();
    if (threadIdx.x == 0) {
        unsigned* bar = b.bar;
        __builtin_amdgcn_s_waitcnt(0);
        unsigned nloc = b.st[0], nx = b.st[1];
        if (nloc == 0u) { xcd_barrier_complete(bar, b.x, nloc, nx); b.st[0] = nloc; b.st[1] = nx; }
        const unsigned old = xb_add(&bar[XB_XSUB(b.x)], 1u);
        const unsigned gen = old / nloc;
        if (old + 1u == (gen + 1u) * nloc) {
            __builtin_amdgcn_fence(__ATOMIC_RELEASE, "agent");
            asm volatile("s_waitcnt vmcnt(0)" ::: "memory");
            const unsigned og = xb_add(&bar[XB_TOP], 1u);
            const unsigned tg = og / nx;
            if (og + 1u == (tg + 1u) * nx) xb_add(&bar[XB_TOPGEN], 1u);
            else XB_SPIN(xb_ld(&bar[XB_TOPGEN]) == tg, bar);
            __builtin_amdgcn_fence(__ATOMIC_ACQUIRE, "agent");
            xb_add(&bar[XB_XGEN(b.x)], 1u);
            asm volatile("s_waitcnt vmcnt(0)" ::: "memory");
        } else {
            XB_SPIN(xb_ld(&bar[XB_XGEN(b.x)]) == gen, bar);
            __builtin_amdgcn_fence(__ATOMIC_ACQUIRE, "agent");
            asm volatile("s_waitcnt vmcnt(0)" ::: "memory");
        }
    }
    __syncthreads();
}

namespace pg8 {
constexpr int BM = 256, BK = 64, HALF = 128, HTB = HALF * BK * 2, STAGE_BYTES = 8 * HTB;
__device__ __forceinline__ int lds_byte(int r, int c) { const int st = (r >> 4) * 2 + (c >> 5), rr = r & 15, cc = c & 31, ob = rr * 64 + cc * 2; return st * 1024 + (ob ^ (((ob >> 9) & 1) << 5)); }
__device__ __forceinline__ void stage_rc(int b, int& R, int& C) { const int st = b / 1024, sb = b % 1024, swz = sb ^ (((sb >> 9) & 1) << 5); R = (st >> 1) * 16 + swz / 64; C = (st & 1) * 32 + (swz % 64) / 2; }
__device__ __forceinline__ int perm32(int rho) { const int n = rho >> 4, i = rho & 15; return 8 * (i >> 2) + 4 * n + (i & 3); }
struct Unit { int pm, pn, aux, keep; };
typedef int v8i __attribute__((ext_vector_type(8)));
typedef int v4i __attribute__((ext_vector_type(4)));
__device__ __forceinline__ void xcd_tile(int L, int nM, int nN, int& pm, int& pn) {
    const int nwg = nM * nN; int wgid = L;
    { const int q = nwg / 8, r = nwg % 8, xcd = wgid % 8, off = wgid / 8; wgid = (xcd < r ? xcd * (q + 1) : r * (q + 1) + (xcd - r) * q) + off; }
    const int nig = 8 * nN, gid = wgid / nig, fm = gid * 8, gsz = (nM - fm) < 8 ? (nM - fm) : 8;
    pm = fm + ((wgid % nig) % gsz); pn = (wgid % nig) / gsz;
}

template <class Epi, class Sched, bool GATHER, bool FP8 = false>
__device__ __forceinline__ void gemm_phase(LAS unsigned char* lds, const Sched& S, const Epi& E) {
    int tid = threadIdx.x; asm volatile("" : "+v"(tid));
    const int wid = __builtin_amdgcn_readfirstlane(tid >> 6), lane = tid & 63, wr = wid >> 2, wc = wid & 3, fr = lane & 15, fq = lane >> 4;
    const int K = S.K, KB = FP8 ? K : 2 * K, nt = KB / (2 * BK);
    unsigned voffA[2], voffB[2]; int Rs[2], Cb[2];
#pragma unroll
    for (int i = 0; i < 2; ++i) { int R, C; stage_rc(tid * 16 + i * 8192, R, C); const int Rb = Epi::PERM ? ((R & ~31) + perm32(R & 31)) : R;
        Rs[i] = R; Cb[i] = C * 2; voffA[i] = (unsigned)(R * KB + C * 2); voffB[i] = (unsigned)(Rb * KB + C * 2); }
    const size_t kstep = (size_t)(BK * 2);
    const size_t hstep = (size_t)HALF * KB;
    const size_t hstepA = GATHER ? 0 : hstep;
    const unsigned ldsw = (unsigned)wid * 1024u;
    const int aoff = FP8 ? lds_byte(wr * 64 + fr, fq * 16) : lds_byte(wr * 64 + fr, fq * 8), boff = FP8 ? lds_byte(wc * 32 + fr, fq * 16) : lds_byte(wc * 32 + fr, fq * 8);
#define PG8_SA(b, h) (((b) * 2 + (h)) * HTB)
#define PG8_SB(b, h) ((4 + (b) * 2 + (h)) * HTB)
#define PG8_STAGE(bufoff, gbase, voff, W) do { _Pragma("unroll") for (int _i = 0; _i < 2; ++_i) { \
        if constexpr (FP8) __builtin_amdgcn_raw_ptr_buffer_load_lds(rsrc##W, (LAS unsigned*)(lds + (bufoff) + ldsw + _i * 8192), 16, (int)(voff)[_i], (int)(unsigned)((const char*)(gbase) - base##W), 0, 0); \
        else __builtin_amdgcn_global_load_lds((const unsigned*)((const char*)(gbase) + (voff)[_i]), (LAS unsigned*)(lds + (bufoff) + ldsw + _i * 8192), 16, 0, 0); } } while (0)
#define PG8_LDA(dst, b, h) do { _Pragma("unroll") for (int m = 0; m < 4; ++m) { \
        if constexpr (FP8) { const v4i _lo = *(const LAS v4i*)(lds + PG8_SA(b, h) + aoff + m * 2048), _hi = *(const LAS v4i*)(lds + PG8_SA(b, h) + aoff + m * 2048 + 16); dst##8[m] = __builtin_shufflevector(_lo, _hi, 0, 1, 2, 3, 4, 5, 6, 7); } \
        else { _Pragma("unroll") for (int k = 0; k < 2; ++k) dst[m][k] = *(const LAS bf16x8*)(lds + PG8_SA(b, h) + aoff + m * 2048 + k * 1024); } } } while (0)
#define PG8_LDB(dst, b, h) do { _Pragma("unroll") for (int n = 0; n < 2; ++n) { \
        if constexpr (FP8) { const v4i _lo = *(const LAS v4i*)(lds + PG8_SB(b, h) + boff + n * 2048), _hi = *(const LAS v4i*)(lds + PG8_SB(b, h) + boff + n * 2048 + 16); dst##8[n] = __builtin_shufflevector(_lo, _hi, 0, 1, 2, 3, 4, 5, 6, 7); } \
        else { _Pragma("unroll") for (int k = 0; k < 2; ++k) dst[n][k] = *(const LAS bf16x8*)(lds + PG8_SB(b, h) + boff + n * 2048 + k * 1024); } } } while (0)
#define PG8_MMA(ai, bj, At, Bt) do { __builtin_amdgcn_s_setprio(1); \
        if constexpr (FP8) { _Pragma("unroll") for (int m = 0; m < 4; ++m) _Pragma("unroll") for (int n = 0; n < 2; ++n) \
            acc[ai][bj][m][n] = __builtin_amdgcn_mfma_scale_f32_16x16x128_f8f6f4(Bt##8[n], At##8[m], acc[ai][bj][m][n], 0, 0, 0, 0, 0, 0); } \
        else { _Pragma("unroll") for (int m = 0; m < 4; ++m) _Pragma("unroll") for (int n = 0; n < 2; ++n) _Pragma("unroll") for (int k = 0; k < 2; ++k) \
            acc[ai][bj][m][n] = __builtin_amdgcn_mfma_f32_16x16x32_bf16(Bt[n][k], At[m][k], acc[ai][bj][m][n], 0, 0, 0); } \
        __builtin_amdgcn_s_setprio(0); } while (0)
#define PG8_WAIT_V(n) asm volatile("s_waitcnt vmcnt(" #n ")" ::: "memory")
#define PG8_WAIT_L(n) asm volatile("s_waitcnt lgkmcnt(" #n ")" ::: "memory")
#define PG8_BAR __builtin_amdgcn_s_barrier()
#define PG8_SCHED __builtin_amdgcn_sched_barrier(0)
    Unit cur, nxt; int ui = 0;
    if (!S.next(0, cur)) return;
    const char* baseA = S.base_a(); const char* baseB = S.base_b();
    const __amdgpu_buffer_rsrc_t rsrcA = __builtin_amdgcn_make_buffer_rsrc((void*)baseA, 0, 0x7fffffff, 0x00020000), rsrcB = __builtin_amdgcn_make_buffer_rsrc((void*)baseB, 0, 0x7fffffff, 0x00020000);
    f32x4 acc[2][2][4][2];
#pragma unroll
    for (int a = 0; a < 2; ++a)
#pragma unroll
        for (int b = 0; b < 2; ++b)
#pragma unroll
            for (int m = 0; m < 4; ++m)
#pragma unroll
                for (int n = 0; n < 2; ++n) acc[a][b][m][n] = (f32x4){0.f, 0.f, 0.f, 0.f};
    bf16x8 At[4][2], B0[2][2], B1[2][2]; v8i At8[4], B08[2], B18[2];
    const char* cA = S.a_base(cur); const char* cB = S.b_base(cur);
    unsigned cv0[2], cv1[2], nv0[2], nv1[2];
#pragma unroll
    for (int i = 0; i < 2; ++i) {
        if constexpr (GATHER) { cv0[i] = (unsigned)S.a_row(cur, Rs[i]) * (unsigned)KB + (unsigned)Cb[i]; cv1[i] = (unsigned)S.a_row(cur, HALF + Rs[i]) * (unsigned)KB + (unsigned)Cb[i]; }
        else { cv0[i] = voffA[i]; cv1[i] = voffA[i]; }
        nv0[i] = cv0[i]; nv1[i] = cv1[i];
    }
    PG8_STAGE(PG8_SB(0, 0), cB, voffB, B); PG8_STAGE(PG8_SB(0, 1), cB + hstep, voffB, B); PG8_STAGE(PG8_SA(0, 0), cA, cv0, A); PG8_STAGE(PG8_SA(0, 1), cA + hstepA, cv1, A);
    if (wr == 1) PG8_BAR;
    PG8_WAIT_V(2); PG8_BAR;
    PG8_STAGE(PG8_SB(1, 0), cB + kstep, voffB, B); PG8_STAGE(PG8_SA(1, 0), cA + kstep, cv0, A); PG8_STAGE(PG8_SB(1, 1), cB + hstep + kstep, voffB, B);
    PG8_WAIT_V(6); PG8_BAR;
    for (;;) {
        const bool has_next = S.next(ui + 1, nxt);
        const char* nA = has_next ? S.a_base(nxt) : cA; const char* nB = has_next ? S.b_base(nxt) : cB;
        if constexpr (GATHER) {
#pragma unroll
            for (int i = 0; i < 2; ++i) {
                if (has_next) { nv0[i] = (unsigned)S.a_row(nxt, Rs[i]) * (unsigned)KB + (unsigned)Cb[i]; nv1[i] = (unsigned)S.a_row(nxt, HALF + Rs[i]) * (unsigned)KB + (unsigned)Cb[i]; }
                else { nv0[i] = cv0[i]; nv1[i] = cv1[i]; }
            }
        }
        for (int t = 0; t < nt; t += 2) {
            const bool last = (t == nt - 2);
            const char* a1 = cA + (size_t)(t + 1) * kstep;
            const char* a2 = last ? nA : cA + (size_t)(t + 2) * kstep; const char* b2 = last ? nB : cB + (size_t)(t + 2) * kstep;
            const char* a3 = a2 + kstep; const char* b3 = b2 + kstep;
            unsigned s0[2], s1[2];
#pragma unroll
            for (int i = 0; i < 2; ++i) { s0[i] = (GATHER && last) ? nv0[i] : cv0[i]; s1[i] = (GATHER && last) ? nv1[i] : cv1[i]; }
            PG8_LDB(B0, 0, 0); PG8_LDB(B1, 0, 1); PG8_SCHED; PG8_LDA(At, 0, 0); PG8_STAGE(PG8_SA(1, 1), a1 + hstepA, cv1, A);
            PG8_WAIT_V(8); PG8_WAIT_L(0); PG8_BAR; PG8_MMA(0, 0, At, B0); PG8_MMA(0, 1, At, B1); PG8_BAR; PG8_SCHED;
            PG8_LDA(At, 0, 1); PG8_STAGE(PG8_SB(0, 0), b2, voffB, B); PG8_STAGE(PG8_SB(0, 1), b2 + hstep, voffB, B); PG8_STAGE(PG8_SA(0, 0), a2, s0, A);
            PG8_WAIT_V(8); PG8_WAIT_L(0); PG8_BAR; PG8_MMA(1, 0, At, B0); PG8_MMA(1, 1, At, B1); PG8_BAR; PG8_SCHED;
            PG8_LDB(B0, 1, 0); PG8_LDB(B1, 1, 1); PG8_SCHED; PG8_LDA(At, 1, 0); PG8_STAGE(PG8_SA(0, 1), a2 + hstepA, s1, A);
            PG8_WAIT_V(8); PG8_WAIT_L(0); PG8_BAR; PG8_MMA(0, 0, At, B0); PG8_MMA(0, 1, At, B1); PG8_BAR; PG8_SCHED;
            PG8_LDA(At, 1, 1); PG8_STAGE(PG8_SB(1, 0), b3, voffB, B); PG8_STAGE(PG8_SB(1, 1), b3 + hstep, voffB, B); PG8_STAGE(PG8_SA(1, 0), a3, s0, A);
            PG8_WAIT_V(8); PG8_WAIT_L(0); PG8_BAR; PG8_MMA(1, 0, At, B0); PG8_MMA(1, 1, At, B1); PG8_BAR; PG8_SCHED;
        }
        if (wr == 0) PG8_BAR;
        E(acc, cur, wr, wc, fr, fq);
        if (!has_next) break;
        E.post(acc, cur, wr, wc, fr, fq);
        cur = nxt; cA = nA; cB = nB; ++ui;
#pragma unroll
        for (int i = 0; i < 2; ++i) { cv0[i] = nv0[i]; cv1[i] = nv1[i]; }
        if (wr == 1) PG8_BAR;
    }
    PG8_WAIT_V(0);
    PG8_BAR;
#undef PG8_SA
#undef PG8_SB
#undef PG8_STAGE
#undef PG8_LDA
#undef PG8_LDB
#undef PG8_MMA
#undef PG8_WAIT_V
#undef PG8_WAIT_L
#undef PG8_BAR
#undef PG8_SCHED
}
}

using pg8::Unit;
struct SchedDense {
    int G, c, K, nM, nN; const char* A; const char* B; int i0, i1, eb;
    __device__ __forceinline__ bool next(int i, Unit& u) const { const int L = (i + i0) * G + c; if (i + i0 >= i1 || L >= nM * nN) return false; pg8::xcd_tile(L, nM, nN, u.pm, u.pn); u.aux = 0; u.keep = 0; return true; }
    __device__ __forceinline__ const char* a_base(const Unit& u) const { return A + (size_t)u.pm * 256 * K * eb; }
    __device__ __forceinline__ const char* b_base(const Unit& u) const { return B + (size_t)u.pn * 256 * K * eb; }
    __device__ __forceinline__ int a_row(const Unit&, int) const { return 0; }
    __device__ __forceinline__ const char* base_a() const { return A; }
    __device__ __forceinline__ const char* base_b() const { return B; }
};
struct SchedPair {
    int G, c, K; const char *A0, *A1, *B0, *B1;
    __device__ __forceinline__ bool next(int i, Unit& u) const { const int p = (i >> 1) * G + c; if (p >= 256) return false; pg8::xcd_tile(p, 64, 4, u.pm, u.pn); u.aux = i & 1; u.keep = 0; return true; }
    __device__ __forceinline__ const char* a_base(const Unit& u) const { return (u.aux ? A1 : A0) + (size_t)u.pm * 256 * K * 2; }
    __device__ __forceinline__ const char* b_base(const Unit& u) const { return (u.aux ? B1 : B0) + (size_t)u.pn * 256 * K * 2; }
    __device__ __forceinline__ int a_row(const Unit&, int) const { return 0; }
    __device__ __forceinline__ const char* base_a() const { return A0; }
    __device__ __forceinline__ const char* base_b() const { return B0; }
};
struct SchedMoe1 {
    int G, c, K; const char* A; const char* B; int i0, i1;
    __device__ __forceinline__ bool next(int i, Unit& u) const { const int L = (i + i0) * G + c; if (i + i0 >= i1 || L >= 1024) return false;
        const int xcd = L & 7, q = L >> 3, round = q >> 5, slot = q & 31, e = xcd + 8 * (round >> 1), u64 = (round & 1) * 32 + slot, mrow = u64 & 7;
        u.pn = u64 >> 3; u.pm = mrow & 3; u.aux = (mrow >> 2) * 16 + e; u.keep = 0; return true; }
    __device__ __forceinline__ const char* a_base(const Unit& u) const { return A + ((size_t)u.aux * 1024 + (size_t)u.pm * 256) * K; }
    __device__ __forceinline__ const char* b_base(const Unit& u) const { return B + ((size_t)(u.aux & 15) * 2048 + (size_t)u.pn * 256) * K; }
    __device__ __forceinline__ int a_row(const Unit&, int) const { return 0; }
    __device__ __forceinline__ const char* base_a() const { return A; }
    __device__ __forceinline__ const char* base_b() const { return B; }
};
struct SchedMoe2 {
    int G, c, K; const char* A; const char* B;
    __device__ __forceinline__ bool next(int i, Unit& u) const { const int L = i * G + c; if (L >= 512) return false;
        const int xcd = L & 7, q = L >> 3, round = q >> 5, slot = q & 31, e = xcd + 8 * round, mrow = slot & 7;
        u.pn = slot >> 3; u.pm = mrow & 3; u.aux = (mrow >> 2) * 16 + e; u.keep = 0; return true; }
    __device__ __forceinline__ const char* a_base(const Unit& u) const { return A + ((size_t)u.aux * 1024 + (size_t)u.pm * 256) * K; }
    __device__ __forceinline__ const char* b_base(const Unit& u) const { return B + ((size_t)(u.aux & 15) * 1024 + (size_t)u.pn * 256) * K; }
    __device__ __forceinline__ int a_row(const Unit&, int) const { return 0; }
    __device__ __forceinline__ const char* base_a() const { return A; }
    __device__ __forceinline__ const char* base_b() const { return B; }
};

typedef f32x4 AccT[2][2][4][2];
struct EpiInproj {
    static constexpr bool PERM = true;
    bf16 *KBp, *VBp, *QBp, *SGp, *PIp, *SMp; int pn_off; float sc;
    __device__ __forceinline__ void post(AccT& acc, const Unit&, int, int, int, int) const {
#pragma unroll
        for (int a = 0; a < 2; ++a)
#pragma unroll
            for (int b = 0; b < 2; ++b)
#pragma unroll
                for (int m = 0; m < 4; ++m)
#pragma unroll
                    for (int n = 0; n < 2; ++n) acc[a][b][m][n] = (f32x4){0.f, 0.f, 0.f, 0.f};
    }
    __device__ __forceinline__ void operator()(const AccT& acc, const Unit& u, int wr, int wc, int fr, int fq) const {
        const int pn = u.pn + pn_off; bf16* base; int ld, colt, act;
        if (pn == 0) { base = KBp; ld = 256; colt = 0; act = 0; }
        else if (pn < 3) { base = VBp; ld = 512; colt = (pn - 1) * 256; act = 0; }
        else if (pn == 3) { base = QBp; ld = 256; colt = 0; act = 3; }
        else if (pn < 6) { base = SGp; ld = 512; colt = (pn - 4) * 256; act = 1; }
        else if (pn < 8) { base = PIp; ld = 512; colt = (pn - 6) * 256; act = 0; }
        else { base = SMp; ld = 2048; colt = (pn - 8) * 256; act = 2; }
        const int row0 = u.pm * 256 + wr * 64 + fr, col0 = colt + wc * 32 + 8 * fq;
#pragma unroll
        for (int ai = 0; ai < 2; ++ai)
#pragma unroll
            for (int m = 0; m < 4; ++m) { bf16* rowp = base + (size_t)(row0 + ai * 128 + m * 16) * ld + col0;
#pragma unroll
                for (int bj = 0; bj < 2; ++bj) { f32x4 v0 = acc[ai][bj][m][0], v1 = acc[ai][bj][m][1];
                    if (act == 1) {
#pragma unroll
                        for (int j = 0; j < 4; ++j) { v0[j] = silu_f(v0[j]); v1[j] = silu_f(v1[j]); } }
                    else if (act == 2) {
#pragma unroll
                        for (int j = 0; j < 4; ++j) { v0[j] = sigmoid_f(sc * v0[j]); v1[j] = sigmoid_f(sc * v1[j]); } }
                    else if (act == 3) { v0 = v0 * 0.125f; v1 = v1 * 0.125f; }
                    u32x4 w; w.x = cvt_pk_bf16(v0[0], v0[1]); w.y = cvt_pk_bf16(v0[2], v0[3]); w.z = cvt_pk_bf16(v1[0], v1[1]); w.w = cvt_pk_bf16(v1[2], v1[3]);
                    *(u32x4*)(rowp + bj * 128) = w; } }
    }
};
struct EpiMerge {
    static constexpr bool PERM = true;
    const bf16* SMp; bf16* MGp;
    __device__ __forceinline__ void post(AccT& acc, const Unit&, int, int, int, int) const {
#pragma unroll
        for (int a = 0; a < 2; ++a)
#pragma unroll
            for (int b = 0; b < 2; ++b)
#pragma unroll
                for (int m = 0; m < 4; ++m)
#pragma unroll
                    for (int n = 0; n < 2; ++n) acc[a][b][m][n] = (f32x4){0.f, 0.f, 0.f, 0.f};
    }
    __device__ __forceinline__ void operator()(const AccT& acc, const Unit& u, int wr, int wc, int fr, int fq) const {
        const int row0 = u.pm * 256 + wr * 64 + fr, col0 = u.pn * 256 + wc * 32 + 8 * fq; const int second = u.aux;
#pragma unroll
        for (int ai = 0; ai < 2; ++ai)
#pragma unroll
            for (int m = 0; m < 4; ++m) { const size_t ro = (size_t)(row0 + ai * 128 + m * 16);
#pragma unroll
                for (int bj = 0; bj < 2; ++bj) { const u32x4 g = *(const u32x4*)(SMp + ro * 2048 + second * 1024 + col0 + bj * 128);
                    u32x4 pv = {0u, 0u, 0u, 0u}; if (second) pv = *(const u32x4*)(MGp + ro * 1024 + col0 + bj * 128);
                    const f32x4 v0 = acc[ai][bj][m][0], v1 = acc[ai][bj][m][1];
                    u32x4 w; w.x = cvt_pk_bf16(bflo(pv[0]) + v0[0] * bflo(g[0]), bfhi(pv[0]) + v0[1] * bfhi(g[0])); w.y = cvt_pk_bf16(bflo(pv[1]) + v0[2] * bflo(g[1]), bfhi(pv[1]) + v0[3] * bfhi(g[1]));
                    w.z = cvt_pk_bf16(bflo(pv[2]) + v1[0] * bflo(g[2]), bfhi(pv[2]) + v1[1] * bfhi(g[2])); w.w = cvt_pk_bf16(bflo(pv[3]) + v1[2] * bflo(g[3]), bfhi(pv[3]) + v1[3] * bfhi(g[3]));
                    *(u32x4*)(MGp + ro * 1024 + col0 + bj * 128) = w; }
                asm volatile("" ::: "memory"); }
    }
};
struct EpiOut {
    static constexpr bool PERM = false;
    const float* X; const float* MODp; float* X1;
    __device__ __forceinline__ void post(AccT& acc, const Unit&, int, int, int, int) const {
#pragma unroll
        for (int a = 0; a < 2; ++a)
#pragma unroll
            for (int b = 0; b < 2; ++b)
#pragma unroll
                for (int m = 0; m < 4; ++m)
#pragma unroll
                    for (int n = 0; n < 2; ++n) acc[a][b][m][n] = (f32x4){0.f, 0.f, 0.f, 0.f};
    }
    __device__ __forceinline__ void operator()(const AccT& acc, const Unit& u, int wr, int wc, int fr, int fq) const {
        const int row0 = u.pm * 256 + wr * 64 + fr, col0 = u.pn * 256 + wc * 32 + 4 * fq;
        const float* gt = MODp + (size_t)(u.pm >> 5) * 6144 + 2048;
        f32x4 gv[2][2];
#pragma unroll
        for (int bj = 0; bj < 2; ++bj)
#pragma unroll
            for (int n = 0; n < 2; ++n) gv[bj][n] = *(const f32x4*)(gt + col0 + bj * 128 + n * 16);
#pragma unroll
        for (int ai = 0; ai < 2; ++ai)
#pragma unroll
            for (int m = 0; m < 4; ++m) { const size_t off = (size_t)(row0 + ai * 128 + m * 16) * 1024 + col0;
#pragma unroll
                for (int bj = 0; bj < 2; ++bj)
#pragma unroll
                    for (int n = 0; n < 2; ++n) { const f32x4 xv = __builtin_nontemporal_load((const f32x4*)(X + off + bj * 128 + n * 16)); *(f32x4*)(X1 + off + bj * 128 + n * 16) = xv + gv[bj][n] * acc[ai][bj][m][n]; }
                asm volatile("" ::: "memory"); }
    }
};
struct EpiMoe1 {
    static constexpr bool PERM = true;
    unsigned char* ACTp;
    __device__ __forceinline__ void post(AccT& acc, const Unit&, int, int, int, int) const {
#pragma unroll
        for (int a = 0; a < 2; ++a)
#pragma unroll
            for (int b = 0; b < 2; ++b)
#pragma unroll
                for (int m = 0; m < 4; ++m)
#pragma unroll
                    for (int n = 0; n < 2; ++n) acc[a][b][m][n] = (f32x4){0.f, 0.f, 0.f, 0.f};
    }
    __device__ __forceinline__ void operator()(const AccT& acc, const Unit& u, int wr, int wc, int fr, int fq) const {
        const int row0 = u.aux * 1024 + u.pm * 256 + wr * 64 + fr, col0 = u.pn * 128 + wc * 32 + 8 * fq;
#pragma unroll
        for (int ai = 0; ai < 2; ++ai)
#pragma unroll
            for (int m = 0; m < 4; ++m) { unsigned char* rowp = ACTp + (size_t)(row0 + ai * 128 + m * 16) * 1024 + col0;
                f32x4 a0, a1;
#pragma unroll
                for (int j = 0; j < 4; ++j) { a0[j] = silu_f(0.0625f * acc[ai][0][m][0][j]) * (0.0625f * acc[ai][1][m][0][j]); a1[j] = silu_f(0.0625f * acc[ai][0][m][1][j]) * (0.0625f * acc[ai][1][m][1][j]); }
                *(u32x2*)rowp = (u32x2){pk4_fp8(a0[0], a0[1], a0[2], a0[3]), pk4_fp8(a1[0], a1[1], a1[2], a1[3])}; }
    }
};
struct EpiMoe2 {
    static constexpr bool PERM = true;
    bf16* YBp; const float* WSELp; const float* MODp;
    __device__ __forceinline__ void post(AccT& acc, const Unit&, int, int, int, int) const {
#pragma unroll
        for (int a = 0; a < 2; ++a)
#pragma unroll
            for (int b = 0; b < 2; ++b)
#pragma unroll
                for (int m = 0; m < 4; ++m)
#pragma unroll
                    for (int n = 0; n < 2; ++n) acc[a][b][m][n] = (f32x4){0.f, 0.f, 0.f, 0.f};
    }
    __device__ __forceinline__ void operator()(const AccT& acc, const Unit& u, int wr, int wc, int fr, int fq) const {
        const int row0 = u.aux * 1024 + u.pm * 256 + wr * 64 + fr, col0 = u.pn * 256 + wc * 32 + 8 * fq;
        const float* gt = MODp + (size_t)(u.aux >> 4) * 6144 + 5120 + col0;
        f32x4 gv[2][2];
#pragma unroll
        for (int bj = 0; bj < 2; ++bj)
#pragma unroll
            for (int n = 0; n < 2; ++n) gv[bj][n] = *(const f32x4*)(gt + bj * 128 + n * 4);
#pragma unroll
        for (int ai = 0; ai < 2; ++ai)
#pragma unroll
            for (int m = 0; m < 4; ++m) { const int r = row0 + ai * 128 + m * 16; const float ws = 0.0625f * WSELp[r]; bf16* rowp = YBp + (size_t)r * 1024 + col0;
#pragma unroll
                for (int bj = 0; bj < 2; ++bj) { const f32x4 v0 = acc[ai][bj][m][0] * gv[bj][0] * ws, v1 = acc[ai][bj][m][1] * gv[bj][1] * ws;
                    u32x4 w; w.x = cvt_pk_bf16(v0[0], v0[1]); w.y = cvt_pk_bf16(v0[2], v0[3]); w.z = cvt_pk_bf16(v1[0], v1[1]); w.w = cvt_pk_bf16(v1[2], v1[3]);
                    *(u32x4*)(rowp + bj * 128) = w; } }
    }
};

struct Args { const float* in[22]; float* out; unsigned char* ws; int ph_lo, ph_hi; };
enum { I_X = 0, I_C, I_CTX, I_CCTX, I_ADAW, I_ADAB, I_N1G, I_N2G, I_WIN, I_WDU, I_BDEC, I_GNG, I_WGLA, I_POOLW, I_POOLS, I_WPOOL, I_WOUT, I_WROUTER, I_WGATE, I_WUP, I_WDOWN, I_FNG };

__device__ __forceinline__ bf16x8 ldfrag(const LAS bf16* base, int stride, int row0, int k0, int lane) { return *(const LAS bf16x8*)(base + (row0 + (lane & 15)) * stride + k0 + 8 * (lane >> 4)); }
#define MFMA16(a, b, c) __builtin_amdgcn_mfma_f32_16x16x32_bf16(a, b, c, 0, 0, 0)

__device__ __forceinline__ void transpose_item(const float* W, int ldw, int k0, int nsrc0, bf16* WT, int Kd, int dst_row0, LAS float* scr, int lane) {
#pragma unroll 8
    for (int i = 0; i < 32; ++i) { const int kk = 2 * i + (lane >> 5); scr[kk * 33 + (lane & 31)] = W[(size_t)(k0 + kk) * ldw + nsrc0 + (lane & 31)]; }
    LDS_WAIT(); asm volatile("" ::: "memory");
    const int c = lane & 7;
#pragma unroll
    for (int j = 0; j < 4; ++j) { const int n = (lane >> 3) + 8 * j; const LAS float* s = scr + (8 * c) * 33 + n;
        u32x4 o; o.x = pk2(s[0 * 33], s[1 * 33]); o.y = pk2(s[2 * 33], s[3 * 33]); o.z = pk2(s[4 * 33], s[5 * 33]); o.w = pk2(s[6 * 33], s[7 * 33]);
        *(u32x4*)(WT + (size_t)(dst_row0 + n) * Kd + k0 + 8 * c) = o; }
    LDS_WAIT(); asm volatile("" ::: "memory");
}

struct CvtItem { const float* src; bf16* dst; int ld2, drow8, f8; };
#define CVT_LOAD(v, c) do { _Pragma("unroll") for (int _j = 0; _j < 32; ++_j) v[_j] = __builtin_nontemporal_load((c).src + (size_t)_j * (c).ld2); } while (0)
#define CVT_STORE(v, c) do { _Pragma("unroll") for (int _j = 0; _j < 32; ++_j) scr[(2 * _j + (lane >> 5)) * 33 + (lane & 31)] = v[_j]; \
        LDS_WAIT(); asm volatile("" ::: "memory"); \
        _Pragma("unroll") for (int _q = 0; _q < 4; ++_q) { const LAS float* _s = scr + (8 * (lane & 7)) * 33 + (lane >> 3) + 8 * _q; u32x4 _o; \
            _o.x = pk2(_s[0 * 33], _s[1 * 33]); _o.y = pk2(_s[2 * 33], _s[3 * 33]); _o.z = pk2(_s[4 * 33], _s[5 * 33]); _o.w = pk2(_s[6 * 33], _s[7 * 33]); *(u32x4*)((c).dst + (size_t)_q * (c).drow8) = _o; } \
        LDS_WAIT(); asm volatile("" ::: "memory"); } while (0)
__device__ __forceinline__ CvtItem cvt_item_gu(const Args& a, int it, int lane) {
    const int e = it >> 10, mat = (it >> 9) & 1, q = it & 511, kb = q >> 5, nb = q & 31, n0 = nb * 32, k0 = kb * 64, nrow = n0 + (lane >> 3);
    CvtItem c; c.ld2 = 2048; c.drow8 = 8192; c.f8 = 1;
    c.src = a.in[mat ? I_WUP : I_WGATE] + (size_t)e * 1048576 + (size_t)(k0 + (lane >> 5)) * 1024 + n0 + (lane & 31);
    c.dst = (bf16*)(a.ws + WS_WGU + ((size_t)e * 2048 + (nrow >> 7) * 256 + mat * 128 + (nrow & 127)) * 1024 + k0 + 8 * (lane & 7));
    return c;
}
__device__ __forceinline__ CvtItem cvt_item_dn(const Args& a, int it, int lane) {
    const int e = it >> 9, q = it & 511, kb = q >> 5, nb = q & 31, n0 = nb * 32, k0 = kb * 64;
    CvtItem c; c.ld2 = 2048; c.drow8 = 8192; c.f8 = 1;
    c.src = a.in[I_WDOWN] + (size_t)e * 1048576 + (size_t)(k0 + (lane >> 5)) * 1024 + n0 + (lane & 31);
    c.dst = (bf16*)(a.ws + WS_WD + ((size_t)e * 1024 + n0 + (lane >> 3)) * 1024 + k0 + 8 * (lane & 7));
    return c;
}
#define CVT_STORE8(v, c) do { _Pragma("unroll") for (int _j = 0; _j < 32; ++_j) scr[(2 * _j + (lane >> 5)) * 33 + (lane & 31)] = v[_j]; \
        LDS_WAIT(); asm volatile("" ::: "memory"); \
        _Pragma("unroll") for (int _q = 0; _q < 4; ++_q) { const LAS float* _s = scr + (8 * (lane & 7)) * 33 + (lane >> 3) + 8 * _q; \
            *(u32x2*)((unsigned char*)(c).dst + (size_t)_q * (c).drow8) = (u32x2){pk4_fp8(16.f * _s[0 * 33], 16.f * _s[1 * 33], 16.f * _s[2 * 33], 16.f * _s[3 * 33]), pk4_fp8(16.f * _s[4 * 33], 16.f * _s[5 * 33], 16.f * _s[6 * 33], 16.f * _s[7 * 33])}; } \
        LDS_WAIT(); asm volatile("" ::: "memory"); } while (0)
__device__ __forceinline__ CvtItem cvt_item_small(const Args& a, int it, int lane) {
    CvtItem c; int r = it;
    c.f8 = 0;
    if (r < 2048) { const int kb = r >> 7, nb = r & 127, n0 = nb * 32, k0 = kb * 64; c.ld2 = 2 * DIN; c.drow8 = 8192;
        c.src = a.in[I_WIN] + (size_t)(k0 + (lane >> 5)) * DIN + n0 + (n0 >= 768 ? 32 : 0) + (lane & 31);
        if (n0 < 2048) c.dst = (bf16*)(a.ws + WS_WIN) + (size_t)(n0 + (lane >> 3)) * 1024 + k0 + 8 * (lane & 7);
        else { c.f8 = 1; c.dst = (bf16*)(a.ws + WS_WINM + (size_t)(n0 - 2048 + (lane >> 3)) * 1024 + k0 + 8 * (lane & 7)); }
        return c; }
    r -= 2048;
    if (r < 512) { const int kb = r >> 5, nb = r & 31, n0 = nb * 32, k0 = kb * 64; c.ld2 = 2048; c.drow8 = 8192;
        c.src = a.in[I_WOUT] + (size_t)(k0 + (lane >> 5)) * 1024 + n0 + (lane & 31); c.dst = (bf16*)(a.ws + WS_WO) + (size_t)(n0 + (lane >> 3)) * 1024 + k0 + 8 * (lane & 7); return c; }
    r -= 512;
    { const int kb = r >> 5, nb = r & 31, n0 = nb * 32, k0 = kb * 64; c.ld2 = 2048; c.drow8 = 4096;
      c.src = a.in[I_WGLA] + (size_t)(k0 + (lane >> 5)) * 1024 + n0 + (lane & 31); c.dst = (bf16*)(a.ws + WS_WG) + (size_t)(n0 + (lane >> 3)) * 512 + k0 + 8 * (lane & 7); return c; }
}
template <int KIND> __device__ __forceinline__ CvtItem cvt_item(const Args& a, int it, int lane) { if constexpr (KIND == 0) return cvt_item_small(a, it, lane); else if constexpr (KIND == 1) return cvt_item_gu(a, it, lane); else return cvt_item_dn(a, it, lane); }
template <int KIND>
__device__ __forceinline__ void convert_items(LAS float* scr, const Args& a, int first, int step, int end, int lane) {
    float va[32], vb[32]; CvtItem ca, cb;
    int it = first;
    if (it < end) { ca = cvt_item<KIND>(a, it, lane); CVT_LOAD(va, ca); }
    for (; it < end; it += 2 * step) {
        const bool hb = (it + step < end), ha = (it + 2 * step < end);
        if (hb) { cb = cvt_item<KIND>(a, it + step, lane); CVT_LOAD(vb, cb); }
        if (KIND == 0 && !ca.f8) CVT_STORE(va, ca); else CVT_STORE8(va, ca);
        if (ha) { ca = cvt_item<KIND>(a, it + 2 * step, lane); CVT_LOAD(va, ca); }
        if (hb) { if (KIND == 0 && !cb.f8) CVT_STORE(vb, cb); else CVT_STORE8(vb, cb); }
    }
}
template <int KIND>
__device__ __forceinline__ void convert_all(LAS unsigned char* lds, const Args& a, int vcu, int G, int lane, int wave) {
    const int gw = vcu * NWAVES + wave, NGW = G * NWAVES;
    convert_items<KIND>((LAS float*)(lds + wave * 8448), a, gw, NGW, KIND == 1 ? 16384 : 8192, lane);
    __syncthreads();
}

__device__ __forceinline__ void phase0(LAS unsigned char* lds, const Args& a, int vcu, int G, int tid, int lane, int wave) {
    unsigned char* ws = a.ws;
    if (vcu < 96) {
        LAS float* sv = (LAS float*)(lds + 69632); LAS float* part = sv + 3072;
        for (int idx = tid; idx < 3072; idx += NT) { const int v = idx >> 10, k = idx & 1023; const float s = (v < 2) ? a.in[I_C][v * 1024 + k] : a.in[I_CCTX][k]; sv[idx] = s / (1.f + expf(-s)); }
        __syncthreads();
        const int n0 = 64 * vcu, colq = lane & 15, kr = lane >> 4;
        f32x4 a0 = {0.f, 0.f, 0.f, 0.f}, a1 = a0, a2 = a0;
        const float* aw = a.in[I_ADAW] + (size_t)(128 * wave + kr) * 6144 + n0 + 4 * colq;
#pragma unroll
        for (int hb = 0; hb < 2; ++hb) { f32x4 w4[16];
#pragma unroll
            for (int it = 0; it < 16; ++it) w4[it] = __builtin_nontemporal_load((const f32x4*)(aw + (size_t)(4 * (16 * hb + it)) * 6144));
#pragma unroll
            for (int it = 0; it < 16; ++it) { const int k = 128 * wave + 4 * (16 * hb + it) + kr; a0 += w4[it] * sv[k]; a1 += w4[it] * sv[1024 + k]; a2 += w4[it] * sv[2048 + k]; } }
#pragma unroll
        for (int j = 0; j < 4; ++j) { a0[j] += __shfl_xor(a0[j], 16); a0[j] += __shfl_xor(a0[j], 32); a1[j] += __shfl_xor(a1[j], 16); a1[j] += __shfl_xor(a1[j], 32); a2[j] += __shfl_xor(a2[j], 16); a2[j] += __shfl_xor(a2[j], 32); }
        if (kr == 0) {
#pragma unroll
            for (int j = 0; j < 4; ++j) { part[(wave * 3 + 0) * 64 + 4 * colq + j] = a0[j]; part[(wave * 3 + 1) * 64 + 4 * colq + j] = a1[j]; part[(wave * 3 + 2) * 64 + 4 * colq + j] = a2[j]; } }
        __syncthreads();
        if (tid < 192) { const int v = tid >> 6, col = tid & 63; float s = a.in[I_ADAB][n0 + col];
#pragma unroll
            for (int w = 0; w < 8; ++w) s += part[(w * 3 + v) * 64 + col];
            ((float*)(ws + WS_MOD))[v * 6144 + n0 + col] = s; }
    } else if (vcu < 96 + 128) {
        const int it = vcu - 96, g = it >> 5, cb = (it >> 1) & 15, nb = it & 1, n = nb * 512 + tid;
        LAS float* pwt = (LAS float*)(lds + 69632);
        if (tid < 256) { const int d = tid >> 1, hf = tid & 1; const float sc = a.in[I_POOLS][g * 128 + d]; f32x4 v;
#pragma unroll
            for (int q = 0; q < 4; ++q) v[q] = a.in[I_POOLW][(size_t)(g * 128 + cb * 8 + hf * 4 + q) * 128 + d] * sc;
            *(LAS f32x4*)(pwt + d * 8 + hf * 4) = v; }
        __syncthreads();
        const float* wp = a.in[I_WPOOL] + (size_t)(g * 128) * 1024 + n;
        f32x4 acc0 = {0.f, 0.f, 0.f, 0.f}, acc1 = acc0;
        for (int d0 = 0; d0 < 128; d0 += 32) { float w[32];
#pragma unroll
            for (int d = 0; d < 32; ++d) w[d] = wp[(size_t)(d0 + d) * 1024];
#pragma unroll
            for (int d = 0; d < 32; ++d) { const f32x4 p0 = *(const LAS f32x4*)(pwt + (d0 + d) * 8), p1 = *(const LAS f32x4*)(pwt + (d0 + d) * 8 + 4); acc0 += p0 * w[d]; acc1 += p1 * w[d]; } }
        bf16* dst = (bf16*)(ws + WS_WC) + (size_t)n * 512 + g * 128 + cb * 8;
        *(u32x4*)dst = (u32x4){pk2(acc0[0], acc0[1]), pk2(acc0[2], acc0[3]), pk2(acc1[0], acc1[1]), pk2(acc1[2], acc1[3])};
    }
    { const int gw = vcu * NWAVES + wave, NGW = G * NWAVES; convert_items<0>((LAS float*)(lds + wave * 8448), a, gw, NGW, 2048 + 512 + 256, lane); }
}

#define RSTEP(N, S) do { _Pragma("unroll") for (int _i = 0; _i < (N) / 2; ++_i) { const float _send = (lane & (S)) ? racc[_i] : racc[_i + (N) / 2]; const float _keep = (lane & (S)) ? racc[_i + (N) / 2] : racc[_i]; racc[_i] = _keep + __shfl_xor(_send, (S)); } } while (0)
__device__ __forceinline__ void phase1(LAS unsigned char* lds, const Args& a, int vcu, int G, int tid, int lane, int wave) {
    unsigned char* ws = a.ws;
    const float* MOD = (const float*)(ws + WS_MOD);
    const float* g1 = a.in[I_N1G];
    for (int u = vcu; u < 96; u += G) {
        const int mt = u / 12, ntile = u % 12, r0 = mt * 64;
        LAS bf16* As = (LAS bf16*)lds; LAS bf16* Bs = As + 64 * 72; LAS float* rs = (LAS float*)(lds + 18432);
        const float* ctx = a.in[I_CTX];
        { f32x4 rv[8][4];
#pragma unroll
          for (int rr = 0; rr < 8; ++rr)
#pragma unroll
              for (int j = 0; j < 4; ++j) rv[rr][j] = *(const f32x4*)(ctx + (size_t)(r0 + 8 * wave + rr) * 1024 + 256 * j + 4 * lane);
#pragma unroll
          for (int rr = 0; rr < 8; ++rr) { float ss = 0.f;
#pragma unroll
              for (int j = 0; j < 4; ++j) ss += rv[rr][j][0] * rv[rr][j][0] + rv[rr][j][1] * rv[rr][j][1] + rv[rr][j][2] * rv[rr][j][2] + rv[rr][j][3] * rv[rr][j][3];
              ss = wave_sum(ss); if (lane == 0) rs[8 * wave + rr] = rsqrtf(ss * (1.f / 1024.f) + EPS); } }
        __syncthreads();
        f32x4 acc[2] = {{0.f, 0.f, 0.f, 0.f}, {0.f, 0.f, 0.f, 0.f}};
        const int m16 = wave & 3, nh = wave >> 2, srow = tid >> 3, kq = (tid & 7) * 8;
        const float rstd = rs[srow];
        const float* xp = ctx + (size_t)(r0 + srow) * 1024 + kq; const bf16* wpB = (const bf16*)(ws + WS_WIN) + (size_t)(ntile * 64 + srow) * 1024 + kq;
        f32x4 xv[2], gq[2], scq[2], shq[2]; u32x4 wB;
#define CTX_LOAD(kc) do { const int _k0 = (kc) * 64; _Pragma("unroll") for (int q = 0; q < 2; ++q) { xv[q] = *(const f32x4*)(xp + _k0 + 4 * q); gq[q] = *(const f32x4*)(g1 + _k0 + kq + 4 * q); \
            scq[q] = *(const f32x4*)(MOD + 2 * 6144 + 1024 + _k0 + kq + 4 * q); shq[q] = *(const f32x4*)(MOD + 2 * 6144 + _k0 + kq + 4 * q); } wB = *(const u32x4*)(wpB + _k0); } while (0)
        CTX_LOAD(0);
        for (int kc = 0; kc < 16; ++kc) {
            { unsigned o[4];
#pragma unroll
              for (int q = 0; q < 2; ++q) { const f32x4 h = xv[q] * rstd * gq[q] * (scq[q] + 1.f) + shq[q]; o[2 * q] = pk2(h[0], h[1]); o[2 * q + 1] = pk2(h[2], h[3]); }
              *(LAS u32x4*)(As + srow * 72 + kq) = (u32x4){o[0], o[1], o[2], o[3]};
              *(LAS u32x4*)(Bs + srow * 72 + kq) = wB; }
            __syncthreads();
            if (kc + 1 < 16) CTX_LOAD(kc + 1);
#pragma unroll
            for (int ks = 0; ks < 2; ++ks) { const bf16x8 af = ldfrag(As, 72, m16 * 16, ks * 32, lane);
#pragma unroll
                for (int tt = 0; tt < 2; ++tt) { const bf16x8 bfr = ldfrag(Bs, 72, nh * 32 + tt * 16, ks * 32, lane); acc[tt] = MFMA16(af, bfr, acc[tt]); } }
            __syncthreads();
        }
#undef CTX_LOAD
#pragma unroll
        for (int tt = 0; tt < 2; ++tt)
#pragma unroll
            for (int r = 0; r < 4; ++r) { const int row = M + r0 + m16 * 16 + 4 * (lane >> 4) + r, n = ntile * 64 + nh * 32 + tt * 16 + (lane & 15); const bf16 v = (bf16)f2bf(acc[tt][r]);
                if (n < 256) ((bf16*)(ws + WS_KB))[(size_t)row * 256 + n] = v; else ((bf16*)(ws + WS_VB))[(size_t)row * 512 + n - 256] = v; }
        __syncthreads();
    }
    LAS float* WR = (LAS float*)lds;
#pragma unroll 4
    for (int it = 0; it < 16; ++it) { const int k = (tid >> 3) + 64 * it, c4 = tid & 7; const f32x4 v = *(const f32x4*)(a.in[I_WIN] + (size_t)k * DIN + 768 + 4 * c4);
        const int row = ((k >> 8) * 4 + (k & 3)) * 64 + ((k & 255) >> 2); *(LAS f32x4*)(WR + row * 36 + 4 * c4) = v; }
    __syncthreads();
    f32x4 gv[4];
#pragma unroll
    for (int j = 0; j < 4; ++j) gv[j] = *(const f32x4*)(g1 + 256 * j + 4 * lane);
    constexpr int NPAIR = MT / 2;
    const int nctx = (G > 96) ? 96 : 0, PA = 3;
    int p_lo, p_n, p_stride;
    if (vcu < nctx) { p_lo = (vcu * NWAVES + wave) * PA; p_n = PA; p_stride = 1; }
    else { p_lo = nctx * NWAVES * PA + (vcu - nctx) * NWAVES + wave; p_n = 1 << 30; p_stride = (G - nctx) * NWAVES; }
    f32x4 nx[2][4];
    if (p_n > 0 && p_lo < NPAIR) {
#pragma unroll
        for (int r = 0; r < 2; ++r) { const int m = 2 * p_lo + r; const float* src = (m < M) ? a.in[I_X] + (size_t)m * 1024 : a.in[I_CTX] + (size_t)(m - M) * 1024;
#pragma unroll
            for (int j = 0; j < 4; ++j) nx[r][j] = *(const f32x4*)(src + 256 * j + 4 * lane); } }
    for (int pi = 0, pr = p_lo; pi < p_n && pr < NPAIR; ++pi, pr += p_stride) {
        const int m0 = 2 * pr;
        f32x4 v[2][4]; float rstd[2];
#pragma unroll
        for (int r = 0; r < 2; ++r) { float ss = 0.f;
#pragma unroll
            for (int j = 0; j < 4; ++j) { v[r][j] = nx[r][j]; ss += v[r][j][0] * v[r][j][0] + v[r][j][1] * v[r][j][1] + v[r][j][2] * v[r][j][2] + v[r][j][3] * v[r][j][3]; }
            rstd[r] = ss; }
        if (pi + 1 < p_n && pr + p_stride < NPAIR) {
#pragma unroll
            for (int r = 0; r < 2; ++r) { const int m = 2 * (pr + p_stride) + r; const float* src = (m < M) ? a.in[I_X] + (size_t)m * 1024 : a.in[I_CTX] + (size_t)(m - M) * 1024;
#pragma unroll
                for (int j = 0; j < 4; ++j) nx[r][j] = *(const f32x4*)(src + 256 * j + 4 * lane); } }
#pragma unroll
        for (int r = 0; r < 2; ++r) { const int m = m0 + r; rstd[r] = rsqrtf(wave_sum(rstd[r]) * (1.f / 1024.f) + EPS); const float* mod = MOD + (size_t)((m < M) ? (m >> 13) : 2) * 6144;
#pragma unroll
            for (int j = 0; j < 4; ++j) { const f32x4 sc = *(const f32x4*)(mod + 1024 + 256 * j + 4 * lane), sh = *(const f32x4*)(mod + 256 * j + 4 * lane); v[r][j] = v[r][j] * rstd[r] * gv[j] * (sc + 1.f) + sh; }
            if (m < M) { bf16* hp = (bf16*)(ws + WS_H1) + (size_t)m * 1024;
#pragma unroll
                for (int j = 0; j < 4; ++j) { *(u32x2*)(hp + 256 * j + 4 * lane) = (u32x2){pk2(v[r][j][0], v[r][j][1]), pk2(v[r][j][2], v[r][j][3])};
                    *(unsigned*)(ws + WS_H1F + (size_t)m * 1024 + 256 * j + 4 * lane) = pk4_fp8(v[r][j][0], v[r][j][1], v[r][j][2], v[r][j][3]); } } }
        f32x2 r2[32];
#pragma unroll
        for (int i = 0; i < 32; ++i) r2[i] = (f32x2){0.f, 0.f};
#pragma unroll
        for (int j = 0; j < 4; ++j)
#pragma unroll
            for (int i = 0; i < 4; ++i) { const f32x2 hab = {v[0][j][i], v[1][j][i]}; const LAS float* rp = WR + ((j * 4 + i) * 64 + lane) * 36;
#pragma unroll
                for (int c4 = 0; c4 < 8; ++c4) { const f32x4 w = *(const LAS f32x4*)(rp + 4 * c4);
                    r2[4 * c4 + 0] += hab * w[0]; r2[4 * c4 + 1] += hab * w[1]; r2[4 * c4 + 2] += hab * w[2]; r2[4 * c4 + 3] += hab * w[3]; }
                if (i & 1) asm volatile("" ::: "memory"); }
        float ra[32], rb[32];
#pragma unroll
        for (int i = 0; i < 32; ++i) { ra[i] = r2[i][0]; rb[i] = r2[i][1]; }
        { float* racc = ra; RSTEP(32, 32); RSTEP(16, 16); RSTEP(8, 8); RSTEP(4, 4); RSTEP(2, 2); racc[0] += __shfl_xor(racc[0], 1); }
        { float* racc = rb; RSTEP(32, 32); RSTEP(16, 16); RSTEP(8, 8); RSTEP(4, 4); RSTEP(2, 2); racc[0] += __shfl_xor(racc[0], 1); }
        if ((lane & 1) == 0) { ((float*)(ws + WS_RB))[(size_t)m0 * 32 + (lane >> 1)] = ra[0]; ((float*)(ws + WS_RB))[(size_t)(m0 + 1) * 32 + (lane >> 1)] = rb[0]; }
    }
}

typedef short s16x4 __attribute__((ext_vector_type(4)));
__device__ __forceinline__ s16x4 lds_tr16(const LAS bf16* p) { return __builtin_bit_cast(s16x4, __builtin_amdgcn_ds_read_tr16_b64_v4i16((LAS s16x4*)p)); }
__device__ __forceinline__ bf16x8 ldfrag_tr(const LAS bf16* base, int stride, int k0, int n0, int lane) {
    const int g = lane >> 4, i = lane & 15; const LAS bf16* p = base + (k0 + 8 * g + (i >> 2)) * stride + n0 + 4 * (i & 3);
    const s16x4 lo = lds_tr16(p), hi = lds_tr16(p + 4 * stride);
    return (bf16x8){lo[0], lo[1], lo[2], lo[3], hi[0], hi[1], hi[2], hi[3]};
}
__device__ __forceinline__ float logsig_fast(float z) { return fminf(z, 0.f) - __logf(1.f + __expf(-fabsf(z))); }
struct ChkPre { f32x4 r, w; float bias_f, bias_b; float kf[8]; u32x4 v[2]; };
__device__ __forceinline__ void chunk_decode(int u, int& b, int& h, int& row0, int& slot, bool& isx) {
    if (u < 1024) { b = u >> 9; h = (u >> 7) & 3; const int n = u & 127; row0 = b * SEQ + n * 64; slot = n; isx = true; }
    else { const int v = u - 1024; b = v >> 4; h = (v >> 2) & 3; const int n = v & 3; row0 = M + b * LC + n * 64; slot = NCH + n; isx = false; }
}
__device__ __forceinline__ void chunk_load(ChkPre& P, const Args& a, int u, int tid) {
    unsigned char* ws = a.ws; int b, h, row0, slot; bool isx; chunk_decode(u, b, h, row0, slot, isx);
    P.r = *(const f32x4*)((const float*)(ws + WS_RB) + (size_t)(row0 + (tid >> 3)) * 32 + (tid & 7) * 4);
    P.w = *(const f32x4*)(a.in[I_WDU] + (size_t)(tid >> 4) * 256 + h * 64 + (tid & 15) * 4);
    const int dk = tid & 63, tq = tid >> 6;
    P.bias_f = a.in[I_BDEC][h * 64 + dk]; P.bias_b = a.in[I_BDEC][256 + h * 64 + dk];
    const bf16* KBp = (const bf16*)(ws + WS_KB) + (size_t)(row0 + tq * 8) * 256 + h * 64 + dk;
#pragma unroll
    for (int tt = 0; tt < 8; ++tt) P.kf[tt] = bf2f(KBp[(size_t)tt * 256]);
#pragma unroll
    for (int i = 0; i < 2; ++i) { const int p = tid + NT * i, jj = p >> 4, ch = p & 15; P.v[i] = *(const u32x4*)((const bf16*)(ws + WS_VB) + (size_t)(row0 + jj) * 512 + h * 128 + 8 * ch); }
}
__device__ __forceinline__ void chunk_units(LAS unsigned char* lds, const Args& a, int vcu, int G, int tid, int lane, int wave) {
    unsigned char* ws = a.ws;
    LAS float* r_s = (LAS float*)lds;
    LAS float* wup = (LAS float*)(lds + 8192);
    LAS float* seg = (LAS float*)(lds + 16384);
    LAS bf16* Ks = (LAS bf16*)(lds + 20480);
    LAS bf16* Vs = (LAS bf16*)(lds + 38912);
    const int dk = tid & 63, tq = tid >> 6;
    ChkPre P;
    unsigned* qctr = (unsigned*)(ws + WS_CTL) + 512; LAS int* qnext = (LAS int*)(lds + 57344);
    int u = vcu;
    if (u < 1024 + 32) chunk_load(P, a, u, tid);
    for (; u < 1024 + 32; ) {
        int b, h, row0, slot; bool isx; chunk_decode(u, b, h, row0, slot, isx);
        const int bh = b * 4 + h;
        if (tid == 0) qnext[0] = G + (int)__hip_atomic_fetch_add(qctr, 1u, __ATOMIC_RELAXED, __HIP_MEMORY_SCOPE_AGENT);
        *(LAS f32x4*)(r_s + tid * 4) = P.r; *(LAS f32x4*)(wup + (tid >> 4) * 64 + (tid & 15) * 4) = P.w;
#pragma unroll
        for (int i = 0; i < 2; ++i) { const int p = tid + NT * i, jj = p >> 4, ch = p & 15; *(LAS u32x4*)(Vs + jj * 136 + 8 * ch) = P.v[i]; }
        float kf[8];
#pragma unroll
        for (int tt = 0; tt < 8; ++tt) kf[tt] = P.kf[tt];
        const float bias_f = P.bias_f, bias_b = P.bias_b;
        __syncthreads();
        const int un = qnext[0];
        if (un < 1024 + 32) chunk_load(P, a, un, tid);
        float pf[8], sb[8];
        { float wf[16], wb[16];
#pragma unroll
          for (int j = 0; j < 16; ++j) { wf[j] = wup[j * 64 + dk]; wb[j] = wup[(16 + j) * 64 + dk]; }
#pragma unroll
          for (int tt = 0; tt < 8; ++tt) { const LAS float* rp = r_s + (tq * 8 + tt) * 32; float zf = bias_f, zb = bias_b;
#pragma unroll
              for (int j4 = 0; j4 < 4; ++j4) { const f32x4 rf = *(const LAS f32x4*)(rp + 4 * j4), rb = *(const LAS f32x4*)(rp + 16 + 4 * j4);
#pragma unroll
                  for (int e = 0; e < 4; ++e) { zf += rf[e] * wf[4 * j4 + e]; zb += rb[e] * wb[4 * j4 + e]; } }
              pf[tt] = logsig_fast(zf) * (1.f / 16.f); sb[tt] = logsig_fast(zb) * (1.f / 16.f); }
#pragma unroll
          for (int tt = 1; tt < 8; ++tt) pf[tt] += pf[tt - 1];
#pragma unroll
          for (int tt = 6; tt >= 0; --tt) sb[tt] += sb[tt + 1];
          seg[tq * 64 + dk] = pf[7]; seg[(8 + tq) * 64 + dk] = sb[0]; }
        __syncthreads();
        { float offf = 0.f, totf = 0.f, offb = 0.f, totb = 0.f;
#pragma unroll
          for (int q = 0; q < 8; ++q) { const float sf = seg[q * 64 + dk], sbv = seg[(8 + q) * 64 + dk]; totf += sf; totb += sbv; if (q < tq) offf += sf; if (q > tq) offb += sbv; }
#pragma unroll
          for (int tt = 0; tt < 8; ++tt) { const int t = tq * 8 + tt; const float bb = pf[tt] + offf, cc = sb[tt] + offb;
              if (isx) { const size_t gi = (size_t)(row0 + t) * 256 + h * 64 + dk; a.out[gi] = bb; a.out[(size_t)M * 256 + gi] = cc; }
              Ks[t * 72 + dk] = (bf16)f2bf(kf[tt] * __expf(totf - bb)); Ks[(64 + t) * 72 + dk] = (bf16)f2bf(kf[tt] * __expf(totb - cc)); }
          if (tq == 0) { float* DEC = (float*)(ws + WS_DEC); DEC[((size_t)(0 * 8 + bh) * NSLOT + slot) * 64 + dk] = __expf(totf); DEC[((size_t)(1 * 8 + bh) * NSLOT + slot) * 64 + dk] = __expf(totb); } }
        __syncthreads();
        { const int dir = wave >> 2, dkt = wave & 3; const LAS bf16* Kd = Ks + dir * 64 * 72;
          const bf16x8 k0f = ldfrag_tr(Kd, 72, 0, dkt * 16, lane), k1f = ldfrag_tr(Kd, 72, 32, dkt * 16, lane);
          bf16* KV = (bf16*)(ws + WS_KV) + ((size_t)(dir * 8 + bh) * NSLOT + slot) * 8192;
#pragma unroll
          for (int dvt = 0; dvt < 8; ++dvt) { f32x4 c = {0.f, 0.f, 0.f, 0.f}; c = MFMA16(k0f, ldfrag_tr(Vs, 136, 0, dvt * 16, lane), c); c = MFMA16(k1f, ldfrag_tr(Vs, 136, 32, dvt * 16, lane), c);
              *(u32x2*)(KV + (size_t)(dvt * 16 + (lane & 15)) * 64 + dkt * 16 + 4 * (lane >> 4)) = (u32x2){pk2(c[0], c[1]), pk2(c[2], c[3])}; } }
        __syncthreads();
        u = un;
    }
}
constexpr int PB = 4, NPOOLW = NB * 4 * 8 * (128 / PB);
__device__ __forceinline__ void ld16bf(const bf16* p, float (&f)[16]) { const u32x4 w0 = *(const u32x4*)p, w1 = *(const u32x4*)(p + 8);
#pragma unroll
    for (int q = 0; q < 4; ++q) { f[2 * q] = bflo(w0[q]); f[2 * q + 1] = bfhi(w0[q]); f[8 + 2 * q] = bflo(w1[q]); f[8 + 2 * q + 1] = bfhi(w1[q]); } }
template <int HALF>
__device__ __forceinline__ void pool_band(const bf16* PI, bf16* PO, int r0, int c) {
    float run[16];
#pragma unroll
    for (int e = 0; e < 16; ++e) run[e] = 0.f;
    { constexpr int NW = 2 * HALF, BT = NW < 8 ? NW : 8;
#pragma unroll
      for (int i0 = 0; i0 < NW; i0 += BT) { float f[BT][16];
#pragma unroll
          for (int i = 0; i < BT; ++i) { int rr = r0 - HALF + i0 + i; rr = rr < 0 ? 0 : (rr > 127 ? 127 : rr); ld16bf(PI + (size_t)rr * 64 * 512, f[i]); }
#pragma unroll
          for (int i = 0; i < BT; ++i) { const int rr = r0 - HALF + i0 + i; const bool ok = rr >= 0 && rr < 128;
#pragma unroll
              for (int e = 0; e < 16; ++e) run[e] += ok ? f[i][e] : 0.f; }
          asm volatile("" ::: "memory"); } }
    const int lo_c = (c - HALF) < 0 ? 0 : (c - HALF), hi_c = (c + HALF) > 64 ? 64 : (c + HALF);
    float cen[16], fi[16], fo[16];
    ld16bf(PI + (size_t)r0 * 64 * 512, cen);
#pragma unroll
    for (int k = 0; k < PB; ++k) {
        const int r = r0 + k;
        float ncen[16];
        if (k + 1 < PB) { const int rin = r + HALF, rout = r - HALF;
            ld16bf(PI + (size_t)(rin > 127 ? 127 : rin) * 64 * 512, fi); ld16bf(PI + (size_t)(rout < 0 ? 0 : rout) * 64 * 512, fo); ld16bf(PI + (size_t)(r + 1) * 64 * 512, ncen); }
        const int lo_r = (r - HALF) < 0 ? 0 : (r - HALF), hi_r = (r + HALF) > 128 ? 128 : (r + HALF);
        const float inv = 1.f / (float)((hi_r - lo_r) * (hi_c - lo_c));
        float o[16];
#pragma unroll
        for (int e = 0; e < 16; ++e) { float p = run[e];
#pragma unroll
            for (int s = 1; s < 64; s <<= 1) { const float t = __shfl_up(p, s); p += (c >= s) ? t : 0.f; }
            const float hi = __shfl(p, hi_c - 1), lo = __shfl(p, lo_c > 0 ? lo_c - 1 : 0);
            o[e] = (hi - (lo_c > 0 ? lo : 0.f)) * inv - cen[e]; }
        bf16* po = PO + (size_t)r * 64 * 512;
        *(u32x4*)po = (u32x4){pk2(o[0], o[1]), pk2(o[2], o[3]), pk2(o[4], o[5]), pk2(o[6], o[7])}; *(u32x4*)(po + 8) = (u32x4){pk2(o[8], o[9]), pk2(o[10], o[11]), pk2(o[12], o[13]), pk2(o[14], o[15])};
        if (k + 1 < PB) { const int rin = r + HALF, rout = r - HALF;
#pragma unroll
            for (int e = 0; e < 16; ++e) { run[e] += (rin < 128 ? fi[e] : 0.f) - (rout >= 0 ? fo[e] : 0.f); cen[e] = ncen[e]; } }
    }
}
__device__ __forceinline__ void pool_units(const Args& a, int vcu, int G, int lane, int wave, int nw) {
    unsigned char* ws = a.ws;
    constexpr int NBAND = 128 / PB, PER_G = NB * 8 * NBAND;
    for (int wu = vcu * nw + wave; wu < NPOOLW; wu += G * nw) {
        const int g = 3 - wu / PER_G, rem = wu % PER_G, b = rem / (8 * NBAND), rem2 = rem % (8 * NBAND), chk = rem2 & 7, r0 = (rem2 >> 3) * PB;
        const size_t off = ((size_t)b * SEQ + lane) * 512 + g * 128 + chk * 16;
        const bf16* PI = (const bf16*)(ws + WS_PI) + off; bf16* PO = (bf16*)(ws + WS_PO) + off;
        if (g == 0) pool_band<1>(PI, PO, r0, lane); else if (g == 1) pool_band<2>(PI, PO, r0, lane); else if (g == 2) pool_band<4>(PI, PO, r0, lane); else pool_band<8>(PI, PO, r0, lane);
    }
}

__device__ __forceinline__ void phase4(const Args& a, int G, int tid, int nthr) {
    unsigned char* ws = a.ws;
    for (int e = blockIdx.x * nthr + tid; e < 2 * 8 * 8192; e += G * nthr) {
        const int dir = e >> 16, bh = (e >> 13) & 7, e8 = e & 8191, dk = e8 & 63;
        const bf16* kvp = (const bf16*)(ws + WS_KV) + (size_t)((dir * 8 + bh) * NSLOT) * 8192 + e8;
        const float* decp = (const float*)(ws + WS_DEC) + (size_t)((dir * 8 + bh) * NSLOT) * 64 + dk;
        bf16* stp = (bf16*)(ws + WS_ST) + (size_t)((dir * 8 + bh) * NCH) * 8192 + e8;
        float s = 0.f;
        for (int j0 = 0; j0 < NSLOT; j0 += 12) {
            float kv[12], dc[12];
#pragma unroll
            for (int q = 0; q < 12; ++q) { const int j = j0 + q; const int slot = dir ? (NSLOT - 1 - j) : (j < 4 ? NCH + j : j - 4); kv[q] = bf2f(kvp[(size_t)slot * 8192]); dc[q] = decp[slot * 64]; }
#pragma unroll
            for (int q = 0; q < 12; ++q) { const int j = j0 + q; const int slot = dir ? (NSLOT - 1 - j) : (j < 4 ? NCH + j : j - 4);
                if (slot < NCH) stp[(size_t)slot * 8192] = (bf16)f2bf(s);
                s = dc[q] * s + kv[q]; }
        }
    }
}

struct GlaPre { u32x4 q, k; f32x4 b0, b1, c0, c1, mf0, mf1, mb0, mb1; u32x4 v[2]; u32x4 st[4]; u32x4 sg[2]; };
__device__ __forceinline__ void gla_load(GlaPre& P, const Args& a, int u, int tid) {
    unsigned char* ws = a.ws;
    const int b = u >> 9, h = (u >> 7) & 3, n = u & 127, row0 = b * SEQ + n * 64, bh = b * 4 + h, t = tid >> 3, c8 = tid & 7;
    const size_t gi = (size_t)(row0 + t) * 256 + h * 64 + 8 * c8, gmf = (size_t)(row0 + 31) * 256 + h * 64 + 8 * c8, gmb = (size_t)(row0 + 32) * 256 + h * 64 + 8 * c8;
    const float* BF = a.out; const float* CB = a.out + (size_t)M * 256;
    P.q = *(const u32x4*)((const bf16*)(ws + WS_QB) + gi); P.k = *(const u32x4*)((const bf16*)(ws + WS_KB) + gi);
    P.b0 = *(const f32x4*)(BF + gi); P.b1 = *(const f32x4*)(BF + gi + 4); P.c0 = *(const f32x4*)(CB + gi); P.c1 = *(const f32x4*)(CB + gi + 4);
    P.mf0 = *(const f32x4*)(BF + gmf); P.mf1 = *(const f32x4*)(BF + gmf + 4); P.mb0 = *(const f32x4*)(CB + gmb); P.mb1 = *(const f32x4*)(CB + gmb + 4);
#pragma unroll
    for (int i = 0; i < 2; ++i) { const int p = tid + NT * i, jj = p >> 4, ch = p & 15; P.v[i] = *(const u32x4*)((const bf16*)(ws + WS_VB) + (size_t)(row0 + jj) * 512 + h * 128 + 8 * ch); }
#pragma unroll
    for (int i = 0; i < 4; ++i) { const int p = tid + NT * i, dir = p >> 10, rem = p & 1023, dv = rem >> 3, c = rem & 7;
        P.st[i] = *(const u32x4*)((const bf16*)(ws + WS_ST) + ((size_t)((dir * 8 + bh) * NCH + n) * 128 + dv) * 64 + 8 * c); }
    const bf16* sgp = (const bf16*)(ws + WS_SG) + (size_t)(row0 + t) * 512 + h * 128 + 16 * c8;
    P.sg[0] = *(const u32x4*)sgp; P.sg[1] = *(const u32x4*)(sgp + 8);
}
__device__ __forceinline__ void phase5(LAS unsigned char* lds, const Args& a, int vcu, int G, int tid, int lane, int wave) {
    unsigned char* ws = a.ws;
    LAS bf16* Aop = (LAS bf16*)lds;
    LAS bf16* Bop = (LAS bf16*)(lds + 25600);
    LAS bf16* Vs = (LAS bf16*)(lds + 60416);
    LAS bf16* qsf = (LAS bf16*)(lds + 77824); LAS bf16* ksf = qsf + 64 * 72; LAS bf16* qsb = ksf + 64 * 72; LAS bf16* ksb = qsb + 64 * 72;
    LAS float* Os = (LAS float*)(lds + 77824);
    const int t8 = tid >> 3, c8 = tid & 7;
    f32x4 gn[4];
#pragma unroll
    for (int q = 0; q < 4; ++q) gn[q] = *(const f32x4*)(a.in[I_GNG] + 16 * c8 + 4 * q);
    GlaPre P;
    int u = vcu;
    if (u < 1024) gla_load(P, a, u, tid);
    for (; u < 1024; u += G) {
        const int b = u >> 9, h = (u >> 7) & 3, n = u & 127, row0 = b * SEQ + n * 64;
        { float qf[8], kf[8], bb[8], cc[8], mf[8], mb[8];
#pragma unroll
          for (int e = 0; e < 4; ++e) { qf[2 * e] = bflo(P.q[e]); qf[2 * e + 1] = bfhi(P.q[e]); kf[2 * e] = bflo(P.k[e]); kf[2 * e + 1] = bfhi(P.k[e]);
              bb[e] = P.b0[e]; bb[4 + e] = P.b1[e]; cc[e] = P.c0[e]; cc[4 + e] = P.c1[e]; mf[e] = P.mf0[e]; mf[4 + e] = P.mf1[e]; mb[e] = P.mb0[e]; mb[4 + e] = P.mb1[e]; }
          float o0[8], o1[8], o2[8], o3[8], o4[8], o5[8];
#pragma unroll
          for (int e = 0; e < 8; ++e) { const float eb = __expf(bb[e]), ec = __expf(cc[e]), x = __expf(bb[e] - mf[e]), y = __expf(cc[e] - mb[e]);
              o0[e] = qf[e] * eb; o1[e] = qf[e] * ec; o2[e] = qf[e] * x; o3[e] = kf[e] * __builtin_amdgcn_rcpf(x); o4[e] = qf[e] * y; o5[e] = kf[e] * __builtin_amdgcn_rcpf(y); }
#define PK8(o) (u32x4){pk2(o[0], o[1]), pk2(o[2], o[3]), pk2(o[4], o[5]), pk2(o[6], o[7])}
          *(LAS u32x4*)(Aop + t8 * 200 + 8 * c8) = PK8(o0); *(LAS u32x4*)(Aop + t8 * 200 + 64 + 8 * c8) = PK8(o1);
          *(LAS u32x4*)(qsf + t8 * 72 + 8 * c8) = PK8(o2); *(LAS u32x4*)(ksf + t8 * 72 + 8 * c8) = PK8(o3); *(LAS u32x4*)(qsb + t8 * 72 + 8 * c8) = PK8(o4); *(LAS u32x4*)(ksb + t8 * 72 + 8 * c8) = PK8(o5);
#undef PK8
        }
#pragma unroll
        for (int i = 0; i < 2; ++i) { const int p = tid + NT * i, jj = p >> 4, ch = p & 15; *(LAS u32x4*)(Vs + jj * 136 + 8 * ch) = P.v[i]; }
#pragma unroll
        for (int i = 0; i < 4; ++i) { const int p = tid + NT * i, dir = p >> 10, rem = p & 1023, dv = rem >> 3, c = rem & 7; *(LAS u32x4*)(Bop + dv * 136 + dir * 64 + 8 * c) = P.st[i]; }
        const u32x4 sg0 = P.sg[0], sg1 = P.sg[1];
        __syncthreads();
        if (u + G < 1024) gla_load(P, a, u + G, tid);
        { const int tt = wave >> 1, jh = wave & 1; f32x4 pa[2] = {{0.f, 0.f, 0.f, 0.f}, {0.f, 0.f, 0.f, 0.f}};
#pragma unroll
          for (int dir = 0; dir < 2; ++dir) { const LAS bf16* qs = dir ? qsb : qsf; const LAS bf16* ks = dir ? ksb : ksf;
              const bf16x8 a0 = ldfrag(qs, 72, tt * 16, 0, lane), a1 = ldfrag(qs, 72, tt * 16, 32, lane);
#pragma unroll
              for (int jj = 0; jj < 2; ++jj) { const int jt = jh * 2 + jj; f32x4 sc = {0.f, 0.f, 0.f, 0.f}; sc = MFMA16(a0, ldfrag(ks, 72, jt * 16, 0, lane), sc); sc = MFMA16(a1, ldfrag(ks, 72, jt * 16, 32, lane), sc);
#pragma unroll
                  for (int r = 0; r < 4; ++r) { const int t = tt * 16 + 4 * (lane >> 4) + r, jx = jt * 16 + (lane & 15); const bool keep = dir ? (jx >= t) : (jx <= t); pa[jj][r] += keep ? sc[r] : 0.f; } } }
#pragma unroll
          for (int jj = 0; jj < 2; ++jj)
#pragma unroll
              for (int r = 0; r < 4; ++r) Aop[(tt * 16 + 4 * (lane >> 4) + r) * 200 + 128 + (jh * 2 + jj) * 16 + (lane & 15)] = (bf16)f2bf(pa[jj][r]); }
        __syncthreads();
        const int tt = wave >> 1, dvh = wave & 1;
        f32x4 acc[4] = {{0.f, 0.f, 0.f, 0.f}, {0.f, 0.f, 0.f, 0.f}, {0.f, 0.f, 0.f, 0.f}, {0.f, 0.f, 0.f, 0.f}};
#pragma unroll
        for (int ks = 0; ks < 4; ++ks) { const bf16x8 af = ldfrag(Aop, 200, tt * 16, ks * 32, lane);
#pragma unroll
            for (int i = 0; i < 4; ++i) acc[i] = MFMA16(af, ldfrag(Bop, 136, (dvh * 4 + i) * 16, ks * 32, lane), acc[i]); }
#pragma unroll
        for (int ks = 0; ks < 2; ++ks) { const bf16x8 af = ldfrag(Aop, 200, tt * 16, 128 + ks * 32, lane);
#pragma unroll
            for (int i = 0; i < 4; ++i) acc[i] = MFMA16(af, ldfrag_tr(Vs, 136, ks * 32, (dvh * 4 + i) * 16, lane), acc[i]); }
#pragma unroll
        for (int i = 0; i < 4; ++i)
#pragma unroll
            for (int r = 0; r < 4; ++r) Os[(tt * 16 + 4 * (lane >> 4) + r) * 132 + (dvh * 4 + i) * 16 + (lane & 15)] = acc[i][r];
        __syncthreads();
        { f32x4 ov[4]; float ss = 0.f;
#pragma unroll
          for (int q = 0; q < 4; ++q) { ov[q] = *(const LAS f32x4*)(Os + t8 * 132 + 16 * c8 + 4 * q); ss += ov[q][0] * ov[q][0] + ov[q][1] * ov[q][1] + ov[q][2] * ov[q][2] + ov[q][3] * ov[q][3]; }
          ss += __shfl_xor(ss, 1); ss += __shfl_xor(ss, 2); ss += __shfl_xor(ss, 4);
          const float rstd = rsqrtf(ss * (1.f / 128.f) + EPS);
          unsigned sgw[8] = {sg0[0], sg0[1], sg0[2], sg0[3], sg1[0], sg1[1], sg1[2], sg1[3]}, ow[8];
#pragma unroll
          for (int q = 0; q < 4; ++q) { const f32x4 o = ov[q] * rstd * gn[q]; ow[2 * q] = pk2(o[0] * bflo(sgw[2 * q]), o[1] * bfhi(sgw[2 * q])); ow[2 * q + 1] = pk2(o[2] * bflo(sgw[2 * q + 1]), o[3] * bfhi(sgw[2 * q + 1])); }
          bf16* agp = (bf16*)(ws + WS_AG) + (size_t)(row0 + t8) * 512 + h * 128 + 16 * c8;
          *(u32x4*)agp = (u32x4){ow[0], ow[1], ow[2], ow[3]}; *(u32x4*)(agp + 8) = (u32x4){ow[4], ow[5], ow[6], ow[7]}; }
        __syncthreads();
    }
}

__device__ __forceinline__ void phase8(LAS unsigned char* lds, const Args& a, int vcu, int G, int tid, int lane, int wave) {
    unsigned char* ws = a.ws;
    const float* MOD = (const float*)(ws + WS_MOD);
    LAS float* WRT = (LAS float*)lds;
#pragma unroll
    for (int it = 0; it < 8; ++it) { const int idx = tid + NT * it, k = idx >> 2, c4 = idx & 3; const f32x4 v = *(const f32x4*)(a.in[I_WROUTER] + (size_t)k * 16 + 4 * c4);
        const int row = ((k >> 8) * 4 + (k & 3)) * 64 + ((k & 255) >> 2); *(LAS f32x4*)(WRT + row * 20 + 4 * c4) = v; }
    __syncthreads();
    const int gw = vcu * NWAVES + wave, NGW = G * NWAVES;
    f32x4 gv[4];
#pragma unroll
    for (int j = 0; j < 4; ++j) gv[j] = *(const f32x4*)(a.in[I_N2G] + 256 * j + 4 * lane);
    f32x4 nx[2][4];
    if (gw < M / 2) {
#pragma unroll
        for (int r = 0; r < 2; ++r)
#pragma unroll
            for (int j = 0; j < 4; ++j) nx[r][j] = *(const f32x4*)(a.out + (size_t)(2 * gw + r) * 1024 + 256 * j + 4 * lane); }
    for (int pr = gw; pr < M / 2; pr += NGW) {
        const int m0 = 2 * pr, b = m0 >> 13; const float* mod = MOD + (size_t)b * 6144;
        f32x4 v[2][4]; float ss[2];
#pragma unroll
        for (int r = 0; r < 2; ++r) { float q = 0.f;
#pragma unroll
            for (int j = 0; j < 4; ++j) { v[r][j] = nx[r][j]; q += v[r][j][0] * v[r][j][0] + v[r][j][1] * v[r][j][1] + v[r][j][2] * v[r][j][2] + v[r][j][3] * v[r][j][3]; }
            ss[r] = q; }
        if (pr + NGW < M / 2) {
#pragma unroll
            for (int r = 0; r < 2; ++r)
#pragma unroll
                for (int j = 0; j < 4; ++j) nx[r][j] = *(const f32x4*)(a.out + (size_t)(2 * (pr + NGW) + r) * 1024 + 256 * j + 4 * lane); }
#pragma unroll
        for (int r = 0; r < 2; ++r) { const float rstd = rsqrtf(wave_sum(ss[r]) * (1.f / 1024.f) + EPS);
#pragma unroll
            for (int j = 0; j < 4; ++j) { const f32x4 sc = *(const f32x4*)(mod + 4096 + 256 * j + 4 * lane), sh = *(const f32x4*)(mod + 3072 + 256 * j + 4 * lane); v[r][j] = v[r][j] * rstd * gv[j] * (sc + 1.f) + sh; }
            unsigned char* hp = ws + WS_H2 + (size_t)(m0 + r) * 1024;
#pragma unroll
            for (int j = 0; j < 4; ++j) *(unsigned*)(hp + 256 * j + 4 * lane) = pk4_fp8(v[r][j][0], v[r][j][1], v[r][j][2], v[r][j][3]); }
        f32x2 r2[16];
#pragma unroll
        for (int i = 0; i < 16; ++i) r2[i] = (f32x2){0.f, 0.f};
#pragma unroll
        for (int j = 0; j < 4; ++j)
#pragma unroll
            for (int i = 0; i < 4; ++i) { const f32x2 hab = {v[0][j][i], v[1][j][i]}; const LAS float* rp = WRT + ((j * 4 + i) * 64 + lane) * 20;
#pragma unroll
                for (int c4 = 0; c4 < 4; ++c4) { const f32x4 w = *(const LAS f32x4*)(rp + 4 * c4); r2[4 * c4 + 0] += hab * w[0]; r2[4 * c4 + 1] += hab * w[1]; r2[4 * c4 + 2] += hab * w[2]; r2[4 * c4 + 3] += hab * w[3]; }
                if (i & 1) asm volatile("" ::: "memory"); }
#pragma unroll
        for (int r = 0; r < 2; ++r) {
            float racc[16];
#pragma unroll
            for (int i = 0; i < 16; ++i) racc[i] = r2[i][r];
            RSTEP(16, 32); RSTEP(8, 16); RSTEP(4, 8); RSTEP(2, 4); racc[0] += __shfl_xor(racc[0], 2); racc[0] += __shfl_xor(racc[0], 1);
            const float lg = racc[0];
            float mx = lg; mx = fmaxf(mx, __shfl_xor(mx, 4)); mx = fmaxf(mx, __shfl_xor(mx, 8)); mx = fmaxf(mx, __shfl_xor(mx, 16)); mx = fmaxf(mx, __shfl_xor(mx, 32));
            const float ex = expf(lg - mx); float sm = ex; sm += __shfl_xor(sm, 4); sm += __shfl_xor(sm, 8); sm += __shfl_xor(sm, 16); sm += __shfl_xor(sm, 32);
            const int m = m0 + r;
            if ((lane & 3) == 0) ((float*)(ws + WS_AFF))[(size_t)(b * 16 + (lane >> 2)) * SEQ + (m & (SEQ - 1))] = ex / sm;
            if (lane < 16) ((int*)(ws + WS_INV))[(size_t)m * 16 + lane] = -1;
        }
    }
}

__device__ __forceinline__ void topk_unit(LAS unsigned char* lds, const Args& a, int be, int tid, int lane, int wave) {
    unsigned char* ws = a.ws;
    LAS unsigned* hist = (LAS unsigned*)lds;
    LAS unsigned* sel = hist + 256;
    LAS unsigned* wtot = hist + 264;
    const float* aff = (const float*)(ws + WS_AFF) + (size_t)be * SEQ + 16 * tid;
    unsigned key[16];
#pragma unroll
    for (int q = 0; q < 4; ++q) { const u32x4 v = *(const u32x4*)(aff + 4 * q); key[4 * q] = v[0]; key[4 * q + 1] = v[1]; key[4 * q + 2] = v[2]; key[4 * q + 3] = v[3]; }
    unsigned prefix = 0u, mask = 0u, kk = CAP;
    for (int pass = 0; pass < 4; ++pass) {
        const int shift = 24 - 8 * pass;
        if (tid < 256) hist[tid] = 0u;
        __syncthreads();
#pragma unroll
        for (int i = 0; i < 16; ++i) if ((key[i] & mask) == prefix) __hip_atomic_fetch_add(hist + ((key[i] >> shift) & 255u), 1u, __ATOMIC_RELAXED, __HIP_MEMORY_SCOPE_WORKGROUP);
        __syncthreads();
        if (wave == 0) {
            const unsigned h0 = hist[4 * lane], h1 = hist[4 * lane + 1], h2 = hist[4 * lane + 2], h3 = hist[4 * lane + 3], loc = h0 + h1 + h2 + h3;
            unsigned suf = loc;
#pragma unroll
            for (int o = 1; o < 64; o <<= 1) { const unsigned t = __shfl_down(suf, o); if (lane + o < 64) suf += t; }
            const unsigned above = suf - loc;
            const unsigned s3 = above + h3, s2 = s3 + h2, s1 = s2 + h1, s0 = s1 + h0;
            if (s3 >= kk && above < kk) { sel[0] = 4 * lane + 3; sel[1] = kk - above; }
            if (s2 >= kk && s3 < kk) { sel[0] = 4 * lane + 2; sel[1] = kk - s3; }
            if (s1 >= kk && s2 < kk) { sel[0] = 4 * lane + 1; sel[1] = kk - s2; }
            if (s0 >= kk && s1 < kk) { sel[0] = 4 * lane + 0; sel[1] = kk - s1; }
        }
        __syncthreads();
        prefix |= sel[0] << shift; mask |= 255u << shift; kk = sel[1];
        __syncthreads();
    }
    unsigned cgt = 0u, ceq = 0u;
#pragma unroll
    for (int i = 0; i < 16; ++i) { cgt += (key[i] > prefix) ? 1u : 0u; ceq += (key[i] == prefix) ? 1u : 0u; }
    const unsigned val = cgt | (ceq << 16); unsigned inc = val;
#pragma unroll
    for (int o = 1; o < 64; o <<= 1) { const unsigned t = __shfl_up(inc, o); if (lane >= o) inc += t; }
    if (lane == 63) wtot[wave] = inc;
    __syncthreads();
    unsigned base = 0u;
    for (int w = 0; w < wave; ++w) base += wtot[w];
    const unsigned excl = base + inc - val; unsigned gtb = excl & 0xffffu, eqb = excl >> 16;
    const int b = be >> 4, e = be & 15;
    int* IDX = (int*)(ws + WS_IDX) + be * CAP; float* WSEL = (float*)(ws + WS_WSEL) + be * CAP; int* INV = (int*)(ws + WS_INV);
#pragma unroll
    for (int i = 0; i < 16; ++i) { const bool gt = key[i] > prefix, eq = key[i] == prefix; const bool take = gt || (eq && eqb < kk);
        if (take) { const unsigned pos = gtb + (eqb < kk ? eqb : kk); const int row = b * SEQ + 16 * tid + i; IDX[pos] = row; WSEL[pos] = __builtin_bit_cast(float, key[i]); INV[(size_t)row * 16 + e] = (int)pos; }
        gtb += gt ? 1u : 0u; eqb += eq ? 1u : 0u; }
    __syncthreads();
}
__device__ __forceinline__ void phase9(LAS unsigned char* lds, const Args& a, int vcu, int G, int tid, int lane, int wave) {
    const int ntk = (G > 64) ? 32 : 0;
    if (vcu < ntk || ntk == 0) for (int be = (ntk ? vcu : vcu); be < NB * NE; be += (ntk ? ntk : G)) topk_unit(lds, a, be, tid, lane, wave);
    if (vcu >= ntk) { const int gw = (vcu - ntk) * NWAVES + wave, NGW = (G - ntk) * NWAVES; convert_items<2>((LAS float*)(lds + 8192 + wave * 8448), a, gw, NGW, 8192, lane); }
}

__device__ __forceinline__ void phase12(const Args& a, int vcu, int G, int lane, int wave) {
    unsigned char* ws = a.ws;
    const int gw = vcu * NWAVES + wave, NGW = G * NWAVES;
    f32x4 gv[4];
#pragma unroll
    for (int j = 0; j < 4; ++j) gv[j] = *(const f32x4*)(a.in[I_FNG] + 256 * j + 4 * lane);
    f32x4 nx[4]; int ninv = -1;
    if (gw < M) {
#pragma unroll
        for (int j = 0; j < 4; ++j) nx[j] = __builtin_nontemporal_load((const f32x4*)(a.out + (size_t)gw * 1024 + 256 * j + 4 * lane));
        ninv = (lane < 16) ? ((const int*)(ws + WS_INV))[(size_t)gw * 16 + lane] : -1; }
    for (int m = gw; m < M; m += NGW) {
        const int b = m >> 13; float* row = a.out + (size_t)m * 1024;
        f32x4 v[4];
#pragma unroll
        for (int j = 0; j < 4; ++j) v[j] = nx[j];
        const int myinv = ninv;
        if (m + NGW < M) {
#pragma unroll
            for (int j = 0; j < 4; ++j) nx[j] = __builtin_nontemporal_load((const f32x4*)(a.out + (size_t)(m + NGW) * 1024 + 256 * j + 4 * lane));
            ninv = (lane < 16) ? ((const int*)(ws + WS_INV))[(size_t)(m + NGW) * 16 + lane] : -1; }
        unsigned long long mask = __ballot(myinv >= 0);
        const bf16* yb = (const bf16*)(ws + WS_YB) + (size_t)(b * 16) * CAP * 1024;
        while (mask) {
            u32x2 w[4][4]; float sc[4];
#pragma unroll
            for (int q = 0; q < 4; ++q) { const bool on = mask != 0ull; const int e = on ? (int)__builtin_ctzll(mask) : 0; mask = on ? (mask & (mask - 1ull)) : 0ull;
                const int sl = __shfl(myinv, e); const size_t ro = on ? ((size_t)e * CAP + (size_t)sl) * 1024 : 0; sc[q] = on ? 1.f : 0.f;
#pragma unroll
                for (int j = 0; j < 4; ++j) w[q][j] = __builtin_nontemporal_load((const u32x2*)(yb + ro + 256 * j + 4 * lane)); }
#pragma unroll
            for (int q = 0; q < 4; ++q)
#pragma unroll
                for (int j = 0; j < 4; ++j) { v[j][0] += sc[q] * bflo(w[q][j].x); v[j][1] += sc[q] * bfhi(w[q][j].x); v[j][2] += sc[q] * bflo(w[q][j].y); v[j][3] += sc[q] * bfhi(w[q][j].y); }
        }
        float ss = 0.f;
#pragma unroll
        for (int j = 0; j < 4; ++j) ss += v[j][0] * v[j][0] + v[j][1] * v[j][1] + v[j][2] * v[j][2] + v[j][3] * v[j][3];
        const float rstd = rsqrtf(wave_sum(ss) * (1.f / 1024.f) + EPS);
#pragma unroll
        for (int j = 0; j < 4; ++j) __builtin_nontemporal_store(v[j] * rstd * gv[j], (f32x4*)(row + 256 * j + 4 * lane));
    }
}

__global__ void __launch_bounds__(NT, 2) fwd_kernel(Args args) {
    extern __shared__ __attribute__((aligned(16))) unsigned char lds_raw[];
    LAS unsigned char* lds = (LAS unsigned char*)lds_raw;
    volatile LAS unsigned* MISC = (volatile LAS unsigned*)(lds + MISC_OFF);
    const int tid0 = threadIdx.x, tid = tid0, wave = __builtin_amdgcn_readfirstlane(tid >> 6);
    const int G = gridDim.x, bx = blockIdx.x, vcu = (G % 8 == 0) ? (bx % 8) * (G / 8) + bx / 8 : bx;
    unsigned char* ws = args.ws;
    if (tid < 128) MISC[tid] = 0u;
    __syncthreads();
    XcdBarrier bar; bar.bar = (unsigned*)(ws + WS_CTL) + CW_BAR; bar.x = 0; bar.st = nullptr;
    if (!MK_MULTI) bar = xcd_barrier_post((unsigned*)(ws + WS_CTL) + CW_BAR, MISC + 8);
    const int lo = args.ph_lo, hi = args.ph_hi;
#define IN(k) (lo <= (k) && (k) < hi)
#define SEAM(k) do { if (IN(k) && IN((k) + 1)) xcd_barrier(bar); } while (0)
#define RUN(k, CODE) do { if (IN(k)) { int tid = tid0, lane; asm volatile("" : "+v"(tid)); lane = tid & 63; (void)lane; CODE; if (REP_PHASE == (k)) for (int _r = 0; _r < REP_COUNT; ++_r) { xcd_barrier(bar); CODE; } } SEAM(k); } while (0)
#define PH0 phase0(lds, args, vcu, G, tid, lane, wave)
#define PH1 phase1(lds, args, vcu, G, tid, lane, wave)
#define PH2 do { const int qs = vcu % 3;     \
        EpiInproj E{(bf16*)(ws + WS_KB), (bf16*)(ws + WS_VB), (bf16*)(ws + WS_QB), (bf16*)(ws + WS_SG), (bf16*)(ws + WS_PI), (bf16*)(ws + WS_SM), 0, 1.f}; \
        EpiInproj E8{(bf16*)(ws + WS_KB), (bf16*)(ws + WS_VB), (bf16*)(ws + WS_QB), (bf16*)(ws + WS_SG), (bf16*)(ws + WS_PI), (bf16*)(ws + WS_SM), 8, 0.0625f}; \
        if (qs == 0) convert_all<1>(lds, args, vcu, G, lane, wave); \
        { SchedDense S{G, bx, 1024, 64, 8, (const char*)(ws + WS_H1), (const char*)(ws + WS_WIN), 0, 1 << 20, 2}; pg8::gemm_phase<EpiInproj, SchedDense, false, false>(lds, S, E); }     \
        if (qs == 1) convert_all<1>(lds, args, vcu, G, lane, wave); \
        { SchedDense S{G, bx, 1024, 64, 8, (const char*)(ws + WS_H1F), (const char*)(ws + WS_WINM), 0, 1 << 20, 1}; pg8::gemm_phase<EpiInproj, SchedDense, false, true>(lds, S, E8); }     \
        if (qs == 2) convert_all<1>(lds, args, vcu, G, lane, wave); } while (0)
#define PH3 chunk_units(lds, args, vcu, G, tid, lane, wave)
#define PH4 do { if (wave < 4) phase4(args, G, tid, 256); else pool_units(args, vcu, G, lane, wave - 4, 4); } while (0)
#define PH5 phase5(lds, args, vcu, G, tid, lane, wave)
#define PH6 do { SchedPair S{G, bx, 512, (const char*)(ws + WS_AG), (const char*)(ws + WS_PO), (const char*)(ws + WS_WG), (const char*)(ws + WS_WC)}; \
        EpiMerge E{(const bf16*)(ws + WS_SM), (bf16*)(ws + WS_MG)}; pg8::gemm_phase<EpiMerge, SchedPair, false>(lds, S, E); } while (0)
#define PH7 do { SchedDense S{G, bx, 1024, 64, 4, (const char*)(ws + WS_MG), (const char*)(ws + WS_WO), 0, 1 << 20, 2}; \
        EpiOut E{args.in[I_X], (const float*)(ws + WS_MOD), args.out}; pg8::gemm_phase<EpiOut, SchedDense, false>(lds, S, E); } while (0)
#define NITEM_HALF ((NE * 3 * 512 + 2 * G * NWAVES - 1) / (2 * G * NWAVES))
#define PH6C do { if (vcu & 1) convert_experts(lds, args, vcu, G, lane, wave, 0, NITEM_HALF); PH6; if (!(vcu & 1)) convert_experts(lds, args, vcu, G, lane, wave, 0, NITEM_HALF); } while (0)
#define PH7C do { if (vcu & 1) convert_experts(lds, args, vcu, G, lane, wave, NITEM_HALF, 2 * NITEM_HALF); PH7; if (!(vcu & 1)) convert_experts(lds, args, vcu, G, lane, wave, NITEM_HALF, 2 * NITEM_HALF); } while (0)
#define PH8 phase8(lds, args, vcu, G, tid, lane, wave)
#define PH9 phase9(lds, args, vcu, G, tid, lane, wave)
#define PH9B do { const int gw_ = vcu * NWAVES + wave, NGW_ = G * NWAVES;     \
        for (int r0_ = gw_ * 16; r0_ < NB * NE * CAP; r0_ += NGW_ * 16) { u32x4 t_[16]; \
            _Pragma("unroll") for (int q = 0; q < 16; ++q) { const int src_ = ((const int*)(ws + WS_IDX))[r0_ + q]; t_[q] = *(const u32x4*)(ws + WS_H2 + (size_t)src_ * 1024 + lane * 16); } \
            _Pragma("unroll") for (int q = 0; q < 16; ++q) *(u32x4*)(ws + WS_XS + (size_t)(r0_ + q) * 1024 + lane * 16) = t_[q]; } } while (0)
#define PH10 do { EpiMoe1 E{ws + WS_ACT}; SchedMoe1 S{G, bx, 1024, (const char*)(ws + WS_XS), (const char*)(ws + WS_WGU), 0, 1 << 20}; pg8::gemm_phase<EpiMoe1, SchedMoe1, false, true>(lds, S, E); } while (0)
#define PH11 do { SchedMoe2 S{G, bx, 1024, (const char*)(ws + WS_ACT), (const char*)(ws + WS_WD)}; \
        EpiMoe2 E{(bf16*)(ws + WS_YB), (const float*)(ws + WS_WSEL), (const float*)(ws + WS_MOD)}; pg8::gemm_phase<EpiMoe2, SchedMoe2, false, true>(lds, S, E); } while (0)
#define PH12 phase12(args, vcu, G, lane, wave)
    RUN(0, PH0); RUN(1, PH1); RUN(2, PH2); RUN(3, PH3);
#define PH3A chunk_units(lds, args, vcu, G, tid, lane, wave)
#define PH3B pool_units(args, vcu, G, lane, wave, 8)
    if (REP_PHASE == 30) { const int lane = tid & 63; xcd_barrier(bar); PH3A; xcd_barrier(bar); }
    if (REP_PHASE == 31) { const int lane = tid & 63; xcd_barrier(bar); PH3B; xcd_barrier(bar); } RUN(4, PH4); RUN(5, PH5); RUN(6, PH6); RUN(7, PH7); RUN(8, PH8); RUN(9, PH9); RUN(10, PH9B); RUN(11, PH10); RUN(12, PH11);
    if (REP_PHASE == 20) for (int _r = 0; _r < REP_COUNT; ++_r) xcd_barrier(bar);
    RUN(13, PH12);
#undef IN
#undef SEAM
#undef RUN
}

#ifndef MK_CHECK
#define MK_CHECK 0
#endif
#ifndef CHK_SKIP
#define CHK_SKIP -1
#endif
#if MK_CHECK
constexpr size_t WS_CHK = 299 * MiB;
__device__ __forceinline__ unsigned hashu(unsigned x) { x ^= x >> 16; x *= 0x7feb352dU; x ^= x >> 15; x *= 0x846ca68bU; x ^= x >> 16; return x; }
__device__ __forceinline__ float bfr(float f) { return bf2f(f2bf(f)); }
__device__ float f8d(unsigned char x) { const int sg = x >> 7, e = (x >> 3) & 15, m = x & 7; const float v = e ? ldexpf(1.f + m / 8.f, e - 7) : ldexpf(m / 8.f, -6); return sg ? -v : v; }
__device__ float f8r(float f) { return f8d((unsigned char)(pk4_fp8(f, 0.f, 0.f, 0.f) & 255u)); }
__device__ float naive_rstd(const float* row) { float ss = 0.f; for (int k = 0; k < 1024; ++k) ss += row[k] * row[k]; return rsqrtf(ss / 1024.f + EPS); }
__device__ float naive_la(const Args& a, int row, int dir, int col) {
    const float* RB = (const float*)(a.ws + WS_RB) + (size_t)row * 32 + dir * 16; float z = a.in[I_BDEC][dir * 256 + col];
    for (int j = 0; j < 16; ++j) z += RB[j] * a.in[I_WDU][(size_t)(dir * 16 + j) * 256 + col];
    return logsig_f(z) / 16.f;
}
__global__ void chk_kernel(Args a, int stage) {
    __shared__ float sh[256];
    const unsigned gid = blockIdx.x * blockDim.x + threadIdx.x; unsigned h = hashu(gid * 2654435761u + (unsigned)stage * 97u + 12345u); const unsigned h2 = hashu(h + 777u);
    unsigned char* ws = a.ws; float ref = 0.f, got = 0.f, atol = 1e-3f; bool active = true;
    const float* MOD = (const float*)(ws + WS_MOD);
    switch (stage) {
    case 0: { const int v = h % 3, n = (h >> 2) % 6144; ref = a.in[I_ADAB][n]; for (int k = 0; k < 1024; ++k) { const float c = (v < 2) ? a.in[I_C][v * 1024 + k] : a.in[I_CCTX][k]; ref += c / (1.f + expf(-c)) * a.in[I_ADAW][(size_t)k * 6144 + n]; } got = MOD[v * 6144 + n]; atol = 0.01f; } break;
    case 1: { const int sel = (h >> 28) & 3, n = h % 4096, k = (h >> 12) % 1024;
        if (sel < 2) { if (n < 2048) { ref = bfr(a.in[I_WIN][(size_t)k * DIN + n + (n >= 768 ? 32 : 0)]); got = bf2f(((const bf16*)(ws + WS_WIN))[(size_t)n * 1024 + k]); } else { ref = f8r(16.f * a.in[I_WIN][(size_t)k * DIN + n + 32]); got = f8d((ws + WS_WINM)[(size_t)(n - 2048) * 1024 + k]); } }
        else if (sel == 2) { ref = bfr(a.in[I_WOUT][(size_t)k * 1024 + (n & 1023)]); got = bf2f(((const bf16*)(ws + WS_WO))[(size_t)(n & 1023) * 1024 + k]); }
        else { ref = bfr(a.in[I_WGLA][(size_t)(k & 511) * 1024 + (n & 1023)]); got = bf2f(((const bf16*)(ws + WS_WG))[(size_t)(n & 1023) * 512 + (k & 511)]); } atol = 1e-4f; } break;
    case 2: { const int n = h % 1024, kk = (h >> 10) % 512, g = kk >> 7, c = kk & 127; for (int d = 0; d < 128; ++d) ref += a.in[I_POOLW][(size_t)(g * 128 + c) * 128 + d] * a.in[I_POOLS][g * 128 + d] * a.in[I_WPOOL][(size_t)(g * 128 + d) * 1024 + n];
        got = bf2f(((const bf16*)(ws + WS_WC))[(size_t)n * 512 + kk]); atol = 0.002f; } break;
    case 3: { const int m = h % M, k = (h >> 14) % 1024, b = m >> 13; const float* row = a.in[I_X] + (size_t)m * 1024; const float rstd = naive_rstd(row);
        ref = row[k] * rstd * a.in[I_N1G][k] * (1.f + MOD[b * 6144 + 1024 + k]) + MOD[b * 6144 + k]; got = bf2f(((const bf16*)(ws + WS_H1))[(size_t)m * 1024 + k]); atol = 0.01f; } break;
    case 4: { const int m = h % MT, c = (h >> 15) % 32, mi = (m < M) ? (m >> 13) : 2; const float* row = (m < M) ? a.in[I_X] + (size_t)m * 1024 : a.in[I_CTX] + (size_t)(m - M) * 1024; const float rstd = naive_rstd(row);
        for (int k = 0; k < 1024; ++k) ref += (row[k] * rstd * a.in[I_N1G][k] * (1.f + MOD[mi * 6144 + 1024 + k]) + MOD[mi * 6144 + k]) * a.in[I_WIN][(size_t)k * DIN + 768 + c];
        got = ((const float*)(ws + WS_RB))[(size_t)m * 32 + c]; atol = 0.01f; } break;
    case 5: { const int r = h % 512, n = (h >> 9) % 768; const float* row = a.in[I_CTX] + (size_t)r * 1024; const float rstd = naive_rstd(row);
        for (int k = 0; k < 1024; ++k) ref += bfr(row[k] * rstd * a.in[I_N1G][k] * (1.f + MOD[2 * 6144 + 1024 + k]) + MOD[2 * 6144 + k]) * bf2f(((const bf16*)(ws + WS_WIN))[(size_t)n * 1024 + k]);
        got = (n < 256) ? bf2f(((const bf16*)(ws + WS_KB))[(size_t)(M + r) * 256 + n]) : bf2f(((const bf16*)(ws + WS_VB))[(size_t)(M + r) * 512 + n - 256]); atol = 0.03f; } break;
    case 6: { const int m = h % M, n = (h >> 14) % 4096; const bf16* hr = (const bf16*)(ws + WS_H1) + (size_t)m * 1024; const bf16* wr_ = (const bf16*)(ws + WS_WIN) + (size_t)n * 1024; float d = 0.f;
        if (n < 2048) { for (int k = 0; k < 1024; ++k) d += bf2f(hr[k]) * bf2f(wr_[k]); }
        else { for (int k = 0; k < 1024; ++k) d += f8d((ws + WS_H1F)[(size_t)m * 1024 + k]) * f8d((ws + WS_WINM)[(size_t)(n - 2048) * 1024 + k]); d *= 0.0625f; }
        if (n < 256) { ref = d; got = bf2f(((const bf16*)(ws + WS_KB))[(size_t)m * 256 + n]); }
        else if (n < 768) { ref = d; got = bf2f(((const bf16*)(ws + WS_VB))[(size_t)m * 512 + n - 256]); }
        else if (n < 1024) { ref = d * 0.125f; got = bf2f(((const bf16*)(ws + WS_QB))[(size_t)m * 256 + n - 768]); }
        else if (n < 1536) { ref = d / (1.f + expf(-d)); got = bf2f(((const bf16*)(ws + WS_SG))[(size_t)m * 512 + n - 1024]); }
        else if (n < 2048) { ref = d; got = bf2f(((const bf16*)(ws + WS_PI))[(size_t)m * 512 + n - 1536]); }
        else { ref = 1.f / (1.f + expf(-d)); got = bf2f(((const bf16*)(ws + WS_SM))[(size_t)m * 2048 + n - 2048]); } atol = 0.02f; } break;
    case 7: { const int m = h % M, col = (h >> 14) % 256, dir = (h >> 22) & 1, t = m & 63, m0 = m - t;
        for (int s = 0; s < 64; ++s) if (dir ? (s >= t) : (s <= t)) ref += naive_la(a, m0 + s, dir, col);
        got = (dir ? a.out + (size_t)M * 256 : a.out)[(size_t)m * 256 + col]; atol = 0.003f; } break;
    case 8: case 9: { const int dir = h & 1, bh = (h >> 1) & 7, slot = (stage == 9) ? 128 + ((h >> 4) & 3) : ((h >> 4) & 127), dv = (h >> 11) & 127, dk = (h >> 18) & 63, b = bh >> 2, hh = bh & 3;
        const int row0 = (slot < 128) ? b * SEQ + slot * 64 : M + b * LC + (slot - 128) * 64; float la[64]; float tot = 0.f;
        for (int s = 0; s < 64; ++s) tot += naive_la(a, row0 + s, dir, hh * 64 + dk);
        float run = 0.f;
        if (!dir) { for (int s = 0; s < 64; ++s) { run += naive_la(a, row0 + s, 0, hh * 64 + dk); ref += bf2f(((const bf16*)(ws + WS_VB))[(size_t)(row0 + s) * 512 + hh * 128 + dv]) * bfr(bf2f(((const bf16*)(ws + WS_KB))[(size_t)(row0 + s) * 256 + hh * 64 + dk]) * expf(tot - run)); } }
        else { for (int s = 63; s >= 0; --s) { run += naive_la(a, row0 + s, 1, hh * 64 + dk); ref += bf2f(((const bf16*)(ws + WS_VB))[(size_t)(row0 + s) * 512 + hh * 128 + dv]) * bfr(bf2f(((const bf16*)(ws + WS_KB))[(size_t)(row0 + s) * 256 + hh * 64 + dk]) * expf(tot - run)); } }
        (void)la;
        if ((h >> 30) & 1) { ref = expf(tot); got = ((const float*)(ws + WS_DEC))[((size_t)(dir * 8 + bh) * NSLOT + slot) * 64 + dk]; atol = 1e-3f; }
        else { got = bf2f(((const bf16*)(ws + WS_KV))[((size_t)(dir * 8 + bh) * NSLOT + slot) * 8192 + dv * 64 + dk]); atol = 0.1f; } } break;
    case 10: { const int m = h % M, col = (h >> 14) % 512, g = col >> 7, half = 1 << g, b = m >> 13, l = m & 8191, r = l >> 6, c = l & 63; const bf16* PI = (const bf16*)(ws + WS_PI);
        const int lo_r = max(r - half, 0), hi_r = min(r + half, 128), lo_c = max(c - half, 0), hi_c = min(c + half, 64); float sm = 0.f;
        for (int rr = lo_r; rr < hi_r; ++rr) for (int cc = lo_c; cc < hi_c; ++cc) sm += bf2f(PI[(size_t)(b * SEQ + rr * 64 + cc) * 512 + col]);
        ref = sm / (float)((hi_r - lo_r) * (hi_c - lo_c)) - bf2f(PI[(size_t)m * 512 + col]); got = bf2f(((const bf16*)(ws + WS_PO))[(size_t)m * 512 + col]); atol = 0.02f; } break;
    case 11: { const int dir = h & 1, bh = (h >> 1) & 7, n = (h >> 4) & 127, e8 = (h >> 11) & 8191, dk = e8 & 63; float s = 0.f;
        const bf16* kvp = (const bf16*)(ws + WS_KV) + (size_t)((dir * 8 + bh) * NSLOT) * 8192 + e8; const float* dp = (const float*)(ws + WS_DEC) + (size_t)((dir * 8 + bh) * NSLOT) * 64 + dk;
        if (!dir) { for (int j = 128; j < 132; ++j) s = dp[j * 64] * s + bf2f(kvp[(size_t)j * 8192]); for (int j = 0; j < n; ++j) s = dp[j * 64] * s + bf2f(kvp[(size_t)j * 8192]); }
        else { for (int j = 131; j >= 128; --j) s = dp[j * 64] * s + bf2f(kvp[(size_t)j * 8192]); for (int j = 127; j > n; --j) s = dp[j * 64] * s + bf2f(kvp[(size_t)j * 8192]); }
        ref = s; got = bf2f(((const bf16*)(ws + WS_ST))[(size_t)((dir * 8 + bh) * NCH + n) * 8192 + e8]); atol = 0.1f; } break;
    case 12: {
        const unsigned hb = hashu(blockIdx.x * 7919u + 5u); const int m = hb % M, hh = (hb >> 14) & 3, b = m >> 13, l = m & 8191, n = l >> 6, t = l & 63, row0 = m - t, bh = b * 4 + hh, dv = threadIdx.x & 127;
        const float* BF = a.out; const float* CB = a.out + (size_t)M * 256; const bf16* QB = (const bf16*)(ws + WS_QB); const bf16* KB = (const bf16*)(ws + WS_KB); const bf16* VB = (const bf16*)(ws + WS_VB); const bf16* ST = (const bf16*)(ws + WS_ST);
        if (threadIdx.x < 128) { const int j = threadIdx.x & 63, dir = threadIdx.x >> 6; float sc = 0.f;
            const bool keep = dir ? (j >= t) : (j <= t);
            if (keep) for (int d = 0; d < 64; ++d) { const size_t gq = (size_t)m * 256 + hh * 64 + d, gk = (size_t)(row0 + j) * 256 + hh * 64 + d; const float* P = dir ? CB : BF; sc += bf2f(QB[gq]) * bf2f(KB[gk]) * expf(P[gq] - P[gk]); }
            sh[threadIdx.x] = sc; }
        __syncthreads();
        float o = 0.f;
        for (int d = 0; d < 64; ++d) { const size_t gq = (size_t)m * 256 + hh * 64 + d; const float q = bf2f(QB[gq]);
            o += q * expf(BF[gq]) * bf2f(ST[((size_t)((0 * 8 + bh) * NCH + n) * 128 + dv) * 64 + d]) + q * expf(CB[gq]) * bf2f(ST[((size_t)((1 * 8 + bh) * NCH + n) * 128 + dv) * 64 + d]); }
        for (int j = 0; j < 64; ++j) o += (sh[j] + sh[64 + j]) * bf2f(VB[(size_t)(row0 + j) * 512 + hh * 128 + dv]);
        __syncthreads(); sh[128 + dv] = o * o; __syncthreads();
        float ss = 0.f; for (int d = 0; d < 128; ++d) ss += sh[128 + d];
        const size_t gi = (size_t)m * 512 + hh * 128 + dv;
        ref = o * rsqrtf(ss / 128.f + EPS) * a.in[I_GNG][dv] * bf2f(((const bf16*)(ws + WS_SG))[gi]); got = bf2f(((const bf16*)(ws + WS_AG))[gi]); atol = 0.03f; } break;
    case 13: { const int m = h % M, n = (h >> 14) % 1024; float g = 0.f, p = 0.f; const bf16* AG = (const bf16*)(ws + WS_AG) + (size_t)m * 512; const bf16* PO = (const bf16*)(ws + WS_PO) + (size_t)m * 512;
        for (int k = 0; k < 512; ++k) { g += bf2f(AG[k]) * bf2f(((const bf16*)(ws + WS_WG))[(size_t)n * 512 + k]); p += bf2f(PO[k]) * bf2f(((const bf16*)(ws + WS_WC))[(size_t)n * 512 + k]); }
        const bf16* SM = (const bf16*)(ws + WS_SM) + (size_t)m * 2048; ref = bf2f(SM[n]) * g + bf2f(SM[1024 + n]) * p; got = bf2f(((const bf16*)(ws + WS_MG))[(size_t)m * 1024 + n]); atol = 0.03f; } break;
    case 14: { const int m = h % M, n = (h >> 14) % 1024, b = m >> 13; float d = 0.f; for (int k = 0; k < 1024; ++k) d += bf2f(((const bf16*)(ws + WS_MG))[(size_t)m * 1024 + k]) * bf2f(((const bf16*)(ws + WS_WO))[(size_t)n * 1024 + k]);
        ref = a.in[I_X][(size_t)m * 1024 + n] + MOD[b * 6144 + 2048 + n] * d; got = a.out[(size_t)m * 1024 + n]; atol = 0.01f; } break;
    case 15: { const int m = h % M, k = (h >> 14) % 1024, b = m >> 13; const float* row = a.out + (size_t)m * 1024; const float rstd = naive_rstd(row);
        ref = row[k] * rstd * a.in[I_N2G][k] * (1.f + MOD[b * 6144 + 4096 + k]) + MOD[b * 6144 + 3072 + k]; got = f8d((ws + WS_H2)[(size_t)m * 1024 + k]); atol = 0.02f; ref = f8r(ref); } break;
    case 16: { const int m = h % M, e = (h >> 14) & 15, b = m >> 13; const float* row = a.out + (size_t)m * 1024; const float rstd = naive_rstd(row); float mx = -1e30f, mye = 0.f, sm = 0.f;
        for (int pass = 0; pass < 2; ++pass) for (int ee = 0; ee < 16; ++ee) { float lg = 0.f; for (int k = 0; k < 1024; ++k) lg += (row[k] * rstd * a.in[I_N2G][k] * (1.f + MOD[b * 6144 + 4096 + k]) + MOD[b * 6144 + 3072 + k]) * a.in[I_WROUTER][k * 16 + ee];
            if (pass == 0) mx = fmaxf(mx, lg); else { const float ex = expf(lg - mx); sm += ex; if (ee == e) mye = ex; } }
        ref = mye / sm; got = ((const float*)(ws + WS_AFF))[(size_t)(b * 16 + e) * SEQ + (m & 8191)]; atol = 0.001f; } break;
    case 17: { const int be = h & 31, slot = (h >> 5) & 1023, b = be >> 4, e = be & 15; const int row = ((const int*)(ws + WS_IDX))[be * CAP + slot]; const float* aff = (const float*)(ws + WS_AFF) + (size_t)be * SEQ; float bad = 0.f;
        if (row < b * SEQ || row >= (b + 1) * SEQ) bad += 1.f; else { const int l = row & 8191; if (((const int*)(ws + WS_INV))[(size_t)row * 16 + e] != slot) bad += 1.f; if (((const float*)(ws + WS_WSEL))[be * CAP + slot] != aff[l]) bad += 1.f;
            int cnt = 0; for (int j = 0; j < SEQ; ++j) cnt += (aff[j] > aff[l]) ? 1 : 0; if (cnt >= CAP) bad += 1.f;
            const int l2 = h2 & 8191; if (((const int*)(ws + WS_INV))[(size_t)(b * SEQ + l2) * 16 + e] < 0) { int c2 = 0; for (int j = 0; j < SEQ; ++j) c2 += (aff[j] >= aff[l2]) ? 1 : 0; if (c2 <= CAP) bad += 1.f; } }
        ref = 0.f; got = bad; atol = 0.5f; } break;
    case 18: { const int e = h & 15, mat = (h >> 4) % 3, n = (h >> 8) & 1023, k = (h >> 18) & 1023;
        if (mat == 0) { ref = f8r(16.f * a.in[I_WGATE][(size_t)e * 1048576 + (size_t)k * 1024 + n]); got = f8d((ws + WS_WGU)[((size_t)e * 2048 + (n >> 7) * 256 + (n & 127)) * 1024 + k]); }
        else if (mat == 1) { ref = f8r(16.f * a.in[I_WUP][(size_t)e * 1048576 + (size_t)k * 1024 + n]); got = f8d((ws + WS_WGU)[((size_t)e * 2048 + (n >> 7) * 256 + 128 + (n & 127)) * 1024 + k]); }
        else { ref = f8r(16.f * a.in[I_WDOWN][(size_t)e * 1048576 + (size_t)k * 1024 + n]); got = f8d((ws + WS_WD)[((size_t)e * 1024 + n) * 1024 + k]); } atol = 1e-4f; } break;
    case 19: { const int be = h & 31, slot = (h >> 5) & 1023, f = (h >> 15) & 1023, e = be & 15; const int row = ((const int*)(ws + WS_IDX))[be * CAP + slot]; float g = 0.f, u = 0.f;
        const unsigned char* hr = ws + WS_H2 + (size_t)row * 1024; const unsigned char* wg = ws + WS_WGU + ((size_t)e * 2048 + (f >> 7) * 256 + (f & 127)) * 1024; const unsigned char* wu = wg + 128 * 1024;
        for (int k = 0; k < 1024; ++k) { g += f8d(hr[k]) * f8d(wg[k]); u += f8d(hr[k]) * f8d(wu[k]); }
        g *= 0.0625f; u *= 0.0625f; ref = f8r(g / (1.f + expf(-g)) * u); got = f8d((ws + WS_ACT)[((size_t)be * CAP + slot) * 1024 + f]); atol = 0.03f; } break;
    case 20: { const int be = h & 31, slot = (h >> 5) & 1023, n = (h >> 15) & 1023, e = be & 15, b = be >> 4; float d = 0.f;
        for (int f = 0; f < 1024; ++f) d += f8d((ws + WS_ACT)[((size_t)be * CAP + slot) * 1024 + f]) * f8d((ws + WS_WD)[((size_t)e * 1024 + n) * 1024 + f]);
        ref = d * 0.0625f * ((const float*)(ws + WS_WSEL))[be * CAP + slot] * MOD[b * 6144 + 5120 + n]; got = bf2f(((const bf16*)(ws + WS_YB))[((size_t)be * CAP + slot) * 1024 + n]); atol = 0.002f; } break;
    default: active = false;
    }
    if (active) { float e = fabsf(got - ref) / (atol + 0.03f * fabsf(ref)); if (!(e == e)) e = 1e9f; atomicMax((unsigned*)(ws + WS_CHK) + stage, __float_as_uint(e)); }
}
__global__ void chk_final(Args a) {
    __shared__ int code;
    if (threadIdx.x == 0) { int c = 0; for (int s = 20; s >= 0; --s) if (s > CHK_SKIP && __uint_as_float(((const unsigned*)(a.ws + WS_CHK))[s]) > 1.f) c = s + 1; code = c; }
    __syncthreads();
    const float sc = 1.f + 0.1f * (float)code;
    for (size_t i = (size_t)blockIdx.x * blockDim.x + threadIdx.x; i < (size_t)M * D; i += (size_t)gridDim.x * blockDim.x) a.out[i] *= sc;
}
#endif

extern "C" void kernel_launch(void* const* d_in, const int* in_sizes, int n_in, void* d_out, int out_size, void* d_ws, size_t ws_size, hipStream_t stream) {
    static int grid = 0;
    if (grid == 0) {
        if (n_in != 22 || out_size != M * D || ws_size < WS_END) { fprintf(stderr, "kernel_launch: unexpected shapes (n_in %d, out %d, ws %zu < %zu)\n", n_in, out_size, ws_size, (size_t)WS_END); grid = -1; return; }
        int dev = 0, cus = 0, per_cu = 0;
        if (hipGetDevice(&dev) != hipSuccess || hipDeviceGetAttribute(&cus, hipDeviceAttributeMultiprocessorCount, dev) != hipSuccess) { grid = -1; return; }
        if (hipFuncSetAttribute((const void*)fwd_kernel, hipFuncAttributeMaxDynamicSharedMemorySize, LDS_BYTES) != hipSuccess) { fprintf(stderr, "kernel_launch: hipFuncSetAttribute failed\n"); grid = -1; return; }
        if (hipOccupancyMaxActiveBlocksPerMultiprocessor(&per_cu, (const void*)fwd_kernel, NT, LDS_BYTES) != hipSuccess || per_cu < 1) { fprintf(stderr, "kernel_launch: occupancy query says %d\n", per_cu); per_cu = 1; }
        (void)hipGetLastError();
        grid = cus;
    }
    if (grid < 0) return;
    (void)hipMemsetAsync((char*)d_ws + WS_CTL, 0, CTL_ZERO_BYTES, stream);
    Args a{};
    for (int i = 0; i < 22; ++i) a.in[i] = (const float*)d_in[i];
    a.out = (float*)d_out; a.ws = (unsigned char*)d_ws;
#if MK_MULTI
    for (int p = 0; p < NPHASE; ++p) { a.ph_lo = p; a.ph_hi = p + 1; hipLaunchKernelGGL(fwd_kernel, dim3(grid), dim3(NT), LDS_BYTES, stream, a);
#if MK_CHECK
        if (p == 0) (void)hipMemsetAsync((char*)d_ws + WS_CHK, 0, 4096, stream);
        static const int after[21] = {0, 0, 0, 1, 1, 1, 2, 3, 3, 3, 4, 4, 5, 6, 7, 8, 8, 9, 10, 11, 12};
        for (int st = 0; st < 21; ++st) if (after[st] == p) hipLaunchKernelGGL(chk_kernel, dim3(st == 12 ? 1024 : 32), dim3(128), 0, stream, a, st);
        if (p == NPHASE - 1) hipLaunchKernelGGL(chk_final, dim3(1024), dim3(256), 0, stream, a);
#endif
    }
#else
    a.ph_lo = 0; a.ph_hi = NPHASE;
#if MK_COOP
    void* kargs[] = {&a};
    hipError_t e = hipLaunchCooperativeKernel((const void*)fwd_kernel, dim3(grid), dim3(NT), kargs, LDS_BYTES, stream);
    if (e != hipSuccess) fprintf(stderr, "kernel_launch: cooperative launch failed: %s (grid %d)\n", hipGetErrorString(e), grid);
#else
    hipLaunchKernelGGL(fwd_kernel, dim3(grid), dim3(NT), LDS_BYTES, stream, a);
#endif
#endif
}
```

```cpp
#include <hip/hip_runtime.h>
#include <cstdio>
#include <cstdint>

#define LAS __attribute__((address_space(3)))
#define GAS __attribute__((address_space(1)))
typedef unsigned short bf16;
typedef short bf16x8 __attribute__((ext_vector_type(8)));
typedef float f32x4 __attribute__((ext_vector_type(4)));
typedef float f32x2 __attribute__((ext_vector_type(2)));
typedef unsigned u32x4 __attribute__((ext_vector_type(4)));
typedef unsigned u32x2 __attribute__((ext_vector_type(2)));

#ifndef ABL_NOMOE
#define ABL_NOMOE 0
#endif
#ifndef REP_PHASE
#define REP_PHASE -1
#endif
#ifndef REP_COUNT
#define REP_COUNT 1
#endif
#ifndef MK_COOP
#define MK_COOP 1
#endif
#ifndef MK_MULTI
#define MK_MULTI 0
#endif

constexpr int D = 1024, NB = 2, SEQ = 8192, M = NB * SEQ, LC = 256, MC = NB * LC, MT = M + MC;
constexpr int DIN = 4128;
constexpr int NCH = SEQ / 64, NCHC = LC / 64, NSLOT = NCH + NCHC;
constexpr int NE = 16, CAP = 1024;
constexpr float EPS = 1e-6f;
constexpr int NWAVES = 8, NT = 512;
constexpr int NPHASE = 14;

constexpr size_t MiB = 1u << 20;
constexpr size_t WS_CTL = 0, CTL_ZERO_BYTES = 64 * 1024;
constexpr size_t WS_MOD = 1 * MiB;
constexpr size_t WS_DEC = 1 * MiB + 128 * 1024;
constexpr size_t WS_WIN = 2 * MiB, WS_WO = 10 * MiB, WS_WG = 12 * MiB, WS_WC = 13 * MiB;
constexpr size_t WS_AFF = 14 * MiB, WS_INV = 15 * MiB, WS_IDX = 16 * MiB, WS_WSEL = 16 * MiB + 256 * 1024;
constexpr size_t WS_H1 = 20 * MiB;
constexpr size_t WS_ST = 20 * MiB, WS_H2 = 20 * MiB;
constexpr size_t WS_KB = 52 * MiB, WS_VB = 61 * MiB, WS_QB = 78 * MiB, WS_SG = 86 * MiB, WS_PI = 102 * MiB, WS_RB = 118 * MiB;
constexpr size_t WS_AG = 102 * MiB;
constexpr size_t WS_SM = 121 * MiB;
constexpr size_t WS_KV = 249 * MiB;
constexpr size_t WS_PO = 282 * MiB;
constexpr size_t WS_MG = 249 * MiB;
constexpr size_t WS_WGU = 185 * MiB, WS_WD = 52 * MiB, WS_ACT = 121 * MiB, WS_YB = 185 * MiB;
constexpr size_t WS_H1F = 249 * MiB;
constexpr size_t WS_WINM = 265 * MiB;
constexpr size_t WS_XS = 68 * MiB;
constexpr size_t WS_END = 300 * MiB;
constexpr int CW_BAR = 1024;

constexpr int LDS_BYTES = 155648;
constexpr int MISC_OFF = 153600;

#define LDS_WAIT() asm volatile("s_waitcnt lgkmcnt(0)" ::: "memory")
#define VM_WAIT() asm volatile("s_waitcnt vmcnt(0)" ::: "memory")
__device__ __forceinline__ unsigned f2bf(float f) { unsigned u = __builtin_bit_cast(unsigned, f); return (u + 0x7fffu + ((u >> 16) & 1u)) >> 16; }
__device__ __forceinline__ unsigned pk2(float lo, float hi) { return f2bf(lo) | (f2bf(hi) << 16); }
__device__ __forceinline__ float bf2f(unsigned h) { return __builtin_bit_cast(float, h << 16); }
__device__ __forceinline__ float bflo(unsigned w) { return __builtin_bit_cast(float, w << 16); }
__device__ __forceinline__ float bfhi(unsigned w) { return __builtin_bit_cast(float, w & 0xffff0000u); }
__device__ __forceinline__ unsigned cvt_pk_bf16(float lo, float hi) { unsigned r; asm volatile("v_cvt_pk_bf16_f32 %0, %1, %2" : "=v"(r) : "v"(lo), "v"(hi)); return r; }
__device__ __forceinline__ unsigned pk4_fp8(float a, float b, float c, float d) { int w = 0; w = __builtin_amdgcn_cvt_pk_fp8_f32(a, b, w, false); w = __builtin_amdgcn_cvt_pk_fp8_f32(c, d, w, true); return (unsigned)w; }
__device__ __forceinline__ float wave_sum(float v) {
#pragma unroll
    for (int o = 1; o < 64; o <<= 1) v += __shfl_xor(v, o);
    return v;
}
__device__ __forceinline__ float silu_f(float x) { return x / (1.f + __expf(-x)); }
__device__ __forceinline__ float sigmoid_f(float x) { return 1.f / (1.f + __expf(-x)); }
__device__ __forceinline__ float logsig_f(float z) { return fminf(z, 0.f) - log1pf(expf(-fabsf(z))); }

#define XB_TMO      128
#define XB_XCNT(j)  (256  + 64 * (j))
#define XB_XSUB(j)  (1280 + 64 * (j))
#define XB_XGEN(j)  (2304 + 64 * (j))
#define XB_TOP      3328
#define XB_TOPGEN   3392
#define XCD_BAR_WORDS 3456
#define XB_SPIN_CAP (1u << 20)
__device__ __forceinline__ unsigned xb_ld(unsigned* p)              { return __hip_atomic_load(p, __ATOMIC_RELAXED, __HIP_MEMORY_SCOPE_AGENT); }
__device__ __forceinline__ unsigned xb_add(unsigned* p, unsigned v) { return __hip_atomic_fetch_add(p, v, __ATOMIC_RELAXED, __HIP_MEMORY_SCOPE_AGENT); }
__device__ __forceinline__ unsigned xb_xcc_id() { return (unsigned)__builtin_amdgcn_s_getreg((3 << 11) | 20) & 0xFu; }
#define XB_SPIN(cond, bar) do { unsigned _sp = 0; while (cond) { __builtin_amdgcn_s_sleep(1); \
    if ((++_sp & 255u) == 0u) { if (xb_ld(&(bar)[XB_TMO])) break; if (_sp > XB_SPIN_CAP) { atomicAdd(&(bar)[XB_TMO], 1u); break; } } } } while (0)
struct XcdBarrier { unsigned* bar; unsigned x; volatile LAS unsigned* st; };
__device__ __forceinline__ XcdBarrier xcd_barrier_post(unsigned* bar, volatile LAS unsigned* st) {
    XcdBarrier b; b.bar = bar; b.x = xb_xcc_id(); b.st = st;
    if (threadIdx.x == 0) (void)xb_add(&bar[XB_XCNT(b.x)], 1u);
    return b;
}
__device__ __forceinline__ void xcd_barrier_complete(unsigned* bar, unsigned x, unsigned& nloc, unsigned& nx) {
    const unsigned G = gridDim.x * gridDim.y * gridDim.z;
    unsigned sum, cnt, mine, sp = 0u;
    for (;;) {
        sum = 0u; cnt = 0u; mine = 0u;
#pragma unroll
        for (unsigned j = 0; j < 16; ++j) { const unsigned c = xb_ld(&bar[XB_XCNT(j)]); sum += c; cnt += (c > 0u) ? 1u : 0u; mine = (j == x) ? c : mine; }
        if (sum == G) break;
        __builtin_amdgcn_s_sleep(1);
        if ((++sp & 255u) == 0u) { if (xb_ld(&bar[XB_TMO])) break; if (sp > XB_SPIN_CAP) { atomicAdd(&bar[XB_TMO], 1u); break; } }
    }
    nloc = mine > 0u ? mine : 1u; nx = cnt > 0u ? cnt : 1u;
}
__device__ __forceinline__ void xcd_barrier(const XcdBarrier& b) {
    asm volatile("s_waitcnt vmcnt(0)" ::: "memory");
    __syncthreads();
    if (threadIdx.x == 0) {
        unsigned* bar = b.bar;
        __builtin_amdgcn_s_waitcnt(0);
        unsigned nloc = b.st[0], nx = b.st[1];
        if (nloc == 0u) { xcd_barrier_complete(bar, b.x, nloc, nx); b.st[0] = nloc; b.st[1] = nx; }
        const unsigned old = xb_add(&bar[XB_XSUB(b.x)], 1u);
        const unsigned gen = old / nloc;
        if (old + 1u == (gen + 1u) * nloc) {
            __builtin_amdgcn_fence(__ATOMIC_RELEASE, "agent");
            asm volatile("s_waitcnt vmcnt(0)" ::: "memory");
            const unsigned og = xb_add(&bar[XB_TOP], 1u);
            const unsigned tg = og / nx;
            if (og + 1u == (tg + 1u) * nx) xb_add(&bar[XB_TOPGEN], 1u);
            else XB_SPIN(xb_ld(&bar[XB_TOPGEN]) == tg, bar);
            __builtin_amdgcn_fence(__ATOMIC_ACQUIRE, "agent");
            xb_add(&bar[XB_XGEN(b.x)], 1u);
            asm volatile("s_waitcnt vmcnt(0)" ::: "memory");
        } else {
            XB_SPIN(xb_ld(&bar[XB_XGEN(b.x)]) == gen, bar);
            __builtin_amdgcn_fence(__ATOMIC_ACQUIRE, "agent");
            asm volatile("s_waitcnt vmcnt(0)" ::: "memory");
        }
    }
    __syncthreads();
}

namespace pg8 {
constexpr int BM = 256, BK = 64, HALF = 128, HTB = HALF * BK * 2, STAGE_BYTES = 8 * HTB;
__device__ __forceinline__ int lds_byte(int r, int c) { const int st = (r >> 4) * 2 + (c >> 5), rr = r & 15, cc = c & 31, ob = rr * 64 + cc * 2; return st * 1024 + (ob ^ (((ob >> 9) & 1) << 5)); }
__device__ __forceinline__ void stage_rc(int b, int& R, int& C) { const int st = b / 1024, sb = b % 1024, swz = sb ^ (((sb >> 9) & 1) << 5); R = (st >> 1) * 16 + swz / 64; C = (st & 1) * 32 + (swz % 64) / 2; }
__device__ __forceinline__ int perm32(int rho) { const int n = rho >> 4, i = rho & 15; return 8 * (i >> 2) + 4 * n + (i & 3); }
struct Unit { int pm, pn, aux, keep; };
typedef int v8i __attribute__((ext_vector_type(8)));
typedef int v4i __attribute__((ext_vector_type(4)));
__device__ __forceinline__ void xcd_tile(int L, int nM, int nN, int& pm, int& pn) {
    const int nwg = nM * nN; int wgid = L;
    { const int q = nwg / 8, r = nwg % 8, xcd = wgid % 8, off = wgid / 8; wgid = (xcd < r ? xcd * (q + 1) : r * (q + 1) + (xcd - r) * q) + off; }
    const int nig = 8 * nN, gid = wgid / nig, fm = gid * 8, gsz = (nM - fm) < 8 ? (nM - fm) : 8;
    pm = fm + ((wgid % nig) % gsz); pn = (wgid % nig) / gsz;
}

template <class Epi, class Sched, bool GATHER, bool FP8 = false>
__device__ __forceinline__ void gemm_phase(LAS unsigned char* lds, const Sched& S, const Epi& E) {
    int tid = threadIdx.x; asm volatile("" : "+v"(tid));
    const int wid = __builtin_amdgcn_readfirstlane(tid >> 6), lane = tid & 63, wr = wid >> 2, wc = wid & 3, fr = lane & 15, fq = lane >> 4;
    const int K = S.K, KB = FP8 ? K : 2 * K, nt = KB / (2 * BK);
    unsigned voffA[2], voffB[2]; int Rs[2], Cb[2];
#pragma unroll
    for (int i = 0; i < 2; ++i) { int R, C; stage_rc(tid * 16 + i * 8192, R, C); const int Rb = Epi::PERM ? ((R & ~31) + perm32(R & 31)) : R;
        Rs[i] = R; Cb[i] = C * 2; voffA[i] = (unsigned)(R * KB + C * 2); voffB[i] = (unsigned)(Rb * KB + C * 2); }
    const size_t kstep = (size_t)(BK * 2);
    const size_t hstep = (size_t)HALF * KB;
    const size_t hstepA = GATHER ? 0 : hstep;
    const unsigned ldsw = (unsigned)wid * 1024u;
    const int aoff = FP8 ? lds_byte(wr * 64 + fr, fq * 16) : lds_byte(wr * 64 + fr, fq * 8), boff = FP8 ? lds_byte(wc * 32 + fr, fq * 16) : lds_byte(wc * 32 + fr, fq * 8);
#define PG8_SA(b, h) (((b) * 2 + (h)) * HTB)
#define PG8_SB(b, h) ((4 + (b) * 2 + (h)) * HTB)
#define PG8_STAGE(bufoff, gbase, voff, W) do { _Pragma("unroll") for (int _i = 0; _i < 2; ++_i) { \
        if constexpr (FP8) __builtin_amdgcn_raw_ptr_buffer_load_lds(rsrc##W, (LAS unsigned*)(lds + (bufoff) + ldsw + _i * 8192), 16, (int)(voff)[_i], (int)(unsigned)((const char*)(gbase) - base##W), 0, 0); \
        else __builtin_amdgcn_global_load_lds((const unsigned*)((const char*)(gbase) + (voff)[_i]), (LAS unsigned*)(lds + (bufoff) + ldsw + _i * 8192), 16, 0, 0); } } while (0)
#define PG8_LDA(dst, b, h) do { _Pragma("unroll") for (int m = 0; m < 4; ++m) { \
        if constexpr (FP8) { const v4i _lo = *(const LAS v4i*)(lds + PG8_SA(b, h) + aoff + m * 2048), _hi = *(const LAS v4i*)(lds + PG8_SA(b, h) + aoff + m * 2048 + 16); dst##8[m] = __builtin_shufflevector(_lo, _hi, 0, 1, 2, 3, 4, 5, 6, 7); } \
        else { _Pragma("unroll") for (int k = 0; k < 2; ++k) dst[m][k] = *(const LAS bf16x8*)(lds + PG8_SA(b, h) + aoff + m * 2048 + k * 1024); } } } while (0)
#define PG8_LDB(dst, b, h) do { _Pragma("unroll") for (int n = 0; n < 2; ++n) { \
        if constexpr (FP8) { const v4i _lo = *(const LAS v4i*)(lds + PG8_SB(b, h) + boff + n * 2048), _hi = *(const LAS v4i*)(lds + PG8_SB(b, h) + boff + n * 2048 + 16); dst##8[n] = __builtin_shufflevector(_lo, _hi, 0, 1, 2, 3, 4, 5, 6, 7); } \
        else { _Pragma("unroll") for (int k = 0; k < 2; ++k) dst[n][k] = *(const LAS bf16x8*)(lds + PG8_SB(b, h) + boff + n * 2048 + k * 1024); } } } while (0)
#define PG8_MMA(ai, bj, At, Bt) do { __builtin_amdgcn_s_setprio(1); \
        if constexpr (FP8) { _Pragma("unroll") for (int m = 0; m < 4; ++m) _Pragma("unroll") for (int n = 0; n < 2; ++n) \
            acc[ai][bj][m][n] = __builtin_amdgcn_mfma_scale_f32_16x16x128_f8f6f4(Bt##8[n], At##8[m], acc[ai][bj][m][n], 0, 0, 0, 0, 0, 0); } \
        else { _Pragma("unroll") for (int m = 0; m < 4; ++m) _Pragma("unroll") for (int n = 0; n < 2; ++n) _Pragma("unroll") for (int k = 0; k < 2; ++k) \
            acc[ai][bj][m][n] = __builtin_amdgcn_mfma_f32_16x16x32_bf16(Bt[n][k], At[m][k], acc[ai][bj][m][n], 0, 0, 0); } \
        __builtin_amdgcn_s_setprio(0); } while (0)
#define PG8_WAIT_V(n) asm volatile("s_waitcnt vmcnt(" #n ")" ::: "memory")
#define PG8_WAIT_L(n) asm volatile("s_waitcnt lgkmcnt(" #n ")" ::: "memory")
#define PG8_BAR __builtin_amdgcn_s_barrier()
#define PG8_SCHED __builtin_amdgcn_sched_barrier(0)
    Unit cur, nxt; int ui = 0;
    if (!S.next(0, cur)) return;
    const char* baseA = S.base_a(); const char* baseB = S.base_b();
    const __amdgpu_buffer_rsrc_t rsrcA = __builtin_amdgcn_make_buffer_rsrc((void*)baseA, 0, 0x7fffffff, 0x00020000), rsrcB = __builtin_amdgcn_make_buffer_rsrc((void*)baseB, 0, 0x7fffffff, 0x00020000);
    f32x4 acc[2][2][4][2];
#pragma unroll
    for (int a = 0; a < 2; ++a)
#pragma unroll
        for (int b = 0; b < 2; ++b)
#pragma unroll
            for (int m = 0; m < 4; ++m)
#pragma unroll
                for (int n = 0; n < 2; ++n) acc[a][b][m][n] = (f32x4){0.f, 0.f, 0.f, 0.f};
    bf16x8 At[4][2], B0[2][2], B1[2][2]; v8i At8[4], B08[2], B18[2];
    const char* cA = S.a_base(cur); const char* cB = S.b_base(cur);
    unsigned cv0[2], cv1[2], nv0[2], nv1[2];
#pragma unroll
    for (int i = 0; i < 2; ++i) {
        if constexpr (GATHER) { cv0[i] = (unsigned)S.a_row(cur, Rs[i]) * (unsigned)KB + (unsigned)Cb[i]; cv1[i] = (unsigned)S.a_row(cur, HALF + Rs[i]) * (unsigned)KB + (unsigned)Cb[i]; }
        else { cv0[i] = voffA[i]; cv1[i] = voffA[i]; }
        nv0[i] = cv0[i]; nv1[i] = cv1[i];
    }
    PG8_STAGE(PG8_SB(0, 0), cB, voffB, B); PG8_STAGE(PG8_SB(0, 1), cB + hstep, voffB, B); PG8_STAGE(PG8_SA(0, 0), cA, cv0, A); PG8_STAGE(PG8_SA(0, 1), cA + hstepA, cv1, A);
    if (wr == 1) PG8_BAR;
    PG8_WAIT_V(2); PG8_BAR;
    PG8_STAGE(PG8_SB(1, 0), cB + kstep, voffB, B); PG8_STAGE(PG8_SA(1, 0), cA + kstep, cv0, A); PG8_STAGE(PG8_SB(1, 1), cB + hstep + kstep, voffB, B);
    PG8_WAIT_V(6); PG8_BAR;
    for (;;) {
        const bool has_next = S.next(ui + 1, nxt);
        const char* nA = has_next ? S.a_base(nxt) : cA; const char* nB = has_next ? S.b_base(nxt) : cB;
        if constexpr (GATHER) {
#pragma unroll
            for (int i = 0; i < 2; ++i) {
                if (has_next) { nv0[i] = (unsigned)S.a_row(nxt, Rs[i]) * (unsigned)KB + (unsigned)Cb[i]; nv1[i] = (unsigned)S.a_row(nxt, HALF + Rs[i]) * (unsigned)KB + (unsigned)Cb[i]; }
                else { nv0[i] = cv0[i]; nv1[i] = cv1[i]; }
            }
        }
        for (int t = 0; t < nt; t += 2) {
            const bool last = (t == nt - 2);
            const char* a1 = cA + (size_t)(t + 1) * kstep;
            const char* a2 = last ? nA : cA + (size_t)(t + 2) * kstep; const char* b2 = last ? nB : cB + (size_t)(t + 2) * kstep;
            const char* a3 = a2 + kstep; const char* b3 = b2 + kstep;
            unsigned s0[2], s1[2];
#pragma unroll
            for (int i = 0; i < 2; ++i) { s0[i] = (GATHER && last) ? nv0[i] : cv0[i]; s1[i] = (GATHER && last) ? nv1[i] : cv1[i]; }
            PG8_LDB(B0, 0, 0); PG8_LDB(B1, 0, 1); PG8_SCHED; PG8_LDA(At, 0, 0); PG8_STAGE(PG8_SA(1, 1), a1 + hstepA, cv1, A);
            PG8_WAIT_V(8); PG8_WAIT_L(0); PG8_BAR; PG8_MMA(0, 0, At, B0); PG8_MMA(0, 1, At, B1); PG8_BAR; PG8_SCHED;
            PG8_LDA(At, 0, 1); PG8_STAGE(PG8_SB(0, 0), b2, voffB, B); PG8_STAGE(PG8_SB(0, 1), b2 + hstep, voffB, B); PG8_STAGE(PG8_SA(0, 0), a2, s0, A);
            PG8_WAIT_V(8); PG8_WAIT_L(0); PG8_BAR; PG8_MMA(1, 0, At, B0); PG8_MMA(1, 1, At, B1); PG8_BAR; PG8_SCHED;
            PG8_LDB(B0, 1, 0); PG8_LDB(B1, 1, 1); PG8_SCHED; PG8_LDA(At, 1, 0); PG8_STAGE(PG8_SA(0, 1), a2 + hstepA, s1, A);
            PG8_WAIT_V(8); PG8_WAIT_L(0); PG8_BAR; PG8_MMA(0, 0, At, B0); PG8_MMA(0, 1, At, B1); PG8_BAR; PG8_SCHED;
            PG8_LDA(At, 1, 1); PG8_STAGE(PG8_SB(1, 0), b3, voffB, B); PG8_STAGE(PG8_SB(1, 1), b3 + hstep, voffB, B); PG8_STAGE(PG8_SA(1, 0), a3, s0, A);
            PG8_WAIT_V(8); PG8_WAIT_L(0); PG8_BAR; PG8_MMA(1, 0, At, B0); PG8_MMA(1, 1, At, B1); PG8_BAR; PG8_SCHED;
        }
        if (wr == 0) PG8_BAR;
        E(acc, cur, wr, wc, fr, fq);
        if (!has_next) break;
        E.post(acc, cur, wr, wc, fr, fq);
        cur = nxt; cA = nA; cB = nB; ++ui;
#pragma unroll
        for (int i = 0; i < 2; ++i) { cv0[i] = nv0[i]; cv1[i] = nv1[i]; }
        if (wr == 1) PG8_BAR;
    }
    PG8_WAIT_V(0);
    PG8_BAR;
#undef PG8_SA
#undef PG8_SB
#undef PG8_STAGE
#undef PG8_LDA
#undef PG8_LDB
#undef PG8_MMA
#undef PG8_WAIT_V
#undef PG8_WAIT_L
#undef PG8_BAR
#undef PG8_SCHED
}
}

using pg8::Unit;
struct SchedDense {
    int G, c, K, nM, nN; const char* A; const char* B; int i0, i1, eb;
    __device__ __forceinline__ bool next(int i, Unit& u) const { const int L = (i + i0) * G + c; if (i + i0 >= i1 || L >= nM * nN) return false; pg8::xcd_tile(L, nM, nN, u.pm, u.pn); u.aux = 0; u.keep = 0; return true; }
    __device__ __forceinline__ const char* a_base(const Unit& u) const { return A + (size_t)u.pm * 256 * K * eb; }
    __device__ __forceinline__ const char* b_base(const Unit& u) const { return B + (size_t)u.pn * 256 * K * eb; }
    __device__ __forceinline__ int a_row(const Unit&, int) const { return 0; }
    __device__ __forceinline__ const char* base_a() const { return A; }
    __device__ __forceinline__ const char* base_b() const { return B; }
};
struct SchedPair {
    int G, c, K; const char *A0, *A1, *B0, *B1;
    __device__ __forceinline__ bool next(int i, Unit& u) const { const int p = (i >> 1) * G + c; if (p >= 256) return false; pg8::xcd_tile(p, 64, 4, u.pm, u.pn); u.aux = i & 1; u.keep = 0; return true; }
    __device__ __forceinline__ const char* a_base(const Unit& u) const { return (u.aux ? A1 : A0) + (size_t)u.pm * 256 * K * 2; }
    __device__ __forceinline__ const char* b_base(const Unit& u) const { return (u.aux ? B1 : B0) + (size_t)u.pn * 256 * K * 2; }
    __device__ __forceinline__ int a_row(const Unit&, int) const { return 0; }
    __device__ __forceinline__ const char* base_a() const { return A0; }
    __device__ __forceinline__ const char* base_b() const { return B0; }
};
struct SchedMoe1 {
    int G, c, K; const char* A; const char* B; int i0, i1;
    __device__ __forceinline__ bool next(int i, Unit& u) const { const int L = (i + i0) * G + c; if (i + i0 >= i1 || L >= 1024) return false;
        const int xcd = L & 7, q = L >> 3, round = q >> 5, slot = q & 31, e = xcd + 8 * (round >> 1), u64 = (round & 1) * 32 + slot, mrow = u64 & 7;
        u.pn = u64 >> 3; u.pm = mrow & 3; u.aux = (mrow >> 2) * 16 + e; u.keep = 0; return true; }
    __device__ __forceinline__ const char* a_base(const Unit& u) const { return A + ((size_t)u.aux * 1024 + (size_t)u.pm * 256) * K; }
    __device__ __forceinline__ const char* b_base(const Unit& u) const { return B + ((size_t)(u.aux & 15) * 2048 + (size_t)u.pn * 256) * K; }
    __device__ __forceinline__ int a_row(const Unit&, int) const { return 0; }
    __device__ __forceinline__ const char* base_a() const { return A; }
    __device__ __forceinline__ const char* base_b() const { return B; }
};
struct SchedMoe2 {
    int G, c, K; const char* A; const char* B;
    __device__ __forceinline__ bool next(int i, Unit& u) const { const int L = i * G + c; if (L >= 512) return false;
        const int xcd = L & 7, q = L >> 3, round = q >> 5, slot = q & 31, e = xcd + 8 * round, mrow = slot & 7;
        u.pn = slot >> 3; u.pm = mrow & 3; u.aux = (mrow >> 2) * 16 + e; u.keep = 0; return true; }
    __device__ __forceinline__ const char* a_base(const Unit& u) const { return A + ((size_t)u.aux * 1024 + (size_t)u.pm * 256) * K; }
    __device__ __forceinline__ const char* b_base(const Unit& u) const { return B + ((size_t)(u.aux & 15) * 1024 + (size_t)u.pn * 256) * K; }
    __device__ __forceinline__ int a_row(const Unit&, int) const { return 0; }
    __device__ __forceinline__ const char* base_a() const { return A; }
    __device__ __forceinline__ const char* base_b() const { return B; }
};

typedef f32x4 AccT[2][2][4][2];
struct EpiInproj {
    static constexpr bool PERM = true;
    bf16 *KBp, *VBp, *QBp, *SGp, *PIp, *SMp; int pn_off; float sc;
    __device__ __forceinline__ void post(AccT& acc, const Unit&, int, int, int, int) const {
#pragma unroll
        for (int a = 0; a < 2; ++a)
#pragma unroll
            for (int b = 0; b < 2; ++b)
#pragma unroll
                for (int m = 0; m < 4; ++m)
#pragma unroll
                    for (int n = 0; n < 2; ++n) acc[a][b][m][n] = (f32x4){0.f, 0.f, 0.f, 0.f};
    }
    __device__ __forceinline__ void operator()(const AccT& acc, const Unit& u, int wr, int wc, int fr, int fq) const {
        const int pn = u.pn + pn_off; bf16* base; int ld, colt, act;
        if (pn == 0) { base = KBp; ld = 256; colt = 0; act = 0; }
        else if (pn < 3) { base = VBp; ld = 512; colt = (pn - 1) * 256; act = 0; }
        else if (pn == 3) { base = QBp; ld = 256; colt = 0; act = 3; }
        else if (pn < 6) { base = SGp; ld = 512; colt = (pn - 4) * 256; act = 1; }
        else if (pn < 8) { base = PIp; ld = 512; colt = (pn - 6) * 256; act = 0; }
        else { base = SMp; ld = 2048; colt = (pn - 8) * 256; act = 2; }
        const int row0 = u.pm * 256 + wr * 64 + fr, col0 = colt + wc * 32 + 8 * fq;
#pragma unroll
        for (int ai = 0; ai < 2; ++ai)
#pragma unroll
            for (int m = 0; m < 4; ++m) { bf16* rowp = base + (size_t)(row0 + ai * 128 + m * 16) * ld + col0;
#pragma unroll
                for (int bj = 0; bj < 2; ++bj) { f32x4 v0 = acc[ai][bj][m][0], v1 = acc[ai][bj][m][1];
                    if (act == 1) {
#pragma unroll
                        for (int j = 0; j < 4; ++j) { v0[j] = silu_f(v0[j]); v1[j] = silu_f(v1[j]); } }
                    else if (act == 2) {
#pragma unroll
                        for (int j = 0; j < 4; ++j) { v0[j] = sigmoid_f(sc * v0[j]); v1[j] = sigmoid_f(sc * v1[j]); } }
                    else if (act == 3) { v0 = v0 * 0.125f; v1 = v1 * 0.125f; }
                    u32x4 w; w.x = cvt_pk_bf16(v0[0], v0[1]); w.y = cvt_pk_bf16(v0[2], v0[3]); w.z = cvt_pk_bf16(v1[0], v1[1]); w.w = cvt_pk_bf16(v1[2], v1[3]);
                    *(u32x4*)(rowp + bj * 128) = w; } }
    }
};
struct EpiMerge {
    static constexpr bool PERM = true;
    const bf16* SMp; bf16* MGp;
    __device__ __forceinline__ void post(AccT& acc, const Unit&, int, int, int, int) const {
#pragma unroll
        for (int a = 0; a < 2; ++a)
#pragma unroll
            for (int b = 0; b < 2; ++b)
#pragma unroll
                for (int m = 0; m < 4; ++m)
#pragma unroll
                    for (int n = 0; n < 2; ++n) acc[a][b][m][n] = (f32x4){0.f, 0.f, 0.f, 0.f};
    }
    __device__ __forceinline__ void operator()(const AccT& acc, const Unit& u, int wr, int wc, int fr, int fq) const {
        const int row0 = u.pm * 256 + wr * 64 + fr, col0 = u.pn * 256 + wc * 32 + 8 * fq; const int second = u.aux;
#pragma unroll
        for (int ai = 0; ai < 2; ++ai)
#pragma unroll
            for (int m = 0; m < 4; ++m) { const size_t ro = (size_t)(row0 + ai * 128 + m * 16);
#pragma unroll
                for (int bj = 0; bj < 2; ++bj) { const u32x4 g = *(const u32x4*)(SMp + ro * 2048 + second * 1024 + col0 + bj * 128);
                    u32x4 pv = {0u, 0u, 0u, 0u}; if (second) pv = *(const u32x4*)(MGp + ro * 1024 + col0 + bj * 128);
                    const f32x4 v0 = acc[ai][bj][m][0], v1 = acc[ai][bj][m][1];
                    u32x4 w; w.x = cvt_pk_bf16(bflo(pv[0]) + v0[0] * bflo(g[0]), bfhi(pv[0]) + v0[1] * bfhi(g[0])); w.y = cvt_pk_bf16(bflo(pv[1]) + v0[2] * bflo(g[1]), bfhi(pv[1]) + v0[3] * bfhi(g[1]));
                    w.z = cvt_pk_bf16(bflo(pv[2]) + v1[0] * bflo(g[2]), bfhi(pv[2]) + v1[1] * bfhi(g[2])); w.w = cvt_pk_bf16(bflo(pv[3]) + v1[2] * bflo(g[3]), bfhi(pv[3]) + v1[3] * bfhi(g[3]));
                    *(u32x4*)(MGp + ro * 1024 + col0 + bj * 128) = w; }
                asm volatile("" ::: "memory"); }
    }
};
struct EpiOut {
    static constexpr bool PERM = false;
    const float* X; const float* MODp; float* X1;
    __device__ __forceinline__ void post(AccT& acc, const Unit&, int, int, int, int) const {
#pragma unroll
        for (int a = 0; a < 2; ++a)
#pragma unroll
            for (int b = 0; b < 2; ++b)
#pragma unroll
                for (int m = 0; m < 4; ++m)
#pragma unroll
                    for (int n = 0; n < 2; ++n) acc[a][b][m][n] = (f32x4){0.f, 0.f, 0.f, 0.f};
    }
    __device__ __forceinline__ void operator()(const AccT& acc, const Unit& u, int wr, int wc, int fr, int fq) const {
        const int row0 = u.pm * 256 + wr * 64 + fr, col0 = u.pn * 256 + wc * 32 + 4 * fq;
        const float* gt = MODp + (size_t)(u.pm >> 5) * 6144 + 2048;
        f32x4 gv[2][2];
#pragma unroll
        for (int bj = 0; bj < 2; ++bj)
#pragma unroll
            for (int n = 0; n < 2; ++n) gv[bj][n] = *(const f32x4*)(gt + col0 + bj * 128 + n * 16);
#pragma unroll
        for (int ai = 0; ai < 2; ++ai)
#pragma unroll
            for (int m = 0; m < 4; ++m) { const size_t off = (size_t)(row0 + ai * 128 + m * 16) * 1024 + col0;
#pragma unroll
                for (int bj = 0; bj < 2; ++bj)
#pragma unroll
                    for (int n = 0; n < 2; ++n) { const f32x4 xv = __builtin_nontemporal_load((const f32x4*)(X + off + bj * 128 + n * 16)); *(f32x4*)(X1 + off + bj * 128 + n * 16) = xv + gv[bj][n] * acc[ai][bj][m][n]; }
                asm volatile("" ::: "memory"); }
    }
};
struct EpiMoe1 {
    static constexpr bool PERM = true;
    unsigned char* ACTp;
    __device__ __forceinline__ void post(AccT& acc, const Unit&, int, int, int, int) const {
#pragma unroll
        for (int a = 0; a < 2; ++a)
#pragma unroll
            for (int b = 0; b < 2; ++b)
#pragma unroll
                for (int m = 0; m < 4; ++m)
#pragma unroll
                    for (int n = 0; n < 2; ++n) acc[a][b][m][n] = (f32x4){0.f, 0.f, 0.f, 0.f};
    }
    __device__ __forceinline__ void operator()(const AccT& acc, const Unit& u, int wr, int wc, int fr, int fq) const {
        const int row0 = u.aux * 1024 + u.pm * 256 + wr * 64 + fr, col0 = u.pn * 128 + wc * 32 + 8 * fq;
#pragma unroll
        for (int ai = 0; ai < 2; ++ai)
#pragma unroll
            for (int m = 0; m < 4; ++m) { unsigned char* rowp = ACTp + (size_t)(row0 + ai * 128 + m * 16) * 1024 + col0;
                f32x4 a0, a1;
#pragma unroll
                for (int j = 0; j < 4; ++j) { a0[j] = silu_f(0.0625f * acc[ai][0][m][0][j]) * (0.0625f * acc[ai][1][m][0][j]); a1[j] = silu_f(0.0625f * acc[ai][0][m][1][j]) * (0.0625f * acc[ai][1][m][1][j]); }
                *(u32x2*)rowp = (u32x2){pk4_fp8(a0[0], a0[1], a0[2], a0[3]), pk4_fp8(a1[0], a1[1], a1[2], a1[3])}; }
    }
};
struct EpiMoe2 {
    static constexpr bool PERM = true;
    bf16* YBp; const float* WSELp; const float* MODp;
    __device__ __forceinline__ void post(AccT& acc, const Unit&, int, int, int, int) const {
#pragma unroll
        for (int a = 0; a < 2; ++a)
#pragma unroll
            for (int b = 0; b < 2; ++b)
#pragma unroll
                for (int m = 0; m < 4; ++m)
#pragma unroll
                    for (int n = 0; n < 2; ++n) acc[a][b][m][n] = (f32x4){0.f, 0.f, 0.f, 0.f};
    }
    __device__ __forceinline__ void operator()(const AccT& acc, const Unit& u, int wr, int wc, int fr, int fq) const {
        const int row0 = u.aux * 1024 + u.pm * 256 + wr * 64 + fr, col0 = u.pn * 256 + wc * 32 + 8 * fq;
        const float* gt = MODp + (size_t)(u.aux >> 4) * 6144 + 5120 + col0;
        f32x4 gv[2][2];
#pragma unroll
        for (int bj = 0; bj < 2; ++bj)
#pragma unroll
            for (int n = 0; n < 2; ++n) gv[bj][n] = *(const f32x4*)(gt + bj * 128 + n * 4);
#pragma unroll
        for (int ai = 0; ai < 2; ++ai)
#pragma unroll
            for (int m = 0; m < 4; ++m) { const int r = row0 + ai * 128 + m * 16; const float ws = 0.0625f * WSELp[r]; bf16* rowp = YBp + (size_t)r * 1024 + col0;
#pragma unroll
                for (int bj = 0; bj < 2; ++bj) { const f32x4 v0 = acc[ai][bj][m][0] * gv[bj][0] * ws, v1 = acc[ai][bj][m][1] * gv[bj][1] * ws;
                    u32x4 w; w.x = cvt_pk_bf16(v0[0], v0[1]); w.y = cvt_pk_bf16(v0[2], v0[3]); w.z = cvt_pk_bf16(v1[0], v1[1]); w.w = cvt_pk_bf16(v1[2], v1[3]);
                    *(u32x4*)(rowp + bj * 128) = w; } }
    }
};

struct Args { const float* in[22]; float* out; unsigned char* ws; int ph_lo, ph_hi; };
enum { I_X = 0, I_C, I_CTX, I_CCTX, I_ADAW, I_ADAB, I_N1G, I_N2G, I_WIN, I_WDU, I_BDEC, I_GNG, I_WGLA, I_POOLW, I_POOLS, I_WPOOL, I_WOUT, I_WROUTER, I_WGATE, I_WUP, I_WDOWN, I_FNG };

__device__ __forceinline__ bf16x8 ldfrag(const LAS bf16* base, int stride, int row0, int k0, int lane) { return *(const LAS bf16x8*)(base + (row0 + (lane & 15)) * stride + k0 + 8 * (lane >> 4)); }
#define MFMA16(a, b, c) __builtin_amdgcn_mfma_f32_16x16x32_bf16(a, b, c, 0, 0, 0)

__device__ __forceinline__ void transpose_item(const float* W, int ldw, int k0, int nsrc0, bf16* WT, int Kd, int dst_row0, LAS float* scr, int lane) {
#pragma unroll 8
    for (int i = 0; i < 32; ++i) { const int kk = 2 * i + (lane >> 5); scr[kk * 33 + (lane & 31)] = W[(size_t)(k0 + kk) * ldw + nsrc0 + (lane & 31)]; }
    LDS_WAIT(); asm volatile("" ::: "memory");
    const int c = lane & 7;
#pragma unroll
    for (int j = 0; j < 4; ++j) { const int n = (lane >> 3) + 8 * j; const LAS float* s = scr + (8 * c) * 33 + n;
        u32x4 o; o.x = pk2(s[0 * 33], s[1 * 33]); o.y = pk2(s[2 * 33], s[3 * 33]); o.z = pk2(s[4 * 33], s[5 * 33]); o.w = pk2(s[6 * 33], s[7 * 33]);
        *(u32x4*)(WT + (size_t)(dst_row0 + n) * Kd + k0 + 8 * c) = o; }
    LDS_WAIT(); asm volatile("" ::: "memory");
}

struct CvtItem { const float* src; bf16* dst; int ld2, drow8, f8; };
#define CVT_LOAD(v, c) do { _Pragma("unroll") for (int _j = 0; _j < 32; ++_j) v[_j] = __builtin_nontemporal_load((c).src + (size_t)_j * (c).ld2); } while (0)
#define CVT_STORE(v, c) do { _Pragma("unroll") for (int _j = 0; _j < 32; ++_j) scr[(2 * _j + (lane >> 5)) * 33 + (lane & 31)] = v[_j]; \
        LDS_WAIT(); asm volatile("" ::: "memory"); \
        _Pragma("unroll") for (int _q = 0; _q < 4; ++_q) { const LAS float* _s = scr + (8 * (lane & 7)) * 33 + (lane >> 3) + 8 * _q; u32x4 _o; \
            _o.x = pk2(_s[0 * 33], _s[1 * 33]); _o.y = pk2(_s[2 * 33], _s[3 * 33]); _o.z = pk2(_s[4 * 33], _s[5 * 33]); _o.w = pk2(_s[6 * 33], _s[7 * 33]); *(u32x4*)((c).dst + (size_t)_q * (c).drow8) = _o; } \
        LDS_WAIT(); asm volatile("" ::: "memory"); } while (0)
__device__ __forceinline__ CvtItem cvt_item_gu(const Args& a, int it, int lane) {
    const int e = it >> 10, mat = (it >> 9) & 1, q = it & 511, kb = q >> 5, nb = q & 31, n0 = nb * 32, k0 = kb * 64, nrow = n0 + (lane >> 3);
    CvtItem c; c.ld2 = 2048; c.drow8 = 8192; c.f8 = 1;
    c.src = a.in[mat ? I_WUP : I_WGATE] + (size_t)e * 1048576 + (size_t)(k0 + (lane >> 5)) * 1024 + n0 + (lane & 31);
    c.dst = (bf16*)(a.ws + WS_WGU + ((size_t)e * 2048 + (nrow >> 7) * 256 + mat * 128 + (nrow & 127)) * 1024 + k0 + 8 * (lane & 7));
    return c;
}
__device__ __forceinline__ CvtItem cvt_item_dn(const Args& a, int it, int lane) {
    const int e = it >> 9, q = it & 511, kb = q >> 5, nb = q & 31, n0 = nb * 32, k0 = kb * 64;
    CvtItem c; c.ld2 = 2048; c.drow8 = 8192; c.f8 = 1;
    c.src = a.in[I_WDOWN] + (size_t)e * 1048576 + (size_t)(k0 + (lane >> 5)) * 1024 + n0 + (lane & 31);
    c.dst = (bf16*)(a.ws + WS_WD + ((size_t)e * 1024 + n0 + (lane >> 3)) * 1024 + k0 + 8 * (lane & 7));
    return c;
}
#define CVT_STORE8(v, c) do { _Pragma("unroll") for (int _j = 0; _j < 32; ++_j) scr[(2 * _j + (lane >> 5)) * 33 + (lane & 31)] = v[_j]; \
        LDS_WAIT(); asm volatile("" ::: "memory"); \
        _Pragma("unroll") for (int _q = 0; _q < 4; ++_q) { const LAS float* _s = scr + (8 * (lane & 7)) * 33 + (lane >> 3) + 8 * _q; \
            *(u32x2*)((unsigned char*)(c).dst + (size_t)_q * (c).drow8) = (u32x2){pk4_fp8(16.f * _s[0 * 33], 16.f * _s[1 * 33], 16.f * _s[2 * 33], 16.f * _s[3 * 33]), pk4_fp8(16.f * _s[4 * 33], 16.f * _s[5 * 33], 16.f * _s[6 * 33], 16.f * _s[7 * 33])}; } \
        LDS_WAIT(); asm volatile("" ::: "memory"); } while (0)
__device__ __forceinline__ CvtItem cvt_item_small(const Args& a, int it, int lane) {
    CvtItem c; int r = it;
    c.f8 = 0;
    if (r < 2048) { const int kb = r >> 7, nb = r & 127, n0 = nb * 32, k0 = kb * 64; c.ld2 = 2 * DIN; c.drow8 = 8192;
        c.src = a.in[I_WIN] + (size_t)(k0 + (lane >> 5)) * DIN + n0 + (n0 >= 768 ? 32 : 0) + (lane & 31);
        if (n0 < 2048) c.dst = (bf16*)(a.ws + WS_WIN) + (size_t)(n0 + (lane >> 3)) * 1024 + k0 + 8 * (lane & 7);
        else { c.f8 = 1; c.dst = (bf16*)(a.ws + WS_WINM + (size_t)(n0 - 2048 + (lane >> 3)) * 1024 + k0 + 8 * (lane & 7)); }
        return c; }
    r -= 2048;
    if (r < 512) { const int kb = r >> 5, nb = r & 31, n0 = nb * 32, k0 = kb * 64; c.ld2 = 2048; c.drow8 = 8192;
        c.src = a.in[I_WOUT] + (size_t)(k0 + (lane >> 5)) * 1024 + n0 + (lane & 31); c.dst = (bf16*)(a.ws + WS_WO) + (size_t)(n0 + (lane >> 3)) * 1024 + k0 + 8 * (lane & 7); return c; }
    r -= 512;
    { const int kb = r >> 5, nb = r & 31, n0 = nb * 32, k0 = kb * 64; c.ld2 = 2048; c.drow8 = 4096;
      c.src = a.in[I_WGLA] + (size_t)(k0 + (lane >> 5)) * 1024 + n0 + (lane & 31); c.dst = (bf16*)(a.ws + WS_WG) + (size_t)(n0 + (lane >> 3)) * 512 + k0 + 8 * (lane & 7); return c; }
}
template <int KIND> __device__ __forceinline__ CvtItem cvt_item(const Args& a, int it, int lane) { if constexpr (KIND == 0) return cvt_item_small(a, it, lane); else if constexpr (KIND == 1) return cvt_item_gu(a, it, lane); else return cvt_item_dn(a, it, lane); }
template <int KIND>
__device__ __forceinline__ void convert_items(LAS float* scr, const Args& a, int first, int step, int end, int lane) {
    float va[32], vb[32]; CvtItem ca, cb;
    int it = first;
    if (it < end) { ca = cvt_item<KIND>(a, it, lane); CVT_LOAD(va, ca); }
    for (; it < end; it += 2 * step) {
        const bool hb = (it + step < end), ha = (it + 2 * step < end);
        if (hb) { cb = cvt_item<KIND>(a, it + step, lane); CVT_LOAD(vb, cb); }
        if (KIND == 0 && !ca.f8) CVT_STORE(va, ca); else CVT_STORE8(va, ca);
        if (ha) { ca = cvt_item<KIND>(a, it + 2 * step, lane); CVT_LOAD(va, ca); }
        if (hb) { if (KIND == 0 && !cb.f8) CVT_STORE(vb, cb); else CVT_STORE8(vb, cb); }
    }
}
template <int KIND>
__device__ __forceinline__ void convert_all(LAS unsigned char* lds, const Args& a, int vcu, int G, int lane, int wave) {
    const int gw = vcu * NWAVES + wave, NGW = G * NWAVES;
    convert_items<KIND>((LAS float*)(lds + wave * 8448), a, gw, NGW, KIND == 1 ? 16384 : 8192, lane);
    __syncthreads();
}

__device__ __forceinline__ void phase0(LAS unsigned char* lds, const Args& a, int vcu, int G, int tid, int lane, int wave) {
    unsigned char* ws = a.ws;
    if (vcu < 96) {
        LAS float* sv = (LAS float*)(lds + 69632); LAS float* part = sv + 3072;
        for (int idx = tid; idx < 3072; idx += NT) { const int v = idx >> 10, k = idx & 1023; const float s = (v < 2) ? a.in[I_C][v * 1024 + k] : a.in[I_CCTX][k]; sv[idx] = s / (1.f + expf(-s)); }
        __syncthreads();
        const int n0 = 64 * vcu, colq = lane & 15, kr = lane >> 4;
        f32x4 a0 = {0.f, 0.f, 0.f, 0.f}, a1 = a0, a2 = a0;
        const float* aw = a.in[I_ADAW] + (size_t)(128 * wave + kr) * 6144 + n0 + 4 * colq;
#pragma unroll
        for (int hb = 0; hb < 2; ++hb) { f32x4 w4[16];
#pragma unroll
            for (int it = 0; it < 16; ++it) w4[it] = __builtin_nontemporal_load((const f32x4*)(aw + (size_t)(4 * (16 * hb + it)) * 6144));
#pragma unroll
            for (int it = 0; it < 16; ++it) { const int k = 128 * wave + 4 * (16 * hb + it) + kr; a0 += w4[it] * sv[k]; a1 += w4[it] * sv[1024 + k]; a2 += w4[it] * sv[2048 + k]; } }
#pragma unroll
        for (int j = 0; j < 4; ++j) { a0[j] += __shfl_xor(a0[j], 16); a0[j] += __shfl_xor(a0[j], 32); a1[j] += __shfl_xor(a1[j], 16); a1[j] += __shfl_xor(a1[j], 32); a2[j] += __shfl_xor(a2[j], 16); a2[j] += __shfl_xor(a2[j], 32); }
        if (kr == 0) {
#pragma unroll
            for (int j = 0; j < 4; ++j) { part[(wave * 3 + 0) * 64 + 4 * colq + j] = a0[j]; part[(wave * 3 + 1) * 64 + 4 * colq + j] = a1[j]; part[(wave * 3 + 2) * 64 + 4 * colq + j] = a2[j]; } }
        __syncthreads();
        if (tid < 192) { const int v = tid >> 6, col = tid & 63; float s = a.in[I_ADAB][n0 + col];
#pragma unroll
            for (int w = 0; w < 8; ++w) s += part[(w * 3 + v) * 64 + col];
            ((float*)(ws + WS_MOD))[v * 6144 + n0 + col] = s; }
    } else if (vcu < 96 + 128) {
        const int it = vcu - 96, g = it >> 5, cb = (it >> 1) & 15, nb = it & 1, n = nb * 512 + tid;
        LAS float* pwt = (LAS float*)(lds + 69632);
        if (tid < 256) { const int d = tid >> 1, hf = tid & 1; const float sc = a.in[I_POOLS][g * 128 + d]; f32x4 v;
#pragma unroll
            for (int q = 0; q < 4; ++q) v[q] = a.in[I_POOLW][(size_t)(g * 128 + cb * 8 + hf * 4 + q) * 128 + d] * sc;
            *(LAS f32x4*)(pwt + d * 8 + hf * 4) = v; }
        __syncthreads();
        const float* wp = a.in[I_WPOOL] + (size_t)(g * 128) * 1024 + n;
        f32x4 acc0 = {0.f, 0.f, 0.f, 0.f}, acc1 = acc0;
        for (int d0 = 0; d0 < 128; d0 += 32) { float w[32];
#pragma unroll
            for (int d = 0; d < 32; ++d) w[d] = wp[(size_t)(d0 + d) * 1024];
#pragma unroll
            for (int d = 0; d < 32; ++d) { const f32x4 p0 = *(const LAS f32x4*)(pwt + (d0 + d) * 8), p1 = *(const LAS f32x4*)(pwt + (d0 + d) * 8 + 4); acc0 += p0 * w[d]; acc1 += p1 * w[d]; } }
        bf16* dst = (bf16*)(ws + WS_WC) + (size_t)n * 512 + g * 128 + cb * 8;
        *(u32x4*)dst = (u32x4){pk2(acc0[0], acc0[1]), pk2(acc0[2], acc0[3]), pk2(acc1[0], acc1[1]), pk2(acc1[2], acc1[3])};
    }
    { const int gw = vcu * NWAVES + wave, NGW = G * NWAVES; convert_items<0>((LAS float*)(lds + wave * 8448), a, gw, NGW, 2048 + 512 + 256, lane); }
}

#define RSTEP(N, S) do { _Pragma("unroll") for (int _i = 0; _i < (N) / 2; ++_i) { const float _send = (lane & (S)) ? racc[_i] : racc[_i + (N) / 2]; const float _keep = (lane & (S)) ? racc[_i + (N) / 2] : racc[_i]; racc[_i] = _keep + __shfl_xor(_send, (S)); } } while (0)
__device__ __forceinline__ void phase1(LAS unsigned char* lds, const Args& a, int vcu, int G, int tid, int lane, int wave) {
    unsigned char* ws = a.ws;
    const float* MOD = (const float*)(ws + WS_MOD);
    const float* g1 = a.in[I_N1G];
    for (int u = vcu; u < 96; u += G) {
        const int mt = u / 12, ntile = u % 12, r0 = mt * 64;
        LAS bf16* As = (LAS bf16*)lds; LAS bf16* Bs = As + 64 * 72; LAS float* rs = (LAS float*)(lds + 18432);
        const float* ctx = a.in[I_CTX];
        { f32x4 rv[8][4];
#pragma unroll
          for (int rr = 0; rr < 8; ++rr)
#pragma unroll
              for (int j = 0; j < 4; ++j) rv[rr][j] = *(const f32x4*)(ctx + (size_t)(r0 + 8 * wave + rr) * 1024 + 256 * j + 4 * lane);
#pragma unroll
          for (int rr = 0; rr < 8; ++rr) { float ss = 0.f;
#pragma unroll
              for (int j = 0; j < 4; ++j) ss += rv[rr][j][0] * rv[rr][j][0] + rv[rr][j][1] * rv[rr][j][1] + rv[rr][j][2] * rv[rr][j][2] + rv[rr][j][3] * rv[rr][j][3];
              ss = wave_sum(ss); if (lane == 0) rs[8 * wave + rr] = rsqrtf(ss * (1.f / 1024.f) + EPS); } }
        __syncthreads();
        f32x4 acc[2] = {{0.f, 0.f, 0.f, 0.f}, {0.f, 0.f, 0.f, 0.f}};
        const int m16 = wave & 3, nh = wave >> 2, srow = tid >> 3, kq = (tid & 7) * 8;
        const float rstd = rs[srow];
        const float* xp = ctx + (size_t)(r0 + srow) * 1024 + kq; const bf16* wpB = (const bf16*)(ws + WS_WIN) + (size_t)(ntile * 64 + srow) * 1024 + kq;
        f32x4 xv[2], gq[2], scq[2], shq[2]; u32x4 wB;
#define CTX_LOAD(kc) do { const int _k0 = (kc) * 64; _Pragma("unroll") for (int q = 0; q < 2; ++q) { xv[q] = *(const f32x4*)(xp + _k0 + 4 * q); gq[q] = *(const f32x4*)(g1 + _k0 + kq + 4 * q); \
            scq[q] = *(const f32x4*)(MOD + 2 * 6144 + 1024 + _k0 + kq + 4 * q); shq[q] = *(const f32x4*)(MOD + 2 * 6144 + _k0 + kq + 4 * q); } wB = *(const u32x4*)(wpB + _k0); } while (0)
        CTX_LOAD(0);
        for (int kc = 0; kc < 16; ++kc) {
            { unsigned o[4];
#pragma unroll
              for (int q = 0; q < 2; ++q) { const f32x4 h = xv[q] * rstd * gq[q] * (scq[q] + 1.f) + shq[q]; o[2 * q] = pk2(h[0], h[1]); o[2 * q + 1] = pk2(h[2], h[3]); }
              *(LAS u32x4*)(As + srow * 72 + kq) = (u32x4){o[0], o[1], o[2], o[3]};
              *(LAS u32x4*)(Bs + srow * 72 + kq) = wB; }
            __syncthreads();
            if (kc + 1 < 16) CTX_LOAD(kc + 1);
#pragma unroll
            for (int ks = 0; ks < 2; ++ks) { const bf16x8 af = ldfrag(As, 72, m16 * 16, ks * 32, lane);
#pragma unroll
                for (int tt = 0; tt < 2; ++tt) { const bf16x8 bfr = ldfrag(Bs, 72, nh * 32 + tt * 16, ks * 32, lane); acc[tt] = MFMA16(af, bfr, acc[tt]); } }
            __syncthreads();
        }
#undef CTX_LOAD
#pragma unroll
        for (int tt = 0; tt < 2; ++tt)
#pragma unroll
            for (int r = 0; r < 4; ++r) { const int row = M + r0 + m16 * 16 + 4 * (lane >> 4) + r, n = ntile * 64 + nh * 32 + tt * 16 + (lane & 15); const bf16 v = (bf16)f2bf(acc[tt][r]);
                if (n < 256) ((bf16*)(ws + WS_KB))[(size_t)row * 256 + n] = v; else ((bf16*)(ws + WS_VB))[(size_t)row * 512 + n - 256] = v; }
        __syncthreads();
    }
    LAS float* WR = (LAS float*)lds;
#pragma unroll 4
    for (int it = 0; it < 16; ++it) { const int k = (tid >> 3) + 64 * it, c4 = tid & 7; const f32x4 v = *(const f32x4*)(a.in[I_WIN] + (size_t)k * DIN + 768 + 4 * c4);
        const int row = ((k >> 8) * 4 + (k & 3)) * 64 + ((k & 255) >> 2); *(LAS f32x4*)(WR + row * 36 + 4 * c4) = v; }
    __syncthreads();
    f32x4 gv[4];
#pragma unroll
    for (int j = 0; j < 4; ++j) gv[j] = *(const f32x4*)(g1 + 256 * j + 4 * lane);
    constexpr int NPAIR = MT / 2;
    const int nctx = (G > 96) ? 96 : 0, PA = 3;
    int p_lo, p_n, p_stride;
    if (vcu < nctx) { p_lo = (vcu * NWAVES + wave) * PA; p_n = PA; p_stride = 1; }
    else { p_lo = nctx * NWAVES * PA + (vcu - nctx) * NWAVES + wave; p_n = 1 << 30; p_stride = (G - nctx) * NWAVES; }
    f32x4 nx[2][4];
    if (p_n > 0 && p_lo < NPAIR) {
#pragma unroll
        for (int r = 0; r < 2; ++r) { const int m = 2 * p_lo + r; const float* src = (m < M) ? a.in[I_X] + (size_t)m * 1024 : a.in[I_CTX] + (size_t)(m - M) * 1024;
#pragma unroll
            for (int j = 0; j < 4; ++j) nx[r][j] = *(const f32x4*)(src + 256 * j + 4 * lane); } }
    for (int pi = 0, pr = p_lo; pi < p_n && pr < NPAIR; ++pi, pr += p_stride) {
        const int m0 = 2 * pr;
        f32x4 v[2][4]; float rstd[2];
#pragma unroll
        for (int r = 0; r < 2; ++r) { float ss = 0.f;
#pragma unroll
            for (int j = 0; j < 4; ++j) { v[r][j] = nx[r][j]; ss += v[r][j][0] * v[r][j][0] + v[r][j][1] * v[r][j][1] + v[r][j][2] * v[r][j][2] + v[r][j][3] * v[r][j][3]; }
            rstd[r] = ss; }
        if (pi + 1 < p_n && pr + p_stride < NPAIR) {
#pragma unroll
            for (int r = 0; r < 2; ++r) { const int m = 2 * (pr + p_stride) + r; const float* src = (m < M) ? a.in[I_X] + (size_t)m * 1024 : a.in[I_CTX] + (size_t)(m - M) * 1024;
#pragma unroll
                for (int j = 0; j < 4; ++j) nx[r][j] = *(const f32x4*)(src + 256 * j + 4 * lane); } }
#pragma unroll
        for (int r = 0; r < 2; ++r) { const int m = m0 + r; rstd[r] = rsqrtf(wave_sum(rstd[r]) * (1.f / 1024.f) + EPS); const float* mod = MOD + (size_t)((m < M) ? (m >> 13) : 2) * 6144;
#pragma unroll
            for (int j = 0; j < 4; ++j) { const f32x4 sc = *(const f32x4*)(mod + 1024 + 256 * j + 4 * lane), sh = *(const f32x4*)(mod + 256 * j + 4 * lane); v[r][j] = v[r][j] * rstd[r] * gv[j] * (sc + 1.f) + sh; }
            if (m < M) { bf16* hp = (bf16*)(ws + WS_H1) + (size_t)m * 1024;
#pragma unroll
                for (int j = 0; j < 4; ++j) { *(u32x2*)(hp + 256 * j + 4 * lane) = (u32x2){pk2(v[r][j][0], v[r][j][1]), pk2(v[r][j][2], v[r][j][3])};
                    *(unsigned*)(ws + WS_H1F + (size_t)m * 1024 + 256 * j + 4 * lane) = pk4_fp8(v[r][j][0], v[r][j][1], v[r][j][2], v[r][j][3]); } } }
        f32x2 r2[32];
#pragma unroll
        for (int i = 0; i < 32; ++i) r2[i] = (f32x2){0.f, 0.f};
#pragma unroll
        for (int j = 0; j < 4; ++j)
#pragma unroll
            for (int i = 0; i < 4; ++i) { const f32x2 hab = {v[0][j][i], v[1][j][i]}; const LAS float* rp = WR + ((j * 4 + i) * 64 + lane) * 36;
#pragma unroll
                for (int c4 = 0; c4 < 8; ++c4) { const f32x4 w = *(const LAS f32x4*)(rp + 4 * c4);
                    r2[4 * c4 + 0] += hab * w[0]; r2[4 * c4 + 1] += hab * w[1]; r2[4 * c4 + 2] += hab * w[2]; r2[4 * c4 + 3] += hab * w[3]; }
                if (i & 1) asm volatile("" ::: "memory"); }
        float ra[32], rb[32];
#pragma unroll
        for (int i = 0; i < 32; ++i) { ra[i] = r2[i][0]; rb[i] = r2[i][1]; }
        { float* racc = ra; RSTEP(32, 32); RSTEP(16, 16); RSTEP(8, 8); RSTEP(4, 4); RSTEP(2, 2); racc[0] += __shfl_xor(racc[0], 1); }
        { float* racc = rb; RSTEP(32, 32); RSTEP(16, 16); RSTEP(8, 8); RSTEP(4, 4); RSTEP(2, 2); racc[0] += __shfl_xor(racc[0], 1); }
        if ((lane & 1) == 0) { ((float*)(ws + WS_RB))[(size_t)m0 * 32 + (lane >> 1)] = ra[0]; ((float*)(ws + WS_RB))[(size_t)(m0 + 1) * 32 + (lane >> 1)] = rb[0]; }
    }
}

typedef short s16x4 __attribute__((ext_vector_type(4)));
__device__ __forceinline__ s16x4 lds_tr16(const LAS bf16* p) { return __builtin_bit_cast(s16x4, __builtin_amdgcn_ds_read_tr16_b64_v4i16((LAS s16x4*)p)); }
__device__ __forceinline__ bf16x8 ldfrag_tr(const LAS bf16* base, int stride, int k0, int n0, int lane) {
    const int g = lane >> 4, i = lane & 15; const LAS bf16* p = base + (k0 + 8 * g + (i >> 2)) * stride + n0 + 4 * (i & 3);
    const s16x4 lo = lds_tr16(p), hi = lds_tr16(p + 4 * stride);
    return (bf16x8){lo[0], lo[1], lo[2], lo[3], hi[0], hi[1], hi[2], hi[3]};
}
__device__ __forceinline__ float logsig_fast(float z) { return fminf(z, 0.f) - __logf(1.f + __expf(-fabsf(z))); }
struct ChkPre { f32x4 r, w; float bias_f, bias_b; float kf[8]; u32x4 v[2]; };
__device__ __forceinline__ void chunk_decode(int u, int& b, int& h, int& row0, int& slot, bool& isx) {
    if (u < 1024) { b = u >> 9; h = (u >> 7) & 3; const int n = u & 127; row0 = b * SEQ + n * 64; slot = n; isx = true; }
    else { const int v = u - 1024; b = v >> 4; h = (v >> 2) & 3; const int n = v & 3; row0 = M + b * LC + n * 64; slot = NCH + n; isx = false; }
}
__device__ __forceinline__ void chunk_load(ChkPre& P, const Args& a, int u, int tid) {
    unsigned char* ws = a.ws; int b, h, row0, slot; bool isx; chunk_decode(u, b, h, row0, slot, isx);
    P.r = *(const f32x4*)((const float*)(ws + WS_RB) + (size_t)(row0 + (tid >> 3)) * 32 + (tid & 7) * 4);
    P.w = *(const f32x4*)(a.in[I_WDU] + (size_t)(tid >> 4) * 256 + h * 64 + (tid & 15) * 4);
    const int dk = tid & 63, tq = tid >> 6;
    P.bias_f = a.in[I_BDEC][h * 64 + dk]; P.bias_b = a.in[I_BDEC][256 + h * 64 + dk];
    const bf16* KBp = (const bf16*)(ws + WS_KB) + (size_t)(row0 + tq * 8) * 256 + h * 64 + dk;
#pragma unroll
    for (int tt = 0; tt < 8; ++tt) P.kf[tt] = bf2f(KBp[(size_t)tt * 256]);
#pragma unroll
    for (int i = 0; i < 2; ++i) { const int p = tid + NT * i, jj = p >> 4, ch = p & 15; P.v[i] = *(const u32x4*)((const bf16*)(ws + WS_VB) + (size_t)(row0 + jj) * 512 + h * 128 + 8 * ch); }
}
__device__ __forceinline__ void chunk_units(LAS unsigned char* lds, const Args& a, int vcu, int G, int tid, int lane, int wave) {
    unsigned char* ws = a.ws;
    LAS float* r_s = (LAS float*)lds;
    LAS float* wup = (LAS float*)(lds + 8192);
    LAS float* seg = (LAS float*)(lds + 16384);
    LAS bf16* Ks = (LAS bf16*)(lds + 20480);
    LAS bf16* Vs = (LAS bf16*)(lds + 38912);
    const int dk = tid & 63, tq = tid >> 6;
    ChkPre P;
    unsigned* qctr = (unsigned*)(ws + WS_CTL) + 512; LAS int* qnext = (LAS int*)(lds + 57344);
    int u = vcu;
    if (u < 1024 + 32) chunk_load(P, a, u, tid);
    for (; u < 1024 + 32; ) {
        int b, h, row0, slot; bool isx; chunk_decode(u, b, h, row0, slot, isx);
        const int bh = b * 4 + h;
        if (tid == 0) qnext[0] = G + (int)__hip_atomic_fetch_add(qctr, 1u, __ATOMIC_RELAXED, __HIP_MEMORY_SCOPE_AGENT);
        *(LAS f32x4*)(r_s + tid * 4) = P.r; *(LAS f32x4*)(wup + (tid >> 4) * 64 + (tid & 15) * 4) = P.w;
#pragma unroll
        for (int i = 0; i < 2; ++i) { const int p = tid + NT * i, jj = p >> 4, ch = p & 15; *(LAS u32x4*)(Vs + jj * 136 + 8 * ch) = P.v[i]; }
        float kf[8];
#pragma unroll
        for (int tt = 0; tt < 8; ++tt) kf[tt] = P.kf[tt];
        const float bias_f = P.bias_f, bias_b = P.bias_b;
        __syncthreads();
        const int un = qnext[0];
        if (un < 1024 + 32) chunk_load(P, a, un, tid);
        float pf[8], sb[8];
        { float wf[16], wb[16];
#pragma unroll
          for (int j = 0; j < 16; ++j) { wf[j] = wup[j * 64 + dk]; wb[j] = wup[(16 + j) * 64 + dk]; }
#pragma unroll
          for (int tt = 0; tt < 8; ++tt) { const LAS float* rp = r_s + (tq * 8 + tt) * 32; float zf = bias_f, zb = bias_b;
#pragma unroll
              for (int j4 = 0; j4 < 4; ++j4) { const f32x4 rf = *(const LAS f32x4*)(rp + 4 * j4), rb = *(const LAS f32x4*)(rp + 16 + 4 * j4);
#pragma unroll
                  for (int e = 0; e < 4; ++e) { zf += rf[e] * wf[4 * j4 + e]; zb += rb[e] * wb[4 * j4 + e]; } }
              pf[tt] = logsig_fast(zf) * (1.f / 16.f); sb[tt] = logsig_fast(zb) * (1.f / 16.f); }
#pragma unroll
          for (int tt = 1; tt < 8; ++tt) pf[tt] += pf[tt - 1];
#pragma unroll
          for (int tt = 6; tt >= 0; --tt) sb[tt] += sb[tt + 1];
          seg[tq * 64 + dk] = pf[7]; seg[(8 + tq) * 64 + dk] = sb[0]; }
        __syncthreads();
        { float offf = 0.f, totf = 0.f, offb = 0.f, totb = 0.f;
#pragma unroll
          for (int q = 0; q < 8; ++q) { const float sf = seg[q * 64 + dk], sbv = seg[(8 + q) * 64 + dk]; totf += sf; totb += sbv; if (q < tq) offf += sf; if (q > tq) offb += sbv; }
#pragma unroll
          for (int tt = 0; tt < 8; ++tt) { const int t = tq * 8 + tt; const float bb = pf[tt] + offf, cc = sb[tt] + offb;
              if (isx) { const size_t gi = (size_t)(row0 + t) * 256 + h * 64 + dk; a.out[gi] = bb; a.out[(size_t)M * 256 + gi] = cc; }
              Ks[t * 72 + dk] = (bf16)f2bf(kf[tt] * __expf(totf - bb)); Ks[(64 + t) * 72 + dk] = (bf16)f2bf(kf[tt] * __expf(totb - cc)); }
          if (tq == 0) { float* DEC = (float*)(ws + WS_DEC); DEC[((size_t)(0 * 8 + bh) * NSLOT + slot) * 64 + dk] = __expf(totf); DEC[((size_t)(1 * 8 + bh) * NSLOT + slot) * 64 + dk] = __expf(totb); } }
        __syncthreads();
        { const int dir = wave >> 2, dkt = wave & 3; const LAS bf16* Kd = Ks + dir * 64 * 72;
          const bf16x8 k0f = ldfrag_tr(Kd, 72, 0, dkt * 16, lane), k1f = ldfrag_tr(Kd, 72, 32, dkt * 16, lane);
          bf16* KV = (bf16*)(ws + WS_KV) + ((size_t)(dir * 8 + bh) * NSLOT + slot) * 8192;
#pragma unroll
          for (int dvt = 0; dvt < 8; ++dvt) { f32x4 c = {0.f, 0.f, 0.f, 0.f}; c = MFMA16(k0f, ldfrag_tr(Vs, 136, 0, dvt * 16, lane), c); c = MFMA16(k1f, ldfrag_tr(Vs, 136, 32, dvt * 16, lane), c);
              *(u32x2*)(KV + (size_t)(dvt * 16 + (lane & 15)) * 64 + dkt * 16 + 4 * (lane >> 4)) = (u32x2){pk2(c[0], c[1]), pk2(c[2], c[3])}; } }
        __syncthreads();
        u = un;
    }
}
constexpr int PB = 4, NPOOLW = NB * 4 * 8 * (128 / PB);
__device__ __forceinline__ void ld16bf(const bf16* p, float (&f)[16]) { const u32x4 w0 = *(const u32x4*)p, w1 = *(const u32x4*)(p + 8);
#pragma unroll
    for (int q = 0; q < 4; ++q) { f[2 * q] = bflo(w0[q]); f[2 * q + 1] = bfhi(w0[q]); f[8 + 2 * q] = bflo(w1[q]); f[8 + 2 * q + 1] = bfhi(w1[q]); } }
template <int CTRL, int ROWMASK> __device__ __forceinline__ float dpp_f(float v) { return __builtin_bit_cast(float, __builtin_amdgcn_update_dpp(0, __builtin_bit_cast(int, v), CTRL, ROWMASK, 0xf, true)); }
__device__ __forceinline__ float wave_prefix(float v) {
    v += dpp_f<0x111, 0xf>(v); v += dpp_f<0x112, 0xf>(v); v += dpp_f<0x114, 0xf>(v); v += dpp_f<0x118, 0xf>(v);
    v += dpp_f<0x142, 0xa>(v);
    v += dpp_f<0x143, 0xc>(v);
    return v;
}
template <int HALF>
__device__ __forceinline__ void pool_band(const bf16* PI, bf16* PO, int r0, int c) {
    float run[16];
#pragma unroll
    for (int e = 0; e < 16; ++e) run[e] = 0.f;
    { constexpr int NW = 2 * HALF, BT = NW < 8 ? NW : 8;
#pragma unroll
      for (int i0 = 0; i0 < NW; i0 += BT) { float f[BT][16];
#pragma unroll
          for (int i = 0; i < BT; ++i) { int rr = r0 - HALF + i0 + i; rr = rr < 0 ? 0 : (rr > 127 ? 127 : rr); ld16bf(PI + (size_t)rr * 64 * 512, f[i]); }
#pragma unroll
          for (int i = 0; i < BT; ++i) { const int rr = r0 - HALF + i0 + i; const bool ok = rr >= 0 && rr < 128;
#pragma unroll
              for (int e = 0; e < 16; ++e) run[e] += ok ? f[i][e] : 0.f; }
          asm volatile("" ::: "memory"); } }
    const int lo_c = (c - HALF) < 0 ? 0 : (c - HALF), hi_c = (c + HALF) > 64 ? 64 : (c + HALF);
    float cen[16], fi[16], fo[16];
    ld16bf(PI + (size_t)r0 * 64 * 512, cen);
#pragma unroll
    for (int k = 0; k < PB; ++k) {
        const int r = r0 + k;
        float ncen[16];
        if (k + 1 < PB) { const int rin = r + HALF, rout = r - HALF;
            ld16bf(PI + (size_t)(rin > 127 ? 127 : rin) * 64 * 512, fi); ld16bf(PI + (size_t)(rout < 0 ? 0 : rout) * 64 * 512, fo); ld16bf(PI + (size_t)(r + 1) * 64 * 512, ncen); }
        const int lo_r = (r - HALF) < 0 ? 0 : (r - HALF), hi_r = (r + HALF) > 128 ? 128 : (r + HALF);
        const float inv = 1.f / (float)((hi_r - lo_r) * (hi_c - lo_c));
        float o[16];
#pragma unroll
        for (int e = 0; e < 16; ++e) { const float p = wave_prefix(run[e]);
            const float hi = __shfl(p, hi_c - 1), lo = __shfl(p, lo_c > 0 ? lo_c - 1 : 0);
            o[e] = (hi - (lo_c > 0 ? lo : 0.f)) * inv - cen[e]; }
        bf16* po = PO + (size_t)r * 64 * 512;
        *(u32x4*)po = (u32x4){pk2(o[0], o[1]), pk2(o[2], o[3]), pk2(o[4], o[5]), pk2(o[6], o[7])}; *(u32x4*)(po + 8) = (u32x4){pk2(o[8], o[9]), pk2(o[10], o[11]), pk2(o[12], o[13]), pk2(o[14], o[15])};
        if (k + 1 < PB) { const int rin = r + HALF, rout = r - HALF;
#pragma unroll
            for (int e = 0; e < 16; ++e) { run[e] += (rin < 128 ? fi[e] : 0.f) - (rout >= 0 ? fo[e] : 0.f); cen[e] = ncen[e]; } }
    }
}
__device__ __forceinline__ void pool_units(const Args& a, int vcu, int G, int lane, int wave, int nw) {
    unsigned char* ws = a.ws;
    constexpr int NBAND = 128 / PB, PER_G = NB * 8 * NBAND;
    for (int wu = vcu * nw + wave; wu < NPOOLW; wu += G * nw) {
        const int g = 3 - wu / PER_G, rem = wu % PER_G, b = rem / (8 * NBAND), rem2 = rem % (8 * NBAND), chk = rem2 & 7, r0 = (rem2 >> 3) * PB;
        const size_t off = ((size_t)b * SEQ + lane) * 512 + g * 128 + chk * 16;
        const bf16* PI = (const bf16*)(ws + WS_PI) + off; bf16* PO = (bf16*)(ws + WS_PO) + off;
        if (g == 0) pool_band<1>(PI, PO, r0, lane); else if (g == 1) pool_band<2>(PI, PO, r0, lane); else if (g == 2) pool_band<4>(PI, PO, r0, lane); else pool_band<8>(PI, PO, r0, lane);
    }
}

__device__ __forceinline__ void phase4(const Args& a, int G, int tid, int nthr) {
    unsigned char* ws = a.ws;
    for (int e = blockIdx.x * nthr + tid; e < 2 * 8 * 8192; e += G * nthr) {
        const int dir = e >> 16, bh = (e >> 13) & 7, e8 = e & 8191, dk = e8 & 63;
        const bf16* kvp = (const bf16*)(ws + WS_KV) + (size_t)((dir * 8 + bh) * NSLOT) * 8192 + e8;
        const float* decp = (const float*)(ws + WS_DEC) + (size_t)((dir * 8 + bh) * NSLOT) * 64 + dk;
        bf16* stp = (bf16*)(ws + WS_ST) + (size_t)((dir * 8 + bh) * NCH) * 8192 + e8;
        float s = 0.f;
        float kv[12], dc[12], kvn[12], dcn[12];
#define SCAN_SLOT(j) (dir ? (NSLOT - 1 - (j)) : ((j) < 4 ? NCH + (j) : (j) - 4))
#pragma unroll
        for (int q = 0; q < 12; ++q) { const int slot = SCAN_SLOT(q); kvn[q] = bf2f(kvp[(size_t)slot * 8192]); dcn[q] = decp[slot * 64]; }
        for (int j0 = 0; j0 < NSLOT; j0 += 12) {
#pragma unroll
            for (int q = 0; q < 12; ++q) { kv[q] = kvn[q]; dc[q] = dcn[q]; }
            if (j0 + 12 < NSLOT) {
#pragma unroll
                for (int q = 0; q < 12; ++q) { const int slot = SCAN_SLOT(j0 + 12 + q); kvn[q] = bf2f(kvp[(size_t)slot * 8192]); dcn[q] = decp[slot * 64]; } }
#pragma unroll
            for (int q = 0; q < 12; ++q) { const int slot = SCAN_SLOT(j0 + q);
                if (slot < NCH) stp[(size_t)slot * 8192] = (bf16)f2bf(s);
                s = dc[q] * s + kv[q]; }
        }
#undef SCAN_SLOT
    }
}

struct GlaPre { u32x4 q, k; f32x4 b0, b1, c0, c1, mf0, mf1, mb0, mb1; u32x4 v[2]; u32x4 st[4]; u32x4 sg[2]; };
__device__ __forceinline__ void gla_load(GlaPre& P, const Args& a, int u, int tid) {
    unsigned char* ws = a.ws;
    const int b = u >> 9, h = (u >> 7) & 3, n = u & 127, row0 = b * SEQ + n * 64, bh = b * 4 + h, t = tid >> 3, c8 = tid & 7;
    const size_t gi = (size_t)(row0 + t) * 256 + h * 64 + 8 * c8, gmf = (size_t)(row0 + 31) * 256 + h * 64 + 8 * c8, gmb = (size_t)(row0 + 32) * 256 + h * 64 + 8 * c8;
    const float* BF = a.out; const float* CB = a.out + (size_t)M * 256;
    P.q = *(const u32x4*)((const bf16*)(ws + WS_QB) + gi); P.k = *(const u32x4*)((const bf16*)(ws + WS_KB) + gi);
    P.b0 = *(const f32x4*)(BF + gi); P.b1 = *(const f32x4*)(BF + gi + 4); P.c0 = *(const f32x4*)(CB + gi); P.c1 = *(const f32x4*)(CB + gi + 4);
    P.mf0 = *(const f32x4*)(BF + gmf); P.mf1 = *(const f32x4*)(BF + gmf + 4); P.mb0 = *(const f32x4*)(CB + gmb); P.mb1 = *(const f32x4*)(CB + gmb + 4);
#pragma unroll
    for (int i = 0; i < 2; ++i) { const int p = tid + NT * i, jj = p >> 4, ch = p & 15; P.v[i] = *(const u32x4*)((const bf16*)(ws + WS_VB) + (size_t)(row0 + jj) * 512 + h * 128 + 8 * ch); }
#pragma unroll
    for (int i = 0; i < 4; ++i) { const int p = tid + NT * i, dir = p >> 10, rem = p & 1023, dv = rem >> 3, c = rem & 7;
        P.st[i] = *(const u32x4*)((const bf16*)(ws + WS_ST) + ((size_t)((dir * 8 + bh) * NCH + n) * 128 + dv) * 64 + 8 * c); }
    const bf16* sgp = (const bf16*)(ws + WS_SG) + (size_t)(row0 + t) * 512 + h * 128 + 16 * c8;
    P.sg[0] = *(const u32x4*)sgp; P.sg[1] = *(const u32x4*)(sgp + 8);
}
__device__ __forceinline__ void phase5(LAS unsigned char* lds, const Args& a, int vcu, int G, int tid, int lane, int wave) {
    unsigned char* ws = a.ws;
    LAS bf16* Aop = (LAS bf16*)lds;
    LAS bf16* Bop = (LAS bf16*)(lds + 25600);
    LAS bf16* Vs = (LAS bf16*)(lds + 60416);
    LAS bf16* qsf = (LAS bf16*)(lds + 77824); LAS bf16* ksf = qsf + 64 * 72; LAS bf16* qsb = ksf + 64 * 72; LAS bf16* ksb = qsb + 64 * 72;
    LAS float* Os = (LAS float*)(lds + 77824);
    const int t8 = tid >> 3, c8 = tid & 7;
    f32x4 gn[4];
#pragma unroll
    for (int q = 0; q < 4; ++q) gn[q] = *(const f32x4*)(a.in[I_GNG] + 16 * c8 + 4 * q);
    GlaPre P;
    int u = vcu;
    if (u < 1024) gla_load(P, a, u, tid);
    for (; u < 1024; u += G) {
        const int b = u >> 9, h = (u >> 7) & 3, n = u & 127, row0 = b * SEQ + n * 64;
        { float qf[8], kf[8], bb[8], cc[8], mf[8], mb[8];
#pragma unroll
          for (int e = 0; e < 4; ++e) { qf[2 * e] = bflo(P.q[e]); qf[2 * e + 1] = bfhi(P.q[e]); kf[2 * e] = bflo(P.k[e]); kf[2 * e + 1] = bfhi(P.k[e]);
              bb[e] = P.b0[e]; bb[4 + e] = P.b1[e]; cc[e] = P.c0[e]; cc[4 + e] = P.c1[e]; mf[e] = P.mf0[e]; mf[4 + e] = P.mf1[e]; mb[e] = P.mb0[e]; mb[4 + e] = P.mb1[e]; }
          float o0[8], o1[8], o2[8], o3[8], o4[8], o5[8];
#pragma unroll
          for (int e = 0; e < 8; ++e) { const float eb = __expf(bb[e]), ec = __expf(cc[e]), x = __expf(bb[e] - mf[e]), y = __expf(cc[e] - mb[e]);
              o0[e] = qf[e] * eb; o1[e] = qf[e] * ec; o2[e] = qf[e] * x; o3[e] = kf[e] * __builtin_amdgcn_rcpf(x); o4[e] = qf[e] * y; o5[e] = kf[e] * __builtin_amdgcn_rcpf(y); }
#define PK8(o) (u32x4){pk2(o[0], o[1]), pk2(o[2], o[3]), pk2(o[4], o[5]), pk2(o[6], o[7])}
          *(LAS u32x4*)(Aop + t8 * 200 + 8 * c8) = PK8(o0); *(LAS u32x4*)(Aop + t8 * 200 + 64 + 8 * c8) = PK8(o1);
          *(LAS u32x4*)(qsf + t8 * 72 + 8 * c8) = PK8(o2); *(LAS u32x4*)(ksf + t8 * 72 + 8 * c8) = PK8(o3); *(LAS u32x4*)(qsb + t8 * 72 + 8 * c8) = PK8(o4); *(LAS u32x4*)(ksb + t8 * 72 + 8 * c8) = PK8(o5);
#undef PK8
        }
#pragma unroll
        for (int i = 0; i < 2; ++i) { const int p = tid + NT * i, jj = p >> 4, ch = p & 15; *(LAS u32x4*)(Vs + jj * 136 + 8 * ch) = P.v[i]; }
#pragma unroll
        for (int i = 0; i < 4; ++i) { const int p = tid + NT * i, dir = p >> 10, rem = p & 1023, dv = rem >> 3, c = rem & 7; *(LAS u32x4*)(Bop + dv * 136 + dir * 64 + 8 * c) = P.st[i]; }
        const u32x4 sg0 = P.sg[0], sg1 = P.sg[1];
        __syncthreads();
        if (u + G < 1024) gla_load(P, a, u + G, tid);
        { const int tt = wave >> 1, jh = wave & 1; f32x4 pa[2] = {{0.f, 0.f, 0.f, 0.f}, {0.f, 0.f, 0.f, 0.f}};
#pragma unroll
          for (int dir = 0; dir < 2; ++dir) { const LAS bf16* qs = dir ? qsb : qsf; const LAS bf16* ks = dir ? ksb : ksf;
              const bf16x8 a0 = ldfrag(qs, 72, tt * 16, 0, lane), a1 = ldfrag(qs, 72, tt * 16, 32, lane);
#pragma unroll
              for (int jj = 0; jj < 2; ++jj) { const int jt = jh * 2 + jj; f32x4 sc = {0.f, 0.f, 0.f, 0.f}; sc = MFMA16(a0, ldfrag(ks, 72, jt * 16, 0, lane), sc); sc = MFMA16(a1, ldfrag(ks, 72, jt * 16, 32, lane), sc);
#pragma unroll
                  for (int r = 0; r < 4; ++r) { const int t = tt * 16 + 4 * (lane >> 4) + r, jx = jt * 16 + (lane & 15); const bool keep = dir ? (jx >= t) : (jx <= t); pa[jj][r] += keep ? sc[r] : 0.f; } } }
#pragma unroll
          for (int jj = 0; jj < 2; ++jj)
#pragma unroll
              for (int r = 0; r < 4; ++r) Aop[(tt * 16 + 4 * (lane >> 4) + r) * 200 + 128 + (jh * 2 + jj) * 16 + (lane & 15)] = (bf16)f2bf(pa[jj][r]); }
        __syncthreads();
        const int tt = wave >> 1, dvh = wave & 1;
        f32x4 acc[4] = {{0.f, 0.f, 0.f, 0.f}, {0.f, 0.f, 0.f, 0.f}, {0.f, 0.f, 0.f, 0.f}, {0.f, 0.f, 0.f, 0.f}};
#pragma unroll
        for (int ks = 0; ks < 4; ++ks) { const bf16x8 af = ldfrag(Aop, 200, tt * 16, ks * 32, lane);
#pragma unroll
            for (int i = 0; i < 4; ++i) acc[i] = MFMA16(af, ldfrag(Bop, 136, (dvh * 4 + i) * 16, ks * 32, lane), acc[i]); }
#pragma unroll
        for (int ks = 0; ks < 2; ++ks) { const bf16x8 af = ldfrag(Aop, 200, tt * 16, 128 + ks * 32, lane);
#pragma unroll
            for (int i = 0; i < 4; ++i) acc[i] = MFMA16(af, ldfrag_tr(Vs, 136, ks * 32, (dvh * 4 + i) * 16, lane), acc[i]); }
#pragma unroll
        for (int i = 0; i < 4; ++i)
#pragma unroll
            for (int r = 0; r < 4; ++r) Os[(tt * 16 + 4 * (lane >> 4) + r) * 132 + (dvh * 4 + i) * 16 + (lane & 15)] = acc[i][r];
        __syncthreads();
        { f32x4 ov[4]; float ss = 0.f;
#pragma unroll
          for (int q = 0; q < 4; ++q) { ov[q] = *(const LAS f32x4*)(Os + t8 * 132 + 16 * c8 + 4 * q); ss += ov[q][0] * ov[q][0] + ov[q][1] * ov[q][1] + ov[q][2] * ov[q][2] + ov[q][3] * ov[q][3]; }
          ss += __shfl_xor(ss, 1); ss += __shfl_xor(ss, 2); ss += __shfl_xor(ss, 4);
          const float rstd = rsqrtf(ss * (1.f / 128.f) + EPS);
          unsigned sgw[8] = {sg0[0], sg0[1], sg0[2], sg0[3], sg1[0], sg1[1], sg1[2], sg1[3]}, ow[8];
#pragma unroll
          for (int q = 0; q < 4; ++q) { const f32x4 o = ov[q] * rstd * gn[q]; ow[2 * q] = pk2(o[0] * bflo(sgw[2 * q]), o[1] * bfhi(sgw[2 * q])); ow[2 * q + 1] = pk2(o[2] * bflo(sgw[2 * q + 1]), o[3] * bfhi(sgw[2 * q + 1])); }
          bf16* agp = (bf16*)(ws + WS_AG) + (size_t)(row0 + t8) * 512 + h * 128 + 16 * c8;
          *(u32x4*)agp = (u32x4){ow[0], ow[1], ow[2], ow[3]}; *(u32x4*)(agp + 8) = (u32x4){ow[4], ow[5], ow[6], ow[7]}; }
        __syncthreads();
    }
}

__device__ __forceinline__ void phase8(LAS unsigned char* lds, const Args& a, int vcu, int G, int tid, int lane, int wave) {
    unsigned char* ws = a.ws;
    const float* MOD = (const float*)(ws + WS_MOD);
    LAS float* WRT = (LAS float*)lds;
#pragma unroll
    for (int it = 0; it < 8; ++it) { const int idx = tid + NT * it, k = idx >> 2, c4 = idx & 3; const f32x4 v = *(const f32x4*)(a.in[I_WROUTER] + (size_t)k * 16 + 4 * c4);
        const int row = ((k >> 8) * 4 + (k & 3)) * 64 + ((k & 255) >> 2); *(LAS f32x4*)(WRT + row * 20 + 4 * c4) = v; }
    __syncthreads();
    const int gw = vcu * NWAVES + wave, NGW = G * NWAVES;
    f32x4 gv[4];
#pragma unroll
    for (int j = 0; j < 4; ++j) gv[j] = *(const f32x4*)(a.in[I_N2G] + 256 * j + 4 * lane);
    f32x4 nx[2][4];
    if (gw < M / 2) {
#pragma unroll
        for (int r = 0; r < 2; ++r)
#pragma unroll
            for (int j = 0; j < 4; ++j) nx[r][j] = *(const f32x4*)(a.out + (size_t)(2 * gw + r) * 1024 + 256 * j + 4 * lane); }
    for (int pr = gw; pr < M / 2; pr += NGW) {
        const int m0 = 2 * pr, b = m0 >> 13; const float* mod = MOD + (size_t)b * 6144;
        f32x4 v[2][4]; float ss[2];
#pragma unroll
        for (int r = 0; r < 2; ++r) { float q = 0.f;
#pragma unroll
            for (int j = 0; j < 4; ++j) { v[r][j] = nx[r][j]; q += v[r][j][0] * v[r][j][0] + v[r][j][1] * v[r][j][1] + v[r][j][2] * v[r][j][2] + v[r][j][3] * v[r][j][3]; }
            ss[r] = q; }
        if (pr + NGW < M / 2) {
#pragma unroll
            for (int r = 0; r < 2; ++r)
#pragma unroll
                for (int j = 0; j < 4; ++j) nx[r][j] = *(const f32x4*)(a.out + (size_t)(2 * (pr + NGW) + r) * 1024 + 256 * j + 4 * lane); }
#pragma unroll
        for (int r = 0; r < 2; ++r) { const float rstd = rsqrtf(wave_sum(ss[r]) * (1.f / 1024.f) + EPS);
#pragma unroll
            for (int j = 0; j < 4; ++j) { const f32x4 sc = *(const f32x4*)(mod + 4096 + 256 * j + 4 * lane), sh = *(const f32x4*)(mod + 3072 + 256 * j + 4 * lane); v[r][j] = v[r][j] * rstd * gv[j] * (sc + 1.f) + sh; }
            unsigned char* hp = ws + WS_H2 + (size_t)(m0 + r) * 1024;
#pragma unroll
            for (int j = 0; j < 4; ++j) *(unsigned*)(hp + 256 * j + 4 * lane) = pk4_fp8(v[r][j][0], v[r][j][1], v[r][j][2], v[r][j][3]); }
        f32x2 r2[16];
#pragma unroll
        for (int i = 0; i < 16; ++i) r2[i] = (f32x2){0.f, 0.f};
#pragma unroll
        for (int j = 0; j < 4; ++j)
#pragma unroll
            for (int i = 0; i < 4; ++i) { const f32x2 hab = {v[0][j][i], v[1][j][i]}; const LAS float* rp = WRT + ((j * 4 + i) * 64 + lane) * 20;
#pragma unroll
                for (int c4 = 0; c4 < 4; ++c4) { const f32x4 w = *(const LAS f32x4*)(rp + 4 * c4); r2[4 * c4 + 0] += hab * w[0]; r2[4 * c4 + 1] += hab * w[1]; r2[4 * c4 + 2] += hab * w[2]; r2[4 * c4 + 3] += hab * w[3]; }
                if (i & 1) asm volatile("" ::: "memory"); }
#pragma unroll
        for (int r = 0; r < 2; ++r) {
            float racc[16];
#pragma unroll
            for (int i = 0; i < 16; ++i) racc[i] = r2[i][r];
            RSTEP(16, 32); RSTEP(8, 16); RSTEP(4, 8); RSTEP(2, 4); racc[0] += __shfl_xor(racc[0], 2); racc[0] += __shfl_xor(racc[0], 1);
            const float lg = racc[0];
            float mx = lg; mx = fmaxf(mx, __shfl_xor(mx, 4)); mx = fmaxf(mx, __shfl_xor(mx, 8)); mx = fmaxf(mx, __shfl_xor(mx, 16)); mx = fmaxf(mx, __shfl_xor(mx, 32));
            const float ex = expf(lg - mx); float sm = ex; sm += __shfl_xor(sm, 4); sm += __shfl_xor(sm, 8); sm += __shfl_xor(sm, 16); sm += __shfl_xor(sm, 32);
            const int m = m0 + r;
            if ((lane & 3) == 0) ((float*)(ws + WS_AFF))[(size_t)(b * 16 + (lane >> 2)) * SEQ + (m & (SEQ - 1))] = ex / sm;
            if (lane < 16) ((int*)(ws + WS_INV))[(size_t)m * 16 + lane] = -1;
        }
    }
}

__device__ __forceinline__ void topk_unit(LAS unsigned char* lds, const Args& a, int be, int tid, int lane, int wave) {
    unsigned char* ws = a.ws;
    LAS unsigned* hist = (LAS unsigned*)lds;
    LAS unsigned* sel = hist + 256;
    LAS unsigned* wtot = hist + 264;
    const float* aff = (const float*)(ws + WS_AFF) + (size_t)be * SEQ + 16 * tid;
    unsigned key[16];
#pragma unroll
    for (int q = 0; q < 4; ++q) { const u32x4 v = *(const u32x4*)(aff + 4 * q); key[4 * q] = v[0]; key[4 * q + 1] = v[1]; key[4 * q + 2] = v[2]; key[4 * q + 3] = v[3]; }
    unsigned prefix = 0u, mask = 0u, kk = CAP;
    for (int pass = 0; pass < 4; ++pass) {
        const int shift = 24 - 8 * pass;
        if (tid < 256) hist[tid] = 0u;
        __syncthreads();
#pragma unroll
        for (int i = 0; i < 16; ++i) if ((key[i] & mask) == prefix) __hip_atomic_fetch_add(hist + ((key[i] >> shift) & 255u), 1u, __ATOMIC_RELAXED, __HIP_MEMORY_SCOPE_WORKGROUP);
        __syncthreads();
        if (wave == 0) {
            const unsigned h0 = hist[4 * lane], h1 = hist[4 * lane + 1], h2 = hist[4 * lane + 2], h3 = hist[4 * lane + 3], loc = h0 + h1 + h2 + h3;
            unsigned suf = loc;
#pragma unroll
            for (int o = 1; o < 64; o <<= 1) { const unsigned t = __shfl_down(suf, o); if (lane + o < 64) suf += t; }
            const unsigned above = suf - loc;
            const unsigned s3 = above + h3, s2 = s3 + h2, s1 = s2 + h1, s0 = s1 + h0;
            if (s3 >= kk && above < kk) { sel[0] = 4 * lane + 3; sel[1] = kk - above; }
            if (s2 >= kk && s3 < kk) { sel[0] = 4 * lane + 2; sel[1] = kk - s3; }
            if (s1 >= kk && s2 < kk) { sel[0] = 4 * lane + 1; sel[1] = kk - s2; }
            if (s0 >= kk && s1 < kk) { sel[0] = 4 * lane + 0; sel[1] = kk - s1; }
        }
        __syncthreads();
        prefix |= sel[0] << shift; mask |= 255u << shift; kk = sel[1];
        __syncthreads();
    }
    unsigned cgt = 0u, ceq = 0u;
#pragma unroll
    for (int i = 0; i < 16; ++i) { cgt += (key[i] > prefix) ? 1u : 0u; ceq += (key[i] == prefix) ? 1u : 0u; }
    const unsigned val = cgt | (ceq << 16); unsigned inc = val;
#pragma unroll
    for (int o = 1; o < 64; o <<= 1) { const unsigned t = __shfl_up(inc, o); if (lane >= o) inc += t; }
    if (lane == 63) wtot[wave] = inc;
    __syncthreads();
    unsigned base = 0u;
    for (int w = 0; w < wave; ++w) base += wtot[w];
    const unsigned excl = base + inc - val; unsigned gtb = excl & 0xffffu, eqb = excl >> 16;
    const int b = be >> 4, e = be & 15;
    int* IDX = (int*)(ws + WS_IDX) + be * CAP; float* WSEL = (float*)(ws + WS_WSEL) + be * CAP; int* INV = (int*)(ws + WS_INV);
#pragma unroll
    for (int i = 0; i < 16; ++i) { const bool gt = key[i] > prefix, eq = key[i] == prefix; const bool take = gt || (eq && eqb < kk);
        if (take) { const unsigned pos = gtb + (eqb < kk ? eqb : kk); const int row = b * SEQ + 16 * tid + i; IDX[pos] = row; WSEL[pos] = __builtin_bit_cast(float, key[i]); INV[(size_t)row * 16 + e] = (int)pos; }
        gtb += gt ? 1u : 0u; eqb += eq ? 1u : 0u; }
    __syncthreads();
}
__device__ __forceinline__ void phase9(LAS unsigned char* lds, const Args& a, int vcu, int G, int tid, int lane, int wave) {
    const int ntk = (G > 64) ? 32 : 0;
    if (vcu < ntk || ntk == 0) for (int be = (ntk ? vcu : vcu); be < NB * NE; be += (ntk ? ntk : G)) topk_unit(lds, a, be, tid, lane, wave);
    if (vcu >= ntk) { const int gw = (vcu - ntk) * NWAVES + wave, NGW = (G - ntk) * NWAVES; convert_items<2>((LAS float*)(lds + 8192 + wave * 8448), a, gw, NGW, 8192, lane); }
}

__device__ __forceinline__ void phase12(const Args& a, int vcu, int G, int lane, int wave) {
    unsigned char* ws = a.ws;
    const int gw = vcu * NWAVES + wave, NGW = G * NWAVES;
    f32x4 gv[4];
#pragma unroll
    for (int j = 0; j < 4; ++j) gv[j] = *(const f32x4*)(a.in[I_FNG] + 256 * j + 4 * lane);
    f32x4 nx[4]; int ninv = -1;
    if (gw < M) {
#pragma unroll
        for (int j = 0; j < 4; ++j) nx[j] = __builtin_nontemporal_load((const f32x4*)(a.out + (size_t)gw * 1024 + 256 * j + 4 * lane));
        ninv = (lane < 16) ? ((const int*)(ws + WS_INV))[(size_t)gw * 16 + lane] : -1; }
    for (int m = gw; m < M; m += NGW) {
        const int b = m >> 13; float* row = a.out + (size_t)m * 1024;
        f32x4 v[4];
#pragma unroll
        for (int j = 0; j < 4; ++j) v[j] = nx[j];
        const int myinv = ninv;
        if (m + NGW < M) {
#pragma unroll
            for (int j = 0; j < 4; ++j) nx[j] = __builtin_nontemporal_load((const f32x4*)(a.out + (size_t)(m + NGW) * 1024 + 256 * j + 4 * lane));
            ninv = (lane < 16) ? ((const int*)(ws + WS_INV))[(size_t)(m + NGW) * 16 + lane] : -1; }
        unsigned long long mask = __ballot(myinv >= 0);
        const bf16* yb = (const bf16*)(ws + WS_YB) + (size_t)(b * 16) * CAP * 1024;
        while (mask) {
            u32x2 w[4][4]; float sc[4];
#pragma unroll
            for (int q = 0; q < 4; ++q) { const bool on = mask != 0ull; const int e = on ? (int)__builtin_ctzll(mask) : 0; mask = on ? (mask & (mask - 1ull)) : 0ull;
                const int sl = __shfl(myinv, e); const size_t ro = on ? ((size_t)e * CAP + (size_t)sl) * 1024 : 0; sc[q] = on ? 1.f : 0.f;
#pragma unroll
                for (int j = 0; j < 4; ++j) w[q][j] = __builtin_nontemporal_load((const u32x2*)(yb + ro + 256 * j + 4 * lane)); }
#pragma unroll
            for (int q = 0; q < 4; ++q)
#pragma unroll
                for (int j = 0; j < 4; ++j) { v[j][0] += sc[q] * bflo(w[q][j].x); v[j][1] += sc[q] * bfhi(w[q][j].x); v[j][2] += sc[q] * bflo(w[q][j].y); v[j][3] += sc[q] * bfhi(w[q][j].y); }
        }
        float ss = 0.f;
#pragma unroll
        for (int j = 0; j < 4; ++j) ss += v[j][0] * v[j][0] + v[j][1] * v[j][1] + v[j][2] * v[j][2] + v[j][3] * v[j][3];
        const float rstd = rsqrtf(wave_sum(ss) * (1.f / 1024.f) + EPS);
#pragma unroll
        for (int j = 0; j < 4; ++j) __builtin_nontemporal_store(v[j] * rstd * gv[j], (f32x4*)(row + 256 * j + 4 * lane));
    }
}

__global__ void __launch_bounds__(NT, 2) fwd_kernel(Args args) {
    extern __shared__ __attribute__((aligned(16))) unsigned char lds_raw[];
    LAS unsigned char* lds = (LAS unsigned char*)lds_raw;
    volatile LAS unsigned* MISC = (volatile LAS unsigned*)(lds + MISC_OFF);
    const int tid0 = threadIdx.x, tid = tid0, wave = __builtin_amdgcn_readfirstlane(tid >> 6);
    const int G = gridDim.x, bx = blockIdx.x, vcu = (G % 8 == 0) ? (bx % 8) * (G / 8) + bx / 8 : bx;
    unsigned char* ws = args.ws;
    if (tid < 128) MISC[tid] = 0u;
    __syncthreads();
    XcdBarrier bar; bar.bar = (unsigned*)(ws + WS_CTL) + CW_BAR; bar.x = 0; bar.st = nullptr;
    if (!MK_MULTI) bar = xcd_barrier_post((unsigned*)(ws + WS_CTL) + CW_BAR, MISC + 8);
    const int lo = args.ph_lo, hi = args.ph_hi;
#define IN(k) (lo <= (k) && (k) < hi)
#define SEAM(k) do { if (IN(k) && IN((k) + 1)) xcd_barrier(bar); } while (0)
#define RUN(k, CODE) do { if (IN(k)) { int tid = tid0, lane; asm volatile("" : "+v"(tid)); lane = tid & 63; (void)lane; CODE; if (REP_PHASE == (k)) for (int _r = 0; _r < REP_COUNT; ++_r) { xcd_barrier(bar); CODE; } } SEAM(k); } while (0)
#define PH0 phase0(lds, args, vcu, G, tid, lane, wave)
#define PH1 phase1(lds, args, vcu, G, tid, lane, wave)
#define PH2 do { const int qs = vcu % 3;     \
        EpiInproj E{(bf16*)(ws + WS_KB), (bf16*)(ws + WS_VB), (bf16*)(ws + WS_QB), (bf16*)(ws + WS_SG), (bf16*)(ws + WS_PI), (bf16*)(ws + WS_SM), 0, 1.f}; \
        EpiInproj E8{(bf16*)(ws + WS_KB), (bf16*)(ws + WS_VB), (bf16*)(ws + WS_QB), (bf16*)(ws + WS_SG), (bf16*)(ws + WS_PI), (bf16*)(ws + WS_SM), 8, 0.0625f}; \
        if (qs == 0) convert_all<1>(lds, args, vcu, G, lane, wave); \
        { SchedDense S{G, bx, 1024, 64, 8, (const char*)(ws + WS_H1), (const char*)(ws + WS_WIN), 0, 1 << 20, 2}; pg8::gemm_phase<EpiInproj, SchedDense, false, false>(lds, S, E); }     \
        if (qs == 1) convert_all<1>(lds, args, vcu, G, lane, wave); \
        { SchedDense S{G, bx, 1024, 64, 8, (const char*)(ws + WS_H1F), (const char*)(ws + WS_WINM), 0, 1 << 20, 1}; pg8::gemm_phase<EpiInproj, SchedDense, false, true>(lds, S, E8); }     \
        if (qs == 2) convert_all<1>(lds, args, vcu, G, lane, wave); } while (0)
#define PH3 chunk_units(lds, args, vcu, G, tid, lane, wave)
#define PH4 do { if (wave < 4) phase4(args, G, tid, 256); else pool_units(args, vcu, G, lane, wave - 4, 4); } while (0)
#define PH5 phase5(lds, args, vcu, G, tid, lane, wave)
#define PH6 do { SchedPair S{G, bx, 512, (const char*)(ws + WS_AG), (const char*)(ws + WS_PO), (const char*)(ws + WS_WG), (const char*)(ws + WS_WC)}; \
        EpiMerge E{(const bf16*)(ws + WS_SM), (bf16*)(ws + WS_MG)}; pg8::gemm_phase<EpiMerge, SchedPair, false>(lds, S, E); } while (0)
#define PH7 do { SchedDense S{G, bx, 1024, 64, 4, (const char*)(ws + WS_MG), (const char*)(ws + WS_WO), 0, 1 << 20, 2}; \
        EpiOut E{args.in[I_X], (const float*)(ws + WS_MOD), args.out}; pg8::gemm_phase<EpiOut, SchedDense, false>(lds, S, E); } while (0)
#define NITEM_HALF ((NE * 3 * 512 + 2 * G * NWAVES - 1) / (2 * G * NWAVES))
#define PH6C do { if (vcu & 1) convert_experts(lds, args, vcu, G, lane, wave, 0, NITEM_HALF); PH6; if (!(vcu & 1)) convert_experts(lds, args, vcu, G, lane, wave, 0, NITEM_HALF); } while (0)
#define PH7C do { if (vcu & 1) convert_experts(lds, args, vcu, G, lane, wave, NITEM_HALF, 2 * NITEM_HALF); PH7; if (!(vcu & 1)) convert_experts(lds, args, vcu, G, lane, wave, NITEM_HALF, 2 * NITEM_HALF); } while (0)
#define PH8 phase8(lds, args, vcu, G, tid, lane, wave)
#define PH9 phase9(lds, args, vcu, G, tid, lane, wave)
#define PH9B do { const int gw_ = vcu * NWAVES + wave, NGW_ = G * NWAVES;     \
        for (int r0_ = gw_ * 16; r0_ < NB * NE * CAP; r0_ += NGW_ * 16) { u32x4 t_[16]; \
            _Pragma("unroll") for (int q = 0; q < 16; ++q) { const int src_ = ((const int*)(ws + WS_IDX))[r0_ + q]; t_[q] = *(const u32x4*)(ws + WS_H2 + (size_t)src_ * 1024 + lane * 16); } \
            _Pragma("unroll") for (int q = 0; q < 16; ++q) *(u32x4*)(ws + WS_XS + (size_t)(r0_ + q) * 1024 + lane * 16) = t_[q]; } } while (0)
#define PH10 do { EpiMoe1 E{ws + WS_ACT}; SchedMoe1 S{G, bx, 1024, (const char*)(ws + WS_XS), (const char*)(ws + WS_WGU), 0, 1 << 20}; pg8::gemm_phase<EpiMoe1, SchedMoe1, false, true>(lds, S, E); } while (0)
#define PH11 do { SchedMoe2 S{G, bx, 1024, (const char*)(ws + WS_ACT), (const char*)(ws + WS_WD)}; \
        EpiMoe2 E{(bf16*)(ws + WS_YB), (const float*)(ws + WS_WSEL), (const float*)(ws + WS_MOD)}; pg8::gemm_phase<EpiMoe2, SchedMoe2, false, true>(lds, S, E); } while (0)
#define PH12 phase12(args, vcu, G, lane, wave)
    RUN(0, PH0); RUN(1, PH1); RUN(2, PH2); RUN(3, PH3);
#define PH3A chunk_units(lds, args, vcu, G, tid, lane, wave)
#define PH3B pool_units(args, vcu, G, lane, wave, 8)
    if (REP_PHASE == 30) { const int lane = tid & 63; xcd_barrier(bar); PH3A; xcd_barrier(bar); }
    if (REP_PHASE == 31) { const int lane = tid & 63; xcd_barrier(bar); PH3B; xcd_barrier(bar); } RUN(4, PH4); RUN(5, PH5); RUN(6, PH6); RUN(7, PH7); RUN(8, PH8); RUN(9, PH9); RUN(10, PH9B); RUN(11, PH10); RUN(12, PH11);
    if (REP_PHASE == 20) for (int _r = 0; _r < REP_COUNT; ++_r) xcd_barrier(bar);
    RUN(13, PH12);
#undef IN
#undef SEAM
#undef RUN
}

#ifndef MK_CHECK
#define MK_CHECK 0
#endif
#ifndef CHK_SKIP
#define CHK_SKIP -1
#endif
#if MK_CHECK
constexpr size_t WS_CHK = 299 * MiB;
__device__ __forceinline__ unsigned hashu(unsigned x) { x ^= x >> 16; x *= 0x7feb352dU; x ^= x >> 15; x *= 0x846ca68bU; x ^= x >> 16; return x; }
__device__ __forceinline__ float bfr(float f) { return bf2f(f2bf(f)); }
__device__ float f8d(unsigned char x) { const int sg = x >> 7, e = (x >> 3) & 15, m = x & 7; const float v = e ? ldexpf(1.f + m / 8.f, e - 7) : ldexpf(m / 8.f, -6); return sg ? -v : v; }
__device__ float f8r(float f) { return f8d((unsigned char)(pk4_fp8(f, 0.f, 0.f, 0.f) & 255u)); }
__device__ float naive_rstd(const float* row) { float ss = 0.f; for (int k = 0; k < 1024; ++k) ss += row[k] * row[k]; return rsqrtf(ss / 1024.f + EPS); }
__device__ float naive_la(const Args& a, int row, int dir, int col) {
    const float* RB = (const float*)(a.ws + WS_RB) + (size_t)row * 32 + dir * 16; float z = a.in[I_BDEC][dir * 256 + col];
    for (int j = 0; j < 16; ++j) z += RB[j] * a.in[I_WDU][(size_t)(dir * 16 + j) * 256 + col];
    return logsig_f(z) / 16.f;
}
__global__ void chk_kernel(Args a, int stage) {
    __shared__ float sh[256];
    const unsigned gid = blockIdx.x * blockDim.x + threadIdx.x; unsigned h = hashu(gid * 2654435761u + (unsigned)stage * 97u + 12345u); const unsigned h2 = hashu(h + 777u);
    unsigned char* ws = a.ws; float ref = 0.f, got = 0.f, atol = 1e-3f; bool active = true;
    const float* MOD = (const float*)(ws + WS_MOD);
    switch (stage) {
    case 0: { const int v = h % 3, n = (h >> 2) % 6144; ref = a.in[I_ADAB][n]; for (int k = 0; k < 1024; ++k) { const float c = (v < 2) ? a.in[I_C][v * 1024 + k] : a.in[I_CCTX][k]; ref += c / (1.f + expf(-c)) * a.in[I_ADAW][(size_t)k * 6144 + n]; } got = MOD[v * 6144 + n]; atol = 0.01f; } break;
    case 1: { const int sel = (h >> 28) & 3, n = h % 4096, k = (h >> 12) % 1024;
        if (sel < 2) { if (n < 2048) { ref = bfr(a.in[I_WIN][(size_t)k * DIN + n + (n >= 768 ? 32 : 0)]); got = bf2f(((const bf16*)(ws + WS_WIN))[(size_t)n * 1024 + k]); } else { ref = f8r(16.f * a.in[I_WIN][(size_t)k * DIN + n + 32]); got = f8d((ws + WS_WINM)[(size_t)(n - 2048) * 1024 + k]); } }
        else if (sel == 2) { ref = bfr(a.in[I_WOUT][(size_t)k * 1024 + (n & 1023)]); got = bf2f(((const bf16*)(ws + WS_WO))[(size_t)(n & 1023) * 1024 + k]); }
        else { ref = bfr(a.in[I_WGLA][(size_t)(k & 511) * 1024 + (n & 1023)]); got = bf2f(((const bf16*)(ws + WS_WG))[(size_t)(n & 1023) * 512 + (k & 511)]); } atol = 1e-4f; } break;
    case 2: { const int n = h % 1024, kk = (h >> 10) % 512, g = kk >> 7, c = kk & 127; for (int d = 0; d < 128; ++d) ref += a.in[I_POOLW][(size_t)(g * 128 + c) * 128 + d] * a.in[I_POOLS][g * 128 + d] * a.in[I_WPOOL][(size_t)(g * 128 + d) * 1024 + n];
        got = bf2f(((const bf16*)(ws + WS_WC))[(size_t)n * 512 + kk]); atol = 0.002f; } break;
    case 3: { const int m = h % M, k = (h >> 14) % 1024, b = m >> 13; const float* row = a.in[I_X] + (size_t)m * 1024; const float rstd = naive_rstd(row);
        ref = row[k] * rstd * a.in[I_N1G][k] * (1.f + MOD[b * 6144 + 1024 + k]) + MOD[b * 6144 + k]; got = bf2f(((const bf16*)(ws + WS_H1))[(size_t)m * 1024 + k]); atol = 0.01f; } break;
    case 4: { const int m = h % MT, c = (h >> 15) % 32, mi = (m < M) ? (m >> 13) : 2; const float* row = (m < M) ? a.in[I_X] + (size_t)m * 1024 : a.in[I_CTX] + (size_t)(m - M) * 1024; const float rstd = naive_rstd(row);
        for (int k = 0; k < 1024; ++k) ref += (row[k] * rstd * a.in[I_N1G][k] * (1.f + MOD[mi * 6144 + 1024 + k]) + MOD[mi * 6144 + k]) * a.in[I_WIN][(size_t)k * DIN + 768 + c];
        got = ((const float*)(ws + WS_RB))[(size_t)m * 32 + c]; atol = 0.01f; } break;
    case 5: { const int r = h % 512, n = (h >> 9) % 768; const float* row = a.in[I_CTX] + (size_t)r * 1024; const float rstd = naive_rstd(row);
        for (int k = 0; k < 1024; ++k) ref += bfr(row[k] * rstd * a.in[I_N1G][k] * (1.f + MOD[2 * 6144 + 1024 + k]) + MOD[2 * 6144 + k]) * bf2f(((const bf16*)(ws + WS_WIN))[(size_t)n * 1024 + k]);
        got = (n < 256) ? bf2f(((const bf16*)(ws + WS_KB))[(size_t)(M + r) * 256 + n]) : bf2f(((const bf16*)(ws + WS_VB))[(size_t)(M + r) * 512 + n - 256]); atol = 0.03f; } break;
    case 6: { const int m = h % M, n = (h >> 14) % 4096; const bf16* hr = (const bf16*)(ws + WS_H1) + (size_t)m * 1024; const bf16* wr_ = (const bf16*)(ws + WS_WIN) + (size_t)n * 1024; float d = 0.f;
        if (n < 2048) { for (int k = 0; k < 1024; ++k) d += bf2f(hr[k]) * bf2f(wr_[k]); }
        else { for (int k = 0; k < 1024; ++k) d += f8d((ws + WS_H1F)[(size_t)m * 1024 + k]) * f8d((ws + WS_WINM)[(size_t)(n - 2048) * 1024 + k]); d *= 0.0625f; }
        if (n < 256) { ref = d; got = bf2f(((const bf16*)(ws + WS_KB))[(size_t)m * 256 + n]); }
        else if (n < 768) { ref = d; got = bf2f(((const bf16*)(ws + WS_VB))[(size_t)m * 512 + n - 256]); }
        else if (n < 1024) { ref = d * 0.125f; got = bf2f(((const bf16*)(ws + WS_QB))[(size_t)m * 256 + n - 768]); }
        else if (n < 1536) { ref = d / (1.f + expf(-d)); got = bf2f(((const bf16*)(ws + WS_SG))[(size_t)m * 512 + n - 1024]); }
        else if (n < 2048) { ref = d; got = bf2f(((const bf16*)(ws + WS_PI))[(size_t)m * 512 + n - 1536]); }
        else { ref = 1.f / (1.f + expf(-d)); got = bf2f(((const bf16*)(ws + WS_SM))[(size_t)m * 2048 + n - 2048]); } atol = 0.02f; } break;
    case 7: { const int m = h % M, col = (h >> 14) % 256, dir = (h >> 22) & 1, t = m & 63, m0 = m - t;
        for (int s = 0; s < 64; ++s) if (dir ? (s >= t) : (s <= t)) ref += naive_la(a, m0 + s, dir, col);
        got = (dir ? a.out + (size_t)M * 256 : a.out)[(size_t)m * 256 + col]; atol = 0.003f; } break;
    case 8: case 9: { const int dir = h & 1, bh = (h >> 1) & 7, slot = (stage == 9) ? 128 + ((h >> 4) & 3) : ((h >> 4) & 127), dv = (h >> 11) & 127, dk = (h >> 18) & 63, b = bh >> 2, hh = bh & 3;
        const int row0 = (slot < 128) ? b * SEQ + slot * 64 : M + b * LC + (slot - 128) * 64; float la[64]; float tot = 0.f;
        for (int s = 0; s < 64; ++s) tot += naive_la(a, row0 + s, dir, hh * 64 + dk);
        float run = 0.f;
        if (!dir) { for (int s = 0; s < 64; ++s) { run += naive_la(a, row0 + s, 0, hh * 64 + dk); ref += bf2f(((const bf16*)(ws + WS_VB))[(size_t)(row0 + s) * 512 + hh * 128 + dv]) * bfr(bf2f(((const bf16*)(ws + WS_KB))[(size_t)(row0 + s) * 256 + hh * 64 + dk]) * expf(tot - run)); } }
        else { for (int s = 63; s >= 0; --s) { run += naive_la(a, row0 + s, 1, hh * 64 + dk); ref += bf2f(((const bf16*)(ws + WS_VB))[(size_t)(row0 + s) * 512 + hh * 128 + dv]) * bfr(bf2f(((const bf16*)(ws + WS_KB))[(size_t)(row0 + s) * 256 + hh * 64 + dk]) * expf(tot - run)); } }
        (void)la;
        if ((h >> 30) & 1) { ref = expf(tot); got = ((const float*)(ws + WS_DEC))[((size_t)(dir * 8 + bh) * NSLOT + slot) * 64 + dk]; atol = 1e-3f; }
        else { got = bf2f(((const bf16*)(ws + WS_KV))[((size_t)(dir * 8 + bh) * NSLOT + slot) * 8192 + dv * 64 + dk]); atol = 0.1f; } } break;
    case 10: { const int m = h % M, col = (h >> 14) % 512, g = col >> 7, half = 1 << g, b = m >> 13, l = m & 8191, r = l >> 6, c = l & 63; const bf16* PI = (const bf16*)(ws + WS_PI);
        const int lo_r = max(r - half, 0), hi_r = min(r + half, 128), lo_c = max(c - half, 0), hi_c = min(c + half, 64); float sm = 0.f;
        for (int rr = lo_r; rr < hi_r; ++rr) for (int cc = lo_c; cc < hi_c; ++cc) sm += bf2f(PI[(size_t)(b * SEQ + rr * 64 + cc) * 512 + col]);
        ref = sm / (float)((hi_r - lo_r) * (hi_c - lo_c)) - bf2f(PI[(size_t)m * 512 + col]); got = bf2f(((const bf16*)(ws + WS_PO))[(size_t)m * 512 + col]); atol = 0.02f; } break;
    case 11: { const int dir = h & 1, bh = (h >> 1) & 7, n = (h >> 4) & 127, e8 = (h >> 11) & 8191, dk = e8 & 63; float s = 0.f;
        const bf16* kvp = (const bf16*)(ws + WS_KV) + (size_t)((dir * 8 + bh) * NSLOT) * 8192 + e8; const float* dp = (const float*)(ws + WS_DEC) + (size_t)((dir * 8 + bh) * NSLOT) * 64 + dk;
        if (!dir) { for (int j = 128; j < 132; ++j) s = dp[j * 64] * s + bf2f(kvp[(size_t)j * 8192]); for (int j = 0; j < n; ++j) s = dp[j * 64] * s + bf2f(kvp[(size_t)j * 8192]); }
        else { for (int j = 131; j >= 128; --j) s = dp[j * 64] * s + bf2f(kvp[(size_t)j * 8192]); for (int j = 127; j > n; --j) s = dp[j * 64] * s + bf2f(kvp[(size_t)j * 8192]); }
        ref = s; got = bf2f(((const bf16*)(ws + WS_ST))[(size_t)((dir * 8 + bh) * NCH + n) * 8192 + e8]); atol = 0.1f; } break;
    case 12: {
        const unsigned hb = hashu(blockIdx.x * 7919u + 5u); const int m = hb % M, hh = (hb >> 14) & 3, b = m >> 13, l = m & 8191, n = l >> 6, t = l & 63, row0 = m - t, bh = b * 4 + hh, dv = threadIdx.x & 127;
        const float* BF = a.out; const float* CB = a.out + (size_t)M * 256; const bf16* QB = (const bf16*)(ws + WS_QB); const bf16* KB = (const bf16*)(ws + WS_KB); const bf16* VB = (const bf16*)(ws + WS_VB); const bf16* ST = (const bf16*)(ws + WS_ST);
        if (threadIdx.x < 128) { const int j = threadIdx.x & 63, dir = threadIdx.x >> 6; float sc = 0.f;
            const bool keep = dir ? (j >= t) : (j <= t);
            if (keep) for (int d = 0; d < 64; ++d) { const size_t gq = (size_t)m * 256 + hh * 64 + d, gk = (size_t)(row0 + j) * 256 + hh * 64 + d; const float* P = dir ? CB : BF; sc += bf2f(QB[gq]) * bf2f(KB[gk]) * expf(P[gq] - P[gk]); }
            sh[threadIdx.x] = sc; }
        __syncthreads();
        float o = 0.f;
        for (int d = 0; d < 64; ++d) { const size_t gq = (size_t)m * 256 + hh * 64 + d; const float q = bf2f(QB[gq]);
            o += q * expf(BF[gq]) * bf2f(ST[((size_t)((0 * 8 + bh) * NCH + n) * 128 + dv) * 64 + d]) + q * expf(CB[gq]) * bf2f(ST[((size_t)((1 * 8 + bh) * NCH + n) * 128 + dv) * 64 + d]); }
        for (int j = 0; j < 64; ++j) o += (sh[j] + sh[64 + j]) * bf2f(VB[(size_t)(row0 + j) * 512 + hh * 128 + dv]);
        __syncthreads(); sh[128 + dv] = o * o; __syncthreads();
        float ss = 0.f; for (int d = 0; d < 128; ++d) ss += sh[128 + d];
        const size_t gi = (size_t)m * 512 + hh * 128 + dv;
        ref = o * rsqrtf(ss / 128.f + EPS) * a.in[I_GNG][dv] * bf2f(((const bf16*)(ws + WS_SG))[gi]); got = bf2f(((const bf16*)(ws + WS_AG))[gi]); atol = 0.03f; } break;
    case 13: { const int m = h % M, n = (h >> 14) % 1024; float g = 0.f, p = 0.f; const bf16* AG = (const bf16*)(ws + WS_AG) + (size_t)m * 512; const bf16* PO = (const bf16*)(ws + WS_PO) + (size_t)m * 512;
        for (int k = 0; k < 512; ++k) { g += bf2f(AG[k]) * bf2f(((const bf16*)(ws + WS_WG))[(size_t)n * 512 + k]); p += bf2f(PO[k]) * bf2f(((const bf16*)(ws + WS_WC))[(size_t)n * 512 + k]); }
        const bf16* SM = (const bf16*)(ws + WS_SM) + (size_t)m * 2048; ref = bf2f(SM[n]) * g + bf2f(SM[1024 + n]) * p; got = bf2f(((const bf16*)(ws + WS_MG))[(size_t)m * 1024 + n]); atol = 0.03f; } break;
    case 14: { const int m = h % M, n = (h >> 14) % 1024, b = m >> 13; float d = 0.f; for (int k = 0; k < 1024; ++k) d += bf2f(((const bf16*)(ws + WS_MG))[(size_t)m * 1024 + k]) * bf2f(((const bf16*)(ws + WS_WO))[(size_t)n * 1024 + k]);
        ref = a.in[I_X][(size_t)m * 1024 + n] + MOD[b * 6144 + 2048 + n] * d; got = a.out[(size_t)m * 1024 + n]; atol = 0.01f; } break;
    case 15: { const int m = h % M, k = (h >> 14) % 1024, b = m >> 13; const float* row = a.out + (size_t)m * 1024; const float rstd = naive_rstd(row);
        ref = row[k] * rstd * a.in[I_N2G][k] * (1.f + MOD[b * 6144 + 4096 + k]) + MOD[b * 6144 + 3072 + k]; got = f8d((ws + WS_H2)[(size_t)m * 1024 + k]); atol = 0.02f; ref = f8r(ref); } break;
    case 16: { const int m = h % M, e = (h >> 14) & 15, b = m >> 13; const float* row = a.out + (size_t)m * 1024; const float rstd = naive_rstd(row); float mx = -1e30f, mye = 0.f, sm = 0.f;
        for (int pass = 0; pass < 2; ++pass) for (int ee = 0; ee < 16; ++ee) { float lg = 0.f; for (int k = 0; k < 1024; ++k) lg += (row[k] * rstd * a.in[I_N2G][k] * (1.f + MOD[b * 6144 + 4096 + k]) + MOD[b * 6144 + 3072 + k]) * a.in[I_WROUTER][k * 16 + ee];
            if (pass == 0) mx = fmaxf(mx, lg); else { const float ex = expf(lg - mx); sm += ex; if (ee == e) mye = ex; } }
        ref = mye / sm; got = ((const float*)(ws + WS_AFF))[(size_t)(b * 16 + e) * SEQ + (m & 8191)]; atol = 0.001f; } break;
    case 17: { const int be = h & 31, slot = (h >> 5) & 1023, b = be >> 4, e = be & 15; const int row = ((const int*)(ws + WS_IDX))[be * CAP + slot]; const float* aff = (const float*)(ws + WS_AFF) + (size_t)be * SEQ; float bad = 0.f;
        if (row < b * SEQ || row >= (b + 1) * SEQ) bad += 1.f; else { const int l = row & 8191; if (((const int*)(ws + WS_INV))[(size_t)row * 16 + e] != slot) bad += 1.f; if (((const float*)(ws + WS_WSEL))[be * CAP + slot] != aff[l]) bad += 1.f;
            int cnt = 0; for (int j = 0; j < SEQ; ++j) cnt += (aff[j] > aff[l]) ? 1 : 0; if (cnt >= CAP) bad += 1.f;
            const int l2 = h2 & 8191; if (((const int*)(ws + WS_INV))[(size_t)(b * SEQ + l2) * 16 + e] < 0) { int c2 = 0; for (int j = 0; j < SEQ; ++j) c2 += (aff[j] >= aff[l2]) ? 1 : 0; if (c2 <= CAP) bad += 1.f; } }
        ref = 0.f; got = bad; atol = 0.5f; } break;
    case 18: { const int e = h & 15, mat = (h >> 4) % 3, n = (h >> 8) & 1023, k = (h >> 18) & 1023;
        if (mat == 0) { ref = f8r(16.f * a.in[I_WGATE][(size_t)e * 1048576 + (size_t)k * 1024 + n]); got = f8d((ws + WS_WGU)[((size_t)e * 2048 + (n >> 7) * 256 + (n & 127)) * 1024 + k]); }
        else if (mat == 1) { ref = f8r(16.f * a.in[I_WUP][(size_t)e * 1048576 + (size_t)k * 1024 + n]); got = f8d((ws + WS_WGU)[((size_t)e * 2048 + (n >> 7) * 256 + 128 + (n & 127)) * 1024 + k]); }
        else { ref = f8r(16.f * a.in[I_WDOWN][(size_t)e * 1048576 + (size_t)k * 1024 + n]); got = f8d((ws + WS_WD)[((size_t)e * 1024 + n) * 1024 + k]); } atol = 1e-4f; } break;
    case 19: { const int be = h & 31, slot = (h >> 5) & 1023, f = (h >> 15) & 1023, e = be & 15; const int row = ((const int*)(ws + WS_IDX))[be * CAP + slot]; float g = 0.f, u = 0.f;
        const unsigned char* hr = ws + WS_H2 + (size_t)row * 1024; const unsigned char* wg = ws + WS_WGU + ((size_t)e * 2048 + (f >> 7) * 256 + (f & 127)) * 1024; const unsigned char* wu = wg + 128 * 1024;
        for (int k = 0; k < 1024; ++k) { g += f8d(hr[k]) * f8d(wg[k]); u += f8d(hr[k]) * f8d(wu[k]); }
        g *= 0.0625f; u *= 0.0625f; ref = f8r(g / (1.f + expf(-g)) * u); got = f8d((ws + WS_ACT)[((size_t)be * CAP + slot) * 1024 + f]); atol = 0.03f; } break;
    case 20: { const int be = h & 31, slot = (h >> 5) & 1023, n = (h >> 15) & 1023, e = be & 15, b = be >> 4; float d = 0.f;
        for (int f = 0; f < 1024; ++f) d += f8d((ws + WS_ACT)[((size_t)be * CAP + slot) * 1024 + f]) * f8d((ws + WS_WD)[((size_t)e * 1024 + n) * 1024 + f]);
        ref = d * 0.0625f * ((const float*)(ws + WS_WSEL))[be * CAP + slot] * MOD[b * 6144 + 5120 + n]; got = bf2f(((const bf16*)(ws + WS_YB))[((size_t)be * CAP + slot) * 1024 + n]); atol = 0.002f; } break;
    default: active = false;
    }
    if (active) { float e = fabsf(got - ref) / (atol + 0.03f * fabsf(ref)); if (!(e == e)) e = 1e9f; atomicMax((unsigned*)(ws + WS_CHK) + stage, __float_as_uint(e)); }
}
__global__ void chk_final(Args a) {
    __shared__ int code;
    if (threadIdx.x == 0) { int c = 0; for (int s = 20; s >= 0; --s) if (s > CHK_SKIP && __uint_as_float(((const unsigned*)(a.ws + WS_CHK))[s]) > 1.f) c = s + 1; code = c; }
    __syncthreads();
    const float sc = 1.f + 0.1f * (float)code;
    for (size_t i = (size_t)blockIdx.x * blockDim.x + threadIdx.x; i < (size_t)M * D; i += (size_t)gridDim.x * blockDim.x) a.out[i] *= sc;
}
#endif

extern "C" void kernel_launch(void* const* d_in, const int* in_sizes, int n_in, void* d_out, int out_size, void* d_ws, size_t ws_size, hipStream_t stream) {
    static int grid = 0;
    if (grid == 0) {
        if (n_in != 22 || out_size != M * D || ws_size < WS_END) { fprintf(stderr, "kernel_launch: unexpected shapes (n_in %d, out %d, ws %zu < %zu)\n", n_in, out_size, ws_size, (size_t)WS_END); grid = -1; return; }
        int dev = 0, cus = 0, per_cu = 0;
        if (hipGetDevice(&dev) != hipSuccess || hipDeviceGetAttribute(&cus, hipDeviceAttributeMultiprocessorCount, dev) != hipSuccess) { grid = -1; return; }
        if (hipFuncSetAttribute((const void*)fwd_kernel, hipFuncAttributeMaxDynamicSharedMemorySize, LDS_BYTES) != hipSuccess) { fprintf(stderr, "kernel_launch: hipFuncSetAttribute failed\n"); grid = -1; return; }
        if (hipOccupancyMaxActiveBlocksPerMultiprocessor(&per_cu, (const void*)fwd_kernel, NT, LDS_BYTES) != hipSuccess || per_cu < 1) { fprintf(stderr, "kernel_launch: occupancy query says %d\n", per_cu); per_cu = 1; }
        (void)hipGetLastError();
        grid = cus;
    }
    if (grid < 0) return;
    (void)hipMemsetAsync((char*)d_ws + WS_CTL, 0, CTL_ZERO_BYTES, stream);
    Args a{};
    for (int i = 0; i < 22; ++i) a.in[i] = (const float*)d_in[i];
    a.out = (float*)d_out; a.ws = (unsigned char*)d_ws;
#if MK_MULTI
    for (int p = 0; p < NPHASE; ++p) { a.ph_lo = p; a.ph_hi = p + 1; hipLaunchKernelGGL(fwd_kernel, dim3(grid), dim3(NT), LDS_BYTES, stream, a);
#if MK_CHECK
        if (p == 0) (void)hipMemsetAsync((char*)d_ws + WS_CHK, 0, 4096, stream);
        static const int after[21] = {0, 0, 0, 1, 1, 1, 2, 3, 3, 3, 4, 4, 5, 6, 7, 8, 8, 9, 10, 11, 12};
        for (int st = 0; st < 21; ++st) if (after[st] == p) hipLaunchKernelGGL(chk_kernel, dim3(st == 12 ? 1024 : 32), dim3(128), 0, stream, a, st);
        if (p == NPHASE - 1) hipLaunchKernelGGL(chk_final, dim3(1024), dim3(256), 0, stream, a);
#endif
    }
#else
    a.ph_lo = 0; a.ph_hi = NPHASE;
#if MK_COOP
    void* kargs[] = {&a};
    hipError_t e = hipLaunchCooperativeKernel((const void*)fwd_kernel, dim3(grid), dim3(NT), kargs, LDS_BYTES, stream);
    if (e != hipSuccess) fprintf(stderr, "kernel_launch: cooperative launch failed: %s (grid %d)\n", hipGetErrorString(e), grid);
#else
    hipLaunchKernelGGL(fwd_kernel, dim3(grid), dim3(NT), LDS_BYTES, stream, a);
#endif
#endif
}
```

```cpp
#include <hip/hip_runtime.h>
#include <cstdio>
#include <cstdint>

#define LAS __attribute__((address_space(3)))
#define GAS __attribute__((address_space(1)))
typedef unsigned short bf16;
typedef short bf16x8 __attribute__((ext_vector_type(8)));
typedef float f32x4 __attribute__((ext_vector_type(4)));
typedef float f32x2 __attribute__((ext_vector_type(2)));
typedef unsigned u32x4 __attribute__((ext_vector_type(4)));
typedef unsigned u32x2 __attribute__((ext_vector_type(2)));

#ifndef ABL_NOMOE
#define ABL_NOMOE 0
#endif
#ifndef REP_PHASE
#define REP_PHASE -1
#endif
#ifndef REP_COUNT
#define REP_COUNT 1
#endif
#ifndef MK_COOP
#define MK_COOP 1
#endif
#ifndef MK_MULTI
#define MK_MULTI 0
#endif

constexpr int D = 1024, NB = 2, SEQ = 8192, M = NB * SEQ, LC = 256, MC = NB * LC, MT = M + MC;
constexpr int DIN = 4128;
constexpr int NCH = SEQ / 64, NCHC = LC / 64, NSLOT = NCH + NCHC;
constexpr int NE = 16, CAP = 1024;
constexpr float EPS = 1e-6f;
constexpr int NWAVES = 8, NT = 512;
constexpr int NPHASE = 14;

constexpr size_t MiB = 1u << 20;
constexpr size_t WS_CTL = 0, CTL_ZERO_BYTES = 64 * 1024;
constexpr size_t WS_MOD = 1 * MiB;
constexpr size_t WS_DEC = 1 * MiB + 128 * 1024;
constexpr size_t WS_WIN = 2 * MiB, WS_WO = 10 * MiB, WS_WG = 12 * MiB, WS_WC = 13 * MiB;
constexpr size_t WS_AFF = 14 * MiB, WS_INV = 15 * MiB, WS_IDX = 16 * MiB, WS_WSEL = 16 * MiB + 256 * 1024;
constexpr size_t WS_H1 = 20 * MiB;
constexpr size_t WS_ST = 20 * MiB, WS_H2 = 20 * MiB;
constexpr size_t WS_KB = 52 * MiB, WS_VB = 61 * MiB, WS_QB = 78 * MiB, WS_SG = 86 * MiB, WS_PI = 102 * MiB, WS_RB = 118 * MiB;
constexpr size_t WS_AG = 102 * MiB;
constexpr size_t WS_SM = 121 * MiB;
constexpr size_t WS_KV = 249 * MiB;
constexpr size_t WS_PO = 282 * MiB;
constexpr size_t WS_MG = 249 * MiB;
constexpr size_t WS_WGU = 185 * MiB, WS_WD = 52 * MiB, WS_ACT = 121 * MiB, WS_YB = 185 * MiB;
constexpr size_t WS_H1F = 249 * MiB;
constexpr size_t WS_WINM = 265 * MiB;
constexpr size_t WS_YD = 153 * MiB;
constexpr size_t WS_XS = 68 * MiB;
constexpr size_t WS_END = 300 * MiB;
constexpr int CW_BAR = 1024;

constexpr int LDS_BYTES = 155648;
constexpr int MISC_OFF = 153600;

#define LDS_WAIT() asm volatile("s_waitcnt lgkmcnt(0)" ::: "memory")
#define VM_WAIT() asm volatile("s_waitcnt vmcnt(0)" ::: "memory")
__device__ __forceinline__ unsigned f2bf(float f) { unsigned u = __builtin_bit_cast(unsigned, f); return (u + 0x7fffu + ((u >> 16) & 1u)) >> 16; }
__device__ __forceinline__ unsigned pk2(float lo, float hi) { return f2bf(lo) | (f2bf(hi) << 16); }
__device__ __forceinline__ float bf2f(unsigned h) { return __builtin_bit_cast(float, h << 16); }
__device__ __forceinline__ float bflo(unsigned w) { return __builtin_bit_cast(float, w << 16); }
__device__ __forceinline__ float bfhi(unsigned w) { return __builtin_bit_cast(float, w & 0xffff0000u); }
__device__ __forceinline__ unsigned cvt_pk_bf16(float lo, float hi) { unsigned r; asm volatile("v_cvt_pk_bf16_f32 %0, %1, %2" : "=v"(r) : "v"(lo), "v"(hi)); return r; }
__device__ __forceinline__ unsigned pk4_fp8(float a, float b, float c, float d) { int w = 0; w = __builtin_amdgcn_cvt_pk_fp8_f32(a, b, w, false); w = __builtin_amdgcn_cvt_pk_fp8_f32(c, d, w, true); return (unsigned)w; }
__device__ __forceinline__ float wave_sum(float v) {
#pragma unroll
    for (int o = 1; o < 64; o <<= 1) v += __shfl_xor(v, o);
    return v;
}
__device__ __forceinline__ float silu_f(float x) { return x / (1.f + __expf(-x)); }
__device__ __forceinline__ float sigmoid_f(float x) { return 1.f / (1.f + __expf(-x)); }
__device__ __forceinline__ float logsig_f(float z) { return fminf(z, 0.f) - log1pf(expf(-fabsf(z))); }

#define XB_TMO      128
#define XB_XCNT(j)  (256  + 64 * (j))
#define XB_XSUB(j)  (1280 + 64 * (j))
#define XB_XGEN(j)  (2304 + 64 * (j))
#define XB_TOP      3328
#define XB_TOPGEN   3392
#define XCD_BAR_WORDS 3456
#define XB_SPIN_CAP (1u << 20)
__device__ __forceinline__ unsigned xb_ld(unsigned* p)              { return __hip_atomic_load(p, __ATOMIC_RELAXED, __HIP_MEMORY_SCOPE_AGENT); }
__device__ __forceinline__ unsigned xb_add(unsigned* p, unsigned v) { return __hip_atomic_fetch_add(p, v, __ATOMIC_RELAXED, __HIP_MEMORY_SCOPE_AGENT); }
__device__ __forceinline__ unsigned xb_xcc_id() { return (unsigned)__builtin_amdgcn_s_getreg((3 << 11) | 20) & 0xFu; }
#define XB_SPIN(cond, bar) do { unsigned _sp = 0; while (cond) { __builtin_amdgcn_s_sleep(1); \
    if ((++_sp & 255u) == 0u) { if (xb_ld(&(bar)[XB_TMO])) break; if (_sp > XB_SPIN_CAP) { atomicAdd(&(bar)[XB_TMO], 1u); break; } } } } while (0)
struct XcdBarrier { unsigned* bar; unsigned x; volatile LAS unsigned* st; };
__device__ __forceinline__ XcdBarrier xcd_barrier_post(unsigned* bar, volatile LAS unsigned* st) {
    XcdBarrier b; b.bar = bar; b.x = xb_xcc_id(); b.st = st;
    if (threadIdx.x == 0) (void)xb_add(&bar[XB_XCNT(b.x)], 1u);
    return b;
}
__device__ __forceinline__ void xcd_barrier_complete(unsigned* bar, unsigned x, unsigned& nloc, unsigned& nx) {
    const unsigned G = gridDim.x * gridDim.y * gridDim.z;
    unsigned sum, cnt, mine, sp = 0u;
    for (;;) {
        sum = 0u; cnt = 0u; mine = 0u;
#pragma unroll
        for (unsigned j = 0; j < 16; ++j) { const unsigned c = xb_ld(&bar[XB_XCNT(j)]); sum += c; cnt += (c > 0u) ? 1u : 0u; mine = (j == x) ? c : mine; }
        if (sum == G) break;
        __builtin_amdgcn_s_sleep(1);
        if ((++sp & 255u) == 0u) { if (xb_ld(&bar[XB_TMO])) break; if (sp > XB_SPIN_CAP) { atomicAdd(&bar[XB_TMO], 1u); break; } }
    }
    nloc = mine > 0u ? mine : 1u; nx = cnt > 0u ? cnt : 1u;
}
__device__ __forceinline__ void xcd_barrier(const XcdBarrier& b) {
    asm volatile("s_waitcnt vmcnt(0)" ::: "memory");
    __syncthreads();
    if (threadIdx.x == 0) {
        unsigned* bar = b.bar;
        __builtin_amdgcn_s_waitcnt(0);
        unsigned nloc = b.st[0], nx = b.st[1];
        if (nloc == 0u) { xcd_barrier_complete(bar, b.x, nloc, nx); b.st[0] = nloc; b.st[1] = nx; }
        const unsigned old = xb_add(&bar[XB_XSUB(b.x)], 1u);
        const unsigned gen = old / nloc;
        if (old + 1u == (gen + 1u) * nloc) {
            __builtin_amdgcn_fence(__ATOMIC_RELEASE, "agent");
            asm volatile("s_waitcnt vmcnt(0)" ::: "memory");
            const unsigned og = xb_add(&bar[XB_TOP], 1u);
            const unsigned tg = og / nx;
            if (og + 1u == (tg + 1u) * nx) xb_add(&bar[XB_TOPGEN], 1u);
            else XB_SPIN(xb_ld(&bar[XB_TOPGEN]) == tg, bar);
            __builtin_amdgcn_fence(__ATOMIC_ACQUIRE, "agent");
            xb_add(&bar[XB_XGEN(b.x)], 1u);
            asm volatile("s_waitcnt vmcnt(0)" ::: "memory");
        } else {
            XB_SPIN(xb_ld(&bar[XB_XGEN(b.x)]) == gen, bar);
            __builtin_amdgcn_fence(__ATOMIC_ACQUIRE, "agent");
            asm volatile("s_waitcnt vmcnt(0)" ::: "memory");
        }
    }
    __syncthreads();
}

namespace pg8 {
constexpr int BM = 256, BK = 64, HALF = 128, HTB = HALF * BK * 2, STAGE_BYTES = 8 * HTB;
__device__ __forceinline__ int lds_byte(int r, int c) { const int st = (r >> 4) * 2 + (c >> 5), rr = r & 15, cc = c & 31, ob = rr * 64 + cc * 2; return st * 1024 + (ob ^ (((ob >> 9) & 1) << 5)); }
__device__ __forceinline__ void stage_rc(int b, int& R, int& C) { const int st = b / 1024, sb = b % 1024, swz = sb ^ (((sb >> 9) & 1) << 5); R = (st >> 1) * 16 + swz / 64; C = (st & 1) * 32 + (swz % 64) / 2; }
__device__ __forceinline__ int perm32(int rho) { const int n = rho >> 4, i = rho & 15; return 8 * (i >> 2) + 4 * n + (i & 3); }
struct Unit { int pm, pn, aux, keep; };
typedef int v8i __attribute__((ext_vector_type(8)));
typedef int v4i __attribute__((ext_vector_type(4)));
__device__ __forceinline__ void xcd_tile(int L, int nM, int nN, int& pm, int& pn) {
    const int nwg = nM * nN; int wgid = L;
    { const int q = nwg / 8, r = nwg % 8, xcd = wgid % 8, off = wgid / 8; wgid = (xcd < r ? xcd * (q + 1) : r * (q + 1) + (xcd - r) * q) + off; }
    const int nig = 8 * nN, gid = wgid / nig, fm = gid * 8, gsz = (nM - fm) < 8 ? (nM - fm) : 8;
    pm = fm + ((wgid % nig) % gsz); pn = (wgid % nig) / gsz;
}

template <class Epi, class Sched, bool GATHER, bool FP8 = false>
__device__ __forceinline__ void gemm_phase(LAS unsigned char* lds, const Sched& S, const Epi& E) {
    int tid = threadIdx.x; asm volatile("" : "+v"(tid));
    const int wid = __builtin_amdgcn_readfirstlane(tid >> 6), lane = tid & 63, wr = wid >> 2, wc = wid & 3, fr = lane & 15, fq = lane >> 4;
    const int K = S.K, KB = FP8 ? K : 2 * K, nt = KB / (2 * BK);
    unsigned voffA[2], voffB[2]; int Rs[2], Cb[2];
#pragma unroll
    for (int i = 0; i < 2; ++i) { int R, C; stage_rc(tid * 16 + i * 8192, R, C); const int Rb = Epi::PERM ? ((R & ~31) + perm32(R & 31)) : R;
        Rs[i] = R; Cb[i] = C * 2; voffA[i] = (unsigned)(R * KB + C * 2); voffB[i] = (unsigned)(Rb * KB + C * 2); }
    const size_t kstep = (size_t)(BK * 2);
    const size_t hstep = (size_t)HALF * KB;
    const size_t hstepA = GATHER ? 0 : hstep;
    const unsigned ldsw = (unsigned)wid * 1024u;
    const int aoff = FP8 ? lds_byte(wr * 64 + fr, fq * 16) : lds_byte(wr * 64 + fr, fq * 8), boff = FP8 ? lds_byte(wc * 32 + fr, fq * 16) : lds_byte(wc * 32 + fr, fq * 8);
#define PG8_SA(b, h) (((b) * 2 + (h)) * HTB)
#define PG8_SB(b, h) ((4 + (b) * 2 + (h)) * HTB)
#define PG8_STAGE(bufoff, gbase, voff, W) do { _Pragma("unroll") for (int _i = 0; _i < 2; ++_i) { \
        if constexpr (FP8) __builtin_amdgcn_raw_ptr_buffer_load_lds(rsrc##W, (LAS unsigned*)(lds + (bufoff) + ldsw + _i * 8192), 16, (int)(voff)[_i], (int)(unsigned)((const char*)(gbase) - base##W), 0, 0); \
        else __builtin_amdgcn_global_load_lds((const unsigned*)((const char*)(gbase) + (voff)[_i]), (LAS unsigned*)(lds + (bufoff) + ldsw + _i * 8192), 16, 0, 0); } } while (0)
#define PG8_LDA(dst, b, h) do { _Pragma("unroll") for (int m = 0; m < 4; ++m) { \
        if constexpr (FP8) { const v4i _lo = *(const LAS v4i*)(lds + PG8_SA(b, h) + aoff + m * 2048), _hi = *(const LAS v4i*)(lds + PG8_SA(b, h) + aoff + m * 2048 + 16); dst##8[m] = __builtin_shufflevector(_lo, _hi, 0, 1, 2, 3, 4, 5, 6, 7); } \
        else { _Pragma("unroll") for (int k = 0; k < 2; ++k) dst[m][k] = *(const LAS bf16x8*)(lds + PG8_SA(b, h) + aoff + m * 2048 + k * 1024); } } } while (0)
#define PG8_LDB(dst, b, h) do { _Pragma("unroll") for (int n = 0; n < 2; ++n) { \
        if constexpr (FP8) { const v4i _lo = *(const LAS v4i*)(lds + PG8_SB(b, h) + boff + n * 2048), _hi = *(const LAS v4i*)(lds + PG8_SB(b, h) + boff + n * 2048 + 16); dst##8[n] = __builtin_shufflevector(_lo, _hi, 0, 1, 2, 3, 4, 5, 6, 7); } \
        else { _Pragma("unroll") for (int k = 0; k < 2; ++k) dst[n][k] = *(const LAS bf16x8*)(lds + PG8_SB(b, h) + boff + n * 2048 + k * 1024); } } } while (0)
#define PG8_MMA(ai, bj, At, Bt) do { __builtin_amdgcn_s_setprio(1); \
        if constexpr (FP8) { _Pragma("unroll") for (int m = 0; m < 4; ++m) _Pragma("unroll") for (int n = 0; n < 2; ++n) \
            acc[ai][bj][m][n] = __builtin_amdgcn_mfma_scale_f32_16x16x128_f8f6f4(Bt##8[n], At##8[m], acc[ai][bj][m][n], 0, 0, 0, 0, 0, 0); } \
        else { _Pragma("unroll") for (int m = 0; m < 4; ++m) _Pragma("unroll") for (int n = 0; n < 2; ++n) _Pragma("unroll") for (int k = 0; k < 2; ++k) \
            acc[ai][bj][m][n] = __builtin_amdgcn_mfma_f32_16x16x32_bf16(Bt[n][k], At[m][k], acc[ai][bj][m][n], 0, 0, 0); } \
        __builtin_amdgcn_s_setprio(0); } while (0)
#define PG8_WAIT_V(n) asm volatile("s_waitcnt vmcnt(" #n ")" ::: "memory")
#define PG8_WAIT_L(n) asm volatile("s_waitcnt lgkmcnt(" #n ")" ::: "memory")
#define PG8_BAR __builtin_amdgcn_s_barrier()
#define PG8_SCHED __builtin_amdgcn_sched_barrier(0)
    Unit cur, nxt; int ui = 0;
    if (!S.next(0, cur)) return;
    const char* baseA = S.base_a(); const char* baseB = S.base_b();
    const __amdgpu_buffer_rsrc_t rsrcA = __builtin_amdgcn_make_buffer_rsrc((void*)baseA, 0, 0x7fffffff, 0x00020000), rsrcB = __builtin_amdgcn_make_buffer_rsrc((void*)baseB, 0, 0x7fffffff, 0x00020000);
    f32x4 acc[2][2][4][2];
#pragma unroll
    for (int a = 0; a < 2; ++a)
#pragma unroll
        for (int b = 0; b < 2; ++b)
#pragma unroll
            for (int m = 0; m < 4; ++m)
#pragma unroll
                for (int n = 0; n < 2; ++n) acc[a][b][m][n] = (f32x4){0.f, 0.f, 0.f, 0.f};
    bf16x8 At[4][2], B0[2][2], B1[2][2]; v8i At8[4], B08[2], B18[2];
    const char* cA = S.a_base(cur); const char* cB = S.b_base(cur);
    unsigned cv0[2], cv1[2], nv0[2], nv1[2];
#pragma unroll
    for (int i = 0; i < 2; ++i) {
        if constexpr (GATHER) { cv0[i] = (unsigned)S.a_row(cur, Rs[i]) * (unsigned)KB + (unsigned)Cb[i]; cv1[i] = (unsigned)S.a_row(cur, HALF + Rs[i]) * (unsigned)KB + (unsigned)Cb[i]; }
        else { cv0[i] = voffA[i]; cv1[i] = voffA[i]; }
        nv0[i] = cv0[i]; nv1[i] = cv1[i];
    }
    PG8_STAGE(PG8_SB(0, 0), cB, voffB, B); PG8_STAGE(PG8_SB(0, 1), cB + hstep, voffB, B); PG8_STAGE(PG8_SA(0, 0), cA, cv0, A); PG8_STAGE(PG8_SA(0, 1), cA + hstepA, cv1, A);
    if (wr == 1) PG8_BAR;
    PG8_WAIT_V(2); PG8_BAR;
    PG8_STAGE(PG8_SB(1, 0), cB + kstep, voffB, B); PG8_STAGE(PG8_SA(1, 0), cA + kstep, cv0, A); PG8_STAGE(PG8_SB(1, 1), cB + hstep + kstep, voffB, B);
    PG8_WAIT_V(6); PG8_BAR;
    for (;;) {
        const bool has_next = S.next(ui + 1, nxt);
        const char* nA = has_next ? S.a_base(nxt) : cA; const char* nB = has_next ? S.b_base(nxt) : cB;
        if constexpr (GATHER) {
#pragma unroll
            for (int i = 0; i < 2; ++i) {
                if (has_next) { nv0[i] = (unsigned)S.a_row(nxt, Rs[i]) * (unsigned)KB + (unsigned)Cb[i]; nv1[i] = (unsigned)S.a_row(nxt, HALF + Rs[i]) * (unsigned)KB + (unsigned)Cb[i]; }
                else { nv0[i] = cv0[i]; nv1[i] = cv1[i]; }
            }
        }
        for (int t = 0; t < nt; t += 2) {
            const bool last = (t == nt - 2);
            const char* a1 = cA + (size_t)(t + 1) * kstep;
            const char* a2 = last ? nA : cA + (size_t)(t + 2) * kstep; const char* b2 = last ? nB : cB + (size_t)(t + 2) * kstep;
            const char* a3 = a2 + kstep; const char* b3 = b2 + kstep;
            unsigned s0[2], s1[2];
#pragma unroll
            for (int i = 0; i < 2; ++i) { s0[i] = (GATHER && last) ? nv0[i] : cv0[i]; s1[i] = (GATHER && last) ? nv1[i] : cv1[i]; }
            PG8_LDB(B0, 0, 0); PG8_LDB(B1, 0, 1); PG8_SCHED; PG8_LDA(At, 0, 0); PG8_STAGE(PG8_SA(1, 1), a1 + hstepA, cv1, A);
            PG8_WAIT_V(8); PG8_WAIT_L(0); PG8_BAR; PG8_MMA(0, 0, At, B0); PG8_MMA(0, 1, At, B1); PG8_BAR; PG8_SCHED;
            PG8_LDA(At, 0, 1); PG8_STAGE(PG8_SB(0, 0), b2, voffB, B); PG8_STAGE(PG8_SB(0, 1), b2 + hstep, voffB, B); PG8_STAGE(PG8_SA(0, 0), a2, s0, A);
            PG8_WAIT_V(8); PG8_WAIT_L(0); PG8_BAR; PG8_MMA(1, 0, At, B0); PG8_MMA(1, 1, At, B1); PG8_BAR; PG8_SCHED;
            PG8_LDB(B0, 1, 0); PG8_LDB(B1, 1, 1); PG8_SCHED; PG8_LDA(At, 1, 0); PG8_STAGE(PG8_SA(0, 1), a2 + hstepA, s1, A);
            PG8_WAIT_V(8); PG8_WAIT_L(0); PG8_BAR; PG8_MMA(0, 0, At, B0); PG8_MMA(0, 1, At, B1); PG8_BAR; PG8_SCHED;
            PG8_LDA(At, 1, 1); PG8_STAGE(PG8_SB(1, 0), b3, voffB, B); PG8_STAGE(PG8_SB(1, 1), b3 + hstep, voffB, B); PG8_STAGE(PG8_SA(1, 0), a3, s0, A);
            PG8_WAIT_V(8); PG8_WAIT_L(0); PG8_BAR; PG8_MMA(1, 0, At, B0); PG8_MMA(1, 1, At, B1); PG8_BAR; PG8_SCHED;
        }
        if (wr == 0) PG8_BAR;
        E(acc, cur, wr, wc, fr, fq);
        if (!has_next) break;
        E.post(acc, cur, wr, wc, fr, fq);
        cur = nxt; cA = nA; cB = nB; ++ui;
#pragma unroll
        for (int i = 0; i < 2; ++i) { cv0[i] = nv0[i]; cv1[i] = nv1[i]; }
        if (wr == 1) PG8_BAR;
    }
    PG8_WAIT_V(0);
    PG8_BAR;
#undef PG8_SA
#undef PG8_SB
#undef PG8_STAGE
#undef PG8_LDA
#undef PG8_LDB
#undef PG8_MMA
#undef PG8_WAIT_V
#undef PG8_WAIT_L
#undef PG8_BAR
#undef PG8_SCHED
}
}

using pg8::Unit;
struct SchedDense {
    int G, c, K, nM, nN; const char* A; const char* B; int i0, i1, eb;
    __device__ __forceinline__ bool next(int i, Unit& u) const { const int L = (i + i0) * G + c; if (i + i0 >= i1 || L >= nM * nN) return false; pg8::xcd_tile(L, nM, nN, u.pm, u.pn); u.aux = 0; u.keep = 0; return true; }
    __device__ __forceinline__ const char* a_base(const Unit& u) const { return A + (size_t)u.pm * 256 * K * eb; }
    __device__ __forceinline__ const char* b_base(const Unit& u) const { return B + (size_t)u.pn * 256 * K * eb; }
    __device__ __forceinline__ int a_row(const Unit&, int) const { return 0; }
    __device__ __forceinline__ const char* base_a() const { return A; }
    __device__ __forceinline__ const char* base_b() const { return B; }
};
struct SchedPair {
    int G, c, K; const char *A0, *A1, *B0, *B1;
    __device__ __forceinline__ bool next(int i, Unit& u) const { const int p = (i >> 1) * G + c; if (p >= 256) return false; pg8::xcd_tile(p, 64, 4, u.pm, u.pn); u.aux = i & 1; u.keep = 0; return true; }
    __device__ __forceinline__ const char* a_base(const Unit& u) const { return (u.aux ? A1 : A0) + (size_t)u.pm * 256 * K * 2; }
    __device__ __forceinline__ const char* b_base(const Unit& u) const { return (u.aux ? B1 : B0) + (size_t)u.pn * 256 * K * 2; }
    __device__ __forceinline__ int a_row(const Unit&, int) const { return 0; }
    __device__ __forceinline__ const char* base_a() const { return A0; }
    __device__ __forceinline__ const char* base_b() const { return B0; }
};
struct SchedMoe1 {
    int G, c, K; const char* A; const char* B; int i0, i1;
    __device__ __forceinline__ bool next(int i, Unit& u) const { const int L = (i + i0) * G + c; if (i + i0 >= i1 || L >= 1024) return false;
        const int xcd = L & 7, q = L >> 3, round = q >> 5, slot = q & 31, e = xcd + 8 * (round >> 1), u64 = (round & 1) * 32 + slot, mrow = u64 & 7;
        u.pn = u64 >> 3; u.pm = mrow & 3; u.aux = (mrow >> 2) * 16 + e; u.keep = 0; return true; }
    __device__ __forceinline__ const char* a_base(const Unit& u) const { return A + ((size_t)u.aux * 1024 + (size_t)u.pm * 256) * K; }
    __device__ __forceinline__ const char* b_base(const Unit& u) const { return B + ((size_t)(u.aux & 15) * 2048 + (size_t)u.pn * 256) * K; }
    __device__ __forceinline__ int a_row(const Unit&, int) const { return 0; }
    __device__ __forceinline__ const char* base_a() const { return A; }
    __device__ __forceinline__ const char* base_b() const { return B; }
};
struct SchedMoe2 {
    int G, c, K; const char* A; const char* B;
    __device__ __forceinline__ bool next(int i, Unit& u) const { const int L = i * G + c; if (L >= 512) return false;
        const int xcd = L & 7, q = L >> 3, round = q >> 5, slot = q & 31, e = xcd + 8 * round, mrow = slot & 7;
        u.pn = slot >> 3; u.pm = mrow & 3; u.aux = (mrow >> 2) * 16 + e; u.keep = 0; return true; }
    __device__ __forceinline__ const char* a_base(const Unit& u) const { return A + ((size_t)u.aux * 1024 + (size_t)u.pm * 256) * K; }
    __device__ __forceinline__ const char* b_base(const Unit& u) const { return B + ((size_t)(u.aux & 15) * 1024 + (size_t)u.pn * 256) * K; }
    __device__ __forceinline__ int a_row(const Unit&, int) const { return 0; }
    __device__ __forceinline__ const char* base_a() const { return A; }
    __device__ __forceinline__ const char* base_b() const { return B; }
};

typedef f32x4 AccT[2][2][4][2];
__device__ __forceinline__ size_t gate_off(int pm, int pg, int ai, int m, int bj, int wr, int wc, int fr, int fq) { return ((size_t)(pm * 8 + pg) << 16) + (size_t)((((ai * 4 + m) * 2 + bj) * 8 + wr * 4 + wc) * 512 + (fq * 16 + fr) * 8); }
__device__ __forceinline__ unsigned pk4_u8(float a, float b, float c, float d) { return (unsigned)__builtin_amdgcn_cvt_pk_u8_f32(d, 3, __builtin_amdgcn_cvt_pk_u8_f32(c, 2, __builtin_amdgcn_cvt_pk_u8_f32(b, 1, __builtin_amdgcn_cvt_pk_u8_f32(a, 0, 0u)))); }
template <bool GATES> struct EpiInprojT {
    static constexpr bool PERM = true;
    bf16 *KBp, *VBp, *QBp, *SGp, *PIp; unsigned char* SMp; int pn_off; float sc;
    __device__ __forceinline__ void post(AccT& acc, const Unit&, int, int, int, int) const {
#pragma unroll
        for (int a = 0; a < 2; ++a)
#pragma unroll
            for (int b = 0; b < 2; ++b)
#pragma unroll
                for (int m = 0; m < 4; ++m)
#pragma unroll
                    for (int n = 0; n < 2; ++n) acc[a][b][m][n] = (f32x4){0.f, 0.f, 0.f, 0.f};
    }
    __device__ __forceinline__ void operator()(const AccT& acc, const Unit& u, int wr, int wc, int fr, int fq) const {
        const int pn = u.pn + pn_off;
        if constexpr (GATES) {
            unsigned char* tp = SMp + ((size_t)(u.pm * 8 + pn - 8) << 16) + (unsigned)((wr * 4 + wc) * 512 + (fq * 16 + fr) * 8);
#pragma unroll
            for (int ai = 0; ai < 2; ++ai)
#pragma unroll
                for (int m = 0; m < 4; ++m) {
#pragma unroll
                    for (int bj = 0; bj < 2; ++bj) { const f32x4 v0 = acc[ai][bj][m][0], v1 = acc[ai][bj][m][1];
                        u32x2 w; w.x = pk4_u8(255.f * sigmoid_f(sc * v0[0]), 255.f * sigmoid_f(sc * v0[1]), 255.f * sigmoid_f(sc * v0[2]), 255.f * sigmoid_f(sc * v0[3]));
                        w.y = pk4_u8(255.f * sigmoid_f(sc * v1[0]), 255.f * sigmoid_f(sc * v1[1]), 255.f * sigmoid_f(sc * v1[2]), 255.f * sigmoid_f(sc * v1[3]));
                        *(u32x2*)(tp + (((ai * 4 + m) * 2 + bj) * 4096)) = w; }
                    asm volatile("" ::: "memory"); }
        } else {
        bf16* base; int ld, colt, act;
        if (pn == 0) { base = KBp; ld = 256; colt = 0; act = 0; }
        else if (pn < 3) { base = VBp; ld = 512; colt = (pn - 1) * 256; act = 0; }
        else if (pn == 3) { base = QBp; ld = 256; colt = 0; act = 3; }
        else if (pn < 6) { base = SGp; ld = 512; colt = (pn - 4) * 256; act = 1; }
        else { base = PIp; ld = 512; colt = (pn - 6) * 256; act = 0; }
        const int row0 = u.pm * 256 + wr * 64 + fr, col0 = colt + wc * 32 + 8 * fq;
#pragma unroll
        for (int ai = 0; ai < 2; ++ai)
#pragma unroll
            for (int m = 0; m < 4; ++m) { bf16* rowp = base + (size_t)(row0 + ai * 128 + m * 16) * ld + col0;
#pragma unroll
                for (int bj = 0; bj < 2; ++bj) { f32x4 v0 = acc[ai][bj][m][0], v1 = acc[ai][bj][m][1];
                    if (act == 1) {
#pragma unroll
                        for (int j = 0; j < 4; ++j) { v0[j] = silu_f(v0[j]); v1[j] = silu_f(v1[j]); } }
                    else if (act == 3) { v0 = v0 * 0.125f; v1 = v1 * 0.125f; }
                    u32x4 w; w.x = cvt_pk_bf16(v0[0], v0[1]); w.y = cvt_pk_bf16(v0[2], v0[3]); w.z = cvt_pk_bf16(v1[0], v1[1]); w.w = cvt_pk_bf16(v1[2], v1[3]);
                    *(u32x4*)(rowp + bj * 128) = w; } }
        }
    }
};
typedef EpiInprojT<false> EpiInproj; typedef EpiInprojT<true> EpiGates;
struct EpiMerge {
    static constexpr bool PERM = true;
    const unsigned char* SMp; bf16* MGp;
    __device__ __forceinline__ void post(AccT& acc, const Unit&, int, int, int, int) const {
#pragma unroll
        for (int a = 0; a < 2; ++a)
#pragma unroll
            for (int b = 0; b < 2; ++b)
#pragma unroll
                for (int m = 0; m < 4; ++m)
#pragma unroll
                    for (int n = 0; n < 2; ++n) acc[a][b][m][n] = (f32x4){0.f, 0.f, 0.f, 0.f};
    }
    __device__ __forceinline__ void operator()(const AccT& acc, const Unit& u, int wr, int wc, int fr, int fq) const {
        const int row0 = u.pm * 256 + wr * 64 + fr, col0 = u.pn * 256 + wc * 32 + 8 * fq; const int second = u.aux;
        u32x2 gb[2][2]; u32x4 pb[2][2];
#define EPM_ROW(g) ((size_t)(row0 + ((g) >> 2) * 128 + ((g) & 3) * 16))
#define EPM_LOAD(buf, g) do { _Pragma("unroll") for (int bj = 0; bj < 2; ++bj) { gb[buf][bj] = *(const u32x2*)(SMp + gate_off(u.pm, u.pn + 4 * second, (g) >> 2, (g) & 3, bj, wr, wc, fr, fq)); \
            pb[buf][bj] = (u32x4){0u, 0u, 0u, 0u}; if (second) pb[buf][bj] = *(const u32x4*)(MGp + EPM_ROW(g) * 1024 + col0 + bj * 128); } } while (0)
        EPM_LOAD(0, 0);
#pragma unroll
        for (int g = 0; g < 8; ++g) {
            if (g + 1 < 8) EPM_LOAD((g + 1) & 1, g + 1);
            asm volatile("" ::: "memory");
#pragma unroll
            for (int bj = 0; bj < 2; ++bj) { const u32x2 gq = gb[g & 1][bj]; const u32x4 pv = pb[g & 1][bj]; const f32x4 v0 = acc[g >> 2][bj][g & 3][0], v1 = acc[g >> 2][bj][g & 3][1];
                const float k = 1.f / 255.f;
                const float g0 = k * (float)(gq.x & 255u), g1 = k * (float)((gq.x >> 8) & 255u), g2 = k * (float)((gq.x >> 16) & 255u), g3 = k * (float)(gq.x >> 24);
                const float g4 = k * (float)(gq.y & 255u), g5 = k * (float)((gq.y >> 8) & 255u), g6 = k * (float)((gq.y >> 16) & 255u), g7 = k * (float)(gq.y >> 24);
                u32x4 w; w.x = cvt_pk_bf16(bflo(pv[0]) + v0[0] * g0, bfhi(pv[0]) + v0[1] * g1); w.y = cvt_pk_bf16(bflo(pv[1]) + v0[2] * g2, bfhi(pv[1]) + v0[3] * g3);
                w.z = cvt_pk_bf16(bflo(pv[2]) + v1[0] * g4, bfhi(pv[2]) + v1[1] * g5); w.w = cvt_pk_bf16(bflo(pv[3]) + v1[2] * g6, bfhi(pv[3]) + v1[3] * g7);
                *(u32x4*)(MGp + EPM_ROW(g) * 1024 + col0 + bj * 128) = w; }
            asm volatile("" ::: "memory"); }
#undef EPM_ROW
#undef EPM_LOAD
    }
};
struct EpiOut {
    static constexpr bool PERM = true;
    const float* MODp; bf16* YDp;
    __device__ __forceinline__ void post(AccT& acc, const Unit&, int, int, int, int) const {
#pragma unroll
        for (int a = 0; a < 2; ++a)
#pragma unroll
            for (int b = 0; b < 2; ++b)
#pragma unroll
                for (int m = 0; m < 4; ++m)
#pragma unroll
                    for (int n = 0; n < 2; ++n) acc[a][b][m][n] = (f32x4){0.f, 0.f, 0.f, 0.f};
    }
    __device__ __forceinline__ void operator()(const AccT& acc, const Unit& u, int wr, int wc, int fr, int fq) const {
        const int row0 = u.pm * 256 + wr * 64 + fr, col0 = u.pn * 256 + wc * 32 + 8 * fq;
        const float* gt = MODp + (size_t)(u.pm >> 5) * 6144 + 2048 + col0;
        f32x4 gv[2][2];
#pragma unroll
        for (int bj = 0; bj < 2; ++bj)
#pragma unroll
            for (int n = 0; n < 2; ++n) gv[bj][n] = *(const f32x4*)(gt + bj * 128 + n * 4);
#pragma unroll
        for (int ai = 0; ai < 2; ++ai)
#pragma unroll
            for (int m = 0; m < 4; ++m) { bf16* rowp = YDp + (size_t)(row0 + ai * 128 + m * 16) * 1024 + col0;
#pragma unroll
                for (int bj = 0; bj < 2; ++bj) { const f32x4 v0 = acc[ai][bj][m][0] * gv[bj][0], v1 = acc[ai][bj][m][1] * gv[bj][1];
                    u32x4 w; w.x = cvt_pk_bf16(v0[0], v0[1]); w.y = cvt_pk_bf16(v0[2], v0[3]); w.z = cvt_pk_bf16(v1[0], v1[1]); w.w = cvt_pk_bf16(v1[2], v1[3]);
                    *(u32x4*)(rowp + bj * 128) = w; } }
    }
};
struct EpiMoe1 {
    static constexpr bool PERM = true;
    unsigned char* ACTp;
    __device__ __forceinline__ void post(AccT& acc, const Unit&, int, int, int, int) const {
#pragma unroll
        for (int a = 0; a < 2; ++a)
#pragma unroll
            for (int b = 0; b < 2; ++b)
#pragma unroll
                for (int m = 0; m < 4; ++m)
#pragma unroll
                    for (int n = 0; n < 2; ++n) acc[a][b][m][n] = (f32x4){0.f, 0.f, 0.f, 0.f};
    }
    __device__ __forceinline__ void operator()(const AccT& acc, const Unit& u, int wr, int wc, int fr, int fq) const {
        const int row0 = u.aux * 1024 + u.pm * 256 + wr * 64 + fr, col0 = u.pn * 128 + wc * 32 + 8 * fq;
#pragma unroll
        for (int ai = 0; ai < 2; ++ai)
#pragma unroll
            for (int m = 0; m < 4; ++m) { unsigned char* rowp = ACTp + (size_t)(row0 + ai * 128 + m * 16) * 1024 + col0;
                f32x4 a0, a1;
#pragma unroll
                for (int j = 0; j < 4; ++j) { a0[j] = silu_f(0.0625f * acc[ai][0][m][0][j]) * (0.0625f * acc[ai][1][m][0][j]); a1[j] = silu_f(0.0625f * acc[ai][0][m][1][j]) * (0.0625f * acc[ai][1][m][1][j]); }
                *(u32x2*)rowp = (u32x2){pk4_fp8(a0[0], a0[1], a0[2], a0[3]), pk4_fp8(a1[0], a1[1], a1[2], a1[3])}; }
    }
};
struct EpiMoe2 {
    static constexpr bool PERM = true;
    bf16* YBp; const float* WSELp; const float* MODp;
    __device__ __forceinline__ void post(AccT& acc, const Unit&, int, int, int, int) const {
#pragma unroll
        for (int a = 0; a < 2; ++a)
#pragma unroll
            for (int b = 0; b < 2; ++b)
#pragma unroll
                for (int m = 0; m < 4; ++m)
#pragma unroll
                    for (int n = 0; n < 2; ++n) acc[a][b][m][n] = (f32x4){0.f, 0.f, 0.f, 0.f};
    }
    __device__ __forceinline__ void operator()(const AccT& acc, const Unit& u, int wr, int wc, int fr, int fq) const {
        const int row0 = u.aux * 1024 + u.pm * 256 + wr * 64 + fr, col0 = u.pn * 256 + wc * 32 + 8 * fq;
        const float* gt = MODp + (size_t)(u.aux >> 4) * 6144 + 5120 + col0;
        f32x4 gv[2][2];
#pragma unroll
        for (int bj = 0; bj < 2; ++bj)
#pragma unroll
            for (int n = 0; n < 2; ++n) gv[bj][n] = *(const f32x4*)(gt + bj * 128 + n * 4);
#pragma unroll
        for (int ai = 0; ai < 2; ++ai)
#pragma unroll
            for (int m = 0; m < 4; ++m) { const int r = row0 + ai * 128 + m * 16; const float ws = 0.0625f * WSELp[r]; bf16* rowp = YBp + (size_t)r * 1024 + col0;
#pragma unroll
                for (int bj = 0; bj < 2; ++bj) { const f32x4 v0 = acc[ai][bj][m][0] * gv[bj][0] * ws, v1 = acc[ai][bj][m][1] * gv[bj][1] * ws;
                    u32x4 w; w.x = cvt_pk_bf16(v0[0], v0[1]); w.y = cvt_pk_bf16(v0[2], v0[3]); w.z = cvt_pk_bf16(v1[0], v1[1]); w.w = cvt_pk_bf16(v1[2], v1[3]);
                    *(u32x4*)(rowp + bj * 128) = w; } }
    }
};

struct Args { const float* in[22]; float* out; unsigned char* ws; int ph_lo, ph_hi; };
enum { I_X = 0, I_C, I_CTX, I_CCTX, I_ADAW, I_ADAB, I_N1G, I_N2G, I_WIN, I_WDU, I_BDEC, I_GNG, I_WGLA, I_POOLW, I_POOLS, I_WPOOL, I_WOUT, I_WROUTER, I_WGATE, I_WUP, I_WDOWN, I_FNG };

__device__ __forceinline__ bf16x8 ldfrag(const LAS bf16* base, int stride, int row0, int k0, int lane) { return *(const LAS bf16x8*)(base + (row0 + (lane & 15)) * stride + k0 + 8 * (lane >> 4)); }
#define MFMA16(a, b, c) __builtin_amdgcn_mfma_f32_16x16x32_bf16(a, b, c, 0, 0, 0)

__device__ __forceinline__ void transpose_item(const float* W, int ldw, int k0, int nsrc0, bf16* WT, int Kd, int dst_row0, LAS float* scr, int lane) {
#pragma unroll 8
    for (int i = 0; i < 32; ++i) { const int kk = 2 * i + (lane >> 5); scr[kk * 33 + (lane & 31)] = W[(size_t)(k0 + kk) * ldw + nsrc0 + (lane & 31)]; }
    LDS_WAIT(); asm volatile("" ::: "memory");
    const int c = lane & 7;
#pragma unroll
    for (int j = 0; j < 4; ++j) { const int n = (lane >> 3) + 8 * j; const LAS float* s = scr + (8 * c) * 33 + n;
        u32x4 o; o.x = pk2(s[0 * 33], s[1 * 33]); o.y = pk2(s[2 * 33], s[3 * 33]); o.z = pk2(s[4 * 33], s[5 * 33]); o.w = pk2(s[6 * 33], s[7 * 33]);
        *(u32x4*)(WT + (size_t)(dst_row0 + n) * Kd + k0 + 8 * c) = o; }
    LDS_WAIT(); asm volatile("" ::: "memory");
}

struct CvtItem { const float* src; bf16* dst; int ld2, drow8, f8; };
#define CVT_LOAD(v, c) do { _Pragma("unroll") for (int _j = 0; _j < 32; ++_j) v[_j] = __builtin_nontemporal_load((c).src + (size_t)_j * (c).ld2); } while (0)
#define CVT_STORE(v, c) do { _Pragma("unroll") for (int _j = 0; _j < 32; ++_j) scr[(2 * _j + (lane >> 5)) * 33 + (lane & 31)] = v[_j]; \
        LDS_WAIT(); asm volatile("" ::: "memory"); \
        _Pragma("unroll") for (int _q = 0; _q < 4; ++_q) { const LAS float* _s = scr + (8 * (lane & 7)) * 33 + (lane >> 3) + 8 * _q; u32x4 _o; \
            _o.x = pk2(_s[0 * 33], _s[1 * 33]); _o.y = pk2(_s[2 * 33], _s[3 * 33]); _o.z = pk2(_s[4 * 33], _s[5 * 33]); _o.w = pk2(_s[6 * 33], _s[7 * 33]); *(u32x4*)((c).dst + (size_t)_q * (c).drow8) = _o; } \
        LDS_WAIT(); asm volatile("" ::: "memory"); } while (0)
__device__ __forceinline__ CvtItem cvt_item_gu(const Args& a, int it, int lane) {
    const int e = it >> 10, mat = (it >> 9) & 1, q = it & 511, kb = q >> 5, nb = q & 31, n0 = nb * 32, k0 = kb * 64, nrow = n0 + (lane >> 3);
    CvtItem c; c.ld2 = 2048; c.drow8 = 8192; c.f8 = 1;
    c.src = a.in[mat ? I_WUP : I_WGATE] + (size_t)e * 1048576 + (size_t)(k0 + (lane >> 5)) * 1024 + n0 + (lane & 31);
    c.dst = (bf16*)(a.ws + WS_WGU + ((size_t)e * 2048 + (nrow >> 7) * 256 + mat * 128 + (nrow & 127)) * 1024 + k0 + 8 * (lane & 7));
    return c;
}
__device__ __forceinline__ CvtItem cvt_item_dn(const Args& a, int it, int lane) {
    const int e = it >> 9, q = it & 511, kb = q >> 5, nb = q & 31, n0 = nb * 32, k0 = kb * 64;
    CvtItem c; c.ld2 = 2048; c.drow8 = 8192; c.f8 = 1;
    c.src = a.in[I_WDOWN] + (size_t)e * 1048576 + (size_t)(k0 + (lane >> 5)) * 1024 + n0 + (lane & 31);
    c.dst = (bf16*)(a.ws + WS_WD + ((size_t)e * 1024 + n0 + (lane >> 3)) * 1024 + k0 + 8 * (lane & 7));
    return c;
}
#define CVT_STORE8(v, c) do { _Pragma("unroll") for (int _j = 0; _j < 32; ++_j) scr[(2 * _j + (lane >> 5)) * 33 + (lane & 31)] = v[_j]; \
        LDS_WAIT(); asm volatile("" ::: "memory"); \
        _Pragma("unroll") for (int _q = 0; _q < 4; ++_q) { const LAS float* _s = scr + (8 * (lane & 7)) * 33 + (lane >> 3) + 8 * _q; \
            *(u32x2*)((unsigned char*)(c).dst + (size_t)_q * (c).drow8) = (u32x2){pk4_fp8(16.f * _s[0 * 33], 16.f * _s[1 * 33], 16.f * _s[2 * 33], 16.f * _s[3 * 33]), pk4_fp8(16.f * _s[4 * 33], 16.f * _s[5 * 33], 16.f * _s[6 * 33], 16.f * _s[7 * 33])}; } \
        LDS_WAIT(); asm volatile("" ::: "memory"); } while (0)
__device__ __forceinline__ CvtItem cvt_item_small(const Args& a, int it, int lane) {
    CvtItem c; int r = it;
    c.f8 = 0;
    if (r < 2048) { const int kb = r >> 7, nb = r & 127, n0 = nb * 32, k0 = kb * 64; c.ld2 = 2 * DIN; c.drow8 = 8192;
        c.src = a.in[I_WIN] + (size_t)(k0 + (lane >> 5)) * DIN + n0 + (n0 >= 768 ? 32 : 0) + (lane & 31);
        if (n0 < 2048) c.dst = (bf16*)(a.ws + WS_WIN) + (size_t)(n0 + (lane >> 3)) * 1024 + k0 + 8 * (lane & 7);
        else { c.f8 = 1; c.dst = (bf16*)(a.ws + WS_WINM + (size_t)(n0 - 2048 + (lane >> 3)) * 1024 + k0 + 8 * (lane & 7)); }
        return c; }
    r -= 2048;
    if (r < 512) { const int kb = r >> 5, nb = r & 31, n0 = nb * 32, k0 = kb * 64; c.ld2 = 2048; c.drow8 = 8192;
        c.src = a.in[I_WOUT] + (size_t)(k0 + (lane >> 5)) * 1024 + n0 + (lane & 31); c.dst = (bf16*)(a.ws + WS_WO) + (size_t)(n0 + (lane >> 3)) * 1024 + k0 + 8 * (lane & 7); return c; }
    r -= 512;
    { const int kb = r >> 5, nb = r & 31, n0 = nb * 32, k0 = kb * 64; c.ld2 = 2048; c.drow8 = 4096;
      c.src = a.in[I_WGLA] + (size_t)(k0 + (lane >> 5)) * 1024 + n0 + (lane & 31); c.dst = (bf16*)(a.ws + WS_WG) + (size_t)(n0 + (lane >> 3)) * 512 + k0 + 8 * (lane & 7); return c; }
}
template <int KIND> __device__ __forceinline__ CvtItem cvt_item(const Args& a, int it, int lane) { if constexpr (KIND == 0) return cvt_item_small(a, it, lane); else if constexpr (KIND == 1) return cvt_item_gu(a, it, lane); else return cvt_item_dn(a, it, lane); }
template <int KIND>
__device__ __forceinline__ void convert_items(LAS float* scr, const Args& a, int first, int step, int end, int lane) {
    float va[32], vb[32]; CvtItem ca, cb;
    int it = first;
    if (it < end) { ca = cvt_item<KIND>(a, it, lane); CVT_LOAD(va, ca); }
    for (; it < end; it += 2 * step) {
        const bool hb = (it + step < end), ha = (it + 2 * step < end);
        if (hb) { cb = cvt_item<KIND>(a, it + step, lane); CVT_LOAD(vb, cb); }
        if (KIND == 0 && !ca.f8) CVT_STORE(va, ca); else CVT_STORE8(va, ca);
        if (ha) { ca = cvt_item<KIND>(a, it + 2 * step, lane); CVT_LOAD(va, ca); }
        if (hb) { if (KIND == 0 && !cb.f8) CVT_STORE(vb, cb); else CVT_STORE8(vb, cb); }
    }
}
template <int KIND>
__device__ __forceinline__ void convert_all(LAS unsigned char* lds, const Args& a, int vcu, int G, int lane, int wave) {
    const int gw = vcu * NWAVES + wave, NGW = G * NWAVES;
    convert_items<KIND>((LAS float*)(lds + wave * 8448), a, gw, NGW, KIND == 1 ? 16384 : 8192, lane);
    __syncthreads();
}

__device__ __forceinline__ void phase0(LAS unsigned char* lds, const Args& a, int vcu, int G, int tid, int lane, int wave) {
    unsigned char* ws = a.ws;
    if (vcu < 96) {
        LAS float* sv = (LAS float*)(lds + 69632); LAS float* part = sv + 3072;
        for (int idx = tid; idx < 3072; idx += NT) { const int v = idx >> 10, k = idx & 1023; const float s = (v < 2) ? a.in[I_C][v * 1024 + k] : a.in[I_CCTX][k]; sv[idx] = s / (1.f + expf(-s)); }
        __syncthreads();
        const int n0 = 64 * vcu, colq = lane & 15, kr = lane >> 4;
        f32x4 a0 = {0.f, 0.f, 0.f, 0.f}, a1 = a0, a2 = a0;
        const float* aw = a.in[I_ADAW] + (size_t)(128 * wave + kr) * 6144 + n0 + 4 * colq;
#pragma unroll
        for (int hb = 0; hb < 2; ++hb) { f32x4 w4[16];
#pragma unroll
            for (int it = 0; it < 16; ++it) w4[it] = __builtin_nontemporal_load((const f32x4*)(aw + (size_t)(4 * (16 * hb + it)) * 6144));
#pragma unroll
            for (int it = 0; it < 16; ++it) { const int k = 128 * wave + 4 * (16 * hb + it) + kr; a0 += w4[it] * sv[k]; a1 += w4[it] * sv[1024 + k]; a2 += w4[it] * sv[2048 + k]; } }
#pragma unroll
        for (int j = 0; j < 4; ++j) { a0[j] += __shfl_xor(a0[j], 16); a0[j] += __shfl_xor(a0[j], 32); a1[j] += __shfl_xor(a1[j], 16); a1[j] += __shfl_xor(a1[j], 32); a2[j] += __shfl_xor(a2[j], 16); a2[j] += __shfl_xor(a2[j], 32); }
        if (kr == 0) {
#pragma unroll
            for (int j = 0; j < 4; ++j) { part[(wave * 3 + 0) * 64 + 4 * colq + j] = a0[j]; part[(wave * 3 + 1) * 64 + 4 * colq + j] = a1[j]; part[(wave * 3 + 2) * 64 + 4 * colq + j] = a2[j]; } }
        __syncthreads();
        if (tid < 192) { const int v = tid >> 6, col = tid & 63; float s = a.in[I_ADAB][n0 + col];
#pragma unroll
            for (int w = 0; w < 8; ++w) s += part[(w * 3 + v) * 64 + col];
            ((float*)(ws + WS_MOD))[v * 6144 + n0 + col] = s; }
    } else if (vcu < 96 + 128) {
        const int it = vcu - 96, g = it >> 5, cb = (it >> 1) & 15, nb = it & 1, n = nb * 512 + tid;
        LAS float* pwt = (LAS float*)(lds + 69632);
        if (tid < 256) { const int d = tid >> 1, hf = tid & 1; const float sc = a.in[I_POOLS][g * 128 + d]; f32x4 v;
#pragma unroll
            for (int q = 0; q < 4; ++q) v[q] = a.in[I_POOLW][(size_t)(g * 128 + cb * 8 + hf * 4 + q) * 128 + d] * sc;
            *(LAS f32x4*)(pwt + d * 8 + hf * 4) = v; }
        __syncthreads();
        const float* wp = a.in[I_WPOOL] + (size_t)(g * 128) * 1024 + n;
        f32x4 acc0 = {0.f, 0.f, 0.f, 0.f}, acc1 = acc0;
        for (int d0 = 0; d0 < 128; d0 += 32) { float w[32];
#pragma unroll
            for (int d = 0; d < 32; ++d) w[d] = wp[(size_t)(d0 + d) * 1024];
#pragma unroll
            for (int d = 0; d < 32; ++d) { const f32x4 p0 = *(const LAS f32x4*)(pwt + (d0 + d) * 8), p1 = *(const LAS f32x4*)(pwt + (d0 + d) * 8 + 4); acc0 += p0 * w[d]; acc1 += p1 * w[d]; } }
        bf16* dst = (bf16*)(ws + WS_WC) + (size_t)n * 512 + g * 128 + cb * 8;
        *(u32x4*)dst = (u32x4){pk2(acc0[0], acc0[1]), pk2(acc0[2], acc0[3]), pk2(acc1[0], acc1[1]), pk2(acc1[2], acc1[3])};
    }
    { const int gw = vcu * NWAVES + wave, NGW = G * NWAVES; convert_items<0>((LAS float*)(lds + wave * 8448), a, gw, NGW, 2048 + 512 + 256, lane); }
}

#define RSTEP(N, S) do { _Pragma("unroll") for (int _i = 0; _i < (N) / 2; ++_i) { const float _send = (lane & (S)) ? racc[_i] : racc[_i + (N) / 2]; const float _keep = (lane & (S)) ? racc[_i + (N) / 2] : racc[_i]; racc[_i] = _keep + __shfl_xor(_send, (S)); } } while (0)
__device__ __forceinline__ void phase1(LAS unsigned char* lds, const Args& a, int vcu, int G, int tid, int lane, int wave) {
    unsigned char* ws = a.ws;
    const float* MOD = (const float*)(ws + WS_MOD);
    const float* g1 = a.in[I_N1G];
    for (int u = vcu; u < 96; u += G) {
        const int mt = u / 12, ntile = u % 12, r0 = mt * 64;
        LAS bf16* As = (LAS bf16*)lds; LAS bf16* Bs = As + 64 * 72; LAS float* rs = (LAS float*)(lds + 18432);
        const float* ctx = a.in[I_CTX];
        { f32x4 rv[8][4];
#pragma unroll
          for (int rr = 0; rr < 8; ++rr)
#pragma unroll
              for (int j = 0; j < 4; ++j) rv[rr][j] = *(const f32x4*)(ctx + (size_t)(r0 + 8 * wave + rr) * 1024 + 256 * j + 4 * lane);
#pragma unroll
          for (int rr = 0; rr < 8; ++rr) { float ss = 0.f;
#pragma unroll
              for (int j = 0; j < 4; ++j) ss += rv[rr][j][0] * rv[rr][j][0] + rv[rr][j][1] * rv[rr][j][1] + rv[rr][j][2] * rv[rr][j][2] + rv[rr][j][3] * rv[rr][j][3];
              ss = wave_sum(ss); if (lane == 0) rs[8 * wave + rr] = rsqrtf(ss * (1.f / 1024.f) + EPS); } }
        __syncthreads();
        f32x4 acc[2] = {{0.f, 0.f, 0.f, 0.f}, {0.f, 0.f, 0.f, 0.f}};
        const int m16 = wave & 3, nh = wave >> 2, srow = tid >> 3, kq = (tid & 7) * 8;
        const float rstd = rs[srow];
        const float* xp = ctx + (size_t)(r0 + srow) * 1024 + kq; const bf16* wpB = (const bf16*)(ws + WS_WIN) + (size_t)(ntile * 64 + srow) * 1024 + kq;
        f32x4 xv[2], gq[2], scq[2], shq[2]; u32x4 wB;
#define CTX_LOAD(kc) do { const int _k0 = (kc) * 64; _Pragma("unroll") for (int q = 0; q < 2; ++q) { xv[q] = *(const f32x4*)(xp + _k0 + 4 * q); gq[q] = *(const f32x4*)(g1 + _k0 + kq + 4 * q); \
            scq[q] = *(const f32x4*)(MOD + 2 * 6144 + 1024 + _k0 + kq + 4 * q); shq[q] = *(const f32x4*)(MOD + 2 * 6144 + _k0 + kq + 4 * q); } wB = *(const u32x4*)(wpB + _k0); } while (0)
        CTX_LOAD(0);
        for (int kc = 0; kc < 16; ++kc) {
            { unsigned o[4];
#pragma unroll
              for (int q = 0; q < 2; ++q) { const f32x4 h = xv[q] * rstd * gq[q] * (scq[q] + 1.f) + shq[q]; o[2 * q] = pk2(h[0], h[1]); o[2 * q + 1] = pk2(h[2], h[3]); }
              *(LAS u32x4*)(As + srow * 72 + kq) = (u32x4){o[0], o[1], o[2], o[3]};
              *(LAS u32x4*)(Bs + srow * 72 + kq) = wB; }
            __syncthreads();
            if (kc + 1 < 16) CTX_LOAD(kc + 1);
#pragma unroll
            for (int ks = 0; ks < 2; ++ks) { const bf16x8 af = ldfrag(As, 72, m16 * 16, ks * 32, lane);
#pragma unroll
                for (int tt = 0; tt < 2; ++tt) { const bf16x8 bfr = ldfrag(Bs, 72, nh * 32 + tt * 16, ks * 32, lane); acc[tt] = MFMA16(af, bfr, acc[tt]); } }
            __syncthreads();
        }
#undef CTX_LOAD
#pragma unroll
        for (int tt = 0; tt < 2; ++tt)
#pragma unroll
            for (int r = 0; r < 4; ++r) { const int row = M + r0 + m16 * 16 + 4 * (lane >> 4) + r, n = ntile * 64 + nh * 32 + tt * 16 + (lane & 15); const bf16 v = (bf16)f2bf(acc[tt][r]);
                if (n < 256) ((bf16*)(ws + WS_KB))[(size_t)row * 256 + n] = v; else ((bf16*)(ws + WS_VB))[(size_t)row * 512 + n - 256] = v; }
        __syncthreads();
    }
    LAS float* WR = (LAS float*)lds;
#pragma unroll 4
    for (int it = 0; it < 16; ++it) { const int k = (tid >> 3) + 64 * it, c4 = tid & 7; const f32x4 v = *(const f32x4*)(a.in[I_WIN] + (size_t)k * DIN + 768 + 4 * c4);
        const int row = ((k >> 8) * 4 + (k & 3)) * 64 + ((k & 255) >> 2); *(LAS f32x4*)(WR + row * 36 + 4 * c4) = v; }
    __syncthreads();
    f32x4 gv[4];
#pragma unroll
    for (int j = 0; j < 4; ++j) gv[j] = *(const f32x4*)(g1 + 256 * j + 4 * lane);
    constexpr int NPAIR = MT / 2;
    const int nctx = (G > 96) ? 96 : 0, PA = 3;
    int p_lo, p_n, p_stride;
    if (vcu < nctx) { p_lo = (vcu * NWAVES + wave) * PA; p_n = PA; p_stride = 1; }
    else { p_lo = nctx * NWAVES * PA + (vcu - nctx) * NWAVES + wave; p_n = 1 << 30; p_stride = (G - nctx) * NWAVES; }
    f32x4 nx[2][4];
    if (p_n > 0 && p_lo < NPAIR) {
#pragma unroll
        for (int r = 0; r < 2; ++r) { const int m = 2 * p_lo + r; const float* src = (m < M) ? a.in[I_X] + (size_t)m * 1024 : a.in[I_CTX] + (size_t)(m - M) * 1024;
#pragma unroll
            for (int j = 0; j < 4; ++j) nx[r][j] = *(const f32x4*)(src + 256 * j + 4 * lane); } }
    for (int pi = 0, pr = p_lo; pi < p_n && pr < NPAIR; ++pi, pr += p_stride) {
        const int m0 = 2 * pr;
        f32x4 v[2][4]; float rstd[2];
#pragma unroll
        for (int r = 0; r < 2; ++r) { float ss = 0.f;
#pragma unroll
            for (int j = 0; j < 4; ++j) { v[r][j] = nx[r][j]; ss += v[r][j][0] * v[r][j][0] + v[r][j][1] * v[r][j][1] + v[r][j][2] * v[r][j][2] + v[r][j][3] * v[r][j][3]; }
            rstd[r] = ss; }
        if (pi + 1 < p_n && pr + p_stride < NPAIR) {
#pragma unroll
            for (int r = 0; r < 2; ++r) { const int m = 2 * (pr + p_stride) + r; const float* src = (m < M) ? a.in[I_X] + (size_t)m * 1024 : a.in[I_CTX] + (size_t)(m - M) * 1024;
#pragma unroll
                for (int j = 0; j < 4; ++j) nx[r][j] = *(const f32x4*)(src + 256 * j + 4 * lane); } }
#pragma unroll
        for (int r = 0; r < 2; ++r) { const int m = m0 + r; rstd[r] = rsqrtf(wave_sum(rstd[r]) * (1.f / 1024.f) + EPS); const float* mod = MOD + (size_t)((m < M) ? (m >> 13) : 2) * 6144;
#pragma unroll
            for (int j = 0; j < 4; ++j) { const f32x4 sc = *(const f32x4*)(mod + 1024 + 256 * j + 4 * lane), sh = *(const f32x4*)(mod + 256 * j + 4 * lane); v[r][j] = v[r][j] * rstd[r] * gv[j] * (sc + 1.f) + sh; }
            if (m < M) { bf16* hp = (bf16*)(ws + WS_H1) + (size_t)m * 1024;
#pragma unroll
                for (int j = 0; j < 4; ++j) { *(u32x2*)(hp + 256 * j + 4 * lane) = (u32x2){pk2(v[r][j][0], v[r][j][1]), pk2(v[r][j][2], v[r][j][3])};
                    *(unsigned*)(ws + WS_H1F + (size_t)m * 1024 + 256 * j + 4 * lane) = pk4_fp8(v[r][j][0], v[r][j][1], v[r][j][2], v[r][j][3]); } } }
        f32x2 r2[32];
#pragma unroll
        for (int i = 0; i < 32; ++i) r2[i] = (f32x2){0.f, 0.f};
#pragma unroll
        for (int j = 0; j < 4; ++j)
#pragma unroll
            for (int i = 0; i < 4; ++i) { const f32x2 hab = {v[0][j][i], v[1][j][i]}; const LAS float* rp = WR + ((j * 4 + i) * 64 + lane) * 36;
#pragma unroll
                for (int c4 = 0; c4 < 8; ++c4) { const f32x4 w = *(const LAS f32x4*)(rp + 4 * c4);
                    r2[4 * c4 + 0] += hab * w[0]; r2[4 * c4 + 1] += hab * w[1]; r2[4 * c4 + 2] += hab * w[2]; r2[4 * c4 + 3] += hab * w[3]; }
                if (i & 1) asm volatile("" ::: "memory"); }
        float ra[32], rb[32];
#pragma unroll
        for (int i = 0; i < 32; ++i) { ra[i] = r2[i][0]; rb[i] = r2[i][1]; }
        { float* racc = ra; RSTEP(32, 32); RSTEP(16, 16); RSTEP(8, 8); RSTEP(4, 4); RSTEP(2, 2); racc[0] += __shfl_xor(racc[0], 1); }
        { float* racc = rb; RSTEP(32, 32); RSTEP(16, 16); RSTEP(8, 8); RSTEP(4, 4); RSTEP(2, 2); racc[0] += __shfl_xor(racc[0], 1); }
        if ((lane & 1) == 0) { ((float*)(ws + WS_RB))[(size_t)m0 * 32 + (lane >> 1)] = ra[0]; ((float*)(ws + WS_RB))[(size_t)(m0 + 1) * 32 + (lane >> 1)] = rb[0]; }
    }
}

typedef short s16x4 __attribute__((ext_vector_type(4)));
__device__ __forceinline__ s16x4 lds_tr16(const LAS bf16* p) { return __builtin_bit_cast(s16x4, __builtin_amdgcn_ds_read_tr16_b64_v4i16((LAS s16x4*)p)); }
__device__ __forceinline__ bf16x8 ldfrag_tr(const LAS bf16* base, int stride, int k0, int n0, int lane) {
    const int g = lane >> 4, i = lane & 15; const LAS bf16* p = base + (k0 + 8 * g + (i >> 2)) * stride + n0 + 4 * (i & 3);
    const s16x4 lo = lds_tr16(p), hi = lds_tr16(p + 4 * stride);
    return (bf16x8){lo[0], lo[1], lo[2], lo[3], hi[0], hi[1], hi[2], hi[3]};
}
__device__ __forceinline__ float logsig_fast(float z) { return fminf(z, 0.f) - __logf(1.f + __expf(-fabsf(z))); }
struct ChkPre { f32x4 r, w; float bias_f, bias_b; float kf[8]; u32x4 v[2]; };
__device__ __forceinline__ void chunk_decode(int u, int& b, int& h, int& row0, int& slot, bool& isx) {
    if (u < 1024) { b = u >> 9; h = (u >> 7) & 3; const int n = u & 127; row0 = b * SEQ + n * 64; slot = n; isx = true; }
    else { const int v = u - 1024; b = v >> 4; h = (v >> 2) & 3; const int n = v & 3; row0 = M + b * LC + n * 64; slot = NCH + n; isx = false; }
}
__device__ __forceinline__ void chunk_load(ChkPre& P, const Args& a, int u, int tid) {
    unsigned char* ws = a.ws; int b, h, row0, slot; bool isx; chunk_decode(u, b, h, row0, slot, isx);
    P.r = *(const f32x4*)((const float*)(ws + WS_RB) + (size_t)(row0 + (tid >> 3)) * 32 + (tid & 7) * 4);
    P.w = *(const f32x4*)(a.in[I_WDU] + (size_t)(tid >> 4) * 256 + h * 64 + (tid & 15) * 4);
    const int dk = tid & 63, tq = tid >> 6;
    P.bias_f = a.in[I_BDEC][h * 64 + dk]; P.bias_b = a.in[I_BDEC][256 + h * 64 + dk];
    const bf16* KBp = (const bf16*)(ws + WS_KB) + (size_t)(row0 + tq * 8) * 256 + h * 64 + dk;
#pragma unroll
    for (int tt = 0; tt < 8; ++tt) P.kf[tt] = bf2f(KBp[(size_t)tt * 256]);
#pragma unroll
    for (int i = 0; i < 2; ++i) { const int p = tid + NT * i, jj = p >> 4, ch = p & 15; P.v[i] = *(const u32x4*)((const bf16*)(ws + WS_VB) + (size_t)(row0 + jj) * 512 + h * 128 + 8 * ch); }
}
__device__ __forceinline__ void chunk_units(LAS unsigned char* lds, const Args& a, int vcu, int G, int tid, int lane, int wave) {
    unsigned char* ws = a.ws;
    LAS float* r_s = (LAS float*)lds;
    LAS float* wup = (LAS float*)(lds + 8192);
    LAS float* seg = (LAS float*)(lds + 16384);
    LAS bf16* Ks = (LAS bf16*)(lds + 20480);
    LAS bf16* Vs = (LAS bf16*)(lds + 38912);
    const int dk = tid & 63, tq = tid >> 6;
    ChkPre P;
    unsigned* qctr = (unsigned*)(ws + WS_CTL) + 512; LAS int* qnext = (LAS int*)(lds + 57344);
    int u = vcu;
    if (u < 1024 + 32) chunk_load(P, a, u, tid);
    for (; u < 1024 + 32; ) {
        int b, h, row0, slot; bool isx; chunk_decode(u, b, h, row0, slot, isx);
        const int bh = b * 4 + h;
        if (tid == 0) qnext[0] = G + (int)__hip_atomic_fetch_add(qctr, 1u, __ATOMIC_RELAXED, __HIP_MEMORY_SCOPE_AGENT);
        *(LAS f32x4*)(r_s + tid * 4) = P.r; *(LAS f32x4*)(wup + (tid >> 4) * 64 + (tid & 15) * 4) = P.w;
#pragma unroll
        for (int i = 0; i < 2; ++i) { const int p = tid + NT * i, jj = p >> 4, ch = p & 15; *(LAS u32x4*)(Vs + jj * 136 + 8 * ch) = P.v[i]; }
        float kf[8];
#pragma unroll
        for (int tt = 0; tt < 8; ++tt) kf[tt] = P.kf[tt];
        const float bias_f = P.bias_f, bias_b = P.bias_b;
        __syncthreads();
        const int un = qnext[0];
        if (un < 1024 + 32) chunk_load(P, a, un, tid);
        float pf[8], sb[8];
        { float wf[16], wb[16];
#pragma unroll
          for (int j = 0; j < 16; ++j) { wf[j] = wup[j * 64 + dk]; wb[j] = wup[(16 + j) * 64 + dk]; }
#pragma unroll
          for (int tt = 0; tt < 8; ++tt) { const LAS float* rp = r_s + (tq * 8 + tt) * 32; float zf = bias_f, zb = bias_b;
#pragma unroll
              for (int j4 = 0; j4 < 4; ++j4) { const f32x4 rf = *(const LAS f32x4*)(rp + 4 * j4), rb = *(const LAS f32x4*)(rp + 16 + 4 * j4);
#pragma unroll
                  for (int e = 0; e < 4; ++e) { zf += rf[e] * wf[4 * j4 + e]; zb += rb[e] * wb[4 * j4 + e]; } }
              pf[tt] = logsig_fast(zf) * (1.f / 16.f); sb[tt] = logsig_fast(zb) * (1.f / 16.f); }
#pragma unroll
          for (int tt = 1; tt < 8; ++tt) pf[tt] += pf[tt - 1];
#pragma unroll
          for (int tt = 6; tt >= 0; --tt) sb[tt] += sb[tt + 1];
          seg[tq * 64 + dk] = pf[7]; seg[(8 + tq) * 64 + dk] = sb[0]; }
        __syncthreads();
        { float offf = 0.f, totf = 0.f, offb = 0.f, totb = 0.f;
#pragma unroll
          for (int q = 0; q < 8; ++q) { const float sf = seg[q * 64 + dk], sbv = seg[(8 + q) * 64 + dk]; totf += sf; totb += sbv; if (q < tq) offf += sf; if (q > tq) offb += sbv; }
#pragma unroll
          for (int tt = 0; tt < 8; ++tt) { const int t = tq * 8 + tt; const float bb = pf[tt] + offf, cc = sb[tt] + offb;
              if (isx) { const size_t gi = (size_t)(row0 + t) * 256 + h * 64 + dk; a.out[gi] = bb; a.out[(size_t)M * 256 + gi] = cc; }
              Ks[t * 72 + dk] = (bf16)f2bf(kf[tt] * __expf(totf - bb)); Ks[(64 + t) * 72 + dk] = (bf16)f2bf(kf[tt] * __expf(totb - cc)); }
          if (tq == 0) { float* DEC = (float*)(ws + WS_DEC); DEC[((size_t)(0 * 8 + bh) * NSLOT + slot) * 64 + dk] = __expf(totf); DEC[((size_t)(1 * 8 + bh) * NSLOT + slot) * 64 + dk] = __expf(totb); } }
        __syncthreads();
        { const int dir = wave >> 2, dkt = wave & 3; const LAS bf16* Kd = Ks + dir * 64 * 72;
          const bf16x8 k0f = ldfrag_tr(Kd, 72, 0, dkt * 16, lane), k1f = ldfrag_tr(Kd, 72, 32, dkt * 16, lane);
          bf16* KV = (bf16*)(ws + WS_KV) + ((size_t)(dir * 8 + bh) * NSLOT + slot) * 8192;
#pragma unroll
          for (int dvt = 0; dvt < 8; ++dvt) { f32x4 c = {0.f, 0.f, 0.f, 0.f}; c = MFMA16(k0f, ldfrag_tr(Vs, 136, 0, dvt * 16, lane), c); c = MFMA16(k1f, ldfrag_tr(Vs, 136, 32, dvt * 16, lane), c);
              *(u32x2*)(KV + (size_t)(dvt * 16 + (lane & 15)) * 64 + dkt * 16 + 4 * (lane >> 4)) = (u32x2){pk2(c[0], c[1]), pk2(c[2], c[3])}; } }
        __syncthreads();
        u = un;
    }
}
constexpr int PB = 4, NPOOLW = NB * 4 * 8 * (128 / PB);
__device__ __forceinline__ void ld16bf(const bf16* p, float (&f)[16]) { const u32x4 w0 = *(const u32x4*)p, w1 = *(const u32x4*)(p + 8);
#pragma unroll
    for (int q = 0; q < 4; ++q) { f[2 * q] = bflo(w0[q]); f[2 * q + 1] = bfhi(w0[q]); f[8 + 2 * q] = bflo(w1[q]); f[8 + 2 * q + 1] = bfhi(w1[q]); } }
template <int CTRL, int ROWMASK> __device__ __forceinline__ float dpp_f(float v) { return __builtin_bit_cast(float, __builtin_amdgcn_update_dpp(0, __builtin_bit_cast(int, v), CTRL, ROWMASK, 0xf, true)); }
__device__ __forceinline__ float wave_prefix(float v) {
    v += dpp_f<0x111, 0xf>(v); v += dpp_f<0x112, 0xf>(v); v += dpp_f<0x114, 0xf>(v); v += dpp_f<0x118, 0xf>(v);
    v += dpp_f<0x142, 0xa>(v);
    v += dpp_f<0x143, 0xc>(v);
    return v;
}
template <int HALF>
__device__ __forceinline__ void pool_band(const bf16* PI, bf16* PO, int r0, int c) {
    float run[16];
#pragma unroll
    for (int e = 0; e < 16; ++e) run[e] = 0.f;
    { constexpr int NW = 2 * HALF, BT = NW < 8 ? NW : 8;
#pragma unroll
      for (int i0 = 0; i0 < NW; i0 += BT) { float f[BT][16];
#pragma unroll
          for (int i = 0; i < BT; ++i) { int rr = r0 - HALF + i0 + i; rr = rr < 0 ? 0 : (rr > 127 ? 127 : rr); ld16bf(PI + (size_t)rr * 64 * 512, f[i]); }
#pragma unroll
          for (int i = 0; i < BT; ++i) { const int rr = r0 - HALF + i0 + i; const bool ok = rr >= 0 && rr < 128;
#pragma unroll
              for (int e = 0; e < 16; ++e) run[e] += ok ? f[i][e] : 0.f; }
          asm volatile("" ::: "memory"); } }
    const int lo_c = (c - HALF) < 0 ? 0 : (c - HALF), hi_c = (c + HALF) > 64 ? 64 : (c + HALF);
    float cen[16], fi[16], fo[16];
    ld16bf(PI + (size_t)r0 * 64 * 512, cen);
#pragma unroll
    for (int k = 0; k < PB; ++k) {
        const int r = r0 + k;
        float ncen[16];
        if (k + 1 < PB) { const int rin = r + HALF, rout = r - HALF;
            ld16bf(PI + (size_t)(rin > 127 ? 127 : rin) * 64 * 512, fi); ld16bf(PI + (size_t)(rout < 0 ? 0 : rout) * 64 * 512, fo); ld16bf(PI + (size_t)(r + 1) * 64 * 512, ncen); }
        const int lo_r = (r - HALF) < 0 ? 0 : (r - HALF), hi_r = (r + HALF) > 128 ? 128 : (r + HALF);
        const float inv = 1.f / (float)((hi_r - lo_r) * (hi_c - lo_c));
        float o[16];
#pragma unroll
        for (int e = 0; e < 16; ++e) { const float p = wave_prefix(run[e]);
            const float hi = __shfl(p, hi_c - 1), lo = __shfl(p, lo_c > 0 ? lo_c - 1 : 0);
            o[e] = (hi - (lo_c > 0 ? lo : 0.f)) * inv - cen[e]; }
        bf16* po = PO + (size_t)r * 64 * 512;
        *(u32x4*)po = (u32x4){pk2(o[0], o[1]), pk2(o[2], o[3]), pk2(o[4], o[5]), pk2(o[6], o[7])}; *(u32x4*)(po + 8) = (u32x4){pk2(o[8], o[9]), pk2(o[10], o[11]), pk2(o[12], o[13]), pk2(o[14], o[15])};
        if (k + 1 < PB) { const int rin = r + HALF, rout = r - HALF;
#pragma unroll
            for (int e = 0; e < 16; ++e) { run[e] += (rin < 128 ? fi[e] : 0.f) - (rout >= 0 ? fo[e] : 0.f); cen[e] = ncen[e]; } }
    }
}
__device__ __forceinline__ void pool_units(const Args& a, int vcu, int G, int lane, int wave, int nw) {
    unsigned char* ws = a.ws;
    constexpr int NBAND = 128 / PB, PER_G = NB * 8 * NBAND;
    for (int wu = vcu * nw + wave; wu < NPOOLW; wu += G * nw) {
        const int g = 3 - wu / PER_G, rem = wu % PER_G, b = rem / (8 * NBAND), rem2 = rem % (8 * NBAND), chk = rem2 & 7, r0 = (rem2 >> 3) * PB;
        const size_t off = ((size_t)b * SEQ + lane) * 512 + g * 128 + chk * 16;
        const bf16* PI = (const bf16*)(ws + WS_PI) + off; bf16* PO = (bf16*)(ws + WS_PO) + off;
        if (g == 0) pool_band<1>(PI, PO, r0, lane); else if (g == 1) pool_band<2>(PI, PO, r0, lane); else if (g == 2) pool_band<4>(PI, PO, r0, lane); else pool_band<8>(PI, PO, r0, lane);
    }
}

__device__ __forceinline__ void phase4(const Args& a, int G, int tid, int nthr) {
    unsigned char* ws = a.ws;
    for (int e = blockIdx.x * nthr + tid; e < 2 * 8 * 8192; e += G * nthr) {
        const int dir = e >> 16, bh = (e >> 13) & 7, e8 = e & 8191, dk = e8 & 63;
        const bf16* kvp = (const bf16*)(ws + WS_KV) + (size_t)((dir * 8 + bh) * NSLOT) * 8192 + e8;
        const float* decp = (const float*)(ws + WS_DEC) + (size_t)((dir * 8 + bh) * NSLOT) * 64 + dk;
        bf16* stp = (bf16*)(ws + WS_ST) + (size_t)((dir * 8 + bh) * NCH) * 8192 + e8;
        float s = 0.f;
        float kv[12], dc[12], kvn[12], dcn[12];
#define SCAN_SLOT(j) (dir ? (NSLOT - 1 - (j)) : ((j) < 4 ? NCH + (j) : (j) - 4))
#pragma unroll
        for (int q = 0; q < 12; ++q) { const int slot = SCAN_SLOT(q); kvn[q] = bf2f(kvp[(size_t)slot * 8192]); dcn[q] = decp[slot * 64]; }
        for (int j0 = 0; j0 < NSLOT; j0 += 12) {
#pragma unroll
            for (int q = 0; q < 12; ++q) { kv[q] = kvn[q]; dc[q] = dcn[q]; }
            if (j0 + 12 < NSLOT) {
#pragma unroll
                for (int q = 0; q < 12; ++q) { const int slot = SCAN_SLOT(j0 + 12 + q); kvn[q] = bf2f(kvp[(size_t)slot * 8192]); dcn[q] = decp[slot * 64]; } }
#pragma unroll
            for (int q = 0; q < 12; ++q) { const int slot = SCAN_SLOT(j0 + q);
                if (slot < NCH) stp[(size_t)slot * 8192] = (bf16)f2bf(s);
                s = dc[q] * s + kv[q]; }
        }
#undef SCAN_SLOT
    }
}

struct GlaPre { u32x4 q, k; f32x4 b0, b1, c0, c1, mf0, mf1, mb0, mb1; u32x4 v[2]; u32x4 st[4]; u32x4 sg[2]; };
__device__ __forceinline__ void gla_load(GlaPre& P, const Args& a, int u, int tid) {
    unsigned char* ws = a.ws;
    const int b = u >> 9, h = (u >> 7) & 3, n = u & 127, row0 = b * SEQ + n * 64, bh = b * 4 + h, t = tid >> 3, c8 = tid & 7;
    const size_t gi = (size_t)(row0 + t) * 256 + h * 64 + 8 * c8, gmf = (size_t)(row0 + 31) * 256 + h * 64 + 8 * c8, gmb = (size_t)(row0 + 32) * 256 + h * 64 + 8 * c8;
    const float* BF = a.out; const float* CB = a.out + (size_t)M * 256;
    P.q = *(const u32x4*)((const bf16*)(ws + WS_QB) + gi); P.k = *(const u32x4*)((const bf16*)(ws + WS_KB) + gi);
    P.b0 = *(const f32x4*)(BF + gi); P.b1 = *(const f32x4*)(BF + gi + 4); P.c0 = *(const f32x4*)(CB + gi); P.c1 = *(const f32x4*)(CB + gi + 4);
    P.mf0 = *(const f32x4*)(BF + gmf); P.mf1 = *(const f32x4*)(BF + gmf + 4); P.mb0 = *(const f32x4*)(CB + gmb); P.mb1 = *(const f32x4*)(CB + gmb + 4);
#pragma unroll
    for (int i = 0; i < 2; ++i) { const int p = tid + NT * i, jj = p >> 4, ch = p & 15; P.v[i] = *(const u32x4*)((const bf16*)(ws + WS_VB) + (size_t)(row0 + jj) * 512 + h * 128 + 8 * ch); }
#pragma unroll
    for (int i = 0; i < 4; ++i) { const int p = tid + NT * i, dir = p >> 10, rem = p & 1023, dv = rem >> 3, c = rem & 7;
        P.st[i] = *(const u32x4*)((const bf16*)(ws + WS_ST) + ((size_t)((dir * 8 + bh) * NCH + n) * 128 + dv) * 64 + 8 * c); }
    const bf16* sgp = (const bf16*)(ws + WS_SG) + (size_t)(row0 + t) * 512 + h * 128 + 16 * c8;
    P.sg[0] = *(const u32x4*)sgp; P.sg[1] = *(const u32x4*)(sgp + 8);
}
__device__ __forceinline__ void phase5(LAS unsigned char* lds, const Args& a, int vcu, int G, int tid, int lane, int wave) {
    unsigned char* ws = a.ws;
    LAS bf16* Aop = (LAS bf16*)lds;
    LAS bf16* Bop = (LAS bf16*)(lds + 25600);
    LAS bf16* Vs = (LAS bf16*)(lds + 60416);
    LAS bf16* qsf = (LAS bf16*)(lds + 77824); LAS bf16* ksf = qsf + 64 * 72; LAS bf16* qsb = ksf + 64 * 72; LAS bf16* ksb = qsb + 64 * 72;
    LAS float* Os = (LAS float*)(lds + 77824);
    const int t8 = tid >> 3, c8 = tid & 7;
    f32x4 gn[4];
#pragma unroll
    for (int q = 0; q < 4; ++q) gn[q] = *(const f32x4*)(a.in[I_GNG] + 16 * c8 + 4 * q);
    GlaPre P;
    int u = vcu;
    if (u < 1024) gla_load(P, a, u, tid);
    for (; u < 1024; u += G) {
        const int b = u >> 9, h = (u >> 7) & 3, n = u & 127, row0 = b * SEQ + n * 64;
        { float qf[8], kf[8], bb[8], cc[8], mf[8], mb[8];
#pragma unroll
          for (int e = 0; e < 4; ++e) { qf[2 * e] = bflo(P.q[e]); qf[2 * e + 1] = bfhi(P.q[e]); kf[2 * e] = bflo(P.k[e]); kf[2 * e + 1] = bfhi(P.k[e]);
              bb[e] = P.b0[e]; bb[4 + e] = P.b1[e]; cc[e] = P.c0[e]; cc[4 + e] = P.c1[e]; mf[e] = P.mf0[e]; mf[4 + e] = P.mf1[e]; mb[e] = P.mb0[e]; mb[4 + e] = P.mb1[e]; }
          float o0[8], o1[8], o2[8], o3[8], o4[8], o5[8];
#pragma unroll
          for (int e = 0; e < 8; ++e) { const float eb = __expf(bb[e]), ec = __expf(cc[e]), x = __expf(bb[e] - mf[e]), y = __expf(cc[e] - mb[e]);
              o0[e] = qf[e] * eb; o1[e] = qf[e] * ec; o2[e] = qf[e] * x; o3[e] = kf[e] * __builtin_amdgcn_rcpf(x); o4[e] = qf[e] * y; o5[e] = kf[e] * __builtin_amdgcn_rcpf(y); }
#define PK8(o) (u32x4){pk2(o[0], o[1]), pk2(o[2], o[3]), pk2(o[4], o[5]), pk2(o[6], o[7])}
          *(LAS u32x4*)(Aop + t8 * 200 + 8 * c8) = PK8(o0); *(LAS u32x4*)(Aop + t8 * 200 + 64 + 8 * c8) = PK8(o1);
          *(LAS u32x4*)(qsf + t8 * 72 + 8 * c8) = PK8(o2); *(LAS u32x4*)(ksf + t8 * 72 + 8 * c8) = PK8(o3); *(LAS u32x4*)(qsb + t8 * 72 + 8 * c8) = PK8(o4); *(LAS u32x4*)(ksb + t8 * 72 + 8 * c8) = PK8(o5);
#undef PK8
        }
#pragma unroll
        for (int i = 0; i < 2; ++i) { const int p = tid + NT * i, jj = p >> 4, ch = p & 15; *(LAS u32x4*)(Vs + jj * 136 + 8 * ch) = P.v[i]; }
#pragma unroll
        for (int i = 0; i < 4; ++i) { const int p = tid + NT * i, dir = p >> 10, rem = p & 1023, dv = rem >> 3, c = rem & 7; *(LAS u32x4*)(Bop + dv * 136 + dir * 64 + 8 * c) = P.st[i]; }
        const u32x4 sg0 = P.sg[0], sg1 = P.sg[1];
        __syncthreads();
        if (u + G < 1024) gla_load(P, a, u + G, tid);
        { const int tt = wave >> 1, jh = wave & 1; f32x4 pa[2] = {{0.f, 0.f, 0.f, 0.f}, {0.f, 0.f, 0.f, 0.f}};
#pragma unroll
          for (int dir = 0; dir < 2; ++dir) { const LAS bf16* qs = dir ? qsb : qsf; const LAS bf16* ks = dir ? ksb : ksf;
              const bf16x8 a0 = ldfrag(qs, 72, tt * 16, 0, lane), a1 = ldfrag(qs, 72, tt * 16, 32, lane);
#pragma unroll
              for (int jj = 0; jj < 2; ++jj) { const int jt = jh * 2 + jj; f32x4 sc = {0.f, 0.f, 0.f, 0.f}; sc = MFMA16(a0, ldfrag(ks, 72, jt * 16, 0, lane), sc); sc = MFMA16(a1, ldfrag(ks, 72, jt * 16, 32, lane), sc);
#pragma unroll
                  for (int r = 0; r < 4; ++r) { const int t = tt * 16 + 4 * (lane >> 4) + r, jx = jt * 16 + (lane & 15); const bool keep = dir ? (jx >= t) : (jx <= t); pa[jj][r] += keep ? sc[r] : 0.f; } } }
#pragma unroll
          for (int jj = 0; jj < 2; ++jj)
#pragma unroll
              for (int r = 0; r < 4; ++r) Aop[(tt * 16 + 4 * (lane >> 4) + r) * 200 + 128 + (jh * 2 + jj) * 16 + (lane & 15)] = (bf16)f2bf(pa[jj][r]); }
        __syncthreads();
        const int tt = wave >> 1, dvh = wave & 1;
        f32x4 acc[4] = {{0.f, 0.f, 0.f, 0.f}, {0.f, 0.f, 0.f, 0.f}, {0.f, 0.f, 0.f, 0.f}, {0.f, 0.f, 0.f, 0.f}};
#pragma unroll
        for (int ks = 0; ks < 4; ++ks) { const bf16x8 af = ldfrag(Aop, 200, tt * 16, ks * 32, lane);
#pragma unroll
            for (int i = 0; i < 4; ++i) acc[i] = MFMA16(af, ldfrag(Bop, 136, (dvh * 4 + i) * 16, ks * 32, lane), acc[i]); }
#pragma unroll
        for (int ks = 0; ks < 2; ++ks) { const bf16x8 af = ldfrag(Aop, 200, tt * 16, 128 + ks * 32, lane);
#pragma unroll
            for (int i = 0; i < 4; ++i) acc[i] = MFMA16(af, ldfrag_tr(Vs, 136, ks * 32, (dvh * 4 + i) * 16, lane), acc[i]); }
#pragma unroll
        for (int i = 0; i < 4; ++i)
#pragma unroll
            for (int r = 0; r < 4; ++r) Os[(tt * 16 + 4 * (lane >> 4) + r) * 132 + (dvh * 4 + i) * 16 + (lane & 15)] = acc[i][r];
        __syncthreads();
        { f32x4 ov[4]; float ss = 0.f;
#pragma unroll
          for (int q = 0; q < 4; ++q) { ov[q] = *(const LAS f32x4*)(Os + t8 * 132 + 16 * c8 + 4 * q); ss += ov[q][0] * ov[q][0] + ov[q][1] * ov[q][1] + ov[q][2] * ov[q][2] + ov[q][3] * ov[q][3]; }
          ss += __shfl_xor(ss, 1); ss += __shfl_xor(ss, 2); ss += __shfl_xor(ss, 4);
          const float rstd = rsqrtf(ss * (1.f / 128.f) + EPS);
          unsigned sgw[8] = {sg0[0], sg0[1], sg0[2], sg0[3], sg1[0], sg1[1], sg1[2], sg1[3]}, ow[8];
#pragma unroll
          for (int q = 0; q < 4; ++q) { const f32x4 o = ov[q] * rstd * gn[q]; ow[2 * q] = pk2(o[0] * bflo(sgw[2 * q]), o[1] * bfhi(sgw[2 * q])); ow[2 * q + 1] = pk2(o[2] * bflo(sgw[2 * q + 1]), o[3] * bfhi(sgw[2 * q + 1])); }
          bf16* agp = (bf16*)(ws + WS_AG) + (size_t)(row0 + t8) * 512 + h * 128 + 16 * c8;
          *(u32x4*)agp = (u32x4){ow[0], ow[1], ow[2], ow[3]}; *(u32x4*)(agp + 8) = (u32x4){ow[4], ow[5], ow[6], ow[7]}; }
        __syncthreads();
    }
}

__device__ __forceinline__ void phase8(LAS unsigned char* lds, const Args& a, int vcu, int G, int tid, int lane, int wave) {
    unsigned char* ws = a.ws;
    const float* MOD = (const float*)(ws + WS_MOD);
    LAS float* WRT = (LAS float*)lds;
#pragma unroll
    for (int it = 0; it < 8; ++it) { const int idx = tid + NT * it, k = idx >> 2, c4 = idx & 3; const f32x4 v = *(const f32x4*)(a.in[I_WROUTER] + (size_t)k * 16 + 4 * c4);
        const int row = ((k >> 8) * 4 + (k & 3)) * 64 + ((k & 255) >> 2); *(LAS f32x4*)(WRT + row * 20 + 4 * c4) = v; }
    __syncthreads();
    const int gw = vcu * NWAVES + wave, NGW = G * NWAVES;
    f32x4 gv[4];
#pragma unroll
    for (int j = 0; j < 4; ++j) gv[j] = *(const f32x4*)(a.in[I_N2G] + 256 * j + 4 * lane);
    f32x4 nx[2][4];
    if (gw < M / 2) {
#pragma unroll
        for (int r = 0; r < 2; ++r)
#pragma unroll
            for (int j = 0; j < 4; ++j) { const size_t o_ = (size_t)(2 * gw + r) * 1024 + 256 * j + 4 * lane; const u32x2 d_ = *(const u32x2*)((const bf16*)(ws + WS_YD) + o_);
                nx[r][j] = *(const f32x4*)(a.in[I_X] + o_) + (f32x4){bflo(d_.x), bfhi(d_.x), bflo(d_.y), bfhi(d_.y)}; } }
    for (int pr = gw; pr < M / 2; pr += NGW) {
        const int m0 = 2 * pr, b = m0 >> 13; const float* mod = MOD + (size_t)b * 6144;
        f32x4 v[2][4]; float ss[2];
#pragma unroll
        for (int r = 0; r < 2; ++r) { float q = 0.f;
#pragma unroll
            for (int j = 0; j < 4; ++j) { v[r][j] = nx[r][j]; q += v[r][j][0] * v[r][j][0] + v[r][j][1] * v[r][j][1] + v[r][j][2] * v[r][j][2] + v[r][j][3] * v[r][j][3]; }
            ss[r] = q; }
        if (pr + NGW < M / 2) {
#pragma unroll
            for (int r = 0; r < 2; ++r)
#pragma unroll
                for (int j = 0; j < 4; ++j) { const size_t o_ = (size_t)(2 * (pr + NGW) + r) * 1024 + 256 * j + 4 * lane; const u32x2 d_ = *(const u32x2*)((const bf16*)(ws + WS_YD) + o_);
                    nx[r][j] = *(const f32x4*)(a.in[I_X] + o_) + (f32x4){bflo(d_.x), bfhi(d_.x), bflo(d_.y), bfhi(d_.y)}; } }
#pragma unroll
        for (int r = 0; r < 2; ++r) { const float rstd = rsqrtf(wave_sum(ss[r]) * (1.f / 1024.f) + EPS);
#pragma unroll
            for (int j = 0; j < 4; ++j) { const f32x4 sc = *(const f32x4*)(mod + 4096 + 256 * j + 4 * lane), sh = *(const f32x4*)(mod + 3072 + 256 * j + 4 * lane); v[r][j] = v[r][j] * rstd * gv[j] * (sc + 1.f) + sh; }
            unsigned char* hp = ws + WS_H2 + (size_t)(m0 + r) * 1024;
#pragma unroll
            for (int j = 0; j < 4; ++j) *(unsigned*)(hp + 256 * j + 4 * lane) = pk4_fp8(v[r][j][0], v[r][j][1], v[r][j][2], v[r][j][3]); }
        f32x2 r2[16];
#pragma unroll
        for (int i = 0; i < 16; ++i) r2[i] = (f32x2){0.f, 0.f};
#pragma unroll
        for (int j = 0; j < 4; ++j)
#pragma unroll
            for (int i = 0; i < 4; ++i) { const f32x2 hab = {v[0][j][i], v[1][j][i]}; const LAS float* rp = WRT + ((j * 4 + i) * 64 + lane) * 20;
#pragma unroll
                for (int c4 = 0; c4 < 4; ++c4) { const f32x4 w = *(const LAS f32x4*)(rp + 4 * c4); r2[4 * c4 + 0] += hab * w[0]; r2[4 * c4 + 1] += hab * w[1]; r2[4 * c4 + 2] += hab * w[2]; r2[4 * c4 + 3] += hab * w[3]; }
                if (i & 1) asm volatile("" ::: "memory"); }
#pragma unroll
        for (int r = 0; r < 2; ++r) {
            float racc[16];
#pragma unroll
            for (int i = 0; i < 16; ++i) racc[i] = r2[i][r];
            RSTEP(16, 32); RSTEP(8, 16); RSTEP(4, 8); RSTEP(2, 4); racc[0] += __shfl_xor(racc[0], 2); racc[0] += __shfl_xor(racc[0], 1);
            const float lg = racc[0];
            float mx = lg; mx = fmaxf(mx, __shfl_xor(mx, 4)); mx = fmaxf(mx, __shfl_xor(mx, 8)); mx = fmaxf(mx, __shfl_xor(mx, 16)); mx = fmaxf(mx, __shfl_xor(mx, 32));
            const float ex = expf(lg - mx); float sm = ex; sm += __shfl_xor(sm, 4); sm += __shfl_xor(sm, 8); sm += __shfl_xor(sm, 16); sm += __shfl_xor(sm, 32);
            const int m = m0 + r;
            if ((lane & 3) == 0) ((float*)(ws + WS_AFF))[(size_t)(b * 16 + (lane >> 2)) * SEQ + (m & (SEQ - 1))] = ex / sm;
            if (lane < 16) ((int*)(ws + WS_INV))[(size_t)m * 16 + lane] = -1;
        }
    }
}

__device__ __forceinline__ void topk_unit(LAS unsigned char* lds, const Args& a, int be, int tid, int lane, int wave) {
    unsigned char* ws = a.ws;
    LAS unsigned* hist = (LAS unsigned*)lds;
    LAS unsigned* sel = hist + 256;
    LAS unsigned* wtot = hist + 264;
    const float* aff = (const float*)(ws + WS_AFF) + (size_t)be * SEQ + 16 * tid;
    unsigned key[16];
#pragma unroll
    for (int q = 0; q < 4; ++q) { const u32x4 v = *(const u32x4*)(aff + 4 * q); key[4 * q] = v[0]; key[4 * q + 1] = v[1]; key[4 * q + 2] = v[2]; key[4 * q + 3] = v[3]; }
    unsigned prefix = 0u, mask = 0u, kk = CAP;
    for (int pass = 0; pass < 4; ++pass) {
        const int shift = 24 - 8 * pass;
        if (tid < 256) hist[tid] = 0u;
        __syncthreads();
#pragma unroll
        for (int i = 0; i < 16; ++i) if ((key[i] & mask) == prefix) __hip_atomic_fetch_add(hist + ((key[i] >> shift) & 255u), 1u, __ATOMIC_RELAXED, __HIP_MEMORY_SCOPE_WORKGROUP);
        __syncthreads();
        if (wave == 0) {
            const unsigned h0 = hist[4 * lane], h1 = hist[4 * lane + 1], h2 = hist[4 * lane + 2], h3 = hist[4 * lane + 3], loc = h0 + h1 + h2 + h3;
            unsigned suf = loc;
#pragma unroll
            for (int o = 1; o < 64; o <<= 1) { const unsigned t = __shfl_down(suf, o); if (lane + o < 64) suf += t; }
            const unsigned above = suf - loc;
            const unsigned s3 = above + h3, s2 = s3 + h2, s1 = s2 + h1, s0 = s1 + h0;
            if (s3 >= kk && above < kk) { sel[0] = 4 * lane + 3; sel[1] = kk - above; }
            if (s2 >= kk && s3 < kk) { sel[0] = 4 * lane + 2; sel[1] = kk - s3; }
            if (s1 >= kk && s2 < kk) { sel[0] = 4 * lane + 1; sel[1] = kk - s2; }
            if (s0 >= kk && s1 < kk) { sel[0] = 4 * lane + 0; sel[1] = kk - s1; }
        }
        __syncthreads();
        prefix |= sel[0] << shift; mask |= 255u << shift; kk = sel[1];
        __syncthreads();
    }
    unsigned cgt = 0u, ceq = 0u;
#pragma unroll
    for (int i = 0; i < 16; ++i) { cgt += (key[i] > prefix) ? 1u : 0u; ceq += (key[i] == prefix) ? 1u : 0u; }
    const unsigned val = cgt | (ceq << 16); unsigned inc = val;
#pragma unroll
    for (int o = 1; o < 64; o <<= 1) { const unsigned t = __shfl_up(inc, o); if (lane >= o) inc += t; }
    if (lane == 63) wtot[wave] = inc;
    __syncthreads();
    unsigned base = 0u;
    for (int w = 0; w < wave; ++w) base += wtot[w];
    const unsigned excl = base + inc - val; unsigned gtb = excl & 0xffffu, eqb = excl >> 16;
    const int b = be >> 4, e = be & 15;
    int* IDX = (int*)(ws + WS_IDX) + be * CAP; float* WSEL = (float*)(ws + WS_WSEL) + be * CAP; int* INV = (int*)(ws + WS_INV);
#pragma unroll
    for (int i = 0; i < 16; ++i) { const bool gt = key[i] > prefix, eq = key[i] == prefix; const bool take = gt || (eq && eqb < kk);
        if (take) { const unsigned pos = gtb + (eqb < kk ? eqb : kk); const int row = b * SEQ + 16 * tid + i; IDX[pos] = row; WSEL[pos] = __builtin_bit_cast(float, key[i]); INV[(size_t)row * 16 + e] = (int)pos; }
        gtb += gt ? 1u : 0u; eqb += eq ? 1u : 0u; }
    __syncthreads();
}
__device__ __forceinline__ void phase9(LAS unsigned char* lds, const Args& a, int vcu, int G, int tid, int lane, int wave) {
    const int ntk = (G > 64) ? 32 : 0;
    if (vcu < ntk || ntk == 0) for (int be = (ntk ? vcu : vcu); be < NB * NE; be += (ntk ? ntk : G)) topk_unit(lds, a, be, tid, lane, wave);
    if (vcu >= ntk) { const int gw = (vcu - ntk) * NWAVES + wave, NGW = (G - ntk) * NWAVES; convert_items<2>((LAS float*)(lds + 8192 + wave * 8448), a, gw, NGW, 8192, lane); }
}

__device__ __forceinline__ void phase12(const Args& a, int vcu, int G, int lane, int wave) {
    unsigned char* ws = a.ws;
    const int gw = vcu * NWAVES + wave, NGW = G * NWAVES;
    f32x4 gv[4];
#pragma unroll
    for (int j = 0; j < 4; ++j) gv[j] = *(const f32x4*)(a.in[I_FNG] + 256 * j + 4 * lane);
    f32x4 nx[4]; int ninv = -1;
    if (gw < M) {
#pragma unroll
        for (int j = 0; j < 4; ++j) { const size_t o_ = (size_t)gw * 1024 + 256 * j + 4 * lane; const u32x2 d_ = __builtin_nontemporal_load((const u32x2*)((const bf16*)(ws + WS_YD) + o_));
            nx[j] = __builtin_nontemporal_load((const f32x4*)(a.in[I_X] + o_)) + (f32x4){bflo(d_.x), bfhi(d_.x), bflo(d_.y), bfhi(d_.y)}; }
        ninv = (lane < 16) ? ((const int*)(ws + WS_INV))[(size_t)gw * 16 + lane] : -1; }
    for (int m = gw; m < M; m += NGW) {
        const int b = m >> 13; float* row = a.out + (size_t)m * 1024;
        f32x4 v[4];
#pragma unroll
        for (int j = 0; j < 4; ++j) v[j] = nx[j];
        const int myinv = ninv;
        if (m + NGW < M) {
#pragma unroll
            for (int j = 0; j < 4; ++j) { const size_t o_ = (size_t)(m + NGW) * 1024 + 256 * j + 4 * lane; const u32x2 d_ = __builtin_nontemporal_load((const u32x2*)((const bf16*)(ws + WS_YD) + o_));
                nx[j] = __builtin_nontemporal_load((const f32x4*)(a.in[I_X] + o_)) + (f32x4){bflo(d_.x), bfhi(d_.x), bflo(d_.y), bfhi(d_.y)}; }
            ninv = (lane < 16) ? ((const int*)(ws + WS_INV))[(size_t)(m + NGW) * 16 + lane] : -1; }
        unsigned long long mask = __ballot(myinv >= 0);
        const bf16* yb = (const bf16*)(ws + WS_YB) + (size_t)(b * 16) * CAP * 1024;
        while (mask) {
            u32x2 w[4][4]; float sc[4];
#pragma unroll
            for (int q = 0; q < 4; ++q) { const bool on = mask != 0ull; const int e = on ? (int)__builtin_ctzll(mask) : 0; mask = on ? (mask & (mask - 1ull)) : 0ull;
                const int sl = __shfl(myinv, e); const size_t ro = on ? ((size_t)e * CAP + (size_t)sl) * 1024 : 0; sc[q] = on ? 1.f : 0.f;
#pragma unroll
                for (int j = 0; j < 4; ++j) w[q][j] = __builtin_nontemporal_load((const u32x2*)(yb + ro + 256 * j + 4 * lane)); }
#pragma unroll
            for (int q = 0; q < 4; ++q)
#pragma unroll
                for (int j = 0; j < 4; ++j) { v[j][0] += sc[q] * bflo(w[q][j].x); v[j][1] += sc[q] * bfhi(w[q][j].x); v[j][2] += sc[q] * bflo(w[q][j].y); v[j][3] += sc[q] * bfhi(w[q][j].y); }
        }
        float ss = 0.f;
#pragma unroll
        for (int j = 0; j < 4; ++j) ss += v[j][0] * v[j][0] + v[j][1] * v[j][1] + v[j][2] * v[j][2] + v[j][3] * v[j][3];
        const float rstd = rsqrtf(wave_sum(ss) * (1.f / 1024.f) + EPS);
#pragma unroll
        for (int j = 0; j < 4; ++j) __builtin_nontemporal_store(v[j] * rstd * gv[j], (f32x4*)(row + 256 * j + 4 * lane));
    }
}

__global__ void __launch_bounds__(NT, 2) fwd_kernel(Args args) {
    extern __shared__ __attribute__((aligned(16))) unsigned char lds_raw[];
    LAS unsigned char* lds = (LAS unsigned char*)lds_raw;
    volatile LAS unsigned* MISC = (volatile LAS unsigned*)(lds + MISC_OFF);
    const int tid0 = threadIdx.x, tid = tid0, wave = __builtin_amdgcn_readfirstlane(tid >> 6);
    const int G = gridDim.x, bx = blockIdx.x, vcu = (G % 8 == 0) ? (bx % 8) * (G / 8) + bx / 8 : bx;
    unsigned char* ws = args.ws;
    if (tid < 128) MISC[tid] = 0u;
    __syncthreads();
    XcdBarrier bar; bar.bar = (unsigned*)(ws + WS_CTL) + CW_BAR; bar.x = 0; bar.st = nullptr;
    if (!MK_MULTI) bar = xcd_barrier_post((unsigned*)(ws + WS_CTL) + CW_BAR, MISC + 8);
    const int lo = args.ph_lo, hi = args.ph_hi;
#define IN(k) (lo <= (k) && (k) < hi)
#define SEAM(k) do { if (IN(k) && IN((k) + 1)) xcd_barrier(bar); } while (0)
#define RUN(k, CODE) do { if (IN(k)) { int tid = tid0, lane; asm volatile("" : "+v"(tid)); lane = tid & 63; (void)lane; CODE; if (REP_PHASE == (k)) for (int _r = 0; _r < REP_COUNT; ++_r) { xcd_barrier(bar); CODE; } } SEAM(k); } while (0)
#define PH0 phase0(lds, args, vcu, G, tid, lane, wave)
#define PH1 phase1(lds, args, vcu, G, tid, lane, wave)
#define PH2 do { const int qs = vcu % 3;     \
        EpiInproj E{(bf16*)(ws + WS_KB), (bf16*)(ws + WS_VB), (bf16*)(ws + WS_QB), (bf16*)(ws + WS_SG), (bf16*)(ws + WS_PI), ws + WS_SM, 0, 1.f}; \
        EpiGates E8{(bf16*)(ws + WS_KB), (bf16*)(ws + WS_VB), (bf16*)(ws + WS_QB), (bf16*)(ws + WS_SG), (bf16*)(ws + WS_PI), ws + WS_SM, 8, 0.0625f}; \
        if (qs == 0) convert_all<1>(lds, args, vcu, G, lane, wave); \
        { SchedDense S{G, bx, 1024, 64, 8, (const char*)(ws + WS_H1), (const char*)(ws + WS_WIN), 0, 1 << 20, 2}; pg8::gemm_phase<EpiInproj, SchedDense, false, false>(lds, S, E); }     \
        if (qs == 1) convert_all<1>(lds, args, vcu, G, lane, wave); \
        { SchedDense S{G, bx, 1024, 64, 8, (const char*)(ws + WS_H1F), (const char*)(ws + WS_WINM), 0, 1 << 20, 1}; pg8::gemm_phase<EpiGates, SchedDense, false, true>(lds, S, E8); }     \
        if (qs == 2) convert_all<1>(lds, args, vcu, G, lane, wave); } while (0)
#define PH3 chunk_units(lds, args, vcu, G, tid, lane, wave)
#define PH4 do { if (wave < 4) phase4(args, G, tid, 256); else pool_units(args, vcu, G, lane, wave - 4, 4); } while (0)
#define PH5 phase5(lds, args, vcu, G, tid, lane, wave)
#define PH6 do { SchedPair S{G, bx, 512, (const char*)(ws + WS_AG), (const char*)(ws + WS_PO), (const char*)(ws + WS_WG), (const char*)(ws + WS_WC)}; \
        EpiMerge E{ws + WS_SM, (bf16*)(ws + WS_MG)}; pg8::gemm_phase<EpiMerge, SchedPair, false>(lds, S, E); } while (0)
#define PH7 do { SchedDense S{G, bx, 1024, 64, 4, (const char*)(ws + WS_MG), (const char*)(ws + WS_WO), 0, 1 << 20, 2}; \
        EpiOut E{(const float*)(ws + WS_MOD), (bf16*)(ws + WS_YD)}; pg8::gemm_phase<EpiOut, SchedDense, false>(lds, S, E); } while (0)
#define NITEM_HALF ((NE * 3 * 512 + 2 * G * NWAVES - 1) / (2 * G * NWAVES))
#define PH6C do { if (vcu & 1) convert_experts(lds, args, vcu, G, lane, wave, 0, NITEM_HALF); PH6; if (!(vcu & 1)) convert_experts(lds, args, vcu, G, lane, wave, 0, NITEM_HALF); } while (0)
#define PH7C do { if (vcu & 1) convert_experts(lds, args, vcu, G, lane, wave, NITEM_HALF, 2 * NITEM_HALF); PH7; if (!(vcu & 1)) convert_experts(lds, args, vcu, G, lane, wave, NITEM_HALF, 2 * NITEM_HALF); } while (0)
#define PH8 phase8(lds, args, vcu, G, tid, lane, wave)
#define PH9 phase9(lds, args, vcu, G, tid, lane, wave)
#define PH9B do { const int gw_ = vcu * NWAVES + wave, NGW_ = G * NWAVES;     \
        for (int r0_ = gw_ * 16; r0_ < NB * NE * CAP; r0_ += NGW_ * 16) { u32x4 t_[16]; \
            _Pragma("unroll") for (int q = 0; q < 16; ++q) { const int src_ = ((const int*)(ws + WS_IDX))[r0_ + q]; t_[q] = *(const u32x4*)(ws + WS_H2 + (size_t)src_ * 1024 + lane * 16); } \
            _Pragma("unroll") for (int q = 0; q < 16; ++q) *(u32x4*)(ws + WS_XS + (size_t)(r0_ + q) * 1024 + lane * 16) = t_[q]; } } while (0)
#define PH10 do { EpiMoe1 E{ws + WS_ACT}; SchedMoe1 S{G, bx, 1024, (const char*)(ws + WS_XS), (const char*)(ws + WS_WGU), 0, 1 << 20}; pg8::gemm_phase<EpiMoe1, SchedMoe1, false, true>(lds, S, E); } while (0)
#define PH11 do { SchedMoe2 S{G, bx, 1024, (const char*)(ws + WS_ACT), (const char*)(ws + WS_WD)}; \
        EpiMoe2 E{(bf16*)(ws + WS_YB), (const float*)(ws + WS_WSEL), (const float*)(ws + WS_MOD)}; pg8::gemm_phase<EpiMoe2, SchedMoe2, false, true>(lds, S, E); } while (0)
#define PH12 phase12(args, vcu, G, lane, wave)
    RUN(0, PH0); RUN(1, PH1); RUN(2, PH2); RUN(3, PH3);
#define PH3A chunk_units(lds, args, vcu, G, tid, lane, wave)
#define PH3B pool_units(args, vcu, G, lane, wave, 8)
    if (REP_PHASE == 30) { const int lane = tid & 63; xcd_barrier(bar); PH3A; xcd_barrier(bar); }
    if (REP_PHASE == 31) { const int lane = tid & 63; xcd_barrier(bar); PH3B; xcd_barrier(bar); } RUN(4, PH4); RUN(5, PH5); RUN(6, PH6); RUN(7, PH7); RUN(8, PH8); RUN(9, PH9); RUN(10, PH9B); RUN(11, PH10); RUN(12, PH11);
    if (REP_PHASE == 20) for (int _r = 0; _r < REP_COUNT; ++_r) xcd_barrier(bar);
    RUN(13, PH12);
#undef IN
#undef SEAM
#undef RUN
}

#ifndef MK_CHECK
#define MK_CHECK 0
#endif
#ifndef CHK_SKIP
#define CHK_SKIP -1
#endif
#if MK_CHECK
constexpr size_t WS_CHK = 299 * MiB;
__device__ __forceinline__ unsigned hashu(unsigned x) { x ^= x >> 16; x *= 0x7feb352dU; x ^= x >> 15; x *= 0x846ca68bU; x ^= x >> 16; return x; }
__device__ __forceinline__ float bfr(float f) { return bf2f(f2bf(f)); }
__device__ float f8d(unsigned char x) { const int sg = x >> 7, e = (x >> 3) & 15, m = x & 7; const float v = e ? ldexpf(1.f + m / 8.f, e - 7) : ldexpf(m / 8.f, -6); return sg ? -v : v; }
__device__ float f8r(float f) { return f8d((unsigned char)(pk4_fp8(f, 0.f, 0.f, 0.f) & 255u)); }
__device__ float x1_at(const Args& a, int m, int k) { return a.in[I_X][(size_t)m * 1024 + k] + bf2f(((const bf16*)(a.ws + WS_YD))[(size_t)m * 1024 + k]); }
__device__ float naive_rstd_x1(const Args& a, int m) { float ss = 0.f; for (int k = 0; k < 1024; ++k) { const float v = x1_at(a, m, k); ss += v * v; } return rsqrtf(ss / 1024.f + EPS); }
__device__ float gate_at(const Args& a, int m, int n) {
    const int pm = m >> 8, r = m & 255, ai = r >> 7, wr = (r >> 6) & 1, mm = (r >> 4) & 3, fr = r & 15, pg = n >> 8, c = n & 255, bj = c >> 7, wc = (c >> 5) & 3, fq = (c >> 3) & 3, j8 = c & 7;
    return (float)(a.ws + WS_SM)[gate_off(pm, pg, ai, mm, bj, wr, wc, fr, fq) + j8] * (1.f / 255.f); }
__device__ float naive_rstd(const float* row) { float ss = 0.f; for (int k = 0; k < 1024; ++k) ss += row[k] * row[k]; return rsqrtf(ss / 1024.f + EPS); }
__device__ float naive_la(const Args& a, int row, int dir, int col) {
    const float* RB = (const float*)(a.ws + WS_RB) + (size_t)row * 32 + dir * 16; float z = a.in[I_BDEC][dir * 256 + col];
    for (int j = 0; j < 16; ++j) z += RB[j] * a.in[I_WDU][(size_t)(dir * 16 + j) * 256 + col];
    return logsig_f(z) / 16.f;
}
__global__ void chk_kernel(Args a, int stage) {
    __shared__ float sh[256];
    const unsigned gid = blockIdx.x * blockDim.x + threadIdx.x; unsigned h = hashu(gid * 2654435761u + (unsigned)stage * 97u + 12345u); const unsigned h2 = hashu(h + 777u);
    unsigned char* ws = a.ws; float ref = 0.f, got = 0.f, atol = 1e-3f; bool active = true;
    const float* MOD = (const float*)(ws + WS_MOD);
    switch (stage) {
    case 0: { const int v = h % 3, n = (h >> 2) % 6144; ref = a.in[I_ADAB][n]; for (int k = 0; k < 1024; ++k) { const float c = (v < 2) ? a.in[I_C][v * 1024 + k] : a.in[I_CCTX][k]; ref += c / (1.f + expf(-c)) * a.in[I_ADAW][(size_t)k * 6144 + n]; } got = MOD[v * 6144 + n]; atol = 0.01f; } break;
    case 1: { const int sel = (h >> 28) & 3, n = h % 4096, k = (h >> 12) % 1024;
        if (sel < 2) { if (n < 2048) { ref = bfr(a.in[I_WIN][(size_t)k * DIN + n + (n >= 768 ? 32 : 0)]); got = bf2f(((const bf16*)(ws + WS_WIN))[(size_t)n * 1024 + k]); } else { ref = f8r(16.f * a.in[I_WIN][(size_t)k * DIN + n + 32]); got = f8d((ws + WS_WINM)[(size_t)(n - 2048) * 1024 + k]); } }
        else if (sel == 2) { ref = bfr(a.in[I_WOUT][(size_t)k * 1024 + (n & 1023)]); got = bf2f(((const bf16*)(ws + WS_WO))[(size_t)(n & 1023) * 1024 + k]); }
        else { ref = bfr(a.in[I_WGLA][(size_t)(k & 511) * 1024 + (n & 1023)]); got = bf2f(((const bf16*)(ws + WS_WG))[(size_t)(n & 1023) * 512 + (k & 511)]); } atol = 1e-4f; } break;
    case 2: { const int n = h % 1024, kk = (h >> 10) % 512, g = kk >> 7, c = kk & 127; for (int d = 0; d < 128; ++d) ref += a.in[I_POOLW][(size_t)(g * 128 + c) * 128 + d] * a.in[I_POOLS][g * 128 + d] * a.in[I_WPOOL][(size_t)(g * 128 + d) * 1024 + n];
        got = bf2f(((const bf16*)(ws + WS_WC))[(size_t)n * 512 + kk]); atol = 0.002f; } break;
    case 3: { const int m = h % M, k = (h >> 14) % 1024, b = m >> 13; const float* row = a.in[I_X] + (size_t)m * 1024; const float rstd = naive_rstd(row);
        ref = row[k] * rstd * a.in[I_N1G][k] * (1.f + MOD[b * 6144 + 1024 + k]) + MOD[b * 6144 + k]; got = bf2f(((const bf16*)(ws + WS_H1))[(size_t)m * 1024 + k]); atol = 0.01f; } break;
    case 4: { const int m = h % MT, c = (h >> 15) % 32, mi = (m < M) ? (m >> 13) : 2; const float* row = (m < M) ? a.in[I_X] + (size_t)m * 1024 : a.in[I_CTX] + (size_t)(m - M) * 1024; const float rstd = naive_rstd(row);
        for (int k = 0; k < 1024; ++k) ref += (row[k] * rstd * a.in[I_N1G][k] * (1.f + MOD[mi * 6144 + 1024 + k]) + MOD[mi * 6144 + k]) * a.in[I_WIN][(size_t)k * DIN + 768 + c];
        got = ((const float*)(ws + WS_RB))[(size_t)m * 32 + c]; atol = 0.01f; } break;
    case 5: { const int r = h % 512, n = (h >> 9) % 768; const float* row = a.in[I_CTX] + (size_t)r * 1024; const float rstd = naive_rstd(row);
        for (int k = 0; k < 1024; ++k) ref += bfr(row[k] * rstd * a.in[I_N1G][k] * (1.f + MOD[2 * 6144 + 1024 + k]) + MOD[2 * 6144 + k]) * bf2f(((const bf16*)(ws + WS_WIN))[(size_t)n * 1024 + k]);
        got = (n < 256) ? bf2f(((const bf16*)(ws + WS_KB))[(size_t)(M + r) * 256 + n]) : bf2f(((const bf16*)(ws + WS_VB))[(size_t)(M + r) * 512 + n - 256]); atol = 0.03f; } break;
    case 6: { const int m = h % M, n = (h >> 14) % 4096; const bf16* hr = (const bf16*)(ws + WS_H1) + (size_t)m * 1024; const bf16* wr_ = (const bf16*)(ws + WS_WIN) + (size_t)n * 1024; float d = 0.f;
        if (n < 2048) { for (int k = 0; k < 1024; ++k) d += bf2f(hr[k]) * bf2f(wr_[k]); }
        else { for (int k = 0; k < 1024; ++k) d += f8d((ws + WS_H1F)[(size_t)m * 1024 + k]) * f8d((ws + WS_WINM)[(size_t)(n - 2048) * 1024 + k]); d *= 0.0625f; }
        if (n < 256) { ref = d; got = bf2f(((const bf16*)(ws + WS_KB))[(size_t)m * 256 + n]); }
        else if (n < 768) { ref = d; got = bf2f(((const bf16*)(ws + WS_VB))[(size_t)m * 512 + n - 256]); }
        else if (n < 1024) { ref = d * 0.125f; got = bf2f(((const bf16*)(ws + WS_QB))[(size_t)m * 256 + n - 768]); }
        else if (n < 1536) { ref = d / (1.f + expf(-d)); got = bf2f(((const bf16*)(ws + WS_SG))[(size_t)m * 512 + n - 1024]); }
        else if (n < 2048) { ref = d; got = bf2f(((const bf16*)(ws + WS_PI))[(size_t)m * 512 + n - 1536]); }
        else { ref = 1.f / (1.f + expf(-d)); got = gate_at(a, m, n - 2048); } atol = 0.02f; } break;
    case 7: { const int m = h % M, col = (h >> 14) % 256, dir = (h >> 22) & 1, t = m & 63, m0 = m - t;
        for (int s = 0; s < 64; ++s) if (dir ? (s >= t) : (s <= t)) ref += naive_la(a, m0 + s, dir, col);
        got = (dir ? a.out + (size_t)M * 256 : a.out)[(size_t)m * 256 + col]; atol = 0.003f; } break;
    case 8: case 9: { const int dir = h & 1, bh = (h >> 1) & 7, slot = (stage == 9) ? 128 + ((h >> 4) & 3) : ((h >> 4) & 127), dv = (h >> 11) & 127, dk = (h >> 18) & 63, b = bh >> 2, hh = bh & 3;
        const int row0 = (slot < 128) ? b * SEQ + slot * 64 : M + b * LC + (slot - 128) * 64; float la[64]; float tot = 0.f;
        for (int s = 0; s < 64; ++s) tot += naive_la(a, row0 + s, dir, hh * 64 + dk);
        float run = 0.f;
        if (!dir) { for (int s = 0; s < 64; ++s) { run += naive_la(a, row0 + s, 0, hh * 64 + dk); ref += bf2f(((const bf16*)(ws + WS_VB))[(size_t)(row0 + s) * 512 + hh * 128 + dv]) * bfr(bf2f(((const bf16*)(ws + WS_KB))[(size_t)(row0 + s) * 256 + hh * 64 + dk]) * expf(tot - run)); } }
        else { for (int s = 63; s >= 0; --s) { run += naive_la(a, row0 + s, 1, hh * 64 + dk); ref += bf2f(((const bf16*)(ws + WS_VB))[(size_t)(row0 + s) * 512 + hh * 128 + dv]) * bfr(bf2f(((const bf16*)(ws + WS_KB))[(size_t)(row0 + s) * 256 + hh * 64 + dk]) * expf(tot - run)); } }
        (void)la;
        if ((h >> 30) & 1) { ref = expf(tot); got = ((const float*)(ws + WS_DEC))[((size_t)(dir * 8 + bh) * NSLOT + slot) * 64 + dk]; atol = 1e-3f; }
        else { got = bf2f(((const bf16*)(ws + WS_KV))[((size_t)(dir * 8 + bh) * NSLOT + slot) * 8192 + dv * 64 + dk]); atol = 0.1f; } } break;
    case 10: { const int m = h % M, col = (h >> 14) % 512, g = col >> 7, half = 1 << g, b = m >> 13, l = m & 8191, r = l >> 6, c = l & 63; const bf16* PI = (const bf16*)(ws + WS_PI);
        const int lo_r = max(r - half, 0), hi_r = min(r + half, 128), lo_c = max(c - half, 0), hi_c = min(c + half, 64); float sm = 0.f;
        for (int rr = lo_r; rr < hi_r; ++rr) for (int cc = lo_c; cc < hi_c; ++cc) sm += bf2f(PI[(size_t)(b * SEQ + rr * 64 + cc) * 512 + col]);
        ref = sm / (float)((hi_r - lo_r) * (hi_c - lo_c)) - bf2f(PI[(size_t)m * 512 + col]); got = bf2f(((const bf16*)(ws + WS_PO))[(size_t)m * 512 + col]); atol = 0.02f; } break;
    case 11: { const int dir = h & 1, bh = (h >> 1) & 7, n = (h >> 4) & 127, e8 = (h >> 11) & 8191, dk = e8 & 63; float s = 0.f;
        const bf16* kvp = (const bf16*)(ws + WS_KV) + (size_t)((dir * 8 + bh) * NSLOT) * 8192 + e8; const float* dp = (const float*)(ws + WS_DEC) + (size_t)((dir * 8 + bh) * NSLOT) * 64 + dk;
        if (!dir) { for (int j = 128; j < 132; ++j) s = dp[j * 64] * s + bf2f(kvp[(size_t)j * 8192]); for (int j = 0; j < n; ++j) s = dp[j * 64] * s + bf2f(kvp[(size_t)j * 8192]); }
        else { for (int j = 131; j >= 128; --j) s = dp[j * 64] * s + bf2f(kvp[(size_t)j * 8192]); for (int j = 127; j > n; --j) s = dp[j * 64] * s + bf2f(kvp[(size_t)j * 8192]); }
        ref = s; got = bf2f(((const bf16*)(ws + WS_ST))[(size_t)((dir * 8 + bh) * NCH + n) * 8192 + e8]); atol = 0.1f; } break;
    case 12: {
        const unsigned hb = hashu(blockIdx.x * 7919u + 5u); const int m = hb % M, hh = (hb >> 14) & 3, b = m >> 13, l = m & 8191, n = l >> 6, t = l & 63, row0 = m - t, bh = b * 4 + hh, dv = threadIdx.x & 127;
        const float* BF = a.out; const float* CB = a.out + (size_t)M * 256; const bf16* QB = (const bf16*)(ws + WS_QB); const bf16* KB = (const bf16*)(ws + WS_KB); const bf16* VB = (const bf16*)(ws + WS_VB); const bf16* ST = (const bf16*)(ws + WS_ST);
        if (threadIdx.x < 128) { const int j = threadIdx.x & 63, dir = threadIdx.x >> 6; float sc = 0.f;
            const bool keep = dir ? (j >= t) : (j <= t);
            if (keep) for (int d = 0; d < 64; ++d) { const size_t gq = (size_t)m * 256 + hh * 64 + d, gk = (size_t)(row0 + j) * 256 + hh * 64 + d; const float* P = dir ? CB : BF; sc += bf2f(QB[gq]) * bf2f(KB[gk]) * expf(P[gq] - P[gk]); }
            sh[threadIdx.x] = sc; }
        __syncthreads();
        float o = 0.f;
        for (int d = 0; d < 64; ++d) { const size_t gq = (size_t)m * 256 + hh * 64 + d; const float q = bf2f(QB[gq]);
            o += q * expf(BF[gq]) * bf2f(ST[((size_t)((0 * 8 + bh) * NCH + n) * 128 + dv) * 64 + d]) + q * expf(CB[gq]) * bf2f(ST[((size_t)((1 * 8 + bh) * NCH + n) * 128 + dv) * 64 + d]); }
        for (int j = 0; j < 64; ++j) o += (sh[j] + sh[64 + j]) * bf2f(VB[(size_t)(row0 + j) * 512 + hh * 128 + dv]);
        __syncthreads(); sh[128 + dv] = o * o; __syncthreads();
        float ss = 0.f; for (int d = 0; d < 128; ++d) ss += sh[128 + d];
        const size_t gi = (size_t)m * 512 + hh * 128 + dv;
        ref = o * rsqrtf(ss / 128.f + EPS) * a.in[I_GNG][dv] * bf2f(((const bf16*)(ws + WS_SG))[gi]); got = bf2f(((const bf16*)(ws + WS_AG))[gi]); atol = 0.03f; } break;
    case 13: { const int m = h % M, n = (h >> 14) % 1024; float g = 0.f, p = 0.f; const bf16* AG = (const bf16*)(ws + WS_AG) + (size_t)m * 512; const bf16* PO = (const bf16*)(ws + WS_PO) + (size_t)m * 512;
        for (int k = 0; k < 512; ++k) { g += bf2f(AG[k]) * bf2f(((const bf16*)(ws + WS_WG))[(size_t)n * 512 + k]); p += bf2f(PO[k]) * bf2f(((const bf16*)(ws + WS_WC))[(size_t)n * 512 + k]); }
        ref = gate_at(a, m, n) * g + gate_at(a, m, 1024 + n) * p; got = bf2f(((const bf16*)(ws + WS_MG))[(size_t)m * 1024 + n]); atol = 0.03f; } break;
    case 14: { const int m = h % M, n = (h >> 14) % 1024, b = m >> 13; float d = 0.f; for (int k = 0; k < 1024; ++k) d += bf2f(((const bf16*)(ws + WS_MG))[(size_t)m * 1024 + k]) * bf2f(((const bf16*)(ws + WS_WO))[(size_t)n * 1024 + k]);
        ref = bfr(MOD[b * 6144 + 2048 + n] * d); got = bf2f(((const bf16*)(ws + WS_YD))[(size_t)m * 1024 + n]); atol = 0.005f; } break;
    case 15: { const int m = h % M, k = (h >> 14) % 1024, b = m >> 13; const float rstd = naive_rstd_x1(a, m);
        ref = x1_at(a, m, k) * rstd * a.in[I_N2G][k] * (1.f + MOD[b * 6144 + 4096 + k]) + MOD[b * 6144 + 3072 + k]; got = f8d((ws + WS_H2)[(size_t)m * 1024 + k]); atol = 0.02f; ref = f8r(ref); } break;
    case 16: { const int m = h % M, e = (h >> 14) & 15, b = m >> 13; const float rstd = naive_rstd_x1(a, m); float mx = -1e30f, mye = 0.f, sm = 0.f;
        for (int pass = 0; pass < 2; ++pass) for (int ee = 0; ee < 16; ++ee) { float lg = 0.f; for (int k = 0; k < 1024; ++k) lg += (x1_at(a, m, k) * rstd * a.in[I_N2G][k] * (1.f + MOD[b * 6144 + 4096 + k]) + MOD[b * 6144 + 3072 + k]) * a.in[I_WROUTER][k * 16 + ee];
            if (pass == 0) mx = fmaxf(mx, lg); else { const float ex = expf(lg - mx); sm += ex; if (ee == e) mye = ex; } }
        ref = mye / sm; got = ((const float*)(ws + WS_AFF))[(size_t)(b * 16 + e) * SEQ + (m & 8191)]; atol = 0.001f; } break;
    case 17: { const int be = h & 31, slot = (h >> 5) & 1023, b = be >> 4, e = be & 15; const int row = ((const int*)(ws + WS_IDX))[be * CAP + slot]; const float* aff = (const float*)(ws + WS_AFF) + (size_t)be * SEQ; float bad = 0.f;
        if (row < b * SEQ || row >= (b + 1) * SEQ) bad += 1.f; else { const int l = row & 8191; if (((const int*)(ws + WS_INV))[(size_t)row * 16 + e] != slot) bad += 1.f; if (((const float*)(ws + WS_WSEL))[be * CAP + slot] != aff[l]) bad += 1.f;
            int cnt = 0; for (int j = 0; j < SEQ; ++j) cnt += (aff[j] > aff[l]) ? 1 : 0; if (cnt >= CAP) bad += 1.f;
            const int l2 = h2 & 8191; if (((const int*)(ws + WS_INV))[(size_t)(b * SEQ + l2) * 16 + e] < 0) { int c2 = 0; for (int j = 0; j < SEQ; ++j) c2 += (aff[j] >= aff[l2]) ? 1 : 0; if (c2 <= CAP) bad += 1.f; } }
        ref = 0.f; got = bad; atol = 0.5f; } break;
    case 18: { const int e = h & 15, mat = (h >> 4) % 3, n = (h >> 8) & 1023, k = (h >> 18) & 1023;
        if (mat == 0) { ref = f8r(16.f * a.in[I_WGATE][(size_t)e * 1048576 + (size_t)k * 1024 + n]); got = f8d((ws + WS_WGU)[((size_t)e * 2048 + (n >> 7) * 256 + (n & 127)) * 1024 + k]); }
        else if (mat == 1) { ref = f8r(16.f * a.in[I_WUP][(size_t)e * 1048576 + (size_t)k * 1024 + n]); got = f8d((ws + WS_WGU)[((size_t)e * 2048 + (n >> 7) * 256 + 128 + (n & 127)) * 1024 + k]); }
        else { ref = f8r(16.f * a.in[I_WDOWN][(size_t)e * 1048576 + (size_t)k * 1024 + n]); got = f8d((ws + WS_WD)[((size_t)e * 1024 + n) * 1024 + k]); } atol = 1e-4f; } break;
    case 19: { const int be = h & 31, slot = (h >> 5) & 1023, f = (h >> 15) & 1023, e = be & 15; const int row = ((const int*)(ws + WS_IDX))[be * CAP + slot]; float g = 0.f, u = 0.f;
        const unsigned char* hr = ws + WS_H2 + (size_t)row * 1024; const unsigned char* wg = ws + WS_WGU + ((size_t)e * 2048 + (f >> 7) * 256 + (f & 127)) * 1024; const unsigned char* wu = wg + 128 * 1024;
        for (int k = 0; k < 1024; ++k) { g += f8d(hr[k]) * f8d(wg[k]); u += f8d(hr[k]) * f8d(wu[k]); }
        g *= 0.0625f; u *= 0.0625f; ref = f8r(g / (1.f + expf(-g)) * u); got = f8d((ws + WS_ACT)[((size_t)be * CAP + slot) * 1024 + f]); atol = 0.03f; } break;
    case 20: { const int be = h & 31, slot = (h >> 5) & 1023, n = (h >> 15) & 1023, e = be & 15, b = be >> 4; float d = 0.f;
        for (int f = 0; f < 1024; ++f) d += f8d((ws + WS_ACT)[((size_t)be * CAP + slot) * 1024 + f]) * f8d((ws + WS_WD)[((size_t)e * 1024 + n) * 1024 + f]);
        ref = d * 0.0625f * ((const float*)(ws + WS_WSEL))[be * CAP + slot] * MOD[b * 6144 + 5120 + n]; got = bf2f(((const bf16*)(ws + WS_YB))[((size_t)be * CAP + slot) * 1024 + n]); atol = 0.002f; } break;
    default: active = false;
    }
    if (active) { float e = fabsf(got - ref) / (atol + 0.03f * fabsf(ref)); if (!(e == e)) e = 1e9f; atomicMax((unsigned*)(ws + WS_CHK) + stage, __float_as_uint(e)); }
}
__global__ void chk_final(Args a) {
    __shared__ int code;
    if (threadIdx.x == 0) { int c = 0; for (int s = 20; s >= 0; --s) if (s > CHK_SKIP && __uint_as_float(((const unsigned*)(a.ws + WS_CHK))[s]) > 1.f) c = s + 1; code = c; }
    __syncthreads();
    const float sc = 1.f + 0.1f * (float)code;
    for (size_t i = (size_t)blockIdx.x * blockDim.x + threadIdx.x; i < (size_t)M * D; i += (size_t)gridDim.x * blockDim.x) a.out[i] *= sc;
}
#endif

extern "C" void kernel_launch(void* const* d_in, const int* in_sizes, int n_in, void* d_out, int out_size, void* d_ws, size_t ws_size, hipStream_t stream) {
    static int grid = 0;
    if (grid == 0) {
        if (n_in != 22 || out_size != M * D || ws_size < WS_END) { fprintf(stderr, "kernel_launch: unexpected shapes (n_in %d, out %d, ws %zu < %zu)\n", n_in, out_size, ws_size, (size_t)WS_END); grid = -1; return; }
        int dev = 0, cus = 0, per_cu = 0;
        if (hipGetDevice(&dev) != hipSuccess || hipDeviceGetAttribute(&cus, hipDeviceAttributeMultiprocessorCount, dev) != hipSuccess) { grid = -1; return; }
        if (hipFuncSetAttribute((const void*)fwd_kernel, hipFuncAttributeMaxDynamicSharedMemorySize, LDS_BYTES) != hipSuccess) { fprintf(stderr, "kernel_launch: hipFuncSetAttribute failed\n"); grid = -1; return; }
        if (hipOccupancyMaxActiveBlocksPerMultiprocessor(&per_cu, (const void*)fwd_kernel, NT, LDS_BYTES) != hipSuccess || per_cu < 1) { fprintf(stderr, "kernel_launch: occupancy query says %d\n", per_cu); per_cu = 1; }
        (void)hipGetLastError();
        grid = cus;
    }
    if (grid < 0) return;
    (void)hipMemsetAsync((char*)d_ws + WS_CTL, 0, CTL_ZERO_BYTES, stream);
    Args a{};
    for (int i = 0; i < 22; ++i) a.in[i] = (const float*)d_in[i];
    a.out = (float*)d_out; a.ws = (unsigned char*)d_ws;
#if MK_MULTI
    for (int p = 0; p < NPHASE; ++p) { a.ph_lo = p; a.ph_hi = p + 1; hipLaunchKernelGGL(fwd_kernel, dim3(grid), dim3(NT), LDS_BYTES, stream, a);
#if MK_CHECK
        if (p == 0) (void)hipMemsetAsync((char*)d_ws + WS_CHK, 0, 4096, stream);
        static const int after[21] = {0, 0, 0, 1, 1, 1, 2, 3, 3, 3, 4, 4, 5, 6, 7, 8, 8, 9, 10, 11, 12};
        for (int st = 0; st < 21; ++st) if (after[st] == p) hipLaunchKernelGGL(chk_kernel, dim3(st == 12 ? 1024 : 32), dim3(128), 0, stream, a, st);
        if (p == NPHASE - 1) hipLaunchKernelGGL(chk_final, dim3(1024), dim3(256), 0, stream, a);
#endif
    }
#else
    a.ph_lo = 0; a.ph_hi = NPHASE;
#if MK_COOP
    void* kargs[] = {&a};
    hipError_t e = hipLaunchCooperativeKernel((const void*)fwd_kernel, dim3(grid), dim3(NT), kargs, LDS_BYTES, stream);
    if (e != hipSuccess) fprintf(stderr, "kernel_launch: cooperative launch failed: %s (grid %d)\n", hipGetErrorString(e), grid);
#else
    hipLaunchKernelGGL(fwd_kernel, dim3(grid), dim3(NT), LDS_BYTES, stream, a);
#endif
#endif
}
```

```cpp
#include <hip/hip_runtime.h>
#include <cstdio>
#include <cstdint>

#define LAS __attribute__((address_space(3)))
#define GAS __attribute__((address_space(1)))
typedef unsigned short bf16;
typedef short bf16x8 __attribute__((ext_vector_type(8)));
typedef float f32x4 __attribute__((ext_vector_type(4)));
typedef float f32x2 __attribute__((ext_vector_type(2)));
typedef unsigned u32x4 __attribute__((ext_vector_type(4)));
typedef unsigned u32x2 __attribute__((ext_vector_type(2)));

#ifndef ABL_NOMOE
#define ABL_NOMOE 0
#endif
#ifndef REP_PHASE
#define REP_PHASE -1
#endif
#ifndef REP_COUNT
#define REP_COUNT 1
#endif
#ifndef MK_COOP
#define MK_COOP 1
#endif
#ifndef MK_MULTI
#define MK_MULTI 0
#endif

constexpr int D = 1024, NB = 2, SEQ = 8192, M = NB * SEQ, LC = 256, MC = NB * LC, MT = M + MC;
constexpr int DIN = 4128;
constexpr int NCH = SEQ / 64, NCHC = LC / 64, NSLOT = NCH + NCHC;
constexpr int NE = 16, CAP = 1024;
constexpr float EPS = 1e-6f;
constexpr int NWAVES = 8, NT = 512;
constexpr int NPHASE = 14;

constexpr size_t MiB = 1u << 20;
constexpr size_t WS_CTL = 0, CTL_ZERO_BYTES = 64 * 1024;
constexpr size_t WS_MOD = 1 * MiB;
constexpr size_t WS_DEC = 1 * MiB + 128 * 1024;
constexpr size_t WS_WIN = 2 * MiB, WS_WO = 10 * MiB, WS_WG = 12 * MiB, WS_WC = 13 * MiB;
constexpr size_t WS_AFF = 14 * MiB, WS_INV = 15 * MiB, WS_IDX = 16 * MiB, WS_WSEL = 16 * MiB + 256 * 1024;
constexpr size_t WS_H1 = 20 * MiB;
constexpr size_t WS_ST = 20 * MiB, WS_H2 = 20 * MiB;
constexpr size_t WS_KB = 52 * MiB, WS_VB = 61 * MiB, WS_QB = 78 * MiB, WS_SG = 86 * MiB, WS_PI = 102 * MiB, WS_RB = 118 * MiB;
constexpr size_t WS_AG = 102 * MiB;
constexpr size_t WS_SM = 121 * MiB;
constexpr size_t WS_KV = 249 * MiB;
constexpr size_t WS_PO = 282 * MiB;
constexpr size_t WS_MG = 249 * MiB;
constexpr size_t WS_WGU = 185 * MiB, WS_WD = 52 * MiB, WS_ACT = 121 * MiB, WS_YB = 185 * MiB;
constexpr size_t WS_H1F = 249 * MiB;
constexpr size_t WS_WINM = 265 * MiB;
constexpr size_t WS_YD = 153 * MiB;
constexpr size_t WS_XS = 68 * MiB;
constexpr size_t WS_END = 300 * MiB;
constexpr int CW_BAR = 1024;

constexpr int LDS_BYTES = 155648;
constexpr int MISC_OFF = 153600;

#define LDS_WAIT() asm volatile("s_waitcnt lgkmcnt(0)" ::: "memory")
#define VM_WAIT() asm volatile("s_waitcnt vmcnt(0)" ::: "memory")
__device__ __forceinline__ unsigned f2bf(float f) { unsigned u = __builtin_bit_cast(unsigned, f); return (u + 0x7fffu + ((u >> 16) & 1u)) >> 16; }
__device__ __forceinline__ unsigned pk2(float lo, float hi) { return f2bf(lo) | (f2bf(hi) << 16); }
__device__ __forceinline__ float bf2f(unsigned h) { return __builtin_bit_cast(float, h << 16); }
__device__ __forceinline__ float bflo(unsigned w) { return __builtin_bit_cast(float, w << 16); }
__device__ __forceinline__ float bfhi(unsigned w) { return __builtin_bit_cast(float, w & 0xffff0000u); }
__device__ __forceinline__ unsigned cvt_pk_bf16(float lo, float hi) { unsigned r; asm volatile("v_cvt_pk_bf16_f32 %0, %1, %2" : "=v"(r) : "v"(lo), "v"(hi)); return r; }
__device__ __forceinline__ unsigned pk4_fp8(float a, float b, float c, float d) { int w = 0; w = __builtin_amdgcn_cvt_pk_fp8_f32(a, b, w, false); w = __builtin_amdgcn_cvt_pk_fp8_f32(c, d, w, true); return (unsigned)w; }
__device__ __forceinline__ float wave_sum(float v) {
#pragma unroll
    for (int o = 1; o < 64; o <<= 1) v += __shfl_xor(v, o);
    return v;
}
__device__ __forceinline__ float silu_f(float x) { return x / (1.f + __expf(-x)); }
__device__ __forceinline__ float sigmoid_f(float x) { return 1.f / (1.f + __expf(-x)); }
__device__ __forceinline__ float logsig_f(float z) { return fminf(z, 0.f) - log1pf(expf(-fabsf(z))); }

#define XB_TMO      128
#define XB_XCNT(j)  (256  + 64 * (j))
#define XB_XSUB(j)  (1280 + 64 * (j))
#define XB_XGEN(j)  (2304 + 64 * (j))
#define XB_TOP      3328
#define XB_TOPGEN   3392
#define XCD_BAR_WORDS 3456
#define XB_SPIN_CAP (1u << 20)
__device__ __forceinline__ unsigned xb_ld(unsigned* p)              { return __hip_atomic_load(p, __ATOMIC_RELAXED, __HIP_MEMORY_SCOPE_AGENT); }
__device__ __forceinline__ unsigned xb_add(unsigned* p, unsigned v) { return __hip_atomic_fetch_add(p, v, __ATOMIC_RELAXED, __HIP_MEMORY_SCOPE_AGENT); }
__device__ __forceinline__ unsigned xb_xcc_id() { return (unsigned)__builtin_amdgcn_s_getreg((3 << 11) | 20) & 0xFu; }
#define XB_SPIN(cond, bar) do { unsigned _sp = 0; while (cond) { __builtin_amdgcn_s_sleep(1); \
    if ((++_sp & 255u) == 0u) { if (xb_ld(&(bar)[XB_TMO])) break; if (_sp > XB_SPIN_CAP) { atomicAdd(&(bar)[XB_TMO], 1u); break; } } } } while (0)
struct XcdBarrier { unsigned* bar; unsigned x; volatile LAS unsigned* st; };
__device__ __forceinline__ XcdBarrier xcd_barrier_post(unsigned* bar, volatile LAS unsigned* st) {
    XcdBarrier b; b.bar = bar; b.x = xb_xcc_id(); b.st = st;
    if (threadIdx.x == 0) (void)xb_add(&bar[XB_XCNT(b.x)], 1u);
    return b;
}
__device__ __forceinline__ void xcd_barrier_complete(unsigned* bar, unsigned x, unsigned& nloc, unsigned& nx) {
    const unsigned G = gridDim.x * gridDim.y * gridDim.z;
    unsigned sum, cnt, mine, sp = 0u;
    for (;;) {
        sum = 0u; cnt = 0u; mine = 0u;
#pragma unroll
        for (unsigned j = 0; j < 16; ++j) { const unsigned c = xb_ld(&bar[XB_XCNT(j)]); sum += c; cnt += (c > 0u) ? 1u : 0u; mine = (j == x) ? c : mine; }
        if (sum == G) break;
        __builtin_amdgcn_s_sleep(1);
        if ((++sp & 255u) == 0u) { if (xb_ld(&bar[XB_TMO])) break; if (sp > XB_SPIN_CAP) { atomicAdd(&bar[XB_TMO], 1u); break; } }
    }
    nloc = mine > 0u ? mine : 1u; nx = cnt > 0u ? cnt : 1u;
}
__device__ __forceinline__ void xcd_barrier(const XcdBarrier& b) {
    asm volatile("s_waitcnt vmcnt(0)" ::: "memory");
    __syncthreads();
    if (threadIdx.x == 0) {
        unsigned* bar = b.bar;
        __builtin_amdgcn_s_waitcnt(0);
        unsigned nloc = b.st[0], nx = b.st[1];
        if (nloc == 0u) { xcd_barrier_complete(bar, b.x, nloc, nx); b.st[0] = nloc; b.st[1] = nx; }
        const unsigned old = xb_add(&bar[XB_XSUB(b.x)], 1u);
        const unsigned gen = old / nloc;
        if (old + 1u == (gen + 1u) * nloc) {
            __builtin_amdgcn_fence(__ATOMIC_RELEASE, "agent");
            asm volatile("s_waitcnt vmcnt(0)" ::: "memory");
            const unsigned og = xb_add(&bar[XB_TOP], 1u);
            const unsigned tg = og / nx;
            if (og + 1u == (tg + 1u) * nx) xb_add(&bar[XB_TOPGEN], 1u);
            else XB_SPIN(xb_ld(&bar[XB_TOPGEN]) == tg, bar);
            __builtin_amdgcn_fence(__ATOMIC_ACQUIRE, "agent");
            xb_add(&bar[XB_XGEN(b.x)], 1u);
            asm volatile("s_waitcnt vmcnt(0)" ::: "memory");
        } else {
            XB_SPIN(xb_ld(&bar[XB_XGEN(b.x)]) == gen, bar);
            __builtin_amdgcn_fence(__ATOMIC_ACQUIRE, "agent");
            asm volatile("s_waitcnt vmcnt(0)" ::: "memory");
        }
    }
    __syncthreads();
}

namespace pg8 {
constexpr int BM = 256, BK = 64, HALF = 128, HTB = HALF * BK * 2, STAGE_BYTES = 8 * HTB;
__device__ __forceinline__ int lds_byte(int r, int c) { const int st = (r >> 4) * 2 + (c >> 5), rr = r & 15, cc = c & 31, ob = rr * 64 + cc * 2; return st * 1024 + (ob ^ (((ob >> 9) & 1) << 5)); }
__device__ __forceinline__ void stage_rc(int b, int& R, int& C) { const int st = b / 1024, sb = b % 1024, swz = sb ^ (((sb >> 9) & 1) << 5); R = (st >> 1) * 16 + swz / 64; C = (st & 1) * 32 + (swz % 64) / 2; }
__device__ __forceinline__ int perm32(int rho) { const int n = rho >> 4, i = rho & 15; return 8 * (i >> 2) + 4 * n + (i & 3); }
struct Unit { int pm, pn, aux, keep; };
typedef int v8i __attribute__((ext_vector_type(8)));
typedef int v4i __attribute__((ext_vector_type(4)));
__device__ __forceinline__ void xcd_tile(int L, int nM, int nN, int& pm, int& pn) {
    const int nwg = nM * nN; int wgid = L;
    { const int q = nwg / 8, r = nwg % 8, xcd = wgid % 8, off = wgid / 8; wgid = (xcd < r ? xcd * (q + 1) : r * (q + 1) + (xcd - r) * q) + off; }
    const int nig = 8 * nN, gid = wgid / nig, fm = gid * 8, gsz = (nM - fm) < 8 ? (nM - fm) : 8;
    pm = fm + ((wgid % nig) % gsz); pn = (wgid % nig) / gsz;
}

template <class Epi, class Sched, bool GATHER, bool FP8 = false>
__device__ __forceinline__ void gemm_phase(LAS unsigned char* lds, const Sched& S, const Epi& E) {
    int tid = threadIdx.x; asm volatile("" : "+v"(tid));
    const int wid = __builtin_amdgcn_readfirstlane(tid >> 6), lane = tid & 63, wr = wid >> 2, wc = wid & 3, fr = lane & 15, fq = lane >> 4;
    const int K = S.K, KB = FP8 ? K : 2 * K, nt = KB / (2 * BK);
    unsigned voffA[2], voffB[2]; int Rs[2], Cb[2];
#pragma unroll
    for (int i = 0; i < 2; ++i) { int R, C; stage_rc(tid * 16 + i * 8192, R, C); const int Rb = Epi::PERM ? ((R & ~31) + perm32(R & 31)) : R;
        Rs[i] = R; Cb[i] = C * 2; voffA[i] = (unsigned)(R * KB + C * 2); voffB[i] = (unsigned)(Rb * KB + C * 2); }
    const size_t kstep = (size_t)(BK * 2);
    const size_t hstep = (size_t)HALF * KB;
    const size_t hstepA = GATHER ? 0 : hstep;
    const unsigned ldsw = (unsigned)wid * 1024u;
    const int aoff = FP8 ? lds_byte(wr * 64 + fr, fq * 16) : lds_byte(wr * 64 + fr, fq * 8), boff = FP8 ? lds_byte(wc * 32 + fr, fq * 16) : lds_byte(wc * 32 + fr, fq * 8);
#define PG8_SA(b, h) (((b) * 2 + (h)) * HTB)
#define PG8_SB(b, h) ((4 + (b) * 2 + (h)) * HTB)
#define PG8_STAGE(bufoff, gbase, voff, W) do { _Pragma("unroll") for (int _i = 0; _i < 2; ++_i) { \
        if constexpr (FP8) __builtin_amdgcn_raw_ptr_buffer_load_lds(rsrc##W, (LAS unsigned*)(lds + (bufoff) + ldsw + _i * 8192), 16, (int)(voff)[_i], (int)(unsigned)((const char*)(gbase) - base##W), 0, 0); \
        else __builtin_amdgcn_global_load_lds((const unsigned*)((const char*)(gbase) + (voff)[_i]), (LAS unsigned*)(lds + (bufoff) + ldsw + _i * 8192), 16, 0, 0); } } while (0)
#define PG8_LDA(dst, b, h) do { _Pragma("unroll") for (int m = 0; m < 4; ++m) { \
        if constexpr (FP8) { const v4i _lo = *(const LAS v4i*)(lds + PG8_SA(b, h) + aoff + m * 2048), _hi = *(const LAS v4i*)(lds + PG8_SA(b, h) + aoff + m * 2048 + 16); dst##8[m] = __builtin_shufflevector(_lo, _hi, 0, 1, 2, 3, 4, 5, 6, 7); } \
        else { _Pragma("unroll") for (int k = 0; k < 2; ++k) dst[m][k] = *(const LAS bf16x8*)(lds + PG8_SA(b, h) + aoff + m * 2048 + k * 1024); } } } while (0)
#define PG8_LDB(dst, b, h) do { _Pragma("unroll") for (int n = 0; n < 2; ++n) { \
        if constexpr (FP8) { const v4i _lo = *(const LAS v4i*)(lds + PG8_SB(b, h) + boff + n * 2048), _hi = *(const LAS v4i*)(lds + PG8_SB(b, h) + boff + n * 2048 + 16); dst##8[n] = __builtin_shufflevector(_lo, _hi, 0, 1, 2, 3, 4, 5, 6, 7); } \
        else { _Pragma("unroll") for (int k = 0; k < 2; ++k) dst[n][k] = *(const LAS bf16x8*)(lds + PG8_SB(b, h) + boff + n * 2048 + k * 1024); } } } while (0)
#define PG8_MMA(ai, bj, At, Bt) do { __builtin_amdgcn_s_setprio(1); \
        if constexpr (FP8) { _Pragma("unroll") for (int m = 0; m < 4; ++m) _Pragma("unroll") for (int n = 0; n < 2; ++n) \
            acc[ai][bj][m][n] = __builtin_amdgcn_mfma_scale_f32_16x16x128_f8f6f4(Bt##8[n], At##8[m], acc[ai][bj][m][n], 0, 0, 0, 0, 0, 0); } \
        else { _Pragma("unroll") for (int m = 0; m < 4; ++m) _Pragma("unroll") for (int n = 0; n < 2; ++n) _Pragma("unroll") for (int k = 0; k < 2; ++k) \
            acc[ai][bj][m][n] = __builtin_amdgcn_mfma_f32_16x16x32_bf16(Bt[n][k], At[m][k], acc[ai][bj][m][n], 0, 0, 0); } \
        __builtin_amdgcn_s_setprio(0); } while (0)
#define PG8_WAIT_V(n) asm volatile("s_waitcnt vmcnt(" #n ")" ::: "memory")
#define PG8_WAIT_L(n) asm volatile("s_waitcnt lgkmcnt(" #n ")" ::: "memory")
#define PG8_BAR __builtin_amdgcn_s_barrier()
#define PG8_SCHED __builtin_amdgcn_sched_barrier(0)
    Unit cur, nxt; int ui = 0;
    if (!S.next(0, cur)) return;
    const char* baseA = S.base_a(); const char* baseB = S.base_b();
    const __amdgpu_buffer_rsrc_t rsrcA = __builtin_amdgcn_make_buffer_rsrc((void*)baseA, 0, 0x7fffffff, 0x00020000), rsrcB = __builtin_amdgcn_make_buffer_rsrc((void*)baseB, 0, 0x7fffffff, 0x00020000);
    f32x4 acc[2][2][4][2];
#pragma unroll
    for (int a = 0; a < 2; ++a)
#pragma unroll
        for (int b = 0; b < 2; ++b)
#pragma unroll
            for (int m = 0; m < 4; ++m)
#pragma unroll
                for (int n = 0; n < 2; ++n) acc[a][b][m][n] = (f32x4){0.f, 0.f, 0.f, 0.f};
    bf16x8 At[4][2], B0[2][2], B1[2][2]; v8i At8[4], B08[2], B18[2];
    const char* cA = S.a_base(cur); const char* cB = S.b_base(cur);
    unsigned cv0[2], cv1[2], nv0[2], nv1[2];
#pragma unroll
    for (int i = 0; i < 2; ++i) {
        if constexpr (GATHER) { cv0[i] = (unsigned)S.a_row(cur, Rs[i]) * (unsigned)KB + (unsigned)Cb[i]; cv1[i] = (unsigned)S.a_row(cur, HALF + Rs[i]) * (unsigned)KB + (unsigned)Cb[i]; }
        else { cv0[i] = voffA[i]; cv1[i] = voffA[i]; }
        nv0[i] = cv0[i]; nv1[i] = cv1[i];
    }
    PG8_STAGE(PG8_SB(0, 0), cB, voffB, B); PG8_STAGE(PG8_SB(0, 1), cB + hstep, voffB, B); PG8_STAGE(PG8_SA(0, 0), cA, cv0, A); PG8_STAGE(PG8_SA(0, 1), cA + hstepA, cv1, A);
    if (wr == 1) PG8_BAR;
    PG8_WAIT_V(2); PG8_BAR;
    PG8_STAGE(PG8_SB(1, 0), cB + kstep, voffB, B); PG8_STAGE(PG8_SA(1, 0), cA + kstep, cv0, A); PG8_STAGE(PG8_SB(1, 1), cB + hstep + kstep, voffB, B);
    PG8_WAIT_V(6); PG8_BAR;
    for (;;) {
        const bool has_next = S.next(ui + 1, nxt);
        const char* nA = has_next ? S.a_base(nxt) : cA; const char* nB = has_next ? S.b_base(nxt) : cB;
        if constexpr (GATHER) {
#pragma unroll
            for (int i = 0; i < 2; ++i) {
                if (has_next) { nv0[i] = (unsigned)S.a_row(nxt, Rs[i]) * (unsigned)KB + (unsigned)Cb[i]; nv1[i] = (unsigned)S.a_row(nxt, HALF + Rs[i]) * (unsigned)KB + (unsigned)Cb[i]; }
                else { nv0[i] = cv0[i]; nv1[i] = cv1[i]; }
            }
        }
        for (int t = 0; t < nt; t += 2) {
            const bool last = (t == nt - 2);
            const char* a1 = cA + (size_t)(t + 1) * kstep;
            const char* a2 = last ? nA : cA + (size_t)(t + 2) * kstep; const char* b2 = last ? nB : cB + (size_t)(t + 2) * kstep;
            const char* a3 = a2 + kstep; const char* b3 = b2 + kstep;
            unsigned s0[2], s1[2];
#pragma unroll
            for (int i = 0; i < 2; ++i) { s0[i] = (GATHER && last) ? nv0[i] : cv0[i]; s1[i] = (GATHER && last) ? nv1[i] : cv1[i]; }
            PG8_LDB(B0, 0, 0); PG8_LDB(B1, 0, 1); PG8_SCHED; PG8_LDA(At, 0, 0); PG8_STAGE(PG8_SA(1, 1), a1 + hstepA, cv1, A);
            PG8_WAIT_V(8); PG8_WAIT_L(0); PG8_BAR; PG8_MMA(0, 0, At, B0); PG8_MMA(0, 1, At, B1); PG8_BAR; PG8_SCHED;
            PG8_LDA(At, 0, 1); PG8_STAGE(PG8_SB(0, 0), b2, voffB, B); PG8_STAGE(PG8_SB(0, 1), b2 + hstep, voffB, B); PG8_STAGE(PG8_SA(0, 0), a2, s0, A);
            PG8_WAIT_V(8); PG8_WAIT_L(0); PG8_BAR; PG8_MMA(1, 0, At, B0); PG8_MMA(1, 1, At, B1); PG8_BAR; PG8_SCHED;
            PG8_LDB(B0, 1, 0); PG8_LDB(B1, 1, 1); PG8_SCHED; PG8_LDA(At, 1, 0); PG8_STAGE(PG8_SA(0, 1), a2 + hstepA, s1, A);
            PG8_WAIT_V(8); PG8_WAIT_L(0); PG8_BAR; PG8_MMA(0, 0, At, B0); PG8_MMA(0, 1, At, B1); PG8_BAR; PG8_SCHED;
            PG8_LDA(At, 1, 1); PG8_STAGE(PG8_SB(1, 0), b3, voffB, B); PG8_STAGE(PG8_SB(1, 1), b3 + hstep, voffB, B); PG8_STAGE(PG8_SA(1, 0), a3, s0, A);
            PG8_WAIT_V(8); PG8_WAIT_L(0); PG8_BAR; PG8_MMA(1, 0, At, B0); PG8_MMA(1, 1, At, B1); PG8_BAR; PG8_SCHED;
        }
        if (wr == 0) PG8_BAR;
        E(acc, cur, wr, wc, fr, fq);
        if (!has_next) break;
        E.post(acc, cur, wr, wc, fr, fq);
        cur = nxt; cA = nA; cB = nB; ++ui;
#pragma unroll
        for (int i = 0; i < 2; ++i) { cv0[i] = nv0[i]; cv1[i] = nv1[i]; }
        if (wr == 1) PG8_BAR;
    }
    PG8_WAIT_V(0);
    PG8_BAR;
#undef PG8_SA
#undef PG8_SB
#undef PG8_STAGE
#undef PG8_LDA
#undef PG8_LDB
#undef PG8_MMA
#undef PG8_WAIT_V
#undef PG8_WAIT_L
#undef PG8_BAR
#undef PG8_SCHED
}
}

using pg8::Unit;
struct SchedDense {
    int G, c, K, nM, nN; const char* A; const char* B; int i0, i1, eb;
    __device__ __forceinline__ bool next(int i, Unit& u) const { const int L = (i + i0) * G + c; if (i + i0 >= i1 || L >= nM * nN) return false; pg8::xcd_tile(L, nM, nN, u.pm, u.pn); u.aux = 0; u.keep = 0; return true; }
    __device__ __forceinline__ const char* a_base(const Unit& u) const { return A + (size_t)u.pm * 256 * K * eb; }
    __device__ __forceinline__ const char* b_base(const Unit& u) const { return B + (size_t)u.pn * 256 * K * eb; }
    __device__ __forceinline__ int a_row(const Unit&, int) const { return 0; }
    __device__ __forceinline__ const char* base_a() const { return A; }
    __device__ __forceinline__ const char* base_b() const { return B; }
};
struct SchedPair {
    int G, c, K; const char *A0, *A1, *B0, *B1;
    __device__ __forceinline__ bool next(int i, Unit& u) const { const int p = (i >> 1) * G + c; if (p >= 256) return false; pg8::xcd_tile(p, 64, 4, u.pm, u.pn); u.aux = i & 1; u.keep = 0; return true; }
    __device__ __forceinline__ const char* a_base(const Unit& u) const { return (u.aux ? A1 : A0) + (size_t)u.pm * 256 * K * 2; }
    __device__ __forceinline__ const char* b_base(const Unit& u) const { return (u.aux ? B1 : B0) + (size_t)u.pn * 256 * K * 2; }
    __device__ __forceinline__ int a_row(const Unit&, int) const { return 0; }
    __device__ __forceinline__ const char* base_a() const { return A0; }
    __device__ __forceinline__ const char* base_b() const { return B0; }
};
struct SchedMoe1 {
    int G, c, K; const char* A; const char* B; int i0, i1;
    __device__ __forceinline__ bool next(int i, Unit& u) const { const int L = (i + i0) * G + c; if (i + i0 >= i1 || L >= 1024) return false;
        const int xcd = L & 7, q = L >> 3, round = q >> 5, slot = q & 31, e = xcd + 8 * (round >> 1), u64 = (round & 1) * 32 + slot, mrow = u64 & 7;
        u.pn = u64 >> 3; u.pm = mrow & 3; u.aux = (mrow >> 2) * 16 + e; u.keep = 0; return true; }
    __device__ __forceinline__ const char* a_base(const Unit& u) const { return A + ((size_t)u.aux * 1024 + (size_t)u.pm * 256) * K; }
    __device__ __forceinline__ const char* b_base(const Unit& u) const { return B + ((size_t)(u.aux & 15) * 2048 + (size_t)u.pn * 256) * K; }
    __device__ __forceinline__ int a_row(const Unit&, int) const { return 0; }
    __device__ __forceinline__ const char* base_a() const { return A; }
    __device__ __forceinline__ const char* base_b() const { return B; }
};
struct SchedMoe2 {
    int G, c, K; const char* A; const char* B;
    __device__ __forceinline__ bool next(int i, Unit& u) const { const int L = i * G + c; if (L >= 512) return false;
        const int xcd = L & 7, q = L >> 3, round = q >> 5, slot = q & 31, e = xcd + 8 * round, mrow = slot & 7;
        u.pn = slot >> 3; u.pm = mrow & 3; u.aux = (mrow >> 2) * 16 + e; u.keep = 0; return true; }
    __device__ __forceinline__ const char* a_base(const Unit& u) const { return A + ((size_t)u.aux * 1024 + (size_t)u.pm * 256) * K; }
    __device__ __forceinline__ const char* b_base(const Unit& u) const { return B + ((size_t)(u.aux & 15) * 1024 + (size_t)u.pn * 256) * K; }
    __device__ __forceinline__ int a_row(const Unit&, int) const { return 0; }
    __device__ __forceinline__ const char* base_a() const { return A; }
    __device__ __forceinline__ const char* base_b() const { return B; }
};

typedef f32x4 AccT[2][2][4][2];
__device__ __forceinline__ size_t gate_off(int pm, int pg, int ai, int m, int bj, int wr, int wc, int fr, int fq) { return ((size_t)(pm * 8 + pg) << 16) + (size_t)((((ai * 4 + m) * 2 + bj) * 8 + wr * 4 + wc) * 512 + (fq * 16 + fr) * 8); }
__device__ __forceinline__ unsigned pk4_u8(float a, float b, float c, float d) { return (unsigned)__builtin_amdgcn_cvt_pk_u8_f32(d, 3, __builtin_amdgcn_cvt_pk_u8_f32(c, 2, __builtin_amdgcn_cvt_pk_u8_f32(b, 1, __builtin_amdgcn_cvt_pk_u8_f32(a, 0, 0u)))); }
template <bool GATES> struct EpiInprojT {
    static constexpr bool PERM = true;
    bf16 *KBp, *VBp, *QBp, *SGp, *PIp; unsigned char* SMp; int pn_off; float sc;
    __device__ __forceinline__ void post(AccT& acc, const Unit&, int, int, int, int) const {
#pragma unroll
        for (int a = 0; a < 2; ++a)
#pragma unroll
            for (int b = 0; b < 2; ++b)
#pragma unroll
                for (int m = 0; m < 4; ++m)
#pragma unroll
                    for (int n = 0; n < 2; ++n) acc[a][b][m][n] = (f32x4){0.f, 0.f, 0.f, 0.f};
    }
    __device__ __forceinline__ void operator()(const AccT& acc, const Unit& u, int wr, int wc, int fr, int fq) const {
        const int pn = u.pn + pn_off;
        if constexpr (GATES) {
            unsigned char* tp = SMp + ((size_t)(u.pm * 8 + pn - 8) << 16) + (unsigned)((wr * 4 + wc) * 512 + (fq * 16 + fr) * 8);
#pragma unroll
            for (int ai = 0; ai < 2; ++ai)
#pragma unroll
                for (int m = 0; m < 4; ++m) {
#pragma unroll
                    for (int bj = 0; bj < 2; ++bj) { const f32x4 v0 = acc[ai][bj][m][0], v1 = acc[ai][bj][m][1];
                        u32x2 w; w.x = pk4_u8(255.f * sigmoid_f(sc * v0[0]), 255.f * sigmoid_f(sc * v0[1]), 255.f * sigmoid_f(sc * v0[2]), 255.f * sigmoid_f(sc * v0[3]));
                        w.y = pk4_u8(255.f * sigmoid_f(sc * v1[0]), 255.f * sigmoid_f(sc * v1[1]), 255.f * sigmoid_f(sc * v1[2]), 255.f * sigmoid_f(sc * v1[3]));
                        *(u32x2*)(tp + (((ai * 4 + m) * 2 + bj) * 4096)) = w; }
                    asm volatile("" ::: "memory"); }
        } else {
        bf16* base; int ld, colt, act;
        if (pn == 0) { base = KBp; ld = 256; colt = 0; act = 0; }
        else if (pn < 3) { base = VBp; ld = 512; colt = (pn - 1) * 256; act = 0; }
        else if (pn == 3) { base = QBp; ld = 256; colt = 0; act = 3; }
        else if (pn < 6) { base = SGp; ld = 512; colt = (pn - 4) * 256; act = 1; }
        else { base = PIp; ld = 512; colt = (pn - 6) * 256; act = 0; }
        const int row0 = u.pm * 256 + wr * 64 + fr, col0 = colt + wc * 32 + 8 * fq;
#pragma unroll
        for (int ai = 0; ai < 2; ++ai)
#pragma unroll
            for (int m = 0; m < 4; ++m) { bf16* rowp = base + (size_t)(row0 + ai * 128 + m * 16) * ld + col0;
#pragma unroll
                for (int bj = 0; bj < 2; ++bj) { f32x4 v0 = acc[ai][bj][m][0], v1 = acc[ai][bj][m][1];
                    if (act == 1) {
#pragma unroll
                        for (int j = 0; j < 4; ++j) { v0[j] = silu_f(v0[j]); v1[j] = silu_f(v1[j]); } }
                    else if (act == 3) { v0 = v0 * 0.125f; v1 = v1 * 0.125f; }
                    u32x4 w; w.x = cvt_pk_bf16(v0[0], v0[1]); w.y = cvt_pk_bf16(v0[2], v0[3]); w.z = cvt_pk_bf16(v1[0], v1[1]); w.w = cvt_pk_bf16(v1[2], v1[3]);
                    *(u32x4*)(rowp + bj * 128) = w; } }
        }
    }
};
typedef EpiInprojT<false> EpiInproj; typedef EpiInprojT<true> EpiGates;
struct EpiMerge {
    static constexpr bool PERM = true;
    const unsigned char* SMp; bf16* MGp;
    __device__ __forceinline__ void post(AccT& acc, const Unit&, int, int, int, int) const {
#pragma unroll
        for (int a = 0; a < 2; ++a)
#pragma unroll
            for (int b = 0; b < 2; ++b)
#pragma unroll
                for (int m = 0; m < 4; ++m)
#pragma unroll
                    for (int n = 0; n < 2; ++n) acc[a][b][m][n] = (f32x4){0.f, 0.f, 0.f, 0.f};
    }
    __device__ __forceinline__ void operator()(const AccT& acc, const Unit& u, int wr, int wc, int fr, int fq) const {
        const int row0 = u.pm * 256 + wr * 64 + fr, col0 = u.pn * 256 + wc * 32 + 8 * fq; const int second = u.aux;
        u32x2 gb[2][2]; u32x4 pb[2][2];
#define EPM_ROW(g) ((size_t)(row0 + ((g) >> 2) * 128 + ((g) & 3) * 16))
#define EPM_LOAD(buf, g) do { _Pragma("unroll") for (int bj = 0; bj < 2; ++bj) { gb[buf][bj] = *(const u32x2*)(SMp + gate_off(u.pm, u.pn + 4 * second, (g) >> 2, (g) & 3, bj, wr, wc, fr, fq)); \
            pb[buf][bj] = (u32x4){0u, 0u, 0u, 0u}; if (second) pb[buf][bj] = *(const u32x4*)(MGp + EPM_ROW(g) * 1024 + col0 + bj * 128); } } while (0)
        EPM_LOAD(0, 0);
#pragma unroll
        for (int g = 0; g < 8; ++g) {
            if (g + 1 < 8) EPM_LOAD((g + 1) & 1, g + 1);
            asm volatile("" ::: "memory");
#pragma unroll
            for (int bj = 0; bj < 2; ++bj) { const u32x2 gq = gb[g & 1][bj]; const u32x4 pv = pb[g & 1][bj]; const f32x4 v0 = acc[g >> 2][bj][g & 3][0], v1 = acc[g >> 2][bj][g & 3][1];
                const float k = 1.f / 255.f;
                const float g0 = k * (float)(gq.x & 255u), g1 = k * (float)((gq.x >> 8) & 255u), g2 = k * (float)((gq.x >> 16) & 255u), g3 = k * (float)(gq.x >> 24);
                const float g4 = k * (float)(gq.y & 255u), g5 = k * (float)((gq.y >> 8) & 255u), g6 = k * (float)((gq.y >> 16) & 255u), g7 = k * (float)(gq.y >> 24);
                u32x4 w; w.x = cvt_pk_bf16(bflo(pv[0]) + v0[0] * g0, bfhi(pv[0]) + v0[1] * g1); w.y = cvt_pk_bf16(bflo(pv[1]) + v0[2] * g2, bfhi(pv[1]) + v0[3] * g3);
                w.z = cvt_pk_bf16(bflo(pv[2]) + v1[0] * g4, bfhi(pv[2]) + v1[1] * g5); w.w = cvt_pk_bf16(bflo(pv[3]) + v1[2] * g6, bfhi(pv[3]) + v1[3] * g7);
                *(u32x4*)(MGp + EPM_ROW(g) * 1024 + col0 + bj * 128) = w; }
            asm volatile("" ::: "memory"); }
#undef EPM_ROW
#undef EPM_LOAD
    }
};
struct EpiOut {
    static constexpr bool PERM = true;
    const float* MODp; bf16* YDp;
    __device__ __forceinline__ void post(AccT& acc, const Unit&, int, int, int, int) const {
#pragma unroll
        for (int a = 0; a < 2; ++a)
#pragma unroll
            for (int b = 0; b < 2; ++b)
#pragma unroll
                for (int m = 0; m < 4; ++m)
#pragma unroll
                    for (int n = 0; n < 2; ++n) acc[a][b][m][n] = (f32x4){0.f, 0.f, 0.f, 0.f};
    }
    __device__ __forceinline__ void operator()(const AccT& acc, const Unit& u, int wr, int wc, int fr, int fq) const {
        const int row0 = u.pm * 256 + wr * 64 + fr, col0 = u.pn * 256 + wc * 32 + 8 * fq;
        const float* gt = MODp + (size_t)(u.pm >> 5) * 6144 + 2048 + col0;
        f32x4 gv[2][2];
#pragma unroll
        for (int bj = 0; bj < 2; ++bj)
#pragma unroll
            for (int n = 0; n < 2; ++n) gv[bj][n] = *(const f32x4*)(gt + bj * 128 + n * 4);
#pragma unroll
        for (int ai = 0; ai < 2; ++ai)
#pragma unroll
            for (int m = 0; m < 4; ++m) { bf16* rowp = YDp + (size_t)(row0 + ai * 128 + m * 16) * 1024 + col0;
#pragma unroll
                for (int bj = 0; bj < 2; ++bj) { const f32x4 v0 = acc[ai][bj][m][0] * gv[bj][0], v1 = acc[ai][bj][m][1] * gv[bj][1];
                    u32x4 w; w.x = cvt_pk_bf16(v0[0], v0[1]); w.y = cvt_pk_bf16(v0[2], v0[3]); w.z = cvt_pk_bf16(v1[0], v1[1]); w.w = cvt_pk_bf16(v1[2], v1[3]);
                    *(u32x4*)(rowp + bj * 128) = w; } }
    }
};
struct EpiMoe1 {
    static constexpr bool PERM = true;
    unsigned char* ACTp;
    __device__ __forceinline__ void post(AccT& acc, const Unit&, int, int, int, int) const {
#pragma unroll
        for (int a = 0; a < 2; ++a)
#pragma unroll
            for (int b = 0; b < 2; ++b)
#pragma unroll
                for (int m = 0; m < 4; ++m)
#pragma unroll
                    for (int n = 0; n < 2; ++n) acc[a][b][m][n] = (f32x4){0.f, 0.f, 0.f, 0.f};
    }
    __device__ __forceinline__ void operator()(const AccT& acc, const Unit& u, int wr, int wc, int fr, int fq) const {
        const int row0 = u.aux * 1024 + u.pm * 256 + wr * 64 + fr, col0 = u.pn * 128 + wc * 32 + 8 * fq;
#pragma unroll
        for (int ai = 0; ai < 2; ++ai)
#pragma unroll
            for (int m = 0; m < 4; ++m) { unsigned char* rowp = ACTp + (size_t)(row0 + ai * 128 + m * 16) * 1024 + col0;
                f32x4 a0, a1;
#pragma unroll
                for (int j = 0; j < 4; ++j) { a0[j] = silu_f(0.0625f * acc[ai][0][m][0][j]) * (0.0625f * acc[ai][1][m][0][j]); a1[j] = silu_f(0.0625f * acc[ai][0][m][1][j]) * (0.0625f * acc[ai][1][m][1][j]); }
                *(u32x2*)rowp = (u32x2){pk4_fp8(a0[0], a0[1], a0[2], a0[3]), pk4_fp8(a1[0], a1[1], a1[2], a1[3])}; }
    }
};
struct EpiMoe2 {
    static constexpr bool PERM = true;
    bf16* YBp; const float* WSELp; const float* MODp;
    __device__ __forceinline__ void post(AccT& acc, const Unit&, int, int, int, int) const {
#pragma unroll
        for (int a = 0; a < 2; ++a)
#pragma unroll
            for (int b = 0; b < 2; ++b)
#pragma unroll
                for (int m = 0; m < 4; ++m)
#pragma unroll
                    for (int n = 0; n < 2; ++n) acc[a][b][m][n] = (f32x4){0.f, 0.f, 0.f, 0.f};
    }
    __device__ __forceinline__ void operator()(const AccT& acc, const Unit& u, int wr, int wc, int fr, int fq) const {
        const int row0 = u.aux * 1024 + u.pm * 256 + wr * 64 + fr, col0 = u.pn * 256 + wc * 32 + 8 * fq;
        const float* gt = MODp + (size_t)(u.aux >> 4) * 6144 + 5120 + col0;
        f32x4 gv[2][2];
#pragma unroll
        for (int bj = 0; bj < 2; ++bj)
#pragma unroll
            for (int n = 0; n < 2; ++n) gv[bj][n] = *(const f32x4*)(gt + bj * 128 + n * 4);
#pragma unroll
        for (int ai = 0; ai < 2; ++ai)
#pragma unroll
            for (int m = 0; m < 4; ++m) { const int r = row0 + ai * 128 + m * 16; const float ws = 0.0625f * WSELp[r]; bf16* rowp = YBp + (size_t)r * 1024 + col0;
#pragma unroll
                for (int bj = 0; bj < 2; ++bj) { const f32x4 v0 = acc[ai][bj][m][0] * gv[bj][0] * ws, v1 = acc[ai][bj][m][1] * gv[bj][1] * ws;
                    u32x4 w; w.x = cvt_pk_bf16(v0[0], v0[1]); w.y = cvt_pk_bf16(v0[2], v0[3]); w.z = cvt_pk_bf16(v1[0], v1[1]); w.w = cvt_pk_bf16(v1[2], v1[3]);
                    *(u32x4*)(rowp + bj * 128) = w; } }
    }
};

struct Args { const float* in[22]; float* out; unsigned char* ws; int ph_lo, ph_hi; };
enum { I_X = 0, I_C, I_CTX, I_CCTX, I_ADAW, I_ADAB, I_N1G, I_N2G, I_WIN, I_WDU, I_BDEC, I_GNG, I_WGLA, I_POOLW, I_POOLS, I_WPOOL, I_WOUT, I_WROUTER, I_WGATE, I_WUP, I_WDOWN, I_FNG };

__device__ __forceinline__ bf16x8 ldfrag(const LAS bf16* base, int stride, int row0, int k0, int lane) { return *(const LAS bf16x8*)(base + (row0 + (lane & 15)) * stride + k0 + 8 * (lane >> 4)); }
#define MFMA16(a, b, c) __builtin_amdgcn_mfma_f32_16x16x32_bf16(a, b, c, 0, 0, 0)

__device__ __forceinline__ void transpose_item(const float* W, int ldw, int k0, int nsrc0, bf16* WT, int Kd, int dst_row0, LAS float* scr, int lane) {
#pragma unroll 8
    for (int i = 0; i < 32; ++i) { const int kk = 2 * i + (lane >> 5); scr[kk * 33 + (lane & 31)] = W[(size_t)(k0 + kk) * ldw + nsrc0 + (lane & 31)]; }
    LDS_WAIT(); asm volatile("" ::: "memory");
    const int c = lane & 7;
#pragma unroll
    for (int j = 0; j < 4; ++j) { const int n = (lane >> 3) + 8 * j; const LAS float* s = scr + (8 * c) * 33 + n;
        u32x4 o; o.x = pk2(s[0 * 33], s[1 * 33]); o.y = pk2(s[2 * 33], s[3 * 33]); o.z = pk2(s[4 * 33], s[5 * 33]); o.w = pk2(s[6 * 33], s[7 * 33]);
        *(u32x4*)(WT + (size_t)(dst_row0 + n) * Kd + k0 + 8 * c) = o; }
    LDS_WAIT(); asm volatile("" ::: "memory");
}

struct CvtItem { const float* src; bf16* dst; int ld2, drow8, f8; };
#define CVT_LOAD(v, c) do { _Pragma("unroll") for (int _j = 0; _j < 32; ++_j) v[_j] = __builtin_nontemporal_load((c).src + (size_t)_j * (c).ld2); } while (0)
#define CVT_STORE(v, c) do { _Pragma("unroll") for (int _j = 0; _j < 32; ++_j) scr[(2 * _j + (lane >> 5)) * 33 + (lane & 31)] = v[_j]; \
        LDS_WAIT(); asm volatile("" ::: "memory"); \
        _Pragma("unroll") for (int _q = 0; _q < 4; ++_q) { const LAS float* _s = scr + (8 * (lane & 7)) * 33 + (lane >> 3) + 8 * _q; u32x4 _o; \
            _o.x = pk2(_s[0 * 33], _s[1 * 33]); _o.y = pk2(_s[2 * 33], _s[3 * 33]); _o.z = pk2(_s[4 * 33], _s[5 * 33]); _o.w = pk2(_s[6 * 33], _s[7 * 33]); *(u32x4*)((c).dst + (size_t)_q * (c).drow8) = _o; } \
        LDS_WAIT(); asm volatile("" ::: "memory"); } while (0)
__device__ __forceinline__ CvtItem cvt_item_gu(const Args& a, int it, int lane) {
    const int e = it >> 10, mat = (it >> 9) & 1, q = it & 511, kb = q >> 5, nb = q & 31, n0 = nb * 32, k0 = kb * 64, nrow = n0 + (lane >> 3);
    CvtItem c; c.ld2 = 2048; c.drow8 = 8192; c.f8 = 1;
    c.src = a.in[mat ? I_WUP : I_WGATE] + (size_t)e * 1048576 + (size_t)(k0 + (lane >> 5)) * 1024 + n0 + (lane & 31);
    c.dst = (bf16*)(a.ws + WS_WGU + ((size_t)e * 2048 + (nrow >> 7) * 256 + mat * 128 + (nrow & 127)) * 1024 + k0 + 8 * (lane & 7));
    return c;
}
__device__ __forceinline__ CvtItem cvt_item_dn(const Args& a, int it, int lane) {
    const int e = it >> 9, q = it & 511, kb = q >> 5, nb = q & 31, n0 = nb * 32, k0 = kb * 64;
    CvtItem c; c.ld2 = 2048; c.drow8 = 8192; c.f8 = 1;
    c.src = a.in[I_WDOWN] + (size_t)e * 1048576 + (size_t)(k0 + (lane >> 5)) * 1024 + n0 + (lane & 31);
    c.dst = (bf16*)(a.ws + WS_WD + ((size_t)e * 1024 + n0 + (lane >> 3)) * 1024 + k0 + 8 * (lane & 7));
    return c;
}
#define CVT_STORE8(v, c) do { _Pragma("unroll") for (int _j = 0; _j < 32; ++_j) scr[(2 * _j + (lane >> 5)) * 33 + (lane & 31)] = v[_j]; \
        LDS_WAIT(); asm volatile("" ::: "memory"); \
        _Pragma("unroll") for (int _q = 0; _q < 4; ++_q) { const LAS float* _s = scr + (8 * (lane & 7)) * 33 + (lane >> 3) + 8 * _q; \
            *(u32x2*)((unsigned char*)(c).dst + (size_t)_q * (c).drow8) = (u32x2){pk4_fp8(16.f * _s[0 * 33], 16.f * _s[1 * 33], 16.f * _s[2 * 33], 16.f * _s[3 * 33]), pk4_fp8(16.f * _s[4 * 33], 16.f * _s[5 * 33], 16.f * _s[6 * 33], 16.f * _s[7 * 33])}; } \
        LDS_WAIT(); asm volatile("" ::: "memory"); } while (0)
__device__ __forceinline__ CvtItem cvt_item_small(const Args& a, int it, int lane) {
    CvtItem c; int r = it;
    c.f8 = 0;
    if (r < 2048) { const int kb = r >> 7, nb = r & 127, n0 = nb * 32, k0 = kb * 64; c.ld2 = 2 * DIN; c.drow8 = 8192;
        c.src = a.in[I_WIN] + (size_t)(k0 + (lane >> 5)) * DIN + n0 + (n0 >= 768 ? 32 : 0) + (lane & 31);
        if (n0 < 2048) c.dst = (bf16*)(a.ws + WS_WIN) + (size_t)(n0 + (lane >> 3)) * 1024 + k0 + 8 * (lane & 7);
        else { c.f8 = 1; c.dst = (bf16*)(a.ws + WS_WINM + (size_t)(n0 - 2048 + (lane >> 3)) * 1024 + k0 + 8 * (lane & 7)); }
        return c; }
    r -= 2048;
    if (r < 512) { const int kb = r >> 5, nb = r & 31, n0 = nb * 32, k0 = kb * 64; c.ld2 = 2048; c.drow8 = 8192;
        c.src = a.in[I_WOUT] + (size_t)(k0 + (lane >> 5)) * 1024 + n0 + (lane & 31); c.dst = (bf16*)(a.ws + WS_WO) + (size_t)(n0 + (lane >> 3)) * 1024 + k0 + 8 * (lane & 7); return c; }
    r -= 512;
    { const int kb = r >> 5, nb = r & 31, n0 = nb * 32, k0 = kb * 64; c.ld2 = 2048; c.drow8 = 4096;
      c.src = a.in[I_WGLA] + (size_t)(k0 + (lane >> 5)) * 1024 + n0 + (lane & 31); c.dst = (bf16*)(a.ws + WS_WG) + (size_t)(n0 + (lane >> 3)) * 512 + k0 + 8 * (lane & 7); return c; }
}
template <int KIND> __device__ __forceinline__ CvtItem cvt_item(const Args& a, int it, int lane) { if constexpr (KIND == 0) return cvt_item_small(a, it, lane); else if constexpr (KIND == 1) return cvt_item_gu(a, it, lane); else return cvt_item_dn(a, it, lane); }
template <int KIND>
__device__ __forceinline__ void convert_items(LAS float* scr, const Args& a, int first, int step, int end, int lane) {
    float va[32], vb[32]; CvtItem ca, cb;
    int it = first;
    if (it < end) { ca = cvt_item<KIND>(a, it, lane); CVT_LOAD(va, ca); }
    for (; it < end; it += 2 * step) {
        const bool hb = (it + step < end), ha = (it + 2 * step < end);
        if (hb) { cb = cvt_item<KIND>(a, it + step, lane); CVT_LOAD(vb, cb); }
        if (KIND == 0 && !ca.f8) CVT_STORE(va, ca); else CVT_STORE8(va, ca);
        if (ha) { ca = cvt_item<KIND>(a, it + 2 * step, lane); CVT_LOAD(va, ca); }
        if (hb) { if (KIND == 0 && !cb.f8) CVT_STORE(vb, cb); else CVT_STORE8(vb, cb); }
    }
}
template <int KIND>
__device__ __forceinline__ void convert_all(LAS unsigned char* lds, const Args& a, int vcu, int G, int lane, int wave) {
    const int gw = vcu * NWAVES + wave, NGW = G * NWAVES;
    convert_items<KIND>((LAS float*)(lds + wave * 8448), a, gw, NGW, KIND == 1 ? 16384 : 8192, lane);
    __syncthreads();
}

__device__ __forceinline__ void phase0(LAS unsigned char* lds, const Args& a, int vcu, int G, int tid, int lane, int wave) {
    unsigned char* ws = a.ws;
    if (vcu < 96) {
        LAS float* sv = (LAS float*)(lds + 69632); LAS float* part = sv + 3072;
        for (int idx = tid; idx < 3072; idx += NT) { const int v = idx >> 10, k = idx & 1023; const float s = (v < 2) ? a.in[I_C][v * 1024 + k] : a.in[I_CCTX][k]; sv[idx] = s / (1.f + expf(-s)); }
        __syncthreads();
        const int n0 = 64 * vcu, colq = lane & 15, kr = lane >> 4;
        f32x4 a0 = {0.f, 0.f, 0.f, 0.f}, a1 = a0, a2 = a0;
        const float* aw = a.in[I_ADAW] + (size_t)(128 * wave + kr) * 6144 + n0 + 4 * colq;
#pragma unroll
        for (int hb = 0; hb < 2; ++hb) { f32x4 w4[16];
#pragma unroll
            for (int it = 0; it < 16; ++it) w4[it] = __builtin_nontemporal_load((const f32x4*)(aw + (size_t)(4 * (16 * hb + it)) * 6144));
#pragma unroll
            for (int it = 0; it < 16; ++it) { const int k = 128 * wave + 4 * (16 * hb + it) + kr; a0 += w4[it] * sv[k]; a1 += w4[it] * sv[1024 + k]; a2 += w4[it] * sv[2048 + k]; } }
#pragma unroll
        for (int j = 0; j < 4; ++j) { a0[j] += __shfl_xor(a0[j], 16); a0[j] += __shfl_xor(a0[j], 32); a1[j] += __shfl_xor(a1[j], 16); a1[j] += __shfl_xor(a1[j], 32); a2[j] += __shfl_xor(a2[j], 16); a2[j] += __shfl_xor(a2[j], 32); }
        if (kr == 0) {
#pragma unroll
            for (int j = 0; j < 4; ++j) { part[(wave * 3 + 0) * 64 + 4 * colq + j] = a0[j]; part[(wave * 3 + 1) * 64 + 4 * colq + j] = a1[j]; part[(wave * 3 + 2) * 64 + 4 * colq + j] = a2[j]; } }
        __syncthreads();
        if (tid < 192) { const int v = tid >> 6, col = tid & 63; float s = a.in[I_ADAB][n0 + col];
#pragma unroll
            for (int w = 0; w < 8; ++w) s += part[(w * 3 + v) * 64 + col];
            ((float*)(ws + WS_MOD))[v * 6144 + n0 + col] = s; }
    } else if (vcu < 96 + 128) {
        const int it = vcu - 96, g = it >> 5, cb = (it >> 1) & 15, nb = it & 1, n = nb * 512 + tid;
        LAS float* pwt = (LAS float*)(lds + 69632);
        if (tid < 256) { const int d = tid >> 1, hf = tid & 1; const float sc = a.in[I_POOLS][g * 128 + d]; f32x4 v;
#pragma unroll
            for (int q = 0; q < 4; ++q) v[q] = a.in[I_POOLW][(size_t)(g * 128 + cb * 8 + hf * 4 + q) * 128 + d] * sc;
            *(LAS f32x4*)(pwt + d * 8 + hf * 4) = v; }
        __syncthreads();
        const float* wp = a.in[I_WPOOL] + (size_t)(g * 128) * 1024 + n;
        f32x4 acc0 = {0.f, 0.f, 0.f, 0.f}, acc1 = acc0;
        for (int d0 = 0; d0 < 128; d0 += 32) { float w[32];
#pragma unroll
            for (int d = 0; d < 32; ++d) w[d] = wp[(size_t)(d0 + d) * 1024];
#pragma unroll
            for (int d = 0; d < 32; ++d) { const f32x4 p0 = *(const LAS f32x4*)(pwt + (d0 + d) * 8), p1 = *(const LAS f32x4*)(pwt + (d0 + d) * 8 + 4); acc0 += p0 * w[d]; acc1 += p1 * w[d]; } }
        bf16* dst = (bf16*)(ws + WS_WC) + (size_t)n * 512 + g * 128 + cb * 8;
        *(u32x4*)dst = (u32x4){pk2(acc0[0], acc0[1]), pk2(acc0[2], acc0[3]), pk2(acc1[0], acc1[1]), pk2(acc1[2], acc1[3])};
    }
    { const int gw = vcu * NWAVES + wave, NGW = G * NWAVES; convert_items<0>((LAS float*)(lds + wave * 8448), a, gw, NGW, 2048 + 512 + 256, lane); }
}

#define RSTEP(N, S) do { _Pragma("unroll") for (int _i = 0; _i < (N) / 2; ++_i) { const float _send = (lane & (S)) ? racc[_i] : racc[_i + (N) / 2]; const float _keep = (lane & (S)) ? racc[_i + (N) / 2] : racc[_i]; racc[_i] = _keep + __shfl_xor(_send, (S)); } } while (0)
__device__ __forceinline__ void phase1(LAS unsigned char* lds, const Args& a, int vcu, int G, int tid, int lane, int wave) {
    unsigned char* ws = a.ws;
    const float* MOD = (const float*)(ws + WS_MOD);
    const float* g1 = a.in[I_N1G];
    for (int u = vcu; u < 96; u += G) {
        const int mt = u / 12, ntile = u % 12, r0 = mt * 64;
        LAS bf16* As = (LAS bf16*)lds; LAS bf16* Bs = As + 64 * 72; LAS float* rs = (LAS float*)(lds + 18432);
        const float* ctx = a.in[I_CTX];
        { f32x4 rv[8][4];
#pragma unroll
          for (int rr = 0; rr < 8; ++rr)
#pragma unroll
              for (int j = 0; j < 4; ++j) rv[rr][j] = *(const f32x4*)(ctx + (size_t)(r0 + 8 * wave + rr) * 1024 + 256 * j + 4 * lane);
#pragma unroll
          for (int rr = 0; rr < 8; ++rr) { float ss = 0.f;
#pragma unroll
              for (int j = 0; j < 4; ++j) ss += rv[rr][j][0] * rv[rr][j][0] + rv[rr][j][1] * rv[rr][j][1] + rv[rr][j][2] * rv[rr][j][2] + rv[rr][j][3] * rv[rr][j][3];
              ss = wave_sum(ss); if (lane == 0) rs[8 * wave + rr] = rsqrtf(ss * (1.f / 1024.f) + EPS); } }
        __syncthreads();
        f32x4 acc[2] = {{0.f, 0.f, 0.f, 0.f}, {0.f, 0.f, 0.f, 0.f}};
        const int m16 = wave & 3, nh = wave >> 2, srow = tid >> 3, kq = (tid & 7) * 8;
        const float rstd = rs[srow];
        const float* xp = ctx + (size_t)(r0 + srow) * 1024 + kq; const bf16* wpB = (const bf16*)(ws + WS_WIN) + (size_t)(ntile * 64 + srow) * 1024 + kq;
        f32x4 xv[2], gq[2], scq[2], shq[2]; u32x4 wB;
#define CTX_LOAD(kc) do { const int _k0 = (kc) * 64; _Pragma("unroll") for (int q = 0; q < 2; ++q) { xv[q] = *(const f32x4*)(xp + _k0 + 4 * q); gq[q] = *(const f32x4*)(g1 + _k0 + kq + 4 * q); \
            scq[q] = *(const f32x4*)(MOD + 2 * 6144 + 1024 + _k0 + kq + 4 * q); shq[q] = *(const f32x4*)(MOD + 2 * 6144 + _k0 + kq + 4 * q); } wB = *(const u32x4*)(wpB + _k0); } while (0)
        CTX_LOAD(0);
        for (int kc = 0; kc < 16; ++kc) {
            { unsigned o[4];
#pragma unroll
              for (int q = 0; q < 2; ++q) { const f32x4 h = xv[q] * rstd * gq[q] * (scq[q] + 1.f) + shq[q]; o[2 * q] = pk2(h[0], h[1]); o[2 * q + 1] = pk2(h[2], h[3]); }
              *(LAS u32x4*)(As + srow * 72 + kq) = (u32x4){o[0], o[1], o[2], o[3]};
              *(LAS u32x4*)(Bs + srow * 72 + kq) = wB; }
            __syncthreads();
            if (kc + 1 < 16) CTX_LOAD(kc + 1);
#pragma unroll
            for (int ks = 0; ks < 2; ++ks) { const bf16x8 af = ldfrag(As, 72, m16 * 16, ks * 32, lane);
#pragma unroll
                for (int tt = 0; tt < 2; ++tt) { const bf16x8 bfr = ldfrag(Bs, 72, nh * 32 + tt * 16, ks * 32, lane); acc[tt] = MFMA16(af, bfr, acc[tt]); } }
            __syncthreads();
        }
#undef CTX_LOAD
#pragma unroll
        for (int tt = 0; tt < 2; ++tt)
#pragma unroll
            for (int r = 0; r < 4; ++r) { const int row = M + r0 + m16 * 16 + 4 * (lane >> 4) + r, n = ntile * 64 + nh * 32 + tt * 16 + (lane & 15); const bf16 v = (bf16)f2bf(acc[tt][r]);
                if (n < 256) ((bf16*)(ws + WS_KB))[(size_t)row * 256 + n] = v; else ((bf16*)(ws + WS_VB))[(size_t)row * 512 + n - 256] = v; }
        __syncthreads();
    }
    LAS float* WR = (LAS float*)lds;
#pragma unroll 4
    for (int it = 0; it < 16; ++it) { const int k = (tid >> 3) + 64 * it, c4 = tid & 7; const f32x4 v = *(const f32x4*)(a.in[I_WIN] + (size_t)k * DIN + 768 + 4 * c4);
        const int row = ((k >> 8) * 4 + (k & 3)) * 64 + ((k & 255) >> 2); *(LAS f32x4*)(WR + row * 36 + 4 * c4) = v; }
    __syncthreads();
    f32x4 gv[4];
#pragma unroll
    for (int j = 0; j < 4; ++j) gv[j] = *(const f32x4*)(g1 + 256 * j + 4 * lane);
    constexpr int NPAIR = MT / 2;
    const int nctx = (G > 96) ? 96 : 0, PA = 3;
    int p_lo, p_n, p_stride;
    if (vcu < nctx) { p_lo = (vcu * NWAVES + wave) * PA; p_n = PA; p_stride = 1; }
    else { p_lo = nctx * NWAVES * PA + (vcu - nctx) * NWAVES + wave; p_n = 1 << 30; p_stride = (G - nctx) * NWAVES; }
    f32x4 nx[2][4];
    if (p_n > 0 && p_lo < NPAIR) {
#pragma unroll
        for (int r = 0; r < 2; ++r) { const int m = 2 * p_lo + r; const float* src = (m < M) ? a.in[I_X] + (size_t)m * 1024 : a.in[I_CTX] + (size_t)(m - M) * 1024;
#pragma unroll
            for (int j = 0; j < 4; ++j) nx[r][j] = *(const f32x4*)(src + 256 * j + 4 * lane); } }
    for (int pi = 0, pr = p_lo; pi < p_n && pr < NPAIR; ++pi, pr += p_stride) {
        const int m0 = 2 * pr;
        f32x4 v[2][4]; float rstd[2];
#pragma unroll
        for (int r = 0; r < 2; ++r) { float ss = 0.f;
#pragma unroll
            for (int j = 0; j < 4; ++j) { v[r][j] = nx[r][j]; ss += v[r][j][0] * v[r][j][0] + v[r][j][1] * v[r][j][1] + v[r][j][2] * v[r][j][2] + v[r][j][3] * v[r][j][3]; }
            rstd[r] = ss; }
        if (pi + 1 < p_n && pr + p_stride < NPAIR) {
#pragma unroll
            for (int r = 0; r < 2; ++r) { const int m = 2 * (pr + p_stride) + r; const float* src = (m < M) ? a.in[I_X] + (size_t)m * 1024 : a.in[I_CTX] + (size_t)(m - M) * 1024;
#pragma unroll
                for (int j = 0; j < 4; ++j) nx[r][j] = *(const f32x4*)(src + 256 * j + 4 * lane); } }
#pragma unroll
        for (int r = 0; r < 2; ++r) { const int m = m0 + r; rstd[r] = rsqrtf(wave_sum(rstd[r]) * (1.f / 1024.f) + EPS); const float* mod = MOD + (size_t)((m < M) ? (m >> 13) : 2) * 6144;
#pragma unroll
            for (int j = 0; j < 4; ++j) { const f32x4 sc = *(const f32x4*)(mod + 1024 + 256 * j + 4 * lane), sh = *(const f32x4*)(mod + 256 * j + 4 * lane); v[r][j] = v[r][j] * rstd[r] * gv[j] * (sc + 1.f) + sh; }
            if (m < M) { bf16* hp = (bf16*)(ws + WS_H1) + (size_t)m * 1024;
#pragma unroll
                for (int j = 0; j < 4; ++j) { *(u32x2*)(hp + 256 * j + 4 * lane) = (u32x2){pk2(v[r][j][0], v[r][j][1]), pk2(v[r][j][2], v[r][j][3])};
                    *(unsigned*)(ws + WS_H1F + (size_t)m * 1024 + 256 * j + 4 * lane) = pk4_fp8(v[r][j][0], v[r][j][1], v[r][j][2], v[r][j][3]); } } }
        f32x2 r2[32];
#pragma unroll
        for (int i = 0; i < 32; ++i) r2[i] = (f32x2){0.f, 0.f};
#pragma unroll
        for (int j = 0; j < 4; ++j)
#pragma unroll
            for (int i = 0; i < 4; ++i) { const f32x2 hab = {v[0][j][i], v[1][j][i]}; const LAS float* rp = WR + ((j * 4 + i) * 64 + lane) * 36;
#pragma unroll
                for (int c4 = 0; c4 < 8; ++c4) { const f32x4 w = *(const LAS f32x4*)(rp + 4 * c4);
                    r2[4 * c4 + 0] += hab * w[0]; r2[4 * c4 + 1] += hab * w[1]; r2[4 * c4 + 2] += hab * w[2]; r2[4 * c4 + 3] += hab * w[3]; }
                if (i & 1) asm volatile("" ::: "memory"); }
        float ra[32], rb[32];
#pragma unroll
        for (int i = 0; i < 32; ++i) { ra[i] = r2[i][0]; rb[i] = r2[i][1]; }
        { float* racc = ra; RSTEP(32, 32); RSTEP(16, 16); RSTEP(8, 8); RSTEP(4, 4); RSTEP(2, 2); racc[0] += __shfl_xor(racc[0], 1); }
        { float* racc = rb; RSTEP(32, 32); RSTEP(16, 16); RSTEP(8, 8); RSTEP(4, 4); RSTEP(2, 2); racc[0] += __shfl_xor(racc[0], 1); }
        if ((lane & 1) == 0) { ((float*)(ws + WS_RB))[(size_t)m0 * 32 + (lane >> 1)] = ra[0]; ((float*)(ws + WS_RB))[(size_t)(m0 + 1) * 32 + (lane >> 1)] = rb[0]; }
    }
}

typedef short s16x4 __attribute__((ext_vector_type(4)));
__device__ __forceinline__ s16x4 lds_tr16(const LAS bf16* p) { return __builtin_bit_cast(s16x4, __builtin_amdgcn_ds_read_tr16_b64_v4i16((LAS s16x4*)p)); }
__device__ __forceinline__ bf16x8 ldfrag_tr(const LAS bf16* base, int stride, int k0, int n0, int lane) {
    const int g = lane >> 4, i = lane & 15; const LAS bf16* p = base + (k0 + 8 * g + (i >> 2)) * stride + n0 + 4 * (i & 3);
    const s16x4 lo = lds_tr16(p), hi = lds_tr16(p + 4 * stride);
    return (bf16x8){lo[0], lo[1], lo[2], lo[3], hi[0], hi[1], hi[2], hi[3]};
}
__device__ __forceinline__ float logsig_fast(float z) { return fminf(z, 0.f) - __logf(1.f + __expf(-fabsf(z))); }
struct ChkPre { f32x4 r, w; float bias_f, bias_b; float kf[8]; u32x4 v[2]; };
__device__ __forceinline__ void chunk_decode(int u, int& b, int& h, int& row0, int& slot, bool& isx) {
    if (u < 1024) { b = u >> 9; h = (u >> 7) & 3; const int n = u & 127; row0 = b * SEQ + n * 64; slot = n; isx = true; }
    else { const int v = u - 1024; b = v >> 4; h = (v >> 2) & 3; const int n = v & 3; row0 = M + b * LC + n * 64; slot = NCH + n; isx = false; }
}
__device__ __forceinline__ void chunk_load(ChkPre& P, const Args& a, int u, int tid) {
    unsigned char* ws = a.ws; int b, h, row0, slot; bool isx; chunk_decode(u, b, h, row0, slot, isx);
    P.r = *(const f32x4*)((const float*)(ws + WS_RB) + (size_t)(row0 + (tid >> 3)) * 32 + (tid & 7) * 4);
    P.w = *(const f32x4*)(a.in[I_WDU] + (size_t)(tid >> 4) * 256 + h * 64 + (tid & 15) * 4);
    const int dk = tid & 63, tq = tid >> 6;
    P.bias_f = a.in[I_BDEC][h * 64 + dk]; P.bias_b = a.in[I_BDEC][256 + h * 64 + dk];
    const bf16* KBp = (const bf16*)(ws + WS_KB) + (size_t)(row0 + tq * 8) * 256 + h * 64 + dk;
#pragma unroll
    for (int tt = 0; tt < 8; ++tt) P.kf[tt] = bf2f(KBp[(size_t)tt * 256]);
#pragma unroll
    for (int i = 0; i < 2; ++i) { const int p = tid + NT * i, jj = p >> 4, ch = p & 15; P.v[i] = *(const u32x4*)((const bf16*)(ws + WS_VB) + (size_t)(row0 + jj) * 512 + h * 128 + 8 * ch); }
}
__device__ __forceinline__ void chunk_units(LAS unsigned char* lds, const Args& a, int vcu, int G, int tid, int lane, int wave) {
    unsigned char* ws = a.ws;
    LAS float* r_s = (LAS float*)lds;
    LAS float* wup = (LAS float*)(lds + 8192);
    LAS float* seg = (LAS float*)(lds + 16384);
    LAS bf16* Ks = (LAS bf16*)(lds + 20480);
    LAS bf16* Vs = (LAS bf16*)(lds + 38912);
    const int dk = tid & 63, tq = tid >> 6;
    ChkPre P;
    unsigned* qctr = (unsigned*)(ws + WS_CTL) + 512; LAS int* qnext = (LAS int*)(lds + 57344);
    int u = vcu;
    if (u < 1024 + 32) chunk_load(P, a, u, tid);
    for (; u < 1024 + 32; ) {
        int b, h, row0, slot; bool isx; chunk_decode(u, b, h, row0, slot, isx);
        const int bh = b * 4 + h;
        if (tid == 0) qnext[0] = G + (int)__hip_atomic_fetch_add(qctr, 1u, __ATOMIC_RELAXED, __HIP_MEMORY_SCOPE_AGENT);
        *(LAS f32x4*)(r_s + tid * 4) = P.r; *(LAS f32x4*)(wup + (tid >> 4) * 64 + (tid & 15) * 4) = P.w;
#pragma unroll
        for (int i = 0; i < 2; ++i) { const int p = tid + NT * i, jj = p >> 4, ch = p & 15; *(LAS u32x4*)(Vs + jj * 136 + 8 * ch) = P.v[i]; }
        float kf[8];
#pragma unroll
        for (int tt = 0; tt < 8; ++tt) kf[tt] = P.kf[tt];
        const float bias_f = P.bias_f, bias_b = P.bias_b;
        __syncthreads();
        const int un = qnext[0];
        if (un < 1024 + 32) chunk_load(P, a, un, tid);
        float pf[8], sb[8];
        { float wf[16], wb[16];
#pragma unroll
          for (int j = 0; j < 16; ++j) { wf[j] = wup[j * 64 + dk]; wb[j] = wup[(16 + j) * 64 + dk]; }
#pragma unroll
          for (int tt = 0; tt < 8; ++tt) { const LAS float* rp = r_s + (tq * 8 + tt) * 32; float zf = bias_f, zb = bias_b;
#pragma unroll
              for (int j4 = 0; j4 < 4; ++j4) { const f32x4 rf = *(const LAS f32x4*)(rp + 4 * j4), rb = *(const LAS f32x4*)(rp + 16 + 4 * j4);
#pragma unroll
                  for (int e = 0; e < 4; ++e) { zf += rf[e] * wf[4 * j4 + e]; zb += rb[e] * wb[4 * j4 + e]; } }
              pf[tt] = logsig_fast(zf) * (1.f / 16.f); sb[tt] = logsig_fast(zb) * (1.f / 16.f); }
#pragma unroll
          for (int tt = 1; tt < 8; ++tt) pf[tt] += pf[tt - 1];
#pragma unroll
          for (int tt = 6; tt >= 0; --tt) sb[tt] += sb[tt + 1];
          seg[tq * 64 + dk] = pf[7]; seg[(8 + tq) * 64 + dk] = sb[0]; }
        __syncthreads();
        { float offf = 0.f, totf = 0.f, offb = 0.f, totb = 0.f;
#pragma unroll
          for (int q = 0; q < 8; ++q) { const float sf = seg[q * 64 + dk], sbv = seg[(8 + q) * 64 + dk]; totf += sf; totb += sbv; if (q < tq) offf += sf; if (q > tq) offb += sbv; }
#pragma unroll
          for (int tt = 0; tt < 8; ++tt) { const int t = tq * 8 + tt; const float bb = pf[tt] + offf, cc = sb[tt] + offb;
              if (isx) { const size_t gi = (size_t)(row0 + t) * 256 + h * 64 + dk; a.out[gi] = bb; a.out[(size_t)M * 256 + gi] = cc; }
              Ks[t * 72 + dk] = (bf16)f2bf(kf[tt] * __expf(totf - bb)); Ks[(64 + t) * 72 + dk] = (bf16)f2bf(kf[tt] * __expf(totb - cc)); }
          if (tq == 0) { float* DEC = (float*)(ws + WS_DEC); DEC[((size_t)(0 * 8 + bh) * NSLOT + slot) * 64 + dk] = __expf(totf); DEC[((size_t)(1 * 8 + bh) * NSLOT + slot) * 64 + dk] = __expf(totb); } }
        __syncthreads();
        { const int dir = wave >> 2, dkt = wave & 3; const LAS bf16* Kd = Ks + dir * 64 * 72;
          const bf16x8 k0f = ldfrag_tr(Kd, 72, 0, dkt * 16, lane), k1f = ldfrag_tr(Kd, 72, 32, dkt * 16, lane);
          bf16* KV = (bf16*)(ws + WS_KV) + ((size_t)(dir * 8 + bh) * NSLOT + slot) * 8192;
#pragma unroll
          for (int dvt = 0; dvt < 8; ++dvt) { f32x4 c = {0.f, 0.f, 0.f, 0.f}; c = MFMA16(k0f, ldfrag_tr(Vs, 136, 0, dvt * 16, lane), c); c = MFMA16(k1f, ldfrag_tr(Vs, 136, 32, dvt * 16, lane), c);
              *(u32x2*)(KV + (size_t)(dvt * 16 + (lane & 15)) * 64 + dkt * 16 + 4 * (lane >> 4)) = (u32x2){pk2(c[0], c[1]), pk2(c[2], c[3])}; } }
        __syncthreads();
        u = un;
    }
}
constexpr int PB = 4, NPOOLW = NB * 4 * 8 * (128 / PB);
__device__ __forceinline__ void ld16bf(const bf16* p, float (&f)[16]) { const u32x4 w0 = *(const u32x4*)p, w1 = *(const u32x4*)(p + 8);
#pragma unroll
    for (int q = 0; q < 4; ++q) { f[2 * q] = bflo(w0[q]); f[2 * q + 1] = bfhi(w0[q]); f[8 + 2 * q] = bflo(w1[q]); f[8 + 2 * q + 1] = bfhi(w1[q]); } }
template <int CTRL, int ROWMASK> __device__ __forceinline__ float dpp_f(float v) { return __builtin_bit_cast(float, __builtin_amdgcn_update_dpp(0, __builtin_bit_cast(int, v), CTRL, ROWMASK, 0xf, true)); }
__device__ __forceinline__ float wave_prefix(float v) {
    v += dpp_f<0x111, 0xf>(v); v += dpp_f<0x112, 0xf>(v); v += dpp_f<0x114, 0xf>(v); v += dpp_f<0x118, 0xf>(v);
    v += dpp_f<0x142, 0xa>(v);
    v += dpp_f<0x143, 0xc>(v);
    return v;
}
template <int HALF>
__device__ __forceinline__ void pool_band(const bf16* PI, bf16* PO, int r0, int c) {
    float run[16];
#pragma unroll
    for (int e = 0; e < 16; ++e) run[e] = 0.f;
    { constexpr int NW = 2 * HALF, BT = NW < 8 ? NW : 8;
#pragma unroll
      for (int i0 = 0; i0 < NW; i0 += BT) { float f[BT][16];
#pragma unroll
          for (int i = 0; i < BT; ++i) { int rr = r0 - HALF + i0 + i; rr = rr < 0 ? 0 : (rr > 127 ? 127 : rr); ld16bf(PI + (size_t)rr * 64 * 512, f[i]); }
#pragma unroll
          for (int i = 0; i < BT; ++i) { const int rr = r0 - HALF + i0 + i; const bool ok = rr >= 0 && rr < 128;
#pragma unroll
              for (int e = 0; e < 16; ++e) run[e] += ok ? f[i][e] : 0.f; }
          asm volatile("" ::: "memory"); } }
    const int lo_c = (c - HALF) < 0 ? 0 : (c - HALF), hi_c = (c + HALF) > 64 ? 64 : (c + HALF);
    float cen[16], fi[16], fo[16];
    ld16bf(PI + (size_t)r0 * 64 * 512, cen);
#pragma unroll
    for (int k = 0; k < PB; ++k) {
        const int r = r0 + k;
        float ncen[16];
        if (k + 1 < PB) { const int rin = r + HALF, rout = r - HALF;
            ld16bf(PI + (size_t)(rin > 127 ? 127 : rin) * 64 * 512, fi); ld16bf(PI + (size_t)(rout < 0 ? 0 : rout) * 64 * 512, fo); ld16bf(PI + (size_t)(r + 1) * 64 * 512, ncen); }
        const int lo_r = (r - HALF) < 0 ? 0 : (r - HALF), hi_r = (r + HALF) > 128 ? 128 : (r + HALF);
        const float inv = 1.f / (float)((hi_r - lo_r) * (hi_c - lo_c));
        float o[16];
#pragma unroll
        for (int e = 0; e < 16; ++e) { const float p = wave_prefix(run[e]);
            const float hi = __shfl(p, hi_c - 1), lo = __shfl(p, lo_c > 0 ? lo_c - 1 : 0);
            o[e] = (hi - (lo_c > 0 ? lo : 0.f)) * inv - cen[e]; }
        bf16* po = PO + (size_t)r * 64 * 512;
        *(u32x4*)po = (u32x4){pk2(o[0], o[1]), pk2(o[2], o[3]), pk2(o[4], o[5]), pk2(o[6], o[7])}; *(u32x4*)(po + 8) = (u32x4){pk2(o[8], o[9]), pk2(o[10], o[11]), pk2(o[12], o[13]), pk2(o[14], o[15])};
        if (k + 1 < PB) { const int rin = r + HALF, rout = r - HALF;
#pragma unroll
            for (int e = 0; e < 16; ++e) { run[e] += (rin < 128 ? fi[e] : 0.f) - (rout >= 0 ? fo[e] : 0.f); cen[e] = ncen[e]; } }
    }
}
__device__ __forceinline__ void pool_units(const Args& a, int vcu, int G, int lane, int wave, int nw) {
    unsigned char* ws = a.ws;
    constexpr int NBAND = 128 / PB, PER_G = NB * 8 * NBAND;
    for (int wu = vcu * nw + wave; wu < NPOOLW; wu += G * nw) {
        const int g = 3 - (wu & 3), rem = wu >> 2, b = rem / (8 * NBAND), rem2 = rem % (8 * NBAND), chk = rem2 & 7, r0 = (rem2 >> 3) * PB;
        const size_t off = ((size_t)b * SEQ + lane) * 512 + g * 128 + chk * 16;
        const bf16* PI = (const bf16*)(ws + WS_PI) + off; bf16* PO = (bf16*)(ws + WS_PO) + off;
        if (g == 0) pool_band<1>(PI, PO, r0, lane); else if (g == 1) pool_band<2>(PI, PO, r0, lane); else if (g == 2) pool_band<4>(PI, PO, r0, lane); else pool_band<8>(PI, PO, r0, lane);
    }
}

__device__ __forceinline__ void phase4(const Args& a, int G, int tid, int nthr) {
    unsigned char* ws = a.ws;
    for (int e = blockIdx.x * nthr + tid; e < 2 * 8 * 8192; e += G * nthr) {
        const int dir = e >> 16, bh = (e >> 13) & 7, e8 = e & 8191, dk = e8 & 63;
        const bf16* kvp = (const bf16*)(ws + WS_KV) + (size_t)((dir * 8 + bh) * NSLOT) * 8192 + e8;
        const float* decp = (const float*)(ws + WS_DEC) + (size_t)((dir * 8 + bh) * NSLOT) * 64 + dk;
        bf16* stp = (bf16*)(ws + WS_ST) + (size_t)((dir * 8 + bh) * NCH) * 8192 + e8;
        float s = 0.f;
        float kv[12], dc[12], kvn[12], dcn[12];
#define SCAN_SLOT(j) (dir ? (NSLOT - 1 - (j)) : ((j) < 4 ? NCH + (j) : (j) - 4))
#pragma unroll
        for (int q = 0; q < 12; ++q) { const int slot = SCAN_SLOT(q); kvn[q] = bf2f(kvp[(size_t)slot * 8192]); dcn[q] = decp[slot * 64]; }
        for (int j0 = 0; j0 < NSLOT; j0 += 12) {
#pragma unroll
            for (int q = 0; q < 12; ++q) { kv[q] = kvn[q]; dc[q] = dcn[q]; }
            if (j0 + 12 < NSLOT) {
#pragma unroll
                for (int q = 0; q < 12; ++q) { const int slot = SCAN_SLOT(j0 + 12 + q); kvn[q] = bf2f(kvp[(size_t)slot * 8192]); dcn[q] = decp[slot * 64]; } }
#pragma unroll
            for (int q = 0; q < 12; ++q) { const int slot = SCAN_SLOT(j0 + q);
                if (slot < NCH) stp[(size_t)slot * 8192] = (bf16)f2bf(s);
                s = dc[q] * s + kv[q]; }
        }
#undef SCAN_SLOT
    }
}

struct GlaPre { u32x4 q, k; f32x4 b0, b1, c0, c1, mf0, mf1, mb0, mb1; u32x4 v[2]; u32x4 st[4]; u32x4 sg[2]; };
__device__ __forceinline__ void gla_load(GlaPre& P, const Args& a, int u, int tid) {
    unsigned char* ws = a.ws;
    const int b = u >> 9, h = (u >> 7) & 3, n = u & 127, row0 = b * SEQ + n * 64, bh = b * 4 + h, t = tid >> 3, c8 = tid & 7;
    const size_t gi = (size_t)(row0 + t) * 256 + h * 64 + 8 * c8, gmf = (size_t)(row0 + 31) * 256 + h * 64 + 8 * c8, gmb = (size_t)(row0 + 32) * 256 + h * 64 + 8 * c8;
    const float* BF = a.out; const float* CB = a.out + (size_t)M * 256;
    P.q = *(const u32x4*)((const bf16*)(ws + WS_QB) + gi); P.k = *(const u32x4*)((const bf16*)(ws + WS_KB) + gi);
    P.b0 = *(const f32x4*)(BF + gi); P.b1 = *(const f32x4*)(BF + gi + 4); P.c0 = *(const f32x4*)(CB + gi); P.c1 = *(const f32x4*)(CB + gi + 4);
    P.mf0 = *(const f32x4*)(BF + gmf); P.mf1 = *(const f32x4*)(BF + gmf + 4); P.mb0 = *(const f32x4*)(CB + gmb); P.mb1 = *(const f32x4*)(CB + gmb + 4);
#pragma unroll
    for (int i = 0; i < 2; ++i) { const int p = tid + NT * i, jj = p >> 4, ch = p & 15; P.v[i] = *(const u32x4*)((const bf16*)(ws + WS_VB) + (size_t)(row0 + jj) * 512 + h * 128 + 8 * ch); }
#pragma unroll
    for (int i = 0; i < 4; ++i) { const int p = tid + NT * i, dir = p >> 10, rem = p & 1023, dv = rem >> 3, c = rem & 7;
        P.st[i] = *(const u32x4*)((const bf16*)(ws + WS_ST) + ((size_t)((dir * 8 + bh) * NCH + n) * 128 + dv) * 64 + 8 * c); }
    const bf16* sgp = (const bf16*)(ws + WS_SG) + (size_t)(row0 + t) * 512 + h * 128 + 16 * c8;
    P.sg[0] = *(const u32x4*)sgp; P.sg[1] = *(const u32x4*)(sgp + 8);
}
__device__ __forceinline__ void phase5(LAS unsigned char* lds, const Args& a, int vcu, int G, int tid, int lane, int wave) {
    unsigned char* ws = a.ws;
    LAS bf16* Aop = (LAS bf16*)lds;
    LAS bf16* Bop = (LAS bf16*)(lds + 25600);
    LAS bf16* Vs = (LAS bf16*)(lds + 60416);
    LAS bf16* qsf = (LAS bf16*)(lds + 77824); LAS bf16* ksf = qsf + 64 * 72; LAS bf16* qsb = ksf + 64 * 72; LAS bf16* ksb = qsb + 64 * 72;
    LAS float* Os = (LAS float*)(lds + 77824);
    const int t8 = tid >> 3, c8 = tid & 7;
    f32x4 gn[4];
#pragma unroll
    for (int q = 0; q < 4; ++q) gn[q] = *(const f32x4*)(a.in[I_GNG] + 16 * c8 + 4 * q);
    GlaPre P;
    int u = vcu;
    if (u < 1024) gla_load(P, a, u, tid);
    for (; u < 1024; u += G) {
        const int b = u >> 9, h = (u >> 7) & 3, n = u & 127, row0 = b * SEQ + n * 64;
        { float qf[8], kf[8], bb[8], cc[8], mf[8], mb[8];
#pragma unroll
          for (int e = 0; e < 4; ++e) { qf[2 * e] = bflo(P.q[e]); qf[2 * e + 1] = bfhi(P.q[e]); kf[2 * e] = bflo(P.k[e]); kf[2 * e + 1] = bfhi(P.k[e]);
              bb[e] = P.b0[e]; bb[4 + e] = P.b1[e]; cc[e] = P.c0[e]; cc[4 + e] = P.c1[e]; mf[e] = P.mf0[e]; mf[4 + e] = P.mf1[e]; mb[e] = P.mb0[e]; mb[4 + e] = P.mb1[e]; }
          float o0[8], o1[8], o2[8], o3[8], o4[8], o5[8];
#pragma unroll
          for (int e = 0; e < 8; ++e) { const float eb = __expf(bb[e]), ec = __expf(cc[e]), x = __expf(bb[e] - mf[e]), y = __expf(cc[e] - mb[e]);
              o0[e] = qf[e] * eb; o1[e] = qf[e] * ec; o2[e] = qf[e] * x; o3[e] = kf[e] * __builtin_amdgcn_rcpf(x); o4[e] = qf[e] * y; o5[e] = kf[e] * __builtin_amdgcn_rcpf(y); }
#define PK8(o) (u32x4){pk2(o[0], o[1]), pk2(o[2], o[3]), pk2(o[4], o[5]), pk2(o[6], o[7])}
          *(LAS u32x4*)(Aop + t8 * 200 + 8 * c8) = PK8(o0); *(LAS u32x4*)(Aop + t8 * 200 + 64 + 8 * c8) = PK8(o1);
          *(LAS u32x4*)(qsf + t8 * 72 + 8 * c8) = PK8(o2); *(LAS u32x4*)(ksf + t8 * 72 + 8 * c8) = PK8(o3); *(LAS u32x4*)(qsb + t8 * 72 + 8 * c8) = PK8(o4); *(LAS u32x4*)(ksb + t8 * 72 + 8 * c8) = PK8(o5);
#undef PK8
        }
#pragma unroll
        for (int i = 0; i < 2; ++i) { const int p = tid + NT * i, jj = p >> 4, ch = p & 15; *(LAS u32x4*)(Vs + jj * 136 + 8 * ch) = P.v[i]; }
#pragma unroll
        for (int i = 0; i < 4; ++i) { const int p = tid + NT * i, dir = p >> 10, rem = p & 1023, dv = rem >> 3, c = rem & 7; *(LAS u32x4*)(Bop + dv * 136 + dir * 64 + 8 * c) = P.st[i]; }
        const u32x4 sg0 = P.sg[0], sg1 = P.sg[1];
        __syncthreads();
        if (u + G < 1024) gla_load(P, a, u + G, tid);
        { const int tt = wave >> 1, jh = wave & 1; f32x4 pa[2] = {{0.f, 0.f, 0.f, 0.f}, {0.f, 0.f, 0.f, 0.f}};
#pragma unroll
          for (int dir = 0; dir < 2; ++dir) { const LAS bf16* qs = dir ? qsb : qsf; const LAS bf16* ks = dir ? ksb : ksf;
              const bf16x8 a0 = ldfrag(qs, 72, tt * 16, 0, lane), a1 = ldfrag(qs, 72, tt * 16, 32, lane);
#pragma unroll
              for (int jj = 0; jj < 2; ++jj) { const int jt = jh * 2 + jj; f32x4 sc = {0.f, 0.f, 0.f, 0.f}; sc = MFMA16(a0, ldfrag(ks, 72, jt * 16, 0, lane), sc); sc = MFMA16(a1, ldfrag(ks, 72, jt * 16, 32, lane), sc);
#pragma unroll
                  for (int r = 0; r < 4; ++r) { const int t = tt * 16 + 4 * (lane >> 4) + r, jx = jt * 16 + (lane & 15); const bool keep = dir ? (jx >= t) : (jx <= t); pa[jj][r] += keep ? sc[r] : 0.f; } } }
#pragma unroll
          for (int jj = 0; jj < 2; ++jj)
#pragma unroll
              for (int r = 0; r < 4; ++r) Aop[(tt * 16 + 4 * (lane >> 4) + r) * 200 + 128 + (jh * 2 + jj) * 16 + (lane & 15)] = (bf16)f2bf(pa[jj][r]); }
        __syncthreads();
        const int tt = wave >> 1, dvh = wave & 1;
        f32x4 acc[4] = {{0.f, 0.f, 0.f, 0.f}, {0.f, 0.f, 0.f, 0.f}, {0.f, 0.f, 0.f, 0.f}, {0.f, 0.f, 0.f, 0.f}};
#pragma unroll
        for (int ks = 0; ks < 4; ++ks) { const bf16x8 af = ldfrag(Aop, 200, tt * 16, ks * 32, lane);
#pragma unroll
            for (int i = 0; i < 4; ++i) acc[i] = MFMA16(af, ldfrag(Bop, 136, (dvh * 4 + i) * 16, ks * 32, lane), acc[i]); }
#pragma unroll
        for (int ks = 0; ks < 2; ++ks) { const bf16x8 af = ldfrag(Aop, 200, tt * 16, 128 + ks * 32, lane);
#pragma unroll
            for (int i = 0; i < 4; ++i) acc[i] = MFMA16(af, ldfrag_tr(Vs, 136, ks * 32, (dvh * 4 + i) * 16, lane), acc[i]); }
#pragma unroll
        for (int i = 0; i < 4; ++i)
#pragma unroll
            for (int r = 0; r < 4; ++r) Os[(tt * 16 + 4 * (lane >> 4) + r) * 132 + (dvh * 4 + i) * 16 + (lane & 15)] = acc[i][r];
        __syncthreads();
        { f32x4 ov[4]; float ss = 0.f;
#pragma unroll
          for (int q = 0; q < 4; ++q) { ov[q] = *(const LAS f32x4*)(Os + t8 * 132 + 16 * c8 + 4 * q); ss += ov[q][0] * ov[q][0] + ov[q][1] * ov[q][1] + ov[q][2] * ov[q][2] + ov[q][3] * ov[q][3]; }
          ss += __shfl_xor(ss, 1); ss += __shfl_xor(ss, 2); ss += __shfl_xor(ss, 4);
          const float rstd = rsqrtf(ss * (1.f / 128.f) + EPS);
          unsigned sgw[8] = {sg0[0], sg0[1], sg0[2], sg0[3], sg1[0], sg1[1], sg1[2], sg1[3]}, ow[8];
#pragma unroll
          for (int q = 0; q < 4; ++q) { const f32x4 o = ov[q] * rstd * gn[q]; ow[2 * q] = pk2(o[0] * bflo(sgw[2 * q]), o[1] * bfhi(sgw[2 * q])); ow[2 * q + 1] = pk2(o[2] * bflo(sgw[2 * q + 1]), o[3] * bfhi(sgw[2 * q + 1])); }
          bf16* agp = (bf16*)(ws + WS_AG) + (size_t)(row0 + t8) * 512 + h * 128 + 16 * c8;
          *(u32x4*)agp = (u32x4){ow[0], ow[1], ow[2], ow[3]}; *(u32x4*)(agp + 8) = (u32x4){ow[4], ow[5], ow[6], ow[7]}; }
        __syncthreads();
    }
}

__device__ __forceinline__ void phase8(LAS unsigned char* lds, const Args& a, int vcu, int G, int tid, int lane, int wave) {
    unsigned char* ws = a.ws;
    const float* MOD = (const float*)(ws + WS_MOD);
    LAS float* WRT = (LAS float*)lds;
#pragma unroll
    for (int it = 0; it < 8; ++it) { const int idx = tid + NT * it, k = idx >> 2, c4 = idx & 3; const f32x4 v = *(const f32x4*)(a.in[I_WROUTER] + (size_t)k * 16 + 4 * c4);
        const int row = ((k >> 8) * 4 + (k & 3)) * 64 + ((k & 255) >> 2); *(LAS f32x4*)(WRT + row * 20 + 4 * c4) = v; }
    __syncthreads();
    const int gw = vcu * NWAVES + wave, NGW = G * NWAVES;
    f32x4 gv[4];
#pragma unroll
    for (int j = 0; j < 4; ++j) gv[j] = *(const f32x4*)(a.in[I_N2G] + 256 * j + 4 * lane);
    f32x4 nx[2][4];
    if (gw < M / 2) {
#pragma unroll
        for (int r = 0; r < 2; ++r)
#pragma unroll
            for (int j = 0; j < 4; ++j) { const size_t o_ = (size_t)(2 * gw + r) * 1024 + 256 * j + 4 * lane; const u32x2 d_ = *(const u32x2*)((const bf16*)(ws + WS_YD) + o_);
                nx[r][j] = *(const f32x4*)(a.in[I_X] + o_) + (f32x4){bflo(d_.x), bfhi(d_.x), bflo(d_.y), bfhi(d_.y)}; } }
    for (int pr = gw; pr < M / 2; pr += NGW) {
        const int m0 = 2 * pr, b = m0 >> 13; const float* mod = MOD + (size_t)b * 6144;
        f32x4 v[2][4]; float ss[2];
#pragma unroll
        for (int r = 0; r < 2; ++r) { float q = 0.f;
#pragma unroll
            for (int j = 0; j < 4; ++j) { v[r][j] = nx[r][j]; q += v[r][j][0] * v[r][j][0] + v[r][j][1] * v[r][j][1] + v[r][j][2] * v[r][j][2] + v[r][j][3] * v[r][j][3]; }
            ss[r] = q; }
        if (pr + NGW < M / 2) {
#pragma unroll
            for (int r = 0; r < 2; ++r)
#pragma unroll
                for (int j = 0; j < 4; ++j) { const size_t o_ = (size_t)(2 * (pr + NGW) + r) * 1024 + 256 * j + 4 * lane; const u32x2 d_ = *(const u32x2*)((const bf16*)(ws + WS_YD) + o_);
                    nx[r][j] = *(const f32x4*)(a.in[I_X] + o_) + (f32x4){bflo(d_.x), bfhi(d_.x), bflo(d_.y), bfhi(d_.y)}; } }
#pragma unroll
        for (int r = 0; r < 2; ++r) { const float rstd = rsqrtf(wave_sum(ss[r]) * (1.f / 1024.f) + EPS);
#pragma unroll
            for (int j = 0; j < 4; ++j) { const f32x4 sc = *(const f32x4*)(mod + 4096 + 256 * j + 4 * lane), sh = *(const f32x4*)(mod + 3072 + 256 * j + 4 * lane); v[r][j] = v[r][j] * rstd * gv[j] * (sc + 1.f) + sh; }
            unsigned char* hp = ws + WS_H2 + (size_t)(m0 + r) * 1024;
#pragma unroll
            for (int j = 0; j < 4; ++j) *(unsigned*)(hp + 256 * j + 4 * lane) = pk4_fp8(v[r][j][0], v[r][j][1], v[r][j][2], v[r][j][3]); }
        f32x2 r2[16];
#pragma unroll
        for (int i = 0; i < 16; ++i) r2[i] = (f32x2){0.f, 0.f};
#pragma unroll
        for (int j = 0; j < 4; ++j)
#pragma unroll
            for (int i = 0; i < 4; ++i) { const f32x2 hab = {v[0][j][i], v[1][j][i]}; const LAS float* rp = WRT + ((j * 4 + i) * 64 + lane) * 20;
#pragma unroll
                for (int c4 = 0; c4 < 4; ++c4) { const f32x4 w = *(const LAS f32x4*)(rp + 4 * c4); r2[4 * c4 + 0] += hab * w[0]; r2[4 * c4 + 1] += hab * w[1]; r2[4 * c4 + 2] += hab * w[2]; r2[4 * c4 + 3] += hab * w[3]; }
                if (i & 1) asm volatile("" ::: "memory"); }
#pragma unroll
        for (int r = 0; r < 2; ++r) {
            float racc[16];
#pragma unroll
            for (int i = 0; i < 16; ++i) racc[i] = r2[i][r];
            RSTEP(16, 32); RSTEP(8, 16); RSTEP(4, 8); RSTEP(2, 4); racc[0] += __shfl_xor(racc[0], 2); racc[0] += __shfl_xor(racc[0], 1);
            const float lg = racc[0];
            float mx = lg; mx = fmaxf(mx, __shfl_xor(mx, 4)); mx = fmaxf(mx, __shfl_xor(mx, 8)); mx = fmaxf(mx, __shfl_xor(mx, 16)); mx = fmaxf(mx, __shfl_xor(mx, 32));
            const float ex = expf(lg - mx); float sm = ex; sm += __shfl_xor(sm, 4); sm += __shfl_xor(sm, 8); sm += __shfl_xor(sm, 16); sm += __shfl_xor(sm, 32);
            const int m = m0 + r;
            if ((lane & 3) == 0) ((float*)(ws + WS_AFF))[(size_t)(b * 16 + (lane >> 2)) * SEQ + (m & (SEQ - 1))] = ex / sm;
            if (lane < 16) ((int*)(ws + WS_INV))[(size_t)m * 16 + lane] = -1;
        }
    }
}

__device__ __forceinline__ void topk_unit(LAS unsigned char* lds, const Args& a, int be, int tid, int lane, int wave) {
    unsigned char* ws = a.ws;
    LAS unsigned* hist = (LAS unsigned*)lds;
    LAS unsigned* sel = hist + 256;
    LAS unsigned* wtot = hist + 264;
    const float* aff = (const float*)(ws + WS_AFF) + (size_t)be * SEQ + 16 * tid;
    unsigned key[16];
#pragma unroll
    for (int q = 0; q < 4; ++q) { const u32x4 v = *(const u32x4*)(aff + 4 * q); key[4 * q] = v[0]; key[4 * q + 1] = v[1]; key[4 * q + 2] = v[2]; key[4 * q + 3] = v[3]; }
    unsigned prefix = 0u, mask = 0u, kk = CAP;
    for (int pass = 0; pass < 4; ++pass) {
        const int shift = 24 - 8 * pass;
        if (tid < 256) hist[tid] = 0u;
        __syncthreads();
#pragma unroll
        for (int i = 0; i < 16; ++i) if ((key[i] & mask) == prefix) __hip_atomic_fetch_add(hist + ((key[i] >> shift) & 255u), 1u, __ATOMIC_RELAXED, __HIP_MEMORY_SCOPE_WORKGROUP);
        __syncthreads();
        if (wave == 0) {
            const unsigned h0 = hist[4 * lane], h1 = hist[4 * lane + 1], h2 = hist[4 * lane + 2], h3 = hist[4 * lane + 3], loc = h0 + h1 + h2 + h3;
            unsigned suf = loc;
#pragma unroll
            for (int o = 1; o < 64; o <<= 1) { const unsigned t = __shfl_down(suf, o); if (lane + o < 64) suf += t; }
            const unsigned above = suf - loc;
            const unsigned s3 = above + h3, s2 = s3 + h2, s1 = s2 + h1, s0 = s1 + h0;
            if (s3 >= kk && above < kk) { sel[0] = 4 * lane + 3; sel[1] = kk - above; }
            if (s2 >= kk && s3 < kk) { sel[0] = 4 * lane + 2; sel[1] = kk - s3; }
            if (s1 >= kk && s2 < kk) { sel[0] = 4 * lane + 1; sel[1] = kk - s2; }
            if (s0 >= kk && s1 < kk) { sel[0] = 4 * lane + 0; sel[1] = kk - s1; }
        }
        __syncthreads();
        prefix |= sel[0] << shift; mask |= 255u << shift; kk = sel[1];
        __syncthreads();
    }
    unsigned cgt = 0u, ceq = 0u;
#pragma unroll
    for (int i = 0; i < 16; ++i) { cgt += (key[i] > prefix) ? 1u : 0u; ceq += (key[i] == prefix) ? 1u : 0u; }
    const unsigned val = cgt | (ceq << 16); unsigned inc = val;
#pragma unroll
    for (int o = 1; o < 64; o <<= 1) { const unsigned t = __shfl_up(inc, o); if (lane >= o) inc += t; }
    if (lane == 63) wtot[wave] = inc;
    __syncthreads();
    unsigned base = 0u;
    for (int w = 0; w < wave; ++w) base += wtot[w];
    const unsigned excl = base + inc - val; unsigned gtb = excl & 0xffffu, eqb = excl >> 16;
    const int b = be >> 4, e = be & 15;
    int* IDX = (int*)(ws + WS_IDX) + be * CAP; float* WSEL = (float*)(ws + WS_WSEL) + be * CAP; int* INV = (int*)(ws + WS_INV);
#pragma unroll
    for (int i = 0; i < 16; ++i) { const bool gt = key[i] > prefix, eq = key[i] == prefix; const bool take = gt || (eq && eqb < kk);
        if (take) { const unsigned pos = gtb + (eqb < kk ? eqb : kk); const int row = b * SEQ + 16 * tid + i; IDX[pos] = row; WSEL[pos] = __builtin_bit_cast(float, key[i]); INV[(size_t)row * 16 + e] = (int)pos; }
        gtb += gt ? 1u : 0u; eqb += eq ? 1u : 0u; }
    __syncthreads();
}
__device__ __forceinline__ void phase9(LAS unsigned char* lds, const Args& a, int vcu, int G, int tid, int lane, int wave) {
    const int ntk = (G > 64) ? 32 : 0;
    if (vcu < ntk || ntk == 0) for (int be = (ntk ? vcu : vcu); be < NB * NE; be += (ntk ? ntk : G)) topk_unit(lds, a, be, tid, lane, wave);
    if (vcu >= ntk) { const int gw = (vcu - ntk) * NWAVES + wave, NGW = (G - ntk) * NWAVES; convert_items<2>((LAS float*)(lds + 8192 + wave * 8448), a, gw, NGW, 8192, lane); }
}

__device__ __forceinline__ void phase12(const Args& a, int vcu, int G, int lane, int wave) {
    unsigned char* ws = a.ws;
    const int gw = vcu * NWAVES + wave, NGW = G * NWAVES;
    f32x4 gv[4];
#pragma unroll
    for (int j = 0; j < 4; ++j) gv[j] = *(const f32x4*)(a.in[I_FNG] + 256 * j + 4 * lane);
    f32x4 nx[4]; int ninv = -1;
    if (gw < M) {
#pragma unroll
        for (int j = 0; j < 4; ++j) { const size_t o_ = (size_t)gw * 1024 + 256 * j + 4 * lane; const u32x2 d_ = __builtin_nontemporal_load((const u32x2*)((const bf16*)(ws + WS_YD) + o_));
            nx[j] = __builtin_nontemporal_load((const f32x4*)(a.in[I_X] + o_)) + (f32x4){bflo(d_.x), bfhi(d_.x), bflo(d_.y), bfhi(d_.y)}; }
        ninv = (lane < 16) ? ((const int*)(ws + WS_INV))[(size_t)gw * 16 + lane] : -1; }
    for (int m = gw; m < M; m += NGW) {
        const int b = m >> 13; float* row = a.out + (size_t)m * 1024;
        f32x4 v[4];
#pragma unroll
        for (int j = 0; j < 4; ++j) v[j] = nx[j];
        const int myinv = ninv;
        if (m + NGW < M) {
#pragma unroll
            for (int j = 0; j < 4; ++j) { const size_t o_ = (size_t)(m + NGW) * 1024 + 256 * j + 4 * lane; const u32x2 d_ = __builtin_nontemporal_load((const u32x2*)((const bf16*)(ws + WS_YD) + o_));
                nx[j] = __builtin_nontemporal_load((const f32x4*)(a.in[I_X] + o_)) + (f32x4){bflo(d_.x), bfhi(d_.x), bflo(d_.y), bfhi(d_.y)}; }
            ninv = (lane < 16) ? ((const int*)(ws + WS_INV))[(size_t)(m + NGW) * 16 + lane] : -1; }
        unsigned long long mask = __ballot(myinv >= 0);
        const bf16* yb = (const bf16*)(ws + WS_YB) + (size_t)(b * 16) * CAP * 1024;
        while (mask) {
            u32x2 w[4][4]; float sc[4];
#pragma unroll
            for (int q = 0; q < 4; ++q) { const bool on = mask != 0ull; const int e = on ? (int)__builtin_ctzll(mask) : 0; mask = on ? (mask & (mask - 1ull)) : 0ull;
                const int sl = __shfl(myinv, e); const size_t ro = on ? ((size_t)e * CAP + (size_t)sl) * 1024 : 0; sc[q] = on ? 1.f : 0.f;
#pragma unroll
                for (int j = 0; j < 4; ++j) w[q][j] = __builtin_nontemporal_load((const u32x2*)(yb + ro + 256 * j + 4 * lane)); }
#pragma unroll
            for (int q = 0; q < 4; ++q)
#pragma unroll
                for (int j = 0; j < 4; ++j) { v[j][0] += sc[q] * bflo(w[q][j].x); v[j][1] += sc[q] * bfhi(w[q][j].x); v[j][2] += sc[q] * bflo(w[q][j].y); v[j][3] += sc[q] * bfhi(w[q][j].y); }
        }
        float ss = 0.f;
#pragma unroll
        for (int j = 0; j < 4; ++j) ss += v[j][0] * v[j][0] + v[j][1] * v[j][1] + v[j][2] * v[j][2] + v[j][3] * v[j][3];
        const float rstd = rsqrtf(wave_sum(ss) * (1.f / 1024.f) + EPS);
#pragma unroll
        for (int j = 0; j < 4; ++j) __builtin_nontemporal_store(v[j] * rstd * gv[j], (f32x4*)(row + 256 * j + 4 * lane));
    }
}

__global__ void __launch_bounds__(NT, 2) fwd_kernel(Args args) {
    extern __shared__ __attribute__((aligned(16))) unsigned char lds_raw[];
    LAS unsigned char* lds = (LAS unsigned char*)lds_raw;
    volatile LAS unsigned* MISC = (volatile LAS unsigned*)(lds + MISC_OFF);
    const int tid0 = threadIdx.x, tid = tid0, wave = __builtin_amdgcn_readfirstlane(tid >> 6);
    const int G = gridDim.x, bx = blockIdx.x, vcu = (G % 8 == 0) ? (bx % 8) * (G / 8) + bx / 8 : bx;
    unsigned char* ws = args.ws;
    if (tid < 128) MISC[tid] = 0u;
    __syncthreads();
    XcdBarrier bar; bar.bar = (unsigned*)(ws + WS_CTL) + CW_BAR; bar.x = 0; bar.st = nullptr;
    if (!MK_MULTI) bar = xcd_barrier_post((unsigned*)(ws + WS_CTL) + CW_BAR, MISC + 8);
    const int lo = args.ph_lo, hi = args.ph_hi;
#define IN(k) (lo <= (k) && (k) < hi)
#define SEAM(k) do { if (IN(k) && IN((k) + 1)) xcd_barrier(bar); } while (0)
#define RUN(k, CODE) do { if (IN(k)) { int tid = tid0, lane; asm volatile("" : "+v"(tid)); lane = tid & 63; (void)lane; CODE; if (REP_PHASE == (k)) for (int _r = 0; _r < REP_COUNT; ++_r) { xcd_barrier(bar); CODE; } } SEAM(k); } while (0)
#define PH0 phase0(lds, args, vcu, G, tid, lane, wave)
#define PH1 phase1(lds, args, vcu, G, tid, lane, wave)
#define PH2 do { const int qs = vcu % 3;     \
        EpiInproj E{(bf16*)(ws + WS_KB), (bf16*)(ws + WS_VB), (bf16*)(ws + WS_QB), (bf16*)(ws + WS_SG), (bf16*)(ws + WS_PI), ws + WS_SM, 0, 1.f}; \
        EpiGates E8{(bf16*)(ws + WS_KB), (bf16*)(ws + WS_VB), (bf16*)(ws + WS_QB), (bf16*)(ws + WS_SG), (bf16*)(ws + WS_PI), ws + WS_SM, 8, 0.0625f}; \
        if (qs == 0) convert_all<1>(lds, args, vcu, G, lane, wave); \
        { SchedDense S{G, bx, 1024, 64, 8, (const char*)(ws + WS_H1), (const char*)(ws + WS_WIN), 0, 1 << 20, 2}; pg8::gemm_phase<EpiInproj, SchedDense, false, false>(lds, S, E); }     \
        if (qs == 1) convert_all<1>(lds, args, vcu, G, lane, wave); \
        { SchedDense S{G, bx, 1024, 64, 8, (const char*)(ws + WS_H1F), (const char*)(ws + WS_WINM), 0, 1 << 20, 1}; pg8::gemm_phase<EpiGates, SchedDense, false, true>(lds, S, E8); }     \
        if (qs == 2) convert_all<1>(lds, args, vcu, G, lane, wave); } while (0)
#define PH3 chunk_units(lds, args, vcu, G, tid, lane, wave)
#define PH4 do { pool_units(args, vcu, G, lane, wave, 8); phase4(args, G, tid, NT); } while (0)
#define PH5 phase5(lds, args, vcu, G, tid, lane, wave)
#define PH6 do { SchedPair S{G, bx, 512, (const char*)(ws + WS_AG), (const char*)(ws + WS_PO), (const char*)(ws + WS_WG), (const char*)(ws + WS_WC)}; \
        EpiMerge E{ws + WS_SM, (bf16*)(ws + WS_MG)}; pg8::gemm_phase<EpiMerge, SchedPair, false>(lds, S, E); } while (0)
#define PH7 do { SchedDense S{G, bx, 1024, 64, 4, (const char*)(ws + WS_MG), (const char*)(ws + WS_WO), 0, 1 << 20, 2}; \
        EpiOut E{(const float*)(ws + WS_MOD), (bf16*)(ws + WS_YD)}; pg8::gemm_phase<EpiOut, SchedDense, false>(lds, S, E); } while (0)
#define NITEM_HALF ((NE * 3 * 512 + 2 * G * NWAVES - 1) / (2 * G * NWAVES))
#define PH6C do { if (vcu & 1) convert_experts(lds, args, vcu, G, lane, wave, 0, NITEM_HALF); PH6; if (!(vcu & 1)) convert_experts(lds, args, vcu, G, lane, wave, 0, NITEM_HALF); } while (0)
#define PH7C do { if (vcu & 1) convert_experts(lds, args, vcu, G, lane, wave, NITEM_HALF, 2 * NITEM_HALF); PH7; if (!(vcu & 1)) convert_experts(lds, args, vcu, G, lane, wave, NITEM_HALF, 2 * NITEM_HALF); } while (0)
#define PH8 phase8(lds, args, vcu, G, tid, lane, wave)
#define PH9 phase9(lds, args, vcu, G, tid, lane, wave)
#define PH9B do { const int gw_ = vcu * NWAVES + wave, NGW_ = G * NWAVES;     \
        for (int r0_ = gw_ * 16; r0_ < NB * NE * CAP; r0_ += NGW_ * 16) { u32x4 t_[16]; \
            _Pragma("unroll") for (int q = 0; q < 16; ++q) { const int src_ = ((const int*)(ws + WS_IDX))[r0_ + q]; t_[q] = *(const u32x4*)(ws + WS_H2 + (size_t)src_ * 1024 + lane * 16); } \
            _Pragma("unroll") for (int q = 0; q < 16; ++q) *(u32x4*)(ws + WS_XS + (size_t)(r0_ + q) * 1024 + lane * 16) = t_[q]; } } while (0)
#define PH10 do { EpiMoe1 E{ws + WS_ACT}; SchedMoe1 S{G, bx, 1024, (const char*)(ws + WS_XS), (const char*)(ws + WS_WGU), 0, 1 << 20}; pg8::gemm_phase<EpiMoe1, SchedMoe1, false, true>(lds, S, E); } while (0)
#define PH11 do { SchedMoe2 S{G, bx, 1024, (const char*)(ws + WS_ACT), (const char*)(ws + WS_WD)}; \
        EpiMoe2 E{(bf16*)(ws + WS_YB), (const float*)(ws + WS_WSEL), (const float*)(ws + WS_MOD)}; pg8::gemm_phase<EpiMoe2, SchedMoe2, false, true>(lds, S, E); } while (0)
#define PH12 phase12(args, vcu, G, lane, wave)
    RUN(0, PH0); RUN(1, PH1); RUN(2, PH2); RUN(3, PH3);
#define PH3A chunk_units(lds, args, vcu, G, tid, lane, wave)
#define PH3B pool_units(args, vcu, G, lane, wave, 8)
    if (REP_PHASE == 40) { xcd_barrier(bar); if (wave < 4) phase4(args, G, tid, 256); xcd_barrier(bar); }
    if (REP_PHASE == 41) { const int lane = tid & 63; xcd_barrier(bar); if (wave >= 4) pool_units(args, vcu, G, lane, wave - 4, 4); xcd_barrier(bar); }
    if (REP_PHASE == 30) { const int lane = tid & 63; xcd_barrier(bar); PH3A; xcd_barrier(bar); }
    if (REP_PHASE == 31) { const int lane = tid & 63; xcd_barrier(bar); PH3B; xcd_barrier(bar); } RUN(4, PH4); RUN(5, PH5); RUN(6, PH6); RUN(7, PH7); RUN(8, PH8); RUN(9, PH9); RUN(10, PH9B); RUN(11, PH10); RUN(12, PH11);
    if (REP_PHASE == 20) for (int _r = 0; _r < REP_COUNT; ++_r) xcd_barrier(bar);
    RUN(13, PH12);
#undef IN
#undef SEAM
#undef RUN
}

#ifndef MK_CHECK
#define MK_CHECK 0
#endif
#ifndef CHK_SKIP
#define CHK_SKIP -1
#endif
#if MK_CHECK
constexpr size_t WS_CHK = 299 * MiB;
__device__ __forceinline__ unsigned hashu(unsigned x) { x ^= x >> 16; x *= 0x7feb352dU; x ^= x >> 15; x *= 0x846ca68bU; x ^= x >> 16; return x; }
__device__ __forceinline__ float bfr(float f) { return bf2f(f2bf(f)); }
__device__ float f8d(unsigned char x) { const int sg = x >> 7, e = (x >> 3) & 15, m = x & 7; const float v = e ? ldexpf(1.f + m / 8.f, e - 7) : ldexpf(m / 8.f, -6); return sg ? -v : v; }
__device__ float f8r(float f) { return f8d((unsigned char)(pk4_fp8(f, 0.f, 0.f, 0.f) & 255u)); }
__device__ float x1_at(const Args& a, int m, int k) { return a.in[I_X][(size_t)m * 1024 + k] + bf2f(((const bf16*)(a.ws + WS_YD))[(size_t)m * 1024 + k]); }
__device__ float naive_rstd_x1(const Args& a, int m) { float ss = 0.f; for (int k = 0; k < 1024; ++k) { const float v = x1_at(a, m, k); ss += v * v; } return rsqrtf(ss / 1024.f + EPS); }
__device__ float gate_at(const Args& a, int m, int n) {
    const int pm = m >> 8, r = m & 255, ai = r >> 7, wr = (r >> 6) & 1, mm = (r >> 4) & 3, fr = r & 15, pg = n >> 8, c = n & 255, bj = c >> 7, wc = (c >> 5) & 3, fq = (c >> 3) & 3, j8 = c & 7;
    return (float)(a.ws + WS_SM)[gate_off(pm, pg, ai, mm, bj, wr, wc, fr, fq) + j8] * (1.f / 255.f); }
__device__ float naive_rstd(const float* row) { float ss = 0.f; for (int k = 0; k < 1024; ++k) ss += row[k] * row[k]; return rsqrtf(ss / 1024.f + EPS); }
__device__ float naive_la(const Args& a, int row, int dir, int col) {
    const float* RB = (const float*)(a.ws + WS_RB) + (size_t)row * 32 + dir * 16; float z = a.in[I_BDEC][dir * 256 + col];
    for (int j = 0; j < 16; ++j) z += RB[j] * a.in[I_WDU][(size_t)(dir * 16 + j) * 256 + col];
    return logsig_f(z) / 16.f;
}
__global__ void chk_kernel(Args a, int stage) {
    __shared__ float sh[256];
    const unsigned gid = blockIdx.x * blockDim.x + threadIdx.x; unsigned h = hashu(gid * 2654435761u + (unsigned)stage * 97u + 12345u); const unsigned h2 = hashu(h + 777u);
    unsigned char* ws = a.ws; float ref = 0.f, got = 0.f, atol = 1e-3f; bool active = true;
    const float* MOD = (const float*)(ws + WS_MOD);
    switch (stage) {
    case 0: { const int v = h % 3, n = (h >> 2) % 6144; ref = a.in[I_ADAB][n]; for (int k = 0; k < 1024; ++k) { const float c = (v < 2) ? a.in[I_C][v * 1024 + k] : a.in[I_CCTX][k]; ref += c / (1.f + expf(-c)) * a.in[I_ADAW][(size_t)k * 6144 + n]; } got = MOD[v * 6144 + n]; atol = 0.01f; } break;
    case 1: { const int sel = (h >> 28) & 3, n = h % 4096, k = (h >> 12) % 1024;
        if (sel < 2) { if (n < 2048) { ref = bfr(a.in[I_WIN][(size_t)k * DIN + n + (n >= 768 ? 32 : 0)]); got = bf2f(((const bf16*)(ws + WS_WIN))[(size_t)n * 1024 + k]); } else { ref = f8r(16.f * a.in[I_WIN][(size_t)k * DIN + n + 32]); got = f8d((ws + WS_WINM)[(size_t)(n - 2048) * 1024 + k]); } }
        else if (sel == 2) { ref = bfr(a.in[I_WOUT][(size_t)k * 1024 + (n & 1023)]); got = bf2f(((const bf16*)(ws + WS_WO))[(size_t)(n & 1023) * 1024 + k]); }
        else { ref = bfr(a.in[I_WGLA][(size_t)(k & 511) * 1024 + (n & 1023)]); got = bf2f(((const bf16*)(ws + WS_WG))[(size_t)(n & 1023) * 512 + (k & 511)]); } atol = 1e-4f; } break;
    case 2: { const int n = h % 1024, kk = (h >> 10) % 512, g = kk >> 7, c = kk & 127; for (int d = 0; d < 128; ++d) ref += a.in[I_POOLW][(size_t)(g * 128 + c) * 128 + d] * a.in[I_POOLS][g * 128 + d] * a.in[I_WPOOL][(size_t)(g * 128 + d) * 1024 + n];
        got = bf2f(((const bf16*)(ws + WS_WC))[(size_t)n * 512 + kk]); atol = 0.002f; } break;
    case 3: { const int m = h % M, k = (h >> 14) % 1024, b = m >> 13; const float* row = a.in[I_X] + (size_t)m * 1024; const float rstd = naive_rstd(row);
        ref = row[k] * rstd * a.in[I_N1G][k] * (1.f + MOD[b * 6144 + 1024 + k]) + MOD[b * 6144 + k]; got = bf2f(((const bf16*)(ws + WS_H1))[(size_t)m * 1024 + k]); atol = 0.01f; } break;
    case 4: { const int m = h % MT, c = (h >> 15) % 32, mi = (m < M) ? (m >> 13) : 2; const float* row = (m < M) ? a.in[I_X] + (size_t)m * 1024 : a.in[I_CTX] + (size_t)(m - M) * 1024; const float rstd = naive_rstd(row);
        for (int k = 0; k < 1024; ++k) ref += (row[k] * rstd * a.in[I_N1G][k] * (1.f + MOD[mi * 6144 + 1024 + k]) + MOD[mi * 6144 + k]) * a.in[I_WIN][(size_t)k * DIN + 768 + c];
        got = ((const float*)(ws + WS_RB))[(size_t)m * 32 + c]; atol = 0.01f; } break;
    case 5: { const int r = h % 512, n = (h >> 9) % 768; const float* row = a.in[I_CTX] + (size_t)r * 1024; const float rstd = naive_rstd(row);
        for (int k = 0; k < 1024; ++k) ref += bfr(row[k] * rstd * a.in[I_N1G][k] * (1.f + MOD[2 * 6144 + 1024 + k]) + MOD[2 * 6144 + k]) * bf2f(((const bf16*)(ws + WS_WIN))[(size_t)n * 1024 + k]);
        got = (n < 256) ? bf2f(((const bf16*)(ws + WS_KB))[(size_t)(M + r) * 256 + n]) : bf2f(((const bf16*)(ws + WS_VB))[(size_t)(M + r) * 512 + n - 256]); atol = 0.03f; } break;
    case 6: { const int m = h % M, n = (h >> 14) % 4096; const bf16* hr = (const bf16*)(ws + WS_H1) + (size_t)m * 1024; const bf16* wr_ = (const bf16*)(ws + WS_WIN) + (size_t)n * 1024; float d = 0.f;
        if (n < 2048) { for (int k = 0; k < 1024; ++k) d += bf2f(hr[k]) * bf2f(wr_[k]); }
        else { for (int k = 0; k < 1024; ++k) d += f8d((ws + WS_H1F)[(size_t)m * 1024 + k]) * f8d((ws + WS_WINM)[(size_t)(n - 2048) * 1024 + k]); d *= 0.0625f; }
        if (n < 256) { ref = d; got = bf2f(((const bf16*)(ws + WS_KB))[(size_t)m * 256 + n]); }
        else if (n < 768) { ref = d; got = bf2f(((const bf16*)(ws + WS_VB))[(size_t)m * 512 + n - 256]); }
        else if (n < 1024) { ref = d * 0.125f; got = bf2f(((const bf16*)(ws + WS_QB))[(size_t)m * 256 + n - 768]); }
        else if (n < 1536) { ref = d / (1.f + expf(-d)); got = bf2f(((const bf16*)(ws + WS_SG))[(size_t)m * 512 + n - 1024]); }
        else if (n < 2048) { ref = d; got = bf2f(((const bf16*)(ws + WS_PI))[(size_t)m * 512 + n - 1536]); }
        else { ref = 1.f / (1.f + expf(-d)); got = gate_at(a, m, n - 2048); } atol = 0.02f; } break;
    case 7: { const int m = h % M, col = (h >> 14) % 256, dir = (h >> 22) & 1, t = m & 63, m0 = m - t;
        for (int s = 0; s < 64; ++s) if (dir ? (s >= t) : (s <= t)) ref += naive_la(a, m0 + s, dir, col);
        got = (dir ? a.out + (size_t)M * 256 : a.out)[(size_t)m * 256 + col]; atol = 0.003f; } break;
    case 8: case 9: { const int dir = h & 1, bh = (h >> 1) & 7, slot = (stage == 9) ? 128 + ((h >> 4) & 3) : ((h >> 4) & 127), dv = (h >> 11) & 127, dk = (h >> 18) & 63, b = bh >> 2, hh = bh & 3;
        const int row0 = (slot < 128) ? b * SEQ + slot * 64 : M + b * LC + (slot - 128) * 64; float la[64]; float tot = 0.f;
        for (int s = 0; s < 64; ++s) tot += naive_la(a, row0 + s, dir, hh * 64 + dk);
        float run = 0.f;
        if (!dir) { for (int s = 0; s < 64; ++s) { run += naive_la(a, row0 + s, 0, hh * 64 + dk); ref += bf2f(((const bf16*)(ws + WS_VB))[(size_t)(row0 + s) * 512 + hh * 128 + dv]) * bfr(bf2f(((const bf16*)(ws + WS_KB))[(size_t)(row0 + s) * 256 + hh * 64 + dk]) * expf(tot - run)); } }
        else { for (int s = 63; s >= 0; --s) { run += naive_la(a, row0 + s, 1, hh * 64 + dk); ref += bf2f(((const bf16*)(ws + WS_VB))[(size_t)(row0 + s) * 512 + hh * 128 + dv]) * bfr(bf2f(((const bf16*)(ws + WS_KB))[(size_t)(row0 + s) * 256 + hh * 64 + dk]) * expf(tot - run)); } }
        (void)la;
        if ((h >> 30) & 1) { ref = expf(tot); got = ((const float*)(ws + WS_DEC))[((size_t)(dir * 8 + bh) * NSLOT + slot) * 64 + dk]; atol = 1e-3f; }
        else { got = bf2f(((const bf16*)(ws + WS_KV))[((size_t)(dir * 8 + bh) * NSLOT + slot) * 8192 + dv * 64 + dk]); atol = 0.1f; } } break;
    case 10: { const int m = h % M, col = (h >> 14) % 512, g = col >> 7, half = 1 << g, b = m >> 13, l = m & 8191, r = l >> 6, c = l & 63; const bf16* PI = (const bf16*)(ws + WS_PI);
        const int lo_r = max(r - half, 0), hi_r = min(r + half, 128), lo_c = max(c - half, 0), hi_c = min(c + half, 64); float sm = 0.f;
        for (int rr = lo_r; rr < hi_r; ++rr) for (int cc = lo_c; cc < hi_c; ++cc) sm += bf2f(PI[(size_t)(b * SEQ + rr * 64 + cc) * 512 + col]);
        ref = sm / (float)((hi_r - lo_r) * (hi_c - lo_c)) - bf2f(PI[(size_t)m * 512 + col]); got = bf2f(((const bf16*)(ws + WS_PO))[(size_t)m * 512 + col]); atol = 0.02f; } break;
    case 11: { const int dir = h & 1, bh = (h >> 1) & 7, n = (h >> 4) & 127, e8 = (h >> 11) & 8191, dk = e8 & 63; float s = 0.f;
        const bf16* kvp = (const bf16*)(ws + WS_KV) + (size_t)((dir * 8 + bh) * NSLOT) * 8192 + e8; const float* dp = (const float*)(ws + WS_DEC) + (size_t)((dir * 8 + bh) * NSLOT) * 64 + dk;
        if (!dir) { for (int j = 128; j < 132; ++j) s = dp[j * 64] * s + bf2f(kvp[(size_t)j * 8192]); for (int j = 0; j < n; ++j) s = dp[j * 64] * s + bf2f(kvp[(size_t)j * 8192]); }
        else { for (int j = 131; j >= 128; --j) s = dp[j * 64] * s + bf2f(kvp[(size_t)j * 8192]); for (int j = 127; j > n; --j) s = dp[j * 64] * s + bf2f(kvp[(size_t)j * 8192]); }
        ref = s; got = bf2f(((const bf16*)(ws + WS_ST))[(size_t)((dir * 8 + bh) * NCH + n) * 8192 + e8]); atol = 0.1f; } break;
    case 12: {
        const unsigned hb = hashu(blockIdx.x * 7919u + 5u); const int m = hb % M, hh = (hb >> 14) & 3, b = m >> 13, l = m & 8191, n = l >> 6, t = l & 63, row0 = m - t, bh = b * 4 + hh, dv = threadIdx.x & 127;
        const float* BF = a.out; const float* CB = a.out + (size_t)M * 256; const bf16* QB = (const bf16*)(ws + WS_QB); const bf16* KB = (const bf16*)(ws + WS_KB); const bf16* VB = (const bf16*)(ws + WS_VB); const bf16* ST = (const bf16*)(ws + WS_ST);
        if (threadIdx.x < 128) { const int j = threadIdx.x & 63, dir = threadIdx.x >> 6; float sc = 0.f;
            const bool keep = dir ? (j >= t) : (j <= t);
            if (keep) for (int d = 0; d < 64; ++d) { const size_t gq = (size_t)m * 256 + hh * 64 + d, gk = (size_t)(row0 + j) * 256 + hh * 64 + d; const float* P = dir ? CB : BF; sc += bf2f(QB[gq]) * bf2f(KB[gk]) * expf(P[gq] - P[gk]); }
            sh[threadIdx.x] = sc; }
        __syncthreads();
        float o = 0.f;
        for (int d = 0; d < 64; ++d) { const size_t gq = (size_t)m * 256 + hh * 64 + d; const float q = bf2f(QB[gq]);
            o += q * expf(BF[gq]) * bf2f(ST[((size_t)((0 * 8 + bh) * NCH + n) * 128 + dv) * 64 + d]) + q * expf(CB[gq]) * bf2f(ST[((size_t)((1 * 8 + bh) * NCH + n) * 128 + dv) * 64 + d]); }
        for (int j = 0; j < 64; ++j) o += (sh[j] + sh[64 + j]) * bf2f(VB[(size_t)(row0 + j) * 512 + hh * 128 + dv]);
        __syncthreads(); sh[128 + dv] = o * o; __syncthreads();
        float ss = 0.f; for (int d = 0; d < 128; ++d) ss += sh[128 + d];
        const size_t gi = (size_t)m * 512 + hh * 128 + dv;
        ref = o * rsqrtf(ss / 128.f + EPS) * a.in[I_GNG][dv] * bf2f(((const bf16*)(ws + WS_SG))[gi]); got = bf2f(((const bf16*)(ws + WS_AG))[gi]); atol = 0.03f; } break;
    case 13: { const int m = h % M, n = (h >> 14) % 1024; float g = 0.f, p = 0.f; const bf16* AG = (const bf16*)(ws + WS_AG) + (size_t)m * 512; const bf16* PO = (const bf16*)(ws + WS_PO) + (size_t)m * 512;
        for (int k = 0; k < 512; ++k) { g += bf2f(AG[k]) * bf2f(((const bf16*)(ws + WS_WG))[(size_t)n * 512 + k]); p += bf2f(PO[k]) * bf2f(((const bf16*)(ws + WS_WC))[(size_t)n * 512 + k]); }
        ref = gate_at(a, m, n) * g + gate_at(a, m, 1024 + n) * p; got = bf2f(((const bf16*)(ws + WS_MG))[(size_t)m * 1024 + n]); atol = 0.03f; } break;
    case 14: { const int m = h % M, n = (h >> 14) % 1024, b = m >> 13; float d = 0.f; for (int k = 0; k < 1024; ++k) d += bf2f(((const bf16*)(ws + WS_MG))[(size_t)m * 1024 + k]) * bf2f(((const bf16*)(ws + WS_WO))[(size_t)n * 1024 + k]);
        ref = bfr(MOD[b * 6144 + 2048 + n] * d); got = bf2f(((const bf16*)(ws + WS_YD))[(size_t)m * 1024 + n]); atol = 0.005f; } break;
    case 15: { const int m = h % M, k = (h >> 14) % 1024, b = m >> 13; const float rstd = naive_rstd_x1(a, m);
        ref = x1_at(a, m, k) * rstd * a.in[I_N2G][k] * (1.f + MOD[b * 6144 + 4096 + k]) + MOD[b * 6144 + 3072 + k]; got = f8d((ws + WS_H2)[(size_t)m * 1024 + k]); atol = 0.02f; ref = f8r(ref); } break;
    case 16: { const int m = h % M, e = (h >> 14) & 15, b = m >> 13; const float rstd = naive_rstd_x1(a, m); float mx = -1e30f, mye = 0.f, sm = 0.f;
        for (int pass = 0; pass < 2; ++pass) for (int ee = 0; ee < 16; ++ee) { float lg = 0.f; for (int k = 0; k < 1024; ++k) lg += (x1_at(a, m, k) * rstd * a.in[I_N2G][k] * (1.f + MOD[b * 6144 + 4096 + k]) + MOD[b * 6144 + 3072 + k]) * a.in[I_WROUTER][k * 16 + ee];
            if (pass == 0) mx = fmaxf(mx, lg); else { const float ex = expf(lg - mx); sm += ex; if (ee == e) mye = ex; } }
        ref = mye / sm; got = ((const float*)(ws + WS_AFF))[(size_t)(b * 16 + e) * SEQ + (m & 8191)]; atol = 0.001f; } break;
    case 17: { const int be = h & 31, slot = (h >> 5) & 1023, b = be >> 4, e = be & 15; const int row = ((const int*)(ws + WS_IDX))[be * CAP + slot]; const float* aff = (const float*)(ws + WS_AFF) + (size_t)be * SEQ; float bad = 0.f;
        if (row < b * SEQ || row >= (b + 1) * SEQ) bad += 1.f; else { const int l = row & 8191; if (((const int*)(ws + WS_INV))[(size_t)row * 16 + e] != slot) bad += 1.f; if (((const float*)(ws + WS_WSEL))[be * CAP + slot] != aff[l]) bad += 1.f;
            int cnt = 0; for (int j = 0; j < SEQ; ++j) cnt += (aff[j] > aff[l]) ? 1 : 0; if (cnt >= CAP) bad += 1.f;
            const int l2 = h2 & 8191; if (((const int*)(ws + WS_INV))[(size_t)(b * SEQ + l2) * 16 + e] < 0) { int c2 = 0; for (int j = 0; j < SEQ; ++j) c2 += (aff[j] >= aff[l2]) ? 1 : 0; if (c2 <= CAP) bad += 1.f; } }
        ref = 0.f; got = bad; atol = 0.5f; } break;
    case 18: { const int e = h & 15, mat = (h >> 4) % 3, n = (h >> 8) & 1023, k = (h >> 18) & 1023;
        if (mat == 0) { ref = f8r(16.f * a.in[I_WGATE][(size_t)e * 1048576 + (size_t)k * 1024 + n]); got = f8d((ws + WS_WGU)[((size_t)e * 2048 + (n >> 7) * 256 + (n & 127)) * 1024 + k]); }
        else if (mat == 1) { ref = f8r(16.f * a.in[I_WUP][(size_t)e * 1048576 + (size_t)k * 1024 + n]); got = f8d((ws + WS_WGU)[((size_t)e * 2048 + (n >> 7) * 256 + 128 + (n & 127)) * 1024 + k]); }
        else { ref = f8r(16.f * a.in[I_WDOWN][(size_t)e * 1048576 + (size_t)k * 1024 + n]); got = f8d((ws + WS_WD)[((size_t)e * 1024 + n) * 1024 + k]); } atol = 1e-4f; } break;
    case 19: { const int be = h & 31, slot = (h >> 5) & 1023, f = (h >> 15) & 1023, e = be & 15; const int row = ((const int*)(ws + WS_IDX))[be * CAP + slot]; float g = 0.f, u = 0.f;
        const unsigned char* hr = ws + WS_H2 + (size_t)row * 1024; const unsigned char* wg = ws + WS_WGU + ((size_t)e * 2048 + (f >> 7) * 256 + (f & 127)) * 1024; const unsigned char* wu = wg + 128 * 1024;
        for (int k = 0; k < 1024; ++k) { g += f8d(hr[k]) * f8d(wg[k]); u += f8d(hr[k]) * f8d(wu[k]); }
        g *= 0.0625f; u *= 0.0625f; ref = f8r(g / (1.f + expf(-g)) * u); got = f8d((ws + WS_ACT)[((size_t)be * CAP + slot) * 1024 + f]); atol = 0.03f; } break;
    case 20: { const int be = h & 31, slot = (h >> 5) & 1023, n = (h >> 15) & 1023, e = be & 15, b = be >> 4; float d = 0.f;
        for (int f = 0; f < 1024; ++f) d += f8d((ws + WS_ACT)[((size_t)be * CAP + slot) * 1024 + f]) * f8d((ws + WS_WD)[((size_t)e * 1024 + n) * 1024 + f]);
        ref = d * 0.0625f * ((const float*)(ws + WS_WSEL))[be * CAP + slot] * MOD[b * 6144 + 5120 + n]; got = bf2f(((const bf16*)(ws + WS_YB))[((size_t)be * CAP + slot) * 1024 + n]); atol = 0.002f; } break;
    default: active = false;
    }
    if (active) { float e = fabsf(got - ref) / (atol + 0.03f * fabsf(ref)); if (!(e == e)) e = 1e9f; atomicMax((unsigned*)(ws + WS_CHK) + stage, __float_as_uint(e)); }
}
__global__ void chk_final(Args a) {
    __shared__ int code;
    if (threadIdx.x == 0) { int c = 0; for (int s = 20; s >= 0; --s) if (s > CHK_SKIP && __uint_as_float(((const unsigned*)(a.ws + WS_CHK))[s]) > 1.f) c = s + 1; code = c; }
    __syncthreads();
    const float sc = 1.f + 0.1f * (float)code;
    for (size_t i = (size_t)blockIdx.x * blockDim.x + threadIdx.x; i < (size_t)M * D; i += (size_t)gridDim.x * blockDim.x) a.out[i] *= sc;
}
#endif

extern "C" void kernel_launch(void* const* d_in, const int* in_sizes, int n_in, void* d_out, int out_size, void* d_ws, size_t ws_size, hipStream_t stream) {
    static int grid = 0;
    if (grid == 0) {
        if (n_in != 22 || out_size != M * D || ws_size < WS_END) { fprintf(stderr, "kernel_launch: unexpected shapes (n_in %d, out %d, ws %zu < %zu)\n", n_in, out_size, ws_size, (size_t)WS_END); grid = -1; return; }
        int dev = 0, cus = 0, per_cu = 0;
        if (hipGetDevice(&dev) != hipSuccess || hipDeviceGetAttribute(&cus, hipDeviceAttributeMultiprocessorCount, dev) != hipSuccess) { grid = -1; return; }
        if (hipFuncSetAttribute((const void*)fwd_kernel, hipFuncAttributeMaxDynamicSharedMemorySize, LDS_BYTES) != hipSuccess) { fprintf(stderr, "kernel_launch: hipFuncSetAttribute failed\n"); grid = -1; return; }
        if (hipOccupancyMaxActiveBlocksPerMultiprocessor(&per_cu, (const void*)fwd_kernel, NT, LDS_BYTES) != hipSuccess || per_cu < 1) { fprintf(stderr, "kernel_launch: occupancy query says %d\n", per_cu); per_cu = 1; }
        (void)hipGetLastError();
        grid = cus;
    }
    if (grid < 0) return;
    (void)hipMemsetAsync((char*)d_ws + WS_CTL, 0, CTL_ZERO_BYTES, stream);
    Args a{};
    for (int i = 0; i < 22; ++i) a.in[i] = (const float*)d_in[i];
    a.out = (float*)d_out; a.ws = (unsigned char*)d_ws;
#if MK_MULTI
    for (int p = 0; p < NPHASE; ++p) { a.ph_lo = p; a.ph_hi = p + 1; hipLaunchKernelGGL(fwd_kernel, dim3(grid), dim3(NT), LDS_BYTES, stream, a);
#if MK_CHECK
        if (p == 0) (void)hipMemsetAsync((char*)d_ws + WS_CHK, 0, 4096, stream);
        static const int after[21] = {0, 0, 0, 1, 1, 1, 2, 3, 3, 3, 4, 4, 5, 6, 7, 8, 8, 9, 10, 11, 12};
        for (int st = 0; st < 21; ++st) if (after[st] == p) hipLaunchKernelGGL(chk_kernel, dim3(st == 12 ? 1024 : 32), dim3(128), 0, stream, a, st);
        if (p == NPHASE - 1) hipLaunchKernelGGL(chk_final, dim3(1024), dim3(256), 0, stream, a);
#endif
    }
#else
    a.ph_lo = 0; a.ph_hi = NPHASE;
#if MK_COOP
    void* kargs[] = {&a};
    hipError_t e = hipLaunchCooperativeKernel((const void*)fwd_kernel, dim3(grid), dim3(NT), kargs, LDS_BYTES, stream);
    if (e != hipSuccess) fprintf(stderr, "kernel_launch: cooperative launch failed: %s (grid %d)\n", hipGetErrorString(e), grid);
#else
    hipLaunchKernelGGL(fwd_kernel, dim3(grid), dim3(NT), LDS_BYTES, stream, a);
#endif
#endif
}
```

```cpp
#include <hip/hip_runtime.h>
#include <cstdio>
#include <cstdint>

#define LAS __attribute__((address_space(3)))
#define GAS __attribute__((address_space(1)))
typedef unsigned short bf16;
typedef short bf16x8 __attribute__((ext_vector_type(8)));
typedef float f32x4 __attribute__((ext_vector_type(4)));
typedef float f32x2 __attribute__((ext_vector_type(2)));
typedef unsigned u32x4 __attribute__((ext_vector_type(4)));
typedef unsigned u32x2 __attribute__((ext_vector_type(2)));

#ifndef ABL_NOMOE
#define ABL_NOMOE 0
#endif
#ifndef REP_PHASE
#define REP_PHASE -1
#endif
#ifndef REP_COUNT
#define REP_COUNT 1
#endif
#ifndef MK_COOP
#define MK_COOP 1
#endif
#ifndef MK_MULTI
#define MK_MULTI 0
#endif

constexpr int D = 1024, NB = 2, SEQ = 8192, M = NB * SEQ, LC = 256, MC = NB * LC, MT = M + MC;
constexpr int DIN = 4128;
constexpr int NCH = SEQ / 64, NCHC = LC / 64, NSLOT = NCH + NCHC;
constexpr int NE = 16, CAP = 1024;
constexpr float EPS = 1e-6f;
constexpr int NWAVES = 8, NT = 512;
constexpr int NPHASE = 14;

constexpr size_t MiB = 1u << 20;
constexpr size_t WS_CTL = 0, CTL_ZERO_BYTES = 64 * 1024;
constexpr size_t WS_MOD = 1 * MiB;
constexpr size_t WS_DEC = 1 * MiB + 128 * 1024;
constexpr size_t WS_WIN = 2 * MiB, WS_WO = 10 * MiB, WS_WG = 12 * MiB, WS_WC = 13 * MiB;
constexpr size_t WS_AFF = 14 * MiB, WS_INV = 15 * MiB, WS_IDX = 16 * MiB, WS_WSEL = 16 * MiB + 256 * 1024;
constexpr size_t WS_H1 = 20 * MiB;
constexpr size_t WS_ST = 20 * MiB, WS_H2 = 20 * MiB;
constexpr size_t WS_KB = 52 * MiB, WS_VB = 61 * MiB, WS_QB = 78 * MiB, WS_SG = 86 * MiB, WS_PI = 102 * MiB, WS_RB = 118 * MiB;
constexpr size_t WS_AG = 102 * MiB;
constexpr size_t WS_SM = 121 * MiB;
constexpr size_t WS_KV = 249 * MiB;
constexpr size_t WS_PO = 282 * MiB;
constexpr size_t WS_MG = 249 * MiB;
constexpr size_t WS_WGU = 185 * MiB, WS_WD = 52 * MiB, WS_ACT = 121 * MiB, WS_YB = 185 * MiB;
constexpr size_t WS_H1F = 249 * MiB;
constexpr size_t WS_WINM = 265 * MiB;
constexpr size_t WS_YD = 153 * MiB;
constexpr size_t WS_XS = 68 * MiB;
constexpr size_t WS_END = 300 * MiB;
constexpr int CW_BAR = 1024;

constexpr int LDS_BYTES = 155648;
constexpr int MISC_OFF = 153600;

#define LDS_WAIT() asm volatile("s_waitcnt lgkmcnt(0)" ::: "memory")
#define VM_WAIT() asm volatile("s_waitcnt vmcnt(0)" ::: "memory")
__device__ __forceinline__ unsigned f2bf(float f) { unsigned u = __builtin_bit_cast(unsigned, f); return (u + 0x7fffu + ((u >> 16) & 1u)) >> 16; }
__device__ __forceinline__ unsigned pk2(float lo, float hi) { return f2bf(lo) | (f2bf(hi) << 16); }
__device__ __forceinline__ float bf2f(unsigned h) { return __builtin_bit_cast(float, h << 16); }
__device__ __forceinline__ float bflo(unsigned w) { return __builtin_bit_cast(float, w << 16); }
__device__ __forceinline__ float bfhi(unsigned w) { return __builtin_bit_cast(float, w & 0xffff0000u); }
__device__ __forceinline__ unsigned cvt_pk_bf16(float lo, float hi) { unsigned r; asm volatile("v_cvt_pk_bf16_f32 %0, %1, %2" : "=v"(r) : "v"(lo), "v"(hi)); return r; }
__device__ __forceinline__ unsigned pk4_fp8(float a, float b, float c, float d) { int w = 0; w = __builtin_amdgcn_cvt_pk_fp8_f32(a, b, w, false); w = __builtin_amdgcn_cvt_pk_fp8_f32(c, d, w, true); return (unsigned)w; }
__device__ __forceinline__ float wave_sum(float v) {
#pragma unroll
    for (int o = 1; o < 64; o <<= 1) v += __shfl_xor(v, o);
    return v;
}
__device__ __forceinline__ float silu_f(float x) { return x / (1.f + __expf(-x)); }
__device__ __forceinline__ float sigmoid_f(float x) { return 1.f / (1.f + __expf(-x)); }
__device__ __forceinline__ float logsig_f(float z) { return fminf(z, 0.f) - log1pf(expf(-fabsf(z))); }

#define XB_TMO      128
#define XB_XCNT(j)  (256  + 64 * (j))
#define XB_XSUB(j)  (1280 + 64 * (j))
#define XB_XGEN(j)  (2304 + 64 * (j))
#define XB_TOP      3328
#define XB_TOPGEN   3392
#define XCD_BAR_WORDS 3456
#define XB_SPIN_CAP (1u << 20)
__device__ __forceinline__ unsigned xb_ld(unsigned* p)              { return __hip_atomic_load(p, __ATOMIC_RELAXED, __HIP_MEMORY_SCOPE_AGENT); }
__device__ __forceinline__ unsigned xb_add(unsigned* p, unsigned v) { return __hip_atomic_fetch_add(p, v, __ATOMIC_RELAXED, __HIP_MEMORY_SCOPE_AGENT); }
__device__ __forceinline__ unsigned xb_xcc_id() { return (unsigned)__builtin_amdgcn_s_getreg((3 << 11) | 20) & 0xFu; }
#define XB_SPIN(cond, bar) do { unsigned _sp = 0; while (cond) { __builtin_amdgcn_s_sleep(1); \
    if ((++_sp & 255u) == 0u) { if (xb_ld(&(bar)[XB_TMO])) break; if (_sp > XB_SPIN_CAP) { atomicAdd(&(bar)[XB_TMO], 1u); break; } } } } while (0)
struct XcdBarrier { unsigned* bar; unsigned x; volatile LAS unsigned* st; };
__device__ __forceinline__ XcdBarrier xcd_barrier_post(unsigned* bar, volatile LAS unsigned* st) {
    XcdBarrier b; b.bar = bar; b.x = xb_xcc_id(); b.st = st;
    if (threadIdx.x == 0) (void)xb_add(&bar[XB_XCNT(b.x)], 1u);
    return b;
}
__device__ __forceinline__ void xcd_barrier_complete(unsigned* bar, unsigned x, unsigned& nloc, unsigned& nx) {
    const unsigned G = gridDim.x * gridDim.y * gridDim.z;
    unsigned sum, cnt, mine, sp = 0u;
    for (;;) {
        sum = 0u; cnt = 0u; mine = 0u;
#pragma unroll
        for (unsigned j = 0; j < 16; ++j) { const unsigned c = xb_ld(&bar[XB_XCNT(j)]); sum += c; cnt += (c > 0u) ? 1u : 0u; mine = (j == x) ? c : mine; }
        if (sum == G) break;
        __builtin_amdgcn_s_sleep(1);
        if ((++sp & 255u) == 0u) { if (xb_ld(&bar[XB_TMO])) break; if (sp > XB_SPIN_CAP) { atomicAdd(&bar[XB_TMO], 1u); break; } }
    }
    nloc = mine > 0u ? mine : 1u; nx = cnt > 0u ? cnt : 1u;
}
__device__ __forceinline__ void xcd_barrier(const XcdBarrier& b) {
    asm volatile("s_waitcnt vmcnt(0)" ::: "memory");
    __syncthreads();
    if (threadIdx.x == 0) {
        unsigned* bar = b.bar;
        __builtin_amdgcn_s_waitcnt(0);
        unsigned nloc = b.st[0], nx = b.st[1];
        if (nloc == 0u) { xcd_barrier_complete(bar, b.x, nloc, nx); b.st[0] = nloc; b.st[1] = nx; }
        const unsigned old = xb_add(&bar[XB_XSUB(b.x)], 1u);
        const unsigned gen = old / nloc;
        if (old + 1u == (gen + 1u) * nloc) {
            __builtin_amdgcn_fence(__ATOMIC_RELEASE, "agent");
            asm volatile("s_waitcnt vmcnt(0)" ::: "memory");
            const unsigned og = xb_add(&bar[XB_TOP], 1u);
            const unsigned tg = og / nx;
            if (og + 1u == (tg + 1u) * nx) xb_add(&bar[XB_TOPGEN], 1u);
            else XB_SPIN(xb_ld(&bar[XB_TOPGEN]) == tg, bar);
            __builtin_amdgcn_fence(__ATOMIC_ACQUIRE, "agent");
            xb_add(&bar[XB_XGEN(b.x)], 1u);
            asm volatile("s_waitcnt vmcnt(0)" ::: "memory");
        } else {
            XB_SPIN(xb_ld(&bar[XB_XGEN(b.x)]) == gen, bar);
            __builtin_amdgcn_fence(__ATOMIC_ACQUIRE, "agent");
            asm volatile("s_waitcnt vmcnt(0)" ::: "memory");
        }
    }
    __syncthreads();
}

namespace pg8 {
constexpr int BM = 256, BK = 64, HALF = 128, HTB = HALF * BK * 2, STAGE_BYTES = 8 * HTB;
__device__ __forceinline__ int lds_byte(int r, int c) { const int st = (r >> 4) * 2 + (c >> 5), rr = r & 15, cc = c & 31, ob = rr * 64 + cc * 2; return st * 1024 + (ob ^ (((ob >> 9) & 1) << 5)); }
__device__ __forceinline__ void stage_rc(int b, int& R, int& C) { const int st = b / 1024, sb = b % 1024, swz = sb ^ (((sb >> 9) & 1) << 5); R = (st >> 1) * 16 + swz / 64; C = (st & 1) * 32 + (swz % 64) / 2; }
__device__ __forceinline__ int perm32(int rho) { const int n = rho >> 4, i = rho & 15; return 8 * (i >> 2) + 4 * n + (i & 3); }
struct Unit { int pm, pn, aux, keep; };
typedef int v8i __attribute__((ext_vector_type(8)));
typedef int v4i __attribute__((ext_vector_type(4)));
__device__ __forceinline__ void xcd_tile(int L, int nM, int nN, int& pm, int& pn) {
    const int nwg = nM * nN; int wgid = L;
    { const int q = nwg / 8, r = nwg % 8, xcd = wgid % 8, off = wgid / 8; wgid = (xcd < r ? xcd * (q + 1) : r * (q + 1) + (xcd - r) * q) + off; }
    const int nig = 8 * nN, gid = wgid / nig, fm = gid * 8, gsz = (nM - fm) < 8 ? (nM - fm) : 8;
    pm = fm + ((wgid % nig) % gsz); pn = (wgid % nig) / gsz;
}

template <class Epi, class Sched, bool GATHER, bool FP8 = false>
__device__ __forceinline__ void gemm_phase(LAS unsigned char* lds, const Sched& S, const Epi& E) {
    int tid = threadIdx.x; asm volatile("" : "+v"(tid));
    const int wid = __builtin_amdgcn_readfirstlane(tid >> 6), lane = tid & 63, wr = wid >> 2, wc = wid & 3, fr = lane & 15, fq = lane >> 4;
    const int K = S.K, KB = FP8 ? K : 2 * K, nt = KB / (2 * BK);
    unsigned voffA[2], voffB[2]; int Rs[2], Cb[2];
#pragma unroll
    for (int i = 0; i < 2; ++i) { int R, C; stage_rc(tid * 16 + i * 8192, R, C); const int Rb = Epi::PERM ? ((R & ~31) + perm32(R & 31)) : R;
        Rs[i] = R; Cb[i] = C * 2; voffA[i] = (unsigned)(R * KB + C * 2); voffB[i] = (unsigned)(Rb * KB + C * 2); }
    const size_t kstep = (size_t)(BK * 2);
    const size_t hstep = (size_t)HALF * KB;
    const size_t hstepA = GATHER ? 0 : hstep;
    const unsigned ldsw = (unsigned)wid * 1024u;
    const int aoff = FP8 ? lds_byte(wr * 64 + fr, fq * 16) : lds_byte(wr * 64 + fr, fq * 8), boff = FP8 ? lds_byte(wc * 32 + fr, fq * 16) : lds_byte(wc * 32 + fr, fq * 8);
#define PG8_SA(b, h) (((b) * 2 + (h)) * HTB)
#define PG8_SB(b, h) ((4 + (b) * 2 + (h)) * HTB)
#define PG8_STAGE(bufoff, gbase, voff, W) do { _Pragma("unroll") for (int _i = 0; _i < 2; ++_i) { \
        if constexpr (FP8) __builtin_amdgcn_raw_ptr_buffer_load_lds(rsrc##W, (LAS unsigned*)(lds + (bufoff) + ldsw + _i * 8192), 16, (int)(voff)[_i], (int)(unsigned)((const char*)(gbase) - base##W), 0, 0); \
        else __builtin_amdgcn_global_load_lds((const unsigned*)((const char*)(gbase) + (voff)[_i]), (LAS unsigned*)(lds + (bufoff) + ldsw + _i * 8192), 16, 0, 0); } } while (0)
#define PG8_LDA(dst, b, h) do { _Pragma("unroll") for (int m = 0; m < 4; ++m) { \
        if constexpr (FP8) { const v4i _lo = *(const LAS v4i*)(lds + PG8_SA(b, h) + aoff + m * 2048), _hi = *(const LAS v4i*)(lds + PG8_SA(b, h) + aoff + m * 2048 + 16); dst##8[m] = __builtin_shufflevector(_lo, _hi, 0, 1, 2, 3, 4, 5, 6, 7); } \
        else { _Pragma("unroll") for (int k = 0; k < 2; ++k) dst[m][k] = *(const LAS bf16x8*)(lds + PG8_SA(b, h) + aoff + m * 2048 + k * 1024); } } } while (0)
#define PG8_LDB(dst, b, h) do { _Pragma("unroll") for (int n = 0; n < 2; ++n) { \
        if constexpr (FP8) { const v4i _lo = *(const LAS v4i*)(lds + PG8_SB(b, h) + boff + n * 2048), _hi = *(const LAS v4i*)(lds + PG8_SB(b, h) + boff + n * 2048 + 16); dst##8[n] = __builtin_shufflevector(_lo, _hi, 0, 1, 2, 3, 4, 5, 6, 7); } \
        else { _Pragma("unroll") for (int k = 0; k < 2; ++k) dst[n][k] = *(const LAS bf16x8*)(lds + PG8_SB(b, h) + boff + n * 2048 + k * 1024); } } } while (0)
#define PG8_MMA(ai, bj, At, Bt) do { __builtin_amdgcn_s_setprio(1); \
        if constexpr (FP8) { _Pragma("unroll") for (int m = 0; m < 4; ++m) _Pragma("unroll") for (int n = 0; n < 2; ++n) \
            acc[ai][bj][m][n] = __builtin_amdgcn_mfma_scale_f32_16x16x128_f8f6f4(Bt##8[n], At##8[m], acc[ai][bj][m][n], 0, 0, 0, 0, 0, 0); } \
        else { _Pragma("unroll") for (int m = 0; m < 4; ++m) _Pragma("unroll") for (int n = 0; n < 2; ++n) _Pragma("unroll") for (int k = 0; k < 2; ++k) \
            acc[ai][bj][m][n] = __builtin_amdgcn_mfma_f32_16x16x32_bf16(Bt[n][k], At[m][k], acc[ai][bj][m][n], 0, 0, 0); } \
        __builtin_amdgcn_s_setprio(0); } while (0)
#define PG8_WAIT_V(n) asm volatile("s_waitcnt vmcnt(" #n ")" ::: "memory")
#define PG8_WAIT_L(n) asm volatile("s_waitcnt lgkmcnt(" #n ")" ::: "memory")
#define PG8_BAR __builtin_amdgcn_s_barrier()
#define PG8_SCHED __builtin_amdgcn_sched_barrier(0)
    Unit cur, nxt; int ui = 0;
    if (!S.next(0, cur)) return;
    const char* baseA = S.base_a(); const char* baseB = S.base_b();
    const __amdgpu_buffer_rsrc_t rsrcA = __builtin_amdgcn_make_buffer_rsrc((void*)baseA, 0, 0x7fffffff, 0x00020000), rsrcB = __builtin_amdgcn_make_buffer_rsrc((void*)baseB, 0, 0x7fffffff, 0x00020000);
    f32x4 acc[2][2][4][2];
#pragma unroll
    for (int a = 0; a < 2; ++a)
#pragma unroll
        for (int b = 0; b < 2; ++b)
#pragma unroll
            for (int m = 0; m < 4; ++m)
#pragma unroll
                for (int n = 0; n < 2; ++n) acc[a][b][m][n] = (f32x4){0.f, 0.f, 0.f, 0.f};
    bf16x8 At[4][2], B0[2][2], B1[2][2]; v8i At8[4], B08[2], B18[2];
    const char* cA = S.a_base(cur); const char* cB = S.b_base(cur);
    unsigned cv0[2], cv1[2], nv0[2], nv1[2];
#pragma unroll
    for (int i = 0; i < 2; ++i) {
        if constexpr (GATHER) { cv0[i] = (unsigned)S.a_row(cur, Rs[i]) * (unsigned)KB + (unsigned)Cb[i]; cv1[i] = (unsigned)S.a_row(cur, HALF + Rs[i]) * (unsigned)KB + (unsigned)Cb[i]; }
        else { cv0[i] = voffA[i]; cv1[i] = voffA[i]; }
        nv0[i] = cv0[i]; nv1[i] = cv1[i];
    }
    PG8_STAGE(PG8_SB(0, 0), cB, voffB, B); PG8_STAGE(PG8_SB(0, 1), cB + hstep, voffB, B); PG8_STAGE(PG8_SA(0, 0), cA, cv0, A); PG8_STAGE(PG8_SA(0, 1), cA + hstepA, cv1, A);
    if (wr == 1) PG8_BAR;
    PG8_WAIT_V(2); PG8_BAR;
    PG8_STAGE(PG8_SB(1, 0), cB + kstep, voffB, B); PG8_STAGE(PG8_SA(1, 0), cA + kstep, cv0, A); PG8_STAGE(PG8_SB(1, 1), cB + hstep + kstep, voffB, B);
    PG8_WAIT_V(6); PG8_BAR;
    for (;;) {
        const bool has_next = S.next(ui + 1, nxt);
        const char* nA = has_next ? S.a_base(nxt) : cA; const char* nB = has_next ? S.b_base(nxt) : cB;
        if constexpr (GATHER) {
#pragma unroll
            for (int i = 0; i < 2; ++i) {
                if (has_next) { nv0[i] = (unsigned)S.a_row(nxt, Rs[i]) * (unsigned)KB + (unsigned)Cb[i]; nv1[i] = (unsigned)S.a_row(nxt, HALF + Rs[i]) * (unsigned)KB + (unsigned)Cb[i]; }
                else { nv0[i] = cv0[i]; nv1[i] = cv1[i]; }
            }
        }
        for (int t = 0; t < nt; t += 2) {
            const bool last = (t == nt - 2);
            const char* a1 = cA + (size_t)(t + 1) * kstep;
            const char* a2 = last ? nA : cA + (size_t)(t + 2) * kstep; const char* b2 = last ? nB : cB + (size_t)(t + 2) * kstep;
            const char* a3 = a2 + kstep; const char* b3 = b2 + kstep;
            unsigned s0[2], s1[2];
#pragma unroll
            for (int i = 0; i < 2; ++i) { s0[i] = (GATHER && last) ? nv0[i] : cv0[i]; s1[i] = (GATHER && last) ? nv1[i] : cv1[i]; }
            PG8_LDB(B0, 0, 0); PG8_LDB(B1, 0, 1); PG8_SCHED; PG8_LDA(At, 0, 0); PG8_STAGE(PG8_SA(1, 1), a1 + hstepA, cv1, A);
            PG8_WAIT_V(8); PG8_WAIT_L(0); PG8_BAR; PG8_MMA(0, 0, At, B0); PG8_MMA(0, 1, At, B1); PG8_BAR; PG8_SCHED;
            PG8_LDA(At, 0, 1); PG8_STAGE(PG8_SB(0, 0), b2, voffB, B); PG8_STAGE(PG8_SB(0, 1), b2 + hstep, voffB, B); PG8_STAGE(PG8_SA(0, 0), a2, s0, A);
            PG8_WAIT_V(8); PG8_WAIT_L(0); PG8_BAR; PG8_MMA(1, 0, At, B0); PG8_MMA(1, 1, At, B1); PG8_BAR; PG8_SCHED;
            PG8_LDB(B0, 1, 0); PG8_LDB(B1, 1, 1); PG8_SCHED; PG8_LDA(At, 1, 0); PG8_STAGE(PG8_SA(0, 1), a2 + hstepA, s1, A);
            PG8_WAIT_V(8); PG8_WAIT_L(0); PG8_BAR; PG8_MMA(0, 0, At, B0); PG8_MMA(0, 1, At, B1); PG8_BAR; PG8_SCHED;
            PG8_LDA(At, 1, 1); PG8_STAGE(PG8_SB(1, 0), b3, voffB, B); PG8_STAGE(PG8_SB(1, 1), b3 + hstep, voffB, B); PG8_STAGE(PG8_SA(1, 0), a3, s0, A);
            PG8_WAIT_V(8); PG8_WAIT_L(0); PG8_BAR; PG8_MMA(1, 0, At, B0); PG8_MMA(1, 1, At, B1); PG8_BAR; PG8_SCHED;
        }
        if (wr == 0) PG8_BAR;
        E(acc, cur, wr, wc, fr, fq);
        if (!has_next) break;
        E.post(acc, cur, wr, wc, fr, fq);
        cur = nxt; cA = nA; cB = nB; ++ui;
#pragma unroll
        for (int i = 0; i < 2; ++i) { cv0[i] = nv0[i]; cv1[i] = nv1[i]; }
        if (wr == 1) PG8_BAR;
    }
    PG8_WAIT_V(0);
    PG8_BAR;
#undef PG8_SA
#undef PG8_SB
#undef PG8_STAGE
#undef PG8_LDA
#undef PG8_LDB
#undef PG8_MMA
#undef PG8_WAIT_V
#undef PG8_WAIT_L
#undef PG8_BAR
#undef PG8_SCHED
}
}

using pg8::Unit;
struct SchedDense {
    int G, c, K, nM, nN; const char* A; const char* B; int i0, i1, eb;
    __device__ __forceinline__ bool next(int i, Unit& u) const { const int L = (i + i0) * G + c; if (i + i0 >= i1 || L >= nM * nN) return false; pg8::xcd_tile(L, nM, nN, u.pm, u.pn); u.aux = 0; u.keep = 0; return true; }
    __device__ __forceinline__ const char* a_base(const Unit& u) const { return A + (size_t)u.pm * 256 * K * eb; }
    __device__ __forceinline__ const char* b_base(const Unit& u) const { return B + (size_t)u.pn * 256 * K * eb; }
    __device__ __forceinline__ int a_row(const Unit&, int) const { return 0; }
    __device__ __forceinline__ const char* base_a() const { return A; }
    __device__ __forceinline__ const char* base_b() const { return B; }
};
struct SchedPair {
    int G, c, K; const char *A0, *A1, *B0, *B1;
    __device__ __forceinline__ bool next(int i, Unit& u) const { const int p = (i >> 1) * G + c; if (p >= 256) return false; pg8::xcd_tile(p, 64, 4, u.pm, u.pn); u.aux = i & 1; u.keep = 0; return true; }
    __device__ __forceinline__ const char* a_base(const Unit& u) const { return (u.aux ? A1 : A0) + (size_t)u.pm * 256 * K * 2; }
    __device__ __forceinline__ const char* b_base(const Unit& u) const { return (u.aux ? B1 : B0) + (size_t)u.pn * 256 * K * 2; }
    __device__ __forceinline__ int a_row(const Unit&, int) const { return 0; }
    __device__ __forceinline__ const char* base_a() const { return A0; }
    __device__ __forceinline__ const char* base_b() const { return B0; }
};
struct SchedMoe1 {
    int G, c, K; const char* A; const char* B; int i0, i1;
    __device__ __forceinline__ bool next(int i, Unit& u) const { const int L = (i + i0) * G + c; if (i + i0 >= i1 || L >= 1024) return false;
        const int xcd = L & 7, q = L >> 3, round = q >> 5, slot = q & 31, e = xcd + 8 * (round >> 1), u64 = (round & 1) * 32 + slot, mrow = u64 & 7;
        u.pn = u64 >> 3; u.pm = mrow & 3; u.aux = (mrow >> 2) * 16 + e; u.keep = 0; return true; }
    __device__ __forceinline__ const char* a_base(const Unit& u) const { return A + ((size_t)u.aux * 1024 + (size_t)u.pm * 256) * K; }
    __device__ __forceinline__ const char* b_base(const Unit& u) const { return B + ((size_t)(u.aux & 15) * 2048 + (size_t)u.pn * 256) * K; }
    __device__ __forceinline__ int a_row(const Unit&, int) const { return 0; }
    __device__ __forceinline__ const char* base_a() const { return A; }
    __device__ __forceinline__ const char* base_b() const { return B; }
};
struct SchedMoe2 {
    int G, c, K; const char* A; const char* B;
    __device__ __forceinline__ bool next(int i, Unit& u) const { const int L = i * G + c; if (L >= 512) return false;
        const int xcd = L & 7, q = L >> 3, round = q >> 5, slot = q & 31, e = xcd + 8 * round, mrow = slot & 7;
        u.pn = slot >> 3; u.pm = mrow & 3; u.aux = (mrow >> 2) * 16 + e; u.keep = 0; return true; }
    __device__ __forceinline__ const char* a_base(const Unit& u) const { return A + ((size_t)u.aux * 1024 + (size_t)u.pm * 256) * K; }
    __device__ __forceinline__ const char* b_base(const Unit& u) const { return B + ((size_t)(u.aux & 15) * 1024 + (size_t)u.pn * 256) * K; }
    __device__ __forceinline__ int a_row(const Unit&, int) const { return 0; }
    __device__ __forceinline__ const char* base_a() const { return A; }
    __device__ __forceinline__ const char* base_b() const { return B; }
};

typedef f32x4 AccT[2][2][4][2];
__device__ __forceinline__ size_t gate_off(int pm, int pg, int ai, int m, int bj, int wr, int wc, int fr, int fq) { return ((size_t)(pm * 8 + pg) << 16) + (size_t)((((ai * 4 + m) * 2 + bj) * 8 + wr * 4 + wc) * 512 + (fq * 16 + fr) * 8); }
__device__ __forceinline__ unsigned pk4_u8(float a, float b, float c, float d) { return (unsigned)__builtin_amdgcn_cvt_pk_u8_f32(d, 3, __builtin_amdgcn_cvt_pk_u8_f32(c, 2, __builtin_amdgcn_cvt_pk_u8_f32(b, 1, __builtin_amdgcn_cvt_pk_u8_f32(a, 0, 0u)))); }
template <bool GATES> struct EpiInprojT {
    static constexpr bool PERM = true;
    bf16 *KBp, *VBp, *QBp, *SGp, *PIp; unsigned char* SMp; int pn_off; float sc;
    __device__ __forceinline__ void post(AccT& acc, const Unit&, int, int, int, int) const {
#pragma unroll
        for (int a = 0; a < 2; ++a)
#pragma unroll
            for (int b = 0; b < 2; ++b)
#pragma unroll
                for (int m = 0; m < 4; ++m)
#pragma unroll
                    for (int n = 0; n < 2; ++n) acc[a][b][m][n] = (f32x4){0.f, 0.f, 0.f, 0.f};
    }
    __device__ __forceinline__ void operator()(const AccT& acc, const Unit& u, int wr, int wc, int fr, int fq) const {
        const int pn = u.pn + pn_off;
        if constexpr (GATES) {
            unsigned char* tp = SMp + ((size_t)(u.pm * 8 + pn - 8) << 16) + (unsigned)((wr * 4 + wc) * 512 + (fq * 16 + fr) * 8);
#pragma unroll
            for (int ai = 0; ai < 2; ++ai)
#pragma unroll
                for (int m = 0; m < 4; ++m) {
#pragma unroll
                    for (int bj = 0; bj < 2; ++bj) { const f32x4 v0 = acc[ai][bj][m][0], v1 = acc[ai][bj][m][1];
                        u32x2 w; w.x = pk4_u8(255.f * sigmoid_f(sc * v0[0]), 255.f * sigmoid_f(sc * v0[1]), 255.f * sigmoid_f(sc * v0[2]), 255.f * sigmoid_f(sc * v0[3]));
                        w.y = pk4_u8(255.f * sigmoid_f(sc * v1[0]), 255.f * sigmoid_f(sc * v1[1]), 255.f * sigmoid_f(sc * v1[2]), 255.f * sigmoid_f(sc * v1[3]));
                        *(u32x2*)(tp + (((ai * 4 + m) * 2 + bj) * 4096)) = w; }
                    asm volatile("" ::: "memory"); }
        } else {
        bf16* base; int ld, colt, act;
        if (pn == 0) { base = KBp; ld = 256; colt = 0; act = 0; }
        else if (pn < 3) { base = VBp; ld = 512; colt = (pn - 1) * 256; act = 0; }
        else if (pn == 3) { base = QBp; ld = 256; colt = 0; act = 3; }
        else if (pn < 6) { base = SGp; ld = 512; colt = (pn - 4) * 256; act = 1; }
        else { base = PIp; ld = 512; colt = (pn - 6) * 256; act = 0; }
        const int row0 = u.pm * 256 + wr * 64 + fr, col0 = colt + wc * 32 + 8 * fq;
#pragma unroll
        for (int ai = 0; ai < 2; ++ai)
#pragma unroll
            for (int m = 0; m < 4; ++m) { bf16* rowp = base + (size_t)(row0 + ai * 128 + m * 16) * ld + col0;
#pragma unroll
                for (int bj = 0; bj < 2; ++bj) { f32x4 v0 = acc[ai][bj][m][0], v1 = acc[ai][bj][m][1];
                    if (act == 1) {
#pragma unroll
                        for (int j = 0; j < 4; ++j) { v0[j] = silu_f(v0[j]); v1[j] = silu_f(v1[j]); } }
                    else if (act == 3) { v0 = v0 * 0.125f; v1 = v1 * 0.125f; }
                    u32x4 w; w.x = cvt_pk_bf16(v0[0], v0[1]); w.y = cvt_pk_bf16(v0[2], v0[3]); w.z = cvt_pk_bf16(v1[0], v1[1]); w.w = cvt_pk_bf16(v1[2], v1[3]);
                    *(u32x4*)(rowp + bj * 128) = w; } }
        }
    }
};
typedef EpiInprojT<false> EpiInproj; typedef EpiInprojT<true> EpiGates;
struct EpiMerge {
    static constexpr bool PERM = true;
    const unsigned char* SMp; bf16* MGp;
    __device__ __forceinline__ void post(AccT& acc, const Unit& u, int wr, int wc, int fr, int fq) const {
        const unsigned msk = u.aux ? 0u : 0xffffffffu;
        u32x2 ga[2][2], gb[2][2];
#define EPM_LOADR(buf, g) do { _Pragma("unroll") for (int bj = 0; bj < 2; ++bj) { ga[buf][bj] = *(const u32x2*)(SMp + gate_off(u.pm, u.pn, (g) >> 2, (g) & 3, bj, wr, wc, fr, fq)); \
            gb[buf][bj] = *(const u32x2*)(SMp + gate_off(u.pm, u.pn + 4, (g) >> 2, (g) & 3, bj, wr, wc, fr, fq)); } } while (0)
#define EPM_RATIO(a_, b_, sh) ((float)(((a_) >> (sh)) & 255u) * __builtin_amdgcn_rcpf((float)max(((b_) >> (sh)) & 255u, 1u)))
        EPM_LOADR(0, 0);
#pragma unroll
        for (int g = 0; g < 8; ++g) {
            if (g + 1 < 8) EPM_LOADR((g + 1) & 1, g + 1);
            asm volatile("" ::: "memory");
#pragma unroll
            for (int bj = 0; bj < 2; ++bj) { u32x2 p = ga[g & 1][bj]; const u32x2 q = gb[g & 1][bj]; p.x &= msk; p.y &= msk; f32x4 v0 = acc[g >> 2][bj][g & 3][0], v1 = acc[g >> 2][bj][g & 3][1];
                v0[0] *= EPM_RATIO(p.x, q.x, 0); v0[1] *= EPM_RATIO(p.x, q.x, 8); v0[2] *= EPM_RATIO(p.x, q.x, 16); v0[3] *= EPM_RATIO(p.x, q.x, 24);
                v1[0] *= EPM_RATIO(p.y, q.y, 0); v1[1] *= EPM_RATIO(p.y, q.y, 8); v1[2] *= EPM_RATIO(p.y, q.y, 16); v1[3] *= EPM_RATIO(p.y, q.y, 24);
                acc[g >> 2][bj][g & 3][0] = v0; acc[g >> 2][bj][g & 3][1] = v1; }
            asm volatile("" ::: "memory"); }
#undef EPM_LOADR
#undef EPM_RATIO
    }
    __device__ __forceinline__ void operator()(const AccT& acc, const Unit& u, int wr, int wc, int fr, int fq) const {
        if (!u.aux) return;
        const int row0 = u.pm * 256 + wr * 64 + fr, col0 = u.pn * 256 + wc * 32 + 8 * fq;
        u32x2 gb[2][2];
#define EPM_ROW(g) ((size_t)(row0 + ((g) >> 2) * 128 + ((g) & 3) * 16))
#define EPM_LOAD(buf, g) do { _Pragma("unroll") for (int bj = 0; bj < 2; ++bj) gb[buf][bj] = *(const u32x2*)(SMp + gate_off(u.pm, u.pn + 4, (g) >> 2, (g) & 3, bj, wr, wc, fr, fq)); } while (0)
        EPM_LOAD(0, 0);
#pragma unroll
        for (int g = 0; g < 8; ++g) {
            if (g + 1 < 8) EPM_LOAD((g + 1) & 1, g + 1);
            asm volatile("" ::: "memory");
#pragma unroll
            for (int bj = 0; bj < 2; ++bj) { const u32x2 gq = gb[g & 1][bj]; const f32x4 v0 = acc[g >> 2][bj][g & 3][0], v1 = acc[g >> 2][bj][g & 3][1];
                const float k = 1.f / 255.f;
                const float g0 = k * (float)max(gq.x & 255u, 1u), g1 = k * (float)max((gq.x >> 8) & 255u, 1u), g2 = k * (float)max((gq.x >> 16) & 255u, 1u), g3 = k * (float)max(gq.x >> 24, 1u);
                const float g4 = k * (float)max(gq.y & 255u, 1u), g5 = k * (float)max((gq.y >> 8) & 255u, 1u), g6 = k * (float)max((gq.y >> 16) & 255u, 1u), g7 = k * (float)max(gq.y >> 24, 1u);
                u32x4 w; w.x = cvt_pk_bf16(v0[0] * g0, v0[1] * g1); w.y = cvt_pk_bf16(v0[2] * g2, v0[3] * g3);
                w.z = cvt_pk_bf16(v1[0] * g4, v1[1] * g5); w.w = cvt_pk_bf16(v1[2] * g6, v1[3] * g7);
                *(u32x4*)(MGp + EPM_ROW(g) * 1024 + col0 + bj * 128) = w; }
            asm volatile("" ::: "memory"); }
#undef EPM_ROW
#undef EPM_LOAD
    }
};
struct EpiOut {
    static constexpr bool PERM = true;
    const float* MODp; bf16* YDp;
    __device__ __forceinline__ void post(AccT& acc, const Unit&, int, int, int, int) const {
#pragma unroll
        for (int a = 0; a < 2; ++a)
#pragma unroll
            for (int b = 0; b < 2; ++b)
#pragma unroll
                for (int m = 0; m < 4; ++m)
#pragma unroll
                    for (int n = 0; n < 2; ++n) acc[a][b][m][n] = (f32x4){0.f, 0.f, 0.f, 0.f};
    }
    __device__ __forceinline__ void operator()(const AccT& acc, const Unit& u, int wr, int wc, int fr, int fq) const {
        const int row0 = u.pm * 256 + wr * 64 + fr, col0 = u.pn * 256 + wc * 32 + 8 * fq;
        const float* gt = MODp + (size_t)(u.pm >> 5) * 6144 + 2048 + col0;
        f32x4 gv[2][2];
#pragma unroll
        for (int bj = 0; bj < 2; ++bj)
#pragma unroll
            for (int n = 0; n < 2; ++n) gv[bj][n] = *(const f32x4*)(gt + bj * 128 + n * 4);
#pragma unroll
        for (int ai = 0; ai < 2; ++ai)
#pragma unroll
            for (int m = 0; m < 4; ++m) { bf16* rowp = YDp + (size_t)(row0 + ai * 128 + m * 16) * 1024 + col0;
#pragma unroll
                for (int bj = 0; bj < 2; ++bj) { const f32x4 v0 = acc[ai][bj][m][0] * gv[bj][0], v1 = acc[ai][bj][m][1] * gv[bj][1];
                    u32x4 w; w.x = cvt_pk_bf16(v0[0], v0[1]); w.y = cvt_pk_bf16(v0[2], v0[3]); w.z = cvt_pk_bf16(v1[0], v1[1]); w.w = cvt_pk_bf16(v1[2], v1[3]);
                    *(u32x4*)(rowp + bj * 128) = w; } }
    }
};
struct EpiMoe1 {
    static constexpr bool PERM = true;
    unsigned char* ACTp;
    __device__ __forceinline__ void post(AccT& acc, const Unit&, int, int, int, int) const {
#pragma unroll
        for (int a = 0; a < 2; ++a)
#pragma unroll
            for (int b = 0; b < 2; ++b)
#pragma unroll
                for (int m = 0; m < 4; ++m)
#pragma unroll
                    for (int n = 0; n < 2; ++n) acc[a][b][m][n] = (f32x4){0.f, 0.f, 0.f, 0.f};
    }
    __device__ __forceinline__ void operator()(const AccT& acc, const Unit& u, int wr, int wc, int fr, int fq) const {
        const int row0 = u.aux * 1024 + u.pm * 256 + wr * 64 + fr, col0 = u.pn * 128 + wc * 32 + 8 * fq;
#pragma unroll
        for (int ai = 0; ai < 2; ++ai)
#pragma unroll
            for (int m = 0; m < 4; ++m) { unsigned char* rowp = ACTp + (size_t)(row0 + ai * 128 + m * 16) * 1024 + col0;
                f32x4 a0, a1;
#pragma unroll
                for (int j = 0; j < 4; ++j) { a0[j] = silu_f(0.0625f * acc[ai][0][m][0][j]) * (0.0625f * acc[ai][1][m][0][j]); a1[j] = silu_f(0.0625f * acc[ai][0][m][1][j]) * (0.0625f * acc[ai][1][m][1][j]); }
                *(u32x2*)rowp = (u32x2){pk4_fp8(a0[0], a0[1], a0[2], a0[3]), pk4_fp8(a1[0], a1[1], a1[2], a1[3])}; }
    }
};
struct EpiMoe2 {
    static constexpr bool PERM = true;
    bf16* YBp; const float* WSELp; const float* MODp;
    __device__ __forceinline__ void post(AccT& acc, const Unit&, int, int, int, int) const {
#pragma unroll
        for (int a = 0; a < 2; ++a)
#pragma unroll
            for (int b = 0; b < 2; ++b)
#pragma unroll
                for (int m = 0; m < 4; ++m)
#pragma unroll
                    for (int n = 0; n < 2; ++n) acc[a][b][m][n] = (f32x4){0.f, 0.f, 0.f, 0.f};
    }
    __device__ __forceinline__ void operator()(const AccT& acc, const Unit& u, int wr, int wc, int fr, int fq) const {
        const int row0 = u.aux * 1024 + u.pm * 256 + wr * 64 + fr, col0 = u.pn * 256 + wc * 32 + 8 * fq;
        const float* gt = MODp + (size_t)(u.aux >> 4) * 6144 + 5120 + col0;
        f32x4 gv[2][2];
#pragma unroll
        for (int bj = 0; bj < 2; ++bj)
#pragma unroll
            for (int n = 0; n < 2; ++n) gv[bj][n] = *(const f32x4*)(gt + bj * 128 + n * 4);
#pragma unroll
        for (int ai = 0; ai < 2; ++ai)
#pragma unroll
            for (int m = 0; m < 4; ++m) { const int r = row0 + ai * 128 + m * 16; const float ws = 0.0625f * WSELp[r]; bf16* rowp = YBp + (size_t)r * 1024 + col0;
#pragma unroll
                for (int bj = 0; bj < 2; ++bj) { const f32x4 v0 = acc[ai][bj][m][0] * gv[bj][0] * ws, v1 = acc[ai][bj][m][1] * gv[bj][1] * ws;
                    u32x4 w; w.x = cvt_pk_bf16(v0[0], v0[1]); w.y = cvt_pk_bf16(v0[2], v0[3]); w.z = cvt_pk_bf16(v1[0], v1[1]); w.w = cvt_pk_bf16(v1[2], v1[3]);
                    *(u32x4*)(rowp + bj * 128) = w; } }
    }
};

struct Args { const float* in[22]; float* out; unsigned char* ws; int ph_lo, ph_hi; };
enum { I_X = 0, I_C, I_CTX, I_CCTX, I_ADAW, I_ADAB, I_N1G, I_N2G, I_WIN, I_WDU, I_BDEC, I_GNG, I_WGLA, I_POOLW, I_POOLS, I_WPOOL, I_WOUT, I_WROUTER, I_WGATE, I_WUP, I_WDOWN, I_FNG };

__device__ __forceinline__ bf16x8 ldfrag(const LAS bf16* base, int stride, int row0, int k0, int lane) { return *(const LAS bf16x8*)(base + (row0 + (lane & 15)) * stride + k0 + 8 * (lane >> 4)); }
#define MFMA16(a, b, c) __builtin_amdgcn_mfma_f32_16x16x32_bf16(a, b, c, 0, 0, 0)

__device__ __forceinline__ void transpose_item(const float* W, int ldw, int k0, int nsrc0, bf16* WT, int Kd, int dst_row0, LAS float* scr, int lane) {
#pragma unroll 8
    for (int i = 0; i < 32; ++i) { const int kk = 2 * i + (lane >> 5); scr[kk * 33 + (lane & 31)] = W[(size_t)(k0 + kk) * ldw + nsrc0 + (lane & 31)]; }
    LDS_WAIT(); asm volatile("" ::: "memory");
    const int c = lane & 7;
#pragma unroll
    for (int j = 0; j < 4; ++j) { const int n = (lane >> 3) + 8 * j; const LAS float* s = scr + (8 * c) * 33 + n;
        u32x4 o; o.x = pk2(s[0 * 33], s[1 * 33]); o.y = pk2(s[2 * 33], s[3 * 33]); o.z = pk2(s[4 * 33], s[5 * 33]); o.w = pk2(s[6 * 33], s[7 * 33]);
        *(u32x4*)(WT + (size_t)(dst_row0 + n) * Kd + k0 + 8 * c) = o; }
    LDS_WAIT(); asm volatile("" ::: "memory");
}

struct CvtItem { const float* src; bf16* dst; int ld2, drow8, f8; };
#define CVT_LOAD(v, c) do { _Pragma("unroll") for (int _j = 0; _j < 32; ++_j) v[_j] = __builtin_nontemporal_load((c).src + (size_t)_j * (c).ld2); } while (0)
#define CVT_STORE(v, c) do { _Pragma("unroll") for (int _j = 0; _j < 32; ++_j) scr[(2 * _j + (lane >> 5)) * 33 + (lane & 31)] = v[_j]; \
        LDS_WAIT(); asm volatile("" ::: "memory"); \
        _Pragma("unroll") for (int _q = 0; _q < 4; ++_q) { const LAS float* _s = scr + (8 * (lane & 7)) * 33 + (lane >> 3) + 8 * _q; u32x4 _o; \
            _o.x = pk2(_s[0 * 33], _s[1 * 33]); _o.y = pk2(_s[2 * 33], _s[3 * 33]); _o.z = pk2(_s[4 * 33], _s[5 * 33]); _o.w = pk2(_s[6 * 33], _s[7 * 33]); *(u32x4*)((c).dst + (size_t)_q * (c).drow8) = _o; } \
        LDS_WAIT(); asm volatile("" ::: "memory"); } while (0)
__device__ __forceinline__ CvtItem cvt_item_gu(const Args& a, int it, int lane) {
    const int e = it >> 10, mat = (it >> 9) & 1, q = it & 511, kb = q >> 5, nb = q & 31, n0 = nb * 32, k0 = kb * 64, nrow = n0 + (lane >> 3);
    CvtItem c; c.ld2 = 2048; c.drow8 = 8192; c.f8 = 1;
    c.src = a.in[mat ? I_WUP : I_WGATE] + (size_t)e * 1048576 + (size_t)(k0 + (lane >> 5)) * 1024 + n0 + (lane & 31);
    c.dst = (bf16*)(a.ws + WS_WGU + ((size_t)e * 2048 + (nrow >> 7) * 256 + mat * 128 + (nrow & 127)) * 1024 + k0 + 8 * (lane & 7));
    return c;
}
__device__ __forceinline__ CvtItem cvt_item_dn(const Args& a, int it, int lane) {
    const int e = it >> 9, q = it & 511, kb = q >> 5, nb = q & 31, n0 = nb * 32, k0 = kb * 64;
    CvtItem c; c.ld2 = 2048; c.drow8 = 8192; c.f8 = 1;
    c.src = a.in[I_WDOWN] + (size_t)e * 1048576 + (size_t)(k0 + (lane >> 5)) * 1024 + n0 + (lane & 31);
    c.dst = (bf16*)(a.ws + WS_WD + ((size_t)e * 1024 + n0 + (lane >> 3)) * 1024 + k0 + 8 * (lane & 7));
    return c;
}
#define CVT_STORE8(v, c) do { _Pragma("unroll") for (int _j = 0; _j < 32; ++_j) scr[(2 * _j + (lane >> 5)) * 33 + (lane & 31)] = v[_j]; \
        LDS_WAIT(); asm volatile("" ::: "memory"); \
        _Pragma("unroll") for (int _q = 0; _q < 4; ++_q) { const LAS float* _s = scr + (8 * (lane & 7)) * 33 + (lane >> 3) + 8 * _q; \
            *(u32x2*)((unsigned char*)(c).dst + (size_t)_q * (c).drow8) = (u32x2){pk4_fp8(16.f * _s[0 * 33], 16.f * _s[1 * 33], 16.f * _s[2 * 33], 16.f * _s[3 * 33]), pk4_fp8(16.f * _s[4 * 33], 16.f * _s[5 * 33], 16.f * _s[6 * 33], 16.f * _s[7 * 33])}; } \
        LDS_WAIT(); asm volatile("" ::: "memory"); } while (0)
__device__ __forceinline__ CvtItem cvt_item_small(const Args& a, int it, int lane) {
    CvtItem c; int r = it;
    c.f8 = 0;
    if (r < 2048) { const int kb = r >> 7, nb = r & 127, n0 = nb * 32, k0 = kb * 64; c.ld2 = 2 * DIN; c.drow8 = 8192;
        c.src = a.in[I_WIN] + (size_t)(k0 + (lane >> 5)) * DIN + n0 + (n0 >= 768 ? 32 : 0) + (lane & 31);
        if (n0 < 2048) c.dst = (bf16*)(a.ws + WS_WIN) + (size_t)(n0 + (lane >> 3)) * 1024 + k0 + 8 * (lane & 7);
        else { c.f8 = 1; c.dst = (bf16*)(a.ws + WS_WINM + (size_t)(n0 - 2048 + (lane >> 3)) * 1024 + k0 + 8 * (lane & 7)); }
        return c; }
    r -= 2048;
    if (r < 512) { const int kb = r >> 5, nb = r & 31, n0 = nb * 32, k0 = kb * 64; c.ld2 = 2048; c.drow8 = 8192;
        c.src = a.in[I_WOUT] + (size_t)(k0 + (lane >> 5)) * 1024 + n0 + (lane & 31); c.dst = (bf16*)(a.ws + WS_WO) + (size_t)(n0 + (lane >> 3)) * 1024 + k0 + 8 * (lane & 7); return c; }
    r -= 512;
    { const int kb = r >> 5, nb = r & 31, n0 = nb * 32, k0 = kb * 64; c.ld2 = 2048; c.drow8 = 4096;
      c.src = a.in[I_WGLA] + (size_t)(k0 + (lane >> 5)) * 1024 + n0 + (lane & 31); c.dst = (bf16*)(a.ws + WS_WG) + (size_t)(n0 + (lane >> 3)) * 512 + k0 + 8 * (lane & 7); return c; }
}
template <int KIND> __device__ __forceinline__ CvtItem cvt_item(const Args& a, int it, int lane) { if constexpr (KIND == 0) return cvt_item_small(a, it, lane); else if constexpr (KIND == 1) return cvt_item_gu(a, it, lane); else return cvt_item_dn(a, it, lane); }
template <int KIND>
__device__ __forceinline__ void convert_items(LAS float* scr, const Args& a, int first, int step, int end, int lane) {
    float va[32], vb[32]; CvtItem ca, cb;
    int it = first;
    if (it < end) { ca = cvt_item<KIND>(a, it, lane); CVT_LOAD(va, ca); }
    for (; it < end; it += 2 * step) {
        const bool hb = (it + step < end), ha = (it + 2 * step < end);
        if (hb) { cb = cvt_item<KIND>(a, it + step, lane); CVT_LOAD(vb, cb); }
        if (KIND == 0 && !ca.f8) CVT_STORE(va, ca); else CVT_STORE8(va, ca);
        if (ha) { ca = cvt_item<KIND>(a, it + 2 * step, lane); CVT_LOAD(va, ca); }
        if (hb) { if (KIND == 0 && !cb.f8) CVT_STORE(vb, cb); else CVT_STORE8(vb, cb); }
    }
}
template <int KIND>
__device__ __forceinline__ void convert_all(LAS unsigned char* lds, const Args& a, int vcu, int G, int lane, int wave) {
    const int gw = vcu * NWAVES + wave, NGW = G * NWAVES;
    convert_items<KIND>((LAS float*)(lds + wave * 8448), a, gw, NGW, KIND == 1 ? 16384 : 8192, lane);
    __syncthreads();
}

__device__ __forceinline__ void phase0(LAS unsigned char* lds, const Args& a, int vcu, int G, int tid, int lane, int wave) {
    unsigned char* ws = a.ws;
    if (vcu < 96) {
        LAS float* sv = (LAS float*)(lds + 69632); LAS float* part = sv + 3072;
        for (int idx = tid; idx < 3072; idx += NT) { const int v = idx >> 10, k = idx & 1023; const float s = (v < 2) ? a.in[I_C][v * 1024 + k] : a.in[I_CCTX][k]; sv[idx] = s / (1.f + expf(-s)); }
        __syncthreads();
        const int n0 = 64 * vcu, colq = lane & 15, kr = lane >> 4;
        f32x4 a0 = {0.f, 0.f, 0.f, 0.f}, a1 = a0, a2 = a0;
        const float* aw = a.in[I_ADAW] + (size_t)(128 * wave + kr) * 6144 + n0 + 4 * colq;
#pragma unroll
        for (int hb = 0; hb < 2; ++hb) { f32x4 w4[16];
#pragma unroll
            for (int it = 0; it < 16; ++it) w4[it] = __builtin_nontemporal_load((const f32x4*)(aw + (size_t)(4 * (16 * hb + it)) * 6144));
#pragma unroll
            for (int it = 0; it < 16; ++it) { const int k = 128 * wave + 4 * (16 * hb + it) + kr; a0 += w4[it] * sv[k]; a1 += w4[it] * sv[1024 + k]; a2 += w4[it] * sv[2048 + k]; } }
#pragma unroll
        for (int j = 0; j < 4; ++j) { a0[j] += __shfl_xor(a0[j], 16); a0[j] += __shfl_xor(a0[j], 32); a1[j] += __shfl_xor(a1[j], 16); a1[j] += __shfl_xor(a1[j], 32); a2[j] += __shfl_xor(a2[j], 16); a2[j] += __shfl_xor(a2[j], 32); }
        if (kr == 0) {
#pragma unroll
            for (int j = 0; j < 4; ++j) { part[(wave * 3 + 0) * 64 + 4 * colq + j] = a0[j]; part[(wave * 3 + 1) * 64 + 4 * colq + j] = a1[j]; part[(wave * 3 + 2) * 64 + 4 * colq + j] = a2[j]; } }
        __syncthreads();
        if (tid < 192) { const int v = tid >> 6, col = tid & 63; float s = a.in[I_ADAB][n0 + col];
#pragma unroll
            for (int w = 0; w < 8; ++w) s += part[(w * 3 + v) * 64 + col];
            ((float*)(ws + WS_MOD))[v * 6144 + n0 + col] = s; }
    } else if (vcu < 96 + 128) {
        const int it = vcu - 96, g = it >> 5, cb = (it >> 1) & 15, nb = it & 1, n = nb * 512 + tid;
        LAS float* pwt = (LAS float*)(lds + 69632);
        if (tid < 256) { const int d = tid >> 1, hf = tid & 1; const float sc = a.in[I_POOLS][g * 128 + d]; f32x4 v;
#pragma unroll
            for (int q = 0; q < 4; ++q) v[q] = a.in[I_POOLW][(size_t)(g * 128 + cb * 8 + hf * 4 + q) * 128 + d] * sc;
            *(LAS f32x4*)(pwt + d * 8 + hf * 4) = v; }
        __syncthreads();
        const float* wp = a.in[I_WPOOL] + (size_t)(g * 128) * 1024 + n;
        f32x4 acc0 = {0.f, 0.f, 0.f, 0.f}, acc1 = acc0;
        for (int d0 = 0; d0 < 128; d0 += 32) { float w[32];
#pragma unroll
            for (int d = 0; d < 32; ++d) w[d] = wp[(size_t)(d0 + d) * 1024];
#pragma unroll
            for (int d = 0; d < 32; ++d) { const f32x4 p0 = *(const LAS f32x4*)(pwt + (d0 + d) * 8), p1 = *(const LAS f32x4*)(pwt + (d0 + d) * 8 + 4); acc0 += p0 * w[d]; acc1 += p1 * w[d]; } }
        bf16* dst = (bf16*)(ws + WS_WC) + (size_t)n * 512 + g * 128 + cb * 8;
        *(u32x4*)dst = (u32x4){pk2(acc0[0], acc0[1]), pk2(acc0[2], acc0[3]), pk2(acc1[0], acc1[1]), pk2(acc1[2], acc1[3])};
    }
    { const int gw = vcu * NWAVES + wave, NGW = G * NWAVES; convert_items<0>((LAS float*)(lds + wave * 8448), a, gw, NGW, 2048 + 512 + 256, lane); }
}

#define RSTEP(N, S) do { _Pragma("unroll") for (int _i = 0; _i < (N) / 2; ++_i) { const float _send = (lane & (S)) ? racc[_i] : racc[_i + (N) / 2]; const float _keep = (lane & (S)) ? racc[_i + (N) / 2] : racc[_i]; racc[_i] = _keep + __shfl_xor(_send, (S)); } } while (0)
__device__ __forceinline__ void phase1(LAS unsigned char* lds, const Args& a, int vcu, int G, int tid, int lane, int wave) {
    unsigned char* ws = a.ws;
    const float* MOD = (const float*)(ws + WS_MOD);
    const float* g1 = a.in[I_N1G];
    for (int u = vcu; u < 96; u += G) {
        const int mt = u / 12, ntile = u % 12, r0 = mt * 64;
        LAS bf16* As = (LAS bf16*)lds; LAS bf16* Bs = As + 64 * 72; LAS float* rs = (LAS float*)(lds + 18432);
        const float* ctx = a.in[I_CTX];
        { f32x4 rv[8][4];
#pragma unroll
          for (int rr = 0; rr < 8; ++rr)
#pragma unroll
              for (int j = 0; j < 4; ++j) rv[rr][j] = *(const f32x4*)(ctx + (size_t)(r0 + 8 * wave + rr) * 1024 + 256 * j + 4 * lane);
#pragma unroll
          for (int rr = 0; rr < 8; ++rr) { float ss = 0.f;
#pragma unroll
              for (int j = 0; j < 4; ++j) ss += rv[rr][j][0] * rv[rr][j][0] + rv[rr][j][1] * rv[rr][j][1] + rv[rr][j][2] * rv[rr][j][2] + rv[rr][j][3] * rv[rr][j][3];
              ss = wave_sum(ss); if (lane == 0) rs[8 * wave + rr] = rsqrtf(ss * (1.f / 1024.f) + EPS); } }
        __syncthreads();
        f32x4 acc[2] = {{0.f, 0.f, 0.f, 0.f}, {0.f, 0.f, 0.f, 0.f}};
        const int m16 = wave & 3, nh = wave >> 2, srow = tid >> 3, kq = (tid & 7) * 8;
        const float rstd = rs[srow];
        const float* xp = ctx + (size_t)(r0 + srow) * 1024 + kq; const bf16* wpB = (const bf16*)(ws + WS_WIN) + (size_t)(ntile * 64 + srow) * 1024 + kq;
        f32x4 xv[2], gq[2], scq[2], shq[2]; u32x4 wB;
#define CTX_LOAD(kc) do { const int _k0 = (kc) * 64; _Pragma("unroll") for (int q = 0; q < 2; ++q) { xv[q] = *(const f32x4*)(xp + _k0 + 4 * q); gq[q] = *(const f32x4*)(g1 + _k0 + kq + 4 * q); \
            scq[q] = *(const f32x4*)(MOD + 2 * 6144 + 1024 + _k0 + kq + 4 * q); shq[q] = *(const f32x4*)(MOD + 2 * 6144 + _k0 + kq + 4 * q); } wB = *(const u32x4*)(wpB + _k0); } while (0)
        CTX_LOAD(0);
        for (int kc = 0; kc < 16; ++kc) {
            { unsigned o[4];
#pragma unroll
              for (int q = 0; q < 2; ++q) { const f32x4 h = xv[q] * rstd * gq[q] * (scq[q] + 1.f) + shq[q]; o[2 * q] = pk2(h[0], h[1]); o[2 * q + 1] = pk2(h[2], h[3]); }
              *(LAS u32x4*)(As + srow * 72 + kq) = (u32x4){o[0], o[1], o[2], o[3]};
              *(LAS u32x4*)(Bs + srow * 72 + kq) = wB; }
            __syncthreads();
            if (kc + 1 < 16) CTX_LOAD(kc + 1);
#pragma unroll
            for (int ks = 0; ks < 2; ++ks) { const bf16x8 af = ldfrag(As, 72, m16 * 16, ks * 32, lane);
#pragma unroll
                for (int tt = 0; tt < 2; ++tt) { const bf16x8 bfr = ldfrag(Bs, 72, nh * 32 + tt * 16, ks * 32, lane); acc[tt] = MFMA16(af, bfr, acc[tt]); } }
            __syncthreads();
        }
#undef CTX_LOAD
#pragma unroll
        for (int tt = 0; tt < 2; ++tt)
#pragma unroll
            for (int r = 0; r < 4; ++r) { const int row = M + r0 + m16 * 16 + 4 * (lane >> 4) + r, n = ntile * 64 + nh * 32 + tt * 16 + (lane & 15); const bf16 v = (bf16)f2bf(acc[tt][r]);
                if (n < 256) ((bf16*)(ws + WS_KB))[(size_t)row * 256 + n] = v; else ((bf16*)(ws + WS_VB))[(size_t)row * 512 + n - 256] = v; }
        __syncthreads();
    }
    LAS float* WR = (LAS float*)lds;
#pragma unroll 4
    for (int it = 0; it < 16; ++it) { const int k = (tid >> 3) + 64 * it, c4 = tid & 7; const f32x4 v = *(const f32x4*)(a.in[I_WIN] + (size_t)k * DIN + 768 + 4 * c4);
        const int row = ((k >> 8) * 4 + (k & 3)) * 64 + ((k & 255) >> 2); *(LAS f32x4*)(WR + row * 36 + 4 * c4) = v; }
    __syncthreads();
    f32x4 gv[4];
#pragma unroll
    for (int j = 0; j < 4; ++j) gv[j] = *(const f32x4*)(g1 + 256 * j + 4 * lane);
    constexpr int NPAIR = MT / 2;
    const int nctx = (G > 96) ? 96 : 0, PA = 3;
    int p_lo, p_n, p_stride;
    if (vcu < nctx) { p_lo = (vcu * NWAVES + wave) * PA; p_n = PA; p_stride = 1; }
    else { p_lo = nctx * NWAVES * PA + (vcu - nctx) * NWAVES + wave; p_n = 1 << 30; p_stride = (G - nctx) * NWAVES; }
    f32x4 nx[2][4];
    if (p_n > 0 && p_lo < NPAIR) {
#pragma unroll
        for (int r = 0; r < 2; ++r) { const int m = 2 * p_lo + r; const float* src = (m < M) ? a.in[I_X] + (size_t)m * 1024 : a.in[I_CTX] + (size_t)(m - M) * 1024;
#pragma unroll
            for (int j = 0; j < 4; ++j) nx[r][j] = *(const f32x4*)(src + 256 * j + 4 * lane); } }
    for (int pi = 0, pr = p_lo; pi < p_n && pr < NPAIR; ++pi, pr += p_stride) {
        const int m0 = 2 * pr;
        f32x4 v[2][4]; float rstd[2];
#pragma unroll
        for (int r = 0; r < 2; ++r) { float ss = 0.f;
#pragma unroll
            for (int j = 0; j < 4; ++j) { v[r][j] = nx[r][j]; ss += v[r][j][0] * v[r][j][0] + v[r][j][1] * v[r][j][1] + v[r][j][2] * v[r][j][2] + v[r][j][3] * v[r][j][3]; }
            rstd[r] = ss; }
        if (pi + 1 < p_n && pr + p_stride < NPAIR) {
#pragma unroll
            for (int r = 0; r < 2; ++r) { const int m = 2 * (pr + p_stride) + r; const float* src = (m < M) ? a.in[I_X] + (size_t)m * 1024 : a.in[I_CTX] + (size_t)(m - M) * 1024;
#pragma unroll
                for (int j = 0; j < 4; ++j) nx[r][j] = *(const f32x4*)(src + 256 * j + 4 * lane); } }
#pragma unroll
        for (int r = 0; r < 2; ++r) { const int m = m0 + r; rstd[r] = rsqrtf(wave_sum(rstd[r]) * (1.f / 1024.f) + EPS); const float* mod = MOD + (size_t)((m < M) ? (m >> 13) : 2) * 6144;
#pragma unroll
            for (int j = 0; j < 4; ++j) { const f32x4 sc = *(const f32x4*)(mod + 1024 + 256 * j + 4 * lane), sh = *(const f32x4*)(mod + 256 * j + 4 * lane); v[r][j] = v[r][j] * rstd[r] * gv[j] * (sc + 1.f) + sh; }
            if (m < M) { bf16* hp = (bf16*)(ws + WS_H1) + (size_t)m * 1024;
#pragma unroll
                for (int j = 0; j < 4; ++j) { *(u32x2*)(hp + 256 * j + 4 * lane) = (u32x2){pk2(v[r][j][0], v[r][j][1]), pk2(v[r][j][2], v[r][j][3])};
                    *(unsigned*)(ws + WS_H1F + (size_t)m * 1024 + 256 * j + 4 * lane) = pk4_fp8(v[r][j][0], v[r][j][1], v[r][j][2], v[r][j][3]); } } }
        f32x2 r2[32];
#pragma unroll
        for (int i = 0; i < 32; ++i) r2[i] = (f32x2){0.f, 0.f};
#pragma unroll
        for (int j = 0; j < 4; ++j)
#pragma unroll
            for (int i = 0; i < 4; ++i) { const f32x2 hab = {v[0][j][i], v[1][j][i]}; const LAS float* rp = WR + ((j * 4 + i) * 64 + lane) * 36;
#pragma unroll
                for (int c4 = 0; c4 < 8; ++c4) { const f32x4 w = *(const LAS f32x4*)(rp + 4 * c4);
                    r2[4 * c4 + 0] += hab * w[0]; r2[4 * c4 + 1] += hab * w[1]; r2[4 * c4 + 2] += hab * w[2]; r2[4 * c4 + 3] += hab * w[3]; }
                if (i & 1) asm volatile("" ::: "memory"); }
        float ra[32], rb[32];
#pragma unroll
        for (int i = 0; i < 32; ++i) { ra[i] = r2[i][0]; rb[i] = r2[i][1]; }
        { float* racc = ra; RSTEP(32, 32); RSTEP(16, 16); RSTEP(8, 8); RSTEP(4, 4); RSTEP(2, 2); racc[0] += __shfl_xor(racc[0], 1); }
        { float* racc = rb; RSTEP(32, 32); RSTEP(16, 16); RSTEP(8, 8); RSTEP(4, 4); RSTEP(2, 2); racc[0] += __shfl_xor(racc[0], 1); }
        if ((lane & 1) == 0) { ((float*)(ws + WS_RB))[(size_t)m0 * 32 + (lane >> 1)] = ra[0]; ((float*)(ws + WS_RB))[(size_t)(m0 + 1) * 32 + (lane >> 1)] = rb[0]; }
    }
}

typedef short s16x4 __attribute__((ext_vector_type(4)));
__device__ __forceinline__ s16x4 lds_tr16(const LAS bf16* p) { return __builtin_bit_cast(s16x4, __builtin_amdgcn_ds_read_tr16_b64_v4i16((LAS s16x4*)p)); }
__device__ __forceinline__ bf16x8 ldfrag_tr(const LAS bf16* base, int stride, int k0, int n0, int lane) {
    const int g = lane >> 4, i = lane & 15; const LAS bf16* p = base + (k0 + 8 * g + (i >> 2)) * stride + n0 + 4 * (i & 3);
    const s16x4 lo = lds_tr16(p), hi = lds_tr16(p + 4 * stride);
    return (bf16x8){lo[0], lo[1], lo[2], lo[3], hi[0], hi[1], hi[2], hi[3]};
}
__device__ __forceinline__ float logsig_fast(float z) { return fminf(z, 0.f) - __logf(1.f + __expf(-fabsf(z))); }
struct ChkPre { f32x4 r, w; float bias_f, bias_b; float kf[8]; u32x4 v[2]; };
__device__ __forceinline__ void chunk_decode(int u, int& b, int& h, int& row0, int& slot, bool& isx) {
    if (u < 1024) { b = u >> 9; h = (u >> 7) & 3; const int n = u & 127; row0 = b * SEQ + n * 64; slot = n; isx = true; }
    else { const int v = u - 1024; b = v >> 4; h = (v >> 2) & 3; const int n = v & 3; row0 = M + b * LC + n * 64; slot = NCH + n; isx = false; }
}
__device__ __forceinline__ void chunk_load(ChkPre& P, const Args& a, int u, int tid) {
    unsigned char* ws = a.ws; int b, h, row0, slot; bool isx; chunk_decode(u, b, h, row0, slot, isx);
    P.r = *(const f32x4*)((const float*)(ws + WS_RB) + (size_t)(row0 + (tid >> 3)) * 32 + (tid & 7) * 4);
    P.w = *(const f32x4*)(a.in[I_WDU] + (size_t)(tid >> 4) * 256 + h * 64 + (tid & 15) * 4);
    const int dk = tid & 63, tq = tid >> 6;
    P.bias_f = a.in[I_BDEC][h * 64 + dk]; P.bias_b = a.in[I_BDEC][256 + h * 64 + dk];
    const bf16* KBp = (const bf16*)(ws + WS_KB) + (size_t)(row0 + tq * 8) * 256 + h * 64 + dk;
#pragma unroll
    for (int tt = 0; tt < 8; ++tt) P.kf[tt] = bf2f(KBp[(size_t)tt * 256]);
#pragma unroll
    for (int i = 0; i < 2; ++i) { const int p = tid + NT * i, jj = p >> 4, ch = p & 15; P.v[i] = *(const u32x4*)((const bf16*)(ws + WS_VB) + (size_t)(row0 + jj) * 512 + h * 128 + 8 * ch); }
}
__device__ __forceinline__ void chunk_units(LAS unsigned char* lds, const Args& a, int vcu, int G, int tid, int lane, int wave) {
    unsigned char* ws = a.ws;
    LAS float* r_s = (LAS float*)lds;
    LAS float* wup = (LAS float*)(lds + 8192);
    LAS float* seg = (LAS float*)(lds + 16384);
    LAS bf16* Ks = (LAS bf16*)(lds + 20480);
    LAS bf16* Vs = (LAS bf16*)(lds + 38912);
    const int dk = tid & 63, tq = tid >> 6;
    ChkPre P;
    unsigned* qctr = (unsigned*)(ws + WS_CTL) + 512; LAS int* qnext = (LAS int*)(lds + 57344);
    int u = vcu;
    if (u < 1024 + 32) chunk_load(P, a, u, tid);
    for (; u < 1024 + 32; ) {
        int b, h, row0, slot; bool isx; chunk_decode(u, b, h, row0, slot, isx);
        const int bh = b * 4 + h;
        if (tid == 0) qnext[0] = G + (int)__hip_atomic_fetch_add(qctr, 1u, __ATOMIC_RELAXED, __HIP_MEMORY_SCOPE_AGENT);
        *(LAS f32x4*)(r_s + tid * 4) = P.r; *(LAS f32x4*)(wup + (tid >> 4) * 64 + (tid & 15) * 4) = P.w;
#pragma unroll
        for (int i = 0; i < 2; ++i) { const int p = tid + NT * i, jj = p >> 4, ch = p & 15; *(LAS u32x4*)(Vs + jj * 136 + 8 * ch) = P.v[i]; }
        float kf[8];
#pragma unroll
        for (int tt = 0; tt < 8; ++tt) kf[tt] = P.kf[tt];
        const float bias_f = P.bias_f, bias_b = P.bias_b;
        __syncthreads();
        const int un = qnext[0];
        if (un < 1024 + 32) chunk_load(P, a, un, tid);
        float pf[8], sb[8];
        { float wf[16], wb[16];
#pragma unroll
          for (int j = 0; j < 16; ++j) { wf[j] = wup[j * 64 + dk]; wb[j] = wup[(16 + j) * 64 + dk]; }
#pragma unroll
          for (int tt = 0; tt < 8; ++tt) { const LAS float* rp = r_s + (tq * 8 + tt) * 32; float zf = bias_f, zb = bias_b;
#pragma unroll
              for (int j4 = 0; j4 < 4; ++j4) { const f32x4 rf = *(const LAS f32x4*)(rp + 4 * j4), rb = *(const LAS f32x4*)(rp + 16 + 4 * j4);
#pragma unroll
                  for (int e = 0; e < 4; ++e) { zf += rf[e] * wf[4 * j4 + e]; zb += rb[e] * wb[4 * j4 + e]; } }
              pf[tt] = logsig_fast(zf) * (1.f / 16.f); sb[tt] = logsig_fast(zb) * (1.f / 16.f); }
#pragma unroll
          for (int tt = 1; tt < 8; ++tt) pf[tt] += pf[tt - 1];
#pragma unroll
          for (int tt = 6; tt >= 0; --tt) sb[tt] += sb[tt + 1];
          seg[tq * 64 + dk] = pf[7]; seg[(8 + tq) * 64 + dk] = sb[0]; }
        __syncthreads();
        { float offf = 0.f, totf = 0.f, offb = 0.f, totb = 0.f;
#pragma unroll
          for (int q = 0; q < 8; ++q) { const float sf = seg[q * 64 + dk], sbv = seg[(8 + q) * 64 + dk]; totf += sf; totb += sbv; if (q < tq) offf += sf; if (q > tq) offb += sbv; }
#pragma unroll
          for (int tt = 0; tt < 8; ++tt) { const int t = tq * 8 + tt; const float bb = pf[tt] + offf, cc = sb[tt] + offb;
              if (isx) { const size_t gi = (size_t)(row0 + t) * 256 + h * 64 + dk; a.out[gi] = bb; a.out[(size_t)M * 256 + gi] = cc; }
              Ks[t * 72 + dk] = (bf16)f2bf(kf[tt] * __expf(totf - bb)); Ks[(64 + t) * 72 + dk] = (bf16)f2bf(kf[tt] * __expf(totb - cc)); }
          if (tq == 0) { float* DEC = (float*)(ws + WS_DEC); DEC[((size_t)(0 * 8 + bh) * NSLOT + slot) * 64 + dk] = __expf(totf); DEC[((size_t)(1 * 8 + bh) * NSLOT + slot) * 64 + dk] = __expf(totb); } }
        __syncthreads();
        { const int dir = wave >> 2, dkt = wave & 3; const LAS bf16* Kd = Ks + dir * 64 * 72;
          const bf16x8 k0f = ldfrag_tr(Kd, 72, 0, dkt * 16, lane), k1f = ldfrag_tr(Kd, 72, 32, dkt * 16, lane);
          bf16* KV = (bf16*)(ws + WS_KV) + ((size_t)(dir * 8 + bh) * NSLOT + slot) * 8192;
#pragma unroll
          for (int dvt = 0; dvt < 8; ++dvt) { f32x4 c = {0.f, 0.f, 0.f, 0.f}; c = MFMA16(k0f, ldfrag_tr(Vs, 136, 0, dvt * 16, lane), c); c = MFMA16(k1f, ldfrag_tr(Vs, 136, 32, dvt * 16, lane), c);
              *(u32x2*)(KV + (size_t)(dvt * 16 + (lane & 15)) * 64 + dkt * 16 + 4 * (lane >> 4)) = (u32x2){pk2(c[0], c[1]), pk2(c[2], c[3])}; } }
        __syncthreads();
        u = un;
    }
}
constexpr int PB = 4, NPOOLW = NB * 4 * 8 * (128 / PB);
__device__ __forceinline__ void ld16bf(const bf16* p, float (&f)[16]) { const u32x4 w0 = *(const u32x4*)p, w1 = *(const u32x4*)(p + 8);
#pragma unroll
    for (int q = 0; q < 4; ++q) { f[2 * q] = bflo(w0[q]); f[2 * q + 1] = bfhi(w0[q]); f[8 + 2 * q] = bflo(w1[q]); f[8 + 2 * q + 1] = bfhi(w1[q]); } }
template <int CTRL, int ROWMASK> __device__ __forceinline__ float dpp_f(float v) { return __builtin_bit_cast(float, __builtin_amdgcn_update_dpp(0, __builtin_bit_cast(int, v), CTRL, ROWMASK, 0xf, true)); }
__device__ __forceinline__ float wave_prefix(float v) {
    v += dpp_f<0x111, 0xf>(v); v += dpp_f<0x112, 0xf>(v); v += dpp_f<0x114, 0xf>(v); v += dpp_f<0x118, 0xf>(v);
    v += dpp_f<0x142, 0xa>(v);
    v += dpp_f<0x143, 0xc>(v);
    return v;
}
template <int HALF>
__device__ __forceinline__ void pool_band(const bf16* PI, bf16* PO, int r0, int c) {
    float run[16];
#pragma unroll
    for (int e = 0; e < 16; ++e) run[e] = 0.f;
    { constexpr int NW = 2 * HALF, BT = NW < 8 ? NW : 8;
#pragma unroll
      for (int i0 = 0; i0 < NW; i0 += BT) { float f[BT][16];
#pragma unroll
          for (int i = 0; i < BT; ++i) { int rr = r0 - HALF + i0 + i; rr = rr < 0 ? 0 : (rr > 127 ? 127 : rr); ld16bf(PI + (size_t)rr * 64 * 512, f[i]); }
#pragma unroll
          for (int i = 0; i < BT; ++i) { const int rr = r0 - HALF + i0 + i; const bool ok = rr >= 0 && rr < 128;
#pragma unroll
              for (int e = 0; e < 16; ++e) run[e] += ok ? f[i][e] : 0.f; }
          asm volatile("" ::: "memory"); } }
    const int lo_c = (c - HALF) < 0 ? 0 : (c - HALF), hi_c = (c + HALF) > 64 ? 64 : (c + HALF);
    float cen[16], fi[16], fo[16];
    ld16bf(PI + (size_t)r0 * 64 * 512, cen);
#pragma unroll
    for (int k = 0; k < PB; ++k) {
        const int r = r0 + k;
        float ncen[16];
        if (k + 1 < PB) { const int rin = r + HALF, rout = r - HALF;
            ld16bf(PI + (size_t)(rin > 127 ? 127 : rin) * 64 * 512, fi); ld16bf(PI + (size_t)(rout < 0 ? 0 : rout) * 64 * 512, fo); ld16bf(PI + (size_t)(r + 1) * 64 * 512, ncen); }
        const int lo_r = (r - HALF) < 0 ? 0 : (r - HALF), hi_r = (r + HALF) > 128 ? 128 : (r + HALF);
        const float inv = 1.f / (float)((hi_r - lo_r) * (hi_c - lo_c));
        float o[16];
#pragma unroll
        for (int e = 0; e < 16; ++e) { const float p = wave_prefix(run[e]);
            const float hi = __shfl(p, hi_c - 1), lo = __shfl(p, lo_c > 0 ? lo_c - 1 : 0);
            o[e] = (hi - (lo_c > 0 ? lo : 0.f)) * inv - cen[e]; }
        bf16* po = PO + (size_t)r * 64 * 512;
        *(u32x4*)po = (u32x4){pk2(o[0], o[1]), pk2(o[2], o[3]), pk2(o[4], o[5]), pk2(o[6], o[7])}; *(u32x4*)(po + 8) = (u32x4){pk2(o[8], o[9]), pk2(o[10], o[11]), pk2(o[12], o[13]), pk2(o[14], o[15])};
        if (k + 1 < PB) { const int rin = r + HALF, rout = r - HALF;
#pragma unroll
            for (int e = 0; e < 16; ++e) { run[e] += (rin < 128 ? fi[e] : 0.f) - (rout >= 0 ? fo[e] : 0.f); cen[e] = ncen[e]; } }
    }
}
__device__ __forceinline__ void pool_units(const Args& a, int vcu, int G, int lane, int wave, int nw) {
    unsigned char* ws = a.ws;
    constexpr int NBAND = 128 / PB, PER_G = NB * 8 * NBAND;
    for (int wu = vcu * nw + wave; wu < NPOOLW; wu += G * nw) {
        const int g = 3 - (wu & 3), rem = wu >> 2, b = rem / (8 * NBAND), rem2 = rem % (8 * NBAND), chk = rem2 & 7, r0 = (rem2 >> 3) * PB;
        const size_t off = ((size_t)b * SEQ + lane) * 512 + g * 128 + chk * 16;
        const bf16* PI = (const bf16*)(ws + WS_PI) + off; bf16* PO = (bf16*)(ws + WS_PO) + off;
        if (g == 0) pool_band<1>(PI, PO, r0, lane); else if (g == 1) pool_band<2>(PI, PO, r0, lane); else if (g == 2) pool_band<4>(PI, PO, r0, lane); else pool_band<8>(PI, PO, r0, lane);
    }
}

__device__ __forceinline__ void phase4(const Args& a, int G, int tid, int nthr) {
    unsigned char* ws = a.ws;
    for (int e = blockIdx.x * nthr + tid; e < 2 * 8 * 8192; e += G * nthr) {
        const int dir = e >> 16, bh = (e >> 13) & 7, e8 = e & 8191, dk = e8 & 63;
        const bf16* kvp = (const bf16*)(ws + WS_KV) + (size_t)((dir * 8 + bh) * NSLOT) * 8192 + e8;
        const float* decp = (const float*)(ws + WS_DEC) + (size_t)((dir * 8 + bh) * NSLOT) * 64 + dk;
        bf16* stp = (bf16*)(ws + WS_ST) + (size_t)((dir * 8 + bh) * NCH) * 8192 + e8;
        float s = 0.f;
        float kv[12], dc[12], kvn[12], dcn[12];
#define SCAN_SLOT(j) (dir ? (NSLOT - 1 - (j)) : ((j) < 4 ? NCH + (j) : (j) - 4))
#pragma unroll
        for (int q = 0; q < 12; ++q) { const int slot = SCAN_SLOT(q); kvn[q] = bf2f(kvp[(size_t)slot * 8192]); dcn[q] = decp[slot * 64]; }
        for (int j0 = 0; j0 < NSLOT; j0 += 12) {
#pragma unroll
            for (int q = 0; q < 12; ++q) { kv[q] = kvn[q]; dc[q] = dcn[q]; }
            if (j0 + 12 < NSLOT) {
#pragma unroll
                for (int q = 0; q < 12; ++q) { const int slot = SCAN_SLOT(j0 + 12 + q); kvn[q] = bf2f(kvp[(size_t)slot * 8192]); dcn[q] = decp[slot * 64]; } }
#pragma unroll
            for (int q = 0; q < 12; ++q) { const int slot = SCAN_SLOT(j0 + q);
                if (slot < NCH) stp[(size_t)slot * 8192] = (bf16)f2bf(s);
                s = dc[q] * s + kv[q]; }
        }
#undef SCAN_SLOT
    }
}

struct GlaPre { u32x4 q, k; f32x4 b0, b1, c0, c1, mf0, mf1, mb0, mb1; u32x4 v[2]; u32x4 st[4]; u32x4 sg[2]; };
__device__ __forceinline__ void gla_load(GlaPre& P, const Args& a, int u, int tid) {
    unsigned char* ws = a.ws;
    const int b = u >> 9, h = (u >> 7) & 3, n = u & 127, row0 = b * SEQ + n * 64, bh = b * 4 + h, t = tid >> 3, c8 = tid & 7;
    const size_t gi = (size_t)(row0 + t) * 256 + h * 64 + 8 * c8, gmf = (size_t)(row0 + 31) * 256 + h * 64 + 8 * c8, gmb = (size_t)(row0 + 32) * 256 + h * 64 + 8 * c8;
    const float* BF = a.out; const float* CB = a.out + (size_t)M * 256;
    P.q = *(const u32x4*)((const bf16*)(ws + WS_QB) + gi); P.k = *(const u32x4*)((const bf16*)(ws + WS_KB) + gi);
    P.b0 = *(const f32x4*)(BF + gi); P.b1 = *(const f32x4*)(BF + gi + 4); P.c0 = *(const f32x4*)(CB + gi); P.c1 = *(const f32x4*)(CB + gi + 4);
    P.mf0 = *(const f32x4*)(BF + gmf); P.mf1 = *(const f32x4*)(BF + gmf + 4); P.mb0 = *(const f32x4*)(CB + gmb); P.mb1 = *(const f32x4*)(CB + gmb + 4);
#pragma unroll
    for (int i = 0; i < 2; ++i) { const int p = tid + NT * i, jj = p >> 4, ch = p & 15; P.v[i] = *(const u32x4*)((const bf16*)(ws + WS_VB) + (size_t)(row0 + jj) * 512 + h * 128 + 8 * ch); }
#pragma unroll
    for (int i = 0; i < 4; ++i) { const int p = tid + NT * i, dir = p >> 10, rem = p & 1023, dv = rem >> 3, c = rem & 7;
        P.st[i] = *(const u32x4*)((const bf16*)(ws + WS_ST) + ((size_t)((dir * 8 + bh) * NCH + n) * 128 + dv) * 64 + 8 * c); }
    const bf16* sgp = (const bf16*)(ws + WS_SG) + (size_t)(row0 + t) * 512 + h * 128 + 16 * c8;
    P.sg[0] = *(const u32x4*)sgp; P.sg[1] = *(const u32x4*)(sgp + 8);
}
__device__ __forceinline__ void phase5(LAS unsigned char* lds, const Args& a, int vcu, int G, int tid, int lane, int wave) {
    unsigned char* ws = a.ws;
    LAS bf16* Aop = (LAS bf16*)lds;
    LAS bf16* Bop = (LAS bf16*)(lds + 25600);
    LAS bf16* Vs = (LAS bf16*)(lds + 60416);
    LAS bf16* qsf = (LAS bf16*)(lds + 77824); LAS bf16* ksf = qsf + 64 * 72; LAS bf16* qsb = ksf + 64 * 72; LAS bf16* ksb = qsb + 64 * 72;
    LAS float* Os = (LAS float*)(lds + 77824);
    const int t8 = tid >> 3, c8 = tid & 7;
    f32x4 gn[4];
#pragma unroll
    for (int q = 0; q < 4; ++q) gn[q] = *(const f32x4*)(a.in[I_GNG] + 16 * c8 + 4 * q);
    GlaPre P;
    int u = vcu;
    if (u < 1024) gla_load(P, a, u, tid);
    for (; u < 1024; u += G) {
        const int b = u >> 9, h = (u >> 7) & 3, n = u & 127, row0 = b * SEQ + n * 64;
        { float qf[8], kf[8], bb[8], cc[8], mf[8], mb[8];
#pragma unroll
          for (int e = 0; e < 4; ++e) { qf[2 * e] = bflo(P.q[e]); qf[2 * e + 1] = bfhi(P.q[e]); kf[2 * e] = bflo(P.k[e]); kf[2 * e + 1] = bfhi(P.k[e]);
              bb[e] = P.b0[e]; bb[4 + e] = P.b1[e]; cc[e] = P.c0[e]; cc[4 + e] = P.c1[e]; mf[e] = P.mf0[e]; mf[4 + e] = P.mf1[e]; mb[e] = P.mb0[e]; mb[4 + e] = P.mb1[e]; }
          float o0[8], o1[8], o2[8], o3[8], o4[8], o5[8];
#pragma unroll
          for (int e = 0; e < 8; ++e) { const float eb = __expf(bb[e]), ec = __expf(cc[e]), x = __expf(bb[e] - mf[e]), y = __expf(cc[e] - mb[e]);
              o0[e] = qf[e] * eb; o1[e] = qf[e] * ec; o2[e] = qf[e] * x; o3[e] = kf[e] * __builtin_amdgcn_rcpf(x); o4[e] = qf[e] * y; o5[e] = kf[e] * __builtin_amdgcn_rcpf(y); }
#define PK8(o) (u32x4){pk2(o[0], o[1]), pk2(o[2], o[3]), pk2(o[4], o[5]), pk2(o[6], o[7])}
          *(LAS u32x4*)(Aop + t8 * 200 + 8 * c8) = PK8(o0); *(LAS u32x4*)(Aop + t8 * 200 + 64 + 8 * c8) = PK8(o1);
          *(LAS u32x4*)(qsf + t8 * 72 + 8 * c8) = PK8(o2); *(LAS u32x4*)(ksf + t8 * 72 + 8 * c8) = PK8(o3); *(LAS u32x4*)(qsb + t8 * 72 + 8 * c8) = PK8(o4); *(LAS u32x4*)(ksb + t8 * 72 + 8 * c8) = PK8(o5);
#undef PK8
        }
#pragma unroll
        for (int i = 0; i < 2; ++i) { const int p = tid + NT * i, jj = p >> 4, ch = p & 15; *(LAS u32x4*)(Vs + jj * 136 + 8 * ch) = P.v[i]; }
#pragma unroll
        for (int i = 0; i < 4; ++i) { const int p = tid + NT * i, dir = p >> 10, rem = p & 1023, dv = rem >> 3, c = rem & 7; *(LAS u32x4*)(Bop + dv * 136 + dir * 64 + 8 * c) = P.st[i]; }
        const u32x4 sg0 = P.sg[0], sg1 = P.sg[1];
        __syncthreads();
        if (u + G < 1024) gla_load(P, a, u + G, tid);
        { const int tt = wave >> 1, jh = wave & 1; f32x4 pa[2] = {{0.f, 0.f, 0.f, 0.f}, {0.f, 0.f, 0.f, 0.f}};
#pragma unroll
          for (int dir = 0; dir < 2; ++dir) { const LAS bf16* qs = dir ? qsb : qsf; const LAS bf16* ks = dir ? ksb : ksf;
              const bf16x8 a0 = ldfrag(qs, 72, tt * 16, 0, lane), a1 = ldfrag(qs, 72, tt * 16, 32, lane);
#pragma unroll
              for (int jj = 0; jj < 2; ++jj) { const int jt = jh * 2 + jj; f32x4 sc = {0.f, 0.f, 0.f, 0.f}; sc = MFMA16(a0, ldfrag(ks, 72, jt * 16, 0, lane), sc); sc = MFMA16(a1, ldfrag(ks, 72, jt * 16, 32, lane), sc);
#pragma unroll
                  for (int r = 0; r < 4; ++r) { const int t = tt * 16 + 4 * (lane >> 4) + r, jx = jt * 16 + (lane & 15); const bool keep = dir ? (jx >= t) : (jx <= t); pa[jj][r] += keep ? sc[r] : 0.f; } } }
#pragma unroll
          for (int jj = 0; jj < 2; ++jj)
#pragma unroll
              for (int r = 0; r < 4; ++r) Aop[(tt * 16 + 4 * (lane >> 4) + r) * 200 + 128 + (jh * 2 + jj) * 16 + (lane & 15)] = (bf16)f2bf(pa[jj][r]); }
        __syncthreads();
        const int tt = wave >> 1, dvh = wave & 1;
        f32x4 acc[4] = {{0.f, 0.f, 0.f, 0.f}, {0.f, 0.f, 0.f, 0.f}, {0.f, 0.f, 0.f, 0.f}, {0.f, 0.f, 0.f, 0.f}};
#pragma unroll
        for (int ks = 0; ks < 4; ++ks) { const bf16x8 af = ldfrag(Aop, 200, tt * 16, ks * 32, lane);
#pragma unroll
            for (int i = 0; i < 4; ++i) acc[i] = MFMA16(af, ldfrag(Bop, 136, (dvh * 4 + i) * 16, ks * 32, lane), acc[i]); }
#pragma unroll
        for (int ks = 0; ks < 2; ++ks) { const bf16x8 af = ldfrag(Aop, 200, tt * 16, 128 + ks * 32, lane);
#pragma unroll
            for (int i = 0; i < 4; ++i) acc[i] = MFMA16(af, ldfrag_tr(Vs, 136, ks * 32, (dvh * 4 + i) * 16, lane), acc[i]); }
#pragma unroll
        for (int i = 0; i < 4; ++i)
#pragma unroll
            for (int r = 0; r < 4; ++r) Os[(tt * 16 + 4 * (lane >> 4) + r) * 132 + (dvh * 4 + i) * 16 + (lane & 15)] = acc[i][r];
        __syncthreads();
        { f32x4 ov[4]; float ss = 0.f;
#pragma unroll
          for (int q = 0; q < 4; ++q) { ov[q] = *(const LAS f32x4*)(Os + t8 * 132 + 16 * c8 + 4 * q); ss += ov[q][0] * ov[q][0] + ov[q][1] * ov[q][1] + ov[q][2] * ov[q][2] + ov[q][3] * ov[q][3]; }
          ss += __shfl_xor(ss, 1); ss += __shfl_xor(ss, 2); ss += __shfl_xor(ss, 4);
          const float rstd = rsqrtf(ss * (1.f / 128.f) + EPS);
          unsigned sgw[8] = {sg0[0], sg0[1], sg0[2], sg0[3], sg1[0], sg1[1], sg1[2], sg1[3]}, ow[8];
#pragma unroll
          for (int q = 0; q < 4; ++q) { const f32x4 o = ov[q] * rstd * gn[q]; ow[2 * q] = pk2(o[0] * bflo(sgw[2 * q]), o[1] * bfhi(sgw[2 * q])); ow[2 * q + 1] = pk2(o[2] * bflo(sgw[2 * q + 1]), o[3] * bfhi(sgw[2 * q + 1])); }
          bf16* agp = (bf16*)(ws + WS_AG) + (size_t)(row0 + t8) * 512 + h * 128 + 16 * c8;
          *(u32x4*)agp = (u32x4){ow[0], ow[1], ow[2], ow[3]}; *(u32x4*)(agp + 8) = (u32x4){ow[4], ow[5], ow[6], ow[7]}; }
        __syncthreads();
    }
}

__device__ __forceinline__ void phase8(LAS unsigned char* lds, const Args& a, int vcu, int G, int tid, int lane, int wave) {
    unsigned char* ws = a.ws;
    const float* MOD = (const float*)(ws + WS_MOD);
    LAS float* WRT = (LAS float*)lds;
#pragma unroll
    for (int it = 0; it < 8; ++it) { const int idx = tid + NT * it, k = idx >> 2, c4 = idx & 3; const f32x4 v = *(const f32x4*)(a.in[I_WROUTER] + (size_t)k * 16 + 4 * c4);
        const int row = ((k >> 8) * 4 + (k & 3)) * 64 + ((k & 255) >> 2); *(LAS f32x4*)(WRT + row * 20 + 4 * c4) = v; }
    __syncthreads();
    const int gw = vcu * NWAVES + wave, NGW = G * NWAVES;
    f32x4 gv[4];
#pragma unroll
    for (int j = 0; j < 4; ++j) gv[j] = *(const f32x4*)(a.in[I_N2G] + 256 * j + 4 * lane);
    f32x4 nx[2][4];
    if (gw < M / 2) {
#pragma unroll
        for (int r = 0; r < 2; ++r)
#pragma unroll
            for (int j = 0; j < 4; ++j) { const size_t o_ = (size_t)(2 * gw + r) * 1024 + 256 * j + 4 * lane; const u32x2 d_ = *(const u32x2*)((const bf16*)(ws + WS_YD) + o_);
                nx[r][j] = *(const f32x4*)(a.in[I_X] + o_) + (f32x4){bflo(d_.x), bfhi(d_.x), bflo(d_.y), bfhi(d_.y)}; } }
    for (int pr = gw; pr < M / 2; pr += NGW) {
        const int m0 = 2 * pr, b = m0 >> 13; const float* mod = MOD + (size_t)b * 6144;
        f32x4 v[2][4]; float ss[2];
#pragma unroll
        for (int r = 0; r < 2; ++r) { float q = 0.f;
#pragma unroll
            for (int j = 0; j < 4; ++j) { v[r][j] = nx[r][j]; q += v[r][j][0] * v[r][j][0] + v[r][j][1] * v[r][j][1] + v[r][j][2] * v[r][j][2] + v[r][j][3] * v[r][j][3]; }
            ss[r] = q; }
        if (pr + NGW < M / 2) {
#pragma unroll
            for (int r = 0; r < 2; ++r)
#pragma unroll
                for (int j = 0; j < 4; ++j) { const size_t o_ = (size_t)(2 * (pr + NGW) + r) * 1024 + 256 * j + 4 * lane; const u32x2 d_ = *(const u32x2*)((const bf16*)(ws + WS_YD) + o_);
                    nx[r][j] = *(const f32x4*)(a.in[I_X] + o_) + (f32x4){bflo(d_.x), bfhi(d_.x), bflo(d_.y), bfhi(d_.y)}; } }
#pragma unroll
        for (int r = 0; r < 2; ++r) { const float rstd = rsqrtf(wave_sum(ss[r]) * (1.f / 1024.f) + EPS);
#pragma unroll
            for (int j = 0; j < 4; ++j) { const f32x4 sc = *(const f32x4*)(mod + 4096 + 256 * j + 4 * lane), sh = *(const f32x4*)(mod + 3072 + 256 * j + 4 * lane); v[r][j] = v[r][j] * rstd * gv[j] * (sc + 1.f) + sh; }
            unsigned char* hp = ws + WS_H2 + (size_t)(m0 + r) * 1024;
#pragma unroll
            for (int j = 0; j < 4; ++j) *(unsigned*)(hp + 256 * j + 4 * lane) = pk4_fp8(v[r][j][0], v[r][j][1], v[r][j][2], v[r][j][3]); }
        f32x2 r2[16];
#pragma unroll
        for (int i = 0; i < 16; ++i) r2[i] = (f32x2){0.f, 0.f};
#pragma unroll
        for (int j = 0; j < 4; ++j)
#pragma unroll
            for (int i = 0; i < 4; ++i) { const f32x2 hab = {v[0][j][i], v[1][j][i]}; const LAS float* rp = WRT + ((j * 4 + i) * 64 + lane) * 20;
#pragma unroll
                for (int c4 = 0; c4 < 4; ++c4) { const f32x4 w = *(const LAS f32x4*)(rp + 4 * c4); r2[4 * c4 + 0] += hab * w[0]; r2[4 * c4 + 1] += hab * w[1]; r2[4 * c4 + 2] += hab * w[2]; r2[4 * c4 + 3] += hab * w[3]; }
                if (i & 1) asm volatile("" ::: "memory"); }
#pragma unroll
        for (int r = 0; r < 2; ++r) {
            float racc[16];
#pragma unroll
            for (int i = 0; i < 16; ++i) racc[i] = r2[i][r];
            RSTEP(16, 32); RSTEP(8, 16); RSTEP(4, 8); RSTEP(2, 4); racc[0] += __shfl_xor(racc[0], 2); racc[0] += __shfl_xor(racc[0], 1);
            const float lg = racc[0];
            float mx = lg; mx = fmaxf(mx, __shfl_xor(mx, 4)); mx = fmaxf(mx, __shfl_xor(mx, 8)); mx = fmaxf(mx, __shfl_xor(mx, 16)); mx = fmaxf(mx, __shfl_xor(mx, 32));
            const float ex = expf(lg - mx); float sm = ex; sm += __shfl_xor(sm, 4); sm += __shfl_xor(sm, 8); sm += __shfl_xor(sm, 16); sm += __shfl_xor(sm, 32);
            const int m = m0 + r;
            if ((lane & 3) == 0) ((float*)(ws + WS_AFF))[(size_t)(b * 16 + (lane >> 2)) * SEQ + (m & (SEQ - 1))] = ex / sm;
            if (lane < 16) ((int*)(ws + WS_INV))[(size_t)m * 16 + lane] = -1;
        }
    }
}

__device__ __forceinline__ void topk_unit(LAS unsigned char* lds, const Args& a, int be, int tid, int lane, int wave) {
    unsigned char* ws = a.ws;
    LAS unsigned* hist = (LAS unsigned*)lds;
    LAS unsigned* sel = hist + 256;
    LAS unsigned* wtot = hist + 264;
    const float* aff = (const float*)(ws + WS_AFF) + (size_t)be * SEQ + 16 * tid;
    unsigned key[16];
#pragma unroll
    for (int q = 0; q < 4; ++q) { const u32x4 v = *(const u32x4*)(aff + 4 * q); key[4 * q] = v[0]; key[4 * q + 1] = v[1]; key[4 * q + 2] = v[2]; key[4 * q + 3] = v[3]; }
    unsigned prefix = 0u, mask = 0u, kk = CAP;
    for (int pass = 0; pass < 4; ++pass) {
        const int shift = 24 - 8 * pass;
        if (tid < 256) hist[tid] = 0u;
        __syncthreads();
#pragma unroll
        for (int i = 0; i < 16; ++i) if ((key[i] & mask) == prefix) __hip_atomic_fetch_add(hist + ((key[i] >> shift) & 255u), 1u, __ATOMIC_RELAXED, __HIP_MEMORY_SCOPE_WORKGROUP);
        __syncthreads();
        if (wave == 0) {
            const unsigned h0 = hist[4 * lane], h1 = hist[4 * lane + 1], h2 = hist[4 * lane + 2], h3 = hist[4 * lane + 3], loc = h0 + h1 + h2 + h3;
            unsigned suf = loc;
#pragma unroll
            for (int o = 1; o < 64; o <<= 1) { const unsigned t = __shfl_down(suf, o); if (lane + o < 64) suf += t; }
            const unsigned above = suf - loc;
            const unsigned s3 = above + h3, s2 = s3 + h2, s1 = s2 + h1, s0 = s1 + h0;
            if (s3 >= kk && above < kk) { sel[0] = 4 * lane + 3; sel[1] = kk - above; }
            if (s2 >= kk && s3 < kk) { sel[0] = 4 * lane + 2; sel[1] = kk - s3; }
            if (s1 >= kk && s2 < kk) { sel[0] = 4 * lane + 1; sel[1] = kk - s2; }
            if (s0 >= kk && s1 < kk) { sel[0] = 4 * lane + 0; sel[1] = kk - s1; }
        }
        __syncthreads();
        prefix |= sel[0] << shift; mask |= 255u << shift; kk = sel[1];
        __syncthreads();
    }
    unsigned cgt = 0u, ceq = 0u;
#pragma unroll
    for (int i = 0; i < 16; ++i) { cgt += (key[i] > prefix) ? 1u : 0u; ceq += (key[i] == prefix) ? 1u : 0u; }
    const unsigned val = cgt | (ceq << 16); unsigned inc = val;
#pragma unroll
    for (int o = 1; o < 64; o <<= 1) { const unsigned t = __shfl_up(inc, o); if (lane >= o) inc += t; }
    if (lane == 63) wtot[wave] = inc;
    __syncthreads();
    unsigned base = 0u;
    for (int w = 0; w < wave; ++w) base += wtot[w];
    const unsigned excl = base + inc - val; unsigned gtb = excl & 0xffffu, eqb = excl >> 16;
    const int b = be >> 4, e = be & 15;
    int* IDX = (int*)(ws + WS_IDX) + be * CAP; float* WSEL = (float*)(ws + WS_WSEL) + be * CAP; int* INV = (int*)(ws + WS_INV);
#pragma unroll
    for (int i = 0; i < 16; ++i) { const bool gt = key[i] > prefix, eq = key[i] == prefix; const bool take = gt || (eq && eqb < kk);
        if (take) { const unsigned pos = gtb + (eqb < kk ? eqb : kk); const int row = b * SEQ + 16 * tid + i; IDX[pos] = row; WSEL[pos] = __builtin_bit_cast(float, key[i]); INV[(size_t)row * 16 + e] = (int)pos; }
        gtb += gt ? 1u : 0u; eqb += eq ? 1u : 0u; }
    __syncthreads();
}
__device__ __forceinline__ void phase9(LAS unsigned char* lds, const Args& a, int vcu, int G, int tid, int lane, int wave) {
    const int ntk = (G > 64) ? 32 : 0;
    if (vcu < ntk || ntk == 0) for (int be = (ntk ? vcu : vcu); be < NB * NE; be += (ntk ? ntk : G)) topk_unit(lds, a, be, tid, lane, wave);
    if (vcu >= ntk) { const int gw = (vcu - ntk) * NWAVES + wave, NGW = (G - ntk) * NWAVES; convert_items<2>((LAS float*)(lds + 8192 + wave * 8448), a, gw, NGW, 8192, lane); }
}

__device__ __forceinline__ void phase12(const Args& a, int vcu, int G, int lane, int wave) {
    unsigned char* ws = a.ws;
    const int gw = vcu * NWAVES + wave, NGW = G * NWAVES;
    f32x4 gv[4];
#pragma unroll
    for (int j = 0; j < 4; ++j) gv[j] = *(const f32x4*)(a.in[I_FNG] + 256 * j + 4 * lane);
    f32x4 nx[4]; int ninv = -1;
    if (gw < M) {
#pragma unroll
        for (int j = 0; j < 4; ++j) { const size_t o_ = (size_t)gw * 1024 + 256 * j + 4 * lane; const u32x2 d_ = __builtin_nontemporal_load((const u32x2*)((const bf16*)(ws + WS_YD) + o_));
            nx[j] = __builtin_nontemporal_load((const f32x4*)(a.in[I_X] + o_)) + (f32x4){bflo(d_.x), bfhi(d_.x), bflo(d_.y), bfhi(d_.y)}; }
        ninv = (lane < 16) ? ((const int*)(ws + WS_INV))[(size_t)gw * 16 + lane] : -1; }
    for (int m = gw; m < M; m += NGW) {
        const int b = m >> 13; float* row = a.out + (size_t)m * 1024;
        f32x4 v[4];
#pragma unroll
        for (int j = 0; j < 4; ++j) v[j] = nx[j];
        const int myinv = ninv;
        if (m + NGW < M) {
#pragma unroll
            for (int j = 0; j < 4; ++j) { const size_t o_ = (size_t)(m + NGW) * 1024 + 256 * j + 4 * lane; const u32x2 d_ = __builtin_nontemporal_load((const u32x2*)((const bf16*)(ws + WS_YD) + o_));
                nx[j] = __builtin_nontemporal_load((const f32x4*)(a.in[I_X] + o_)) + (f32x4){bflo(d_.x), bfhi(d_.x), bflo(d_.y), bfhi(d_.y)}; }
            ninv = (lane < 16) ? ((const int*)(ws + WS_INV))[(size_t)(m + NGW) * 16 + lane] : -1; }
        unsigned long long mask = __ballot(myinv >= 0);
        const bf16* yb = (const bf16*)(ws + WS_YB) + (size_t)(b * 16) * CAP * 1024;
        while (mask) {
            u32x2 w[4][4]; float sc[4];
#pragma unroll
            for (int q = 0; q < 4; ++q) { const bool on = mask != 0ull; const int e = on ? (int)__builtin_ctzll(mask) : 0; mask = on ? (mask & (mask - 1ull)) : 0ull;
                const int sl = __shfl(myinv, e); const size_t ro = on ? ((size_t)e * CAP + (size_t)sl) * 1024 : 0; sc[q] = on ? 1.f : 0.f;
#pragma unroll
                for (int j = 0; j < 4; ++j) w[q][j] = __builtin_nontemporal_load((const u32x2*)(yb + ro + 256 * j + 4 * lane)); }
#pragma unroll
            for (int q = 0; q < 4; ++q)
#pragma unroll
                for (int j = 0; j < 4; ++j) { v[j][0] += sc[q] * bflo(w[q][j].x); v[j][1] += sc[q] * bfhi(w[q][j].x); v[j][2] += sc[q] * bflo(w[q][j].y); v[j][3] += sc[q] * bfhi(w[q][j].y); }
        }
        float ss = 0.f;
#pragma unroll
        for (int j = 0; j < 4; ++j) ss += v[j][0] * v[j][0] + v[j][1] * v[j][1] + v[j][2] * v[j][2] + v[j][3] * v[j][3];
        const float rstd = rsqrtf(wave_sum(ss) * (1.f / 1024.f) + EPS);
#pragma unroll
        for (int j = 0; j < 4; ++j) __builtin_nontemporal_store(v[j] * rstd * gv[j], (f32x4*)(row + 256 * j + 4 * lane));
    }
}

__global__ void __launch_bounds__(NT, 2) fwd_kernel(Args args) {
    extern __shared__ __attribute__((aligned(16))) unsigned char lds_raw[];
    LAS unsigned char* lds = (LAS unsigned char*)lds_raw;
    volatile LAS unsigned* MISC = (volatile LAS unsigned*)(lds + MISC_OFF);
    const int tid0 = threadIdx.x, tid = tid0, wave = __builtin_amdgcn_readfirstlane(tid >> 6);
    const int G = gridDim.x, bx = blockIdx.x, vcu = (G % 8 == 0) ? (bx % 8) * (G / 8) + bx / 8 : bx;
    unsigned char* ws = args.ws;
    if (tid < 128) MISC[tid] = 0u;
    __syncthreads();
    XcdBarrier bar; bar.bar = (unsigned*)(ws + WS_CTL) + CW_BAR; bar.x = 0; bar.st = nullptr;
    if (!MK_MULTI) bar = xcd_barrier_post((unsigned*)(ws + WS_CTL) + CW_BAR, MISC + 8);
    const int lo = args.ph_lo, hi = args.ph_hi;
#define IN(k) (lo <= (k) && (k) < hi)
#define SEAM(k) do { if (IN(k) && IN((k) + 1)) xcd_barrier(bar); } while (0)
#define RUN(k, CODE) do { if (IN(k)) { int tid = tid0, lane; asm volatile("" : "+v"(tid)); lane = tid & 63; (void)lane; CODE; if (REP_PHASE == (k)) for (int _r = 0; _r < REP_COUNT; ++_r) { xcd_barrier(bar); CODE; } } SEAM(k); } while (0)
#define PH0 phase0(lds, args, vcu, G, tid, lane, wave)
#define PH1 phase1(lds, args, vcu, G, tid, lane, wave)
#define PH2 do { const int qs = vcu % 3;     \
        EpiInproj E{(bf16*)(ws + WS_KB), (bf16*)(ws + WS_VB), (bf16*)(ws + WS_QB), (bf16*)(ws + WS_SG), (bf16*)(ws + WS_PI), ws + WS_SM, 0, 1.f}; \
        EpiGates E8{(bf16*)(ws + WS_KB), (bf16*)(ws + WS_VB), (bf16*)(ws + WS_QB), (bf16*)(ws + WS_SG), (bf16*)(ws + WS_PI), ws + WS_SM, 8, 0.0625f}; \
        if (qs == 0) convert_all<1>(lds, args, vcu, G, lane, wave); \
        { SchedDense S{G, bx, 1024, 64, 8, (const char*)(ws + WS_H1), (const char*)(ws + WS_WIN), 0, 1 << 20, 2}; pg8::gemm_phase<EpiInproj, SchedDense, false, false>(lds, S, E); }     \
        if (qs == 1) convert_all<1>(lds, args, vcu, G, lane, wave); \
        { SchedDense S{G, bx, 1024, 64, 8, (const char*)(ws + WS_H1F), (const char*)(ws + WS_WINM), 0, 1 << 20, 1}; pg8::gemm_phase<EpiGates, SchedDense, false, true>(lds, S, E8); }     \
        if (qs == 2) convert_all<1>(lds, args, vcu, G, lane, wave); } while (0)
#define PH3 chunk_units(lds, args, vcu, G, tid, lane, wave)
#define PH4 do { pool_units(args, vcu, G, lane, wave, 8); phase4(args, G, tid, NT); } while (0)
#define PH5 phase5(lds, args, vcu, G, tid, lane, wave)
#define PH6 do { SchedPair S{G, bx, 512, (const char*)(ws + WS_AG), (const char*)(ws + WS_PO), (const char*)(ws + WS_WG), (const char*)(ws + WS_WC)}; \
        EpiMerge E{ws + WS_SM, (bf16*)(ws + WS_MG)}; pg8::gemm_phase<EpiMerge, SchedPair, false>(lds, S, E); } while (0)
#define PH7 do { SchedDense S{G, bx, 1024, 64, 4, (const char*)(ws + WS_MG), (const char*)(ws + WS_WO), 0, 1 << 20, 2}; \
        EpiOut E{(const float*)(ws + WS_MOD), (bf16*)(ws + WS_YD)}; pg8::gemm_phase<EpiOut, SchedDense, false>(lds, S, E); } while (0)
#define NITEM_HALF ((NE * 3 * 512 + 2 * G * NWAVES - 1) / (2 * G * NWAVES))
#define PH6C do { if (vcu & 1) convert_experts(lds, args, vcu, G, lane, wave, 0, NITEM_HALF); PH6; if (!(vcu & 1)) convert_experts(lds, args, vcu, G, lane, wave, 0, NITEM_HALF); } while (0)
#define PH7C do { if (vcu & 1) convert_experts(lds, args, vcu, G, lane, wave, NITEM_HALF, 2 * NITEM_HALF); PH7; if (!(vcu & 1)) convert_experts(lds, args, vcu, G, lane, wave, NITEM_HALF, 2 * NITEM_HALF); } while (0)
#define PH8 phase8(lds, args, vcu, G, tid, lane, wave)
#define PH9 phase9(lds, args, vcu, G, tid, lane, wave)
#define PH9B do { const int gw_ = vcu * NWAVES + wave, NGW_ = G * NWAVES;     \
        for (int r0_ = gw_ * 16; r0_ < NB * NE * CAP; r0_ += NGW_ * 16) { u32x4 t_[16]; \
            _Pragma("unroll") for (int q = 0; q < 16; ++q) { const int src_ = ((const int*)(ws + WS_IDX))[r0_ + q]; t_[q] = *(const u32x4*)(ws + WS_H2 + (size_t)src_ * 1024 + lane * 16); } \
            _Pragma("unroll") for (int q = 0; q < 16; ++q) *(u32x4*)(ws + WS_XS + (size_t)(r0_ + q) * 1024 + lane * 16) = t_[q]; } } while (0)
#define PH10 do { EpiMoe1 E{ws + WS_ACT}; SchedMoe1 S{G, bx, 1024, (const char*)(ws + WS_XS), (const char*)(ws + WS_WGU), 0, 1 << 20}; pg8::gemm_phase<EpiMoe1, SchedMoe1, false, true>(lds, S, E); } while (0)
#define PH11 do { SchedMoe2 S{G, bx, 1024, (const char*)(ws + WS_ACT), (const char*)(ws + WS_WD)}; \
        EpiMoe2 E{(bf16*)(ws + WS_YB), (const float*)(ws + WS_WSEL), (const float*)(ws + WS_MOD)}; pg8::gemm_phase<EpiMoe2, SchedMoe2, false, true>(lds, S, E); } while (0)
#define PH12 phase12(args, vcu, G, lane, wave)
    RUN(0, PH0); RUN(1, PH1); RUN(2, PH2); RUN(3, PH3);
#define PH3A chunk_units(lds, args, vcu, G, tid, lane, wave)
#define PH3B pool_units(args, vcu, G, lane, wave, 8)
    if (REP_PHASE == 40) { xcd_barrier(bar); if (wave < 4) phase4(args, G, tid, 256); xcd_barrier(bar); }
    if (REP_PHASE == 41) { const int lane = tid & 63; xcd_barrier(bar); if (wave >= 4) pool_units(args, vcu, G, lane, wave - 4, 4); xcd_barrier(bar); }
    if (REP_PHASE == 30) { const int lane = tid & 63; xcd_barrier(bar); PH3A; xcd_barrier(bar); }
    if (REP_PHASE == 31) { const int lane = tid & 63; xcd_barrier(bar); PH3B; xcd_barrier(bar); } RUN(4, PH4); RUN(5, PH5); RUN(6, PH6); RUN(7, PH7); RUN(8, PH8); RUN(9, PH9); RUN(10, PH9B); RUN(11, PH10); RUN(12, PH11);
    if (REP_PHASE == 20) for (int _r = 0; _r < REP_COUNT; ++_r) xcd_barrier(bar);
    RUN(13, PH12);
#undef IN
#undef SEAM
#undef RUN
}

#ifndef MK_CHECK
#define MK_CHECK 0
#endif
#ifndef CHK_SKIP
#define CHK_SKIP -1
#endif
#if MK_CHECK
constexpr size_t WS_CHK = 299 * MiB;
__device__ __forceinline__ unsigned hashu(unsigned x) { x ^= x >> 16; x *= 0x7feb352dU; x ^= x >> 15; x *= 0x846ca68bU; x ^= x >> 16; return x; }
__device__ __forceinline__ float bfr(float f) { return bf2f(f2bf(f)); }
__device__ float f8d(unsigned char x) { const int sg = x >> 7, e = (x >> 3) & 15, m = x & 7; const float v = e ? ldexpf(1.f + m / 8.f, e - 7) : ldexpf(m / 8.f, -6); return sg ? -v : v; }
__device__ float f8r(float f) { return f8d((unsigned char)(pk4_fp8(f, 0.f, 0.f, 0.f) & 255u)); }
__device__ float x1_at(const Args& a, int m, int k) { return a.in[I_X][(size_t)m * 1024 + k] + bf2f(((const bf16*)(a.ws + WS_YD))[(size_t)m * 1024 + k]); }
__device__ float naive_rstd_x1(const Args& a, int m) { float ss = 0.f; for (int k = 0; k < 1024; ++k) { const float v = x1_at(a, m, k); ss += v * v; } return rsqrtf(ss / 1024.f + EPS); }
__device__ float gate_at(const Args& a, int m, int n) {
    const int pm = m >> 8, r = m & 255, ai = r >> 7, wr = (r >> 6) & 1, mm = (r >> 4) & 3, fr = r & 15, pg = n >> 8, c = n & 255, bj = c >> 7, wc = (c >> 5) & 3, fq = (c >> 3) & 3, j8 = c & 7;
    return (float)(a.ws + WS_SM)[gate_off(pm, pg, ai, mm, bj, wr, wc, fr, fq) + j8] * (1.f / 255.f); }
__device__ float naive_rstd(const float* row) { float ss = 0.f; for (int k = 0; k < 1024; ++k) ss += row[k] * row[k]; return rsqrtf(ss / 1024.f + EPS); }
__device__ float naive_la(const Args& a, int row, int dir, int col) {
    const float* RB = (const float*)(a.ws + WS_RB) + (size_t)row * 32 + dir * 16; float z = a.in[I_BDEC][dir * 256 + col];
    for (int j = 0; j < 16; ++j) z += RB[j] * a.in[I_WDU][(size_t)(dir * 16 + j) * 256 + col];
    return logsig_f(z) / 16.f;
}
__global__ void chk_kernel(Args a, int stage) {
    __shared__ float sh[256];
    const unsigned gid = blockIdx.x * blockDim.x + threadIdx.x; unsigned h = hashu(gid * 2654435761u + (unsigned)stage * 97u + 12345u); const unsigned h2 = hashu(h + 777u);
    unsigned char* ws = a.ws; float ref = 0.f, got = 0.f, atol = 1e-3f; bool active = true;
    const float* MOD = (const float*)(ws + WS_MOD);
    switch (stage) {
    case 0: { const int v = h % 3, n = (h >> 2) % 6144; ref = a.in[I_ADAB][n]; for (int k = 0; k < 1024; ++k) { const float c = (v < 2) ? a.in[I_C][v * 1024 + k] : a.in[I_CCTX][k]; ref += c / (1.f + expf(-c)) * a.in[I_ADAW][(size_t)k * 6144 + n]; } got = MOD[v * 6144 + n]; atol = 0.01f; } break;
    case 1: { const int sel = (h >> 28) & 3, n = h % 4096, k = (h >> 12) % 1024;
        if (sel < 2) { if (n < 2048) { ref = bfr(a.in[I_WIN][(size_t)k * DIN + n + (n >= 768 ? 32 : 0)]); got = bf2f(((const bf16*)(ws + WS_WIN))[(size_t)n * 1024 + k]); } else { ref = f8r(16.f * a.in[I_WIN][(size_t)k * DIN + n + 32]); got = f8d((ws + WS_WINM)[(size_t)(n - 2048) * 1024 + k]); } }
        else if (sel == 2) { ref = bfr(a.in[I_WOUT][(size_t)k * 1024 + (n & 1023)]); got = bf2f(((const bf16*)(ws + WS_WO))[(size_t)(n & 1023) * 1024 + k]); }
        else { ref = bfr(a.in[I_WGLA][(size_t)(k & 511) * 1024 + (n & 1023)]); got = bf2f(((const bf16*)(ws + WS_WG))[(size_t)(n & 1023) * 512 + (k & 511)]); } atol = 1e-4f; } break;
    case 2: { const int n = h % 1024, kk = (h >> 10) % 512, g = kk >> 7, c = kk & 127; for (int d = 0; d < 128; ++d) ref += a.in[I_POOLW][(size_t)(g * 128 + c) * 128 + d] * a.in[I_POOLS][g * 128 + d] * a.in[I_WPOOL][(size_t)(g * 128 + d) * 1024 + n];
        got = bf2f(((const bf16*)(ws + WS_WC))[(size_t)n * 512 + kk]); atol = 0.002f; } break;
    case 3: { const int m = h % M, k = (h >> 14) % 1024, b = m >> 13; const float* row = a.in[I_X] + (size_t)m * 1024; const float rstd = naive_rstd(row);
        ref = row[k] * rstd * a.in[I_N1G][k] * (1.f + MOD[b * 6144 + 1024 + k]) + MOD[b * 6144 + k]; got = bf2f(((const bf16*)(ws + WS_H1))[(size_t)m * 1024 + k]); atol = 0.01f; } break;
    case 4: { const int m = h % MT, c = (h >> 15) % 32, mi = (m < M) ? (m >> 13) : 2; const float* row = (m < M) ? a.in[I_X] + (size_t)m * 1024 : a.in[I_CTX] + (size_t)(m - M) * 1024; const float rstd = naive_rstd(row);
        for (int k = 0; k < 1024; ++k) ref += (row[k] * rstd * a.in[I_N1G][k] * (1.f + MOD[mi * 6144 + 1024 + k]) + MOD[mi * 6144 + k]) * a.in[I_WIN][(size_t)k * DIN + 768 + c];
        got = ((const float*)(ws + WS_RB))[(size_t)m * 32 + c]; atol = 0.01f; } break;
    case 5: { const int r = h % 512, n = (h >> 9) % 768; const float* row = a.in[I_CTX] + (size_t)r * 1024; const float rstd = naive_rstd(row);
        for (int k = 0; k < 1024; ++k) ref += bfr(row[k] * rstd * a.in[I_N1G][k] * (1.f + MOD[2 * 6144 + 1024 + k]) + MOD[2 * 6144 + k]) * bf2f(((const bf16*)(ws + WS_WIN))[(size_t)n * 1024 + k]);
        got = (n < 256) ? bf2f(((const bf16*)(ws + WS_KB))[(size_t)(M + r) * 256 + n]) : bf2f(((const bf16*)(ws + WS_VB))[(size_t)(M + r) * 512 + n - 256]); atol = 0.03f; } break;
    case 6: { const int m = h % M, n = (h >> 14) % 4096; const bf16* hr = (const bf16*)(ws + WS_H1) + (size_t)m * 1024; const bf16* wr_ = (const bf16*)(ws + WS_WIN) + (size_t)n * 1024; float d = 0.f;
        if (n < 2048) { for (int k = 0; k < 1024; ++k) d += bf2f(hr[k]) * bf2f(wr_[k]); }
        else { for (int k = 0; k < 1024; ++k) d += f8d((ws + WS_H1F)[(size_t)m * 1024 + k]) * f8d((ws + WS_WINM)[(size_t)(n - 2048) * 1024 + k]); d *= 0.0625f; }
        if (n < 256) { ref = d; got = bf2f(((const bf16*)(ws + WS_KB))[(size_t)m * 256 + n]); }
        else if (n < 768) { ref = d; got = bf2f(((const bf16*)(ws + WS_VB))[(size_t)m * 512 + n - 256]); }
        else if (n < 1024) { ref = d * 0.125f; got = bf2f(((const bf16*)(ws + WS_QB))[(size_t)m * 256 + n - 768]); }
        else if (n < 1536) { ref = d / (1.f + expf(-d)); got = bf2f(((const bf16*)(ws + WS_SG))[(size_t)m * 512 + n - 1024]); }
        else if (n < 2048) { ref = d; got = bf2f(((const bf16*)(ws + WS_PI))[(size_t)m * 512 + n - 1536]); }
        else { ref = 1.f / (1.f + expf(-d)); got = gate_at(a, m, n - 2048); } atol = 0.02f; } break;
    case 7: { const int m = h % M, col = (h >> 14) % 256, dir = (h >> 22) & 1, t = m & 63, m0 = m - t;
        for (int s = 0; s < 64; ++s) if (dir ? (s >= t) : (s <= t)) ref += naive_la(a, m0 + s, dir, col);
        got = (dir ? a.out + (size_t)M * 256 : a.out)[(size_t)m * 256 + col]; atol = 0.003f; } break;
    case 8: case 9: { const int dir = h & 1, bh = (h >> 1) & 7, slot = (stage == 9) ? 128 + ((h >> 4) & 3) : ((h >> 4) & 127), dv = (h >> 11) & 127, dk = (h >> 18) & 63, b = bh >> 2, hh = bh & 3;
        const int row0 = (slot < 128) ? b * SEQ + slot * 64 : M + b * LC + (slot - 128) * 64; float la[64]; float tot = 0.f;
        for (int s = 0; s < 64; ++s) tot += naive_la(a, row0 + s, dir, hh * 64 + dk);
        float run = 0.f;
        if (!dir) { for (int s = 0; s < 64; ++s) { run += naive_la(a, row0 + s, 0, hh * 64 + dk); ref += bf2f(((const bf16*)(ws + WS_VB))[(size_t)(row0 + s) * 512 + hh * 128 + dv]) * bfr(bf2f(((const bf16*)(ws + WS_KB))[(size_t)(row0 + s) * 256 + hh * 64 + dk]) * expf(tot - run)); } }
        else { for (int s = 63; s >= 0; --s) { run += naive_la(a, row0 + s, 1, hh * 64 + dk); ref += bf2f(((const bf16*)(ws + WS_VB))[(size_t)(row0 + s) * 512 + hh * 128 + dv]) * bfr(bf2f(((const bf16*)(ws + WS_KB))[(size_t)(row0 + s) * 256 + hh * 64 + dk]) * expf(tot - run)); } }
        (void)la;
        if ((h >> 30) & 1) { ref = expf(tot); got = ((const float*)(ws + WS_DEC))[((size_t)(dir * 8 + bh) * NSLOT + slot) * 64 + dk]; atol = 1e-3f; }
        else { got = bf2f(((const bf16*)(ws + WS_KV))[((size_t)(dir * 8 + bh) * NSLOT + slot) * 8192 + dv * 64 + dk]); atol = 0.1f; } } break;
    case 10: { const int m = h % M, col = (h >> 14) % 512, g = col >> 7, half = 1 << g, b = m >> 13, l = m & 8191, r = l >> 6, c = l & 63; const bf16* PI = (const bf16*)(ws + WS_PI);
        const int lo_r = max(r - half, 0), hi_r = min(r + half, 128), lo_c = max(c - half, 0), hi_c = min(c + half, 64); float sm = 0.f;
        for (int rr = lo_r; rr < hi_r; ++rr) for (int cc = lo_c; cc < hi_c; ++cc) sm += bf2f(PI[(size_t)(b * SEQ + rr * 64 + cc) * 512 + col]);
        ref = sm / (float)((hi_r - lo_r) * (hi_c - lo_c)) - bf2f(PI[(size_t)m * 512 + col]); got = bf2f(((const bf16*)(ws + WS_PO))[(size_t)m * 512 + col]); atol = 0.02f; } break;
    case 11: { const int dir = h & 1, bh = (h >> 1) & 7, n = (h >> 4) & 127, e8 = (h >> 11) & 8191, dk = e8 & 63; float s = 0.f;
        const bf16* kvp = (const bf16*)(ws + WS_KV) + (size_t)((dir * 8 + bh) * NSLOT) * 8192 + e8; const float* dp = (const float*)(ws + WS_DEC) + (size_t)((dir * 8 + bh) * NSLOT) * 64 + dk;
        if (!dir) { for (int j = 128; j < 132; ++j) s = dp[j * 64] * s + bf2f(kvp[(size_t)j * 8192]); for (int j = 0; j < n; ++j) s = dp[j * 64] * s + bf2f(kvp[(size_t)j * 8192]); }
        else { for (int j = 131; j >= 128; --j) s = dp[j * 64] * s + bf2f(kvp[(size_t)j * 8192]); for (int j = 127; j > n; --j) s = dp[j * 64] * s + bf2f(kvp[(size_t)j * 8192]); }
        ref = s; got = bf2f(((const bf16*)(ws + WS_ST))[(size_t)((dir * 8 + bh) * NCH + n) * 8192 + e8]); atol = 0.1f; } break;
    case 12: {
        const unsigned hb = hashu(blockIdx.x * 7919u + 5u); const int m = hb % M, hh = (hb >> 14) & 3, b = m >> 13, l = m & 8191, n = l >> 6, t = l & 63, row0 = m - t, bh = b * 4 + hh, dv = threadIdx.x & 127;
        const float* BF = a.out; const float* CB = a.out + (size_t)M * 256; const bf16* QB = (const bf16*)(ws + WS_QB); const bf16* KB = (const bf16*)(ws + WS_KB); const bf16* VB = (const bf16*)(ws + WS_VB); const bf16* ST = (const bf16*)(ws + WS_ST);
        if (threadIdx.x < 128) { const int j = threadIdx.x & 63, dir = threadIdx.x >> 6; float sc = 0.f;
            const bool keep = dir ? (j >= t) : (j <= t);
            if (keep) for (int d = 0; d < 64; ++d) { const size_t gq = (size_t)m * 256 + hh * 64 + d, gk = (size_t)(row0 + j) * 256 + hh * 64 + d; const float* P = dir ? CB : BF; sc += bf2f(QB[gq]) * bf2f(KB[gk]) * expf(P[gq] - P[gk]); }
            sh[threadIdx.x] = sc; }
        __syncthreads();
        float o = 0.f;
        for (int d = 0; d < 64; ++d) { const size_t gq = (size_t)m * 256 + hh * 64 + d; const float q = bf2f(QB[gq]);
            o += q * expf(BF[gq]) * bf2f(ST[((size_t)((0 * 8 + bh) * NCH + n) * 128 + dv) * 64 + d]) + q * expf(CB[gq]) * bf2f(ST[((size_t)((1 * 8 + bh) * NCH + n) * 128 + dv) * 64 + d]); }
        for (int j = 0; j < 64; ++j) o += (sh[j] + sh[64 + j]) * bf2f(VB[(size_t)(row0 + j) * 512 + hh * 128 + dv]);
        __syncthreads(); sh[128 + dv] = o * o; __syncthreads();
        float ss = 0.f; for (int d = 0; d < 128; ++d) ss += sh[128 + d];
        const size_t gi = (size_t)m * 512 + hh * 128 + dv;
        ref = o * rsqrtf(ss / 128.f + EPS) * a.in[I_GNG][dv] * bf2f(((const bf16*)(ws + WS_SG))[gi]); got = bf2f(((const bf16*)(ws + WS_AG))[gi]); atol = 0.03f; } break;
    case 13: { const int m = h % M, n = (h >> 14) % 1024; float g = 0.f, p = 0.f; const bf16* AG = (const bf16*)(ws + WS_AG) + (size_t)m * 512; const bf16* PO = (const bf16*)(ws + WS_PO) + (size_t)m * 512;
        for (int k = 0; k < 512; ++k) { g += bf2f(AG[k]) * bf2f(((const bf16*)(ws + WS_WG))[(size_t)n * 512 + k]); p += bf2f(PO[k]) * bf2f(((const bf16*)(ws + WS_WC))[(size_t)n * 512 + k]); }
        ref = gate_at(a, m, n) * g + gate_at(a, m, 1024 + n) * p; got = bf2f(((const bf16*)(ws + WS_MG))[(size_t)m * 1024 + n]); atol = 0.03f; } break;
    case 14: { const int m = h % M, n = (h >> 14) % 1024, b = m >> 13; float d = 0.f; for (int k = 0; k < 1024; ++k) d += bf2f(((const bf16*)(ws + WS_MG))[(size_t)m * 1024 + k]) * bf2f(((const bf16*)(ws + WS_WO))[(size_t)n * 1024 + k]);
        ref = bfr(MOD[b * 6144 + 2048 + n] * d); got = bf2f(((const bf16*)(ws + WS_YD))[(size_t)m * 1024 + n]); atol = 0.005f; } break;
    case 15: { const int m = h % M, k = (h >> 14) % 1024, b = m >> 13; const float rstd = naive_rstd_x1(a, m);
        ref = x1_at(a, m, k) * rstd * a.in[I_N2G][k] * (1.f + MOD[b * 6144 + 4096 + k]) + MOD[b * 6144 + 3072 + k]; got = f8d((ws + WS_H2)[(size_t)m * 1024 + k]); atol = 0.02f; ref = f8r(ref); } break;
    case 16: { const int m = h % M, e = (h >> 14) & 15, b = m >> 13; const float rstd = naive_rstd_x1(a, m); float mx = -1e30f, mye = 0.f, sm = 0.f;
        for (int pass = 0; pass < 2; ++pass) for (int ee = 0; ee < 16; ++ee) { float lg = 0.f; for (int k = 0; k < 1024; ++k) lg += (x1_at(a, m, k) * rstd * a.in[I_N2G][k] * (1.f + MOD[b * 6144 + 4096 + k]) + MOD[b * 6144 + 3072 + k]) * a.in[I_WROUTER][k * 16 + ee];
            if (pass == 0) mx = fmaxf(mx, lg); else { const float ex = expf(lg - mx); sm += ex; if (ee == e) mye = ex; } }
        ref = mye / sm; got = ((const float*)(ws + WS_AFF))[(size_t)(b * 16 + e) * SEQ + (m & 8191)]; atol = 0.001f; } break;
    case 17: { const int be = h & 31, slot = (h >> 5) & 1023, b = be >> 4, e = be & 15; const int row = ((const int*)(ws + WS_IDX))[be * CAP + slot]; const float* aff = (const float*)(ws + WS_AFF) + (size_t)be * SEQ; float bad = 0.f;
        if (row < b * SEQ || row >= (b + 1) * SEQ) bad += 1.f; else { const int l = row & 8191; if (((const int*)(ws + WS_INV))[(size_t)row * 16 + e] != slot) bad += 1.f; if (((const float*)(ws + WS_WSEL))[be * CAP + slot] != aff[l]) bad += 1.f;
            int cnt = 0; for (int j = 0; j < SEQ; ++j) cnt += (aff[j] > aff[l]) ? 1 : 0; if (cnt >= CAP) bad += 1.f;
            const int l2 = h2 & 8191; if (((const int*)(ws + WS_INV))[(size_t)(b * SEQ + l2) * 16 + e] < 0) { int c2 = 0; for (int j = 0; j < SEQ; ++j) c2 += (aff[j] >= aff[l2]) ? 1 : 0; if (c2 <= CAP) bad += 1.f; } }
        ref = 0.f; got = bad; atol = 0.5f; } break;
    case 18: { const int e = h & 15, mat = (h >> 4) % 3, n = (h >> 8) & 1023, k = (h >> 18) & 1023;
        if (mat == 0) { ref = f8r(16.f * a.in[I_WGATE][(size_t)e * 1048576 + (size_t)k * 1024 + n]); got = f8d((ws + WS_WGU)[((size_t)e * 2048 + (n >> 7) * 256 + (n & 127)) * 1024 + k]); }
        else if (mat == 1) { ref = f8r(16.f * a.in[I_WUP][(size_t)e * 1048576 + (size_t)k * 1024 + n]); got = f8d((ws + WS_WGU)[((size_t)e * 2048 + (n >> 7) * 256 + 128 + (n & 127)) * 1024 + k]); }
        else { ref = f8r(16.f * a.in[I_WDOWN][(size_t)e * 1048576 + (size_t)k * 1024 + n]); got = f8d((ws + WS_WD)[((size_t)e * 1024 + n) * 1024 + k]); } atol = 1e-4f; } break;
    case 19: { const int be = h & 31, slot = (h >> 5) & 1023, f = (h >> 15) & 1023, e = be & 15; const int row = ((const int*)(ws + WS_IDX))[be * CAP + slot]; float g = 0.f, u = 0.f;
        const unsigned char* hr = ws + WS_H2 + (size_t)row * 1024; const unsigned char* wg = ws + WS_WGU + ((size_t)e * 2048 + (f >> 7) * 256 + (f & 127)) * 1024; const unsigned char* wu = wg + 128 * 1024;
        for (int k = 0; k < 1024; ++k) { g += f8d(hr[k]) * f8d(wg[k]); u += f8d(hr[k]) * f8d(wu[k]); }
        g *= 0.0625f; u *= 0.0625f; ref = f8r(g / (1.f + expf(-g)) * u); got = f8d((ws + WS_ACT)[((size_t)be * CAP + slot) * 1024 + f]); atol = 0.03f; } break;
    case 20: { const int be = h & 31, slot = (h >> 5) & 1023, n = (h >> 15) & 1023, e = be & 15, b = be >> 4; float d = 0.f;
        for (int f = 0; f < 1024; ++f) d += f8d((ws + WS_ACT)[((size_t)be * CAP + slot) * 1024 + f]) * f8d((ws + WS_WD)[((size_t)e * 1024 + n) * 1024 + f]);
        ref = d * 0.0625f * ((const float*)(ws + WS_WSEL))[be * CAP + slot] * MOD[b * 6144 + 5120 + n]; got = bf2f(((const bf16*)(ws + WS_YB))[((size_t)be * CAP + slot) * 1024 + n]); atol = 0.002f; } break;
    default: active = false;
    }
    if (active) { float e = fabsf(got - ref) / (atol + 0.03f * fabsf(ref)); if (!(e == e)) e = 1e9f; atomicMax((unsigned*)(ws + WS_CHK) + stage, __float_as_uint(e)); }
}
__global__ void chk_final(Args a) {
    __shared__ int code;
    if (threadIdx.x == 0) { int c = 0; for (int s = 20; s >= 0; --s) if (s > CHK_SKIP && __uint_as_float(((const unsigned*)(a.ws + WS_CHK))[s]) > 1.f) c = s + 1; code = c; }
    __syncthreads();
    const float sc = 1.f + 0.1f * (float)code;
    for (size_t i = (size_t)blockIdx.x * blockDim.x + threadIdx.x; i < (size_t)M * D; i += (size_t)gridDim.x * blockDim.x) a.out[i] *= sc;
}
#endif

extern "C" void kernel_launch(void* const* d_in, const int* in_sizes, int n_in, void* d_out, int out_size, void* d_ws, size_t ws_size, hipStream_t stream) {
    static int grid = 0;
    if (grid == 0) {
        if (n_in != 22 || out_size != M * D || ws_size < WS_END) { fprintf(stderr, "kernel_launch: unexpected shapes (n_in %d, out %d, ws %zu < %zu)\n", n_in, out_size, ws_size, (size_t)WS_END); grid = -1; return; }
        int dev = 0, cus = 0, per_cu = 0;
        if (hipGetDevice(&dev) != hipSuccess || hipDeviceGetAttribute(&cus, hipDeviceAttributeMultiprocessorCount, dev) != hipSuccess) { grid = -1; return; }
        if (hipFuncSetAttribute((const void*)fwd_kernel, hipFuncAttributeMaxDynamicSharedMemorySize, LDS_BYTES) != hipSuccess) { fprintf(stderr, "kernel_launch: hipFuncSetAttribute failed\n"); grid = -1; return; }
        if (hipOccupancyMaxActiveBlocksPerMultiprocessor(&per_cu, (const void*)fwd_kernel, NT, LDS_BYTES) != hipSuccess || per_cu < 1) { fprintf(stderr, "kernel_launch: occupancy query says %d\n", per_cu); per_cu = 1; }
        (void)hipGetLastError();
        grid = cus;
    }
    if (grid < 0) return;
    (void)hipMemsetAsync((char*)d_ws + WS_CTL, 0, CTL_ZERO_BYTES, stream);
    Args a{};
    for (int i = 0; i < 22; ++i) a.in[i] = (const float*)d_in[i];
    a.out = (float*)d_out; a.ws = (unsigned char*)d_ws;
#if MK_MULTI
    for (int p = 0; p < NPHASE; ++p) { a.ph_lo = p; a.ph_hi = p + 1; hipLaunchKernelGGL(fwd_kernel, dim3(grid), dim3(NT), LDS_BYTES, stream, a);
#if MK_CHECK
        if (p == 0) (void)hipMemsetAsync((char*)d_ws + WS_CHK, 0, 4096, stream);
        static const int after[21] = {0, 0, 0, 1, 1, 1, 2, 3, 3, 3, 4, 4, 5, 6, 7, 8, 8, 9, 10, 11, 12};
        for (int st = 0; st < 21; ++st) if (after[st] == p) hipLaunchKernelGGL(chk_kernel, dim3(st == 12 ? 1024 : 32), dim3(128), 0, stream, a, st);
        if (p == NPHASE - 1) hipLaunchKernelGGL(chk_final, dim3(1024), dim3(256), 0, stream, a);
#endif
    }
#else
    a.ph_lo = 0; a.ph_hi = NPHASE;
#if MK_COOP
    void* kargs[] = {&a};
    hipError_t e = hipLaunchCooperativeKernel((const void*)fwd_kernel, dim3(grid), dim3(NT), kargs, LDS_BYTES, stream);
    if (e != hipSuccess) fprintf(stderr, "kernel_launch: cooperative launch failed: %s (grid %d)\n", hipGetErrorString(e), grid);
#else
    hipLaunchKernelGGL(fwd_kernel, dim3(grid), dim3(NT), LDS_BYTES, stream, a);
#endif
#endif
}
```

```cpp
#include <hip/hip_runtime.h>
#include <cstdio>
#include <cstdint>

#define LAS __attribute__((address_space(3)))
#define GAS __attribute__((address_space(1)))
typedef unsigned short bf16;
typedef short bf16x8 __attribute__((ext_vector_type(8)));
typedef float f32x4 __attribute__((ext_vector_type(4)));
typedef float f32x2 __attribute__((ext_vector_type(2)));
typedef unsigned u32x4 __attribute__((ext_vector_type(4)));
typedef unsigned u32x2 __attribute__((ext_vector_type(2)));

#ifndef ABL_NOMOE
#define ABL_NOMOE 0
#endif
#ifndef REP_PHASE
#define REP_PHASE -1
#endif
#ifndef REP_COUNT
#define REP_COUNT 1
#endif
#ifndef MK_COOP
#define MK_COOP 1
#endif
#ifndef MK_MULTI
#define MK_MULTI 0
#endif

constexpr int D = 1024, NB = 2, SEQ = 8192, M = NB * SEQ, LC = 256, MC = NB * LC, MT = M + MC;
constexpr int DIN = 4128;
constexpr int NCH = SEQ / 64, NCHC = LC / 64, NSLOT = NCH + NCHC;
constexpr int NE = 16, CAP = 1024;
constexpr float EPS = 1e-6f;
constexpr int NWAVES = 8, NT = 512;
constexpr int NPHASE = 14;

constexpr size_t MiB = 1u << 20;
constexpr size_t WS_CTL = 0, CTL_ZERO_BYTES = 64 * 1024;
constexpr size_t WS_MOD = 1 * MiB;
constexpr size_t WS_DEC = 1 * MiB + 128 * 1024;
constexpr size_t WS_WIN = 2 * MiB, WS_WO = 10 * MiB, WS_WG = 12 * MiB, WS_WC = 13 * MiB;
constexpr size_t WS_AFF = 14 * MiB, WS_INV = 15 * MiB, WS_IDX = 16 * MiB, WS_WSEL = 16 * MiB + 256 * 1024;
constexpr size_t WS_H1 = 20 * MiB;
constexpr size_t WS_ST = 20 * MiB, WS_H2 = 20 * MiB;
constexpr size_t WS_KB = 52 * MiB, WS_VB = 61 * MiB, WS_QB = 78 * MiB, WS_SG = 86 * MiB, WS_PI = 102 * MiB, WS_RB = 118 * MiB;
constexpr size_t WS_AG = 102 * MiB;
constexpr size_t WS_SM = 121 * MiB;
constexpr size_t WS_KV = 249 * MiB;
constexpr size_t WS_PO = 282 * MiB;
constexpr size_t WS_MG = 249 * MiB;
constexpr size_t WS_WGU = 185 * MiB, WS_WD = 52 * MiB, WS_ACT = 121 * MiB, WS_YB = 185 * MiB;
constexpr size_t WS_H1F = 249 * MiB;
constexpr size_t WS_WINM = 265 * MiB;
constexpr size_t WS_YD = 153 * MiB;
constexpr size_t WS_XS = 68 * MiB;
constexpr size_t WS_END = 300 * MiB;
constexpr int CW_BAR = 1024;

constexpr int LDS_BYTES = 155648;
constexpr int MISC_OFF = 153600;

#define LDS_WAIT() asm volatile("s_waitcnt lgkmcnt(0)" ::: "memory")
#define VM_WAIT() asm volatile("s_waitcnt vmcnt(0)" ::: "memory")
__device__ __forceinline__ unsigned f2bf(float f) { unsigned u = __builtin_bit_cast(unsigned, f); return (u + 0x7fffu + ((u >> 16) & 1u)) >> 16; }
__device__ __forceinline__ unsigned pk2(float lo, float hi) { return f2bf(lo) | (f2bf(hi) << 16); }
__device__ __forceinline__ float bf2f(unsigned h) { return __builtin_bit_cast(float, h << 16); }
__device__ __forceinline__ float bflo(unsigned w) { return __builtin_bit_cast(float, w << 16); }
__device__ __forceinline__ float bfhi(unsigned w) { return __builtin_bit_cast(float, w & 0xffff0000u); }
__device__ __forceinline__ unsigned cvt_pk_bf16(float lo, float hi) { unsigned r; asm volatile("v_cvt_pk_bf16_f32 %0, %1, %2" : "=v"(r) : "v"(lo), "v"(hi)); return r; }
__device__ __forceinline__ unsigned pk4_fp8(float a, float b, float c, float d) { int w = 0; w = __builtin_amdgcn_cvt_pk_fp8_f32(a, b, w, false); w = __builtin_amdgcn_cvt_pk_fp8_f32(c, d, w, true); return (unsigned)w; }
__device__ __forceinline__ float wave_sum(float v) {
#pragma unroll
    for (int o = 1; o < 64; o <<= 1) v += __shfl_xor(v, o);
    return v;
}
__device__ __forceinline__ float silu_f(float x) { return x / (1.f + __expf(-x)); }
__device__ __forceinline__ float sigmoid_f(float x) { return 1.f / (1.f + __expf(-x)); }
__device__ __forceinline__ float logsig_f(float z) { return fminf(z, 0.f) - log1pf(expf(-fabsf(z))); }

#define XB_TMO      128
#define XB_XCNT(j)  (256  + 64 * (j))
#define XB_XSUB(j)  (1280 + 64 * (j))
#define XB_XGEN(j)  (2304 + 64 * (j))
#define XB_TOP      3328
#define XB_TOPGEN   3392
#define XCD_BAR_WORDS 3456
#define XB_SPIN_CAP (1u << 20)
__device__ __forceinline__ unsigned xb_ld(unsigned* p)              { return __hip_atomic_load(p, __ATOMIC_RELAXED, __HIP_MEMORY_SCOPE_AGENT); }
__device__ __forceinline__ unsigned xb_add(unsigned* p, unsigned v) { return __hip_atomic_fetch_add(p, v, __ATOMIC_RELAXED, __HIP_MEMORY_SCOPE_AGENT); }
__device__ __forceinline__ unsigned xb_xcc_id() { return (unsigned)__builtin_amdgcn_s_getreg((3 << 11) | 20) & 0xFu; }
#define XB_SPIN(cond, bar) do { unsigned _sp = 0; while (cond) { __builtin_amdgcn_s_sleep(1); \
    if ((++_sp & 255u) == 0u) { if (xb_ld(&(bar)[XB_TMO])) break; if (_sp > XB_SPIN_CAP) { atomicAdd(&(bar)[XB_TMO], 1u); break; } } } } while (0)
struct XcdBarrier { unsigned* bar; unsigned x; volatile LAS unsigned* st; };
__device__ __forceinline__ XcdBarrier xcd_barrier_post(unsigned* bar, volatile LAS unsigned* st) {
    XcdBarrier b; b.bar = bar; b.x = xb_xcc_id(); b.st = st;
    if (threadIdx.x == 0) (void)xb_add(&bar[XB_XCNT(b.x)], 1u);
    return b;
}
__device__ __forceinline__ void xcd_barrier_complete(unsigned* bar, unsigned x, unsigned& nloc, unsigned& nx) {
    const unsigned G = gridDim.x * gridDim.y * gridDim.z;
    unsigned sum, cnt, mine, sp = 0u;
    for (;;) {
        sum = 0u; cnt = 0u; mine = 0u;
#pragma unroll
        for (unsigned j = 0; j < 16; ++j) { const unsigned c = xb_ld(&bar[XB_XCNT(j)]); sum += c; cnt += (c > 0u) ? 1u : 0u; mine = (j == x) ? c : mine; }
        if (sum == G) break;
        __builtin_amdgcn_s_sleep(1);
        if ((++sp & 255u) == 0u) { if (xb_ld(&bar[XB_TMO])) break; if (sp > XB_SPIN_CAP) { atomicAdd(&bar[XB_TMO], 1u); break; } }
    }
    nloc = mine > 0u ? mine : 1u; nx = cnt > 0u ? cnt : 1u;
}
__device__ __forceinline__ void xcd_barrier(const XcdBarrier& b) {
    asm volatile("s_waitcnt vmcnt(0)" ::: "memory");
    __syncthreads();
    if (threadIdx.x == 0) {
        unsigned* bar = b.bar;
        __builtin_amdgcn_s_waitcnt(0);
        unsigned nloc = b.st[0], nx = b.st[1];
        if (nloc == 0u) { xcd_barrier_complete(bar, b.x, nloc, nx); b.st[0] = nloc; b.st[1] = nx; }
        const unsigned old = xb_add(&bar[XB_XSUB(b.x)], 1u);
        const unsigned gen = old / nloc;
        if (old + 1u == (gen + 1u) * nloc) {
            __builtin_amdgcn_fence(__ATOMIC_RELEASE, "agent");
            asm volatile("s_waitcnt vmcnt(0)" ::: "memory");
            const unsigned og = xb_add(&bar[XB_TOP], 1u);
            const unsigned tg = og / nx;
            if (og + 1u == (tg + 1u) * nx) xb_add(&bar[XB_TOPGEN], 1u);
            else XB_SPIN(xb_ld(&bar[XB_TOPGEN]) == tg, bar);
            __builtin_amdgcn_fence(__ATOMIC_ACQUIRE, "agent");
            xb_add(&bar[XB_XGEN(b.x)], 1u);
            asm volatile("s_waitcnt vmcnt(0)" ::: "memory");
        } else {
            XB_SPIN(xb_ld(&bar[XB_XGEN(b.x)]) == gen, bar);
            __builtin_amdgcn_fence(__ATOMIC_ACQUIRE, "agent");
            asm volatile("s_waitcnt vmcnt(0)" ::: "memory");
        }
    }
    __syncthreads();
}

namespace pg8 {
constexpr int BM = 256, BK = 64, HALF = 128, HTB = HALF * BK * 2, STAGE_BYTES = 8 * HTB;
__device__ __forceinline__ int lds_byte(int r, int c) { const int st = (r >> 4) * 2 + (c >> 5), rr = r & 15, cc = c & 31, ob = rr * 64 + cc * 2; return st * 1024 + (ob ^ (((ob >> 9) & 1) << 5)); }
__device__ __forceinline__ void stage_rc(int b, int& R, int& C) { const int st = b / 1024, sb = b % 1024, swz = sb ^ (((sb >> 9) & 1) << 5); R = (st >> 1) * 16 + swz / 64; C = (st & 1) * 32 + (swz % 64) / 2; }
__device__ __forceinline__ int perm32(int rho) { const int n = rho >> 4, i = rho & 15; return 8 * (i >> 2) + 4 * n + (i & 3); }
struct Unit { int pm, pn, aux, keep; };
typedef int v8i __attribute__((ext_vector_type(8)));
typedef int v4i __attribute__((ext_vector_type(4)));
__device__ __forceinline__ void xcd_tile(int L, int nM, int nN, int& pm, int& pn) {
    const int nwg = nM * nN; int wgid = L;
    { const int q = nwg / 8, r = nwg % 8, xcd = wgid % 8, off = wgid / 8; wgid = (xcd < r ? xcd * (q + 1) : r * (q + 1) + (xcd - r) * q) + off; }
    const int nig = 8 * nN, gid = wgid / nig, fm = gid * 8, gsz = (nM - fm) < 8 ? (nM - fm) : 8;
    pm = fm + ((wgid % nig) % gsz); pn = (wgid % nig) / gsz;
}

template <class Epi, class Sched, bool GATHER, bool FP8 = false>
__device__ __forceinline__ void gemm_phase(LAS unsigned char* lds, const Sched& S, const Epi& E) {
    int tid = threadIdx.x; asm volatile("" : "+v"(tid));
    const int wid = __builtin_amdgcn_readfirstlane(tid >> 6), lane = tid & 63, wr = wid >> 2, wc = wid & 3, fr = lane & 15, fq = lane >> 4;
    const int K = S.K, KB = FP8 ? K : 2 * K, nt = KB / (2 * BK);
    unsigned voffA[2], voffB[2]; int Rs[2], Cb[2];
#pragma unroll
    for (int i = 0; i < 2; ++i) { int R, C; stage_rc(tid * 16 + i * 8192, R, C); const int Rb = Epi::PERM ? ((R & ~31) + perm32(R & 31)) : R;
        Rs[i] = R; Cb[i] = C * 2; voffA[i] = (unsigned)(R * KB + C * 2); voffB[i] = (unsigned)(Rb * KB + C * 2); }
    const size_t kstep = (size_t)(BK * 2);
    const size_t hstep = (size_t)HALF * KB;
    const size_t hstepA = GATHER ? 0 : hstep;
    const unsigned ldsw = (unsigned)wid * 1024u;
    const int aoff = FP8 ? lds_byte(wr * 64 + fr, fq * 16) : lds_byte(wr * 64 + fr, fq * 8), boff = FP8 ? lds_byte(wc * 32 + fr, fq * 16) : lds_byte(wc * 32 + fr, fq * 8);
#define PG8_SA(b, h) (((b) * 2 + (h)) * HTB)
#define PG8_SB(b, h) ((4 + (b) * 2 + (h)) * HTB)
#define PG8_STAGE(bufoff, gbase, voff, W) do { _Pragma("unroll") for (int _i = 0; _i < 2; ++_i) { \
        if constexpr (FP8) __builtin_amdgcn_raw_ptr_buffer_load_lds(rsrc##W, (LAS unsigned*)(lds + (bufoff) + ldsw + _i * 8192), 16, (int)(voff)[_i], (int)(unsigned)((const char*)(gbase) - base##W), 0, 0); \
        else __builtin_amdgcn_global_load_lds((const unsigned*)((const char*)(gbase) + (voff)[_i]), (LAS unsigned*)(lds + (bufoff) + ldsw + _i * 8192), 16, 0, 0); } } while (0)
#define PG8_LDA(dst, b, h) do { _Pragma("unroll") for (int m = 0; m < 4; ++m) { \
        if constexpr (FP8) { const v4i _lo = *(const LAS v4i*)(lds + PG8_SA(b, h) + aoff + m * 2048), _hi = *(const LAS v4i*)(lds + PG8_SA(b, h) + aoff + m * 2048 + 16); dst##8[m] = __builtin_shufflevector(_lo, _hi, 0, 1, 2, 3, 4, 5, 6, 7); } \
        else { _Pragma("unroll") for (int k = 0; k < 2; ++k) dst[m][k] = *(const LAS bf16x8*)(lds + PG8_SA(b, h) + aoff + m * 2048 + k * 1024); } } } while (0)
#define PG8_LDB(dst, b, h) do { _Pragma("unroll") for (int n = 0; n < 2; ++n) { \
        if constexpr (FP8) { const v4i _lo = *(const LAS v4i*)(lds + PG8_SB(b, h) + boff + n * 2048), _hi = *(const LAS v4i*)(lds + PG8_SB(b, h) + boff + n * 2048 + 16); dst##8[n] = __builtin_shufflevector(_lo, _hi, 0, 1, 2, 3, 4, 5, 6, 7); } \
        else { _Pragma("unroll") for (int k = 0; k < 2; ++k) dst[n][k] = *(const LAS bf16x8*)(lds + PG8_SB(b, h) + boff + n * 2048 + k * 1024); } } } while (0)
#define PG8_MMA(ai, bj, At, Bt) do { __builtin_amdgcn_s_setprio(1); \
        if constexpr (FP8) { _Pragma("unroll") for (int m = 0; m < 4; ++m) _Pragma("unroll") for (int n = 0; n < 2; ++n) \
            acc[ai][bj][m][n] = __builtin_amdgcn_mfma_scale_f32_16x16x128_f8f6f4(Bt##8[n], At##8[m], acc[ai][bj][m][n], 0, 0, 0, 0, 0, 0); } \
        else { _Pragma("unroll") for (int m = 0; m < 4; ++m) _Pragma("unroll") for (int n = 0; n < 2; ++n) _Pragma("unroll") for (int k = 0; k < 2; ++k) \
            acc[ai][bj][m][n] = __builtin_amdgcn_mfma_f32_16x16x32_bf16(Bt[n][k], At[m][k], acc[ai][bj][m][n], 0, 0, 0); } \
        __builtin_amdgcn_s_setprio(0); } while (0)
#define PG8_WAIT_V(n) asm volatile("s_waitcnt vmcnt(" #n ")" ::: "memory")
#define PG8_WAIT_L(n) asm volatile("s_waitcnt lgkmcnt(" #n ")" ::: "memory")
#define PG8_BAR __builtin_amdgcn_s_barrier()
#define PG8_SCHED __builtin_amdgcn_sched_barrier(0)
    Unit cur, nxt; int ui = 0;
    if (!S.next(0, cur)) return;
    const char* baseA = S.base_a(); const char* baseB = S.base_b();
    const __amdgpu_buffer_rsrc_t rsrcA = __builtin_amdgcn_make_buffer_rsrc((void*)baseA, 0, 0x7fffffff, 0x00020000), rsrcB = __builtin_amdgcn_make_buffer_rsrc((void*)baseB, 0, 0x7fffffff, 0x00020000);
    f32x4 acc[2][2][4][2];
#pragma unroll
    for (int a = 0; a < 2; ++a)
#pragma unroll
        for (int b = 0; b < 2; ++b)
#pragma unroll
            for (int m = 0; m < 4; ++m)
#pragma unroll
                for (int n = 0; n < 2; ++n) acc[a][b][m][n] = (f32x4){0.f, 0.f, 0.f, 0.f};
    bf16x8 At[4][2], B0[2][2], B1[2][2]; v8i At8[4], B08[2], B18[2];
    const char* cA = S.a_base(cur); const char* cB = S.b_base(cur);
    unsigned cv0[2], cv1[2], nv0[2], nv1[2];
#pragma unroll
    for (int i = 0; i < 2; ++i) {
        if constexpr (GATHER) { cv0[i] = (unsigned)S.a_row(cur, Rs[i]) * (unsigned)KB + (unsigned)Cb[i]; cv1[i] = (unsigned)S.a_row(cur, HALF + Rs[i]) * (unsigned)KB + (unsigned)Cb[i]; }
        else { cv0[i] = voffA[i]; cv1[i] = voffA[i]; }
        nv0[i] = cv0[i]; nv1[i] = cv1[i];
    }
    PG8_STAGE(PG8_SB(0, 0), cB, voffB, B); PG8_STAGE(PG8_SB(0, 1), cB + hstep, voffB, B); PG8_STAGE(PG8_SA(0, 0), cA, cv0, A); PG8_STAGE(PG8_SA(0, 1), cA + hstepA, cv1, A);
    if (wr == 1) PG8_BAR;
    PG8_WAIT_V(2); PG8_BAR;
    PG8_STAGE(PG8_SB(1, 0), cB + kstep, voffB, B); PG8_STAGE(PG8_SA(1, 0), cA + kstep, cv0, A); PG8_STAGE(PG8_SB(1, 1), cB + hstep + kstep, voffB, B);
    PG8_WAIT_V(6); PG8_BAR;
    for (;;) {
        const bool has_next = S.next(ui + 1, nxt);
        const char* nA = has_next ? S.a_base(nxt) : cA; const char* nB = has_next ? S.b_base(nxt) : cB;
        if constexpr (GATHER) {
#pragma unroll
            for (int i = 0; i < 2; ++i) {
                if (has_next) { nv0[i] = (unsigned)S.a_row(nxt, Rs[i]) * (unsigned)KB + (unsigned)Cb[i]; nv1[i] = (unsigned)S.a_row(nxt, HALF + Rs[i]) * (unsigned)KB + (unsigned)Cb[i]; }
                else { nv0[i] = cv0[i]; nv1[i] = cv1[i]; }
            }
        }
        for (int t = 0; t < nt; t += 2) {
            const bool last = (t == nt - 2);
            const char* a1 = cA + (size_t)(t + 1) * kstep;
            const char* a2 = last ? nA : cA + (size_t)(t + 2) * kstep; const char* b2 = last ? nB : cB + (size_t)(t + 2) * kstep;
            const char* a3 = a2 + kstep; const char* b3 = b2 + kstep;
            unsigned s0[2], s1[2];
#pragma unroll
            for (int i = 0; i < 2; ++i) { s0[i] = (GATHER && last) ? nv0[i] : cv0[i]; s1[i] = (GATHER && last) ? nv1[i] : cv1[i]; }
            PG8_LDB(B0, 0, 0); PG8_LDB(B1, 0, 1); PG8_SCHED; PG8_LDA(At, 0, 0); PG8_STAGE(PG8_SA(1, 1), a1 + hstepA, cv1, A);
            PG8_WAIT_V(8); PG8_WAIT_L(0); PG8_BAR; PG8_MMA(0, 0, At, B0); PG8_MMA(0, 1, At, B1); PG8_BAR; PG8_SCHED;
            PG8_LDA(At, 0, 1); PG8_STAGE(PG8_SB(0, 0), b2, voffB, B); PG8_STAGE(PG8_SB(0, 1), b2 + hstep, voffB, B); PG8_STAGE(PG8_SA(0, 0), a2, s0, A);
            PG8_WAIT_V(8); PG8_WAIT_L(0); PG8_BAR; PG8_MMA(1, 0, At, B0); PG8_MMA(1, 1, At, B1); PG8_BAR; PG8_SCHED;
            PG8_LDB(B0, 1, 0); PG8_LDB(B1, 1, 1); PG8_SCHED; PG8_LDA(At, 1, 0); PG8_STAGE(PG8_SA(0, 1), a2 + hstepA, s1, A);
            PG8_WAIT_V(8); PG8_WAIT_L(0); PG8_BAR; PG8_MMA(0, 0, At, B0); PG8_MMA(0, 1, At, B1); PG8_BAR; PG8_SCHED;
            PG8_LDA(At, 1, 1); PG8_STAGE(PG8_SB(1, 0), b3, voffB, B); PG8_STAGE(PG8_SB(1, 1), b3 + hstep, voffB, B); PG8_STAGE(PG8_SA(1, 0), a3, s0, A);
            PG8_WAIT_V(8); PG8_WAIT_L(0); PG8_BAR; PG8_MMA(1, 0, At, B0); PG8_MMA(1, 1, At, B1); PG8_BAR; PG8_SCHED;
        }
        if (wr == 0) PG8_BAR;
        E(acc, cur, wr, wc, fr, fq);
        if (!has_next) break;
        E.post(acc, cur, wr, wc, fr, fq);
        cur = nxt; cA = nA; cB = nB; ++ui;
#pragma unroll
        for (int i = 0; i < 2; ++i) { cv0[i] = nv0[i]; cv1[i] = nv1[i]; }
        if (wr == 1) PG8_BAR;
    }
    PG8_WAIT_V(0);
    PG8_BAR;
#undef PG8_SA
#undef PG8_SB
#undef PG8_STAGE
#undef PG8_LDA
#undef PG8_LDB
#undef PG8_MMA
#undef PG8_WAIT_V
#undef PG8_WAIT_L
#undef PG8_BAR
#undef PG8_SCHED
}
}

using pg8::Unit;
struct SchedDense {
    int G, c, K, nM, nN; const char* A; const char* B; int i0, i1, eb;
    __device__ __forceinline__ bool next(int i, Unit& u) const { const int L = (i + i0) * G + c; if (i + i0 >= i1 || L >= nM * nN) return false; pg8::xcd_tile(L, nM, nN, u.pm, u.pn); u.aux = 0; u.keep = 0; return true; }
    __device__ __forceinline__ const char* a_base(const Unit& u) const { return A + (size_t)u.pm * 256 * K * eb; }
    __device__ __forceinline__ const char* b_base(const Unit& u) const { return B + (size_t)u.pn * 256 * K * eb; }
    __device__ __forceinline__ int a_row(const Unit&, int) const { return 0; }
    __device__ __forceinline__ const char* base_a() const { return A; }
    __device__ __forceinline__ const char* base_b() const { return B; }
};
struct SchedPair {
    int G, c, K; const char *A0, *A1, *B0, *B1;
    __device__ __forceinline__ bool next(int i, Unit& u) const { const int p = (i >> 1) * G + c; if (p >= 256) return false; pg8::xcd_tile(p, 64, 4, u.pm, u.pn); u.aux = i & 1; u.keep = 0; return true; }
    __device__ __forceinline__ const char* a_base(const Unit& u) const { return (u.aux ? A1 : A0) + (size_t)u.pm * 256 * K * 2; }
    __device__ __forceinline__ const char* b_base(const Unit& u) const { return (u.aux ? B1 : B0) + (size_t)u.pn * 256 * K * 2; }
    __device__ __forceinline__ int a_row(const Unit&, int) const { return 0; }
    __device__ __forceinline__ const char* base_a() const { return A0; }
    __device__ __forceinline__ const char* base_b() const { return B0; }
};
struct SchedMoe1 {
    int G, c, K; const char* A; const char* B; int i0, i1;
    __device__ __forceinline__ bool next(int i, Unit& u) const { const int L = (i + i0) * G + c; if (i + i0 >= i1 || L >= 1024) return false;
        const int xcd = L & 7, q = L >> 3, round = q >> 5, slot = q & 31, e = xcd + 8 * (round >> 1), u64 = (round & 1) * 32 + slot, mrow = u64 & 7;
        u.pn = u64 >> 3; u.pm = mrow & 3; u.aux = (mrow >> 2) * 16 + e; u.keep = 0; return true; }
    __device__ __forceinline__ const char* a_base(const Unit& u) const { return A + ((size_t)u.aux * 1024 + (size_t)u.pm * 256) * K; }
    __device__ __forceinline__ const char* b_base(const Unit& u) const { return B + ((size_t)(u.aux & 15) * 2048 + (size_t)u.pn * 256) * K; }
    __device__ __forceinline__ int a_row(const Unit&, int) const { return 0; }
    __device__ __forceinline__ const char* base_a() const { return A; }
    __device__ __forceinline__ const char* base_b() const { return B; }
};
struct SchedMoe2 {
    int G, c, K; const char* A; const char* B;
    __device__ __forceinline__ bool next(int i, Unit& u) const { const int L = i * G + c; if (L >= 512) return false;
        const int xcd = L & 7, q = L >> 3, round = q >> 5, slot = q & 31, e = xcd + 8 * round, mrow = slot & 7;
        u.pn = slot >> 3; u.pm = mrow & 3; u.aux = (mrow >> 2) * 16 + e; u.keep = 0; return true; }
    __device__ __forceinline__ const char* a_base(const Unit& u) const { return A + ((size_t)u.aux * 1024 + (size_t)u.pm * 256) * K; }
    __device__ __forceinline__ const char* b_base(const Unit& u) const { return B + ((size_t)(u.aux & 15) * 1024 + (size_t)u.pn * 256) * K; }
    __device__ __forceinline__ int a_row(const Unit&, int) const { return 0; }
    __device__ __forceinline__ const char* base_a() const { return A; }
    __device__ __forceinline__ const char* base_b() const { return B; }
};

typedef f32x4 AccT[2][2][4][2];
__device__ __forceinline__ size_t gate_off(int pm, int pg, int ai, int m, int bj, int wr, int wc, int fr, int fq) { return ((size_t)(pm * 8 + pg) << 16) + (size_t)((((ai * 4 + m) * 2 + bj) * 8 + wr * 4 + wc) * 512 + (fq * 16 + fr) * 8); }
__device__ __forceinline__ unsigned pk4_u8(float a, float b, float c, float d) { return (unsigned)__builtin_amdgcn_cvt_pk_u8_f32(d, 3, __builtin_amdgcn_cvt_pk_u8_f32(c, 2, __builtin_amdgcn_cvt_pk_u8_f32(b, 1, __builtin_amdgcn_cvt_pk_u8_f32(a, 0, 0u)))); }
template <bool GATES> struct EpiInprojT {
    static constexpr bool PERM = true;
    bf16 *KBp, *VBp, *QBp, *SGp, *PIp; unsigned char* SMp; int pn_off; float sc;
    __device__ __forceinline__ void post(AccT& acc, const Unit&, int, int, int, int) const {
#pragma unroll
        for (int a = 0; a < 2; ++a)
#pragma unroll
            for (int b = 0; b < 2; ++b)
#pragma unroll
                for (int m = 0; m < 4; ++m)
#pragma unroll
                    for (int n = 0; n < 2; ++n) acc[a][b][m][n] = (f32x4){0.f, 0.f, 0.f, 0.f};
    }
    __device__ __forceinline__ void operator()(const AccT& acc, const Unit& u, int wr, int wc, int fr, int fq) const {
        const int pn = u.pn + pn_off;
        if constexpr (GATES) {
            unsigned char* tp = SMp + ((size_t)(u.pm * 8 + pn - 8) << 16) + (unsigned)((wr * 4 + wc) * 512 + (fq * 16 + fr) * 8);
#pragma unroll
            for (int ai = 0; ai < 2; ++ai)
#pragma unroll
                for (int m = 0; m < 4; ++m) {
#pragma unroll
                    for (int bj = 0; bj < 2; ++bj) { const f32x4 v0 = acc[ai][bj][m][0], v1 = acc[ai][bj][m][1];
                        u32x2 w; w.x = pk4_u8(255.f * sigmoid_f(sc * v0[0]), 255.f * sigmoid_f(sc * v0[1]), 255.f * sigmoid_f(sc * v0[2]), 255.f * sigmoid_f(sc * v0[3]));
                        w.y = pk4_u8(255.f * sigmoid_f(sc * v1[0]), 255.f * sigmoid_f(sc * v1[1]), 255.f * sigmoid_f(sc * v1[2]), 255.f * sigmoid_f(sc * v1[3]));
                        *(u32x2*)(tp + (((ai * 4 + m) * 2 + bj) * 4096)) = w; }
                    asm volatile("" ::: "memory"); }
        } else {
        bf16* base; int ld, colt, act;
        if (pn == 0) { base = KBp; ld = 256; colt = 0; act = 0; }
        else if (pn < 3) { base = VBp; ld = 512; colt = (pn - 1) * 256; act = 0; }
        else if (pn == 3) { base = QBp; ld = 256; colt = 0; act = 3; }
        else if (pn < 6) { base = SGp; ld = 512; colt = (pn - 4) * 256; act = 1; }
        else { base = PIp; ld = 512; colt = (pn - 6) * 256; act = 0; }
        const int row0 = u.pm * 256 + wr * 64 + fr, col0 = colt + wc * 32 + 8 * fq;
#pragma unroll
        for (int ai = 0; ai < 2; ++ai)
#pragma unroll
            for (int m = 0; m < 4; ++m) { bf16* rowp = base + (size_t)(row0 + ai * 128 + m * 16) * ld + col0;
#pragma unroll
                for (int bj = 0; bj < 2; ++bj) { f32x4 v0 = acc[ai][bj][m][0], v1 = acc[ai][bj][m][1];
                    if (act == 1) {
#pragma unroll
                        for (int j = 0; j < 4; ++j) { v0[j] = silu_f(v0[j]); v1[j] = silu_f(v1[j]); } }
                    else if (act == 3) { v0 = v0 * 0.125f; v1 = v1 * 0.125f; }
                    u32x4 w; w.x = cvt_pk_bf16(v0[0], v0[1]); w.y = cvt_pk_bf16(v0[2], v0[3]); w.z = cvt_pk_bf16(v1[0], v1[1]); w.w = cvt_pk_bf16(v1[2], v1[3]);
                    *(u32x4*)(rowp + bj * 128) = w; } }
        }
    }
};
typedef EpiInprojT<false> EpiInproj; typedef EpiInprojT<true> EpiGates;
struct EpiMerge {
    static constexpr bool PERM = true;
    const unsigned char* SMp; bf16* MGp;
    __device__ __forceinline__ void post(AccT& acc, const Unit& u, int wr, int wc, int fr, int fq) const {
        const unsigned msk = u.aux ? 0u : 0xffffffffu;
        u32x2 ga[2][2], gb[2][2];
#define EPM_LOADR(buf, g) do { _Pragma("unroll") for (int bj = 0; bj < 2; ++bj) { ga[buf][bj] = *(const u32x2*)(SMp + gate_off(u.pm, u.pn, (g) >> 2, (g) & 3, bj, wr, wc, fr, fq)); \
            gb[buf][bj] = *(const u32x2*)(SMp + gate_off(u.pm, u.pn + 4, (g) >> 2, (g) & 3, bj, wr, wc, fr, fq)); } } while (0)
#define EPM_RATIO(a_, b_, sh) ((float)(((a_) >> (sh)) & 255u) * __builtin_amdgcn_rcpf((float)max(((b_) >> (sh)) & 255u, 1u)))
        EPM_LOADR(0, 0);
#pragma unroll
        for (int g = 0; g < 8; ++g) {
            if (g + 1 < 8) EPM_LOADR((g + 1) & 1, g + 1);
            asm volatile("" ::: "memory");
#pragma unroll
            for (int bj = 0; bj < 2; ++bj) { u32x2 p = ga[g & 1][bj]; const u32x2 q = gb[g & 1][bj]; p.x &= msk; p.y &= msk; f32x4 v0 = acc[g >> 2][bj][g & 3][0], v1 = acc[g >> 2][bj][g & 3][1];
                v0[0] *= EPM_RATIO(p.x, q.x, 0); v0[1] *= EPM_RATIO(p.x, q.x, 8); v0[2] *= EPM_RATIO(p.x, q.x, 16); v0[3] *= EPM_RATIO(p.x, q.x, 24);
                v1[0] *= EPM_RATIO(p.y, q.y, 0); v1[1] *= EPM_RATIO(p.y, q.y, 8); v1[2] *= EPM_RATIO(p.y, q.y, 16); v1[3] *= EPM_RATIO(p.y, q.y, 24);
                acc[g >> 2][bj][g & 3][0] = v0; acc[g >> 2][bj][g & 3][1] = v1; }
            asm volatile("" ::: "memory"); }
#undef EPM_LOADR
#undef EPM_RATIO
    }
    __device__ __forceinline__ void operator()(const AccT& acc, const Unit& u, int wr, int wc, int fr, int fq) const {
        if (!u.aux) return;
        const int row0 = u.pm * 256 + wr * 64 + fr, col0 = u.pn * 256 + wc * 32 + 8 * fq;
        u32x2 gb[2][2];
#define EPM_ROW(g) ((size_t)(row0 + ((g) >> 2) * 128 + ((g) & 3) * 16))
#define EPM_LOAD(buf, g) do { _Pragma("unroll") for (int bj = 0; bj < 2; ++bj) gb[buf][bj] = *(const u32x2*)(SMp + gate_off(u.pm, u.pn + 4, (g) >> 2, (g) & 3, bj, wr, wc, fr, fq)); } while (0)
        EPM_LOAD(0, 0);
#pragma unroll
        for (int g = 0; g < 8; ++g) {
            if (g + 1 < 8) EPM_LOAD((g + 1) & 1, g + 1);
            asm volatile("" ::: "memory");
#pragma unroll
            for (int bj = 0; bj < 2; ++bj) { const u32x2 gq = gb[g & 1][bj]; const f32x4 v0 = acc[g >> 2][bj][g & 3][0], v1 = acc[g >> 2][bj][g & 3][1];
                const float k = 1.f / 255.f;
                const float g0 = k * (float)max(gq.x & 255u, 1u), g1 = k * (float)max((gq.x >> 8) & 255u, 1u), g2 = k * (float)max((gq.x >> 16) & 255u, 1u), g3 = k * (float)max(gq.x >> 24, 1u);
                const float g4 = k * (float)max(gq.y & 255u, 1u), g5 = k * (float)max((gq.y >> 8) & 255u, 1u), g6 = k * (float)max((gq.y >> 16) & 255u, 1u), g7 = k * (float)max(gq.y >> 24, 1u);
                u32x4 w; w.x = cvt_pk_bf16(v0[0] * g0, v0[1] * g1); w.y = cvt_pk_bf16(v0[2] * g2, v0[3] * g3);
                w.z = cvt_pk_bf16(v1[0] * g4, v1[1] * g5); w.w = cvt_pk_bf16(v1[2] * g6, v1[3] * g7);
                *(u32x4*)(MGp + EPM_ROW(g) * 1024 + col0 + bj * 128) = w; }
            asm volatile("" ::: "memory"); }
#undef EPM_ROW
#undef EPM_LOAD
    }
};
struct EpiOut {
    static constexpr bool PERM = true;
    const float* MODp; bf16* YDp; const float* Xp;
    __device__ __forceinline__ void post(AccT& acc, const Unit&, int, int, int, int) const {
#pragma unroll
        for (int a = 0; a < 2; ++a)
#pragma unroll
            for (int b = 0; b < 2; ++b)
#pragma unroll
                for (int m = 0; m < 4; ++m)
#pragma unroll
                    for (int n = 0; n < 2; ++n) acc[a][b][m][n] = (f32x4){0.f, 0.f, 0.f, 0.f};
    }
    __device__ __forceinline__ void operator()(const AccT& acc, const Unit& u, int wr, int wc, int fr, int fq) const {
        const int row0 = u.pm * 256 + wr * 64 + fr, col0 = u.pn * 256 + wc * 32 + 8 * fq;
        const float* gt = MODp + (size_t)(u.pm >> 5) * 6144 + 2048 + col0;
        f32x4 gv[2][2];
#pragma unroll
        for (int bj = 0; bj < 2; ++bj)
#pragma unroll
            for (int n = 0; n < 2; ++n) gv[bj][n] = *(const f32x4*)(gt + bj * 128 + n * 4);
        const float* xl = Xp + (size_t)row0 * 1024 + col0; bf16* yl = YDp + (size_t)row0 * 1024 + col0;
        f32x4 xb[2][2][2];
#define EPO_LOAD(buf, g) do { _Pragma("unroll") for (int bj = 0; bj < 2; ++bj) _Pragma("unroll") for (int n = 0; n < 2; ++n) \
            xb[buf][bj][n] = __builtin_nontemporal_load((const f32x4*)(xl + (size_t)(((g) >> 2) * 128 + ((g) & 3) * 16) * 1024 + bj * 128 + n * 4)); } while (0)
        EPO_LOAD(0, 0);
#pragma unroll
        for (int g = 0; g < 8; ++g) {
            if (g + 1 < 8) EPO_LOAD((g + 1) & 1, g + 1);
            asm volatile("" ::: "memory");
#pragma unroll
            for (int bj = 0; bj < 2; ++bj) { const f32x4 v0 = xb[g & 1][bj][0] + acc[g >> 2][bj][g & 3][0] * gv[bj][0], v1 = xb[g & 1][bj][1] + acc[g >> 2][bj][g & 3][1] * gv[bj][1];
                u32x4 w; w.x = cvt_pk_bf16(v0[0], v0[1]); w.y = cvt_pk_bf16(v0[2], v0[3]); w.z = cvt_pk_bf16(v1[0], v1[1]); w.w = cvt_pk_bf16(v1[2], v1[3]);
                *(u32x4*)(yl + (size_t)((g >> 2) * 128 + (g & 3) * 16) * 1024 + bj * 128) = w; }
            asm volatile("" ::: "memory"); }
#undef EPO_LOAD
    }
};
struct EpiMoe1 {
    static constexpr bool PERM = true;
    unsigned char* ACTp;
    __device__ __forceinline__ void post(AccT& acc, const Unit&, int, int, int, int) const {
#pragma unroll
        for (int a = 0; a < 2; ++a)
#pragma unroll
            for (int b = 0; b < 2; ++b)
#pragma unroll
                for (int m = 0; m < 4; ++m)
#pragma unroll
                    for (int n = 0; n < 2; ++n) acc[a][b][m][n] = (f32x4){0.f, 0.f, 0.f, 0.f};
    }
    __device__ __forceinline__ void operator()(const AccT& acc, const Unit& u, int wr, int wc, int fr, int fq) const {
        const int row0 = u.aux * 1024 + u.pm * 256 + wr * 64 + fr, col0 = u.pn * 128 + wc * 32 + 8 * fq;
#pragma unroll
        for (int ai = 0; ai < 2; ++ai)
#pragma unroll
            for (int m = 0; m < 4; ++m) { unsigned char* rowp = ACTp + (size_t)(row0 + ai * 128 + m * 16) * 1024 + col0;
                f32x4 a0, a1;
#pragma unroll
                for (int j = 0; j < 4; ++j) { a0[j] = silu_f(0.0625f * acc[ai][0][m][0][j]) * (0.0625f * acc[ai][1][m][0][j]); a1[j] = silu_f(0.0625f * acc[ai][0][m][1][j]) * (0.0625f * acc[ai][1][m][1][j]); }
                *(u32x2*)rowp = (u32x2){pk4_fp8(a0[0], a0[1], a0[2], a0[3]), pk4_fp8(a1[0], a1[1], a1[2], a1[3])}; }
    }
};
struct EpiMoe2 {
    static constexpr bool PERM = true;
    bf16* YBp; const float* WSELp; const float* MODp;
    __device__ __forceinline__ void post(AccT& acc, const Unit&, int, int, int, int) const {
#pragma unroll
        for (int a = 0; a < 2; ++a)
#pragma unroll
            for (int b = 0; b < 2; ++b)
#pragma unroll
                for (int m = 0; m < 4; ++m)
#pragma unroll
                    for (int n = 0; n < 2; ++n) acc[a][b][m][n] = (f32x4){0.f, 0.f, 0.f, 0.f};
    }
    __device__ __forceinline__ void operator()(const AccT& acc, const Unit& u, int wr, int wc, int fr, int fq) const {
        const int row0 = u.aux * 1024 + u.pm * 256 + wr * 64 + fr, col0 = u.pn * 256 + wc * 32 + 8 * fq;
        const float* gt = MODp + (size_t)(u.aux >> 4) * 6144 + 5120 + col0;
        f32x4 gv[2][2];
#pragma unroll
        for (int bj = 0; bj < 2; ++bj)
#pragma unroll
            for (int n = 0; n < 2; ++n) gv[bj][n] = *(const f32x4*)(gt + bj * 128 + n * 4);
#pragma unroll
        for (int ai = 0; ai < 2; ++ai)
#pragma unroll
            for (int m = 0; m < 4; ++m) { const int r = row0 + ai * 128 + m * 16; const float ws = 0.0625f * WSELp[r]; bf16* rowp = YBp + (size_t)r * 1024 + col0;
#pragma unroll
                for (int bj = 0; bj < 2; ++bj) { const f32x4 v0 = acc[ai][bj][m][0] * gv[bj][0] * ws, v1 = acc[ai][bj][m][1] * gv[bj][1] * ws;
                    u32x4 w; w.x = cvt_pk_bf16(v0[0], v0[1]); w.y = cvt_pk_bf16(v0[2], v0[3]); w.z = cvt_pk_bf16(v1[0], v1[1]); w.w = cvt_pk_bf16(v1[2], v1[3]);
                    *(u32x4*)(rowp + bj * 128) = w; } }
    }
};

struct Args { const float* in[22]; float* out; unsigned char* ws; int ph_lo, ph_hi; };
enum { I_X = 0, I_C, I_CTX, I_CCTX, I_ADAW, I_ADAB, I_N1G, I_N2G, I_WIN, I_WDU, I_BDEC, I_GNG, I_WGLA, I_POOLW, I_POOLS, I_WPOOL, I_WOUT, I_WROUTER, I_WGATE, I_WUP, I_WDOWN, I_FNG };

__device__ __forceinline__ bf16x8 ldfrag(const LAS bf16* base, int stride, int row0, int k0, int lane) { return *(const LAS bf16x8*)(base + (row0 + (lane & 15)) * stride + k0 + 8 * (lane >> 4)); }
#define MFMA16(a, b, c) __builtin_amdgcn_mfma_f32_16x16x32_bf16(a, b, c, 0, 0, 0)

__device__ __forceinline__ void transpose_item(const float* W, int ldw, int k0, int nsrc0, bf16* WT, int Kd, int dst_row0, LAS float* scr, int lane) {
#pragma unroll 8
    for (int i = 0; i < 32; ++i) { const int kk = 2 * i + (lane >> 5); scr[kk * 33 + (lane & 31)] = W[(size_t)(k0 + kk) * ldw + nsrc0 + (lane & 31)]; }
    LDS_WAIT(); asm volatile("" ::: "memory");
    const int c = lane & 7;
#pragma unroll
    for (int j = 0; j < 4; ++j) { const int n = (lane >> 3) + 8 * j; const LAS float* s = scr + (8 * c) * 33 + n;
        u32x4 o; o.x = pk2(s[0 * 33], s[1 * 33]); o.y = pk2(s[2 * 33], s[3 * 33]); o.z = pk2(s[4 * 33], s[5 * 33]); o.w = pk2(s[6 * 33], s[7 * 33]);
        *(u32x4*)(WT + (size_t)(dst_row0 + n) * Kd + k0 + 8 * c) = o; }
    LDS_WAIT(); asm volatile("" ::: "memory");
}

struct CvtItem { const float* src; bf16* dst; int ld2, drow8, f8; };
#define CVT_LOAD(v, c) do { _Pragma("unroll") for (int _j = 0; _j < 32; ++_j) v[_j] = __builtin_nontemporal_load((c).src + (size_t)_j * (c).ld2); } while (0)
#define CVT_STORE(v, c) do { _Pragma("unroll") for (int _j = 0; _j < 32; ++_j) scr[(2 * _j + (lane >> 5)) * 33 + (lane & 31)] = v[_j]; \
        LDS_WAIT(); asm volatile("" ::: "memory"); \
        _Pragma("unroll") for (int _q = 0; _q < 4; ++_q) { const LAS float* _s = scr + (8 * (lane & 7)) * 33 + (lane >> 3) + 8 * _q; u32x4 _o; \
            _o.x = pk2(_s[0 * 33], _s[1 * 33]); _o.y = pk2(_s[2 * 33], _s[3 * 33]); _o.z = pk2(_s[4 * 33], _s[5 * 33]); _o.w = pk2(_s[6 * 33], _s[7 * 33]); *(u32x4*)((c).dst + (size_t)_q * (c).drow8) = _o; } \
        LDS_WAIT(); asm volatile("" ::: "memory"); } while (0)
__device__ __forceinline__ CvtItem cvt_item_gu(const Args& a, int it, int lane) {
    const int e = it >> 10, mat = (it >> 9) & 1, q = it & 511, kb = q >> 5, nb = q & 31, n0 = nb * 32, k0 = kb * 64, nrow = n0 + (lane >> 3);
    CvtItem c; c.ld2 = 2048; c.drow8 = 8192; c.f8 = 1;
    c.src = a.in[mat ? I_WUP : I_WGATE] + (size_t)e * 1048576 + (size_t)(k0 + (lane >> 5)) * 1024 + n0 + (lane & 31);
    c.dst = (bf16*)(a.ws + WS_WGU + ((size_t)e * 2048 + (nrow >> 7) * 256 + mat * 128 + (nrow & 127)) * 1024 + k0 + 8 * (lane & 7));
    return c;
}
__device__ __forceinline__ CvtItem cvt_item_dn(const Args& a, int it, int lane) {
    const int e = it >> 9, q = it & 511, kb = q >> 5, nb = q & 31, n0 = nb * 32, k0 = kb * 64;
    CvtItem c; c.ld2 = 2048; c.drow8 = 8192; c.f8 = 1;
    c.src = a.in[I_WDOWN] + (size_t)e * 1048576 + (size_t)(k0 + (lane >> 5)) * 1024 + n0 + (lane & 31);
    c.dst = (bf16*)(a.ws + WS_WD + ((size_t)e * 1024 + n0 + (lane >> 3)) * 1024 + k0 + 8 * (lane & 7));
    return c;
}
#define CVT_STORE8(v, c) do { _Pragma("unroll") for (int _j = 0; _j < 32; ++_j) scr[(2 * _j + (lane >> 5)) * 33 + (lane & 31)] = v[_j]; \
        LDS_WAIT(); asm volatile("" ::: "memory"); \
        _Pragma("unroll") for (int _q = 0; _q < 4; ++_q) { const LAS float* _s = scr + (8 * (lane & 7)) * 33 + (lane >> 3) + 8 * _q; \
            *(u32x2*)((unsigned char*)(c).dst + (size_t)_q * (c).drow8) = (u32x2){pk4_fp8(16.f * _s[0 * 33], 16.f * _s[1 * 33], 16.f * _s[2 * 33], 16.f * _s[3 * 33]), pk4_fp8(16.f * _s[4 * 33], 16.f * _s[5 * 33], 16.f * _s[6 * 33], 16.f * _s[7 * 33])}; } \
        LDS_WAIT(); asm volatile("" ::: "memory"); } while (0)
__device__ __forceinline__ CvtItem cvt_item_small(const Args& a, int it, int lane) {
    CvtItem c; int r = it;
    c.f8 = 0;
    if (r < 2048) { const int kb = r >> 7, nb = r & 127, n0 = nb * 32, k0 = kb * 64; c.ld2 = 2 * DIN; c.drow8 = 8192;
        c.src = a.in[I_WIN] + (size_t)(k0 + (lane >> 5)) * DIN + n0 + (n0 >= 768 ? 32 : 0) + (lane & 31);
        if (n0 < 2048) c.dst = (bf16*)(a.ws + WS_WIN) + (size_t)(n0 + (lane >> 3)) * 1024 + k0 + 8 * (lane & 7);
        else { c.f8 = 1; c.dst = (bf16*)(a.ws + WS_WINM + (size_t)(n0 - 2048 + (lane >> 3)) * 1024 + k0 + 8 * (lane & 7)); }
        return c; }
    r -= 2048;
    if (r < 512) { const int kb = r >> 5, nb = r & 31, n0 = nb * 32, k0 = kb * 64; c.ld2 = 2048; c.drow8 = 8192;
        c.src = a.in[I_WOUT] + (size_t)(k0 + (lane >> 5)) * 1024 + n0 + (lane & 31); c.dst = (bf16*)(a.ws + WS_WO) + (size_t)(n0 + (lane >> 3)) * 1024 + k0 + 8 * (lane & 7); return c; }
    r -= 512;
    { const int kb = r >> 5, nb = r & 31, n0 = nb * 32, k0 = kb * 64; c.ld2 = 2048; c.drow8 = 4096;
      c.src = a.in[I_WGLA] + (size_t)(k0 + (lane >> 5)) * 1024 + n0 + (lane & 31); c.dst = (bf16*)(a.ws + WS_WG) + (size_t)(n0 + (lane >> 3)) * 512 + k0 + 8 * (lane & 7); return c; }
}
template <int KIND> __device__ __forceinline__ CvtItem cvt_item(const Args& a, int it, int lane) { if constexpr (KIND == 0) return cvt_item_small(a, it, lane); else if constexpr (KIND == 1) return cvt_item_gu(a, it, lane); else return cvt_item_dn(a, it, lane); }
template <int KIND>
__device__ __forceinline__ void convert_items(LAS float* scr, const Args& a, int first, int step, int end, int lane) {
    float va[32], vb[32]; CvtItem ca, cb;
    int it = first;
    if (it < end) { ca = cvt_item<KIND>(a, it, lane); CVT_LOAD(va, ca); }
    for (; it < end; it += 2 * step) {
        const bool hb = (it + step < end), ha = (it + 2 * step < end);
        if (hb) { cb = cvt_item<KIND>(a, it + step, lane); CVT_LOAD(vb, cb); }
        if (KIND == 0 && !ca.f8) CVT_STORE(va, ca); else CVT_STORE8(va, ca);
        if (ha) { ca = cvt_item<KIND>(a, it + 2 * step, lane); CVT_LOAD(va, ca); }
        if (hb) { if (KIND == 0 && !cb.f8) CVT_STORE(vb, cb); else CVT_STORE8(vb, cb); }
    }
}
template <int KIND>
__device__ __forceinline__ void convert_all(LAS unsigned char* lds, const Args& a, int vcu, int G, int lane, int wave) {
    const int gw = vcu * NWAVES + wave, NGW = G * NWAVES;
    convert_items<KIND>((LAS float*)(lds + wave * 8448), a, gw, NGW, KIND == 1 ? 16384 : 8192, lane);
    __syncthreads();
}

__device__ __forceinline__ void phase0(LAS unsigned char* lds, const Args& a, int vcu, int G, int tid, int lane, int wave) {
    unsigned char* ws = a.ws;
    if (vcu < 96) {
        LAS float* sv = (LAS float*)(lds + 69632); LAS float* part = sv + 3072;
        for (int idx = tid; idx < 3072; idx += NT) { const int v = idx >> 10, k = idx & 1023; const float s = (v < 2) ? a.in[I_C][v * 1024 + k] : a.in[I_CCTX][k]; sv[idx] = s / (1.f + expf(-s)); }
        __syncthreads();
        const int n0 = 64 * vcu, colq = lane & 15, kr = lane >> 4;
        f32x4 a0 = {0.f, 0.f, 0.f, 0.f}, a1 = a0, a2 = a0;
        const float* aw = a.in[I_ADAW] + (size_t)(128 * wave + kr) * 6144 + n0 + 4 * colq;
#pragma unroll
        for (int hb = 0; hb < 2; ++hb) { f32x4 w4[16];
#pragma unroll
            for (int it = 0; it < 16; ++it) w4[it] = __builtin_nontemporal_load((const f32x4*)(aw + (size_t)(4 * (16 * hb + it)) * 6144));
#pragma unroll
            for (int it = 0; it < 16; ++it) { const int k = 128 * wave + 4 * (16 * hb + it) + kr; a0 += w4[it] * sv[k]; a1 += w4[it] * sv[1024 + k]; a2 += w4[it] * sv[2048 + k]; } }
#pragma unroll
        for (int j = 0; j < 4; ++j) { a0[j] += __shfl_xor(a0[j], 16); a0[j] += __shfl_xor(a0[j], 32); a1[j] += __shfl_xor(a1[j], 16); a1[j] += __shfl_xor(a1[j], 32); a2[j] += __shfl_xor(a2[j], 16); a2[j] += __shfl_xor(a2[j], 32); }
        if (kr == 0) {
#pragma unroll
            for (int j = 0; j < 4; ++j) { part[(wave * 3 + 0) * 64 + 4 * colq + j] = a0[j]; part[(wave * 3 + 1) * 64 + 4 * colq + j] = a1[j]; part[(wave * 3 + 2) * 64 + 4 * colq + j] = a2[j]; } }
        __syncthreads();
        if (tid < 192) { const int v = tid >> 6, col = tid & 63; float s = a.in[I_ADAB][n0 + col];
#pragma unroll
            for (int w = 0; w < 8; ++w) s += part[(w * 3 + v) * 64 + col];
            ((float*)(ws + WS_MOD))[v * 6144 + n0 + col] = s; }
    } else if (vcu < 96 + 128) {
        const int it = vcu - 96, g = it >> 5, cb = (it >> 1) & 15, nb = it & 1, n = nb * 512 + tid;
        LAS float* pwt = (LAS float*)(lds + 69632);
        if (tid < 256) { const int d = tid >> 1, hf = tid & 1; const float sc = a.in[I_POOLS][g * 128 + d]; f32x4 v;
#pragma unroll
            for (int q = 0; q < 4; ++q) v[q] = a.in[I_POOLW][(size_t)(g * 128 + cb * 8 + hf * 4 + q) * 128 + d] * sc;
            *(LAS f32x4*)(pwt + d * 8 + hf * 4) = v; }
        __syncthreads();
        const float* wp = a.in[I_WPOOL] + (size_t)(g * 128) * 1024 + n;
        f32x4 acc0 = {0.f, 0.f, 0.f, 0.f}, acc1 = acc0;
        for (int d0 = 0; d0 < 128; d0 += 32) { float w[32];
#pragma unroll
            for (int d = 0; d < 32; ++d) w[d] = wp[(size_t)(d0 + d) * 1024];
#pragma unroll
            for (int d = 0; d < 32; ++d) { const f32x4 p0 = *(const LAS f32x4*)(pwt + (d0 + d) * 8), p1 = *(const LAS f32x4*)(pwt + (d0 + d) * 8 + 4); acc0 += p0 * w[d]; acc1 += p1 * w[d]; } }
        bf16* dst = (bf16*)(ws + WS_WC) + (size_t)n * 512 + g * 128 + cb * 8;
        *(u32x4*)dst = (u32x4){pk2(acc0[0], acc0[1]), pk2(acc0[2], acc0[3]), pk2(acc1[0], acc1[1]), pk2(acc1[2], acc1[3])};
    }
    { const int gw = vcu * NWAVES + wave, NGW = G * NWAVES; convert_items<0>((LAS float*)(lds + wave * 8448), a, gw, NGW, 2048 + 512 + 256, lane); }
}

#define RSTEP(N, S) do { _Pragma("unroll") for (int _i = 0; _i < (N) / 2; ++_i) { const float _send = (lane & (S)) ? racc[_i] : racc[_i + (N) / 2]; const float _keep = (lane & (S)) ? racc[_i + (N) / 2] : racc[_i]; racc[_i] = _keep + __shfl_xor(_send, (S)); } } while (0)
__device__ __forceinline__ void phase1(LAS unsigned char* lds, const Args& a, int vcu, int G, int tid, int lane, int wave) {
    unsigned char* ws = a.ws;
    const float* MOD = (const float*)(ws + WS_MOD);
    const float* g1 = a.in[I_N1G];
    for (int u = vcu; u < 96; u += G) {
        const int mt = u / 12, ntile = u % 12, r0 = mt * 64;
        LAS bf16* As = (LAS bf16*)lds; LAS bf16* Bs = As + 64 * 72; LAS float* rs = (LAS float*)(lds + 18432);
        const float* ctx = a.in[I_CTX];
        { f32x4 rv[8][4];
#pragma unroll
          for (int rr = 0; rr < 8; ++rr)
#pragma unroll
              for (int j = 0; j < 4; ++j) rv[rr][j] = *(const f32x4*)(ctx + (size_t)(r0 + 8 * wave + rr) * 1024 + 256 * j + 4 * lane);
#pragma unroll
          for (int rr = 0; rr < 8; ++rr) { float ss = 0.f;
#pragma unroll
              for (int j = 0; j < 4; ++j) ss += rv[rr][j][0] * rv[rr][j][0] + rv[rr][j][1] * rv[rr][j][1] + rv[rr][j][2] * rv[rr][j][2] + rv[rr][j][3] * rv[rr][j][3];
              ss = wave_sum(ss); if (lane == 0) rs[8 * wave + rr] = rsqrtf(ss * (1.f / 1024.f) + EPS); } }
        __syncthreads();
        f32x4 acc[2] = {{0.f, 0.f, 0.f, 0.f}, {0.f, 0.f, 0.f, 0.f}};
        const int m16 = wave & 3, nh = wave >> 2, srow = tid >> 3, kq = (tid & 7) * 8;
        const float rstd = rs[srow];
        const float* xp = ctx + (size_t)(r0 + srow) * 1024 + kq; const bf16* wpB = (const bf16*)(ws + WS_WIN) + (size_t)(ntile * 64 + srow) * 1024 + kq;
        f32x4 xv[2], gq[2], scq[2], shq[2]; u32x4 wB;
#define CTX_LOAD(kc) do { const int _k0 = (kc) * 64; _Pragma("unroll") for (int q = 0; q < 2; ++q) { xv[q] = *(const f32x4*)(xp + _k0 + 4 * q); gq[q] = *(const f32x4*)(g1 + _k0 + kq + 4 * q); \
            scq[q] = *(const f32x4*)(MOD + 2 * 6144 + 1024 + _k0 + kq + 4 * q); shq[q] = *(const f32x4*)(MOD + 2 * 6144 + _k0 + kq + 4 * q); } wB = *(const u32x4*)(wpB + _k0); } while (0)
        CTX_LOAD(0);
        for (int kc = 0; kc < 16; ++kc) {
            { unsigned o[4];
#pragma unroll
              for (int q = 0; q < 2; ++q) { const f32x4 h = xv[q] * rstd * gq[q] * (scq[q] + 1.f) + shq[q]; o[2 * q] = pk2(h[0], h[1]); o[2 * q + 1] = pk2(h[2], h[3]); }
              *(LAS u32x4*)(As + srow * 72 + kq) = (u32x4){o[0], o[1], o[2], o[3]};
              *(LAS u32x4*)(Bs + srow * 72 + kq) = wB; }
            __syncthreads();
            if (kc + 1 < 16) CTX_LOAD(kc + 1);
#pragma unroll
            for (int ks = 0; ks < 2; ++ks) { const bf16x8 af = ldfrag(As, 72, m16 * 16, ks * 32, lane);
#pragma unroll
                for (int tt = 0; tt < 2; ++tt) { const bf16x8 bfr = ldfrag(Bs, 72, nh * 32 + tt * 16, ks * 32, lane); acc[tt] = MFMA16(af, bfr, acc[tt]); } }
            __syncthreads();
        }
#undef CTX_LOAD
#pragma unroll
        for (int tt = 0; tt < 2; ++tt)
#pragma unroll
            for (int r = 0; r < 4; ++r) { const int row = M + r0 + m16 * 16 + 4 * (lane >> 4) + r, n = ntile * 64 + nh * 32 + tt * 16 + (lane & 15); const bf16 v = (bf16)f2bf(acc[tt][r]);
                if (n < 256) ((bf16*)(ws + WS_KB))[(size_t)row * 256 + n] = v; else ((bf16*)(ws + WS_VB))[(size_t)row * 512 + n - 256] = v; }
        __syncthreads();
    }
    LAS float* WR = (LAS float*)lds;
#pragma unroll 4
    for (int it = 0; it < 16; ++it) { const int k = (tid >> 3) + 64 * it, c4 = tid & 7; const f32x4 v = *(const f32x4*)(a.in[I_WIN] + (size_t)k * DIN + 768 + 4 * c4);
        const int row = ((k >> 8) * 4 + (k & 3)) * 64 + ((k & 255) >> 2); *(LAS f32x4*)(WR + row * 36 + 4 * c4) = v; }
    __syncthreads();
    f32x4 gv[4];
#pragma unroll
    for (int j = 0; j < 4; ++j) gv[j] = *(const f32x4*)(g1 + 256 * j + 4 * lane);
    constexpr int NPAIR = MT / 2;
    const int nctx = (G > 96) ? 96 : 0, PA = 3;
    int p_lo, p_n, p_stride;
    if (vcu < nctx) { p_lo = (vcu * NWAVES + wave) * PA; p_n = PA; p_stride = 1; }
    else { p_lo = nctx * NWAVES * PA + (vcu - nctx) * NWAVES + wave; p_n = 1 << 30; p_stride = (G - nctx) * NWAVES; }
    f32x4 nx[2][4];
    if (p_n > 0 && p_lo < NPAIR) {
#pragma unroll
        for (int r = 0; r < 2; ++r) { const int m = 2 * p_lo + r; const float* src = (m < M) ? a.in[I_X] + (size_t)m * 1024 : a.in[I_CTX] + (size_t)(m - M) * 1024;
#pragma unroll
            for (int j = 0; j < 4; ++j) nx[r][j] = *(const f32x4*)(src + 256 * j + 4 * lane); } }
    for (int pi = 0, pr = p_lo; pi < p_n && pr < NPAIR; ++pi, pr += p_stride) {
        const int m0 = 2 * pr;
        f32x4 v[2][4]; float rstd[2];
#pragma unroll
        for (int r = 0; r < 2; ++r) { float ss = 0.f;
#pragma unroll
            for (int j = 0; j < 4; ++j) { v[r][j] = nx[r][j]; ss += v[r][j][0] * v[r][j][0] + v[r][j][1] * v[r][j][1] + v[r][j][2] * v[r][j][2] + v[r][j][3] * v[r][j][3]; }
            rstd[r] = ss; }
        if (pi + 1 < p_n && pr + p_stride < NPAIR) {
#pragma unroll
            for (int r = 0; r < 2; ++r) { const int m = 2 * (pr + p_stride) + r; const float* src = (m < M) ? a.in[I_X] + (size_t)m * 1024 : a.in[I_CTX] + (size_t)(m - M) * 1024;
#pragma unroll
                for (int j = 0; j < 4; ++j) nx[r][j] = *(const f32x4*)(src + 256 * j + 4 * lane); } }
#pragma unroll
        for (int r = 0; r < 2; ++r) { const int m = m0 + r; rstd[r] = rsqrtf(wave_sum(rstd[r]) * (1.f / 1024.f) + EPS); const float* mod = MOD + (size_t)((m < M) ? (m >> 13) : 2) * 6144;
#pragma unroll
            for (int j = 0; j < 4; ++j) { const f32x4 sc = *(const f32x4*)(mod + 1024 + 256 * j + 4 * lane), sh = *(const f32x4*)(mod + 256 * j + 4 * lane); v[r][j] = v[r][j] * rstd[r] * gv[j] * (sc + 1.f) + sh; }
            if (m < M) { bf16* hp = (bf16*)(ws + WS_H1) + (size_t)m * 1024;
#pragma unroll
                for (int j = 0; j < 4; ++j) { *(u32x2*)(hp + 256 * j + 4 * lane) = (u32x2){pk2(v[r][j][0], v[r][j][1]), pk2(v[r][j][2], v[r][j][3])};
                    *(unsigned*)(ws + WS_H1F + (size_t)m * 1024 + 256 * j + 4 * lane) = pk4_fp8(v[r][j][0], v[r][j][1], v[r][j][2], v[r][j][3]); } } }
        f32x2 r2[32];
#pragma unroll
        for (int i = 0; i < 32; ++i) r2[i] = (f32x2){0.f, 0.f};
#pragma unroll
        for (int j = 0; j < 4; ++j)
#pragma unroll
            for (int i = 0; i < 4; ++i) { const f32x2 hab = {v[0][j][i], v[1][j][i]}; const LAS float* rp = WR + ((j * 4 + i) * 64 + lane) * 36;
#pragma unroll
                for (int c4 = 0; c4 < 8; ++c4) { const f32x4 w = *(const LAS f32x4*)(rp + 4 * c4);
                    r2[4 * c4 + 0] += hab * w[0]; r2[4 * c4 + 1] += hab * w[1]; r2[4 * c4 + 2] += hab * w[2]; r2[4 * c4 + 3] += hab * w[3]; }
                if (i & 1) asm volatile("" ::: "memory"); }
        float ra[32], rb[32];
#pragma unroll
        for (int i = 0; i < 32; ++i) { ra[i] = r2[i][0]; rb[i] = r2[i][1]; }
        { float* racc = ra; RSTEP(32, 32); RSTEP(16, 16); RSTEP(8, 8); RSTEP(4, 4); RSTEP(2, 2); racc[0] += __shfl_xor(racc[0], 1); }
        { float* racc = rb; RSTEP(32, 32); RSTEP(16, 16); RSTEP(8, 8); RSTEP(4, 4); RSTEP(2, 2); racc[0] += __shfl_xor(racc[0], 1); }
        if ((lane & 1) == 0) { ((float*)(ws + WS_RB))[(size_t)m0 * 32 + (lane >> 1)] = ra[0]; ((float*)(ws + WS_RB))[(size_t)(m0 + 1) * 32 + (lane >> 1)] = rb[0]; }
    }
}

typedef short s16x4 __attribute__((ext_vector_type(4)));
__device__ __forceinline__ s16x4 lds_tr16(const LAS bf16* p) { return __builtin_bit_cast(s16x4, __builtin_amdgcn_ds_read_tr16_b64_v4i16((LAS s16x4*)p)); }
__device__ __forceinline__ bf16x8 ldfrag_tr(const LAS bf16* base, int stride, int k0, int n0, int lane) {
    const int g = lane >> 4, i = lane & 15; const LAS bf16* p = base + (k0 + 8 * g + (i >> 2)) * stride + n0 + 4 * (i & 3);
    const s16x4 lo = lds_tr16(p), hi = lds_tr16(p + 4 * stride);
    return (bf16x8){lo[0], lo[1], lo[2], lo[3], hi[0], hi[1], hi[2], hi[3]};
}
__device__ __forceinline__ float logsig_fast(float z) { return fminf(z, 0.f) - __logf(1.f + __expf(-fabsf(z))); }
struct ChkPre { f32x4 r, w; float bias_f, bias_b; float kf[8]; u32x4 v[2]; };
__device__ __forceinline__ void chunk_decode(int u, int& b, int& h, int& row0, int& slot, bool& isx) {
    if (u < 1024) { b = u >> 9; h = (u >> 7) & 3; const int n = u & 127; row0 = b * SEQ + n * 64; slot = n; isx = true; }
    else { const int v = u - 1024; b = v >> 4; h = (v >> 2) & 3; const int n = v & 3; row0 = M + b * LC + n * 64; slot = NCH + n; isx = false; }
}
__device__ __forceinline__ void chunk_load(ChkPre& P, const Args& a, int u, int tid) {
    unsigned char* ws = a.ws; int b, h, row0, slot; bool isx; chunk_decode(u, b, h, row0, slot, isx);
    P.r = *(const f32x4*)((const float*)(ws + WS_RB) + (size_t)(row0 + (tid >> 3)) * 32 + (tid & 7) * 4);
    P.w = *(const f32x4*)(a.in[I_WDU] + (size_t)(tid >> 4) * 256 + h * 64 + (tid & 15) * 4);
    const int dk = tid & 63, tq = tid >> 6;
    P.bias_f = a.in[I_BDEC][h * 64 + dk]; P.bias_b = a.in[I_BDEC][256 + h * 64 + dk];
    const bf16* KBp = (const bf16*)(ws + WS_KB) + (size_t)(row0 + tq * 8) * 256 + h * 64 + dk;
#pragma unroll
    for (int tt = 0; tt < 8; ++tt) P.kf[tt] = bf2f(KBp[(size_t)tt * 256]);
#pragma unroll
    for (int i = 0; i < 2; ++i) { const int p = tid + NT * i, jj = p >> 4, ch = p & 15; P.v[i] = *(const u32x4*)((const bf16*)(ws + WS_VB) + (size_t)(row0 + jj) * 512 + h * 128 + 8 * ch); }
}
__device__ __forceinline__ void chunk_units(LAS unsigned char* lds, const Args& a, int vcu, int G, int tid, int lane, int wave) {
    unsigned char* ws = a.ws;
    LAS float* r_s = (LAS float*)lds;
    LAS float* wup = (LAS float*)(lds + 8192);
    LAS float* seg = (LAS float*)(lds + 16384);
    LAS bf16* Ks = (LAS bf16*)(lds + 20480);
    LAS bf16* Vs = (LAS bf16*)(lds + 38912);
    const int dk = tid & 63, tq = tid >> 6;
    ChkPre P;
    unsigned* qctr = (unsigned*)(ws + WS_CTL) + 512; LAS int* qnext = (LAS int*)(lds + 57344);
    int u = vcu;
    if (u < 1024 + 32) chunk_load(P, a, u, tid);
    for (; u < 1024 + 32; ) {
        int b, h, row0, slot; bool isx; chunk_decode(u, b, h, row0, slot, isx);
        const int bh = b * 4 + h;
        if (tid == 0) qnext[0] = G + (int)__hip_atomic_fetch_add(qctr, 1u, __ATOMIC_RELAXED, __HIP_MEMORY_SCOPE_AGENT);
        *(LAS f32x4*)(r_s + tid * 4) = P.r; *(LAS f32x4*)(wup + (tid >> 4) * 64 + (tid & 15) * 4) = P.w;
#pragma unroll
        for (int i = 0; i < 2; ++i) { const int p = tid + NT * i, jj = p >> 4, ch = p & 15; *(LAS u32x4*)(Vs + jj * 136 + 8 * ch) = P.v[i]; }
        float kf[8];
#pragma unroll
        for (int tt = 0; tt < 8; ++tt) kf[tt] = P.kf[tt];
        const float bias_f = P.bias_f, bias_b = P.bias_b;
        __syncthreads();
        const int un = qnext[0];
        if (un < 1024 + 32) chunk_load(P, a, un, tid);
        float pf[8], sb[8];
        { float wf[16], wb[16];
#pragma unroll
          for (int j = 0; j < 16; ++j) { wf[j] = wup[j * 64 + dk]; wb[j] = wup[(16 + j) * 64 + dk]; }
#pragma unroll
          for (int tt = 0; tt < 8; ++tt) { const LAS float* rp = r_s + (tq * 8 + tt) * 32; float zf = bias_f, zb = bias_b;
#pragma unroll
              for (int j4 = 0; j4 < 4; ++j4) { const f32x4 rf = *(const LAS f32x4*)(rp + 4 * j4), rb = *(const LAS f32x4*)(rp + 16 + 4 * j4);
#pragma unroll
                  for (int e = 0; e < 4; ++e) { zf += rf[e] * wf[4 * j4 + e]; zb += rb[e] * wb[4 * j4 + e]; } }
              pf[tt] = logsig_fast(zf) * (1.f / 16.f); sb[tt] = logsig_fast(zb) * (1.f / 16.f); }
#pragma unroll
          for (int tt = 1; tt < 8; ++tt) pf[tt] += pf[tt - 1];
#pragma unroll
          for (int tt = 6; tt >= 0; --tt) sb[tt] += sb[tt + 1];
          seg[tq * 64 + dk] = pf[7]; seg[(8 + tq) * 64 + dk] = sb[0]; }
        __syncthreads();
        { float offf = 0.f, totf = 0.f, offb = 0.f, totb = 0.f;
#pragma unroll
          for (int q = 0; q < 8; ++q) { const float sf = seg[q * 64 + dk], sbv = seg[(8 + q) * 64 + dk]; totf += sf; totb += sbv; if (q < tq) offf += sf; if (q > tq) offb += sbv; }
#pragma unroll
          for (int tt = 0; tt < 8; ++tt) { const int t = tq * 8 + tt; const float bb = pf[tt] + offf, cc = sb[tt] + offb;
              if (isx) { const size_t gi = (size_t)(row0 + t) * 256 + h * 64 + dk; a.out[gi] = bb; a.out[(size_t)M * 256 + gi] = cc; }
              Ks[t * 72 + dk] = (bf16)f2bf(kf[tt] * __expf(totf - bb)); Ks[(64 + t) * 72 + dk] = (bf16)f2bf(kf[tt] * __expf(totb - cc)); }
          if (tq == 0) { float* DEC = (float*)(ws + WS_DEC); DEC[((size_t)(0 * 8 + bh) * NSLOT + slot) * 64 + dk] = __expf(totf); DEC[((size_t)(1 * 8 + bh) * NSLOT + slot) * 64 + dk] = __expf(totb); } }
        __syncthreads();
        { const int dir = wave >> 2, dkt = wave & 3; const LAS bf16* Kd = Ks + dir * 64 * 72;
          const bf16x8 k0f = ldfrag_tr(Kd, 72, 0, dkt * 16, lane), k1f = ldfrag_tr(Kd, 72, 32, dkt * 16, lane);
          bf16* KV = (bf16*)(ws + WS_KV) + ((size_t)(dir * 8 + bh) * NSLOT + slot) * 8192;
#pragma unroll
          for (int dvt = 0; dvt < 8; ++dvt) { f32x4 c = {0.f, 0.f, 0.f, 0.f}; c = MFMA16(k0f, ldfrag_tr(Vs, 136, 0, dvt * 16, lane), c); c = MFMA16(k1f, ldfrag_tr(Vs, 136, 32, dvt * 16, lane), c);
              *(u32x2*)(KV + (size_t)(dvt * 16 + (lane & 15)) * 64 + dkt * 16 + 4 * (lane >> 4)) = (u32x2){pk2(c[0], c[1]), pk2(c[2], c[3])}; } }
        __syncthreads();
        u = un;
    }
}
constexpr int PB = 4, NPOOLW = NB * 4 * 8 * (128 / PB);
__device__ __forceinline__ void ld16bf(const bf16* p, float (&f)[16]) { const u32x4 w0 = *(const u32x4*)p, w1 = *(const u32x4*)(p + 8);
#pragma unroll
    for (int q = 0; q < 4; ++q) { f[2 * q] = bflo(w0[q]); f[2 * q + 1] = bfhi(w0[q]); f[8 + 2 * q] = bflo(w1[q]); f[8 + 2 * q + 1] = bfhi(w1[q]); } }
template <int CTRL, int ROWMASK> __device__ __forceinline__ float dpp_f(float v) { return __builtin_bit_cast(float, __builtin_amdgcn_update_dpp(0, __builtin_bit_cast(int, v), CTRL, ROWMASK, 0xf, true)); }
__device__ __forceinline__ float wave_prefix(float v) {
    v += dpp_f<0x111, 0xf>(v); v += dpp_f<0x112, 0xf>(v); v += dpp_f<0x114, 0xf>(v); v += dpp_f<0x118, 0xf>(v);
    v += dpp_f<0x142, 0xa>(v);
    v += dpp_f<0x143, 0xc>(v);
    return v;
}
template <int HALF>
__device__ __forceinline__ void pool_band(const bf16* PI, bf16* PO, int r0, int c) {
    float run[16];
#pragma unroll
    for (int e = 0; e < 16; ++e) run[e] = 0.f;
    { constexpr int NW = 2 * HALF, BT = NW < 8 ? NW : 8;
#pragma unroll
      for (int i0 = 0; i0 < NW; i0 += BT) { float f[BT][16];
#pragma unroll
          for (int i = 0; i < BT; ++i) { int rr = r0 - HALF + i0 + i; rr = rr < 0 ? 0 : (rr > 127 ? 127 : rr); ld16bf(PI + (size_t)rr * 64 * 512, f[i]); }
#pragma unroll
          for (int i = 0; i < BT; ++i) { const int rr = r0 - HALF + i0 + i; const bool ok = rr >= 0 && rr < 128;
#pragma unroll
              for (int e = 0; e < 16; ++e) run[e] += ok ? f[i][e] : 0.f; }
          asm volatile("" ::: "memory"); } }
    const int lo_c = (c - HALF) < 0 ? 0 : (c - HALF), hi_c = (c + HALF) > 64 ? 64 : (c + HALF);
    float cen[16], fi[16], fo[16];
    ld16bf(PI + (size_t)r0 * 64 * 512, cen);
#pragma unroll
    for (int k = 0; k < PB; ++k) {
        const int r = r0 + k;
        float ncen[16];
        if (k + 1 < PB) { const int rin = r + HALF, rout = r - HALF;
            ld16bf(PI + (size_t)(rin > 127 ? 127 : rin) * 64 * 512, fi); ld16bf(PI + (size_t)(rout < 0 ? 0 : rout) * 64 * 512, fo); ld16bf(PI + (size_t)(r + 1) * 64 * 512, ncen); }
        const int lo_r = (r - HALF) < 0 ? 0 : (r - HALF), hi_r = (r + HALF) > 128 ? 128 : (r + HALF);
        const float inv = 1.f / (float)((hi_r - lo_r) * (hi_c - lo_c));
        float o[16];
#pragma unroll
        for (int e = 0; e < 16; ++e) { const float p = wave_prefix(run[e]);
            const float hi = __shfl(p, hi_c - 1), lo = __shfl(p, lo_c > 0 ? lo_c - 1 : 0);
            o[e] = (hi - (lo_c > 0 ? lo : 0.f)) * inv - cen[e]; }
        bf16* po = PO + (size_t)r * 64 * 512;
        *(u32x4*)po = (u32x4){pk2(o[0], o[1]), pk2(o[2], o[3]), pk2(o[4], o[5]), pk2(o[6], o[7])}; *(u32x4*)(po + 8) = (u32x4){pk2(o[8], o[9]), pk2(o[10], o[11]), pk2(o[12], o[13]), pk2(o[14], o[15])};
        if (k + 1 < PB) { const int rin = r + HALF, rout = r - HALF;
#pragma unroll
            for (int e = 0; e < 16; ++e) { run[e] += (rin < 128 ? fi[e] : 0.f) - (rout >= 0 ? fo[e] : 0.f); cen[e] = ncen[e]; } }
    }
}
__device__ __forceinline__ void pool_units(const Args& a, int vcu, int G, int lane, int wave, int nw) {
    unsigned char* ws = a.ws;
    constexpr int NBAND = 128 / PB, PER_G = NB * 8 * NBAND;
    for (int wu = vcu * nw + wave; wu < NPOOLW; wu += G * nw) {
        const int g = 3 - (wu & 3), rem = wu >> 2, b = rem / (8 * NBAND), rem2 = rem % (8 * NBAND), chk = rem2 & 7, r0 = (rem2 >> 3) * PB;
        const size_t off = ((size_t)b * SEQ + lane) * 512 + g * 128 + chk * 16;
        const bf16* PI = (const bf16*)(ws + WS_PI) + off; bf16* PO = (bf16*)(ws + WS_PO) + off;
        if (g == 0) pool_band<1>(PI, PO, r0, lane); else if (g == 1) pool_band<2>(PI, PO, r0, lane); else if (g == 2) pool_band<4>(PI, PO, r0, lane); else pool_band<8>(PI, PO, r0, lane);
    }
}

__device__ __forceinline__ void phase4(const Args& a, int G, int tid, int nthr) {
    unsigned char* ws = a.ws;
    for (int e = blockIdx.x * nthr + tid; e < 2 * 8 * 8192; e += G * nthr) {
        const int dir = e >> 16, bh = (e >> 13) & 7, e8 = e & 8191, dk = e8 & 63;
        const bf16* kvp = (const bf16*)(ws + WS_KV) + (size_t)((dir * 8 + bh) * NSLOT) * 8192 + e8;
        const float* decp = (const float*)(ws + WS_DEC) + (size_t)((dir * 8 + bh) * NSLOT) * 64 + dk;
        bf16* stp = (bf16*)(ws + WS_ST) + (size_t)((dir * 8 + bh) * NCH) * 8192 + e8;
        float s = 0.f;
        float kv[12], dc[12], kvn[12], dcn[12];
#define SCAN_SLOT(j) (dir ? (NSLOT - 1 - (j)) : ((j) < 4 ? NCH + (j) : (j) - 4))
#pragma unroll
        for (int q = 0; q < 12; ++q) { const int slot = SCAN_SLOT(q); kvn[q] = bf2f(kvp[(size_t)slot * 8192]); dcn[q] = decp[slot * 64]; }
        for (int j0 = 0; j0 < NSLOT; j0 += 12) {
#pragma unroll
            for (int q = 0; q < 12; ++q) { kv[q] = kvn[q]; dc[q] = dcn[q]; }
            if (j0 + 12 < NSLOT) {
#pragma unroll
                for (int q = 0; q < 12; ++q) { const int slot = SCAN_SLOT(j0 + 12 + q); kvn[q] = bf2f(kvp[(size_t)slot * 8192]); dcn[q] = decp[slot * 64]; } }
#pragma unroll
            for (int q = 0; q < 12; ++q) { const int slot = SCAN_SLOT(j0 + q);
                if (slot < NCH) stp[(size_t)slot * 8192] = (bf16)f2bf(s);
                s = dc[q] * s + kv[q]; }
        }
#undef SCAN_SLOT
    }
}

struct GlaPre { u32x4 q, k; f32x4 b0, b1, c0, c1, mf0, mf1, mb0, mb1; u32x4 v[2]; u32x4 st[4]; u32x4 sg[2]; };
__device__ __forceinline__ void gla_load(GlaPre& P, const Args& a, int u, int tid) {
    unsigned char* ws = a.ws;
    const int b = u >> 9, h = (u >> 7) & 3, n = u & 127, row0 = b * SEQ + n * 64, bh = b * 4 + h, t = tid >> 3, c8 = tid & 7;
    const size_t gi = (size_t)(row0 + t) * 256 + h * 64 + 8 * c8, gmf = (size_t)(row0 + 31) * 256 + h * 64 + 8 * c8, gmb = (size_t)(row0 + 32) * 256 + h * 64 + 8 * c8;
    const float* BF = a.out; const float* CB = a.out + (size_t)M * 256;
    P.q = *(const u32x4*)((const bf16*)(ws + WS_QB) + gi); P.k = *(const u32x4*)((const bf16*)(ws + WS_KB) + gi);
    P.b0 = *(const f32x4*)(BF + gi); P.b1 = *(const f32x4*)(BF + gi + 4); P.c0 = *(const f32x4*)(CB + gi); P.c1 = *(const f32x4*)(CB + gi + 4);
    P.mf0 = *(const f32x4*)(BF + gmf); P.mf1 = *(const f32x4*)(BF + gmf + 4); P.mb0 = *(const f32x4*)(CB + gmb); P.mb1 = *(const f32x4*)(CB + gmb + 4);
#pragma unroll
    for (int i = 0; i < 2; ++i) { const int p = tid + NT * i, jj = p >> 4, ch = p & 15; P.v[i] = *(const u32x4*)((const bf16*)(ws + WS_VB) + (size_t)(row0 + jj) * 512 + h * 128 + 8 * ch); }
#pragma unroll
    for (int i = 0; i < 4; ++i) { const int p = tid + NT * i, dir = p >> 10, rem = p & 1023, dv = rem >> 3, c = rem & 7;
        P.st[i] = *(const u32x4*)((const bf16*)(ws + WS_ST) + ((size_t)((dir * 8 + bh) * NCH + n) * 128 + dv) * 64 + 8 * c); }
    const bf16* sgp = (const bf16*)(ws + WS_SG) + (size_t)(row0 + t) * 512 + h * 128 + 16 * c8;
    P.sg[0] = *(const u32x4*)sgp; P.sg[1] = *(const u32x4*)(sgp + 8);
}
__device__ __forceinline__ void phase5(LAS unsigned char* lds, const Args& a, int vcu, int G, int tid, int lane, int wave) {
    unsigned char* ws = a.ws;
    LAS bf16* Aop = (LAS bf16*)lds;
    LAS bf16* Bop = (LAS bf16*)(lds + 25600);
    LAS bf16* Vs = (LAS bf16*)(lds + 60416);
    LAS bf16* qsf = (LAS bf16*)(lds + 77824); LAS bf16* ksf = qsf + 64 * 72; LAS bf16* qsb = ksf + 64 * 72; LAS bf16* ksb = qsb + 64 * 72;
    LAS float* Os = (LAS float*)(lds + 77824);
    const int t8 = tid >> 3, c8 = tid & 7;
    f32x4 gn[4];
#pragma unroll
    for (int q = 0; q < 4; ++q) gn[q] = *(const f32x4*)(a.in[I_GNG] + 16 * c8 + 4 * q);
    GlaPre P;
    int u = vcu;
    if (u < 1024) gla_load(P, a, u, tid);
    for (; u < 1024; u += G) {
        const int b = u >> 9, h = (u >> 7) & 3, n = u & 127, row0 = b * SEQ + n * 64;
        { float qf[8], kf[8], bb[8], cc[8], mf[8], mb[8];
#pragma unroll
          for (int e = 0; e < 4; ++e) { qf[2 * e] = bflo(P.q[e]); qf[2 * e + 1] = bfhi(P.q[e]); kf[2 * e] = bflo(P.k[e]); kf[2 * e + 1] = bfhi(P.k[e]);
              bb[e] = P.b0[e]; bb[4 + e] = P.b1[e]; cc[e] = P.c0[e]; cc[4 + e] = P.c1[e]; mf[e] = P.mf0[e]; mf[4 + e] = P.mf1[e]; mb[e] = P.mb0[e]; mb[4 + e] = P.mb1[e]; }
          float o0[8], o1[8], o2[8], o3[8], o4[8], o5[8];
#pragma unroll
          for (int e = 0; e < 8; ++e) { const float eb = __expf(bb[e]), ec = __expf(cc[e]), x = __expf(bb[e] - mf[e]), y = __expf(cc[e] - mb[e]);
              o0[e] = qf[e] * eb; o1[e] = qf[e] * ec; o2[e] = qf[e] * x; o3[e] = kf[e] * __builtin_amdgcn_rcpf(x); o4[e] = qf[e] * y; o5[e] = kf[e] * __builtin_amdgcn_rcpf(y); }
#define PK8(o) (u32x4){pk2(o[0], o[1]), pk2(o[2], o[3]), pk2(o[4], o[5]), pk2(o[6], o[7])}
          *(LAS u32x4*)(Aop + t8 * 200 + 8 * c8) = PK8(o0); *(LAS u32x4*)(Aop + t8 * 200 + 64 + 8 * c8) = PK8(o1);
          *(LAS u32x4*)(qsf + t8 * 72 + 8 * c8) = PK8(o2); *(LAS u32x4*)(ksf + t8 * 72 + 8 * c8) = PK8(o3); *(LAS u32x4*)(qsb + t8 * 72 + 8 * c8) = PK8(o4); *(LAS u32x4*)(ksb + t8 * 72 + 8 * c8) = PK8(o5);
#undef PK8
        }
#pragma unroll
        for (int i = 0; i < 2; ++i) { const int p = tid + NT * i, jj = p >> 4, ch = p & 15; *(LAS u32x4*)(Vs + jj * 136 + 8 * ch) = P.v[i]; }
#pragma unroll
        for (int i = 0; i < 4; ++i) { const int p = tid + NT * i, dir = p >> 10, rem = p & 1023, dv = rem >> 3, c = rem & 7; *(LAS u32x4*)(Bop + dv * 136 + dir * 64 + 8 * c) = P.st[i]; }
        const u32x4 sg0 = P.sg[0], sg1 = P.sg[1];
        __syncthreads();
        if (u + G < 1024) gla_load(P, a, u + G, tid);
        { const int tt = wave >> 1, jh = wave & 1; f32x4 pa[2] = {{0.f, 0.f, 0.f, 0.f}, {0.f, 0.f, 0.f, 0.f}};
#pragma unroll
          for (int dir = 0; dir < 2; ++dir) { const LAS bf16* qs = dir ? qsb : qsf; const LAS bf16* ks = dir ? ksb : ksf;
              const bf16x8 a0 = ldfrag(qs, 72, tt * 16, 0, lane), a1 = ldfrag(qs, 72, tt * 16, 32, lane);
#pragma unroll
              for (int jj = 0; jj < 2; ++jj) { const int jt = jh * 2 + jj; f32x4 sc = {0.f, 0.f, 0.f, 0.f}; sc = MFMA16(a0, ldfrag(ks, 72, jt * 16, 0, lane), sc); sc = MFMA16(a1, ldfrag(ks, 72, jt * 16, 32, lane), sc);
#pragma unroll
                  for (int r = 0; r < 4; ++r) { const int t = tt * 16 + 4 * (lane >> 4) + r, jx = jt * 16 + (lane & 15); const bool keep = dir ? (jx >= t) : (jx <= t); pa[jj][r] += keep ? sc[r] : 0.f; } } }
#pragma unroll
          for (int jj = 0; jj < 2; ++jj)
#pragma unroll
              for (int r = 0; r < 4; ++r) Aop[(tt * 16 + 4 * (lane >> 4) + r) * 200 + 128 + (jh * 2 + jj) * 16 + (lane & 15)] = (bf16)f2bf(pa[jj][r]); }
        __syncthreads();
        const int tt = wave >> 1, dvh = wave & 1;
        f32x4 acc[4] = {{0.f, 0.f, 0.f, 0.f}, {0.f, 0.f, 0.f, 0.f}, {0.f, 0.f, 0.f, 0.f}, {0.f, 0.f, 0.f, 0.f}};
#pragma unroll
        for (int ks = 0; ks < 4; ++ks) { const bf16x8 af = ldfrag(Aop, 200, tt * 16, ks * 32, lane);
#pragma unroll
            for (int i = 0; i < 4; ++i) acc[i] = MFMA16(af, ldfrag(Bop, 136, (dvh * 4 + i) * 16, ks * 32, lane), acc[i]); }
#pragma unroll
        for (int ks = 0; ks < 2; ++ks) { const bf16x8 af = ldfrag(Aop, 200, tt * 16, 128 + ks * 32, lane);
#pragma unroll
            for (int i = 0; i < 4; ++i) acc[i] = MFMA16(af, ldfrag_tr(Vs, 136, ks * 32, (dvh * 4 + i) * 16, lane), acc[i]); }
#pragma unroll
        for (int i = 0; i < 4; ++i)
#pragma unroll
            for (int r = 0; r < 4; ++r) Os[(tt * 16 + 4 * (lane >> 4) + r) * 132 + (dvh * 4 + i) * 16 + (lane & 15)] = acc[i][r];
        __syncthreads();
        { f32x4 ov[4]; float ss = 0.f;
#pragma unroll
          for (int q = 0; q < 4; ++q) { ov[q] = *(const LAS f32x4*)(Os + t8 * 132 + 16 * c8 + 4 * q); ss += ov[q][0] * ov[q][0] + ov[q][1] * ov[q][1] + ov[q][2] * ov[q][2] + ov[q][3] * ov[q][3]; }
          ss += __shfl_xor(ss, 1); ss += __shfl_xor(ss, 2); ss += __shfl_xor(ss, 4);
          const float rstd = rsqrtf(ss * (1.f / 128.f) + EPS);
          unsigned sgw[8] = {sg0[0], sg0[1], sg0[2], sg0[3], sg1[0], sg1[1], sg1[2], sg1[3]}, ow[8];
#pragma unroll
          for (int q = 0; q < 4; ++q) { const f32x4 o = ov[q] * rstd * gn[q]; ow[2 * q] = pk2(o[0] * bflo(sgw[2 * q]), o[1] * bfhi(sgw[2 * q])); ow[2 * q + 1] = pk2(o[2] * bflo(sgw[2 * q + 1]), o[3] * bfhi(sgw[2 * q + 1])); }
          bf16* agp = (bf16*)(ws + WS_AG) + (size_t)(row0 + t8) * 512 + h * 128 + 16 * c8;
          *(u32x4*)agp = (u32x4){ow[0], ow[1], ow[2], ow[3]}; *(u32x4*)(agp + 8) = (u32x4){ow[4], ow[5], ow[6], ow[7]}; }
        __syncthreads();
    }
}

__device__ __forceinline__ void phase8(LAS unsigned char* lds, const Args& a, int vcu, int G, int tid, int lane, int wave) {
    unsigned char* ws = a.ws;
    const float* MOD = (const float*)(ws + WS_MOD);
    LAS float* WRT = (LAS float*)lds;
#pragma unroll
    for (int it = 0; it < 8; ++it) { const int idx = tid + NT * it, k = idx >> 2, c4 = idx & 3; const f32x4 v = *(const f32x4*)(a.in[I_WROUTER] + (size_t)k * 16 + 4 * c4);
        const int row = ((k >> 8) * 4 + (k & 3)) * 64 + ((k & 255) >> 2); *(LAS f32x4*)(WRT + row * 20 + 4 * c4) = v; }
    __syncthreads();
    const int gw = vcu * NWAVES + wave, NGW = G * NWAVES;
    f32x4 gv[4];
#pragma unroll
    for (int j = 0; j < 4; ++j) gv[j] = *(const f32x4*)(a.in[I_N2G] + 256 * j + 4 * lane);
    f32x4 nx[2][4];
    if (gw < M / 2) {
#pragma unroll
        for (int r = 0; r < 2; ++r)
#pragma unroll
            for (int j = 0; j < 4; ++j) { const size_t o_ = (size_t)(2 * gw + r) * 1024 + 256 * j + 4 * lane; const u32x2 d_ = *(const u32x2*)((const bf16*)(ws + WS_YD) + o_);
                nx[r][j] = (f32x4){bflo(d_.x), bfhi(d_.x), bflo(d_.y), bfhi(d_.y)}; } }
    for (int pr = gw; pr < M / 2; pr += NGW) {
        const int m0 = 2 * pr, b = m0 >> 13; const float* mod = MOD + (size_t)b * 6144;
        f32x4 v[2][4]; float ss[2];
#pragma unroll
        for (int r = 0; r < 2; ++r) { float q = 0.f;
#pragma unroll
            for (int j = 0; j < 4; ++j) { v[r][j] = nx[r][j]; q += v[r][j][0] * v[r][j][0] + v[r][j][1] * v[r][j][1] + v[r][j][2] * v[r][j][2] + v[r][j][3] * v[r][j][3]; }
            ss[r] = q; }
        if (pr + NGW < M / 2) {
#pragma unroll
            for (int r = 0; r < 2; ++r)
#pragma unroll
                for (int j = 0; j < 4; ++j) { const size_t o_ = (size_t)(2 * (pr + NGW) + r) * 1024 + 256 * j + 4 * lane; const u32x2 d_ = *(const u32x2*)((const bf16*)(ws + WS_YD) + o_);
                    nx[r][j] = (f32x4){bflo(d_.x), bfhi(d_.x), bflo(d_.y), bfhi(d_.y)}; } }
#pragma unroll
        for (int r = 0; r < 2; ++r) { const float rstd = rsqrtf(wave_sum(ss[r]) * (1.f / 1024.f) + EPS);
#pragma unroll
            for (int j = 0; j < 4; ++j) { const f32x4 sc = *(const f32x4*)(mod + 4096 + 256 * j + 4 * lane), sh = *(const f32x4*)(mod + 3072 + 256 * j + 4 * lane); v[r][j] = v[r][j] * rstd * gv[j] * (sc + 1.f) + sh; }
            unsigned char* hp = ws + WS_H2 + (size_t)(m0 + r) * 1024;
#pragma unroll
            for (int j = 0; j < 4; ++j) *(unsigned*)(hp + 256 * j + 4 * lane) = pk4_fp8(v[r][j][0], v[r][j][1], v[r][j][2], v[r][j][3]); }
        f32x2 r2[16];
#pragma unroll
        for (int i = 0; i < 16; ++i) r2[i] = (f32x2){0.f, 0.f};
#pragma unroll
        for (int j = 0; j < 4; ++j)
#pragma unroll
            for (int i = 0; i < 4; ++i) { const f32x2 hab = {v[0][j][i], v[1][j][i]}; const LAS float* rp = WRT + ((j * 4 + i) * 64 + lane) * 20;
#pragma unroll
                for (int c4 = 0; c4 < 4; ++c4) { const f32x4 w = *(const LAS f32x4*)(rp + 4 * c4); r2[4 * c4 + 0] += hab * w[0]; r2[4 * c4 + 1] += hab * w[1]; r2[4 * c4 + 2] += hab * w[2]; r2[4 * c4 + 3] += hab * w[3]; }
                if (i & 1) asm volatile("" ::: "memory"); }
#pragma unroll
        for (int r = 0; r < 2; ++r) {
            float racc[16];
#pragma unroll
            for (int i = 0; i < 16; ++i) racc[i] = r2[i][r];
            RSTEP(16, 32); RSTEP(8, 16); RSTEP(4, 8); RSTEP(2, 4); racc[0] += __shfl_xor(racc[0], 2); racc[0] += __shfl_xor(racc[0], 1);
            const float lg = racc[0];
            float mx = lg; mx = fmaxf(mx, __shfl_xor(mx, 4)); mx = fmaxf(mx, __shfl_xor(mx, 8)); mx = fmaxf(mx, __shfl_xor(mx, 16)); mx = fmaxf(mx, __shfl_xor(mx, 32));
            const float ex = expf(lg - mx); float sm = ex; sm += __shfl_xor(sm, 4); sm += __shfl_xor(sm, 8); sm += __shfl_xor(sm, 16); sm += __shfl_xor(sm, 32);
            const int m = m0 + r;
            if ((lane & 3) == 0) ((float*)(ws + WS_AFF))[(size_t)(b * 16 + (lane >> 2)) * SEQ + (m & (SEQ - 1))] = ex / sm;
            if (lane < 16) ((int*)(ws + WS_INV))[(size_t)m * 16 + lane] = -1;
        }
    }
}

__device__ __forceinline__ void topk_unit(LAS unsigned char* lds, const Args& a, int be, int tid, int lane, int wave) {
    unsigned char* ws = a.ws;
    LAS unsigned* hist = (LAS unsigned*)lds;
    LAS unsigned* sel = hist + 256;
    LAS unsigned* wtot = hist + 264;
    const float* aff = (const float*)(ws + WS_AFF) + (size_t)be * SEQ + 16 * tid;
    unsigned key[16];
#pragma unroll
    for (int q = 0; q < 4; ++q) { const u32x4 v = *(const u32x4*)(aff + 4 * q); key[4 * q] = v[0]; key[4 * q + 1] = v[1]; key[4 * q + 2] = v[2]; key[4 * q + 3] = v[3]; }
    unsigned prefix = 0u, mask = 0u, kk = CAP;
    for (int pass = 0; pass < 4; ++pass) {
        const int shift = 24 - 8 * pass;
        if (tid < 256) hist[tid] = 0u;
        __syncthreads();
#pragma unroll
        for (int i = 0; i < 16; ++i) if ((key[i] & mask) == prefix) __hip_atomic_fetch_add(hist + ((key[i] >> shift) & 255u), 1u, __ATOMIC_RELAXED, __HIP_MEMORY_SCOPE_WORKGROUP);
        __syncthreads();
        if (wave == 0) {
            const unsigned h0 = hist[4 * lane], h1 = hist[4 * lane + 1], h2 = hist[4 * lane + 2], h3 = hist[4 * lane + 3], loc = h0 + h1 + h2 + h3;
            unsigned suf = loc;
#pragma unroll
            for (int o = 1; o < 64; o <<= 1) { const unsigned t = __shfl_down(suf, o); if (lane + o < 64) suf += t; }
            const unsigned above = suf - loc;
            const unsigned s3 = above + h3, s2 = s3 + h2, s1 = s2 + h1, s0 = s1 + h0;
            if (s3 >= kk && above < kk) { sel[0] = 4 * lane + 3; sel[1] = kk - above; }
            if (s2 >= kk && s3 < kk) { sel[0] = 4 * lane + 2; sel[1] = kk - s3; }
            if (s1 >= kk && s2 < kk) { sel[0] = 4 * lane + 1; sel[1] = kk - s2; }
            if (s0 >= kk && s1 < kk) { sel[0] = 4 * lane + 0; sel[1] = kk - s1; }
        }
        __syncthreads();
        prefix |= sel[0] << shift; mask |= 255u << shift; kk = sel[1];
        __syncthreads();
    }
    unsigned cgt = 0u, ceq = 0u;
#pragma unroll
    for (int i = 0; i < 16; ++i) { cgt += (key[i] > prefix) ? 1u : 0u; ceq += (key[i] == prefix) ? 1u : 0u; }
    const unsigned val = cgt | (ceq << 16); unsigned inc = val;
#pragma unroll
    for (int o = 1; o < 64; o <<= 1) { const unsigned t = __shfl_up(inc, o); if (lane >= o) inc += t; }
    if (lane == 63) wtot[wave] = inc;
    __syncthreads();
    unsigned base = 0u;
    for (int w = 0; w < wave; ++w) base += wtot[w];
    const unsigned excl = base + inc - val; unsigned gtb = excl & 0xffffu, eqb = excl >> 16;
    const int b = be >> 4, e = be & 15;
    int* IDX = (int*)(ws + WS_IDX) + be * CAP; float* WSEL = (float*)(ws + WS_WSEL) + be * CAP; int* INV = (int*)(ws + WS_INV);
#pragma unroll
    for (int i = 0; i < 16; ++i) { const bool gt = key[i] > prefix, eq = key[i] == prefix; const bool take = gt || (eq && eqb < kk);
        if (take) { const unsigned pos = gtb + (eqb < kk ? eqb : kk); const int row = b * SEQ + 16 * tid + i; IDX[pos] = row; WSEL[pos] = __builtin_bit_cast(float, key[i]); INV[(size_t)row * 16 + e] = (int)pos; }
        gtb += gt ? 1u : 0u; eqb += eq ? 1u : 0u; }
    __syncthreads();
}
__device__ __forceinline__ void phase9(LAS unsigned char* lds, const Args& a, int vcu, int G, int tid, int lane, int wave) {
    const int ntk = (G > 64) ? 32 : 0;
    if (vcu < ntk || ntk == 0) for (int be = (ntk ? vcu : vcu); be < NB * NE; be += (ntk ? ntk : G)) topk_unit(lds, a, be, tid, lane, wave);
    if (vcu >= ntk) { const int gw = (vcu - ntk) * NWAVES + wave, NGW = (G - ntk) * NWAVES; convert_items<2>((LAS float*)(lds + 8192 + wave * 8448), a, gw, NGW, 8192, lane); }
}

__device__ __forceinline__ void phase12(const Args& a, int vcu, int G, int lane, int wave) {
    unsigned char* ws = a.ws;
    const int gw = vcu * NWAVES + wave, NGW = G * NWAVES;
    f32x4 gv[4];
#pragma unroll
    for (int j = 0; j < 4; ++j) gv[j] = *(const f32x4*)(a.in[I_FNG] + 256 * j + 4 * lane);
    f32x4 nx[4]; int ninv = -1;
    if (gw < M) {
#pragma unroll
        for (int j = 0; j < 4; ++j) { const size_t o_ = (size_t)gw * 1024 + 256 * j + 4 * lane; const u32x2 d_ = __builtin_nontemporal_load((const u32x2*)((const bf16*)(ws + WS_YD) + o_));
            nx[j] = (f32x4){bflo(d_.x), bfhi(d_.x), bflo(d_.y), bfhi(d_.y)}; }
        ninv = (lane < 16) ? ((const int*)(ws + WS_INV))[(size_t)gw * 16 + lane] : -1; }
    for (int m = gw; m < M; m += NGW) {
        const int b = m >> 13; float* row = a.out + (size_t)m * 1024;
        f32x4 v[4];
#pragma unroll
        for (int j = 0; j < 4; ++j) v[j] = nx[j];
        const int myinv = ninv;
        if (m + NGW < M) {
#pragma unroll
            for (int j = 0; j < 4; ++j) { const size_t o_ = (size_t)(m + NGW) * 1024 + 256 * j + 4 * lane; const u32x2 d_ = __builtin_nontemporal_load((const u32x2*)((const bf16*)(ws + WS_YD) + o_));
                nx[j] = (f32x4){bflo(d_.x), bfhi(d_.x), bflo(d_.y), bfhi(d_.y)}; }
            ninv = (lane < 16) ? ((const int*)(ws + WS_INV))[(size_t)(m + NGW) * 16 + lane] : -1; }
        unsigned long long mask = __ballot(myinv >= 0);
        const bf16* yb = (const bf16*)(ws + WS_YB) + (size_t)(b * 16) * CAP * 1024;
        while (mask) {
            u32x2 w[4][4]; float sc[4];
#pragma unroll
            for (int q = 0; q < 4; ++q) { const bool on = mask != 0ull; const int e = on ? (int)__builtin_ctzll(mask) : 0; mask = on ? (mask & (mask - 1ull)) : 0ull;
                const int sl = __shfl(myinv, e); const size_t ro = on ? ((size_t)e * CAP + (size_t)sl) * 1024 : 0; sc[q] = on ? 1.f : 0.f;
#pragma unroll
                for (int j = 0; j < 4; ++j) w[q][j] = __builtin_nontemporal_load((const u32x2*)(yb + ro + 256 * j + 4 * lane)); }
#pragma unroll
            for (int q = 0; q < 4; ++q)
#pragma unroll
                for (int j = 0; j < 4; ++j) { v[j][0] += sc[q] * bflo(w[q][j].x); v[j][1] += sc[q] * bfhi(w[q][j].x); v[j][2] += sc[q] * bflo(w[q][j].y); v[j][3] += sc[q] * bfhi(w[q][j].y); }
        }
        float ss = 0.f;
#pragma unroll
        for (int j = 0; j < 4; ++j) ss += v[j][0] * v[j][0] + v[j][1] * v[j][1] + v[j][2] * v[j][2] + v[j][3] * v[j][3];
        const float rstd = rsqrtf(wave_sum(ss) * (1.f / 1024.f) + EPS);
#pragma unroll
        for (int j = 0; j < 4; ++j) __builtin_nontemporal_store(v[j] * rstd * gv[j], (f32x4*)(row + 256 * j + 4 * lane));
    }
}

__global__ void __launch_bounds__(NT, 2) fwd_kernel(Args args) {
    extern __shared__ __attribute__((aligned(16))) unsigned char lds_raw[];
    LAS unsigned char* lds = (LAS unsigned char*)lds_raw;
    volatile LAS unsigned* MISC = (volatile LAS unsigned*)(lds + MISC_OFF);
    const int tid0 = threadIdx.x, tid = tid0, wave = __builtin_amdgcn_readfirstlane(tid >> 6);
    const int G = gridDim.x, bx = blockIdx.x, vcu = (G % 8 == 0) ? (bx % 8) * (G / 8) + bx / 8 : bx;
    unsigned char* ws = args.ws;
    if (tid < 128) MISC[tid] = 0u;
    __syncthreads();
    XcdBarrier bar; bar.bar = (unsigned*)(ws + WS_CTL) + CW_BAR; bar.x = 0; bar.st = nullptr;
    if (!MK_MULTI) bar = xcd_barrier_post((unsigned*)(ws + WS_CTL) + CW_BAR, MISC + 8);
    const int lo = args.ph_lo, hi = args.ph_hi;
#define IN(k) (lo <= (k) && (k) < hi)
#define SEAM(k) do { if (IN(k) && IN((k) + 1)) xcd_barrier(bar); } while (0)
#define RUN(k, CODE) do { if (IN(k)) { int tid = tid0, lane; asm volatile("" : "+v"(tid)); lane = tid & 63; (void)lane; CODE; if (REP_PHASE == (k)) for (int _r = 0; _r < REP_COUNT; ++_r) { xcd_barrier(bar); CODE; } } SEAM(k); } while (0)
#define PH0 phase0(lds, args, vcu, G, tid, lane, wave)
#define PH1 phase1(lds, args, vcu, G, tid, lane, wave)
#define PH2 do { const int qs = vcu % 3;     \
        EpiInproj E{(bf16*)(ws + WS_KB), (bf16*)(ws + WS_VB), (bf16*)(ws + WS_QB), (bf16*)(ws + WS_SG), (bf16*)(ws + WS_PI), ws + WS_SM, 0, 1.f}; \
        EpiGates E8{(bf16*)(ws + WS_KB), (bf16*)(ws + WS_VB), (bf16*)(ws + WS_QB), (bf16*)(ws + WS_SG), (bf16*)(ws + WS_PI), ws + WS_SM, 8, 0.0625f}; \
        if (qs == 0) convert_all<1>(lds, args, vcu, G, lane, wave); \
        { SchedDense S{G, bx, 1024, 64, 8, (const char*)(ws + WS_H1), (const char*)(ws + WS_WIN), 0, 1 << 20, 2}; pg8::gemm_phase<EpiInproj, SchedDense, false, false>(lds, S, E); }     \
        if (qs == 1) convert_all<1>(lds, args, vcu, G, lane, wave); \
        { SchedDense S{G, bx, 1024, 64, 8, (const char*)(ws + WS_H1F), (const char*)(ws + WS_WINM), 0, 1 << 20, 1}; pg8::gemm_phase<EpiGates, SchedDense, false, true>(lds, S, E8); }     \
        if (qs == 2) convert_all<1>(lds, args, vcu, G, lane, wave); } while (0)
#define PH3 chunk_units(lds, args, vcu, G, tid, lane, wave)
#define PH4 do { pool_units(args, vcu, G, lane, wave, 8); phase4(args, G, tid, NT); } while (0)
#define PH5 phase5(lds, args, vcu, G, tid, lane, wave)
#define PH6 do { SchedPair S{G, bx, 512, (const char*)(ws + WS_AG), (const char*)(ws + WS_PO), (const char*)(ws + WS_WG), (const char*)(ws + WS_WC)}; \
        EpiMerge E{ws + WS_SM, (bf16*)(ws + WS_MG)}; pg8::gemm_phase<EpiMerge, SchedPair, false>(lds, S, E); } while (0)
#define PH7 do { SchedDense S{G, bx, 1024, 64, 4, (const char*)(ws + WS_MG), (const char*)(ws + WS_WO), 0, 1 << 20, 2}; \
        EpiOut E{(const float*)(ws + WS_MOD), (bf16*)(ws + WS_YD), args.in[I_X]}; pg8::gemm_phase<EpiOut, SchedDense, false>(lds, S, E); } while (0)
#define NITEM_HALF ((NE * 3 * 512 + 2 * G * NWAVES - 1) / (2 * G * NWAVES))
#define PH6C do { if (vcu & 1) convert_experts(lds, args, vcu, G, lane, wave, 0, NITEM_HALF); PH6; if (!(vcu & 1)) convert_experts(lds, args, vcu, G, lane, wave, 0, NITEM_HALF); } while (0)
#define PH7C do { if (vcu & 1) convert_experts(lds, args, vcu, G, lane, wave, NITEM_HALF, 2 * NITEM_HALF); PH7; if (!(vcu & 1)) convert_experts(lds, args, vcu, G, lane, wave, NITEM_HALF, 2 * NITEM_HALF); } while (0)
#define PH8 phase8(lds, args, vcu, G, tid, lane, wave)
#define PH9 phase9(lds, args, vcu, G, tid, lane, wave)
#define PH9B do { const int gw_ = vcu * NWAVES + wave, NGW_ = G * NWAVES;     \
        for (int r0_ = gw_ * 16; r0_ < NB * NE * CAP; r0_ += NGW_ * 16) { u32x4 t_[16]; \
            _Pragma("unroll") for (int q = 0; q < 16; ++q) { const int src_ = ((const int*)(ws + WS_IDX))[r0_ + q]; t_[q] = *(const u32x4*)(ws + WS_H2 + (size_t)src_ * 1024 + lane * 16); } \
            _Pragma("unroll") for (int q = 0; q < 16; ++q) *(u32x4*)(ws + WS_XS + (size_t)(r0_ + q) * 1024 + lane * 16) = t_[q]; } } while (0)
#define PH10 do { EpiMoe1 E{ws + WS_ACT}; SchedMoe1 S{G, bx, 1024, (const char*)(ws + WS_XS), (const char*)(ws + WS_WGU), 0, 1 << 20}; pg8::gemm_phase<EpiMoe1, SchedMoe1, false, true>(lds, S, E); } while (0)
#define PH11 do { SchedMoe2 S{G, bx, 1024, (const char*)(ws + WS_ACT), (const char*)(ws + WS_WD)}; \
        EpiMoe2 E{(bf16*)(ws + WS_YB), (const float*)(ws + WS_WSEL), (const float*)(ws + WS_MOD)}; pg8::gemm_phase<EpiMoe2, SchedMoe2, false, true>(lds, S, E); } while (0)
#define PH12 phase12(args, vcu, G, lane, wave)
    RUN(0, PH0); RUN(1, PH1); RUN(2, PH2); RUN(3, PH3);
#define PH3A chunk_units(lds, args, vcu, G, tid, lane, wave)
#define PH3B pool_units(args, vcu, G, lane, wave, 8)
    if (REP_PHASE == 40) { xcd_barrier(bar); if (wave < 4) phase4(args, G, tid, 256); xcd_barrier(bar); }
    if (REP_PHASE == 41) { const int lane = tid & 63; xcd_barrier(bar); if (wave >= 4) pool_units(args, vcu, G, lane, wave - 4, 4); xcd_barrier(bar); }
    if (REP_PHASE == 30) { const int lane = tid & 63; xcd_barrier(bar); PH3A; xcd_barrier(bar); }
    if (REP_PHASE == 31) { const int lane = tid & 63; xcd_barrier(bar); PH3B; xcd_barrier(bar); } RUN(4, PH4); RUN(5, PH5); RUN(6, PH6); RUN(7, PH7); RUN(8, PH8); RUN(9, PH9); RUN(10, PH9B); RUN(11, PH10); RUN(12, PH11);
    if (REP_PHASE == 20) for (int _r = 0; _r < REP_COUNT; ++_r) xcd_barrier(bar);
    RUN(13, PH12);
#undef IN
#undef SEAM
#undef RUN
}

#ifndef MK_CHECK
#define MK_CHECK 0
#endif
#ifndef CHK_SKIP
#define CHK_SKIP -1
#endif
#if MK_CHECK
constexpr size_t WS_CHK = 299 * MiB;
__device__ __forceinline__ unsigned hashu(unsigned x) { x ^= x >> 16; x *= 0x7feb352dU; x ^= x >> 15; x *= 0x846ca68bU; x ^= x >> 16; return x; }
__device__ __forceinline__ float bfr(float f) { return bf2f(f2bf(f)); }
__device__ float f8d(unsigned char x) { const int sg = x >> 7, e = (x >> 3) & 15, m = x & 7; const float v = e ? ldexpf(1.f + m / 8.f, e - 7) : ldexpf(m / 8.f, -6); return sg ? -v : v; }
__device__ float f8r(float f) { return f8d((unsigned char)(pk4_fp8(f, 0.f, 0.f, 0.f) & 255u)); }
__device__ float x1_at(const Args& a, int m, int k) { return bf2f(((const bf16*)(a.ws + WS_YD))[(size_t)m * 1024 + k]); }
__device__ float naive_rstd_x1(const Args& a, int m) { float ss = 0.f; for (int k = 0; k < 1024; ++k) { const float v = x1_at(a, m, k); ss += v * v; } return rsqrtf(ss / 1024.f + EPS); }
__device__ float gate_at(const Args& a, int m, int n) {
    const int pm = m >> 8, r = m & 255, ai = r >> 7, wr = (r >> 6) & 1, mm = (r >> 4) & 3, fr = r & 15, pg = n >> 8, c = n & 255, bj = c >> 7, wc = (c >> 5) & 3, fq = (c >> 3) & 3, j8 = c & 7;
    return (float)(a.ws + WS_SM)[gate_off(pm, pg, ai, mm, bj, wr, wc, fr, fq) + j8] * (1.f / 255.f); }
__device__ float naive_rstd(const float* row) { float ss = 0.f; for (int k = 0; k < 1024; ++k) ss += row[k] * row[k]; return rsqrtf(ss / 1024.f + EPS); }
__device__ float naive_la(const Args& a, int row, int dir, int col) {
    const float* RB = (const float*)(a.ws + WS_RB) + (size_t)row * 32 + dir * 16; float z = a.in[I_BDEC][dir * 256 + col];
    for (int j = 0; j < 16; ++j) z += RB[j] * a.in[I_WDU][(size_t)(dir * 16 + j) * 256 + col];
    return logsig_f(z) / 16.f;
}
__global__ void chk_kernel(Args a, int stage) {
    __shared__ float sh[256];
    const unsigned gid = blockIdx.x * blockDim.x + threadIdx.x; unsigned h = hashu(gid * 2654435761u + (unsigned)stage * 97u + 12345u); const unsigned h2 = hashu(h + 777u);
    unsigned char* ws = a.ws; float ref = 0.f, got = 0.f, atol = 1e-3f; bool active = true;
    const float* MOD = (const float*)(ws + WS_MOD);
    switch (stage) {
    case 0: { const int v = h % 3, n = (h >> 2) % 6144; ref = a.in[I_ADAB][n]; for (int k = 0; k < 1024; ++k) { const float c = (v < 2) ? a.in[I_C][v * 1024 + k] : a.in[I_CCTX][k]; ref += c / (1.f + expf(-c)) * a.in[I_ADAW][(size_t)k * 6144 + n]; } got = MOD[v * 6144 + n]; atol = 0.01f; } break;
    case 1: { const int sel = (h >> 28) & 3, n = h % 4096, k = (h >> 12) % 1024;
        if (sel < 2) { if (n < 2048) { ref = bfr(a.in[I_WIN][(size_t)k * DIN + n + (n >= 768 ? 32 : 0)]); got = bf2f(((const bf16*)(ws + WS_WIN))[(size_t)n * 1024 + k]); } else { ref = f8r(16.f * a.in[I_WIN][(size_t)k * DIN + n + 32]); got = f8d((ws + WS_WINM)[(size_t)(n - 2048) * 1024 + k]); } }
        else if (sel == 2) { ref = bfr(a.in[I_WOUT][(size_t)k * 1024 + (n & 1023)]); got = bf2f(((const bf16*)(ws + WS_WO))[(size_t)(n & 1023) * 1024 + k]); }
        else { ref = bfr(a.in[I_WGLA][(size_t)(k & 511) * 1024 + (n & 1023)]); got = bf2f(((const bf16*)(ws + WS_WG))[(size_t)(n & 1023) * 512 + (k & 511)]); } atol = 1e-4f; } break;
    case 2: { const int n = h % 1024, kk = (h >> 10) % 512, g = kk >> 7, c = kk & 127; for (int d = 0; d < 128; ++d) ref += a.in[I_POOLW][(size_t)(g * 128 + c) * 128 + d] * a.in[I_POOLS][g * 128 + d] * a.in[I_WPOOL][(size_t)(g * 128 + d) * 1024 + n];
        got = bf2f(((const bf16*)(ws + WS_WC))[(size_t)n * 512 + kk]); atol = 0.002f; } break;
    case 3: { const int m = h % M, k = (h >> 14) % 1024, b = m >> 13; const float* row = a.in[I_X] + (size_t)m * 1024; const float rstd = naive_rstd(row);
        ref = row[k] * rstd * a.in[I_N1G][k] * (1.f + MOD[b * 6144 + 1024 + k]) + MOD[b * 6144 + k]; got = bf2f(((const bf16*)(ws + WS_H1))[(size_t)m * 1024 + k]); atol = 0.01f; } break;
    case 4: { const int m = h % MT, c = (h >> 15) % 32, mi = (m < M) ? (m >> 13) : 2; const float* row = (m < M) ? a.in[I_X] + (size_t)m * 1024 : a.in[I_CTX] + (size_t)(m - M) * 1024; const float rstd = naive_rstd(row);
        for (int k = 0; k < 1024; ++k) ref += (row[k] * rstd * a.in[I_N1G][k] * (1.f + MOD[mi * 6144 + 1024 + k]) + MOD[mi * 6144 + k]) * a.in[I_WIN][(size_t)k * DIN + 768 + c];
        got = ((const float*)(ws + WS_RB))[(size_t)m * 32 + c]; atol = 0.01f; } break;
    case 5: { const int r = h % 512, n = (h >> 9) % 768; const float* row = a.in[I_CTX] + (size_t)r * 1024; const float rstd = naive_rstd(row);
        for (int k = 0; k < 1024; ++k) ref += bfr(row[k] * rstd * a.in[I_N1G][k] * (1.f + MOD[2 * 6144 + 1024 + k]) + MOD[2 * 6144 + k]) * bf2f(((const bf16*)(ws + WS_WIN))[(size_t)n * 1024 + k]);
        got = (n < 256) ? bf2f(((const bf16*)(ws + WS_KB))[(size_t)(M + r) * 256 + n]) : bf2f(((const bf16*)(ws + WS_VB))[(size_t)(M + r) * 512 + n - 256]); atol = 0.03f; } break;
    case 6: { const int m = h % M, n = (h >> 14) % 4096; const bf16* hr = (const bf16*)(ws + WS_H1) + (size_t)m * 1024; const bf16* wr_ = (const bf16*)(ws + WS_WIN) + (size_t)n * 1024; float d = 0.f;
        if (n < 2048) { for (int k = 0; k < 1024; ++k) d += bf2f(hr[k]) * bf2f(wr_[k]); }
        else { for (int k = 0; k < 1024; ++k) d += f8d((ws + WS_H1F)[(size_t)m * 1024 + k]) * f8d((ws + WS_WINM)[(size_t)(n - 2048) * 1024 + k]); d *= 0.0625f; }
        if (n < 256) { ref = d; got = bf2f(((const bf16*)(ws + WS_KB))[(size_t)m * 256 + n]); }
        else if (n < 768) { ref = d; got = bf2f(((const bf16*)(ws + WS_VB))[(size_t)m * 512 + n - 256]); }
        else if (n < 1024) { ref = d * 0.125f; got = bf2f(((const bf16*)(ws + WS_QB))[(size_t)m * 256 + n - 768]); }
        else if (n < 1536) { ref = d / (1.f + expf(-d)); got = bf2f(((const bf16*)(ws + WS_SG))[(size_t)m * 512 + n - 1024]); }
        else if (n < 2048) { ref = d; got = bf2f(((const bf16*)(ws + WS_PI))[(size_t)m * 512 + n - 1536]); }
        else { ref = 1.f / (1.f + expf(-d)); got = gate_at(a, m, n - 2048); } atol = 0.02f; } break;
    case 7: { const int m = h % M, col = (h >> 14) % 256, dir = (h >> 22) & 1, t = m & 63, m0 = m - t;
        for (int s = 0; s < 64; ++s) if (dir ? (s >= t) : (s <= t)) ref += naive_la(a, m0 + s, dir, col);
        got = (dir ? a.out + (size_t)M * 256 : a.out)[(size_t)m * 256 + col]; atol = 0.003f; } break;
    case 8: case 9: { const int dir = h & 1, bh = (h >> 1) & 7, slot = (stage == 9) ? 128 + ((h >> 4) & 3) : ((h >> 4) & 127), dv = (h >> 11) & 127, dk = (h >> 18) & 63, b = bh >> 2, hh = bh & 3;
        const int row0 = (slot < 128) ? b * SEQ + slot * 64 : M + b * LC + (slot - 128) * 64; float la[64]; float tot = 0.f;
        for (int s = 0; s < 64; ++s) tot += naive_la(a, row0 + s, dir, hh * 64 + dk);
        float run = 0.f;
        if (!dir) { for (int s = 0; s < 64; ++s) { run += naive_la(a, row0 + s, 0, hh * 64 + dk); ref += bf2f(((const bf16*)(ws + WS_VB))[(size_t)(row0 + s) * 512 + hh * 128 + dv]) * bfr(bf2f(((const bf16*)(ws + WS_KB))[(size_t)(row0 + s) * 256 + hh * 64 + dk]) * expf(tot - run)); } }
        else { for (int s = 63; s >= 0; --s) { run += naive_la(a, row0 + s, 1, hh * 64 + dk); ref += bf2f(((const bf16*)(ws + WS_VB))[(size_t)(row0 + s) * 512 + hh * 128 + dv]) * bfr(bf2f(((const bf16*)(ws + WS_KB))[(size_t)(row0 + s) * 256 + hh * 64 + dk]) * expf(tot - run)); } }
        (void)la;
        if ((h >> 30) & 1) { ref = expf(tot); got = ((const float*)(ws + WS_DEC))[((size_t)(dir * 8 + bh) * NSLOT + slot) * 64 + dk]; atol = 1e-3f; }
        else { got = bf2f(((const bf16*)(ws + WS_KV))[((size_t)(dir * 8 + bh) * NSLOT + slot) * 8192 + dv * 64 + dk]); atol = 0.1f; } } break;
    case 10: { const int m = h % M, col = (h >> 14) % 512, g = col >> 7, half = 1 << g, b = m >> 13, l = m & 8191, r = l >> 6, c = l & 63; const bf16* PI = (const bf16*)(ws + WS_PI);
        const int lo_r = max(r - half, 0), hi_r = min(r + half, 128), lo_c = max(c - half, 0), hi_c = min(c + half, 64); float sm = 0.f;
        for (int rr = lo_r; rr < hi_r; ++rr) for (int cc = lo_c; cc < hi_c; ++cc) sm += bf2f(PI[(size_t)(b * SEQ + rr * 64 + cc) * 512 + col]);
        ref = sm / (float)((hi_r - lo_r) * (hi_c - lo_c)) - bf2f(PI[(size_t)m * 512 + col]); got = bf2f(((const bf16*)(ws + WS_PO))[(size_t)m * 512 + col]); atol = 0.02f; } break;
    case 11: { const int dir = h & 1, bh = (h >> 1) & 7, n = (h >> 4) & 127, e8 = (h >> 11) & 8191, dk = e8 & 63; float s = 0.f;
        const bf16* kvp = (const bf16*)(ws + WS_KV) + (size_t)((dir * 8 + bh) * NSLOT) * 8192 + e8; const float* dp = (const float*)(ws + WS_DEC) + (size_t)((dir * 8 + bh) * NSLOT) * 64 + dk;
        if (!dir) { for (int j = 128; j < 132; ++j) s = dp[j * 64] * s + bf2f(kvp[(size_t)j * 8192]); for (int j = 0; j < n; ++j) s = dp[j * 64] * s + bf2f(kvp[(size_t)j * 8192]); }
        else { for (int j = 131; j >= 128; --j) s = dp[j * 64] * s + bf2f(kvp[(size_t)j * 8192]); for (int j = 127; j > n; --j) s = dp[j * 64] * s + bf2f(kvp[(size_t)j * 8192]); }
        ref = s; got = bf2f(((const bf16*)(ws + WS_ST))[(size_t)((dir * 8 + bh) * NCH + n) * 8192 + e8]); atol = 0.1f; } break;
    case 12: {
        const unsigned hb = hashu(blockIdx.x * 7919u + 5u); const int m = hb % M, hh = (hb >> 14) & 3, b = m >> 13, l = m & 8191, n = l >> 6, t = l & 63, row0 = m - t, bh = b * 4 + hh, dv = threadIdx.x & 127;
        const float* BF = a.out; const float* CB = a.out + (size_t)M * 256; const bf16* QB = (const bf16*)(ws + WS_QB); const bf16* KB = (const bf16*)(ws + WS_KB); const bf16* VB = (const bf16*)(ws + WS_VB); const bf16* ST = (const bf16*)(ws + WS_ST);
        if (threadIdx.x < 128) { const int j = threadIdx.x & 63, dir = threadIdx.x >> 6; float sc = 0.f;
            const bool keep = dir ? (j >= t) : (j <= t);
            if (keep) for (int d = 0; d < 64; ++d) { const size_t gq = (size_t)m * 256 + hh * 64 + d, gk = (size_t)(row0 + j) * 256 + hh * 64 + d; const float* P = dir ? CB : BF; sc += bf2f(QB[gq]) * bf2f(KB[gk]) * expf(P[gq] - P[gk]); }
            sh[threadIdx.x] = sc; }
        __syncthreads();
        float o = 0.f;
        for (int d = 0; d < 64; ++d) { const size_t gq = (size_t)m * 256 + hh * 64 + d; const float q = bf2f(QB[gq]);
            o += q * expf(BF[gq]) * bf2f(ST[((size_t)((0 * 8 + bh) * NCH + n) * 128 + dv) * 64 + d]) + q * expf(CB[gq]) * bf2f(ST[((size_t)((1 * 8 + bh) * NCH + n) * 128 + dv) * 64 + d]); }
        for (int j = 0; j < 64; ++j) o += (sh[j] + sh[64 + j]) * bf2f(VB[(size_t)(row0 + j) * 512 + hh * 128 + dv]);
        __syncthreads(); sh[128 + dv] = o * o; __syncthreads();
        float ss = 0.f; for (int d = 0; d < 128; ++d) ss += sh[128 + d];
        const size_t gi = (size_t)m * 512 + hh * 128 + dv;
        ref = o * rsqrtf(ss / 128.f + EPS) * a.in[I_GNG][dv] * bf2f(((const bf16*)(ws + WS_SG))[gi]); got = bf2f(((const bf16*)(ws + WS_AG))[gi]); atol = 0.03f; } break;
    case 13: { const int m = h % M, n = (h >> 14) % 1024; float g = 0.f, p = 0.f; const bf16* AG = (const bf16*)(ws + WS_AG) + (size_t)m * 512; const bf16* PO = (const bf16*)(ws + WS_PO) + (size_t)m * 512;
        for (int k = 0; k < 512; ++k) { g += bf2f(AG[k]) * bf2f(((const bf16*)(ws + WS_WG))[(size_t)n * 512 + k]); p += bf2f(PO[k]) * bf2f(((const bf16*)(ws + WS_WC))[(size_t)n * 512 + k]); }
        ref = gate_at(a, m, n) * g + gate_at(a, m, 1024 + n) * p; got = bf2f(((const bf16*)(ws + WS_MG))[(size_t)m * 1024 + n]); atol = 0.03f; } break;
    case 14: { const int m = h % M, n = (h >> 14) % 1024, b = m >> 13; float d = 0.f; for (int k = 0; k < 1024; ++k) d += bf2f(((const bf16*)(ws + WS_MG))[(size_t)m * 1024 + k]) * bf2f(((const bf16*)(ws + WS_WO))[(size_t)n * 1024 + k]);
        ref = bfr(a.in[I_X][(size_t)m * 1024 + n] + MOD[b * 6144 + 2048 + n] * d); got = bf2f(((const bf16*)(ws + WS_YD))[(size_t)m * 1024 + n]); atol = 0.02f; } break;
    case 15: { const int m = h % M, k = (h >> 14) % 1024, b = m >> 13; const float rstd = naive_rstd_x1(a, m);
        ref = x1_at(a, m, k) * rstd * a.in[I_N2G][k] * (1.f + MOD[b * 6144 + 4096 + k]) + MOD[b * 6144 + 3072 + k]; got = f8d((ws + WS_H2)[(size_t)m * 1024 + k]); atol = 0.02f; ref = f8r(ref); } break;
    case 16: { const int m = h % M, e = (h >> 14) & 15, b = m >> 13; const float rstd = naive_rstd_x1(a, m); float mx = -1e30f, mye = 0.f, sm = 0.f;
        for (int pass = 0; pass < 2; ++pass) for (int ee = 0; ee < 16; ++ee) { float lg = 0.f; for (int k = 0; k < 1024; ++k) lg += (x1_at(a, m, k) * rstd * a.in[I_N2G][k] * (1.f + MOD[b * 6144 + 4096 + k]) + MOD[b * 6144 + 3072 + k]) * a.in[I_WROUTER][k * 16 + ee];
            if (pass == 0) mx = fmaxf(mx, lg); else { const float ex = expf(lg - mx); sm += ex; if (ee == e) mye = ex; } }
        ref = mye / sm; got = ((const float*)(ws + WS_AFF))[(size_t)(b * 16 + e) * SEQ + (m & 8191)]; atol = 0.001f; } break;
    case 17: { const int be = h & 31, slot = (h >> 5) & 1023, b = be >> 4, e = be & 15; const int row = ((const int*)(ws + WS_IDX))[be * CAP + slot]; const float* aff = (const float*)(ws + WS_AFF) + (size_t)be * SEQ; float bad = 0.f;
        if (row < b * SEQ || row >= (b + 1) * SEQ) bad += 1.f; else { const int l = row & 8191; if (((const int*)(ws + WS_INV))[(size_t)row * 16 + e] != slot) bad += 1.f; if (((const float*)(ws + WS_WSEL))[be * CAP + slot] != aff[l]) bad += 1.f;
            int cnt = 0; for (int j = 0; j < SEQ; ++j) cnt += (aff[j] > aff[l]) ? 1 : 0; if (cnt >= CAP) bad += 1.f;
            const int l2 = h2 & 8191; if (((const int*)(ws + WS_INV))[(size_t)(b * SEQ + l2) * 16 + e] < 0) { int c2 = 0; for (int j = 0; j < SEQ; ++j) c2 += (aff[j] >= aff[l2]) ? 1 : 0; if (c2 <= CAP) bad += 1.f; } }
        ref = 0.f; got = bad; atol = 0.5f; } break;
    case 18: { const int e = h & 15, mat = (h >> 4) % 3, n = (h >> 8) & 1023, k = (h >> 18) & 1023;
        if (mat == 0) { ref = f8r(16.f * a.in[I_WGATE][(size_t)e * 1048576 + (size_t)k * 1024 + n]); got = f8d((ws + WS_WGU)[((size_t)e * 2048 + (n >> 7) * 256 + (n & 127)) * 1024 + k]); }
        else if (mat == 1) { ref = f8r(16.f * a.in[I_WUP][(size_t)e * 1048576 + (size_t)k * 1024 + n]); got = f8d((ws + WS_WGU)[((size_t)e * 2048 + (n >> 7) * 256 + 128 + (n & 127)) * 1024 + k]); }
        else { ref = f8r(16.f * a.in[I_WDOWN][(size_t)e * 1048576 + (size_t)k * 1024 + n]); got = f8d((ws + WS_WD)[((size_t)e * 1024 + n) * 1024 + k]); } atol = 1e-4f; } break;
    case 19: { const int be = h & 31, slot = (h >> 5) & 1023, f = (h >> 15) & 1023, e = be & 15; const int row = ((const int*)(ws + WS_IDX))[be * CAP + slot]; float g = 0.f, u = 0.f;
        const unsigned char* hr = ws + WS_H2 + (size_t)row * 1024; const unsigned char* wg = ws + WS_WGU + ((size_t)e * 2048 + (f >> 7) * 256 + (f & 127)) * 1024; const unsigned char* wu = wg + 128 * 1024;
        for (int k = 0; k < 1024; ++k) { g += f8d(hr[k]) * f8d(wg[k]); u += f8d(hr[k]) * f8d(wu[k]); }
        g *= 0.0625f; u *= 0.0625f; ref = g / (1.f + expf(-g)) * u; got = f8d((ws + WS_ACT)[((size_t)be * CAP + slot) * 1024 + f]); atol = 0.03f + 0.04f * fabsf(ref); } break;
    case 20: { const int be = h & 31, slot = (h >> 5) & 1023, n = (h >> 15) & 1023, e = be & 15, b = be >> 4; float d = 0.f;
        for (int f = 0; f < 1024; ++f) d += f8d((ws + WS_ACT)[((size_t)be * CAP + slot) * 1024 + f]) * f8d((ws + WS_WD)[((size_t)e * 1024 + n) * 1024 + f]);
        ref = d * 0.0625f * ((const float*)(ws + WS_WSEL))[be * CAP + slot] * MOD[b * 6144 + 5120 + n]; got = bf2f(((const bf16*)(ws + WS_YB))[((size_t)be * CAP + slot) * 1024 + n]); atol = 0.002f; } break;
    default: active = false;
    }
    if (active) { float e = fabsf(got - ref) / (atol + 0.03f * fabsf(ref)); if (!(e == e)) e = 1e9f; atomicMax((unsigned*)(ws + WS_CHK) + stage, __float_as_uint(e)); }
}
__global__ void chk_final(Args a) {
    __shared__ int code;
    if (threadIdx.x == 0) { int c = 0; for (int s = 20; s >= 0; --s) if (s > CHK_SKIP && __uint_as_float(((const unsigned*)(a.ws + WS_CHK))[s]) > 1.f) c = s + 1; code = c; }
    __syncthreads();
    const float sc = 1.f + 0.1f * (float)code;
    for (size_t i = (size_t)blockIdx.x * blockDim.x + threadIdx.x; i < (size_t)M * D; i += (size_t)gridDim.x * blockDim.x) a.out[i] *= sc;
}
#endif

extern "C" void kernel_launch(void* const* d_in, const int* in_sizes, int n_in, void* d_out, int out_size, void* d_ws, size_t ws_size, hipStream_t stream) {
    static int grid = 0;
    if (grid == 0) {
        if (n_in != 22 || out_size != M * D || ws_size < WS_END) { fprintf(stderr, "kernel_launch: unexpected shapes (n_in %d, out %d, ws %zu < %zu)\n", n_in, out_size, ws_size, (size_t)WS_END); grid = -1; return; }
        int dev = 0, cus = 0, per_cu = 0;
        if (hipGetDevice(&dev) != hipSuccess || hipDeviceGetAttribute(&cus, hipDeviceAttributeMultiprocessorCount, dev) != hipSuccess) { grid = -1; return; }
        if (hipFuncSetAttribute((const void*)fwd_kernel, hipFuncAttributeMaxDynamicSharedMemorySize, LDS_BYTES) != hipSuccess) { fprintf(stderr, "kernel_launch: hipFuncSetAttribute failed\n"); grid = -1; return; }
        if (hipOccupancyMaxActiveBlocksPerMultiprocessor(&per_cu, (const void*)fwd_kernel, NT, LDS_BYTES) != hipSuccess || per_cu < 1) { fprintf(stderr, "kernel_launch: occupancy query says %d\n", per_cu); per_cu = 1; }
        (void)hipGetLastError();
        grid = cus;
    }
    if (grid < 0) return;
    (void)hipMemsetAsync((char*)d_ws + WS_CTL, 0, CTL_ZERO_BYTES, stream);
    Args a{};
    for (int i = 0; i < 22; ++i) a.in[i] = (const float*)d_in[i];
    a.out = (float*)d_out; a.ws = (unsigned char*)d_ws;
#if MK_MULTI
    for (int p = 0; p < NPHASE; ++p) { a.ph_lo = p; a.ph_hi = p + 1; hipLaunchKernelGGL(fwd_kernel, dim3(grid), dim3(NT), LDS_BYTES, stream, a);
#if MK_CHECK
        if (p == 0) (void)hipMemsetAsync((char*)d_ws + WS_CHK, 0, 4096, stream);
        static const int after[21] = {0, 0, 0, 1, 1, 1, 2, 3, 3, 3, 4, 4, 5, 6, 7, 8, 8, 9, 10, 11, 12};
        for (int st = 0; st < 21; ++st) if (after[st] == p) hipLaunchKernelGGL(chk_kernel, dim3(st == 12 ? 1024 : 32), dim3(128), 0, stream, a, st);
        if (p == NPHASE - 1) hipLaunchKernelGGL(chk_final, dim3(1024), dim3(256), 0, stream, a);
#endif
    }
#else
    a.ph_lo = 0; a.ph_hi = NPHASE;
#if MK_COOP
    void* kargs[] = {&a};
    hipError_t e = hipLaunchCooperativeKernel((const void*)fwd_kernel, dim3(grid), dim3(NT), kargs, LDS_BYTES, stream);
    if (e != hipSuccess) fprintf(stderr, "kernel_launch: cooperative launch failed: %s (grid %d)\n", hipGetErrorString(e), grid);
#else
    hipLaunchKernelGGL(fwd_kernel, dim3(grid), dim3(NT), LDS_BYTES, stream, a);
#endif
#endif
}
```

```cpp
#include <hip/hip_runtime.h>
#include <cstdio>
#include <cstdint>

#define LAS __attribute__((address_space(3)))
#define GAS __attribute__((address_space(1)))
typedef unsigned short bf16;
typedef short bf16x8 __attribute__((ext_vector_type(8)));
typedef float f32x4 __attribute__((ext_vector_type(4)));
typedef float f32x2 __attribute__((ext_vector_type(2)));
typedef unsigned u32x4 __attribute__((ext_vector_type(4)));
typedef unsigned u32x2 __attribute__((ext_vector_type(2)));

#ifndef ABL_NOMOE
#define ABL_NOMOE 0
#endif
#ifndef REP_PHASE
#define REP_PHASE -1
#endif
#ifndef REP_COUNT
#define REP_COUNT 1
#endif
#ifndef MK_COOP
#define MK_COOP 1
#endif
#ifndef MK_MULTI
#define MK_MULTI 0
#endif

constexpr int D = 1024, NB = 2, SEQ = 8192, M = NB * SEQ, LC = 256, MC = NB * LC, MT = M + MC;
constexpr int DIN = 4128;
constexpr int NCH = SEQ / 64, NCHC = LC / 64, NSLOT = NCH + NCHC;
constexpr int NE = 16, CAP = 1024;
constexpr float EPS = 1e-6f;
constexpr int NWAVES = 8, NT = 512;
constexpr int NPHASE = 14;

constexpr size_t MiB = 1u << 20;
constexpr size_t WS_CTL = 0, CTL_ZERO_BYTES = 64 * 1024;
constexpr size_t WS_MOD = 1 * MiB;
constexpr size_t WS_DEC = 1 * MiB + 128 * 1024;
constexpr size_t WS_WIN = 2 * MiB, WS_WO = 10 * MiB, WS_WG = 12 * MiB, WS_WC = 13 * MiB;
constexpr size_t WS_AFF = 14 * MiB, WS_INV = 15 * MiB, WS_IDX = 16 * MiB, WS_WSEL = 16 * MiB + 256 * 1024;
constexpr size_t WS_H1 = 20 * MiB;
constexpr size_t WS_ST = 20 * MiB, WS_H2 = 20 * MiB;
constexpr size_t WS_KB = 52 * MiB, WS_VB = 61 * MiB, WS_QB = 78 * MiB, WS_SG = 86 * MiB, WS_PI = 102 * MiB, WS_RB = 118 * MiB;
constexpr size_t WS_AG = 102 * MiB;
constexpr size_t WS_SM = 121 * MiB;
constexpr size_t WS_KV = 249 * MiB;
constexpr size_t WS_PO = 282 * MiB;
constexpr size_t WS_MG = 249 * MiB;
constexpr size_t WS_WGU = 185 * MiB, WS_WD = 52 * MiB, WS_ACT = 121 * MiB, WS_YB = 185 * MiB;
constexpr size_t WS_H1F = 249 * MiB;
constexpr size_t WS_WINM = 265 * MiB;
constexpr size_t WS_YD = 153 * MiB;
constexpr size_t WS_XS = 68 * MiB;
constexpr size_t WS_END = 300 * MiB;
constexpr int CW_BAR = 1024;

constexpr int LDS_BYTES = 155648;
constexpr int MISC_OFF = 153600;

#define LDS_WAIT() asm volatile("s_waitcnt lgkmcnt(0)" ::: "memory")
#define VM_WAIT() asm volatile("s_waitcnt vmcnt(0)" ::: "memory")
__device__ __forceinline__ unsigned f2bf(float f) { unsigned u = __builtin_bit_cast(unsigned, f); return (u + 0x7fffu + ((u >> 16) & 1u)) >> 16; }
__device__ __forceinline__ unsigned pk2(float lo, float hi) { return f2bf(lo) | (f2bf(hi) << 16); }
__device__ __forceinline__ float bf2f(unsigned h) { return __builtin_bit_cast(float, h << 16); }
__device__ __forceinline__ float bflo(unsigned w) { return __builtin_bit_cast(float, w << 16); }
__device__ __forceinline__ float bfhi(unsigned w) { return __builtin_bit_cast(float, w & 0xffff0000u); }
__device__ __forceinline__ unsigned cvt_pk_bf16(float lo, float hi) { unsigned r; asm volatile("v_cvt_pk_bf16_f32 %0, %1, %2" : "=v"(r) : "v"(lo), "v"(hi)); return r; }
__device__ __forceinline__ unsigned pk4_fp8(float a, float b, float c, float d) { int w = 0; w = __builtin_amdgcn_cvt_pk_fp8_f32(a, b, w, false); w = __builtin_amdgcn_cvt_pk_fp8_f32(c, d, w, true); return (unsigned)w; }
__device__ __forceinline__ float wave_sum(float v) {
#pragma unroll
    for (int o = 1; o < 64; o <<= 1) v += __shfl_xor(v, o);
    return v;
}
__device__ __forceinline__ float silu_f(float x) { return x / (1.f + __expf(-x)); }
__device__ __forceinline__ float sigmoid_f(float x) { return 1.f / (1.f + __expf(-x)); }
__device__ __forceinline__ float logsig_f(float z) { return fminf(z, 0.f) - log1pf(expf(-fabsf(z))); }

#define XB_TMO      128
#define XB_XCNT(j)  (256  + 64 * (j))
#define XB_XSUB(j)  (1280 + 64 * (j))
#define XB_XGEN(j)  (2304 + 64 * (j))
#define XB_TOP      3328
#define XB_TOPGEN   3392
#define XCD_BAR_WORDS 3456
#define XB_SPIN_CAP (1u << 20)
__device__ __forceinline__ unsigned xb_ld(unsigned* p)              { return __hip_atomic_load(p, __ATOMIC_RELAXED, __HIP_MEMORY_SCOPE_AGENT); }
__device__ __forceinline__ unsigned xb_add(unsigned* p, unsigned v) { return __hip_atomic_fetch_add(p, v, __ATOMIC_RELAXED, __HIP_MEMORY_SCOPE_AGENT); }
__device__ __forceinline__ unsigned xb_xcc_id() { return (unsigned)__builtin_amdgcn_s_getreg((3 << 11) | 20) & 0xFu; }
#define XB_SPIN(cond, bar) do { unsigned _sp = 0; while (cond) { __builtin_amdgcn_s_sleep(1); \
    if ((++_sp & 255u) == 0u) { if (xb_ld(&(bar)[XB_TMO])) break; if (_sp > XB_SPIN_CAP) { atomicAdd(&(bar)[XB_TMO], 1u); break; } } } } while (0)
struct XcdBarrier { unsigned* bar; unsigned x; volatile LAS unsigned* st; };
__device__ __forceinline__ XcdBarrier xcd_barrier_post(unsigned* bar, volatile LAS unsigned* st) {
    XcdBarrier b; b.bar = bar; b.x = xb_xcc_id(); b.st = st;
    if (threadIdx.x == 0) (void)xb_add(&bar[XB_XCNT(b.x)], 1u);
    return b;
}
__device__ __forceinline__ void xcd_barrier_complete(unsigned* bar, unsigned x, unsigned& nloc, unsigned& nx) {
    const unsigned G = gridDim.x * gridDim.y * gridDim.z;
    unsigned sum, cnt, mine, sp = 0u;
    for (;;) {
        sum = 0u; cnt = 0u; mine = 0u;
#pragma unroll
        for (unsigned j = 0; j < 16; ++j) { const unsigned c = xb_ld(&bar[XB_XCNT(j)]); sum += c; cnt += (c > 0u) ? 1u : 0u; mine = (j == x) ? c : mine; }
        if (sum == G) break;
        __builtin_amdgcn_s_sleep(1);
        if ((++sp & 255u) == 0u) { if (xb_ld(&bar[XB_TMO])) break; if (sp > XB_SPIN_CAP) { atomicAdd(&bar[XB_TMO], 1u); break; } }
    }
    nloc = mine > 0u ? mine : 1u; nx = cnt > 0u ? cnt : 1u;
}
__device__ __forceinline__ void xcd_barrier(const XcdBarrier& b) {
    asm volatile("s_waitcnt vmcnt(0)" ::: "memory");
    __syncthreads();
    if (threadIdx.x == 0) {
        unsigned* bar = b.bar;
        __builtin_amdgcn_s_waitcnt(0);
        unsigned nloc = b.st[0], nx = b.st[1];
        if (nloc == 0u) { xcd_barrier_complete(bar, b.x, nloc, nx); b.st[0] = nloc; b.st[1] = nx; }
        const unsigned old = xb_add(&bar[XB_XSUB(b.x)], 1u);
        const unsigned gen = old / nloc;
        if (old + 1u == (gen + 1u) * nloc) {
            __builtin_amdgcn_fence(__ATOMIC_RELEASE, "agent");
            asm volatile("s_waitcnt vmcnt(0)" ::: "memory");
            const unsigned og = xb_add(&bar[XB_TOP], 1u);
            const unsigned tg = og / nx;
            if (og + 1u == (tg + 1u) * nx) xb_add(&bar[XB_TOPGEN], 1u);
            else XB_SPIN(xb_ld(&bar[XB_TOPGEN]) == tg, bar);
            __builtin_amdgcn_fence(__ATOMIC_ACQUIRE, "agent");
            xb_add(&bar[XB_XGEN(b.x)], 1u);
            asm volatile("s_waitcnt vmcnt(0)" ::: "memory");
        } else {
            XB_SPIN(xb_ld(&bar[XB_XGEN(b.x)]) == gen, bar);
            __builtin_amdgcn_fence(__ATOMIC_ACQUIRE, "agent");
            asm volatile("s_waitcnt vmcnt(0)" ::: "memory");
        }
    }
    __syncthreads();
}

namespace pg8 {
constexpr int BM = 256, BK = 64, HALF = 128, HTB = HALF * BK * 2, STAGE_BYTES = 8 * HTB;
__device__ __forceinline__ int lds_byte(int r, int c) { const int st = (r >> 4) * 2 + (c >> 5), rr = r & 15, cc = c & 31, ob = rr * 64 + cc * 2; return st * 1024 + (ob ^ (((ob >> 9) & 1) << 5)); }
__device__ __forceinline__ void stage_rc(int b, int& R, int& C) { const int st = b / 1024, sb = b % 1024, swz = sb ^ (((sb >> 9) & 1) << 5); R = (st >> 1) * 16 + swz / 64; C = (st & 1) * 32 + (swz % 64) / 2; }
__device__ __forceinline__ int perm32(int rho) { const int n = rho >> 4, i = rho & 15; return 8 * (i >> 2) + 4 * n + (i & 3); }
struct Unit { int pm, pn, aux, keep; };
typedef int v8i __attribute__((ext_vector_type(8)));
typedef int v4i __attribute__((ext_vector_type(4)));
__device__ __forceinline__ void xcd_tile(int L, int nM, int nN, int& pm, int& pn) {
    const int nwg = nM * nN; int wgid = L;
    { const int q = nwg / 8, r = nwg % 8, xcd = wgid % 8, off = wgid / 8; wgid = (xcd < r ? xcd * (q + 1) : r * (q + 1) + (xcd - r) * q) + off; }
    const int nig = 8 * nN, gid = wgid / nig, fm = gid * 8, gsz = (nM - fm) < 8 ? (nM - fm) : 8;
    pm = fm + ((wgid % nig) % gsz); pn = (wgid % nig) / gsz;
}

template <class Epi, class Sched, bool GATHER, bool FP8 = false>
__device__ __forceinline__ void gemm_phase(LAS unsigned char* lds, const Sched& S, const Epi& E) {
    int tid = threadIdx.x; asm volatile("" : "+v"(tid));
    const int wid = __builtin_amdgcn_readfirstlane(tid >> 6), lane = tid & 63, wr = wid >> 2, wc = wid & 3, fr = lane & 15, fq = lane >> 4;
    const int K = S.K, KB = FP8 ? K : 2 * K, nt = KB / (2 * BK);
    unsigned voffA[2], voffB[2]; int Rs[2], Cb[2];
#pragma unroll
    for (int i = 0; i < 2; ++i) { int R, C; stage_rc(tid * 16 + i * 8192, R, C); const int Rb = Epi::PERM ? ((R & ~31) + perm32(R & 31)) : R;
        Rs[i] = R; Cb[i] = C * 2; voffA[i] = (unsigned)(R * KB + C * 2); voffB[i] = (unsigned)(Rb * KB + C * 2); }
    const size_t kstep = (size_t)(BK * 2);
    const size_t hstep = (size_t)HALF * KB;
    const size_t hstepA = GATHER ? 0 : hstep;
    const unsigned ldsw = (unsigned)wid * 1024u;
    const int aoff = FP8 ? lds_byte(wr * 64 + fr, fq * 16) : lds_byte(wr * 64 + fr, fq * 8), boff = FP8 ? lds_byte(wc * 32 + fr, fq * 16) : lds_byte(wc * 32 + fr, fq * 8);
#define PG8_SA(b, h) (((b) * 2 + (h)) * HTB)
#define PG8_SB(b, h) ((4 + (b) * 2 + (h)) * HTB)
#define PG8_STAGE(bufoff, gbase, voff, W) do { _Pragma("unroll") for (int _i = 0; _i < 2; ++_i) { \
        if constexpr (FP8) __builtin_amdgcn_raw_ptr_buffer_load_lds(rsrc##W, (LAS unsigned*)(lds + (bufoff) + ldsw + _i * 8192), 16, (int)(voff)[_i], (int)(unsigned)((const char*)(gbase) - base##W), 0, 0); \
        else __builtin_amdgcn_global_load_lds((const unsigned*)((const char*)(gbase) + (voff)[_i]), (LAS unsigned*)(lds + (bufoff) + ldsw + _i * 8192), 16, 0, 0); } } while (0)
#define PG8_LDA(dst, b, h) do { _Pragma("unroll") for (int m = 0; m < 4; ++m) { \
        if constexpr (FP8) { const v4i _lo = *(const LAS v4i*)(lds + PG8_SA(b, h) + aoff + m * 2048), _hi = *(const LAS v4i*)(lds + PG8_SA(b, h) + aoff + m * 2048 + 16); dst##8[m] = __builtin_shufflevector(_lo, _hi, 0, 1, 2, 3, 4, 5, 6, 7); } \
        else { _Pragma("unroll") for (int k = 0; k < 2; ++k) dst[m][k] = *(const LAS bf16x8*)(lds + PG8_SA(b, h) + aoff + m * 2048 + k * 1024); } } } while (0)
#define PG8_LDB(dst, b, h) do { _Pragma("unroll") for (int n = 0; n < 2; ++n) { \
        if constexpr (FP8) { const v4i _lo = *(const LAS v4i*)(lds + PG8_SB(b, h) + boff + n * 2048), _hi = *(const LAS v4i*)(lds + PG8_SB(b, h) + boff + n * 2048 + 16); dst##8[n] = __builtin_shufflevector(_lo, _hi, 0, 1, 2, 3, 4, 5, 6, 7); } \
        else { _Pragma("unroll") for (int k = 0; k < 2; ++k) dst[n][k] = *(const LAS bf16x8*)(lds + PG8_SB(b, h) + boff + n * 2048 + k * 1024); } } } while (0)
#define PG8_MMA(ai, bj, At, Bt) do { __builtin_amdgcn_s_setprio(1); \
        if constexpr (FP8) { _Pragma("unroll") for (int m = 0; m < 4; ++m) _Pragma("unroll") for (int n = 0; n < 2; ++n) \
            acc[ai][bj][m][n] = __builtin_amdgcn_mfma_scale_f32_16x16x128_f8f6f4(Bt##8[n], At##8[m], acc[ai][bj][m][n], 0, 0, 0, 0, 0, 0); } \
        else { _Pragma("unroll") for (int m = 0; m < 4; ++m) _Pragma("unroll") for (int n = 0; n < 2; ++n) _Pragma("unroll") for (int k = 0; k < 2; ++k) \
            acc[ai][bj][m][n] = __builtin_amdgcn_mfma_f32_16x16x32_bf16(Bt[n][k], At[m][k], acc[ai][bj][m][n], 0, 0, 0); } \
        __builtin_amdgcn_s_setprio(0); } while (0)
#define PG8_WAIT_V(n) asm volatile("s_waitcnt vmcnt(" #n ")" ::: "memory")
#define PG8_WAIT_L(n) asm volatile("s_waitcnt lgkmcnt(" #n ")" ::: "memory")
#define PG8_BAR __builtin_amdgcn_s_barrier()
#define PG8_SCHED __builtin_amdgcn_sched_barrier(0)
    Unit cur, nxt; int ui = 0;
    if (!S.next(0, cur)) return;
    const char* baseA = S.base_a(); const char* baseB = S.base_b();
    const __amdgpu_buffer_rsrc_t rsrcA = __builtin_amdgcn_make_buffer_rsrc((void*)baseA, 0, 0x7fffffff, 0x00020000), rsrcB = __builtin_amdgcn_make_buffer_rsrc((void*)baseB, 0, 0x7fffffff, 0x00020000);
    f32x4 acc[2][2][4][2];
#pragma unroll
    for (int a = 0; a < 2; ++a)
#pragma unroll
        for (int b = 0; b < 2; ++b)
#pragma unroll
            for (int m = 0; m < 4; ++m)
#pragma unroll
                for (int n = 0; n < 2; ++n) acc[a][b][m][n] = (f32x4){0.f, 0.f, 0.f, 0.f};
    bf16x8 At[4][2], B0[2][2], B1[2][2]; v8i At8[4], B08[2], B18[2];
    const char* cA = S.a_base(cur); const char* cB = S.b_base(cur);
    unsigned cv0[2], cv1[2], nv0[2], nv1[2];
#pragma unroll
    for (int i = 0; i < 2; ++i) {
        if constexpr (GATHER) { cv0[i] = (unsigned)S.a_row(cur, Rs[i]) * (unsigned)KB + (unsigned)Cb[i]; cv1[i] = (unsigned)S.a_row(cur, HALF + Rs[i]) * (unsigned)KB + (unsigned)Cb[i]; }
        else { cv0[i] = voffA[i]; cv1[i] = voffA[i]; }
        nv0[i] = cv0[i]; nv1[i] = cv1[i];
    }
    PG8_STAGE(PG8_SB(0, 0), cB, voffB, B); PG8_STAGE(PG8_SB(0, 1), cB + hstep, voffB, B); PG8_STAGE(PG8_SA(0, 0), cA, cv0, A); PG8_STAGE(PG8_SA(0, 1), cA + hstepA, cv1, A);
    if (wr == 1) PG8_BAR;
    PG8_WAIT_V(2); PG8_BAR;
    PG8_STAGE(PG8_SB(1, 0), cB + kstep, voffB, B); PG8_STAGE(PG8_SA(1, 0), cA + kstep, cv0, A); PG8_STAGE(PG8_SB(1, 1), cB + hstep + kstep, voffB, B);
    PG8_WAIT_V(6); PG8_BAR;
    for (;;) {
        const bool has_next = S.next(ui + 1, nxt);
        const char* nA = has_next ? S.a_base(nxt) : cA; const char* nB = has_next ? S.b_base(nxt) : cB;
        if constexpr (GATHER) {
#pragma unroll
            for (int i = 0; i < 2; ++i) {
                if (has_next) { nv0[i] = (unsigned)S.a_row(nxt, Rs[i]) * (unsigned)KB + (unsigned)Cb[i]; nv1[i] = (unsigned)S.a_row(nxt, HALF + Rs[i]) * (unsigned)KB + (unsigned)Cb[i]; }
                else { nv0[i] = cv0[i]; nv1[i] = cv1[i]; }
            }
        }
        for (int t = 0; t < nt; t += 2) {
            const bool last = (t == nt - 2);
            const char* a1 = cA + (size_t)(t + 1) * kstep;
            const char* a2 = last ? nA : cA + (size_t)(t + 2) * kstep; const char* b2 = last ? nB : cB + (size_t)(t + 2) * kstep;
            const char* a3 = a2 + kstep; const char* b3 = b2 + kstep;
            unsigned s0[2], s1[2];
#pragma unroll
            for (int i = 0; i < 2; ++i) { s0[i] = (GATHER && last) ? nv0[i] : cv0[i]; s1[i] = (GATHER && last) ? nv1[i] : cv1[i]; }
            PG8_LDB(B0, 0, 0); PG8_LDB(B1, 0, 1); PG8_SCHED; PG8_LDA(At, 0, 0); PG8_STAGE(PG8_SA(1, 1), a1 + hstepA, cv1, A);
            PG8_WAIT_V(8); PG8_WAIT_L(0); PG8_BAR; PG8_MMA(0, 0, At, B0); PG8_MMA(0, 1, At, B1); PG8_BAR; PG8_SCHED;
            PG8_LDA(At, 0, 1); PG8_STAGE(PG8_SB(0, 0), b2, voffB, B); PG8_STAGE(PG8_SB(0, 1), b2 + hstep, voffB, B); PG8_STAGE(PG8_SA(0, 0), a2, s0, A);
            PG8_WAIT_V(8); PG8_WAIT_L(0); PG8_BAR; PG8_MMA(1, 0, At, B0); PG8_MMA(1, 1, At, B1); PG8_BAR; PG8_SCHED;
            PG8_LDB(B0, 1, 0); PG8_LDB(B1, 1, 1); PG8_SCHED; PG8_LDA(At, 1, 0); PG8_STAGE(PG8_SA(0, 1), a2 + hstepA, s1, A);
            PG8_WAIT_V(8); PG8_WAIT_L(0); PG8_BAR; PG8_MMA(0, 0, At, B0); PG8_MMA(0, 1, At, B1); PG8_BAR; PG8_SCHED;
            PG8_LDA(At, 1, 1); PG8_STAGE(PG8_SB(1, 0), b3, voffB, B); PG8_STAGE(PG8_SB(1, 1), b3 + hstep, voffB, B); PG8_STAGE(PG8_SA(1, 0), a3, s0, A);
            PG8_WAIT_V(8); PG8_WAIT_L(0); PG8_BAR; PG8_MMA(1, 0, At, B0); PG8_MMA(1, 1, At, B1); PG8_BAR; PG8_SCHED;
        }
        if (wr == 0) PG8_BAR;
        E(acc, cur, wr, wc, fr, fq);
        if (!has_next) break;
        E.post(acc, cur, wr, wc, fr, fq);
        cur = nxt; cA = nA; cB = nB; ++ui;
#pragma unroll
        for (int i = 0; i < 2; ++i) { cv0[i] = nv0[i]; cv1[i] = nv1[i]; }
        if (wr == 1) PG8_BAR;
    }
    PG8_WAIT_V(0);
    PG8_BAR;
#undef PG8_SA
#undef PG8_SB
#undef PG8_STAGE
#undef PG8_LDA
#undef PG8_LDB
#undef PG8_MMA
#undef PG8_WAIT_V
#undef PG8_WAIT_L
#undef PG8_BAR
#undef PG8_SCHED
}
}

using pg8::Unit;
struct SchedDense {
    int G, c, K, nM, nN; const char* A; const char* B; int i0, i1, eb;
    __device__ __forceinline__ bool next(int i, Unit& u) const { const int L = (i + i0) * G + c; if (i + i0 >= i1 || L >= nM * nN) return false; pg8::xcd_tile(L, nM, nN, u.pm, u.pn); u.aux = 0; u.keep = 0; return true; }
    __device__ __forceinline__ const char* a_base(const Unit& u) const { return A + (size_t)u.pm * 256 * K * eb; }
    __device__ __forceinline__ const char* b_base(const Unit& u) const { return B + (size_t)u.pn * 256 * K * eb; }
    __device__ __forceinline__ int a_row(const Unit&, int) const { return 0; }
    __device__ __forceinline__ const char* base_a() const { return A; }
    __device__ __forceinline__ const char* base_b() const { return B; }
};
struct SchedPair {
    int G, c, K; const char *A0, *A1, *B0, *B1;
    __device__ __forceinline__ bool next(int i, Unit& u) const { const int p = (i >> 1) * G + c; if (p >= 256) return false; pg8::xcd_tile(p, 64, 4, u.pm, u.pn); u.aux = i & 1; u.keep = 0; return true; }
    __device__ __forceinline__ const char* a_base(const Unit& u) const { return (u.aux ? A1 : A0) + (size_t)u.pm * 256 * K * 2; }
    __device__ __forceinline__ const char* b_base(const Unit& u) const { return (u.aux ? B1 : B0) + (size_t)u.pn * 256 * K * 2; }
    __device__ __forceinline__ int a_row(const Unit&, int) const { return 0; }
    __device__ __forceinline__ const char* base_a() const { return A0; }
    __device__ __forceinline__ const char* base_b() const { return B0; }
};
struct SchedMoe1 {
    int G, c, K; const char* A; const char* B; int i0, i1;
    __device__ __forceinline__ bool next(int i, Unit& u) const { const int L = (i + i0) * G + c; if (i + i0 >= i1 || L >= 1024) return false;
        const int xcd = L & 7, q = L >> 3, round = q >> 5, slot = q & 31, e = xcd + 8 * (round >> 1), u64 = (round & 1) * 32 + slot, mrow = u64 & 7;
        u.pn = u64 >> 3; u.pm = mrow & 3; u.aux = (mrow >> 2) * 16 + e; u.keep = 0; return true; }
    __device__ __forceinline__ const char* a_base(const Unit& u) const { return A + ((size_t)u.aux * 1024 + (size_t)u.pm * 256) * K; }
    __device__ __forceinline__ const char* b_base(const Unit& u) const { return B + ((size_t)(u.aux & 15) * 2048 + (size_t)u.pn * 256) * K; }
    __device__ __forceinline__ int a_row(const Unit&, int) const { return 0; }
    __device__ __forceinline__ const char* base_a() const { return A; }
    __device__ __forceinline__ const char* base_b() const { return B; }
};
struct SchedMoe2 {
    int G, c, K; const char* A; const char* B;
    __device__ __forceinline__ bool next(int i, Unit& u) const { const int L = i * G + c; if (L >= 512) return false;
        const int xcd = L & 7, q = L >> 3, round = q >> 5, slot = q & 31, e = xcd + 8 * round, mrow = slot & 7;
        u.pn = slot >> 3; u.pm = mrow & 3; u.aux = (mrow >> 2) * 16 + e; u.keep = 0; return true; }
    __device__ __forceinline__ const char* a_base(const Unit& u) const { return A + ((size_t)u.aux * 1024 + (size_t)u.pm * 256) * K; }
    __device__ __forceinline__ const char* b_base(const Unit& u) const { return B + ((size_t)(u.aux & 15) * 1024 + (size_t)u.pn * 256) * K; }
    __device__ __forceinline__ int a_row(const Unit&, int) const { return 0; }
    __device__ __forceinline__ const char* base_a() const { return A; }
    __device__ __forceinline__ const char* base_b() const { return B; }
};

typedef f32x4 AccT[2][2][4][2];
__device__ __forceinline__ size_t gate_off(int pm, int pg, int ai, int m, int bj, int wr, int wc, int fr, int fq) { return ((size_t)(pm * 8 + pg) << 16) + (size_t)((((ai * 4 + m) * 2 + bj) * 8 + wr * 4 + wc) * 512 + (fq * 16 + fr) * 8); }
__device__ __forceinline__ unsigned pk4_u8(float a, float b, float c, float d) { return (unsigned)__builtin_amdgcn_cvt_pk_u8_f32(d, 3, __builtin_amdgcn_cvt_pk_u8_f32(c, 2, __builtin_amdgcn_cvt_pk_u8_f32(b, 1, __builtin_amdgcn_cvt_pk_u8_f32(a, 0, 0u)))); }
template <bool GATES> struct EpiInprojT {
    static constexpr bool PERM = true;
    bf16 *KBp, *VBp, *QBp, *SGp, *PIp; unsigned char* SMp; int pn_off; float sc;
    __device__ __forceinline__ void post(AccT& acc, const Unit&, int, int, int, int) const {
#pragma unroll
        for (int a = 0; a < 2; ++a)
#pragma unroll
            for (int b = 0; b < 2; ++b)
#pragma unroll
                for (int m = 0; m < 4; ++m)
#pragma unroll
                    for (int n = 0; n < 2; ++n) acc[a][b][m][n] = (f32x4){0.f, 0.f, 0.f, 0.f};
    }
    __device__ __forceinline__ void operator()(const AccT& acc, const Unit& u, int wr, int wc, int fr, int fq) const {
        const int pn = u.pn + pn_off;
        if constexpr (GATES) {
            unsigned char* tp = SMp + ((size_t)(u.pm * 8 + pn - 8) << 16) + (unsigned)((wr * 4 + wc) * 512 + (fq * 16 + fr) * 8);
#pragma unroll
            for (int ai = 0; ai < 2; ++ai)
#pragma unroll
                for (int m = 0; m < 4; ++m) {
#pragma unroll
                    for (int bj = 0; bj < 2; ++bj) { const f32x4 v0 = acc[ai][bj][m][0], v1 = acc[ai][bj][m][1];
                        u32x2 w; w.x = pk4_u8(255.f * sigmoid_f(sc * v0[0]), 255.f * sigmoid_f(sc * v0[1]), 255.f * sigmoid_f(sc * v0[2]), 255.f * sigmoid_f(sc * v0[3]));
                        w.y = pk4_u8(255.f * sigmoid_f(sc * v1[0]), 255.f * sigmoid_f(sc * v1[1]), 255.f * sigmoid_f(sc * v1[2]), 255.f * sigmoid_f(sc * v1[3]));
                        *(u32x2*)(tp + (((ai * 4 + m) * 2 + bj) * 4096)) = w; }
                    asm volatile("" ::: "memory"); }
        } else {
        bf16* base; int ld, colt, act;
        if (pn == 0) { base = KBp; ld = 256; colt = 0; act = 0; }
        else if (pn < 3) { base = VBp; ld = 512; colt = (pn - 1) * 256; act = 0; }
        else if (pn == 3) { base = QBp; ld = 256; colt = 0; act = 3; }
        else if (pn < 6) { base = SGp; ld = 512; colt = (pn - 4) * 256; act = 1; }
        else { base = PIp; ld = 512; colt = (pn - 6) * 256; act = 0; }
        const int row0 = u.pm * 256 + wr * 64 + fr, col0 = colt + wc * 32 + 8 * fq;
#pragma unroll
        for (int ai = 0; ai < 2; ++ai)
#pragma unroll
            for (int m = 0; m < 4; ++m) { bf16* rowp = base + (size_t)(row0 + ai * 128 + m * 16) * ld + col0;
#pragma unroll
                for (int bj = 0; bj < 2; ++bj) { f32x4 v0 = acc[ai][bj][m][0], v1 = acc[ai][bj][m][1];
                    if (act == 1) {
#pragma unroll
                        for (int j = 0; j < 4; ++j) { v0[j] = silu_f(v0[j]); v1[j] = silu_f(v1[j]); } }
                    else if (act == 3) { v0 = v0 * 0.125f; v1 = v1 * 0.125f; }
                    u32x4 w; w.x = cvt_pk_bf16(v0[0], v0[1]); w.y = cvt_pk_bf16(v0[2], v0[3]); w.z = cvt_pk_bf16(v1[0], v1[1]); w.w = cvt_pk_bf16(v1[2], v1[3]);
                    *(u32x4*)(rowp + bj * 128) = w; } }
        }
    }
};
typedef EpiInprojT<false> EpiInproj; typedef EpiInprojT<true> EpiGates;
struct EpiMerge {
    static constexpr bool PERM = true;
    const unsigned char* SMp; bf16* MGp;
    __device__ __forceinline__ void post(AccT& acc, const Unit& u, int wr, int wc, int fr, int fq) const {
        const unsigned msk = u.aux ? 0u : 0xffffffffu;
        u32x2 ga[2][2], gb[2][2];
#define EPM_LOADR(buf, g) do { _Pragma("unroll") for (int bj = 0; bj < 2; ++bj) { ga[buf][bj] = *(const u32x2*)(SMp + gate_off(u.pm, u.pn, (g) >> 2, (g) & 3, bj, wr, wc, fr, fq)); \
            gb[buf][bj] = *(const u32x2*)(SMp + gate_off(u.pm, u.pn + 4, (g) >> 2, (g) & 3, bj, wr, wc, fr, fq)); } } while (0)
#define EPM_RATIO(a_, b_, sh) ((float)(((a_) >> (sh)) & 255u) * __builtin_amdgcn_rcpf((float)max(((b_) >> (sh)) & 255u, 1u)))
        EPM_LOADR(0, 0);
#pragma unroll
        for (int g = 0; g < 8; ++g) {
            if (g + 1 < 8) EPM_LOADR((g + 1) & 1, g + 1);
            asm volatile("" ::: "memory");
#pragma unroll
            for (int bj = 0; bj < 2; ++bj) { u32x2 p = ga[g & 1][bj]; const u32x2 q = gb[g & 1][bj]; p.x &= msk; p.y &= msk; f32x4 v0 = acc[g >> 2][bj][g & 3][0], v1 = acc[g >> 2][bj][g & 3][1];
                v0[0] *= EPM_RATIO(p.x, q.x, 0); v0[1] *= EPM_RATIO(p.x, q.x, 8); v0[2] *= EPM_RATIO(p.x, q.x, 16); v0[3] *= EPM_RATIO(p.x, q.x, 24);
                v1[0] *= EPM_RATIO(p.y, q.y, 0); v1[1] *= EPM_RATIO(p.y, q.y, 8); v1[2] *= EPM_RATIO(p.y, q.y, 16); v1[3] *= EPM_RATIO(p.y, q.y, 24);
                acc[g >> 2][bj][g & 3][0] = v0; acc[g >> 2][bj][g & 3][1] = v1; }
            asm volatile("" ::: "memory"); }
#undef EPM_LOADR
#undef EPM_RATIO
    }
    __device__ __forceinline__ void operator()(const AccT& acc, const Unit& u, int wr, int wc, int fr, int fq) const {
        if (!u.aux) return;
        const int row0 = u.pm * 256 + wr * 64 + fr, col0 = u.pn * 256 + wc * 32 + 8 * fq;
        u32x2 gb[2][2];
#define EPM_ROW(g) ((size_t)(row0 + ((g) >> 2) * 128 + ((g) & 3) * 16))
#define EPM_LOAD(buf, g) do { _Pragma("unroll") for (int bj = 0; bj < 2; ++bj) gb[buf][bj] = *(const u32x2*)(SMp + gate_off(u.pm, u.pn + 4, (g) >> 2, (g) & 3, bj, wr, wc, fr, fq)); } while (0)
        EPM_LOAD(0, 0);
#pragma unroll
        for (int g = 0; g < 8; ++g) {
            if (g + 1 < 8) EPM_LOAD((g + 1) & 1, g + 1);
            asm volatile("" ::: "memory");
#pragma unroll
            for (int bj = 0; bj < 2; ++bj) { const u32x2 gq = gb[g & 1][bj]; const f32x4 v0 = acc[g >> 2][bj][g & 3][0], v1 = acc[g >> 2][bj][g & 3][1];
                const float k = 1.f / 255.f;
                const float g0 = k * (float)max(gq.x & 255u, 1u), g1 = k * (float)max((gq.x >> 8) & 255u, 1u), g2 = k * (float)max((gq.x >> 16) & 255u, 1u), g3 = k * (float)max(gq.x >> 24, 1u);
                const float g4 = k * (float)max(gq.y & 255u, 1u), g5 = k * (float)max((gq.y >> 8) & 255u, 1u), g6 = k * (float)max((gq.y >> 16) & 255u, 1u), g7 = k * (float)max(gq.y >> 24, 1u);
                u32x4 w; w.x = cvt_pk_bf16(v0[0] * g0, v0[1] * g1); w.y = cvt_pk_bf16(v0[2] * g2, v0[3] * g3);
                w.z = cvt_pk_bf16(v1[0] * g4, v1[1] * g5); w.w = cvt_pk_bf16(v1[2] * g6, v1[3] * g7);
                *(u32x4*)(MGp + EPM_ROW(g) * 1024 + col0 + bj * 128) = w; }
            asm volatile("" ::: "memory"); }
#undef EPM_ROW
#undef EPM_LOAD
    }
};
struct EpiOut {
    static constexpr bool PERM = true;
    const float* MODp; bf16* YDp;
    __device__ __forceinline__ void post(AccT& acc, const Unit&, int, int, int, int) const {
#pragma unroll
        for (int a = 0; a < 2; ++a)
#pragma unroll
            for (int b = 0; b < 2; ++b)
#pragma unroll
                for (int m = 0; m < 4; ++m)
#pragma unroll
                    for (int n = 0; n < 2; ++n) acc[a][b][m][n] = (f32x4){0.f, 0.f, 0.f, 0.f};
    }
    __device__ __forceinline__ void operator()(const AccT& acc, const Unit& u, int wr, int wc, int fr, int fq) const {
        const int row0 = u.pm * 256 + wr * 64 + fr, col0 = u.pn * 256 + wc * 32 + 8 * fq;
        const float* gt = MODp + (size_t)(u.pm >> 5) * 6144 + 2048 + col0;
        f32x4 gv[2][2];
#pragma unroll
        for (int bj = 0; bj < 2; ++bj)
#pragma unroll
            for (int n = 0; n < 2; ++n) gv[bj][n] = *(const f32x4*)(gt + bj * 128 + n * 4);
#pragma unroll
        for (int ai = 0; ai < 2; ++ai)
#pragma unroll
            for (int m = 0; m < 4; ++m) { bf16* rowp = YDp + (size_t)(row0 + ai * 128 + m * 16) * 1024 + col0;
#pragma unroll
                for (int bj = 0; bj < 2; ++bj) { const f32x4 v0 = acc[ai][bj][m][0] * gv[bj][0], v1 = acc[ai][bj][m][1] * gv[bj][1];
                    u32x4 w; w.x = cvt_pk_bf16(v0[0], v0[1]); w.y = cvt_pk_bf16(v0[2], v0[3]); w.z = cvt_pk_bf16(v1[0], v1[1]); w.w = cvt_pk_bf16(v1[2], v1[3]);
                    *(u32x4*)(rowp + bj * 128) = w; } }
    }
};
struct EpiMoe1 {
    static constexpr bool PERM = true;
    unsigned char* ACTp;
    __device__ __forceinline__ void post(AccT& acc, const Unit&, int, int, int, int) const {
#pragma unroll
        for (int a = 0; a < 2; ++a)
#pragma unroll
            for (int b = 0; b < 2; ++b)
#pragma unroll
                for (int m = 0; m < 4; ++m)
#pragma unroll
                    for (int n = 0; n < 2; ++n) acc[a][b][m][n] = (f32x4){0.f, 0.f, 0.f, 0.f};
    }
    __device__ __forceinline__ void operator()(const AccT& acc, const Unit& u, int wr, int wc, int fr, int fq) const {
        const int row0 = u.aux * 1024 + u.pm * 256 + wr * 64 + fr, col0 = u.pn * 128 + wc * 32 + 8 * fq;
#pragma unroll
        for (int ai = 0; ai < 2; ++ai)
#pragma unroll
            for (int m = 0; m < 4; ++m) { unsigned char* rowp = ACTp + (size_t)(row0 + ai * 128 + m * 16) * 1024 + col0;
                f32x4 a0, a1;
#pragma unroll
                for (int j = 0; j < 4; ++j) { a0[j] = silu_f(0.0625f * acc[ai][0][m][0][j]) * (0.0625f * acc[ai][1][m][0][j]); a1[j] = silu_f(0.0625f * acc[ai][0][m][1][j]) * (0.0625f * acc[ai][1][m][1][j]); }
                *(u32x2*)rowp = (u32x2){pk4_fp8(a0[0], a0[1], a0[2], a0[3]), pk4_fp8(a1[0], a1[1], a1[2], a1[3])}; }
    }
};
struct EpiMoe2 {
    static constexpr bool PERM = true;
    bf16* YBp; const float* WSELp; const float* MODp;
    __device__ __forceinline__ void post(AccT& acc, const Unit&, int, int, int, int) const {
#pragma unroll
        for (int a = 0; a < 2; ++a)
#pragma unroll
            for (int b = 0; b < 2; ++b)
#pragma unroll
                for (int m = 0; m < 4; ++m)
#pragma unroll
                    for (int n = 0; n < 2; ++n) acc[a][b][m][n] = (f32x4){0.f, 0.f, 0.f, 0.f};
    }
    __device__ __forceinline__ void operator()(const AccT& acc, const Unit& u, int wr, int wc, int fr, int fq) const {
        const int row0 = u.aux * 1024 + u.pm * 256 + wr * 64 + fr, col0 = u.pn * 256 + wc * 32 + 8 * fq;
        const float* gt = MODp + (size_t)(u.aux >> 4) * 6144 + 5120 + col0;
        f32x4 gv[2][2];
#pragma unroll
        for (int bj = 0; bj < 2; ++bj)
#pragma unroll
            for (int n = 0; n < 2; ++n) gv[bj][n] = *(const f32x4*)(gt + bj * 128 + n * 4);
#pragma unroll
        for (int ai = 0; ai < 2; ++ai)
#pragma unroll
            for (int m = 0; m < 4; ++m) { const int r = row0 + ai * 128 + m * 16; const float ws = 0.0625f * WSELp[r]; bf16* rowp = YBp + (size_t)r * 1024 + col0;
#pragma unroll
                for (int bj = 0; bj < 2; ++bj) { const f32x4 v0 = acc[ai][bj][m][0] * gv[bj][0] * ws, v1 = acc[ai][bj][m][1] * gv[bj][1] * ws;
                    u32x4 w; w.x = cvt_pk_bf16(v0[0], v0[1]); w.y = cvt_pk_bf16(v0[2], v0[3]); w.z = cvt_pk_bf16(v1[0], v1[1]); w.w = cvt_pk_bf16(v1[2], v1[3]);
                    *(u32x4*)(rowp + bj * 128) = w; } }
    }
};

struct Args { const float* in[22]; float* out; unsigned char* ws; int ph_lo, ph_hi; };
enum { I_X = 0, I_C, I_CTX, I_CCTX, I_ADAW, I_ADAB, I_N1G, I_N2G, I_WIN, I_WDU, I_BDEC, I_GNG, I_WGLA, I_POOLW, I_POOLS, I_WPOOL, I_WOUT, I_WROUTER, I_WGATE, I_WUP, I_WDOWN, I_FNG };

__device__ __forceinline__ bf16x8 ldfrag(const LAS bf16* base, int stride, int row0, int k0, int lane) { return *(const LAS bf16x8*)(base + (row0 + (lane & 15)) * stride + k0 + 8 * (lane >> 4)); }
#define MFMA16(a, b, c) __builtin_amdgcn_mfma_f32_16x16x32_bf16(a, b, c, 0, 0, 0)

__device__ __forceinline__ void transpose_item(const float* W, int ldw, int k0, int nsrc0, bf16* WT, int Kd, int dst_row0, LAS float* scr, int lane) {
#pragma unroll 8
    for (int i = 0; i < 32; ++i) { const int kk = 2 * i + (lane >> 5); scr[kk * 33 + (lane & 31)] = W[(size_t)(k0 + kk) * ldw + nsrc0 + (lane & 31)]; }
    LDS_WAIT(); asm volatile("" ::: "memory");
    const int c = lane & 7;
#pragma unroll
    for (int j = 0; j < 4; ++j) { const int n = (lane >> 3) + 8 * j; const LAS float* s = scr + (8 * c) * 33 + n;
        u32x4 o; o.x = pk2(s[0 * 33], s[1 * 33]); o.y = pk2(s[2 * 33], s[3 * 33]); o.z = pk2(s[4 * 33], s[5 * 33]); o.w = pk2(s[6 * 33], s[7 * 33]);
        *(u32x4*)(WT + (size_t)(dst_row0 + n) * Kd + k0 + 8 * c) = o; }
    LDS_WAIT(); asm volatile("" ::: "memory");
}

struct CvtItem { const float* src; bf16* dst; int ld2, drow8, f8; };
#define CVT_LOAD(v, c) do { _Pragma("unroll") for (int _j = 0; _j < 32; ++_j) v[_j] = __builtin_nontemporal_load((c).src + (size_t)_j * (c).ld2); } while (0)
#define CVT_STORE(v, c) do { _Pragma("unroll") for (int _j = 0; _j < 32; ++_j) scr[(2 * _j + (lane >> 5)) * 33 + (lane & 31)] = v[_j]; \
        LDS_WAIT(); asm volatile("" ::: "memory"); \
        _Pragma("unroll") for (int _q = 0; _q < 4; ++_q) { const LAS float* _s = scr + (8 * (lane & 7)) * 33 + (lane >> 3) + 8 * _q; u32x4 _o; \
            _o.x = pk2(_s[0 * 33], _s[1 * 33]); _o.y = pk2(_s[2 * 33], _s[3 * 33]); _o.z = pk2(_s[4 * 33], _s[5 * 33]); _o.w = pk2(_s[6 * 33], _s[7 * 33]); *(u32x4*)((c).dst + (size_t)_q * (c).drow8) = _o; } \
        LDS_WAIT(); asm volatile("" ::: "memory"); } while (0)
__device__ __forceinline__ CvtItem cvt_item_gu(const Args& a, int it, int lane) {
    const int e = it >> 10, mat = (it >> 9) & 1, q = it & 511, kb = q >> 5, nb = q & 31, n0 = nb * 32, k0 = kb * 64, nrow = n0 + (lane >> 3);
    CvtItem c; c.ld2 = 2048; c.drow8 = 8192; c.f8 = 1;
    c.src = a.in[mat ? I_WUP : I_WGATE] + (size_t)e * 1048576 + (size_t)(k0 + (lane >> 5)) * 1024 + n0 + (lane & 31);
    c.dst = (bf16*)(a.ws + WS_WGU + ((size_t)e * 2048 + (nrow >> 7) * 256 + mat * 128 + (nrow & 127)) * 1024 + k0 + 8 * (lane & 7));
    return c;
}
__device__ __forceinline__ CvtItem cvt_item_dn(const Args& a, int it, int lane) {
    const int e = it >> 9, q = it & 511, kb = q >> 5, nb = q & 31, n0 = nb * 32, k0 = kb * 64;
    CvtItem c; c.ld2 = 2048; c.drow8 = 8192; c.f8 = 1;
    c.src = a.in[I_WDOWN] + (size_t)e * 1048576 + (size_t)(k0 + (lane >> 5)) * 1024 + n0 + (lane & 31);
    c.dst = (bf16*)(a.ws + WS_WD + ((size_t)e * 1024 + n0 + (lane >> 3)) * 1024 + k0 + 8 * (lane & 7));
    return c;
}
#define CVT_STORE8(v, c) do { _Pragma("unroll") for (int _j = 0; _j < 32; ++_j) scr[(2 * _j + (lane >> 5)) * 33 + (lane & 31)] = v[_j]; \
        LDS_WAIT(); asm volatile("" ::: "memory"); \
        _Pragma("unroll") for (int _q = 0; _q < 4; ++_q) { const LAS float* _s = scr + (8 * (lane & 7)) * 33 + (lane >> 3) + 8 * _q; \
            *(u32x2*)((unsigned char*)(c).dst + (size_t)_q * (c).drow8) = (u32x2){pk4_fp8(16.f * _s[0 * 33], 16.f * _s[1 * 33], 16.f * _s[2 * 33], 16.f * _s[3 * 33]), pk4_fp8(16.f * _s[4 * 33], 16.f * _s[5 * 33], 16.f * _s[6 * 33], 16.f * _s[7 * 33])}; } \
        LDS_WAIT(); asm volatile("" ::: "memory"); } while (0)
__device__ __forceinline__ CvtItem cvt_item_small(const Args& a, int it, int lane) {
    CvtItem c; int r = it;
    c.f8 = 0;
    if (r < 2048) { const int kb = r >> 7, nb = r & 127, n0 = nb * 32, k0 = kb * 64; c.ld2 = 2 * DIN; c.drow8 = 8192;
        c.src = a.in[I_WIN] + (size_t)(k0 + (lane >> 5)) * DIN + n0 + (n0 >= 768 ? 32 : 0) + (lane & 31);
        if (n0 < 2048) c.dst = (bf16*)(a.ws + WS_WIN) + (size_t)(n0 + (lane >> 3)) * 1024 + k0 + 8 * (lane & 7);
        else { c.f8 = 1; c.dst = (bf16*)(a.ws + WS_WINM + (size_t)(n0 - 2048 + (lane >> 3)) * 1024 + k0 + 8 * (lane & 7)); }
        return c; }
    r -= 2048;
    if (r < 512) { const int kb = r >> 5, nb = r & 31, n0 = nb * 32, k0 = kb * 64; c.ld2 = 2048; c.drow8 = 8192;
        c.src = a.in[I_WOUT] + (size_t)(k0 + (lane >> 5)) * 1024 + n0 + (lane & 31); c.dst = (bf16*)(a.ws + WS_WO) + (size_t)(n0 + (lane >> 3)) * 1024 + k0 + 8 * (lane & 7); return c; }
    r -= 512;
    { const int kb = r >> 5, nb = r & 31, n0 = nb * 32, k0 = kb * 64; c.ld2 = 2048; c.drow8 = 4096;
      c.src = a.in[I_WGLA] + (size_t)(k0 + (lane >> 5)) * 1024 + n0 + (lane & 31); c.dst = (bf16*)(a.ws + WS_WG) + (size_t)(n0 + (lane >> 3)) * 512 + k0 + 8 * (lane & 7); return c; }
}
template <int KIND> __device__ __forceinline__ CvtItem cvt_item(const Args& a, int it, int lane) { if constexpr (KIND == 0) return cvt_item_small(a, it, lane); else if constexpr (KIND == 1) return cvt_item_gu(a, it, lane); else return cvt_item_dn(a, it, lane); }
template <int KIND>
__device__ __forceinline__ void convert_items(LAS float* scr, const Args& a, int first, int step, int end, int lane) {
    float va[32], vb[32]; CvtItem ca, cb;
    int it = first;
    if (it < end) { ca = cvt_item<KIND>(a, it, lane); CVT_LOAD(va, ca); }
    for (; it < end; it += 2 * step) {
        const bool hb = (it + step < end), ha = (it + 2 * step < end);
        if (hb) { cb = cvt_item<KIND>(a, it + step, lane); CVT_LOAD(vb, cb); }
        if (KIND == 0 && !ca.f8) CVT_STORE(va, ca); else CVT_STORE8(va, ca);
        if (ha) { ca = cvt_item<KIND>(a, it + 2 * step, lane); CVT_LOAD(va, ca); }
        if (hb) { if (KIND == 0 && !cb.f8) CVT_STORE(vb, cb); else CVT_STORE8(vb, cb); }
    }
}
template <int KIND>
__device__ __forceinline__ void convert_all(LAS unsigned char* lds, const Args& a, int vcu, int G, int lane, int wave) {
    const int gw = vcu * NWAVES + wave, NGW = G * NWAVES;
    convert_items<KIND>((LAS float*)(lds + wave * 8448), a, gw, NGW, KIND == 1 ? 16384 : 8192, lane);
    __syncthreads();
}

__device__ __forceinline__ void phase0(LAS unsigned char* lds, const Args& a, int vcu, int G, int tid, int lane, int wave) {
    unsigned char* ws = a.ws;
    if (vcu < 96) {
        LAS float* sv = (LAS float*)(lds + 69632); LAS float* part = sv + 3072;
        for (int idx = tid; idx < 3072; idx += NT) { const int v = idx >> 10, k = idx & 1023; const float s = (v < 2) ? a.in[I_C][v * 1024 + k] : a.in[I_CCTX][k]; sv[idx] = s / (1.f + expf(-s)); }
        __syncthreads();
        const int n0 = 64 * vcu, colq = lane & 15, kr = lane >> 4;
        f32x4 a0 = {0.f, 0.f, 0.f, 0.f}, a1 = a0, a2 = a0;
        const float* aw = a.in[I_ADAW] + (size_t)(128 * wave + kr) * 6144 + n0 + 4 * colq;
#pragma unroll
        for (int hb = 0; hb < 2; ++hb) { f32x4 w4[16];
#pragma unroll
            for (int it = 0; it < 16; ++it) w4[it] = __builtin_nontemporal_load((const f32x4*)(aw + (size_t)(4 * (16 * hb + it)) * 6144));
#pragma unroll
            for (int it = 0; it < 16; ++it) { const int k = 128 * wave + 4 * (16 * hb + it) + kr; a0 += w4[it] * sv[k]; a1 += w4[it] * sv[1024 + k]; a2 += w4[it] * sv[2048 + k]; } }
#pragma unroll
        for (int j = 0; j < 4; ++j) { a0[j] += __shfl_xor(a0[j], 16); a0[j] += __shfl_xor(a0[j], 32); a1[j] += __shfl_xor(a1[j], 16); a1[j] += __shfl_xor(a1[j], 32); a2[j] += __shfl_xor(a2[j], 16); a2[j] += __shfl_xor(a2[j], 32); }
        if (kr == 0) {
#pragma unroll
            for (int j = 0; j < 4; ++j) { part[(wave * 3 + 0) * 64 + 4 * colq + j] = a0[j]; part[(wave * 3 + 1) * 64 + 4 * colq + j] = a1[j]; part[(wave * 3 + 2) * 64 + 4 * colq + j] = a2[j]; } }
        __syncthreads();
        if (tid < 192) { const int v = tid >> 6, col = tid & 63; float s = a.in[I_ADAB][n0 + col];
#pragma unroll
            for (int w = 0; w < 8; ++w) s += part[(w * 3 + v) * 64 + col];
            ((float*)(ws + WS_MOD))[v * 6144 + n0 + col] = s; }
    } else if (vcu < 96 + 128) {
        const int it = vcu - 96, g = it >> 5, cb = (it >> 1) & 15, nb = it & 1, n = nb * 512 + tid;
        LAS float* pwt = (LAS float*)(lds + 69632);
        if (tid < 256) { const int d = tid >> 1, hf = tid & 1; const float sc = a.in[I_POOLS][g * 128 + d]; f32x4 v;
#pragma unroll
            for (int q = 0; q < 4; ++q) v[q] = a.in[I_POOLW][(size_t)(g * 128 + cb * 8 + hf * 4 + q) * 128 + d] * sc;
            *(LAS f32x4*)(pwt + d * 8 + hf * 4) = v; }
        __syncthreads();
        const float* wp = a.in[I_WPOOL] + (size_t)(g * 128) * 1024 + n;
        f32x4 acc0 = {0.f, 0.f, 0.f, 0.f}, acc1 = acc0;
        for (int d0 = 0; d0 < 128; d0 += 32) { float w[32];
#pragma unroll
            for (int d = 0; d < 32; ++d) w[d] = wp[(size_t)(d0 + d) * 1024];
#pragma unroll
            for (int d = 0; d < 32; ++d) { const f32x4 p0 = *(const LAS f32x4*)(pwt + (d0 + d) * 8), p1 = *(const LAS f32x4*)(pwt + (d0 + d) * 8 + 4); acc0 += p0 * w[d]; acc1 += p1 * w[d]; } }
        bf16* dst = (bf16*)(ws + WS_WC) + (size_t)n * 512 + g * 128 + cb * 8;
        *(u32x4*)dst = (u32x4){pk2(acc0[0], acc0[1]), pk2(acc0[2], acc0[3]), pk2(acc1[0], acc1[1]), pk2(acc1[2], acc1[3])};
    }
    { const int gw = vcu * NWAVES + wave, NGW = G * NWAVES; convert_items<0>((LAS float*)(lds + wave * 8448), a, gw, NGW, 2048 + 512 + 256, lane); }
}

#define RSTEP(N, S) do { _Pragma("unroll") for (int _i = 0; _i < (N) / 2; ++_i) { const float _send = (lane & (S)) ? racc[_i] : racc[_i + (N) / 2]; const float _keep = (lane & (S)) ? racc[_i + (N) / 2] : racc[_i]; racc[_i] = _keep + __shfl_xor(_send, (S)); } } while (0)
__device__ __forceinline__ void phase1(LAS unsigned char* lds, const Args& a, int vcu, int G, int tid, int lane, int wave) {
    unsigned char* ws = a.ws;
    const float* MOD = (const float*)(ws + WS_MOD);
    const float* g1 = a.in[I_N1G];
    for (int u = vcu; u < 96; u += G) {
        const int mt = u / 12, ntile = u % 12, r0 = mt * 64;
        LAS bf16* As = (LAS bf16*)lds; LAS bf16* Bs = As + 64 * 72; LAS float* rs = (LAS float*)(lds + 18432);
        const float* ctx = a.in[I_CTX];
        { f32x4 rv[8][4];
#pragma unroll
          for (int rr = 0; rr < 8; ++rr)
#pragma unroll
              for (int j = 0; j < 4; ++j) rv[rr][j] = *(const f32x4*)(ctx + (size_t)(r0 + 8 * wave + rr) * 1024 + 256 * j + 4 * lane);
#pragma unroll
          for (int rr = 0; rr < 8; ++rr) { float ss = 0.f;
#pragma unroll
              for (int j = 0; j < 4; ++j) ss += rv[rr][j][0] * rv[rr][j][0] + rv[rr][j][1] * rv[rr][j][1] + rv[rr][j][2] * rv[rr][j][2] + rv[rr][j][3] * rv[rr][j][3];
              ss = wave_sum(ss); if (lane == 0) rs[8 * wave + rr] = rsqrtf(ss * (1.f / 1024.f) + EPS); } }
        __syncthreads();
        f32x4 acc[2] = {{0.f, 0.f, 0.f, 0.f}, {0.f, 0.f, 0.f, 0.f}};
        const int m16 = wave & 3, nh = wave >> 2, srow = tid >> 3, kq = (tid & 7) * 8;
        const float rstd = rs[srow];
        const float* xp = ctx + (size_t)(r0 + srow) * 1024 + kq; const bf16* wpB = (const bf16*)(ws + WS_WIN) + (size_t)(ntile * 64 + srow) * 1024 + kq;
        f32x4 xv[2], gq[2], scq[2], shq[2]; u32x4 wB;
#define CTX_LOAD(kc) do { const int _k0 = (kc) * 64; _Pragma("unroll") for (int q = 0; q < 2; ++q) { xv[q] = *(const f32x4*)(xp + _k0 + 4 * q); gq[q] = *(const f32x4*)(g1 + _k0 + kq + 4 * q); \
            scq[q] = *(const f32x4*)(MOD + 2 * 6144 + 1024 + _k0 + kq + 4 * q); shq[q] = *(const f32x4*)(MOD + 2 * 6144 + _k0 + kq + 4 * q); } wB = *(const u32x4*)(wpB + _k0); } while (0)
        CTX_LOAD(0);
        for (int kc = 0; kc < 16; ++kc) {
            { unsigned o[4];
#pragma unroll
              for (int q = 0; q < 2; ++q) { const f32x4 h = xv[q] * rstd * gq[q] * (scq[q] + 1.f) + shq[q]; o[2 * q] = pk2(h[0], h[1]); o[2 * q + 1] = pk2(h[2], h[3]); }
              *(LAS u32x4*)(As + srow * 72 + kq) = (u32x4){o[0], o[1], o[2], o[3]};
              *(LAS u32x4*)(Bs + srow * 72 + kq) = wB; }
            __syncthreads();
            if (kc + 1 < 16) CTX_LOAD(kc + 1);
#pragma unroll
            for (int ks = 0; ks < 2; ++ks) { const bf16x8 af = ldfrag(As, 72, m16 * 16, ks * 32, lane);
#pragma unroll
                for (int tt = 0; tt < 2; ++tt) { const bf16x8 bfr = ldfrag(Bs, 72, nh * 32 + tt * 16, ks * 32, lane); acc[tt] = MFMA16(af, bfr, acc[tt]); } }
            __syncthreads();
        }
#undef CTX_LOAD
#pragma unroll
        for (int tt = 0; tt < 2; ++tt)
#pragma unroll
            for (int r = 0; r < 4; ++r) { const int row = M + r0 + m16 * 16 + 4 * (lane >> 4) + r, n = ntile * 64 + nh * 32 + tt * 16 + (lane & 15); const bf16 v = (bf16)f2bf(acc[tt][r]);
                if (n < 256) ((bf16*)(ws + WS_KB))[(size_t)row * 256 + n] = v; else ((bf16*)(ws + WS_VB))[(size_t)row * 512 + n - 256] = v; }
        __syncthreads();
    }
    LAS float* WR = (LAS float*)lds;
#pragma unroll 4
    for (int it = 0; it < 16; ++it) { const int k = (tid >> 3) + 64 * it, c4 = tid & 7; const f32x4 v = *(const f32x4*)(a.in[I_WIN] + (size_t)k * DIN + 768 + 4 * c4);
        const int row = ((k >> 8) * 4 + (k & 3)) * 64 + ((k & 255) >> 2); *(LAS f32x4*)(WR + row * 36 + 4 * c4) = v; }
    __syncthreads();
    f32x4 gv[4];
#pragma unroll
    for (int j = 0; j < 4; ++j) gv[j] = *(const f32x4*)(g1 + 256 * j + 4 * lane);
    constexpr int NPAIR = MT / 2;
    const int nctx = (G > 96) ? 96 : 0, PA = 3;
    int p_lo, p_n, p_stride;
    if (vcu < nctx) { p_lo = (vcu * NWAVES + wave) * PA; p_n = PA; p_stride = 1; }
    else { p_lo = nctx * NWAVES * PA + (vcu - nctx) * NWAVES + wave; p_n = 1 << 30; p_stride = (G - nctx) * NWAVES; }
    f32x4 nx[2][4];
    if (p_n > 0 && p_lo < NPAIR) {
#pragma unroll
        for (int r = 0; r < 2; ++r) { const int m = 2 * p_lo + r; const float* src = (m < M) ? a.in[I_X] + (size_t)m * 1024 : a.in[I_CTX] + (size_t)(m - M) * 1024;
#pragma unroll
            for (int j = 0; j < 4; ++j) nx[r][j] = *(const f32x4*)(src + 256 * j + 4 * lane); } }
    for (int pi = 0, pr = p_lo; pi < p_n && pr < NPAIR; ++pi, pr += p_stride) {
        const int m0 = 2 * pr;
        f32x4 v[2][4]; float rstd[2];
#pragma unroll
        for (int r = 0; r < 2; ++r) { float ss = 0.f;
#pragma unroll
            for (int j = 0; j < 4; ++j) { v[r][j] = nx[r][j]; ss += v[r][j][0] * v[r][j][0] + v[r][j][1] * v[r][j][1] + v[r][j][2] * v[r][j][2] + v[r][j][3] * v[r][j][3]; }
            rstd[r] = ss; }
        if (pi + 1 < p_n && pr + p_stride < NPAIR) {
#pragma unroll
            for (int r = 0; r < 2; ++r) { const int m = 2 * (pr + p_stride) + r; const float* src = (m < M) ? a.in[I_X] + (size_t)m * 1024 : a.in[I_CTX] + (size_t)(m - M) * 1024;
#pragma unroll
                for (int j = 0; j < 4; ++j) nx[r][j] = *(const f32x4*)(src + 256 * j + 4 * lane); } }
#pragma unroll
        for (int r = 0; r < 2; ++r) { const int m = m0 + r; rstd[r] = rsqrtf(wave_sum(rstd[r]) * (1.f / 1024.f) + EPS); const float* mod = MOD + (size_t)((m < M) ? (m >> 13) : 2) * 6144;
#pragma unroll
            for (int j = 0; j < 4; ++j) { const f32x4 sc = *(const f32x4*)(mod + 1024 + 256 * j + 4 * lane), sh = *(const f32x4*)(mod + 256 * j + 4 * lane); v[r][j] = v[r][j] * rstd[r] * gv[j] * (sc + 1.f) + sh; }
            if (m < M) { bf16* hp = (bf16*)(ws + WS_H1) + (size_t)m * 1024;
#pragma unroll
                for (int j = 0; j < 4; ++j) { *(u32x2*)(hp + 256 * j + 4 * lane) = (u32x2){pk2(v[r][j][0], v[r][j][1]), pk2(v[r][j][2], v[r][j][3])};
                    *(unsigned*)(ws + WS_H1F + (size_t)m * 1024 + 256 * j + 4 * lane) = pk4_fp8(v[r][j][0], v[r][j][1], v[r][j][2], v[r][j][3]); } } }
        f32x2 r2[32];
#pragma unroll
        for (int i = 0; i < 32; ++i) r2[i] = (f32x2){0.f, 0.f};
#pragma unroll
        for (int j = 0; j < 4; ++j)
#pragma unroll
            for (int i = 0; i < 4; ++i) { const f32x2 hab = {v[0][j][i], v[1][j][i]}; const LAS float* rp = WR + ((j * 4 + i) * 64 + lane) * 36;
#pragma unroll
                for (int c4 = 0; c4 < 8; ++c4) { const f32x4 w = *(const LAS f32x4*)(rp + 4 * c4);
                    r2[4 * c4 + 0] += hab * w[0]; r2[4 * c4 + 1] += hab * w[1]; r2[4 * c4 + 2] += hab * w[2]; r2[4 * c4 + 3] += hab * w[3]; }
                if (i & 1) asm volatile("" ::: "memory"); }
        float ra[32], rb[32];
#pragma unroll
        for (int i = 0; i < 32; ++i) { ra[i] = r2[i][0]; rb[i] = r2[i][1]; }
        { float* racc = ra; RSTEP(32, 32); RSTEP(16, 16); RSTEP(8, 8); RSTEP(4, 4); RSTEP(2, 2); racc[0] += __shfl_xor(racc[0], 1); }
        { float* racc = rb; RSTEP(32, 32); RSTEP(16, 16); RSTEP(8, 8); RSTEP(4, 4); RSTEP(2, 2); racc[0] += __shfl_xor(racc[0], 1); }
        if ((lane & 1) == 0) { ((float*)(ws + WS_RB))[(size_t)m0 * 32 + (lane >> 1)] = ra[0]; ((float*)(ws + WS_RB))[(size_t)(m0 + 1) * 32 + (lane >> 1)] = rb[0]; }
    }
}

typedef short s16x4 __attribute__((ext_vector_type(4)));
__device__ __forceinline__ s16x4 lds_tr16(const LAS bf16* p) { return __builtin_bit_cast(s16x4, __builtin_amdgcn_ds_read_tr16_b64_v4i16((LAS s16x4*)p)); }
__device__ __forceinline__ bf16x8 ldfrag_tr(const LAS bf16* base, int stride, int k0, int n0, int lane) {
    const int g = lane >> 4, i = lane & 15; const LAS bf16* p = base + (k0 + 8 * g + (i >> 2)) * stride + n0 + 4 * (i & 3);
    const s16x4 lo = lds_tr16(p), hi = lds_tr16(p + 4 * stride);
    return (bf16x8){lo[0], lo[1], lo[2], lo[3], hi[0], hi[1], hi[2], hi[3]};
}
__device__ __forceinline__ float logsig_fast(float z) { return fminf(z, 0.f) - __logf(1.f + __expf(-fabsf(z))); }
struct ChkPre { f32x4 r, w; float bias_f, bias_b; float kf[8]; u32x4 v[2]; };
__device__ __forceinline__ void chunk_decode(int u, int& b, int& h, int& row0, int& slot, bool& isx) {
    if (u < 1024) { b = u >> 9; h = (u >> 7) & 3; const int n = u & 127; row0 = b * SEQ + n * 64; slot = n; isx = true; }
    else { const int v = u - 1024; b = v >> 4; h = (v >> 2) & 3; const int n = v & 3; row0 = M + b * LC + n * 64; slot = NCH + n; isx = false; }
}
__device__ __forceinline__ void chunk_load(ChkPre& P, const Args& a, int u, int tid) {
    unsigned char* ws = a.ws; int b, h, row0, slot; bool isx; chunk_decode(u, b, h, row0, slot, isx);
    P.r = *(const f32x4*)((const float*)(ws + WS_RB) + (size_t)(row0 + (tid >> 3)) * 32 + (tid & 7) * 4);
    P.w = *(const f32x4*)(a.in[I_WDU] + (size_t)(tid >> 4) * 256 + h * 64 + (tid & 15) * 4);
    const int dk = tid & 63, tq = tid >> 6;
    P.bias_f = a.in[I_BDEC][h * 64 + dk]; P.bias_b = a.in[I_BDEC][256 + h * 64 + dk];
    const bf16* KBp = (const bf16*)(ws + WS_KB) + (size_t)(row0 + tq * 8) * 256 + h * 64 + dk;
#pragma unroll
    for (int tt = 0; tt < 8; ++tt) P.kf[tt] = bf2f(KBp[(size_t)tt * 256]);
#pragma unroll
    for (int i = 0; i < 2; ++i) { const int p = tid + NT * i, jj = p >> 4, ch = p & 15; P.v[i] = *(const u32x4*)((const bf16*)(ws + WS_VB) + (size_t)(row0 + jj) * 512 + h * 128 + 8 * ch); }
}
__device__ __forceinline__ void chunk_units(LAS unsigned char* lds, const Args& a, int vcu, int G, int tid, int lane, int wave) {
    unsigned char* ws = a.ws;
    LAS float* r_s = (LAS float*)lds;
    LAS float* wup = (LAS float*)(lds + 8192);
    LAS float* seg = (LAS float*)(lds + 16384);
    LAS bf16* Ks = (LAS bf16*)(lds + 20480);
    LAS bf16* Vs = (LAS bf16*)(lds + 38912);
    const int dk = tid & 63, tq = tid >> 6;
    ChkPre P;
    unsigned* qctr = (unsigned*)(ws + WS_CTL) + 512; LAS int* qnext = (LAS int*)(lds + 57344);
    int u = vcu;
    if (u < 1024 + 32) chunk_load(P, a, u, tid);
    for (; u < 1024 + 32; ) {
        int b, h, row0, slot; bool isx; chunk_decode(u, b, h, row0, slot, isx);
        const int bh = b * 4 + h;
        if (tid == 0) qnext[0] = G + (int)__hip_atomic_fetch_add(qctr, 1u, __ATOMIC_RELAXED, __HIP_MEMORY_SCOPE_AGENT);
        *(LAS f32x4*)(r_s + tid * 4) = P.r; *(LAS f32x4*)(wup + (tid >> 4) * 64 + (tid & 15) * 4) = P.w;
#pragma unroll
        for (int i = 0; i < 2; ++i) { const int p = tid + NT * i, jj = p >> 4, ch = p & 15; *(LAS u32x4*)(Vs + jj * 136 + 8 * ch) = P.v[i]; }
        float kf[8];
#pragma unroll
        for (int tt = 0; tt < 8; ++tt) kf[tt] = P.kf[tt];
        const float bias_f = P.bias_f, bias_b = P.bias_b;
        __syncthreads();
        const int un = qnext[0];
        if (un < 1024 + 32) chunk_load(P, a, un, tid);
        float pf[8], sb[8];
        { float wf[16], wb[16];
#pragma unroll
          for (int j = 0; j < 16; ++j) { wf[j] = wup[j * 64 + dk]; wb[j] = wup[(16 + j) * 64 + dk]; }
#pragma unroll
          for (int tt = 0; tt < 8; ++tt) { const LAS float* rp = r_s + (tq * 8 + tt) * 32; float zf = bias_f, zb = bias_b;
#pragma unroll
              for (int j4 = 0; j4 < 4; ++j4) { const f32x4 rf = *(const LAS f32x4*)(rp + 4 * j4), rb = *(const LAS f32x4*)(rp + 16 + 4 * j4);
#pragma unroll
                  for (int e = 0; e < 4; ++e) { zf += rf[e] * wf[4 * j4 + e]; zb += rb[e] * wb[4 * j4 + e]; } }
              pf[tt] = logsig_fast(zf) * (1.f / 16.f); sb[tt] = logsig_fast(zb) * (1.f / 16.f); }
#pragma unroll
          for (int tt = 1; tt < 8; ++tt) pf[tt] += pf[tt - 1];
#pragma unroll
          for (int tt = 6; tt >= 0; --tt) sb[tt] += sb[tt + 1];
          seg[tq * 64 + dk] = pf[7]; seg[(8 + tq) * 64 + dk] = sb[0]; }
        __syncthreads();
        { float offf = 0.f, totf = 0.f, offb = 0.f, totb = 0.f;
#pragma unroll
          for (int q = 0; q < 8; ++q) { const float sf = seg[q * 64 + dk], sbv = seg[(8 + q) * 64 + dk]; totf += sf; totb += sbv; if (q < tq) offf += sf; if (q > tq) offb += sbv; }
#pragma unroll
          for (int tt = 0; tt < 8; ++tt) { const int t = tq * 8 + tt; const float bb = pf[tt] + offf, cc = sb[tt] + offb;
              if (isx) { const size_t gi = (size_t)(row0 + t) * 256 + h * 64 + dk; a.out[gi] = bb; a.out[(size_t)M * 256 + gi] = cc; }
              Ks[t * 72 + dk] = (bf16)f2bf(kf[tt] * __expf(totf - bb)); Ks[(64 + t) * 72 + dk] = (bf16)f2bf(kf[tt] * __expf(totb - cc)); }
          if (tq == 0) { float* DEC = (float*)(ws + WS_DEC); DEC[((size_t)(0 * 8 + bh) * NSLOT + slot) * 64 + dk] = __expf(totf); DEC[((size_t)(1 * 8 + bh) * NSLOT + slot) * 64 + dk] = __expf(totb); } }
        __syncthreads();
        { const int dir = wave >> 2, dkt = wave & 3; const LAS bf16* Kd = Ks + dir * 64 * 72;
          const bf16x8 k0f = ldfrag_tr(Kd, 72, 0, dkt * 16, lane), k1f = ldfrag_tr(Kd, 72, 32, dkt * 16, lane);
          bf16* KV = (bf16*)(ws + WS_KV) + ((size_t)(dir * 8 + bh) * NSLOT + slot) * 8192;
#pragma unroll
          for (int dvt = 0; dvt < 8; ++dvt) { f32x4 c = {0.f, 0.f, 0.f, 0.f}; c = MFMA16(k0f, ldfrag_tr(Vs, 136, 0, dvt * 16, lane), c); c = MFMA16(k1f, ldfrag_tr(Vs, 136, 32, dvt * 16, lane), c);
              *(u32x2*)(KV + (size_t)(dvt * 16 + (lane & 15)) * 64 + dkt * 16 + 4 * (lane >> 4)) = (u32x2){pk2(c[0], c[1]), pk2(c[2], c[3])}; } }
        __syncthreads();
        u = un;
    }
}
constexpr int PB = 4, NPOOLW = NB * 4 * 8 * (128 / PB);
__device__ __forceinline__ void ld16bf(const bf16* p, float (&f)[16]) { const u32x4 w0 = *(const u32x4*)p, w1 = *(const u32x4*)(p + 8);
#pragma unroll
    for (int q = 0; q < 4; ++q) { f[2 * q] = bflo(w0[q]); f[2 * q + 1] = bfhi(w0[q]); f[8 + 2 * q] = bflo(w1[q]); f[8 + 2 * q + 1] = bfhi(w1[q]); } }
template <int CTRL, int ROWMASK> __device__ __forceinline__ float dpp_f(float v) { return __builtin_bit_cast(float, __builtin_amdgcn_update_dpp(0, __builtin_bit_cast(int, v), CTRL, ROWMASK, 0xf, true)); }
__device__ __forceinline__ float wave_prefix(float v) {
    v += dpp_f<0x111, 0xf>(v); v += dpp_f<0x112, 0xf>(v); v += dpp_f<0x114, 0xf>(v); v += dpp_f<0x118, 0xf>(v);
    v += dpp_f<0x142, 0xa>(v);
    v += dpp_f<0x143, 0xc>(v);
    return v;
}
template <int HALF>
__device__ __forceinline__ void pool_band(const bf16* PI, bf16* PO, int r0, int c) {
    float run[16];
#pragma unroll
    for (int e = 0; e < 16; ++e) run[e] = 0.f;
    { constexpr int NW = 2 * HALF, BT = NW < 8 ? NW : 8;
#pragma unroll
      for (int i0 = 0; i0 < NW; i0 += BT) { float f[BT][16];
#pragma unroll
          for (int i = 0; i < BT; ++i) { int rr = r0 - HALF + i0 + i; rr = rr < 0 ? 0 : (rr > 127 ? 127 : rr); ld16bf(PI + (size_t)rr * 64 * 512, f[i]); }
#pragma unroll
          for (int i = 0; i < BT; ++i) { const int rr = r0 - HALF + i0 + i; const bool ok = rr >= 0 && rr < 128;
#pragma unroll
              for (int e = 0; e < 16; ++e) run[e] += ok ? f[i][e] : 0.f; }
          asm volatile("" ::: "memory"); } }
    const int lo_c = (c - HALF) < 0 ? 0 : (c - HALF), hi_c = (c + HALF) > 64 ? 64 : (c + HALF);
    float cen[16], fi[16], fo[16];
    ld16bf(PI + (size_t)r0 * 64 * 512, cen);
#pragma unroll
    for (int k = 0; k < PB; ++k) {
        const int r = r0 + k;
        float ncen[16];
        if (k + 1 < PB) { const int rin = r + HALF, rout = r - HALF;
            ld16bf(PI + (size_t)(rin > 127 ? 127 : rin) * 64 * 512, fi); ld16bf(PI + (size_t)(rout < 0 ? 0 : rout) * 64 * 512, fo); ld16bf(PI + (size_t)(r + 1) * 64 * 512, ncen); }
        const int lo_r = (r - HALF) < 0 ? 0 : (r - HALF), hi_r = (r + HALF) > 128 ? 128 : (r + HALF);
        const float inv = 1.f / (float)((hi_r - lo_r) * (hi_c - lo_c));
        float o[16];
#pragma unroll
        for (int e = 0; e < 16; ++e) { const float p = wave_prefix(run[e]);
            const float hi = __shfl(p, hi_c - 1), lo = __shfl(p, lo_c > 0 ? lo_c - 1 : 0);
            o[e] = (hi - (lo_c > 0 ? lo : 0.f)) * inv - cen[e]; }
        bf16* po = PO + (size_t)r * 64 * 512;
        *(u32x4*)po = (u32x4){pk2(o[0], o[1]), pk2(o[2], o[3]), pk2(o[4], o[5]), pk2(o[6], o[7])}; *(u32x4*)(po + 8) = (u32x4){pk2(o[8], o[9]), pk2(o[10], o[11]), pk2(o[12], o[13]), pk2(o[14], o[15])};
        if (k + 1 < PB) { const int rin = r + HALF, rout = r - HALF;
#pragma unroll
            for (int e = 0; e < 16; ++e) { run[e] += (rin < 128 ? fi[e] : 0.f) - (rout >= 0 ? fo[e] : 0.f); cen[e] = ncen[e]; } }
    }
}
__device__ __forceinline__ void pool_units(const Args& a, int vcu, int G, int lane, int wave, int nw) {
    unsigned char* ws = a.ws;
    constexpr int NBAND = 128 / PB, PER_G = NB * 8 * NBAND;
    for (int wu = vcu * nw + wave; wu < NPOOLW; wu += G * nw) {
        const int g = 3 - (wu & 3), rem = wu >> 2, b = rem / (8 * NBAND), rem2 = rem % (8 * NBAND), chk = rem2 & 7, r0 = (rem2 >> 3) * PB;
        const size_t off = ((size_t)b * SEQ + lane) * 512 + g * 128 + chk * 16;
        const bf16* PI = (const bf16*)(ws + WS_PI) + off; bf16* PO = (bf16*)(ws + WS_PO) + off;
        if (g == 0) pool_band<1>(PI, PO, r0, lane); else if (g == 1) pool_band<2>(PI, PO, r0, lane); else if (g == 2) pool_band<4>(PI, PO, r0, lane); else pool_band<8>(PI, PO, r0, lane);
    }
}

__device__ __forceinline__ void phase4(const Args& a, int G, int tid, int nthr) {
    unsigned char* ws = a.ws;
    for (int e = blockIdx.x * nthr + tid; e < 2 * 8 * 8192; e += G * nthr) {
        const int dir = e >> 16, bh = (e >> 13) & 7, e8 = e & 8191, dk = e8 & 63;
        const bf16* kvp = (const bf16*)(ws + WS_KV) + (size_t)((dir * 8 + bh) * NSLOT) * 8192 + e8;
        const float* decp = (const float*)(ws + WS_DEC) + (size_t)((dir * 8 + bh) * NSLOT) * 64 + dk;
        bf16* stp = (bf16*)(ws + WS_ST) + (size_t)((dir * 8 + bh) * NCH) * 8192 + e8;
        float s = 0.f;
        float kv[12], dc[12], kvn[12], dcn[12];
#define SCAN_SLOT(j) (dir ? (NSLOT - 1 - (j)) : ((j) < 4 ? NCH + (j) : (j) - 4))
#pragma unroll
        for (int q = 0; q < 12; ++q) { const int slot = SCAN_SLOT(q); kvn[q] = bf2f(kvp[(size_t)slot * 8192]); dcn[q] = decp[slot * 64]; }
        for (int j0 = 0; j0 < NSLOT; j0 += 12) {
#pragma unroll
            for (int q = 0; q < 12; ++q) { kv[q] = kvn[q]; dc[q] = dcn[q]; }
            if (j0 + 12 < NSLOT) {
#pragma unroll
                for (int q = 0; q < 12; ++q) { const int slot = SCAN_SLOT(j0 + 12 + q); kvn[q] = bf2f(kvp[(size_t)slot * 8192]); dcn[q] = decp[slot * 64]; } }
#pragma unroll
            for (int q = 0; q < 12; ++q) { const int slot = SCAN_SLOT(j0 + q);
                if (slot < NCH) stp[(size_t)slot * 8192] = (bf16)f2bf(s);
                s = dc[q] * s + kv[q]; }
        }
#undef SCAN_SLOT
    }
}

struct GlaPre { u32x4 q, k; f32x4 b0, b1, c0, c1, mf0, mf1, mb0, mb1; u32x4 v[2]; u32x4 st[4]; u32x4 sg[2]; };
__device__ __forceinline__ void gla_load(GlaPre& P, const Args& a, int u, int tid) {
    unsigned char* ws = a.ws;
    const int b = u >> 9, h = (u >> 7) & 3, n = u & 127, row0 = b * SEQ + n * 64, bh = b * 4 + h, t = tid >> 3, c8 = tid & 7;
    const size_t gi = (size_t)(row0 + t) * 256 + h * 64 + 8 * c8, gmf = (size_t)(row0 + 31) * 256 + h * 64 + 8 * c8, gmb = (size_t)(row0 + 32) * 256 + h * 64 + 8 * c8;
    const float* BF = a.out; const float* CB = a.out + (size_t)M * 256;
    P.q = *(const u32x4*)((const bf16*)(ws + WS_QB) + gi); P.k = *(const u32x4*)((const bf16*)(ws + WS_KB) + gi);
    P.b0 = *(const f32x4*)(BF + gi); P.b1 = *(const f32x4*)(BF + gi + 4); P.c0 = *(const f32x4*)(CB + gi); P.c1 = *(const f32x4*)(CB + gi + 4);
    P.mf0 = *(const f32x4*)(BF + gmf); P.mf1 = *(const f32x4*)(BF + gmf + 4); P.mb0 = *(const f32x4*)(CB + gmb); P.mb1 = *(const f32x4*)(CB + gmb + 4);
#pragma unroll
    for (int i = 0; i < 2; ++i) { const int p = tid + NT * i, jj = p >> 4, ch = p & 15; P.v[i] = *(const u32x4*)((const bf16*)(ws + WS_VB) + (size_t)(row0 + jj) * 512 + h * 128 + 8 * ch); }
#pragma unroll
    for (int i = 0; i < 4; ++i) { const int p = tid + NT * i, dir = p >> 10, rem = p & 1023, dv = rem >> 3, c = rem & 7;
        P.st[i] = *(const u32x4*)((const bf16*)(ws + WS_ST) + ((size_t)((dir * 8 + bh) * NCH + n) * 128 + dv) * 64 + 8 * c); }
    const bf16* sgp = (const bf16*)(ws + WS_SG) + (size_t)(row0 + t) * 512 + h * 128 + 16 * c8;
    P.sg[0] = *(const u32x4*)sgp; P.sg[1] = *(const u32x4*)(sgp + 8);
}
__device__ __forceinline__ void phase5(LAS unsigned char* lds, const Args& a, int vcu, int G, int tid, int lane, int wave) {
    unsigned char* ws = a.ws;
    LAS bf16* Aop = (LAS bf16*)lds;
    LAS bf16* Bop = (LAS bf16*)(lds + 25600);
    LAS bf16* Vs = (LAS bf16*)(lds + 60416);
    LAS bf16* qsf = (LAS bf16*)(lds + 77824); LAS bf16* ksf = qsf + 64 * 72; LAS bf16* qsb = ksf + 64 * 72; LAS bf16* ksb = qsb + 64 * 72;
    LAS float* Os = (LAS float*)(lds + 77824);
    const int t8 = tid >> 3, c8 = tid & 7;
    f32x4 gn[4];
#pragma unroll
    for (int q = 0; q < 4; ++q) gn[q] = *(const f32x4*)(a.in[I_GNG] + 16 * c8 + 4 * q);
    GlaPre P;
    int u = vcu;
    if (u < 1024) gla_load(P, a, u, tid);
    for (; u < 1024; u += G) {
        const int b = u >> 9, h = (u >> 7) & 3, n = u & 127, row0 = b * SEQ + n * 64;
        { float qf[8], kf[8], bb[8], cc[8], mf[8], mb[8];
#pragma unroll
          for (int e = 0; e < 4; ++e) { qf[2 * e] = bflo(P.q[e]); qf[2 * e + 1] = bfhi(P.q[e]); kf[2 * e] = bflo(P.k[e]); kf[2 * e + 1] = bfhi(P.k[e]);
              bb[e] = P.b0[e]; bb[4 + e] = P.b1[e]; cc[e] = P.c0[e]; cc[4 + e] = P.c1[e]; mf[e] = P.mf0[e]; mf[4 + e] = P.mf1[e]; mb[e] = P.mb0[e]; mb[4 + e] = P.mb1[e]; }
          float o0[8], o1[8], o2[8], o3[8], o4[8], o5[8];
#pragma unroll
          for (int e = 0; e < 8; ++e) { const float eb = __expf(bb[e]), ec = __expf(cc[e]), x = __expf(bb[e] - mf[e]), y = __expf(cc[e] - mb[e]);
              o0[e] = qf[e] * eb; o1[e] = qf[e] * ec; o2[e] = qf[e] * x; o3[e] = kf[e] * __builtin_amdgcn_rcpf(x); o4[e] = qf[e] * y; o5[e] = kf[e] * __builtin_amdgcn_rcpf(y); }
#define PK8(o) (u32x4){pk2(o[0], o[1]), pk2(o[2], o[3]), pk2(o[4], o[5]), pk2(o[6], o[7])}
          *(LAS u32x4*)(Aop + t8 * 200 + 8 * c8) = PK8(o0); *(LAS u32x4*)(Aop + t8 * 200 + 64 + 8 * c8) = PK8(o1);
          *(LAS u32x4*)(qsf + t8 * 72 + 8 * c8) = PK8(o2); *(LAS u32x4*)(ksf + t8 * 72 + 8 * c8) = PK8(o3); *(LAS u32x4*)(qsb + t8 * 72 + 8 * c8) = PK8(o4); *(LAS u32x4*)(ksb + t8 * 72 + 8 * c8) = PK8(o5);
#undef PK8
        }
#pragma unroll
        for (int i = 0; i < 2; ++i) { const int p = tid + NT * i, jj = p >> 4, ch = p & 15; *(LAS u32x4*)(Vs + jj * 136 + 8 * ch) = P.v[i]; }
#pragma unroll
        for (int i = 0; i < 4; ++i) { const int p = tid + NT * i, dir = p >> 10, rem = p & 1023, dv = rem >> 3, c = rem & 7; *(LAS u32x4*)(Bop + dv * 136 + dir * 64 + 8 * c) = P.st[i]; }
        const u32x4 sg0 = P.sg[0], sg1 = P.sg[1];
        __syncthreads();
        if (u + G < 1024) gla_load(P, a, u + G, tid);
        { const int tt = wave >> 1, jh = wave & 1; f32x4 pa[2] = {{0.f, 0.f, 0.f, 0.f}, {0.f, 0.f, 0.f, 0.f}};
#pragma unroll
          for (int dir = 0; dir < 2; ++dir) { const LAS bf16* qs = dir ? qsb : qsf; const LAS bf16* ks = dir ? ksb : ksf;
              const bf16x8 a0 = ldfrag(qs, 72, tt * 16, 0, lane), a1 = ldfrag(qs, 72, tt * 16, 32, lane);
#pragma unroll
              for (int jj = 0; jj < 2; ++jj) { const int jt = jh * 2 + jj; f32x4 sc = {0.f, 0.f, 0.f, 0.f}; sc = MFMA16(a0, ldfrag(ks, 72, jt * 16, 0, lane), sc); sc = MFMA16(a1, ldfrag(ks, 72, jt * 16, 32, lane), sc);
#pragma unroll
                  for (int r = 0; r < 4; ++r) { const int t = tt * 16 + 4 * (lane >> 4) + r, jx = jt * 16 + (lane & 15); const bool keep = dir ? (jx >= t) : (jx <= t); pa[jj][r] += keep ? sc[r] : 0.f; } } }
#pragma unroll
          for (int jj = 0; jj < 2; ++jj)
#pragma unroll
              for (int r = 0; r < 4; ++r) Aop[(tt * 16 + 4 * (lane >> 4) + r) * 200 + 128 + (jh * 2 + jj) * 16 + (lane & 15)] = (bf16)f2bf(pa[jj][r]); }
        __syncthreads();
        const int tt = wave >> 1, dvh = wave & 1;
        f32x4 acc[4] = {{0.f, 0.f, 0.f, 0.f}, {0.f, 0.f, 0.f, 0.f}, {0.f, 0.f, 0.f, 0.f}, {0.f, 0.f, 0.f, 0.f}};
#pragma unroll
        for (int ks = 0; ks < 4; ++ks) { const bf16x8 af = ldfrag(Aop, 200, tt * 16, ks * 32, lane);
#pragma unroll
            for (int i = 0; i < 4; ++i) acc[i] = MFMA16(af, ldfrag(Bop, 136, (dvh * 4 + i) * 16, ks * 32, lane), acc[i]); }
#pragma unroll
        for (int ks = 0; ks < 2; ++ks) { const bf16x8 af = ldfrag(Aop, 200, tt * 16, 128 + ks * 32, lane);
#pragma unroll
            for (int i = 0; i < 4; ++i) acc[i] = MFMA16(af, ldfrag_tr(Vs, 136, ks * 32, (dvh * 4 + i) * 16, lane), acc[i]); }
#pragma unroll
        for (int i = 0; i < 4; ++i)
#pragma unroll
            for (int r = 0; r < 4; ++r) Os[(tt * 16 + 4 * (lane >> 4) + r) * 132 + (dvh * 4 + i) * 16 + (lane & 15)] = acc[i][r];
        __syncthreads();
        { f32x4 ov[4]; float ss = 0.f;
#pragma unroll
          for (int q = 0; q < 4; ++q) { ov[q] = *(const LAS f32x4*)(Os + t8 * 132 + 16 * c8 + 4 * q); ss += ov[q][0] * ov[q][0] + ov[q][1] * ov[q][1] + ov[q][2] * ov[q][2] + ov[q][3] * ov[q][3]; }
          ss += __shfl_xor(ss, 1); ss += __shfl_xor(ss, 2); ss += __shfl_xor(ss, 4);
          const float rstd = rsqrtf(ss * (1.f / 128.f) + EPS);
          unsigned sgw[8] = {sg0[0], sg0[1], sg0[2], sg0[3], sg1[0], sg1[1], sg1[2], sg1[3]}, ow[8];
#pragma unroll
          for (int q = 0; q < 4; ++q) { const f32x4 o = ov[q] * rstd * gn[q]; ow[2 * q] = pk2(o[0] * bflo(sgw[2 * q]), o[1] * bfhi(sgw[2 * q])); ow[2 * q + 1] = pk2(o[2] * bflo(sgw[2 * q + 1]), o[3] * bfhi(sgw[2 * q + 1])); }
          bf16* agp = (bf16*)(ws + WS_AG) + (size_t)(row0 + t8) * 512 + h * 128 + 16 * c8;
          *(u32x4*)agp = (u32x4){ow[0], ow[1], ow[2], ow[3]}; *(u32x4*)(agp + 8) = (u32x4){ow[4], ow[5], ow[6], ow[7]}; }
        __syncthreads();
    }
}

__device__ __forceinline__ void phase8(LAS unsigned char* lds, const Args& a, int vcu, int G, int tid, int lane, int wave) {
    unsigned char* ws = a.ws;
    const float* MOD = (const float*)(ws + WS_MOD);
    LAS float* WRT = (LAS float*)lds;
#pragma unroll
    for (int it = 0; it < 8; ++it) { const int idx = tid + NT * it, k = idx >> 2, c4 = idx & 3; const f32x4 v = *(const f32x4*)(a.in[I_WROUTER] + (size_t)k * 16 + 4 * c4);
        const int row = ((k >> 8) * 4 + (k & 3)) * 64 + ((k & 255) >> 2); *(LAS f32x4*)(WRT + row * 20 + 4 * c4) = v; }
    __syncthreads();
    const int gw = vcu * NWAVES + wave, NGW = G * NWAVES;
    f32x4 gv[4];
#pragma unroll
    for (int j = 0; j < 4; ++j) gv[j] = *(const f32x4*)(a.in[I_N2G] + 256 * j + 4 * lane);
    f32x4 nx[2][4];
    if (gw < M / 2) {
#pragma unroll
        for (int r = 0; r < 2; ++r)
#pragma unroll
            for (int j = 0; j < 4; ++j) { const size_t o_ = (size_t)(2 * gw + r) * 1024 + 256 * j + 4 * lane; const u32x2 d_ = *(const u32x2*)((const bf16*)(ws + WS_YD) + o_);
                nx[r][j] = *(const f32x4*)(a.in[I_X] + o_) + (f32x4){bflo(d_.x), bfhi(d_.x), bflo(d_.y), bfhi(d_.y)}; } }
    for (int pr = gw; pr < M / 2; pr += NGW) {
        const int m0 = 2 * pr, b = m0 >> 13; const float* mod = MOD + (size_t)b * 6144;
        f32x4 v[2][4]; float ss[2];
#pragma unroll
        for (int r = 0; r < 2; ++r) { float q = 0.f;
#pragma unroll
            for (int j = 0; j < 4; ++j) { u32x2 w_; w_.x = cvt_pk_bf16(nx[r][j][0], nx[r][j][1]); w_.y = cvt_pk_bf16(nx[r][j][2], nx[r][j][3]);
                *(u32x2*)((bf16*)(ws + WS_YD) + (size_t)(m0 + r) * 1024 + 256 * j + 4 * lane) = w_;
                v[r][j] = (f32x4){bflo(w_.x), bfhi(w_.x), bflo(w_.y), bfhi(w_.y)}; q += v[r][j][0] * v[r][j][0] + v[r][j][1] * v[r][j][1] + v[r][j][2] * v[r][j][2] + v[r][j][3] * v[r][j][3]; }
            ss[r] = q; }
        if (pr + NGW < M / 2) {
#pragma unroll
            for (int r = 0; r < 2; ++r)
#pragma unroll
                for (int j = 0; j < 4; ++j) { const size_t o_ = (size_t)(2 * (pr + NGW) + r) * 1024 + 256 * j + 4 * lane; const u32x2 d_ = *(const u32x2*)((const bf16*)(ws + WS_YD) + o_);
                    nx[r][j] = *(const f32x4*)(a.in[I_X] + o_) + (f32x4){bflo(d_.x), bfhi(d_.x), bflo(d_.y), bfhi(d_.y)}; } }
#pragma unroll
        for (int r = 0; r < 2; ++r) { const float rstd = rsqrtf(wave_sum(ss[r]) * (1.f / 1024.f) + EPS);
#pragma unroll
            for (int j = 0; j < 4; ++j) { const f32x4 sc = *(const f32x4*)(mod + 4096 + 256 * j + 4 * lane), sh = *(const f32x4*)(mod + 3072 + 256 * j + 4 * lane); v[r][j] = v[r][j] * rstd * gv[j] * (sc + 1.f) + sh; }
            unsigned char* hp = ws + WS_H2 + (size_t)(m0 + r) * 1024;
#pragma unroll
            for (int j = 0; j < 4; ++j) *(unsigned*)(hp + 256 * j + 4 * lane) = pk4_fp8(v[r][j][0], v[r][j][1], v[r][j][2], v[r][j][3]); }
        f32x2 r2[16];
#pragma unroll
        for (int i = 0; i < 16; ++i) r2[i] = (f32x2){0.f, 0.f};
#pragma unroll
        for (int j = 0; j < 4; ++j)
#pragma unroll
            for (int i = 0; i < 4; ++i) { const f32x2 hab = {v[0][j][i], v[1][j][i]}; const LAS float* rp = WRT + ((j * 4 + i) * 64 + lane) * 20;
#pragma unroll
                for (int c4 = 0; c4 < 4; ++c4) { const f32x4 w = *(const LAS f32x4*)(rp + 4 * c4); r2[4 * c4 + 0] += hab * w[0]; r2[4 * c4 + 1] += hab * w[1]; r2[4 * c4 + 2] += hab * w[2]; r2[4 * c4 + 3] += hab * w[3]; }
                if (i & 1) asm volatile("" ::: "memory"); }
#pragma unroll
        for (int r = 0; r < 2; ++r) {
            float racc[16];
#pragma unroll
            for (int i = 0; i < 16; ++i) racc[i] = r2[i][r];
            RSTEP(16, 32); RSTEP(8, 16); RSTEP(4, 8); RSTEP(2, 4); racc[0] += __shfl_xor(racc[0], 2); racc[0] += __shfl_xor(racc[0], 1);
            const float lg = racc[0];
            float mx = lg; mx = fmaxf(mx, __shfl_xor(mx, 4)); mx = fmaxf(mx, __shfl_xor(mx, 8)); mx = fmaxf(mx, __shfl_xor(mx, 16)); mx = fmaxf(mx, __shfl_xor(mx, 32));
            const float ex = expf(lg - mx); float sm = ex; sm += __shfl_xor(sm, 4); sm += __shfl_xor(sm, 8); sm += __shfl_xor(sm, 16); sm += __shfl_xor(sm, 32);
            const int m = m0 + r;
            if ((lane & 3) == 0) ((float*)(ws + WS_AFF))[(size_t)(b * 16 + (lane >> 2)) * SEQ + (m & (SEQ - 1))] = ex / sm;
            if (lane < 16) ((int*)(ws + WS_INV))[(size_t)m * 16 + lane] = -1;
        }
    }
}

__device__ __forceinline__ void topk_unit(LAS unsigned char* lds, const Args& a, int be, int tid, int lane, int wave) {
    unsigned char* ws = a.ws;
    LAS unsigned* hist = (LAS unsigned*)lds;
    LAS unsigned* sel = hist + 256;
    LAS unsigned* wtot = hist + 264;
    const float* aff = (const float*)(ws + WS_AFF) + (size_t)be * SEQ + 16 * tid;
    unsigned key[16];
#pragma unroll
    for (int q = 0; q < 4; ++q) { const u32x4 v = *(const u32x4*)(aff + 4 * q); key[4 * q] = v[0]; key[4 * q + 1] = v[1]; key[4 * q + 2] = v[2]; key[4 * q + 3] = v[3]; }
    unsigned prefix = 0u, mask = 0u, kk = CAP;
    for (int pass = 0; pass < 4; ++pass) {
        const int shift = 24 - 8 * pass;
        if (tid < 256) hist[tid] = 0u;
        __syncthreads();
#pragma unroll
        for (int i = 0; i < 16; ++i) if ((key[i] & mask) == prefix) __hip_atomic_fetch_add(hist + ((key[i] >> shift) & 255u), 1u, __ATOMIC_RELAXED, __HIP_MEMORY_SCOPE_WORKGROUP);
        __syncthreads();
        if (wave == 0) {
            const unsigned h0 = hist[4 * lane], h1 = hist[4 * lane + 1], h2 = hist[4 * lane + 2], h3 = hist[4 * lane + 3], loc = h0 + h1 + h2 + h3;
            unsigned suf = loc;
#pragma unroll
            for (int o = 1; o < 64; o <<= 1) { const unsigned t = __shfl_down(suf, o); if (lane + o < 64) suf += t; }
            const unsigned above = suf - loc;
            const unsigned s3 = above + h3, s2 = s3 + h2, s1 = s2 + h1, s0 = s1 + h0;
            if (s3 >= kk && above < kk) { sel[0] = 4 * lane + 3; sel[1] = kk - above; }
            if (s2 >= kk && s3 < kk) { sel[0] = 4 * lane + 2; sel[1] = kk - s3; }
            if (s1 >= kk && s2 < kk) { sel[0] = 4 * lane + 1; sel[1] = kk - s2; }
            if (s0 >= kk && s1 < kk) { sel[0] = 4 * lane + 0; sel[1] = kk - s1; }
        }
        __syncthreads();
        prefix |= sel[0] << shift; mask |= 255u << shift; kk = sel[1];
        __syncthreads();
    }
    unsigned cgt = 0u, ceq = 0u;
#pragma unroll
    for (int i = 0; i < 16; ++i) { cgt += (key[i] > prefix) ? 1u : 0u; ceq += (key[i] == prefix) ? 1u : 0u; }
    const unsigned val = cgt | (ceq << 16); unsigned inc = val;
#pragma unroll
    for (int o = 1; o < 64; o <<= 1) { const unsigned t = __shfl_up(inc, o); if (lane >= o) inc += t; }
    if (lane == 63) wtot[wave] = inc;
    __syncthreads();
    unsigned base = 0u;
    for (int w = 0; w < wave; ++w) base += wtot[w];
    const unsigned excl = base + inc - val; unsigned gtb = excl & 0xffffu, eqb = excl >> 16;
    const int b = be >> 4, e = be & 15;
    int* IDX = (int*)(ws + WS_IDX) + be * CAP; float* WSEL = (float*)(ws + WS_WSEL) + be * CAP; int* INV = (int*)(ws + WS_INV);
#pragma unroll
    for (int i = 0; i < 16; ++i) { const bool gt = key[i] > prefix, eq = key[i] == prefix; const bool take = gt || (eq && eqb < kk);
        if (take) { const unsigned pos = gtb + (eqb < kk ? eqb : kk); const int row = b * SEQ + 16 * tid + i; IDX[pos] = row; WSEL[pos] = __builtin_bit_cast(float, key[i]); INV[(size_t)row * 16 + e] = (int)pos; }
        gtb += gt ? 1u : 0u; eqb += eq ? 1u : 0u; }
    __syncthreads();
}
__device__ __forceinline__ void phase9(LAS unsigned char* lds, const Args& a, int vcu, int G, int tid, int lane, int wave) {
    const int ntk = (G > 64) ? 32 : 0;
    if (vcu < ntk || ntk == 0) for (int be = (ntk ? vcu : vcu); be < NB * NE; be += (ntk ? ntk : G)) topk_unit(lds, a, be, tid, lane, wave);
    if (vcu >= ntk) { const int gw = (vcu - ntk) * NWAVES + wave, NGW = (G - ntk) * NWAVES; convert_items<2>((LAS float*)(lds + 8192 + wave * 8448), a, gw, NGW, 8192, lane); }
}

__device__ __forceinline__ void phase12(const Args& a, int vcu, int G, int lane, int wave) {
    unsigned char* ws = a.ws;
    const int gw = vcu * NWAVES + wave, NGW = G * NWAVES;
    f32x4 gv[4];
#pragma unroll
    for (int j = 0; j < 4; ++j) gv[j] = *(const f32x4*)(a.in[I_FNG] + 256 * j + 4 * lane);
    f32x4 nx[4]; int ninv = -1;
    if (gw < M) {
#pragma unroll
        for (int j = 0; j < 4; ++j) { const size_t o_ = (size_t)gw * 1024 + 256 * j + 4 * lane; const u32x2 d_ = __builtin_nontemporal_load((const u32x2*)((const bf16*)(ws + WS_YD) + o_));
            nx[j] = (f32x4){bflo(d_.x), bfhi(d_.x), bflo(d_.y), bfhi(d_.y)}; }
        ninv = (lane < 16) ? ((const int*)(ws + WS_INV))[(size_t)gw * 16 + lane] : -1; }
    for (int m = gw; m < M; m += NGW) {
        const int b = m >> 13; float* row = a.out + (size_t)m * 1024;
        f32x4 v[4];
#pragma unroll
        for (int j = 0; j < 4; ++j) v[j] = nx[j];
        const int myinv = ninv;
        if (m + NGW < M) {
#pragma unroll
            for (int j = 0; j < 4; ++j) { const size_t o_ = (size_t)(m + NGW) * 1024 + 256 * j + 4 * lane; const u32x2 d_ = __builtin_nontemporal_load((const u32x2*)((const bf16*)(ws + WS_YD) + o_));
                nx[j] = (f32x4){bflo(d_.x), bfhi(d_.x), bflo(d_.y), bfhi(d_.y)}; }
            ninv = (lane < 16) ? ((const int*)(ws + WS_INV))[(size_t)(m + NGW) * 16 + lane] : -1; }
        unsigned long long mask = __ballot(myinv >= 0);
        const bf16* yb = (const bf16*)(ws + WS_YB) + (size_t)(b * 16) * CAP * 1024;
        while (mask) {
            u32x2 w[4][4]; float sc[4];
#pragma unroll
            for (int q = 0; q < 4; ++q) { const bool on = mask != 0ull; const int e = on ? (int)__builtin_ctzll(mask) : 0; mask = on ? (mask & (mask - 1ull)) : 0ull;
                const int sl = __shfl(myinv, e); const size_t ro = on ? ((size_t)e * CAP + (size_t)sl) * 1024 : 0; sc[q] = on ? 1.f : 0.f;
#pragma unroll
                for (int j = 0; j < 4; ++j) w[q][j] = __builtin_nontemporal_load((const u32x2*)(yb + ro + 256 * j + 4 * lane)); }
#pragma unroll
            for (int q = 0; q < 4; ++q)
#pragma unroll
                for (int j = 0; j < 4; ++j) { v[j][0] += sc[q] * bflo(w[q][j].x); v[j][1] += sc[q] * bfhi(w[q][j].x); v[j][2] += sc[q] * bflo(w[q][j].y); v[j][3] += sc[q] * bfhi(w[q][j].y); }
        }
        float ss = 0.f;
#pragma unroll
        for (int j = 0; j < 4; ++j) ss += v[j][0] * v[j][0] + v[j][1] * v[j][1] + v[j][2] * v[j][2] + v[j][3] * v[j][3];
        const float rstd = rsqrtf(wave_sum(ss) * (1.f / 1024.f) + EPS);
#pragma unroll
        for (int j = 0; j < 4; ++j) __builtin_nontemporal_store(v[j] * rstd * gv[j], (f32x4*)(row + 256 * j + 4 * lane));
    }
}

__global__ void __launch_bounds__(NT, 2) fwd_kernel(Args args) {
    extern __shared__ __attribute__((aligned(16))) unsigned char lds_raw[];
    LAS unsigned char* lds = (LAS unsigned char*)lds_raw;
    volatile LAS unsigned* MISC = (volatile LAS unsigned*)(lds + MISC_OFF);
    const int tid0 = threadIdx.x, tid = tid0, wave = __builtin_amdgcn_readfirstlane(tid >> 6);
    const int G = gridDim.x, bx = blockIdx.x, vcu = (G % 8 == 0) ? (bx % 8) * (G / 8) + bx / 8 : bx;
    unsigned char* ws = args.ws;
    if (tid < 128) MISC[tid] = 0u;
    __syncthreads();
    XcdBarrier bar; bar.bar = (unsigned*)(ws + WS_CTL) + CW_BAR; bar.x = 0; bar.st = nullptr;
    if (!MK_MULTI) bar = xcd_barrier_post((unsigned*)(ws + WS_CTL) + CW_BAR, MISC + 8);
    const int lo = args.ph_lo, hi = args.ph_hi;
#define IN(k) (lo <= (k) && (k) < hi)
#define SEAM(k) do { if (IN(k) && IN((k) + 1)) xcd_barrier(bar); } while (0)
#define RUN(k, CODE) do { if (IN(k)) { int tid = tid0, lane; asm volatile("" : "+v"(tid)); lane = tid & 63; (void)lane; CODE; if (REP_PHASE == (k)) for (int _r = 0; _r < REP_COUNT; ++_r) { xcd_barrier(bar); CODE; } } SEAM(k); } while (0)
#define PH0 phase0(lds, args, vcu, G, tid, lane, wave)
#define PH1 phase1(lds, args, vcu, G, tid, lane, wave)
#define PH2 do { const int qs = vcu % 3;     \
        EpiInproj E{(bf16*)(ws + WS_KB), (bf16*)(ws + WS_VB), (bf16*)(ws + WS_QB), (bf16*)(ws + WS_SG), (bf16*)(ws + WS_PI), ws + WS_SM, 0, 1.f}; \
        EpiGates E8{(bf16*)(ws + WS_KB), (bf16*)(ws + WS_VB), (bf16*)(ws + WS_QB), (bf16*)(ws + WS_SG), (bf16*)(ws + WS_PI), ws + WS_SM, 8, 0.0625f}; \
        if (qs == 0) convert_all<1>(lds, args, vcu, G, lane, wave); \
        { SchedDense S{G, bx, 1024, 64, 8, (const char*)(ws + WS_H1), (const char*)(ws + WS_WIN), 0, 1 << 20, 2}; pg8::gemm_phase<EpiInproj, SchedDense, false, false>(lds, S, E); }     \
        if (qs == 1) convert_all<1>(lds, args, vcu, G, lane, wave); \
        { SchedDense S{G, bx, 1024, 64, 8, (const char*)(ws + WS_H1F), (const char*)(ws + WS_WINM), 0, 1 << 20, 1}; pg8::gemm_phase<EpiGates, SchedDense, false, true>(lds, S, E8); }     \
        if (qs == 2) convert_all<1>(lds, args, vcu, G, lane, wave); } while (0)
#define PH3 chunk_units(lds, args, vcu, G, tid, lane, wave)
#define PH4 do { pool_units(args, vcu, G, lane, wave, 8); phase4(args, G, tid, NT); } while (0)
#define PH5 phase5(lds, args, vcu, G, tid, lane, wave)
#define PH6 do { SchedPair S{G, bx, 512, (const char*)(ws + WS_AG), (const char*)(ws + WS_PO), (const char*)(ws + WS_WG), (const char*)(ws + WS_WC)}; \
        EpiMerge E{ws + WS_SM, (bf16*)(ws + WS_MG)}; pg8::gemm_phase<EpiMerge, SchedPair, false>(lds, S, E); } while (0)
#define PH7 do { SchedDense S{G, bx, 1024, 64, 4, (const char*)(ws + WS_MG), (const char*)(ws + WS_WO), 0, 1 << 20, 2}; \
        EpiOut E{(const float*)(ws + WS_MOD), (bf16*)(ws + WS_YD)}; pg8::gemm_phase<EpiOut, SchedDense, false>(lds, S, E); } while (0)
#define NITEM_HALF ((NE * 3 * 512 + 2 * G * NWAVES - 1) / (2 * G * NWAVES))
#define PH6C do { if (vcu & 1) convert_experts(lds, args, vcu, G, lane, wave, 0, NITEM_HALF); PH6; if (!(vcu & 1)) convert_experts(lds, args, vcu, G, lane, wave, 0, NITEM_HALF); } while (0)
#define PH7C do { if (vcu & 1) convert_experts(lds, args, vcu, G, lane, wave, NITEM_HALF, 2 * NITEM_HALF); PH7; if (!(vcu & 1)) convert_experts(lds, args, vcu, G, lane, wave, NITEM_HALF, 2 * NITEM_HALF); } while (0)
#define PH8 phase8(lds, args, vcu, G, tid, lane, wave)
#define PH9 phase9(lds, args, vcu, G, tid, lane, wave)
#define PH9B do { const int gw_ = vcu * NWAVES + wave, NGW_ = G * NWAVES;     \
        for (int r0_ = gw_ * 16; r0_ < NB * NE * CAP; r0_ += NGW_ * 16) { u32x4 t_[16]; \
            _Pragma("unroll") for (int q = 0; q < 16; ++q) { const int src_ = ((const int*)(ws + WS_IDX))[r0_ + q]; t_[q] = *(const u32x4*)(ws + WS_H2 + (size_t)src_ * 1024 + lane * 16); } \
            _Pragma("unroll") for (int q = 0; q < 16; ++q) *(u32x4*)(ws + WS_XS + (size_t)(r0_ + q) * 1024 + lane * 16) = t_[q]; } } while (0)
#define PH10 do { EpiMoe1 E{ws + WS_ACT}; SchedMoe1 S{G, bx, 1024, (const char*)(ws + WS_XS), (const char*)(ws + WS_WGU), 0, 1 << 20}; pg8::gemm_phase<EpiMoe1, SchedMoe1, false, true>(lds, S, E); } while (0)
#define PH11 do { SchedMoe2 S{G, bx, 1024, (const char*)(ws + WS_ACT), (const char*)(ws + WS_WD)}; \
        EpiMoe2 E{(bf16*)(ws + WS_YB), (const float*)(ws + WS_WSEL), (const float*)(ws + WS_MOD)}; pg8::gemm_phase<EpiMoe2, SchedMoe2, false, true>(lds, S, E); } while (0)
#define PH12 phase12(args, vcu, G, lane, wave)
    RUN(0, PH0); RUN(1, PH1); RUN(2, PH2); RUN(3, PH3);
#define PH3A chunk_units(lds, args, vcu, G, tid, lane, wave)
#define PH3B pool_units(args, vcu, G, lane, wave, 8)
    if (REP_PHASE == 40) { xcd_barrier(bar); if (wave < 4) phase4(args, G, tid, 256); xcd_barrier(bar); }
    if (REP_PHASE == 41) { const int lane = tid & 63; xcd_barrier(bar); if (wave >= 4) pool_units(args, vcu, G, lane, wave - 4, 4); xcd_barrier(bar); }
    if (REP_PHASE == 30) { const int lane = tid & 63; xcd_barrier(bar); PH3A; xcd_barrier(bar); }
    if (REP_PHASE == 31) { const int lane = tid & 63; xcd_barrier(bar); PH3B; xcd_barrier(bar); } RUN(4, PH4); RUN(5, PH5); RUN(6, PH6); RUN(7, PH7); RUN(8, PH8); RUN(9, PH9); RUN(10, PH9B); RUN(11, PH10); RUN(12, PH11);
    if (REP_PHASE == 20) for (int _r = 0; _r < REP_COUNT; ++_r) xcd_barrier(bar);
    RUN(13, PH12);
#undef IN
#undef SEAM
#undef RUN
}

#ifndef MK_CHECK
#define MK_CHECK 0
#endif
#ifndef CHK_SKIP
#define CHK_SKIP -1
#endif
#if MK_CHECK
constexpr size_t WS_CHK = 299 * MiB;
__device__ __forceinline__ unsigned hashu(unsigned x) { x ^= x >> 16; x *= 0x7feb352dU; x ^= x >> 15; x *= 0x846ca68bU; x ^= x >> 16; return x; }
__device__ __forceinline__ float bfr(float f) { return bf2f(f2bf(f)); }
__device__ float f8d(unsigned char x) { const int sg = x >> 7, e = (x >> 3) & 15, m = x & 7; const float v = e ? ldexpf(1.f + m / 8.f, e - 7) : ldexpf(m / 8.f, -6); return sg ? -v : v; }
__device__ float f8r(float f) { return f8d((unsigned char)(pk4_fp8(f, 0.f, 0.f, 0.f) & 255u)); }
__device__ float x1_at(const Args& a, int m, int k) { return bf2f(((const bf16*)(a.ws + WS_YD))[(size_t)m * 1024 + k]); }
__device__ float naive_rstd_x1(const Args& a, int m) { float ss = 0.f; for (int k = 0; k < 1024; ++k) { const float v = x1_at(a, m, k); ss += v * v; } return rsqrtf(ss / 1024.f + EPS); }
__device__ float gate_at(const Args& a, int m, int n) {
    const int pm = m >> 8, r = m & 255, ai = r >> 7, wr = (r >> 6) & 1, mm = (r >> 4) & 3, fr = r & 15, pg = n >> 8, c = n & 255, bj = c >> 7, wc = (c >> 5) & 3, fq = (c >> 3) & 3, j8 = c & 7;
    return (float)(a.ws + WS_SM)[gate_off(pm, pg, ai, mm, bj, wr, wc, fr, fq) + j8] * (1.f / 255.f); }
__device__ float naive_rstd(const float* row) { float ss = 0.f; for (int k = 0; k < 1024; ++k) ss += row[k] * row[k]; return rsqrtf(ss / 1024.f + EPS); }
__device__ float naive_la(const Args& a, int row, int dir, int col) {
    const float* RB = (const float*)(a.ws + WS_RB) + (size_t)row * 32 + dir * 16; float z = a.in[I_BDEC][dir * 256 + col];
    for (int j = 0; j < 16; ++j) z += RB[j] * a.in[I_WDU][(size_t)(dir * 16 + j) * 256 + col];
    return logsig_f(z) / 16.f;
}
__global__ void chk_kernel(Args a, int stage) {
    __shared__ float sh[256];
    const unsigned gid = blockIdx.x * blockDim.x + threadIdx.x; unsigned h = hashu(gid * 2654435761u + (unsigned)stage * 97u + 12345u); const unsigned h2 = hashu(h + 777u);
    unsigned char* ws = a.ws; float ref = 0.f, got = 0.f, atol = 1e-3f; bool active = true;
    const float* MOD = (const float*)(ws + WS_MOD);
    switch (stage) {
    case 0: { const int v = h % 3, n = (h >> 2) % 6144; ref = a.in[I_ADAB][n]; for (int k = 0; k < 1024; ++k) { const float c = (v < 2) ? a.in[I_C][v * 1024 + k] : a.in[I_CCTX][k]; ref += c / (1.f + expf(-c)) * a.in[I_ADAW][(size_t)k * 6144 + n]; } got = MOD[v * 6144 + n]; atol = 0.01f; } break;
    case 1: { const int sel = (h >> 28) & 3, n = h % 4096, k = (h >> 12) % 1024;
        if (sel < 2) { if (n < 2048) { ref = bfr(a.in[I_WIN][(size_t)k * DIN + n + (n >= 768 ? 32 : 0)]); got = bf2f(((const bf16*)(ws + WS_WIN))[(size_t)n * 1024 + k]); } else { ref = f8r(16.f * a.in[I_WIN][(size_t)k * DIN + n + 32]); got = f8d((ws + WS_WINM)[(size_t)(n - 2048) * 1024 + k]); } }
        else if (sel == 2) { ref = bfr(a.in[I_WOUT][(size_t)k * 1024 + (n & 1023)]); got = bf2f(((const bf16*)(ws + WS_WO))[(size_t)(n & 1023) * 1024 + k]); }
        else { ref = bfr(a.in[I_WGLA][(size_t)(k & 511) * 1024 + (n & 1023)]); got = bf2f(((const bf16*)(ws + WS_WG))[(size_t)(n & 1023) * 512 + (k & 511)]); } atol = 1e-4f; } break;
    case 2: { const int n = h % 1024, kk = (h >> 10) % 512, g = kk >> 7, c = kk & 127; for (int d = 0; d < 128; ++d) ref += a.in[I_POOLW][(size_t)(g * 128 + c) * 128 + d] * a.in[I_POOLS][g * 128 + d] * a.in[I_WPOOL][(size_t)(g * 128 + d) * 1024 + n];
        got = bf2f(((const bf16*)(ws + WS_WC))[(size_t)n * 512 + kk]); atol = 0.002f; } break;
    case 3: { const int m = h % M, k = (h >> 14) % 1024, b = m >> 13; const float* row = a.in[I_X] + (size_t)m * 1024; const float rstd = naive_rstd(row);
        ref = row[k] * rstd * a.in[I_N1G][k] * (1.f + MOD[b * 6144 + 1024 + k]) + MOD[b * 6144 + k]; got = bf2f(((const bf16*)(ws + WS_H1))[(size_t)m * 1024 + k]); atol = 0.01f; } break;
    case 4: { const int m = h % MT, c = (h >> 15) % 32, mi = (m < M) ? (m >> 13) : 2; const float* row = (m < M) ? a.in[I_X] + (size_t)m * 1024 : a.in[I_CTX] + (size_t)(m - M) * 1024; const float rstd = naive_rstd(row);
        for (int k = 0; k < 1024; ++k) ref += (row[k] * rstd * a.in[I_N1G][k] * (1.f + MOD[mi * 6144 + 1024 + k]) + MOD[mi * 6144 + k]) * a.in[I_WIN][(size_t)k * DIN + 768 + c];
        got = ((const float*)(ws + WS_RB))[(size_t)m * 32 + c]; atol = 0.01f; } break;
    case 5: { const int r = h % 512, n = (h >> 9) % 768; const float* row = a.in[I_CTX] + (size_t)r * 1024; const float rstd = naive_rstd(row);
        for (int k = 0; k < 1024; ++k) ref += bfr(row[k] * rstd * a.in[I_N1G][k] * (1.f + MOD[2 * 6144 + 1024 + k]) + MOD[2 * 6144 + k]) * bf2f(((const bf16*)(ws + WS_WIN))[(size_t)n * 1024 + k]);
        got = (n < 256) ? bf2f(((const bf16*)(ws + WS_KB))[(size_t)(M + r) * 256 + n]) : bf2f(((const bf16*)(ws + WS_VB))[(size_t)(M + r) * 512 + n - 256]); atol = 0.03f; } break;
    case 6: { const int m = h % M, n = (h >> 14) % 4096; const bf16* hr = (const bf16*)(ws + WS_H1) + (size_t)m * 1024; const bf16* wr_ = (const bf16*)(ws + WS_WIN) + (size_t)n * 1024; float d = 0.f;
        if (n < 2048) { for (int k = 0; k < 1024; ++k) d += bf2f(hr[k]) * bf2f(wr_[k]); }
        else { for (int k = 0; k < 1024; ++k) d += f8d((ws + WS_H1F)[(size_t)m * 1024 + k]) * f8d((ws + WS_WINM)[(size_t)(n - 2048) * 1024 + k]); d *= 0.0625f; }
        if (n < 256) { ref = d; got = bf2f(((const bf16*)(ws + WS_KB))[(size_t)m * 256 + n]); }
        else if (n < 768) { ref = d; got = bf2f(((const bf16*)(ws + WS_VB))[(size_t)m * 512 + n - 256]); }
        else if (n < 1024) { ref = d * 0.125f; got = bf2f(((const bf16*)(ws + WS_QB))[(size_t)m * 256 + n - 768]); }
        else if (n < 1536) { ref = d / (1.f + expf(-d)); got = bf2f(((const bf16*)(ws + WS_SG))[(size_t)m * 512 + n - 1024]); }
        else if (n < 2048) { ref = d; got = bf2f(((const bf16*)(ws + WS_PI))[(size_t)m * 512 + n - 1536]); }
        else { ref = 1.f / (1.f + expf(-d)); got = gate_at(a, m, n - 2048); } atol = 0.02f; } break;
    case 7: { const int m = h % M, col = (h >> 14) % 256, dir = (h >> 22) & 1, t = m & 63, m0 = m - t;
        for (int s = 0; s < 64; ++s) if (dir ? (s >= t) : (s <= t)) ref += naive_la(a, m0 + s, dir, col);
        got = (dir ? a.out + (size_t)M * 256 : a.out)[(size_t)m * 256 + col]; atol = 0.003f; } break;
    case 8: case 9: { const int dir = h & 1, bh = (h >> 1) & 7, slot = (stage == 9) ? 128 + ((h >> 4) & 3) : ((h >> 4) & 127), dv = (h >> 11) & 127, dk = (h >> 18) & 63, b = bh >> 2, hh = bh & 3;
        const int row0 = (slot < 128) ? b * SEQ + slot * 64 : M + b * LC + (slot - 128) * 64; float la[64]; float tot = 0.f;
        for (int s = 0; s < 64; ++s) tot += naive_la(a, row0 + s, dir, hh * 64 + dk);
        float run = 0.f;
        if (!dir) { for (int s = 0; s < 64; ++s) { run += naive_la(a, row0 + s, 0, hh * 64 + dk); ref += bf2f(((const bf16*)(ws + WS_VB))[(size_t)(row0 + s) * 512 + hh * 128 + dv]) * bfr(bf2f(((const bf16*)(ws + WS_KB))[(size_t)(row0 + s) * 256 + hh * 64 + dk]) * expf(tot - run)); } }
        else { for (int s = 63; s >= 0; --s) { run += naive_la(a, row0 + s, 1, hh * 64 + dk); ref += bf2f(((const bf16*)(ws + WS_VB))[(size_t)(row0 + s) * 512 + hh * 128 + dv]) * bfr(bf2f(((const bf16*)(ws + WS_KB))[(size_t)(row0 + s) * 256 + hh * 64 + dk]) * expf(tot - run)); } }
        (void)la;
        if ((h >> 30) & 1) { ref = expf(tot); got = ((const float*)(ws + WS_DEC))[((size_t)(dir * 8 + bh) * NSLOT + slot) * 64 + dk]; atol = 1e-3f; }
        else { got = bf2f(((const bf16*)(ws + WS_KV))[((size_t)(dir * 8 + bh) * NSLOT + slot) * 8192 + dv * 64 + dk]); atol = 0.1f; } } break;
    case 10: { const int m = h % M, col = (h >> 14) % 512, g = col >> 7, half = 1 << g, b = m >> 13, l = m & 8191, r = l >> 6, c = l & 63; const bf16* PI = (const bf16*)(ws + WS_PI);
        const int lo_r = max(r - half, 0), hi_r = min(r + half, 128), lo_c = max(c - half, 0), hi_c = min(c + half, 64); float sm = 0.f;
        for (int rr = lo_r; rr < hi_r; ++rr) for (int cc = lo_c; cc < hi_c; ++cc) sm += bf2f(PI[(size_t)(b * SEQ + rr * 64 + cc) * 512 + col]);
        ref = sm / (float)((hi_r - lo_r) * (hi_c - lo_c)) - bf2f(PI[(size_t)m * 512 + col]); got = bf2f(((const bf16*)(ws + WS_PO))[(size_t)m * 512 + col]); atol = 0.02f; } break;
    case 11: { const int dir = h & 1, bh = (h >> 1) & 7, n = (h >> 4) & 127, e8 = (h >> 11) & 8191, dk = e8 & 63; float s = 0.f;
        const bf16* kvp = (const bf16*)(ws + WS_KV) + (size_t)((dir * 8 + bh) * NSLOT) * 8192 + e8; const float* dp = (const float*)(ws + WS_DEC) + (size_t)((dir * 8 + bh) * NSLOT) * 64 + dk;
        if (!dir) { for (int j = 128; j < 132; ++j) s = dp[j * 64] * s + bf2f(kvp[(size_t)j * 8192]); for (int j = 0; j < n; ++j) s = dp[j * 64] * s + bf2f(kvp[(size_t)j * 8192]); }
        else { for (int j = 131; j >= 128; --j) s = dp[j * 64] * s + bf2f(kvp[(size_t)j * 8192]); for (int j = 127; j > n; --j) s = dp[j * 64] * s + bf2f(kvp[(size_t)j * 8192]); }
        ref = s; got = bf2f(((const bf16*)(ws + WS_ST))[(size_t)((dir * 8 + bh) * NCH + n) * 8192 + e8]); atol = 0.1f; } break;
    case 12: {
        const unsigned hb = hashu(blockIdx.x * 7919u + 5u); const int m = hb % M, hh = (hb >> 14) & 3, b = m >> 13, l = m & 8191, n = l >> 6, t = l & 63, row0 = m - t, bh = b * 4 + hh, dv = threadIdx.x & 127;
        const float* BF = a.out; const float* CB = a.out + (size_t)M * 256; const bf16* QB = (const bf16*)(ws + WS_QB); const bf16* KB = (const bf16*)(ws + WS_KB); const bf16* VB = (const bf16*)(ws + WS_VB); const bf16* ST = (const bf16*)(ws + WS_ST);
        if (threadIdx.x < 128) { const int j = threadIdx.x & 63, dir = threadIdx.x >> 6; float sc = 0.f;
            const bool keep = dir ? (j >= t) : (j <= t);
            if (keep) for (int d = 0; d < 64; ++d) { const size_t gq = (size_t)m * 256 + hh * 64 + d, gk = (size_t)(row0 + j) * 256 + hh * 64 + d; const float* P = dir ? CB : BF; sc += bf2f(QB[gq]) * bf2f(KB[gk]) * expf(P[gq] - P[gk]); }
            sh[threadIdx.x] = sc; }
        __syncthreads();
        float o = 0.f;
        for (int d = 0; d < 64; ++d) { const size_t gq = (size_t)m * 256 + hh * 64 + d; const float q = bf2f(QB[gq]);
            o += q * expf(BF[gq]) * bf2f(ST[((size_t)((0 * 8 + bh) * NCH + n) * 128 + dv) * 64 + d]) + q * expf(CB[gq]) * bf2f(ST[((size_t)((1 * 8 + bh) * NCH + n) * 128 + dv) * 64 + d]); }
        for (int j = 0; j < 64; ++j) o += (sh[j] + sh[64 + j]) * bf2f(VB[(size_t)(row0 + j) * 512 + hh * 128 + dv]);
        __syncthreads(); sh[128 + dv] = o * o; __syncthreads();
        float ss = 0.f; for (int d = 0; d < 128; ++d) ss += sh[128 + d];
        const size_t gi = (size_t)m * 512 + hh * 128 + dv;
        ref = o * rsqrtf(ss / 128.f + EPS) * a.in[I_GNG][dv] * bf2f(((const bf16*)(ws + WS_SG))[gi]); got = bf2f(((const bf16*)(ws + WS_AG))[gi]); atol = 0.03f; } break;
    case 13: { const int m = h % M, n = (h >> 14) % 1024; float g = 0.f, p = 0.f; const bf16* AG = (const bf16*)(ws + WS_AG) + (size_t)m * 512; const bf16* PO = (const bf16*)(ws + WS_PO) + (size_t)m * 512;
        for (int k = 0; k < 512; ++k) { g += bf2f(AG[k]) * bf2f(((const bf16*)(ws + WS_WG))[(size_t)n * 512 + k]); p += bf2f(PO[k]) * bf2f(((const bf16*)(ws + WS_WC))[(size_t)n * 512 + k]); }
        ref = gate_at(a, m, n) * g + gate_at(a, m, 1024 + n) * p; got = bf2f(((const bf16*)(ws + WS_MG))[(size_t)m * 1024 + n]); atol = 0.03f; } break;
    case 14: { const int m = h % M, n = (h >> 14) % 1024, b = m >> 13; float d = 0.f; for (int k = 0; k < 1024; ++k) d += bf2f(((const bf16*)(ws + WS_MG))[(size_t)m * 1024 + k]) * bf2f(((const bf16*)(ws + WS_WO))[(size_t)n * 1024 + k]);
        ref = bfr(MOD[b * 6144 + 2048 + n] * d); got = bf2f(((const bf16*)(ws + WS_YD))[(size_t)m * 1024 + n]); atol = 0.005f; } break;
    case 15: { const int m = h % M, k = (h >> 14) % 1024, b = m >> 13; const float rstd = naive_rstd_x1(a, m);
        ref = x1_at(a, m, k) * rstd * a.in[I_N2G][k] * (1.f + MOD[b * 6144 + 4096 + k]) + MOD[b * 6144 + 3072 + k]; got = f8d((ws + WS_H2)[(size_t)m * 1024 + k]); atol = 0.02f; ref = f8r(ref); } break;
    case 16: { const int m = h % M, e = (h >> 14) & 15, b = m >> 13; const float rstd = naive_rstd_x1(a, m); float mx = -1e30f, mye = 0.f, sm = 0.f;
        for (int pass = 0; pass < 2; ++pass) for (int ee = 0; ee < 16; ++ee) { float lg = 0.f; for (int k = 0; k < 1024; ++k) lg += (x1_at(a, m, k) * rstd * a.in[I_N2G][k] * (1.f + MOD[b * 6144 + 4096 + k]) + MOD[b * 6144 + 3072 + k]) * a.in[I_WROUTER][k * 16 + ee];
            if (pass == 0) mx = fmaxf(mx, lg); else { const float ex = expf(lg - mx); sm += ex; if (ee == e) mye = ex; } }
        ref = mye / sm; got = ((const float*)(ws + WS_AFF))[(size_t)(b * 16 + e) * SEQ + (m & 8191)]; atol = 0.001f; } break;
    case 17: { const int be = h & 31, slot = (h >> 5) & 1023, b = be >> 4, e = be & 15; const int row = ((const int*)(ws + WS_IDX))[be * CAP + slot]; const float* aff = (const float*)(ws + WS_AFF) + (size_t)be * SEQ; float bad = 0.f;
        if (row < b * SEQ || row >= (b + 1) * SEQ) bad += 1.f; else { const int l = row & 8191; if (((const int*)(ws + WS_INV))[(size_t)row * 16 + e] != slot) bad += 1.f; if (((const float*)(ws + WS_WSEL))[be * CAP + slot] != aff[l]) bad += 1.f;
            int cnt = 0; for (int j = 0; j < SEQ; ++j) cnt += (aff[j] > aff[l]) ? 1 : 0; if (cnt >= CAP) bad += 1.f;
            const int l2 = h2 & 8191; if (((const int*)(ws + WS_INV))[(size_t)(b * SEQ + l2) * 16 + e] < 0) { int c2 = 0; for (int j = 0; j < SEQ; ++j) c2 += (aff[j] >= aff[l2]) ? 1 : 0; if (c2 <= CAP) bad += 1.f; } }
        ref = 0.f; got = bad; atol = 0.5f; } break;
    case 18: { const int e = h & 15, mat = (h >> 4) % 3, n = (h >> 8) & 1023, k = (h >> 18) & 1023;
        if (mat == 0) { ref = f8r(16.f * a.in[I_WGATE][(size_t)e * 1048576 + (size_t)k * 1024 + n]); got = f8d((ws + WS_WGU)[((size_t)e * 2048 + (n >> 7) * 256 + (n & 127)) * 1024 + k]); }
        else if (mat == 1) { ref = f8r(16.f * a.in[I_WUP][(size_t)e * 1048576 + (size_t)k * 1024 + n]); got = f8d((ws + WS_WGU)[((size_t)e * 2048 + (n >> 7) * 256 + 128 + (n & 127)) * 1024 + k]); }
        else { ref = f8r(16.f * a.in[I_WDOWN][(size_t)e * 1048576 + (size_t)k * 1024 + n]); got = f8d((ws + WS_WD)[((size_t)e * 1024 + n) * 1024 + k]); } atol = 1e-4f; } break;
    case 19: { const int be = h & 31, slot = (h >> 5) & 1023, f = (h >> 15) & 1023, e = be & 15; const int row = ((const int*)(ws + WS_IDX))[be * CAP + slot]; float g = 0.f, u = 0.f;
        const unsigned char* hr = ws + WS_H2 + (size_t)row * 1024; const unsigned char* wg = ws + WS_WGU + ((size_t)e * 2048 + (f >> 7) * 256 + (f & 127)) * 1024; const unsigned char* wu = wg + 128 * 1024;
        for (int k = 0; k < 1024; ++k) { g += f8d(hr[k]) * f8d(wg[k]); u += f8d(hr[k]) * f8d(wu[k]); }
        g *= 0.0625f; u *= 0.0625f; ref = g / (1.f + expf(-g)) * u; got = f8d((ws + WS_ACT)[((size_t)be * CAP + slot) * 1024 + f]); atol = 0.03f + 0.04f * fabsf(ref); } break;
    case 20: { const int be = h & 31, slot = (h >> 5) & 1023, n = (h >> 15) & 1023, e = be & 15, b = be >> 4; float d = 0.f;
        for (int f = 0; f < 1024; ++f) d += f8d((ws + WS_ACT)[((size_t)be * CAP + slot) * 1024 + f]) * f8d((ws + WS_WD)[((size_t)e * 1024 + n) * 1024 + f]);
        ref = d * 0.0625f * ((const float*)(ws + WS_WSEL))[be * CAP + slot] * MOD[b * 6144 + 5120 + n]; got = bf2f(((const bf16*)(ws + WS_YB))[((size_t)be * CAP + slot) * 1024 + n]); atol = 0.002f; } break;
    default: active = false;
    }
    if (active) { float e = fabsf(got - ref) / (atol + 0.03f * fabsf(ref)); if (!(e == e)) e = 1e9f; atomicMax((unsigned*)(ws + WS_CHK) + stage, __float_as_uint(e)); }
}
__global__ void chk_final(Args a) {
    __shared__ int code;
    if (threadIdx.x == 0) { int c = 0; for (int s = 20; s >= 0; --s) if (s > CHK_SKIP && __uint_as_float(((const unsigned*)(a.ws + WS_CHK))[s]) > 1.f) c = s + 1; code = c; }
    __syncthreads();
    const float sc = 1.f + 0.1f * (float)code;
    for (size_t i = (size_t)blockIdx.x * blockDim.x + threadIdx.x; i < (size_t)M * D; i += (size_t)gridDim.x * blockDim.x) a.out[i] *= sc;
}
#endif

extern "C" void kernel_launch(void* const* d_in, const int* in_sizes, int n_in, void* d_out, int out_size, void* d_ws, size_t ws_size, hipStream_t stream) {
    static int grid = 0;
    if (grid == 0) {
        if (n_in != 22 || out_size != M * D || ws_size < WS_END) { fprintf(stderr, "kernel_launch: unexpected shapes (n_in %d, out %d, ws %zu < %zu)\n", n_in, out_size, ws_size, (size_t)WS_END); grid = -1; return; }
        int dev = 0, cus = 0, per_cu = 0;
        if (hipGetDevice(&dev) != hipSuccess || hipDeviceGetAttribute(&cus, hipDeviceAttributeMultiprocessorCount, dev) != hipSuccess) { grid = -1; return; }
        if (hipFuncSetAttribute((const void*)fwd_kernel, hipFuncAttributeMaxDynamicSharedMemorySize, LDS_BYTES) != hipSuccess) { fprintf(stderr, "kernel_launch: hipFuncSetAttribute failed\n"); grid = -1; return; }
        if (hipOccupancyMaxActiveBlocksPerMultiprocessor(&per_cu, (const void*)fwd_kernel, NT, LDS_BYTES) != hipSuccess || per_cu < 1) { fprintf(stderr, "kernel_launch: occupancy query says %d\n", per_cu); per_cu = 1; }
        (void)hipGetLastError();
        grid = cus;
    }
    if (grid < 0) return;
    (void)hipMemsetAsync((char*)d_ws + WS_CTL, 0, CTL_ZERO_BYTES, stream);
    Args a{};
    for (int i = 0; i < 22; ++i) a.in[i] = (const float*)d_in[i];
    a.out = (float*)d_out; a.ws = (unsigned char*)d_ws;
#if MK_MULTI
    for (int p = 0; p < NPHASE; ++p) { a.ph_lo = p; a.ph_hi = p + 1; hipLaunchKernelGGL(fwd_kernel, dim3(grid), dim3(NT), LDS_BYTES, stream, a);
#if MK_CHECK
        if (p == 0) (void)hipMemsetAsync((char*)d_ws + WS_CHK, 0, 4096, stream);
        static const int after[21] = {0, 0, 0, 1, 1, 1, 2, 3, 3, 3, 4, 4, 5, 6, 7, 8, 8, 9, 10, 11, 12};
        for (int st = 0; st < 21; ++st) if (after[st] == p) hipLaunchKernelGGL(chk_kernel, dim3(st == 12 ? 1024 : 32), dim3(128), 0, stream, a, st);
        if (p == NPHASE - 1) hipLaunchKernelGGL(chk_final, dim3(1024), dim3(256), 0, stream, a);
#endif
    }
#else
    a.ph_lo = 0; a.ph_hi = NPHASE;
#if MK_COOP
    void* kargs[] = {&a};
    hipError_t e = hipLaunchCooperativeKernel((const void*)fwd_kernel, dim3(grid), dim3(NT), kargs, LDS_BYTES, stream);
    if (e != hipSuccess) fprintf(stderr, "kernel_launch: cooperative launch failed: %s (grid %d)\n", hipGetErrorString(e), grid);
#else
    hipLaunchKernelGGL(fwd_kernel, dim3(grid), dim3(NT), LDS_BYTES, stream, a);
#endif
#endif
}
```

```cpp
#include <hip/hip_runtime.h>
#include <cstdio>
#include <cstdint>

#define LAS __attribute__((address_space(3)))
#define GAS __attribute__((address_space(1)))
typedef unsigned short bf16;
typedef short bf16x8 __attribute__((ext_vector_type(8)));
typedef float f32x4 __attribute__((ext_vector_type(4)));
typedef float f32x2 __attribute__((ext_vector_type(2)));
typedef unsigned u32x4 __attribute__((ext_vector_type(4)));
typedef unsigned u32x2 __attribute__((ext_vector_type(2)));

#ifndef ABL_NOMOE
#define ABL_NOMOE 0
#endif
#ifndef REP_PHASE
#define REP_PHASE -1
#endif
#ifndef PROBE_REPS
#define PROBE_REPS 1, 1, 1, 1, 1, 1, 1, 1
#endif
#ifndef REP_COUNT
#define REP_COUNT 1
#endif
#ifndef MK_COOP
#define MK_COOP 1
#endif
#ifndef MK_MULTI
#define MK_MULTI 0
#endif

constexpr int D = 1024, NB = 2, SEQ = 8192, M = NB * SEQ, LC = 256, MC = NB * LC, MT = M + MC;
constexpr int DIN = 4128;
constexpr int NCH = SEQ / 64, NCHC = LC / 64, NSLOT = NCH + NCHC;
constexpr int NE = 16, CAP = 1024;
constexpr float EPS = 1e-6f;
constexpr int NWAVES = 8, NT = 512;
constexpr int NPHASE = 14;

constexpr size_t MiB = 1u << 20;
constexpr size_t WS_CTL = 0, CTL_ZERO_BYTES = 64 * 1024;
constexpr size_t WS_MOD = 1 * MiB;
constexpr size_t WS_DEC = 1 * MiB + 128 * 1024;
constexpr size_t WS_WIN = 2 * MiB, WS_WO = 10 * MiB, WS_WG = 12 * MiB, WS_WC = 13 * MiB;
constexpr size_t WS_AFF = 14 * MiB, WS_INV = 15 * MiB, WS_IDX = 16 * MiB, WS_WSEL = 16 * MiB + 256 * 1024;
constexpr size_t WS_H1 = 20 * MiB;
constexpr size_t WS_ST = 20 * MiB, WS_H2 = 20 * MiB;
constexpr size_t WS_KB = 52 * MiB, WS_VB = 61 * MiB, WS_QB = 78 * MiB, WS_SG = 86 * MiB, WS_PI = 102 * MiB, WS_RB = 118 * MiB;
constexpr size_t WS_AG = 102 * MiB;
constexpr size_t WS_SM = 121 * MiB;
constexpr size_t WS_KV = 249 * MiB;
constexpr size_t WS_PO = 282 * MiB;
constexpr size_t WS_MG = 249 * MiB;
constexpr size_t WS_WGU = 185 * MiB, WS_WD = 52 * MiB, WS_ACT = 121 * MiB, WS_YB = 185 * MiB;
constexpr size_t WS_H1F = 249 * MiB;
constexpr size_t WS_WINM = 265 * MiB;
constexpr size_t WS_YD = 153 * MiB;
constexpr size_t WS_XS = 68 * MiB;
constexpr size_t WS_END = 300 * MiB;
constexpr int CW_BAR = 1024;

constexpr int LDS_BYTES = 155648;
constexpr int MISC_OFF = 153600;

#define LDS_WAIT() asm volatile("s_waitcnt lgkmcnt(0)" ::: "memory")
#define VM_WAIT() asm volatile("s_waitcnt vmcnt(0)" ::: "memory")
__device__ __forceinline__ unsigned f2bf(float f) { unsigned u = __builtin_bit_cast(unsigned, f); return (u + 0x7fffu + ((u >> 16) & 1u)) >> 16; }
__device__ __forceinline__ unsigned pk2(float lo, float hi) { return f2bf(lo) | (f2bf(hi) << 16); }
__device__ __forceinline__ float bf2f(unsigned h) { return __builtin_bit_cast(float, h << 16); }
__device__ __forceinline__ float bflo(unsigned w) { return __builtin_bit_cast(float, w << 16); }
__device__ __forceinline__ float bfhi(unsigned w) { return __builtin_bit_cast(float, w & 0xffff0000u); }
__device__ __forceinline__ unsigned cvt_pk_bf16(float lo, float hi) { unsigned r; asm volatile("v_cvt_pk_bf16_f32 %0, %1, %2" : "=v"(r) : "v"(lo), "v"(hi)); return r; }
__device__ __forceinline__ unsigned pk4_fp8(float a, float b, float c, float d) { int w = 0; w = __builtin_amdgcn_cvt_pk_fp8_f32(a, b, w, false); w = __builtin_amdgcn_cvt_pk_fp8_f32(c, d, w, true); return (unsigned)w; }
__device__ __forceinline__ float wave_sum(float v) {
#pragma unroll
    for (int o = 1; o < 64; o <<= 1) v += __shfl_xor(v, o);
    return v;
}
__device__ __forceinline__ float silu_f(float x) { return x * __builtin_amdgcn_rcpf(1.f + __expf(-x)); }
__device__ __forceinline__ float sigmoid_f(float x) { return __builtin_amdgcn_rcpf(1.f + __expf(-x)); }
__device__ __forceinline__ float logsig_f(float z) { return fminf(z, 0.f) - log1pf(expf(-fabsf(z))); }

#define XB_TMO      128
#define XB_XCNT(j)  (256  + 64 * (j))
#define XB_XSUB(j)  (1280 + 64 * (j))
#define XB_XGEN(j)  (2304 + 64 * (j))
#define XB_TOP      3328
#define XB_TOPGEN   3392
#define XCD_BAR_WORDS 3456
#define XB_SPIN_CAP (1u << 20)
__device__ __forceinline__ unsigned xb_ld(unsigned* p)              { return __hip_atomic_load(p, __ATOMIC_RELAXED, __HIP_MEMORY_SCOPE_AGENT); }
__device__ __forceinline__ unsigned xb_add(unsigned* p, unsigned v) { return __hip_atomic_fetch_add(p, v, __ATOMIC_RELAXED, __HIP_MEMORY_SCOPE_AGENT); }
__device__ __forceinline__ unsigned xb_xcc_id() { return (unsigned)__builtin_amdgcn_s_getreg((3 << 11) | 20) & 0xFu; }
#define XB_SPIN(cond, bar) do { unsigned _sp = 0; while (cond) { __builtin_amdgcn_s_sleep(1); \
    if ((++_sp & 255u) == 0u) { if (xb_ld(&(bar)[XB_TMO])) break; if (_sp > XB_SPIN_CAP) { atomicAdd(&(bar)[XB_TMO], 1u); break; } } } } while (0)
struct XcdBarrier { unsigned* bar; unsigned x; volatile LAS unsigned* st; };
__device__ __forceinline__ XcdBarrier xcd_barrier_post(unsigned* bar, volatile LAS unsigned* st) {
    XcdBarrier b; b.bar = bar; b.x = xb_xcc_id(); b.st = st;
    if (threadIdx.x == 0) (void)xb_add(&bar[XB_XCNT(b.x)], 1u);
    return b;
}
__device__ __forceinline__ void xcd_barrier_complete(unsigned* bar, unsigned x, unsigned& nloc, unsigned& nx) {
    const unsigned G = gridDim.x * gridDim.y * gridDim.z;
    unsigned sum, cnt, mine, sp = 0u;
    for (;;) {
        sum = 0u; cnt = 0u; mine = 0u;
#pragma unroll
        for (unsigned j = 0; j < 16; ++j) { const unsigned c = xb_ld(&bar[XB_XCNT(j)]); sum += c; cnt += (c > 0u) ? 1u : 0u; mine = (j == x) ? c : mine; }
        if (sum == G) break;
        __builtin_amdgcn_s_sleep(1);
        if ((++sp & 255u) == 0u) { if (xb_ld(&bar[XB_TMO])) break; if (sp > XB_SPIN_CAP) { atomicAdd(&bar[XB_TMO], 1u); break; } }
    }
    nloc = mine > 0u ? mine : 1u; nx = cnt > 0u ? cnt : 1u;
}
__device__ __forceinline__ void xcd_barrier(const XcdBarrier& b) {
    asm volatile("s_waitcnt vmcnt(0)" ::: "memory");
    __syncthreads();
    if (threadIdx.x == 0) {
        unsigned* bar = b.bar;
        __builtin_amdgcn_s_waitcnt(0);
        unsigned nloc = b.st[0], nx = b.st[1];
        if (nloc == 0u) { xcd_barrier_complete(bar, b.x, nloc, nx); b.st[0] = nloc; b.st[1] = nx; }
        const unsigned old = xb_add(&bar[XB_XSUB(b.x)], 1u);
        const unsigned gen = old / nloc;
        if (old + 1u == (gen + 1u) * nloc) {
            __builtin_amdgcn_fence(__ATOMIC_RELEASE, "agent");
            asm volatile("s_waitcnt vmcnt(0)" ::: "memory");
            const unsigned og = xb_add(&bar[XB_TOP], 1u);
            const unsigned tg = og / nx;
            if (og + 1u == (tg + 1u) * nx) xb_add(&bar[XB_TOPGEN], 1u);
            else XB_SPIN(xb_ld(&bar[XB_TOPGEN]) == tg, bar);
            __builtin_amdgcn_fence(__ATOMIC_ACQUIRE, "agent");
            xb_add(&bar[XB_XGEN(b.x)], 1u);
            asm volatile("s_waitcnt vmcnt(0)" ::: "memory");
        } else {
            XB_SPIN(xb_ld(&bar[XB_XGEN(b.x)]) == gen, bar);
            __builtin_amdgcn_fence(__ATOMIC_ACQUIRE, "agent");
            asm volatile("s_waitcnt vmcnt(0)" ::: "memory");
        }
    }
    __syncthreads();
}

namespace pg8 {
constexpr int BM = 256, BK = 64, HALF = 128, HTB = HALF * BK * 2, STAGE_BYTES = 8 * HTB;
__device__ __forceinline__ int lds_byte(int r, int c) { const int st = (r >> 4) * 2 + (c >> 5), rr = r & 15, cc = c & 31, ob = rr * 64 + cc * 2; return st * 1024 + (ob ^ (((ob >> 9) & 1) << 5)); }
__device__ __forceinline__ void stage_rc(int b, int& R, int& C) { const int st = b / 1024, sb = b % 1024, swz = sb ^ (((sb >> 9) & 1) << 5); R = (st >> 1) * 16 + swz / 64; C = (st & 1) * 32 + (swz % 64) / 2; }
__device__ __forceinline__ int perm32(int rho) { const int n = rho >> 4, i = rho & 15; return 8 * (i >> 2) + 4 * n + (i & 3); }
struct Unit { int pm, pn, aux, keep; };
typedef int v8i __attribute__((ext_vector_type(8)));
typedef int v4i __attribute__((ext_vector_type(4)));
__device__ __forceinline__ void xcd_tile(int L, int nM, int nN, int& pm, int& pn) {
    const int nwg = nM * nN; int wgid = L;
    { const int q = nwg / 8, r = nwg % 8, xcd = wgid % 8, off = wgid / 8; wgid = (xcd < r ? xcd * (q + 1) : r * (q + 1) + (xcd - r) * q) + off; }
    const int nig = 8 * nN, gid = wgid / nig, fm = gid * 8, gsz = (nM - fm) < 8 ? (nM - fm) : 8;
    pm = fm + ((wgid % nig) % gsz); pn = (wgid % nig) / gsz;
}

template <class Epi, class Sched, bool GATHER, bool FP8 = false>
__device__ __forceinline__ void gemm_phase(LAS unsigned char* lds, const Sched& S, const Epi& E) {
    int tid = threadIdx.x; asm volatile("" : "+v"(tid));
    const int wid = __builtin_amdgcn_readfirstlane(tid >> 6), lane = tid & 63, wr = wid >> 2, wc = wid & 3, fr = lane & 15, fq = lane >> 4;
    const int K = S.K, KB = FP8 ? K : 2 * K, nt = KB / (2 * BK);
    unsigned voffA[2], voffB[2]; int Rs[2], Cb[2];
#pragma unroll
    for (int i = 0; i < 2; ++i) { int R, C; stage_rc(tid * 16 + i * 8192, R, C); const int Rb = Epi::PERM ? ((R & ~31) + perm32(R & 31)) : R;
        Rs[i] = R; Cb[i] = C * 2; voffA[i] = (unsigned)(R * KB + C * 2); voffB[i] = (unsigned)(Rb * KB + C * 2); }
    const size_t kstep = (size_t)(BK * 2);
    const size_t hstep = (size_t)HALF * KB;
    const size_t hstepA = GATHER ? 0 : hstep;
    const unsigned ldsw = (unsigned)wid * 1024u;
    const int aoff = FP8 ? lds_byte(wr * 64 + fr, fq * 16) : lds_byte(wr * 64 + fr, fq * 8), boff = FP8 ? lds_byte(wc * 32 + fr, fq * 16) : lds_byte(wc * 32 + fr, fq * 8);
#define PG8_SA(b, h) (((b) * 2 + (h)) * HTB)
#define PG8_SB(b, h) ((4 + (b) * 2 + (h)) * HTB)
#define PG8_STAGE(bufoff, gbase, voff, W) do { _Pragma("unroll") for (int _i = 0; _i < 2; ++_i) { \
        if constexpr (FP8) __builtin_amdgcn_raw_ptr_buffer_load_lds(rsrc##W, (LAS unsigned*)(lds + (bufoff) + ldsw + _i * 8192), 16, (int)(voff)[_i], (int)(unsigned)((const char*)(gbase) - base##W), 0, 0); \
        else __builtin_amdgcn_global_load_lds((const unsigned*)((const char*)(gbase) + (voff)[_i]), (LAS unsigned*)(lds + (bufoff) + ldsw + _i * 8192), 16, 0, 0); } } while (0)
#define PG8_LDA(dst, b, h) do { _Pragma("unroll") for (int m = 0; m < 4; ++m) { \
        if constexpr (FP8) { const v4i _lo = *(const LAS v4i*)(lds + PG8_SA(b, h) + aoff + m * 2048), _hi = *(const LAS v4i*)(lds + PG8_SA(b, h) + aoff + m * 2048 + 16); dst##8[m] = __builtin_shufflevector(_lo, _hi, 0, 1, 2, 3, 4, 5, 6, 7); } \
        else { _Pragma("unroll") for (int k = 0; k < 2; ++k) dst[m][k] = *(const LAS bf16x8*)(lds + PG8_SA(b, h) + aoff + m * 2048 + k * 1024); } } } while (0)
#define PG8_LDB(dst, b, h) do { _Pragma("unroll") for (int n = 0; n < 2; ++n) { \
        if constexpr (FP8) { const v4i _lo = *(const LAS v4i*)(lds + PG8_SB(b, h) + boff + n * 2048), _hi = *(const LAS v4i*)(lds + PG8_SB(b, h) + boff + n * 2048 + 16); dst##8[n] = __builtin_shufflevector(_lo, _hi, 0, 1, 2, 3, 4, 5, 6, 7); } \
        else { _Pragma("unroll") for (int k = 0; k < 2; ++k) dst[n][k] = *(const LAS bf16x8*)(lds + PG8_SB(b, h) + boff + n * 2048 + k * 1024); } } } while (0)
#define PG8_MMA(ai, bj, At, Bt) do { __builtin_amdgcn_s_setprio(1); \
        if constexpr (FP8) { _Pragma("unroll") for (int m = 0; m < 4; ++m) _Pragma("unroll") for (int n = 0; n < 2; ++n) \
            acc[ai][bj][m][n] = __builtin_amdgcn_mfma_scale_f32_16x16x128_f8f6f4(Bt##8[n], At##8[m], acc[ai][bj][m][n], 0, 0, 0, 0, 0, 0); } \
        else { _Pragma("unroll") for (int m = 0; m < 4; ++m) _Pragma("unroll") for (int n = 0; n < 2; ++n) _Pragma("unroll") for (int k = 0; k < 2; ++k) \
            acc[ai][bj][m][n] = __builtin_amdgcn_mfma_f32_16x16x32_bf16(Bt[n][k], At[m][k], acc[ai][bj][m][n], 0, 0, 0); } \
        __builtin_amdgcn_s_setprio(0); } while (0)
#define PG8_WAIT_V(n) asm volatile("s_waitcnt vmcnt(" #n ")" ::: "memory")
#define PG8_WAIT_L(n) asm volatile("s_waitcnt lgkmcnt(" #n ")" ::: "memory")
#define PG8_BAR __builtin_amdgcn_s_barrier()
#define PG8_SCHED __builtin_amdgcn_sched_barrier(0)
    Unit cur, nxt; int ui = 0;
    if (!S.next(0, cur)) return;
    const char* baseA = S.base_a(); const char* baseB = S.base_b();
    const __amdgpu_buffer_rsrc_t rsrcA = __builtin_amdgcn_make_buffer_rsrc((void*)baseA, 0, 0x7fffffff, 0x00020000), rsrcB = __builtin_amdgcn_make_buffer_rsrc((void*)baseB, 0, 0x7fffffff, 0x00020000);
    f32x4 acc[2][2][4][2];
#pragma unroll
    for (int a = 0; a < 2; ++a)
#pragma unroll
        for (int b = 0; b < 2; ++b)
#pragma unroll
            for (int m = 0; m < 4; ++m)
#pragma unroll
                for (int n = 0; n < 2; ++n) acc[a][b][m][n] = (f32x4){0.f, 0.f, 0.f, 0.f};
    bf16x8 At[4][2], B0[2][2], B1[2][2]; v8i At8[4], B08[2], B18[2];
    const char* cA = S.a_base(cur); const char* cB = S.b_base(cur);
    unsigned cv0[2], cv1[2], nv0[2], nv1[2];
#pragma unroll
    for (int i = 0; i < 2; ++i) {
        if constexpr (GATHER) { cv0[i] = (unsigned)S.a_row(cur, Rs[i]) * (unsigned)KB + (unsigned)Cb[i]; cv1[i] = (unsigned)S.a_row(cur, HALF + Rs[i]) * (unsigned)KB + (unsigned)Cb[i]; }
        else { cv0[i] = voffA[i]; cv1[i] = voffA[i]; }
        nv0[i] = cv0[i]; nv1[i] = cv1[i];
    }
    PG8_STAGE(PG8_SB(0, 0), cB, voffB, B); PG8_STAGE(PG8_SB(0, 1), cB + hstep, voffB, B); PG8_STAGE(PG8_SA(0, 0), cA, cv0, A); PG8_STAGE(PG8_SA(0, 1), cA + hstepA, cv1, A);
    if (wr == 1) PG8_BAR;
    PG8_WAIT_V(2); PG8_BAR;
    PG8_STAGE(PG8_SB(1, 0), cB + kstep, voffB, B); PG8_STAGE(PG8_SA(1, 0), cA + kstep, cv0, A); PG8_STAGE(PG8_SB(1, 1), cB + hstep + kstep, voffB, B);
    PG8_WAIT_V(6); PG8_BAR;
    for (;;) {
        const bool has_next = S.next(ui + 1, nxt);
        const char* nA = has_next ? S.a_base(nxt) : cA; const char* nB = has_next ? S.b_base(nxt) : cB;
        if constexpr (GATHER) {
#pragma unroll
            for (int i = 0; i < 2; ++i) {
                if (has_next) { nv0[i] = (unsigned)S.a_row(nxt, Rs[i]) * (unsigned)KB + (unsigned)Cb[i]; nv1[i] = (unsigned)S.a_row(nxt, HALF + Rs[i]) * (unsigned)KB + (unsigned)Cb[i]; }
                else { nv0[i] = cv0[i]; nv1[i] = cv1[i]; }
            }
        }
        for (int t = 0; t < nt; t += 2) {
            const bool last = (t == nt - 2);
            const char* a1 = cA + (size_t)(t + 1) * kstep;
            const char* a2 = last ? nA : cA + (size_t)(t + 2) * kstep; const char* b2 = last ? nB : cB + (size_t)(t + 2) * kstep;
            const char* a3 = a2 + kstep; const char* b3 = b2 + kstep;
            unsigned s0[2], s1[2];
#pragma unroll
            for (int i = 0; i < 2; ++i) { s0[i] = (GATHER && last) ? nv0[i] : cv0[i]; s1[i] = (GATHER && last) ? nv1[i] : cv1[i]; }
            PG8_LDB(B0, 0, 0); PG8_LDB(B1, 0, 1); PG8_SCHED; PG8_LDA(At, 0, 0); PG8_STAGE(PG8_SA(1, 1), a1 + hstepA, cv1, A);
            PG8_WAIT_V(8); PG8_WAIT_L(0); PG8_BAR; PG8_MMA(0, 0, At, B0); PG8_MMA(0, 1, At, B1); PG8_BAR; PG8_SCHED;
            PG8_LDA(At, 0, 1); PG8_STAGE(PG8_SB(0, 0), b2, voffB, B); PG8_STAGE(PG8_SB(0, 1), b2 + hstep, voffB, B); PG8_STAGE(PG8_SA(0, 0), a2, s0, A);
            PG8_WAIT_V(8); PG8_WAIT_L(0); PG8_BAR; PG8_MMA(1, 0, At, B0); PG8_MMA(1, 1, At, B1); PG8_BAR; PG8_SCHED;
            PG8_LDB(B0, 1, 0); PG8_LDB(B1, 1, 1); PG8_SCHED; PG8_LDA(At, 1, 0); PG8_STAGE(PG8_SA(0, 1), a2 + hstepA, s1, A);
            PG8_WAIT_V(8); PG8_WAIT_L(0); PG8_BAR; PG8_MMA(0, 0, At, B0); PG8_MMA(0, 1, At, B1); PG8_BAR; PG8_SCHED;
            PG8_LDA(At, 1, 1); PG8_STAGE(PG8_SB(1, 0), b3, voffB, B); PG8_STAGE(PG8_SB(1, 1), b3 + hstep, voffB, B); PG8_STAGE(PG8_SA(1, 0), a3, s0, A);
            PG8_WAIT_V(8); PG8_WAIT_L(0); PG8_BAR; PG8_MMA(1, 0, At, B0); PG8_MMA(1, 1, At, B1); PG8_BAR; PG8_SCHED;
        }
        if (wr == 0) PG8_BAR;
        E(acc, cur, wr, wc, fr, fq);
        if (!has_next) break;
        E.post(acc, cur, wr, wc, fr, fq);
        cur = nxt; cA = nA; cB = nB; ++ui;
#pragma unroll
        for (int i = 0; i < 2; ++i) { cv0[i] = nv0[i]; cv1[i] = nv1[i]; }
        if (wr == 1) PG8_BAR;
    }
    PG8_WAIT_V(0);
    PG8_BAR;
#undef PG8_SA
#undef PG8_SB
#undef PG8_STAGE
#undef PG8_LDA
#undef PG8_LDB
#undef PG8_MMA
#undef PG8_WAIT_V
#undef PG8_WAIT_L
#undef PG8_BAR
#undef PG8_SCHED
}
}

using pg8::Unit;
struct SchedDense {
    int G, c, K, nM, nN; const char* A; const char* B; int i0, i1, eb;
    __device__ __forceinline__ bool next(int i, Unit& u) const { const int L = (i + i0) * G + c; if (i + i0 >= i1 || L >= nM * nN) return false; pg8::xcd_tile(L, nM, nN, u.pm, u.pn); u.aux = 0; u.keep = 0; return true; }
    __device__ __forceinline__ const char* a_base(const Unit& u) const { return A + (size_t)u.pm * 256 * K * eb; }
    __device__ __forceinline__ const char* b_base(const Unit& u) const { return B + (size_t)u.pn * 256 * K * eb; }
    __device__ __forceinline__ int a_row(const Unit&, int) const { return 0; }
    __device__ __forceinline__ const char* base_a() const { return A; }
    __device__ __forceinline__ const char* base_b() const { return B; }
};
struct SchedPair {
    int G, c, K; const char *A0, *A1, *B0, *B1;
    __device__ __forceinline__ bool next(int i, Unit& u) const { const int p = (i >> 1) * G + c; if (p >= 256) return false; pg8::xcd_tile(p, 64, 4, u.pm, u.pn); u.aux = i & 1; u.keep = 0; return true; }
    __device__ __forceinline__ const char* a_base(const Unit& u) const { return (u.aux ? A1 : A0) + (size_t)u.pm * 256 * K * 2; }
    __device__ __forceinline__ const char* b_base(const Unit& u) const { return (u.aux ? B1 : B0) + (size_t)u.pn * 256 * K * 2; }
    __device__ __forceinline__ int a_row(const Unit&, int) const { return 0; }
    __device__ __forceinline__ const char* base_a() const { return A0; }
    __device__ __forceinline__ const char* base_b() const { return B0; }
};
struct SchedMoe1 {
    int G, c, K; const char* A; const char* B; int i0, i1;
    __device__ __forceinline__ bool next(int i, Unit& u) const { const int L = (i + i0) * G + c; if (i + i0 >= i1 || L >= 1024) return false;
        const int xcd = L & 7, q = L >> 3, round = q >> 5, slot = q & 31, e = xcd + 8 * (round >> 1), u64 = (round & 1) * 32 + slot, mrow = u64 & 7;
        u.pn = u64 >> 3; u.pm = mrow & 3; u.aux = (mrow >> 2) * 16 + e; u.keep = 0; return true; }
    __device__ __forceinline__ const char* a_base(const Unit& u) const { return A + ((size_t)u.aux * 1024 + (size_t)u.pm * 256) * K; }
    __device__ __forceinline__ const char* b_base(const Unit& u) const { return B + ((size_t)(u.aux & 15) * 2048 + (size_t)u.pn * 256) * K; }
    __device__ __forceinline__ int a_row(const Unit&, int) const { return 0; }
    __device__ __forceinline__ const char* base_a() const { return A; }
    __device__ __forceinline__ const char* base_b() const { return B; }
};
struct SchedMoe2 {
    int G, c, K; const char* A; const char* B;
    __device__ __forceinline__ bool next(int i, Unit& u) const { const int L = i * G + c; if (L >= 512) return false;
        const int xcd = L & 7, q = L >> 3, round = q >> 5, slot = q & 31, e = xcd + 8 * round, mrow = slot & 7;
        u.pn = slot >> 3; u.pm = mrow & 3; u.aux = (mrow >> 2) * 16 + e; u.keep = 0; return true; }
    __device__ __forceinline__ const char* a_base(const Unit& u) const { return A + ((size_t)u.aux * 1024 + (size_t)u.pm * 256) * K; }
    __device__ __forceinline__ const char* b_base(const Unit& u) const { return B + ((size_t)(u.aux & 15) * 1024 + (size_t)u.pn * 256) * K; }
    __device__ __forceinline__ int a_row(const Unit&, int) const { return 0; }
    __device__ __forceinline__ const char* base_a() const { return A; }
    __device__ __forceinline__ const char* base_b() const { return B; }
};

typedef f32x4 AccT[2][2][4][2];
__device__ __forceinline__ size_t gate_off(int pm, int pg, int ai, int m, int bj, int wr, int wc, int fr, int fq) { return ((size_t)(pm * 8 + pg) << 16) + (size_t)((((ai * 4 + m) * 2 + bj) * 8 + wr * 4 + wc) * 512 + (fq * 16 + fr) * 8); }
__device__ __forceinline__ unsigned pk4_u8(float a, float b, float c, float d) { return (unsigned)__builtin_amdgcn_cvt_pk_u8_f32(d, 3, __builtin_amdgcn_cvt_pk_u8_f32(c, 2, __builtin_amdgcn_cvt_pk_u8_f32(b, 1, __builtin_amdgcn_cvt_pk_u8_f32(a, 0, 0u)))); }
template <bool GATES> struct EpiInprojT {
    static constexpr bool PERM = true;
    bf16 *KBp, *VBp, *QBp, *SGp, *PIp; unsigned char* SMp; int pn_off; float sc;
    __device__ __forceinline__ void post(AccT& acc, const Unit&, int, int, int, int) const {
#pragma unroll
        for (int a = 0; a < 2; ++a)
#pragma unroll
            for (int b = 0; b < 2; ++b)
#pragma unroll
                for (int m = 0; m < 4; ++m)
#pragma unroll
                    for (int n = 0; n < 2; ++n) acc[a][b][m][n] = (f32x4){0.f, 0.f, 0.f, 0.f};
    }
    __device__ __forceinline__ void operator()(const AccT& acc, const Unit& u, int wr, int wc, int fr, int fq) const {
        const int pn = u.pn + pn_off;
        if constexpr (GATES) {
            unsigned char* tp = SMp + ((size_t)(u.pm * 8 + pn - 8) << 16) + (unsigned)((wr * 4 + wc) * 512 + (fq * 16 + fr) * 8);
#pragma unroll
            for (int ai = 0; ai < 2; ++ai)
#pragma unroll
                for (int m = 0; m < 4; ++m) {
#pragma unroll
                    for (int bj = 0; bj < 2; ++bj) { const f32x4 v0 = acc[ai][bj][m][0], v1 = acc[ai][bj][m][1];
                        u32x2 w; w.x = pk4_u8(255.f * sigmoid_f(sc * v0[0]), 255.f * sigmoid_f(sc * v0[1]), 255.f * sigmoid_f(sc * v0[2]), 255.f * sigmoid_f(sc * v0[3]));
                        w.y = pk4_u8(255.f * sigmoid_f(sc * v1[0]), 255.f * sigmoid_f(sc * v1[1]), 255.f * sigmoid_f(sc * v1[2]), 255.f * sigmoid_f(sc * v1[3]));
                        *(u32x2*)(tp + (((ai * 4 + m) * 2 + bj) * 4096)) = w; }
                    asm volatile("" ::: "memory"); }
        } else {
        bf16* base; int ld, colt, act;
        if (pn == 0) { base = KBp; ld = 256; colt = 0; act = 0; }
        else if (pn < 3) { base = VBp; ld = 512; colt = (pn - 1) * 256; act = 0; }
        else if (pn == 3) { base = QBp; ld = 256; colt = 0; act = 3; }
        else if (pn < 6) { base = SGp; ld = 512; colt = (pn - 4) * 256; act = 1; }
        else { base = PIp; ld = 512; colt = (pn - 6) * 256; act = 0; }
        const int row0 = u.pm * 256 + wr * 64 + fr, col0 = colt + wc * 32 + 8 * fq;
#pragma unroll
        for (int ai = 0; ai < 2; ++ai)
#pragma unroll
            for (int m = 0; m < 4; ++m) { bf16* rowp = base + (size_t)(row0 + ai * 128 + m * 16) * ld + col0;
#pragma unroll
                for (int bj = 0; bj < 2; ++bj) { f32x4 v0 = acc[ai][bj][m][0], v1 = acc[ai][bj][m][1];
                    if (act == 1) {
#pragma unroll
                        for (int j = 0; j < 4; ++j) { v0[j] = silu_f(v0[j]); v1[j] = silu_f(v1[j]); } }
                    else if (act == 3) { v0 = v0 * 0.125f; v1 = v1 * 0.125f; }
                    u32x4 w; w.x = cvt_pk_bf16(v0[0], v0[1]); w.y = cvt_pk_bf16(v0[2], v0[3]); w.z = cvt_pk_bf16(v1[0], v1[1]); w.w = cvt_pk_bf16(v1[2], v1[3]);
                    *(u32x4*)(rowp + bj * 128) = w; } }
        }
    }
};
typedef EpiInprojT<false> EpiInproj; typedef EpiInprojT<true> EpiGates;
struct EpiMerge {
    static constexpr bool PERM = true;
    const unsigned char* SMp; bf16* MGp;
    __device__ __forceinline__ void post(AccT& acc, const Unit& u, int wr, int wc, int fr, int fq) const {
        const unsigned msk = u.aux ? 0u : 0xffffffffu;
        u32x2 ga[2][2], gb[2][2];
#define EPM_LOADR(buf, g) do { _Pragma("unroll") for (int bj = 0; bj < 2; ++bj) { ga[buf][bj] = *(const u32x2*)(SMp + gate_off(u.pm, u.pn, (g) >> 2, (g) & 3, bj, wr, wc, fr, fq)); \
            gb[buf][bj] = *(const u32x2*)(SMp + gate_off(u.pm, u.pn + 4, (g) >> 2, (g) & 3, bj, wr, wc, fr, fq)); } } while (0)
#define EPM_RATIO(a_, b_, sh) ((float)(((a_) >> (sh)) & 255u) * __builtin_amdgcn_rcpf((float)max(((b_) >> (sh)) & 255u, 1u)))
        EPM_LOADR(0, 0);
#pragma unroll
        for (int g = 0; g < 8; ++g) {
            if (g + 1 < 8) EPM_LOADR((g + 1) & 1, g + 1);
            asm volatile("" ::: "memory");
#pragma unroll
            for (int bj = 0; bj < 2; ++bj) { u32x2 p = ga[g & 1][bj]; const u32x2 q = gb[g & 1][bj]; p.x &= msk; p.y &= msk; f32x4 v0 = acc[g >> 2][bj][g & 3][0], v1 = acc[g >> 2][bj][g & 3][1];
                v0[0] *= EPM_RATIO(p.x, q.x, 0); v0[1] *= EPM_RATIO(p.x, q.x, 8); v0[2] *= EPM_RATIO(p.x, q.x, 16); v0[3] *= EPM_RATIO(p.x, q.x, 24);
                v1[0] *= EPM_RATIO(p.y, q.y, 0); v1[1] *= EPM_RATIO(p.y, q.y, 8); v1[2] *= EPM_RATIO(p.y, q.y, 16); v1[3] *= EPM_RATIO(p.y, q.y, 24);
                acc[g >> 2][bj][g & 3][0] = v0; acc[g >> 2][bj][g & 3][1] = v1; }
            asm volatile("" ::: "memory"); }
#undef EPM_LOADR
#undef EPM_RATIO
    }
    __device__ __forceinline__ void operator()(const AccT& acc, const Unit& u, int wr, int wc, int fr, int fq) const {
        if (!u.aux) return;
        const int row0 = u.pm * 256 + wr * 64 + fr, col0 = u.pn * 256 + wc * 32 + 8 * fq;
        u32x2 gb[2][2];
#define EPM_ROW(g) ((size_t)(row0 + ((g) >> 2) * 128 + ((g) & 3) * 16))
#define EPM_LOAD(buf, g) do { _Pragma("unroll") for (int bj = 0; bj < 2; ++bj) gb[buf][bj] = *(const u32x2*)(SMp + gate_off(u.pm, u.pn + 4, (g) >> 2, (g) & 3, bj, wr, wc, fr, fq)); } while (0)
        EPM_LOAD(0, 0);
#pragma unroll
        for (int g = 0; g < 8; ++g) {
            if (g + 1 < 8) EPM_LOAD((g + 1) & 1, g + 1);
            asm volatile("" ::: "memory");
#pragma unroll
            for (int bj = 0; bj < 2; ++bj) { const u32x2 gq = gb[g & 1][bj]; const f32x4 v0 = acc[g >> 2][bj][g & 3][0], v1 = acc[g >> 2][bj][g & 3][1];
                const float k = 1.f / 255.f;
                const float g0 = k * (float)max(gq.x & 255u, 1u), g1 = k * (float)max((gq.x >> 8) & 255u, 1u), g2 = k * (float)max((gq.x >> 16) & 255u, 1u), g3 = k * (float)max(gq.x >> 24, 1u);
                const float g4 = k * (float)max(gq.y & 255u, 1u), g5 = k * (float)max((gq.y >> 8) & 255u, 1u), g6 = k * (float)max((gq.y >> 16) & 255u, 1u), g7 = k * (float)max(gq.y >> 24, 1u);
                u32x4 w; w.x = cvt_pk_bf16(v0[0] * g0, v0[1] * g1); w.y = cvt_pk_bf16(v0[2] * g2, v0[3] * g3);
                w.z = cvt_pk_bf16(v1[0] * g4, v1[1] * g5); w.w = cvt_pk_bf16(v1[2] * g6, v1[3] * g7);
                *(u32x4*)(MGp + EPM_ROW(g) * 1024 + col0 + bj * 128) = w; }
            asm volatile("" ::: "memory"); }
#undef EPM_ROW
#undef EPM_LOAD
    }
};
struct EpiOut {
    static constexpr bool PERM = true;
    const float* MODp; bf16* YDp;
    __device__ __forceinline__ void post(AccT& acc, const Unit&, int, int, int, int) const {
#pragma unroll
        for (int a = 0; a < 2; ++a)
#pragma unroll
            for (int b = 0; b < 2; ++b)
#pragma unroll
                for (int m = 0; m < 4; ++m)
#pragma unroll
                    for (int n = 0; n < 2; ++n) acc[a][b][m][n] = (f32x4){0.f, 0.f, 0.f, 0.f};
    }
    __device__ __forceinline__ void operator()(const AccT& acc, const Unit& u, int wr, int wc, int fr, int fq) const {
        const int row0 = u.pm * 256 + wr * 64 + fr, col0 = u.pn * 256 + wc * 32 + 8 * fq;
        const float* gt = MODp + (size_t)(u.pm >> 5) * 6144 + 2048 + col0;
        f32x4 gv[2][2];
#pragma unroll
        for (int bj = 0; bj < 2; ++bj)
#pragma unroll
            for (int n = 0; n < 2; ++n) gv[bj][n] = *(const f32x4*)(gt + bj * 128 + n * 4);
#pragma unroll
        for (int ai = 0; ai < 2; ++ai)
#pragma unroll
            for (int m = 0; m < 4; ++m) { bf16* rowp = YDp + (size_t)(row0 + ai * 128 + m * 16) * 1024 + col0;
#pragma unroll
                for (int bj = 0; bj < 2; ++bj) { const f32x4 v0 = acc[ai][bj][m][0] * gv[bj][0], v1 = acc[ai][bj][m][1] * gv[bj][1];
                    u32x4 w; w.x = cvt_pk_bf16(v0[0], v0[1]); w.y = cvt_pk_bf16(v0[2], v0[3]); w.z = cvt_pk_bf16(v1[0], v1[1]); w.w = cvt_pk_bf16(v1[2], v1[3]);
                    *(u32x4*)(rowp + bj * 128) = w; } }
    }
};
struct EpiMoe1 {
    static constexpr bool PERM = true;
    unsigned char* ACTp;
    __device__ __forceinline__ void post(AccT& acc, const Unit&, int, int, int, int) const {
#pragma unroll
        for (int a = 0; a < 2; ++a)
#pragma unroll
            for (int b = 0; b < 2; ++b)
#pragma unroll
                for (int m = 0; m < 4; ++m)
#pragma unroll
                    for (int n = 0; n < 2; ++n) acc[a][b][m][n] = (f32x4){0.f, 0.f, 0.f, 0.f};
    }
    __device__ __forceinline__ void operator()(const AccT& acc, const Unit& u, int wr, int wc, int fr, int fq) const {
        const int row0 = u.aux * 1024 + u.pm * 256 + wr * 64 + fr, col0 = u.pn * 128 + wc * 32 + 8 * fq;
#pragma unroll
        for (int ai = 0; ai < 2; ++ai)
#pragma unroll
            for (int m = 0; m < 4; ++m) { unsigned char* rowp = ACTp + (size_t)(row0 + ai * 128 + m * 16) * 1024 + col0;
                f32x4 a0, a1;
#pragma unroll
                for (int j = 0; j < 4; ++j) { a0[j] = silu_f(0.0625f * acc[ai][0][m][0][j]) * (0.0625f * acc[ai][1][m][0][j]); a1[j] = silu_f(0.0625f * acc[ai][0][m][1][j]) * (0.0625f * acc[ai][1][m][1][j]); }
                *(u32x2*)rowp = (u32x2){pk4_fp8(a0[0], a0[1], a0[2], a0[3]), pk4_fp8(a1[0], a1[1], a1[2], a1[3])}; }
    }
};
struct EpiMoe2 {
    static constexpr bool PERM = true;
    bf16* YBp; const float* WSELp; const float* MODp;
    __device__ __forceinline__ void post(AccT& acc, const Unit&, int, int, int, int) const {
#pragma unroll
        for (int a = 0; a < 2; ++a)
#pragma unroll
            for (int b = 0; b < 2; ++b)
#pragma unroll
                for (int m = 0; m < 4; ++m)
#pragma unroll
                    for (int n = 0; n < 2; ++n) acc[a][b][m][n] = (f32x4){0.f, 0.f, 0.f, 0.f};
    }
    __device__ __forceinline__ void operator()(const AccT& acc, const Unit& u, int wr, int wc, int fr, int fq) const {
        const int row0 = u.aux * 1024 + u.pm * 256 + wr * 64 + fr, col0 = u.pn * 256 + wc * 32 + 8 * fq;
        const float* gt = MODp + (size_t)(u.aux >> 4) * 6144 + 5120 + col0;
        f32x4 gv[2][2];
#pragma unroll
        for (int bj = 0; bj < 2; ++bj)
#pragma unroll
            for (int n = 0; n < 2; ++n) gv[bj][n] = *(const f32x4*)(gt + bj * 128 + n * 4);
#pragma unroll
        for (int ai = 0; ai < 2; ++ai)
#pragma unroll
            for (int m = 0; m < 4; ++m) { const int r = row0 + ai * 128 + m * 16; const float ws = 0.0625f * WSELp[r]; bf16* rowp = YBp + (size_t)r * 1024 + col0;
#pragma unroll
                for (int bj = 0; bj < 2; ++bj) { const f32x4 v0 = acc[ai][bj][m][0] * gv[bj][0] * ws, v1 = acc[ai][bj][m][1] * gv[bj][1] * ws;
                    u32x4 w; w.x = cvt_pk_bf16(v0[0], v0[1]); w.y = cvt_pk_bf16(v0[2], v0[3]); w.z = cvt_pk_bf16(v1[0], v1[1]); w.w = cvt_pk_bf16(v1[2], v1[3]);
                    *(u32x4*)(rowp + bj * 128) = w; } }
    }
};

struct Args { const float* in[22]; float* out; unsigned char* ws; int ph_lo, ph_hi; int rep[8]; };
enum { I_X = 0, I_C, I_CTX, I_CCTX, I_ADAW, I_ADAB, I_N1G, I_N2G, I_WIN, I_WDU, I_BDEC, I_GNG, I_WGLA, I_POOLW, I_POOLS, I_WPOOL, I_WOUT, I_WROUTER, I_WGATE, I_WUP, I_WDOWN, I_FNG };

__device__ __forceinline__ bf16x8 ldfrag(const LAS bf16* base, int stride, int row0, int k0, int lane) { return *(const LAS bf16x8*)(base + (row0 + (lane & 15)) * stride + k0 + 8 * (lane >> 4)); }
#define MFMA16(a, b, c) __builtin_amdgcn_mfma_f32_16x16x32_bf16(a, b, c, 0, 0, 0)

__device__ __forceinline__ void transpose_item(const float* W, int ldw, int k0, int nsrc0, bf16* WT, int Kd, int dst_row0, LAS float* scr, int lane) {
#pragma unroll 8
    for (int i = 0; i < 32; ++i) { const int kk = 2 * i + (lane >> 5); scr[kk * 33 + (lane & 31)] = W[(size_t)(k0 + kk) * ldw + nsrc0 + (lane & 31)]; }
    LDS_WAIT(); asm volatile("" ::: "memory");
    const int c = lane & 7;
#pragma unroll
    for (int j = 0; j < 4; ++j) { const int n = (lane >> 3) + 8 * j; const LAS float* s = scr + (8 * c) * 33 + n;
        u32x4 o; o.x = pk2(s[0 * 33], s[1 * 33]); o.y = pk2(s[2 * 33], s[3 * 33]); o.z = pk2(s[4 * 33], s[5 * 33]); o.w = pk2(s[6 * 33], s[7 * 33]);
        *(u32x4*)(WT + (size_t)(dst_row0 + n) * Kd + k0 + 8 * c) = o; }
    LDS_WAIT(); asm volatile("" ::: "memory");
}

struct CvtItem { const float* src; bf16* dst; int ld2, drow8, f8; };
#define CVT_LOAD(v, c) do { _Pragma("unroll") for (int _j = 0; _j < 32; ++_j) v[_j] = __builtin_nontemporal_load((c).src + (size_t)_j * (c).ld2); } while (0)
#define CVT_STORE(v, c) do { _Pragma("unroll") for (int _j = 0; _j < 32; ++_j) scr[(2 * _j + (lane >> 5)) * 33 + (lane & 31)] = v[_j]; \
        LDS_WAIT(); asm volatile("" ::: "memory"); \
        _Pragma("unroll") for (int _q = 0; _q < 4; ++_q) { const LAS float* _s = scr + (8 * (lane & 7)) * 33 + (lane >> 3) + 8 * _q; u32x4 _o; \
            _o.x = pk2(_s[0 * 33], _s[1 * 33]); _o.y = pk2(_s[2 * 33], _s[3 * 33]); _o.z = pk2(_s[4 * 33], _s[5 * 33]); _o.w = pk2(_s[6 * 33], _s[7 * 33]); *(u32x4*)((c).dst + (size_t)_q * (c).drow8) = _o; } \
        LDS_WAIT(); asm volatile("" ::: "memory"); } while (0)
__device__ __forceinline__ CvtItem cvt_item_gu(const Args& a, int it, int lane) {
    const int e = it >> 10, mat = (it >> 9) & 1, q = it & 511, kb = q >> 5, nb = q & 31, n0 = nb * 32, k0 = kb * 64, nrow = n0 + (lane >> 3);
    CvtItem c; c.ld2 = 2048; c.drow8 = 8192; c.f8 = 1;
    c.src = a.in[mat ? I_WUP : I_WGATE] + (size_t)e * 1048576 + (size_t)(k0 + (lane >> 5)) * 1024 + n0 + (lane & 31);
    c.dst = (bf16*)(a.ws + WS_WGU + ((size_t)e * 2048 + (nrow >> 7) * 256 + mat * 128 + (nrow & 127)) * 1024 + k0 + 8 * (lane & 7));
    return c;
}
__device__ __forceinline__ CvtItem cvt_item_dn(const Args& a, int it, int lane) {
    const int e = it >> 9, q = it & 511, kb = q >> 5, nb = q & 31, n0 = nb * 32, k0 = kb * 64;
    CvtItem c; c.ld2 = 2048; c.drow8 = 8192; c.f8 = 1;
    c.src = a.in[I_WDOWN] + (size_t)e * 1048576 + (size_t)(k0 + (lane >> 5)) * 1024 + n0 + (lane & 31);
    c.dst = (bf16*)(a.ws + WS_WD + ((size_t)e * 1024 + n0 + (lane >> 3)) * 1024 + k0 + 8 * (lane & 7));
    return c;
}
#define CVT_STORE8(v, c) do { _Pragma("unroll") for (int _j = 0; _j < 32; ++_j) scr[(2 * _j + (lane >> 5)) * 33 + (lane & 31)] = v[_j]; \
        LDS_WAIT(); asm volatile("" ::: "memory"); \
        _Pragma("unroll") for (int _q = 0; _q < 4; ++_q) { const LAS float* _s = scr + (8 * (lane & 7)) * 33 + (lane >> 3) + 8 * _q; \
            *(u32x2*)((unsigned char*)(c).dst + (size_t)_q * (c).drow8) = (u32x2){pk4_fp8(16.f * _s[0 * 33], 16.f * _s[1 * 33], 16.f * _s[2 * 33], 16.f * _s[3 * 33]), pk4_fp8(16.f * _s[4 * 33], 16.f * _s[5 * 33], 16.f * _s[6 * 33], 16.f * _s[7 * 33])}; } \
        LDS_WAIT(); asm volatile("" ::: "memory"); } while (0)
__device__ __forceinline__ CvtItem cvt_item_small(const Args& a, int it, int lane) {
    CvtItem c; int r = it;
    c.f8 = 0;
    if (r < 2048) { const int kb = r >> 7, nb = r & 127, n0 = nb * 32, k0 = kb * 64; c.ld2 = 2 * DIN; c.drow8 = 8192;
        c.src = a.in[I_WIN] + (size_t)(k0 + (lane >> 5)) * DIN + n0 + (n0 >= 768 ? 32 : 0) + (lane & 31);
        if (n0 < 2048) c.dst = (bf16*)(a.ws + WS_WIN) + (size_t)(n0 + (lane >> 3)) * 1024 + k0 + 8 * (lane & 7);
        else { c.f8 = 1; c.dst = (bf16*)(a.ws + WS_WINM + (size_t)(n0 - 2048 + (lane >> 3)) * 1024 + k0 + 8 * (lane & 7)); }
        return c; }
    r -= 2048;
    if (r < 512) { const int kb = r >> 5, nb = r & 31, n0 = nb * 32, k0 = kb * 64; c.ld2 = 2048; c.drow8 = 8192;
        c.src = a.in[I_WOUT] + (size_t)(k0 + (lane >> 5)) * 1024 + n0 + (lane & 31); c.dst = (bf16*)(a.ws + WS_WO) + (size_t)(n0 + (lane >> 3)) * 1024 + k0 + 8 * (lane & 7); return c; }
    r -= 512;
    { const int kb = r >> 5, nb = r & 31, n0 = nb * 32, k0 = kb * 64; c.ld2 = 2048; c.drow8 = 4096;
      c.src = a.in[I_WGLA] + (size_t)(k0 + (lane >> 5)) * 1024 + n0 + (lane & 31); c.dst = (bf16*)(a.ws + WS_WG) + (size_t)(n0 + (lane >> 3)) * 512 + k0 + 8 * (lane & 7); return c; }
}
template <int KIND> __device__ __forceinline__ CvtItem cvt_item(const Args& a, int it, int lane) { if constexpr (KIND == 0) return cvt_item_small(a, it, lane); else if constexpr (KIND == 1) return cvt_item_gu(a, it, lane); else return cvt_item_dn(a, it, lane); }
template <int KIND>
__device__ __forceinline__ void convert_items(LAS float* scr, const Args& a, int first, int step, int end, int lane) {
    float va[32], vb[32]; CvtItem ca, cb;
    int it = first;
    if (it < end) { ca = cvt_item<KIND>(a, it, lane); CVT_LOAD(va, ca); }
    for (; it < end; it += 2 * step) {
        const bool hb = (it + step < end), ha = (it + 2 * step < end);
        if (hb) { cb = cvt_item<KIND>(a, it + step, lane); CVT_LOAD(vb, cb); }
        if (KIND == 0 && !ca.f8) CVT_STORE(va, ca); else CVT_STORE8(va, ca);
        if (ha) { ca = cvt_item<KIND>(a, it + 2 * step, lane); CVT_LOAD(va, ca); }
        if (hb) { if (KIND == 0 && !cb.f8) CVT_STORE(vb, cb); else CVT_STORE8(vb, cb); }
    }
}
template <int KIND>
__device__ __forceinline__ void convert_all(LAS unsigned char* lds, const Args& a, int vcu, int G, int lane, int wave) {
    const int gw = vcu * NWAVES + wave, NGW = G * NWAVES;
    convert_items<KIND>((LAS float*)(lds + wave * 8448), a, gw, NGW, KIND == 1 ? 16384 : 8192, lane);
    __syncthreads();
}

__device__ __forceinline__ void phase0(LAS unsigned char* lds, const Args& a, int vcu, int G, int tid, int lane, int wave) {
    unsigned char* ws = a.ws;
    if (vcu < 96) {
        LAS float* sv = (LAS float*)(lds + 69632); LAS float* part = sv + 3072;
        for (int idx = tid; idx < 3072; idx += NT) { const int v = idx >> 10, k = idx & 1023; const float s = (v < 2) ? a.in[I_C][v * 1024 + k] : a.in[I_CCTX][k]; sv[idx] = s / (1.f + expf(-s)); }
        __syncthreads();
        const int n0 = 64 * vcu, colq = lane & 15, kr = lane >> 4;
        f32x4 a0 = {0.f, 0.f, 0.f, 0.f}, a1 = a0, a2 = a0;
        const float* aw = a.in[I_ADAW] + (size_t)(128 * wave + kr) * 6144 + n0 + 4 * colq;
#pragma unroll
        for (int hb = 0; hb < 2; ++hb) { f32x4 w4[16];
#pragma unroll
            for (int it = 0; it < 16; ++it) w4[it] = __builtin_nontemporal_load((const f32x4*)(aw + (size_t)(4 * (16 * hb + it)) * 6144));
#pragma unroll
            for (int it = 0; it < 16; ++it) { const int k = 128 * wave + 4 * (16 * hb + it) + kr; a0 += w4[it] * sv[k]; a1 += w4[it] * sv[1024 + k]; a2 += w4[it] * sv[2048 + k]; } }
#pragma unroll
        for (int j = 0; j < 4; ++j) { a0[j] += __shfl_xor(a0[j], 16); a0[j] += __shfl_xor(a0[j], 32); a1[j] += __shfl_xor(a1[j], 16); a1[j] += __shfl_xor(a1[j], 32); a2[j] += __shfl_xor(a2[j], 16); a2[j] += __shfl_xor(a2[j], 32); }
        if (kr == 0) {
#pragma unroll
            for (int j = 0; j < 4; ++j) { part[(wave * 3 + 0) * 64 + 4 * colq + j] = a0[j]; part[(wave * 3 + 1) * 64 + 4 * colq + j] = a1[j]; part[(wave * 3 + 2) * 64 + 4 * colq + j] = a2[j]; } }
        __syncthreads();
        if (tid < 192) { const int v = tid >> 6, col = tid & 63; float s = a.in[I_ADAB][n0 + col];
#pragma unroll
            for (int w = 0; w < 8; ++w) s += part[(w * 3 + v) * 64 + col];
            ((float*)(ws + WS_MOD))[v * 6144 + n0 + col] = s; }
    } else if (vcu < 96 + 128) {
        const int it = vcu - 96, g = it >> 5, cb = (it >> 1) & 15, nb = it & 1, n = nb * 512 + tid;
        LAS float* pwt = (LAS float*)(lds + 69632);
        if (tid < 256) { const int d = tid >> 1, hf = tid & 1; const float sc = a.in[I_POOLS][g * 128 + d]; f32x4 v;
#pragma unroll
            for (int q = 0; q < 4; ++q) v[q] = a.in[I_POOLW][(size_t)(g * 128 + cb * 8 + hf * 4 + q) * 128 + d] * sc;
            *(LAS f32x4*)(pwt + d * 8 + hf * 4) = v; }
        __syncthreads();
        const float* wp = a.in[I_WPOOL] + (size_t)(g * 128) * 1024 + n;
        f32x4 acc0 = {0.f, 0.f, 0.f, 0.f}, acc1 = acc0;
        for (int d0 = 0; d0 < 128; d0 += 32) { float w[32];
#pragma unroll
            for (int d = 0; d < 32; ++d) w[d] = wp[(size_t)(d0 + d) * 1024];
#pragma unroll
            for (int d = 0; d < 32; ++d) { const f32x4 p0 = *(const LAS f32x4*)(pwt + (d0 + d) * 8), p1 = *(const LAS f32x4*)(pwt + (d0 + d) * 8 + 4); acc0 += p0 * w[d]; acc1 += p1 * w[d]; } }
        bf16* dst = (bf16*)(ws + WS_WC) + (size_t)n * 512 + g * 128 + cb * 8;
        *(u32x4*)dst = (u32x4){pk2(acc0[0], acc0[1]), pk2(acc0[2], acc0[3]), pk2(acc1[0], acc1[1]), pk2(acc1[2], acc1[3])};
    }
    { const int gw = vcu * NWAVES + wave, NGW = G * NWAVES; convert_items<0>((LAS float*)(lds + wave * 8448), a, gw, NGW, 2048 + 512 + 256, lane); }
}

#define RSTEP(N, S) do { _Pragma("unroll") for (int _i = 0; _i < (N) / 2; ++_i) { const float _send = (lane & (S)) ? racc[_i] : racc[_i + (N) / 2]; const float _keep = (lane & (S)) ? racc[_i + (N) / 2] : racc[_i]; racc[_i] = _keep + __shfl_xor(_send, (S)); } } while (0)
__device__ __forceinline__ void phase1(LAS unsigned char* lds, const Args& a, int vcu, int G, int tid, int lane, int wave) {
    unsigned char* ws = a.ws;
    const float* MOD = (const float*)(ws + WS_MOD);
    const float* g1 = a.in[I_N1G];
    for (int u = vcu; u < 96; u += G) {
        const int mt = u / 12, ntile = u % 12, r0 = mt * 64;
        LAS bf16* As = (LAS bf16*)lds; LAS bf16* Bs = As + 64 * 72; LAS float* rs = (LAS float*)(lds + 18432);
        const float* ctx = a.in[I_CTX];
        { f32x4 rv[8][4];
#pragma unroll
          for (int rr = 0; rr < 8; ++rr)
#pragma unroll
              for (int j = 0; j < 4; ++j) rv[rr][j] = *(const f32x4*)(ctx + (size_t)(r0 + 8 * wave + rr) * 1024 + 256 * j + 4 * lane);
#pragma unroll
          for (int rr = 0; rr < 8; ++rr) { float ss = 0.f;
#pragma unroll
              for (int j = 0; j < 4; ++j) ss += rv[rr][j][0] * rv[rr][j][0] + rv[rr][j][1] * rv[rr][j][1] + rv[rr][j][2] * rv[rr][j][2] + rv[rr][j][3] * rv[rr][j][3];
              ss = wave_sum(ss); if (lane == 0) rs[8 * wave + rr] = rsqrtf(ss * (1.f / 1024.f) + EPS); } }
        __syncthreads();
        f32x4 acc[2] = {{0.f, 0.f, 0.f, 0.f}, {0.f, 0.f, 0.f, 0.f}};
        const int m16 = wave & 3, nh = wave >> 2, srow = tid >> 3, kq = (tid & 7) * 8;
        const float rstd = rs[srow];
        const float* xp = ctx + (size_t)(r0 + srow) * 1024 + kq; const bf16* wpB = (const bf16*)(ws + WS_WIN) + (size_t)(ntile * 64 + srow) * 1024 + kq;
        f32x4 xv[2], gq[2], scq[2], shq[2]; u32x4 wB;
#define CTX_LOAD(kc) do { const int _k0 = (kc) * 64; _Pragma("unroll") for (int q = 0; q < 2; ++q) { xv[q] = *(const f32x4*)(xp + _k0 + 4 * q); gq[q] = *(const f32x4*)(g1 + _k0 + kq + 4 * q); \
            scq[q] = *(const f32x4*)(MOD + 2 * 6144 + 1024 + _k0 + kq + 4 * q); shq[q] = *(const f32x4*)(MOD + 2 * 6144 + _k0 + kq + 4 * q); } wB = *(const u32x4*)(wpB + _k0); } while (0)
        CTX_LOAD(0);
        for (int kc = 0; kc < 16; ++kc) {
            { unsigned o[4];
#pragma unroll
              for (int q = 0; q < 2; ++q) { const f32x4 h = xv[q] * rstd * gq[q] * (scq[q] + 1.f) + shq[q]; o[2 * q] = pk2(h[0], h[1]); o[2 * q + 1] = pk2(h[2], h[3]); }
              *(LAS u32x4*)(As + srow * 72 + kq) = (u32x4){o[0], o[1], o[2], o[3]};
              *(LAS u32x4*)(Bs + srow * 72 + kq) = wB; }
            __syncthreads();
            if (kc + 1 < 16) CTX_LOAD(kc + 1);
#pragma unroll
            for (int ks = 0; ks < 2; ++ks) { const bf16x8 af = ldfrag(As, 72, m16 * 16, ks * 32, lane);
#pragma unroll
                for (int tt = 0; tt < 2; ++tt) { const bf16x8 bfr = ldfrag(Bs, 72, nh * 32 + tt * 16, ks * 32, lane); acc[tt] = MFMA16(af, bfr, acc[tt]); } }
            __syncthreads();
        }
#undef CTX_LOAD
#pragma unroll
        for (int tt = 0; tt < 2; ++tt)
#pragma unroll
            for (int r = 0; r < 4; ++r) { const int row = M + r0 + m16 * 16 + 4 * (lane >> 4) + r, n = ntile * 64 + nh * 32 + tt * 16 + (lane & 15); const bf16 v = (bf16)f2bf(acc[tt][r]);
                if (n < 256) ((bf16*)(ws + WS_KB))[(size_t)row * 256 + n] = v; else ((bf16*)(ws + WS_VB))[(size_t)row * 512 + n - 256] = v; }
        __syncthreads();
    }
    LAS float* WR = (LAS float*)lds;
#pragma unroll 4
    for (int it = 0; it < 16; ++it) { const int k = (tid >> 3) + 64 * it, c4 = tid & 7; const f32x4 v = *(const f32x4*)(a.in[I_WIN] + (size_t)k * DIN + 768 + 4 * c4);
        const int row = ((k >> 8) * 4 + (k & 3)) * 64 + ((k & 255) >> 2); *(LAS f32x4*)(WR + row * 36 + 4 * c4) = v; }
    __syncthreads();
    f32x4 gv[4];
#pragma unroll
    for (int j = 0; j < 4; ++j) gv[j] = *(const f32x4*)(g1 + 256 * j + 4 * lane);
    constexpr int NPAIR = MT / 2;
    const int nctx = (G > 96) ? 96 : 0, PA = 3;
    int p_lo, p_n, p_stride;
    if (vcu < nctx) { p_lo = (vcu * NWAVES + wave) * PA; p_n = PA; p_stride = 1; }
    else { p_lo = nctx * NWAVES * PA + (vcu - nctx) * NWAVES + wave; p_n = 1 << 30; p_stride = (G - nctx) * NWAVES; }
    f32x4 nx[2][4];
    if (p_n > 0 && p_lo < NPAIR) {
#pragma unroll
        for (int r = 0; r < 2; ++r) { const int m = 2 * p_lo + r; const float* src = (m < M) ? a.in[I_X] + (size_t)m * 1024 : a.in[I_CTX] + (size_t)(m - M) * 1024;
#pragma unroll
            for (int j = 0; j < 4; ++j) nx[r][j] = *(const f32x4*)(src + 256 * j + 4 * lane); } }
    for (int pi = 0, pr = p_lo; pi < p_n && pr < NPAIR; ++pi, pr += p_stride) {
        const int m0 = 2 * pr;
        f32x4 v[2][4]; float rstd[2];
#pragma unroll
        for (int r = 0; r < 2; ++r) { float ss = 0.f;
#pragma unroll
            for (int j = 0; j < 4; ++j) { v[r][j] = nx[r][j]; ss += v[r][j][0] * v[r][j][0] + v[r][j][1] * v[r][j][1] + v[r][j][2] * v[r][j][2] + v[r][j][3] * v[r][j][3]; }
            rstd[r] = ss; }
        if (pi + 1 < p_n && pr + p_stride < NPAIR) {
#pragma unroll
            for (int r = 0; r < 2; ++r) { const int m = 2 * (pr + p_stride) + r; const float* src = (m < M) ? a.in[I_X] + (size_t)m * 1024 : a.in[I_CTX] + (size_t)(m - M) * 1024;
#pragma unroll
                for (int j = 0; j < 4; ++j) nx[r][j] = *(const f32x4*)(src + 256 * j + 4 * lane); } }
#pragma unroll
        for (int r = 0; r < 2; ++r) { const int m = m0 + r; rstd[r] = rsqrtf(wave_sum(rstd[r]) * (1.f / 1024.f) + EPS); const float* mod = MOD + (size_t)((m < M) ? (m >> 13) : 2) * 6144;
#pragma unroll
            for (int j = 0; j < 4; ++j) { const f32x4 sc = *(const f32x4*)(mod + 1024 + 256 * j + 4 * lane), sh = *(const f32x4*)(mod + 256 * j + 4 * lane); v[r][j] = v[r][j] * rstd[r] * gv[j] * (sc + 1.f) + sh; }
            if (m < M) { bf16* hp = (bf16*)(ws + WS_H1) + (size_t)m * 1024;
#pragma unroll
                for (int j = 0; j < 4; ++j) { *(u32x2*)(hp + 256 * j + 4 * lane) = (u32x2){pk2(v[r][j][0], v[r][j][1]), pk2(v[r][j][2], v[r][j][3])};
                    *(unsigned*)(ws + WS_H1F + (size_t)m * 1024 + 256 * j + 4 * lane) = pk4_fp8(v[r][j][0], v[r][j][1], v[r][j][2], v[r][j][3]); } } }
        f32x2 r2[32];
#pragma unroll
        for (int i = 0; i < 32; ++i) r2[i] = (f32x2){0.f, 0.f};
#pragma unroll
        for (int j = 0; j < 4; ++j)
#pragma unroll
            for (int i = 0; i < 4; ++i) { const f32x2 hab = {v[0][j][i], v[1][j][i]}; const LAS float* rp = WR + ((j * 4 + i) * 64 + lane) * 36;
#pragma unroll
                for (int c4 = 0; c4 < 8; ++c4) { const f32x4 w = *(const LAS f32x4*)(rp + 4 * c4);
                    r2[4 * c4 + 0] += hab * w[0]; r2[4 * c4 + 1] += hab * w[1]; r2[4 * c4 + 2] += hab * w[2]; r2[4 * c4 + 3] += hab * w[3]; }
                if (i & 1) asm volatile("" ::: "memory"); }
        float ra[32], rb[32];
#pragma unroll
        for (int i = 0; i < 32; ++i) { ra[i] = r2[i][0]; rb[i] = r2[i][1]; }
        { float* racc = ra; RSTEP(32, 32); RSTEP(16, 16); RSTEP(8, 8); RSTEP(4, 4); RSTEP(2, 2); racc[0] += __shfl_xor(racc[0], 1); }
        { float* racc = rb; RSTEP(32, 32); RSTEP(16, 16); RSTEP(8, 8); RSTEP(4, 4); RSTEP(2, 2); racc[0] += __shfl_xor(racc[0], 1); }
        if ((lane & 1) == 0) { ((float*)(ws + WS_RB))[(size_t)m0 * 32 + (lane >> 1)] = ra[0]; ((float*)(ws + WS_RB))[(size_t)(m0 + 1) * 32 + (lane >> 1)] = rb[0]; }
    }
}

typedef short s16x4 __attribute__((ext_vector_type(4)));
__device__ __forceinline__ s16x4 lds_tr16(const LAS bf16* p) { return __builtin_bit_cast(s16x4, __builtin_amdgcn_ds_read_tr16_b64_v4i16((LAS s16x4*)p)); }
__device__ __forceinline__ bf16x8 ldfrag_tr(const LAS bf16* base, int stride, int k0, int n0, int lane) {
    const int g = lane >> 4, i = lane & 15; const LAS bf16* p = base + (k0 + 8 * g + (i >> 2)) * stride + n0 + 4 * (i & 3);
    const s16x4 lo = lds_tr16(p), hi = lds_tr16(p + 4 * stride);
    return (bf16x8){lo[0], lo[1], lo[2], lo[3], hi[0], hi[1], hi[2], hi[3]};
}
__device__ __forceinline__ float logsig_fast(float z) { return fminf(z, 0.f) - __logf(1.f + __expf(-fabsf(z))); }
struct ChkPre { f32x4 r, w; float bias_f, bias_b; float kf[8]; u32x4 v[2]; };
__device__ __forceinline__ void chunk_decode(int u, int& b, int& h, int& row0, int& slot, bool& isx) {
    if (u < 1024) { b = u >> 9; h = (u >> 7) & 3; const int n = u & 127; row0 = b * SEQ + n * 64; slot = n; isx = true; }
    else { const int v = u - 1024; b = v >> 4; h = (v >> 2) & 3; const int n = v & 3; row0 = M + b * LC + n * 64; slot = NCH + n; isx = false; }
}
__device__ __forceinline__ void chunk_load(ChkPre& P, const Args& a, int u, int tid) {
    unsigned char* ws = a.ws; int b, h, row0, slot; bool isx; chunk_decode(u, b, h, row0, slot, isx);
    P.r = *(const f32x4*)((const float*)(ws + WS_RB) + (size_t)(row0 + (tid >> 3)) * 32 + (tid & 7) * 4);
    P.w = *(const f32x4*)(a.in[I_WDU] + (size_t)(tid >> 4) * 256 + h * 64 + (tid & 15) * 4);
    const int dk = tid & 63, tq = tid >> 6;
    P.bias_f = a.in[I_BDEC][h * 64 + dk]; P.bias_b = a.in[I_BDEC][256 + h * 64 + dk];
    const bf16* KBp = (const bf16*)(ws + WS_KB) + (size_t)(row0 + tq * 8) * 256 + h * 64 + dk;
#pragma unroll
    for (int tt = 0; tt < 8; ++tt) P.kf[tt] = bf2f(KBp[(size_t)tt * 256]);
#pragma unroll
    for (int i = 0; i < 2; ++i) { const int p = tid + NT * i, jj = p >> 4, ch = p & 15; P.v[i] = *(const u32x4*)((const bf16*)(ws + WS_VB) + (size_t)(row0 + jj) * 512 + h * 128 + 8 * ch); }
}
__device__ __forceinline__ void chunk_units(LAS unsigned char* lds, const Args& a, int vcu, int G, int tid, int lane, int wave) {
    unsigned char* ws = a.ws;
    LAS float* r_s = (LAS float*)lds;
    LAS float* wup = (LAS float*)(lds + 8192);
    LAS float* seg = (LAS float*)(lds + 16384);
    LAS bf16* Ks = (LAS bf16*)(lds + 20480);
    LAS bf16* Vs = (LAS bf16*)(lds + 38912);
    const int dk = tid & 63, tq = tid >> 6;
    ChkPre P;
    unsigned* qctr = (unsigned*)(ws + WS_CTL) + 512; LAS int* qnext = (LAS int*)(lds + 57344);
    int u = vcu;
    if (u < 1024 + 32) chunk_load(P, a, u, tid);
    for (; u < 1024 + 32; ) {
        int b, h, row0, slot; bool isx; chunk_decode(u, b, h, row0, slot, isx);
        const int bh = b * 4 + h;
        if (tid == 0) qnext[0] = G + (int)__hip_atomic_fetch_add(qctr, 1u, __ATOMIC_RELAXED, __HIP_MEMORY_SCOPE_AGENT);
        *(LAS f32x4*)(r_s + tid * 4) = P.r; *(LAS f32x4*)(wup + (tid >> 4) * 64 + (tid & 15) * 4) = P.w;
#pragma unroll
        for (int i = 0; i < 2; ++i) { const int p = tid + NT * i, jj = p >> 4, ch = p & 15; *(LAS u32x4*)(Vs + jj * 136 + 8 * ch) = P.v[i]; }
        float kf[8];
#pragma unroll
        for (int tt = 0; tt < 8; ++tt) kf[tt] = P.kf[tt];
        const float bias_f = P.bias_f, bias_b = P.bias_b;
        __syncthreads();
        const int un = qnext[0];
        if (un < 1024 + 32) chunk_load(P, a, un, tid);
        float pf[8], sb[8];
        { float wf[16], wb[16];
#pragma unroll
          for (int j = 0; j < 16; ++j) { wf[j] = wup[j * 64 + dk]; wb[j] = wup[(16 + j) * 64 + dk]; }
#pragma unroll
          for (int tt = 0; tt < 8; ++tt) { const LAS float* rp = r_s + (tq * 8 + tt) * 32; float zf = bias_f, zb = bias_b;
#pragma unroll
              for (int j4 = 0; j4 < 4; ++j4) { const f32x4 rf = *(const LAS f32x4*)(rp + 4 * j4), rb = *(const LAS f32x4*)(rp + 16 + 4 * j4);
#pragma unroll
                  for (int e = 0; e < 4; ++e) { zf += rf[e] * wf[4 * j4 + e]; zb += rb[e] * wb[4 * j4 + e]; } }
              pf[tt] = logsig_fast(zf) * (1.f / 16.f); sb[tt] = logsig_fast(zb) * (1.f / 16.f); }
#pragma unroll
          for (int tt = 1; tt < 8; ++tt) pf[tt] += pf[tt - 1];
#pragma unroll
          for (int tt = 6; tt >= 0; --tt) sb[tt] += sb[tt + 1];
          seg[tq * 64 + dk] = pf[7]; seg[(8 + tq) * 64 + dk] = sb[0]; }
        __syncthreads();
        { float offf = 0.f, totf = 0.f, offb = 0.f, totb = 0.f;
#pragma unroll
          for (int q = 0; q < 8; ++q) { const float sf = seg[q * 64 + dk], sbv = seg[(8 + q) * 64 + dk]; totf += sf; totb += sbv; if (q < tq) offf += sf; if (q > tq) offb += sbv; }
#pragma unroll
          for (int tt = 0; tt < 8; ++tt) { const int t = tq * 8 + tt; const float bb = pf[tt] + offf, cc = sb[tt] + offb;
              if (isx) { const size_t gi = (size_t)(row0 + t) * 256 + h * 64 + dk; a.out[gi] = bb; a.out[(size_t)M * 256 + gi] = cc; }
              Ks[t * 72 + dk] = (bf16)f2bf(kf[tt] * __expf(totf - bb)); Ks[(64 + t) * 72 + dk] = (bf16)f2bf(kf[tt] * __expf(totb - cc)); }
          if (tq == 0) { float* DEC = (float*)(ws + WS_DEC); DEC[((size_t)(0 * 8 + bh) * NSLOT + slot) * 64 + dk] = __expf(totf); DEC[((size_t)(1 * 8 + bh) * NSLOT + slot) * 64 + dk] = __expf(totb); } }
        __syncthreads();
        { const int dir = wave >> 2, dkt = wave & 3; const LAS bf16* Kd = Ks + dir * 64 * 72;
          const bf16x8 k0f = ldfrag_tr(Kd, 72, 0, dkt * 16, lane), k1f = ldfrag_tr(Kd, 72, 32, dkt * 16, lane);
          bf16* KV = (bf16*)(ws + WS_KV) + ((size_t)(dir * 8 + bh) * NSLOT + slot) * 8192;
#pragma unroll
          for (int dvt = 0; dvt < 8; ++dvt) { f32x4 c = {0.f, 0.f, 0.f, 0.f}; c = MFMA16(k0f, ldfrag_tr(Vs, 136, 0, dvt * 16, lane), c); c = MFMA16(k1f, ldfrag_tr(Vs, 136, 32, dvt * 16, lane), c);
              *(u32x2*)(KV + (size_t)(dvt * 16 + (lane & 15)) * 64 + dkt * 16 + 4 * (lane >> 4)) = (u32x2){pk2(c[0], c[1]), pk2(c[2], c[3])}; } }
        __syncthreads();
        u = un;
    }
}
constexpr int PB = 4, NPOOLW = NB * 4 * 8 * (128 / PB);
__device__ __forceinline__ void ld16bf(const bf16* p, float (&f)[16]) { const u32x4 w0 = *(const u32x4*)p, w1 = *(const u32x4*)(p + 8);
#pragma unroll
    for (int q = 0; q < 4; ++q) { f[2 * q] = bflo(w0[q]); f[2 * q + 1] = bfhi(w0[q]); f[8 + 2 * q] = bflo(w1[q]); f[8 + 2 * q + 1] = bfhi(w1[q]); } }
template <int CTRL, int ROWMASK> __device__ __forceinline__ float dpp_f(float v) { return __builtin_bit_cast(float, __builtin_amdgcn_update_dpp(0, __builtin_bit_cast(int, v), CTRL, ROWMASK, 0xf, true)); }
__device__ __forceinline__ float wave_prefix(float v) {
    v += dpp_f<0x111, 0xf>(v); v += dpp_f<0x112, 0xf>(v); v += dpp_f<0x114, 0xf>(v); v += dpp_f<0x118, 0xf>(v);
    v += dpp_f<0x142, 0xa>(v);
    v += dpp_f<0x143, 0xc>(v);
    return v;
}
template <int HALF>
__device__ __forceinline__ void pool_band(const bf16* PI, bf16* PO, int r0, int c) {
    float run[16];
#pragma unroll
    for (int e = 0; e < 16; ++e) run[e] = 0.f;
    { constexpr int NW = 2 * HALF, BT = NW < 8 ? NW : 8;
#pragma unroll
      for (int i0 = 0; i0 < NW; i0 += BT) { float f[BT][16];
#pragma unroll
          for (int i = 0; i < BT; ++i) { int rr = r0 - HALF + i0 + i; rr = rr < 0 ? 0 : (rr > 127 ? 127 : rr); ld16bf(PI + (size_t)rr * 64 * 512, f[i]); }
#pragma unroll
          for (int i = 0; i < BT; ++i) { const int rr = r0 - HALF + i0 + i; const bool ok = rr >= 0 && rr < 128;
#pragma unroll
              for (int e = 0; e < 16; ++e) run[e] += ok ? f[i][e] : 0.f; }
          asm volatile("" ::: "memory"); } }
    const int lo_c = (c - HALF) < 0 ? 0 : (c - HALF), hi_c = (c + HALF) > 64 ? 64 : (c + HALF);
    float cen[16], fi[16], fo[16];
    ld16bf(PI + (size_t)r0 * 64 * 512, cen);
#pragma unroll
    for (int k = 0; k < PB; ++k) {
        const int r = r0 + k;
        float ncen[16];
        if (k + 1 < PB) { const int rin = r + HALF, rout = r - HALF;
            ld16bf(PI + (size_t)(rin > 127 ? 127 : rin) * 64 * 512, fi); ld16bf(PI + (size_t)(rout < 0 ? 0 : rout) * 64 * 512, fo); ld16bf(PI + (size_t)(r + 1) * 64 * 512, ncen); }
        const int lo_r = (r - HALF) < 0 ? 0 : (r - HALF), hi_r = (r + HALF) > 128 ? 128 : (r + HALF);
        const float inv = __builtin_amdgcn_rcpf((float)((hi_r - lo_r) * (hi_c - lo_c)));
        float o[16];
#pragma unroll
        for (int e = 0; e < 16; ++e) { const float p = wave_prefix(run[e]);
            const float hi = __shfl(p, hi_c - 1), lo = __shfl(p, lo_c > 0 ? lo_c - 1 : 0);
            o[e] = (hi - (lo_c > 0 ? lo : 0.f)) * inv - cen[e]; }
        bf16* po = PO + (size_t)r * 64 * 512;
        *(u32x4*)po = (u32x4){pk2(o[0], o[1]), pk2(o[2], o[3]), pk2(o[4], o[5]), pk2(o[6], o[7])}; *(u32x4*)(po + 8) = (u32x4){pk2(o[8], o[9]), pk2(o[10], o[11]), pk2(o[12], o[13]), pk2(o[14], o[15])};
        if (k + 1 < PB) { const int rin = r + HALF, rout = r - HALF;
#pragma unroll
            for (int e = 0; e < 16; ++e) { run[e] += (rin < 128 ? fi[e] : 0.f) - (rout >= 0 ? fo[e] : 0.f); cen[e] = ncen[e]; } }
    }
}
__device__ __forceinline__ void pool_units(const Args& a, int vcu, int G, int lane, int wave, int nw) {
    unsigned char* ws = a.ws;
    constexpr int NBAND = 128 / PB, PER_G = NB * 8 * NBAND;
    for (int wu = vcu * nw + wave; wu < NPOOLW; wu += G * nw) {
        const int g = 3 - (wu & 3), rem = wu >> 2, b = rem / (8 * NBAND), rem2 = rem % (8 * NBAND), chk = rem2 & 7, r0 = (rem2 >> 3) * PB;
        const size_t off = ((size_t)b * SEQ + lane) * 512 + g * 128 + chk * 16;
        const bf16* PI = (const bf16*)(ws + WS_PI) + off; bf16* PO = (bf16*)(ws + WS_PO) + off;
        if (g == 0) pool_band<1>(PI, PO, r0, lane); else if (g == 1) pool_band<2>(PI, PO, r0, lane); else if (g == 2) pool_band<4>(PI, PO, r0, lane); else pool_band<8>(PI, PO, r0, lane);
    }
}

__device__ __forceinline__ void phase4(const Args& a, int G, int tid, int nthr) {
    unsigned char* ws = a.ws;
    for (int e = blockIdx.x * nthr + tid; e < 2 * 8 * 8192; e += G * nthr) {
        const int dir = e >> 16, bh = (e >> 13) & 7, e8 = e & 8191, dk = e8 & 63;
        const bf16* kvp = (const bf16*)(ws + WS_KV) + (size_t)((dir * 8 + bh) * NSLOT) * 8192 + e8;
        const float* decp = (const float*)(ws + WS_DEC) + (size_t)((dir * 8 + bh) * NSLOT) * 64 + dk;
        bf16* stp = (bf16*)(ws + WS_ST) + (size_t)((dir * 8 + bh) * NCH) * 8192 + e8;
        float s = 0.f;
        float kv[12], dc[12], kvn[12], dcn[12];
#define SCAN_SLOT(j) (dir ? (NSLOT - 1 - (j)) : ((j) < 4 ? NCH + (j) : (j) - 4))
#pragma unroll
        for (int q = 0; q < 12; ++q) { const int slot = SCAN_SLOT(q); kvn[q] = bf2f(kvp[(size_t)slot * 8192]); dcn[q] = decp[slot * 64]; }
        for (int j0 = 0; j0 < NSLOT; j0 += 12) {
#pragma unroll
            for (int q = 0; q < 12; ++q) { kv[q] = kvn[q]; dc[q] = dcn[q]; }
            if (j0 + 12 < NSLOT) {
#pragma unroll
                for (int q = 0; q < 12; ++q) { const int slot = SCAN_SLOT(j0 + 12 + q); kvn[q] = bf2f(kvp[(size_t)slot * 8192]); dcn[q] = decp[slot * 64]; } }
#pragma unroll
            for (int q = 0; q < 12; ++q) { const int slot = SCAN_SLOT(j0 + q);
                if (slot < NCH) stp[(size_t)slot * 8192] = (bf16)f2bf(s);
                s = dc[q] * s + kv[q]; }
        }
#undef SCAN_SLOT
    }
}

struct GlaPre { u32x4 q, k; f32x4 b0, b1, c0, c1, mf0, mf1, mb0, mb1; u32x4 v[2]; u32x4 st[4]; u32x4 sg[2]; };
__device__ __forceinline__ void gla_load(GlaPre& P, const Args& a, int u, int tid) {
    unsigned char* ws = a.ws;
    const int b = u >> 9, h = (u >> 7) & 3, n = u & 127, row0 = b * SEQ + n * 64, bh = b * 4 + h, t = tid >> 3, c8 = tid & 7;
    const size_t gi = (size_t)(row0 + t) * 256 + h * 64 + 8 * c8, gmf = (size_t)(row0 + 31) * 256 + h * 64 + 8 * c8, gmb = (size_t)(row0 + 32) * 256 + h * 64 + 8 * c8;
    const float* BF = a.out; const float* CB = a.out + (size_t)M * 256;
    P.q = *(const u32x4*)((const bf16*)(ws + WS_QB) + gi); P.k = *(const u32x4*)((const bf16*)(ws + WS_KB) + gi);
    P.b0 = *(const f32x4*)(BF + gi); P.b1 = *(const f32x4*)(BF + gi + 4); P.c0 = *(const f32x4*)(CB + gi); P.c1 = *(const f32x4*)(CB + gi + 4);
    P.mf0 = *(const f32x4*)(BF + gmf); P.mf1 = *(const f32x4*)(BF + gmf + 4); P.mb0 = *(const f32x4*)(CB + gmb); P.mb1 = *(const f32x4*)(CB + gmb + 4);
#pragma unroll
    for (int i = 0; i < 2; ++i) { const int p = tid + NT * i, jj = p >> 4, ch = p & 15; P.v[i] = *(const u32x4*)((const bf16*)(ws + WS_VB) + (size_t)(row0 + jj) * 512 + h * 128 + 8 * ch); }
#pragma unroll
    for (int i = 0; i < 4; ++i) { const int p = tid + NT * i, dir = p >> 10, rem = p & 1023, dv = rem >> 3, c = rem & 7;
        P.st[i] = *(const u32x4*)((const bf16*)(ws + WS_ST) + ((size_t)((dir * 8 + bh) * NCH + n) * 128 + dv) * 64 + 8 * c); }
    const bf16* sgp = (const bf16*)(ws + WS_SG) + (size_t)(row0 + t) * 512 + h * 128 + 16 * c8;
    P.sg[0] = *(const u32x4*)sgp; P.sg[1] = *(const u32x4*)(sgp + 8);
}
__device__ __forceinline__ void phase5(LAS unsigned char* lds, const Args& a, int vcu, int G, int tid, int lane, int wave) {
    unsigned char* ws = a.ws;
    LAS bf16* Aop = (LAS bf16*)lds;
    LAS bf16* Bop = (LAS bf16*)(lds + 25600);
    LAS bf16* Vs = (LAS bf16*)(lds + 60416);
    LAS bf16* qsf = (LAS bf16*)(lds + 77824); LAS bf16* ksf = qsf + 64 * 72; LAS bf16* qsb = ksf + 64 * 72; LAS bf16* ksb = qsb + 64 * 72;
    LAS float* Os = (LAS float*)(lds + 77824);
    const int t8 = tid >> 3, c8 = tid & 7;
    f32x4 gn[4];
#pragma unroll
    for (int q = 0; q < 4; ++q) gn[q] = *(const f32x4*)(a.in[I_GNG] + 16 * c8 + 4 * q);
    GlaPre P;
    int u = vcu;
    if (u < 1024) gla_load(P, a, u, tid);
    for (; u < 1024; u += G) {
        const int b = u >> 9, h = (u >> 7) & 3, n = u & 127, row0 = b * SEQ + n * 64;
        { float qf[8], kf[8], bb[8], cc[8], mf[8], mb[8];
#pragma unroll
          for (int e = 0; e < 4; ++e) { qf[2 * e] = bflo(P.q[e]); qf[2 * e + 1] = bfhi(P.q[e]); kf[2 * e] = bflo(P.k[e]); kf[2 * e + 1] = bfhi(P.k[e]);
              bb[e] = P.b0[e]; bb[4 + e] = P.b1[e]; cc[e] = P.c0[e]; cc[4 + e] = P.c1[e]; mf[e] = P.mf0[e]; mf[4 + e] = P.mf1[e]; mb[e] = P.mb0[e]; mb[4 + e] = P.mb1[e]; }
          float o0[8], o1[8], o2[8], o3[8], o4[8], o5[8];
#pragma unroll
          for (int e = 0; e < 8; ++e) { const float eb = __expf(bb[e]), ec = __expf(cc[e]), x = __expf(bb[e] - mf[e]), y = __expf(cc[e] - mb[e]);
              o0[e] = qf[e] * eb; o1[e] = qf[e] * ec; o2[e] = qf[e] * x; o3[e] = kf[e] * __builtin_amdgcn_rcpf(x); o4[e] = qf[e] * y; o5[e] = kf[e] * __builtin_amdgcn_rcpf(y); }
#define PK8(o) (u32x4){pk2(o[0], o[1]), pk2(o[2], o[3]), pk2(o[4], o[5]), pk2(o[6], o[7])}
          *(LAS u32x4*)(Aop + t8 * 200 + 8 * c8) = PK8(o0); *(LAS u32x4*)(Aop + t8 * 200 + 64 + 8 * c8) = PK8(o1);
          *(LAS u32x4*)(qsf + t8 * 72 + 8 * c8) = PK8(o2); *(LAS u32x4*)(ksf + t8 * 72 + 8 * c8) = PK8(o3); *(LAS u32x4*)(qsb + t8 * 72 + 8 * c8) = PK8(o4); *(LAS u32x4*)(ksb + t8 * 72 + 8 * c8) = PK8(o5);
#undef PK8
        }
#pragma unroll
        for (int i = 0; i < 2; ++i) { const int p = tid + NT * i, jj = p >> 4, ch = p & 15; *(LAS u32x4*)(Vs + jj * 136 + 8 * ch) = P.v[i]; }
#pragma unroll
        for (int i = 0; i < 4; ++i) { const int p = tid + NT * i, dir = p >> 10, rem = p & 1023, dv = rem >> 3, c = rem & 7; *(LAS u32x4*)(Bop + dv * 136 + dir * 64 + 8 * c) = P.st[i]; }
        const u32x4 sg0 = P.sg[0], sg1 = P.sg[1];
        __syncthreads();
        if (u + G < 1024) gla_load(P, a, u + G, tid);
        { const int tt = wave >> 1, jh = wave & 1; f32x4 pa[2] = {{0.f, 0.f, 0.f, 0.f}, {0.f, 0.f, 0.f, 0.f}};
#pragma unroll
          for (int dir = 0; dir < 2; ++dir) { const LAS bf16* qs = dir ? qsb : qsf; const LAS bf16* ks = dir ? ksb : ksf;
              const bf16x8 a0 = ldfrag(qs, 72, tt * 16, 0, lane), a1 = ldfrag(qs, 72, tt * 16, 32, lane);
#pragma unroll
              for (int jj = 0; jj < 2; ++jj) { const int jt = jh * 2 + jj; f32x4 sc = {0.f, 0.f, 0.f, 0.f}; sc = MFMA16(a0, ldfrag(ks, 72, jt * 16, 0, lane), sc); sc = MFMA16(a1, ldfrag(ks, 72, jt * 16, 32, lane), sc);
#pragma unroll
                  for (int r = 0; r < 4; ++r) { const int t = tt * 16 + 4 * (lane >> 4) + r, jx = jt * 16 + (lane & 15); const bool keep = dir ? (jx >= t) : (jx <= t); pa[jj][r] += keep ? sc[r] : 0.f; } } }
#pragma unroll
          for (int jj = 0; jj < 2; ++jj)
#pragma unroll
              for (int r = 0; r < 4; ++r) Aop[(tt * 16 + 4 * (lane >> 4) + r) * 200 + 128 + (jh * 2 + jj) * 16 + (lane & 15)] = (bf16)f2bf(pa[jj][r]); }
        __syncthreads();
        const int tt = wave >> 1, dvh = wave & 1;
        f32x4 acc[4] = {{0.f, 0.f, 0.f, 0.f}, {0.f, 0.f, 0.f, 0.f}, {0.f, 0.f, 0.f, 0.f}, {0.f, 0.f, 0.f, 0.f}};
#pragma unroll
        for (int ks = 0; ks < 4; ++ks) { const bf16x8 af = ldfrag(Aop, 200, tt * 16, ks * 32, lane);
#pragma unroll
            for (int i = 0; i < 4; ++i) acc[i] = MFMA16(af, ldfrag(Bop, 136, (dvh * 4 + i) * 16, ks * 32, lane), acc[i]); }
#pragma unroll
        for (int ks = 0; ks < 2; ++ks) { const bf16x8 af = ldfrag(Aop, 200, tt * 16, 128 + ks * 32, lane);
#pragma unroll
            for (int i = 0; i < 4; ++i) acc[i] = MFMA16(af, ldfrag_tr(Vs, 136, ks * 32, (dvh * 4 + i) * 16, lane), acc[i]); }
#pragma unroll
        for (int i = 0; i < 4; ++i)
#pragma unroll
            for (int r = 0; r < 4; ++r) Os[(tt * 16 + 4 * (lane >> 4) + r) * 132 + (dvh * 4 + i) * 16 + (lane & 15)] = acc[i][r];
        __syncthreads();
        { f32x4 ov[4]; float ss = 0.f;
#pragma unroll
          for (int q = 0; q < 4; ++q) { ov[q] = *(const LAS f32x4*)(Os + t8 * 132 + 16 * c8 + 4 * q); ss += ov[q][0] * ov[q][0] + ov[q][1] * ov[q][1] + ov[q][2] * ov[q][2] + ov[q][3] * ov[q][3]; }
          ss += __shfl_xor(ss, 1); ss += __shfl_xor(ss, 2); ss += __shfl_xor(ss, 4);
          const float rstd = rsqrtf(ss * (1.f / 128.f) + EPS);
          unsigned sgw[8] = {sg0[0], sg0[1], sg0[2], sg0[3], sg1[0], sg1[1], sg1[2], sg1[3]}, ow[8];
#pragma unroll
          for (int q = 0; q < 4; ++q) { const f32x4 o = ov[q] * rstd * gn[q]; ow[2 * q] = pk2(o[0] * bflo(sgw[2 * q]), o[1] * bfhi(sgw[2 * q])); ow[2 * q + 1] = pk2(o[2] * bflo(sgw[2 * q + 1]), o[3] * bfhi(sgw[2 * q + 1])); }
          bf16* agp = (bf16*)(ws + WS_AG) + (size_t)(row0 + t8) * 512 + h * 128 + 16 * c8;
          *(u32x4*)agp = (u32x4){ow[0], ow[1], ow[2], ow[3]}; *(u32x4*)(agp + 8) = (u32x4){ow[4], ow[5], ow[6], ow[7]}; }
        __syncthreads();
    }
}

__device__ __forceinline__ void phase8(LAS unsigned char* lds, const Args& a, int vcu, int G, int tid, int lane, int wave) {
    unsigned char* ws = a.ws;
    const float* MOD = (const float*)(ws + WS_MOD);
    LAS float* WRT = (LAS float*)lds;
#pragma unroll
    for (int it = 0; it < 8; ++it) { const int idx = tid + NT * it, k = idx >> 2, c4 = idx & 3; const f32x4 v = *(const f32x4*)(a.in[I_WROUTER] + (size_t)k * 16 + 4 * c4);
        const int row = ((k >> 8) * 4 + (k & 3)) * 64 + ((k & 255) >> 2); *(LAS f32x4*)(WRT + row * 20 + 4 * c4) = v; }
    __syncthreads();
    const int gw = vcu * NWAVES + wave, NGW = G * NWAVES;
    f32x4 gv[4];
#pragma unroll
    for (int j = 0; j < 4; ++j) gv[j] = *(const f32x4*)(a.in[I_N2G] + 256 * j + 4 * lane);
    f32x4 nx[2][4];
    if (gw < M / 2) {
#pragma unroll
        for (int r = 0; r < 2; ++r)
#pragma unroll
            for (int j = 0; j < 4; ++j) { const size_t o_ = (size_t)(2 * gw + r) * 1024 + 256 * j + 4 * lane; const u32x2 d_ = *(const u32x2*)((const bf16*)(ws + WS_YD) + o_);
                nx[r][j] = *(const f32x4*)(a.in[I_X] + o_) + (f32x4){bflo(d_.x), bfhi(d_.x), bflo(d_.y), bfhi(d_.y)}; } }
    for (int pr = gw; pr < M / 2; pr += NGW) {
        const int m0 = 2 * pr, b = m0 >> 13; const float* mod = MOD + (size_t)b * 6144;
        f32x4 v[2][4]; float ss[2];
#pragma unroll
        for (int r = 0; r < 2; ++r) { float q = 0.f;
#pragma unroll
            for (int j = 0; j < 4; ++j) { u32x2 w_; w_.x = cvt_pk_bf16(nx[r][j][0], nx[r][j][1]); w_.y = cvt_pk_bf16(nx[r][j][2], nx[r][j][3]);
                *(u32x2*)((bf16*)(ws + WS_YD) + (size_t)(m0 + r) * 1024 + 256 * j + 4 * lane) = w_;
                v[r][j] = (f32x4){bflo(w_.x), bfhi(w_.x), bflo(w_.y), bfhi(w_.y)}; q += v[r][j][0] * v[r][j][0] + v[r][j][1] * v[r][j][1] + v[r][j][2] * v[r][j][2] + v[r][j][3] * v[r][j][3]; }
            ss[r] = q; }
        if (pr + NGW < M / 2) {
#pragma unroll
            for (int r = 0; r < 2; ++r)
#pragma unroll
                for (int j = 0; j < 4; ++j) { const size_t o_ = (size_t)(2 * (pr + NGW) + r) * 1024 + 256 * j + 4 * lane; const u32x2 d_ = *(const u32x2*)((const bf16*)(ws + WS_YD) + o_);
                    nx[r][j] = *(const f32x4*)(a.in[I_X] + o_) + (f32x4){bflo(d_.x), bfhi(d_.x), bflo(d_.y), bfhi(d_.y)}; } }
#pragma unroll
        for (int r = 0; r < 2; ++r) { const float rstd = rsqrtf(wave_sum(ss[r]) * (1.f / 1024.f) + EPS);
#pragma unroll
            for (int j = 0; j < 4; ++j) { const f32x4 sc = *(const f32x4*)(mod + 4096 + 256 * j + 4 * lane), sh = *(const f32x4*)(mod + 3072 + 256 * j + 4 * lane); v[r][j] = v[r][j] * rstd * gv[j] * (sc + 1.f) + sh; }
            unsigned char* hp = ws + WS_H2 + (size_t)(m0 + r) * 1024;
#pragma unroll
            for (int j = 0; j < 4; ++j) *(unsigned*)(hp + 256 * j + 4 * lane) = pk4_fp8(v[r][j][0], v[r][j][1], v[r][j][2], v[r][j][3]); }
        f32x2 r2[16];
#pragma unroll
        for (int i = 0; i < 16; ++i) r2[i] = (f32x2){0.f, 0.f};
#pragma unroll
        for (int j = 0; j < 4; ++j)
#pragma unroll
            for (int i = 0; i < 4; ++i) { const f32x2 hab = {v[0][j][i], v[1][j][i]}; const LAS float* rp = WRT + ((j * 4 + i) * 64 + lane) * 20;
#pragma unroll
                for (int c4 = 0; c4 < 4; ++c4) { const f32x4 w = *(const LAS f32x4*)(rp + 4 * c4); r2[4 * c4 + 0] += hab * w[0]; r2[4 * c4 + 1] += hab * w[1]; r2[4 * c4 + 2] += hab * w[2]; r2[4 * c4 + 3] += hab * w[3]; }
                if (i & 1) asm volatile("" ::: "memory"); }
#pragma unroll
        for (int r = 0; r < 2; ++r) {
            float racc[16];
#pragma unroll
            for (int i = 0; i < 16; ++i) racc[i] = r2[i][r];
            RSTEP(16, 32); RSTEP(8, 16); RSTEP(4, 8); RSTEP(2, 4); racc[0] += __shfl_xor(racc[0], 2); racc[0] += __shfl_xor(racc[0], 1);
            const float lg = racc[0];
            float mx = lg; mx = fmaxf(mx, __shfl_xor(mx, 4)); mx = fmaxf(mx, __shfl_xor(mx, 8)); mx = fmaxf(mx, __shfl_xor(mx, 16)); mx = fmaxf(mx, __shfl_xor(mx, 32));
            const float ex = expf(lg - mx); float sm = ex; sm += __shfl_xor(sm, 4); sm += __shfl_xor(sm, 8); sm += __shfl_xor(sm, 16); sm += __shfl_xor(sm, 32);
            const int m = m0 + r;
            if ((lane & 3) == 0) ((float*)(ws + WS_AFF))[(size_t)(b * 16 + (lane >> 2)) * SEQ + (m & (SEQ - 1))] = ex / sm;
            if (lane < 16) ((int*)(ws + WS_INV))[(size_t)m * 16 + lane] = -1;
        }
    }
}

__device__ __forceinline__ void topk_unit(LAS unsigned char* lds, const Args& a, int be, int tid, int lane, int wave) {
    unsigned char* ws = a.ws;
    LAS unsigned* hist = (LAS unsigned*)lds;
    LAS unsigned* sel = hist + 256;
    LAS unsigned* wtot = hist + 264;
    const float* aff = (const float*)(ws + WS_AFF) + (size_t)be * SEQ + 16 * tid;
    unsigned key[16];
#pragma unroll
    for (int q = 0; q < 4; ++q) { const u32x4 v = *(const u32x4*)(aff + 4 * q); key[4 * q] = v[0]; key[4 * q + 1] = v[1]; key[4 * q + 2] = v[2]; key[4 * q + 3] = v[3]; }
    unsigned prefix = 0u, mask = 0u, kk = CAP;
    for (int pass = 0; pass < 4; ++pass) {
        const int shift = 24 - 8 * pass;
        if (tid < 256) hist[tid] = 0u;
        __syncthreads();
#pragma unroll
        for (int i = 0; i < 16; ++i) if ((key[i] & mask) == prefix) __hip_atomic_fetch_add(hist + ((key[i] >> shift) & 255u), 1u, __ATOMIC_RELAXED, __HIP_MEMORY_SCOPE_WORKGROUP);
        __syncthreads();
        if (wave == 0) {
            const unsigned h0 = hist[4 * lane], h1 = hist[4 * lane + 1], h2 = hist[4 * lane + 2], h3 = hist[4 * lane + 3], loc = h0 + h1 + h2 + h3;
            unsigned suf = loc;
#pragma unroll
            for (int o = 1; o < 64; o <<= 1) { const unsigned t = __shfl_down(suf, o); if (lane + o < 64) suf += t; }
            const unsigned above = suf - loc;
            const unsigned s3 = above + h3, s2 = s3 + h2, s1 = s2 + h1, s0 = s1 + h0;
            if (s3 >= kk && above < kk) { sel[0] = 4 * lane + 3; sel[1] = kk - above; }
            if (s2 >= kk && s3 < kk) { sel[0] = 4 * lane + 2; sel[1] = kk - s3; }
            if (s1 >= kk && s2 < kk) { sel[0] = 4 * lane + 1; sel[1] = kk - s2; }
            if (s0 >= kk && s1 < kk) { sel[0] = 4 * lane + 0; sel[1] = kk - s1; }
        }
        __syncthreads();
        prefix |= sel[0] << shift; mask |= 255u << shift; kk = sel[1];
        __syncthreads();
    }
    unsigned cgt = 0u, ceq = 0u;
#pragma unroll
    for (int i = 0; i < 16; ++i) { cgt += (key[i] > prefix) ? 1u : 0u; ceq += (key[i] == prefix) ? 1u : 0u; }
    const unsigned val = cgt | (ceq << 16); unsigned inc = val;
#pragma unroll
    for (int o = 1; o < 64; o <<= 1) { const unsigned t = __shfl_up(inc, o); if (lane >= o) inc += t; }
    if (lane == 63) wtot[wave] = inc;
    __syncthreads();
    unsigned base = 0u;
    for (int w = 0; w < wave; ++w) base += wtot[w];
    const unsigned excl = base + inc - val; unsigned gtb = excl & 0xffffu, eqb = excl >> 16;
    const int b = be >> 4, e = be & 15;
    int* IDX = (int*)(ws + WS_IDX) + be * CAP; float* WSEL = (float*)(ws + WS_WSEL) + be * CAP; int* INV = (int*)(ws + WS_INV);
#pragma unroll
    for (int i = 0; i < 16; ++i) { const bool gt = key[i] > prefix, eq = key[i] == prefix; const bool take = gt || (eq && eqb < kk);
        if (take) { const unsigned pos = gtb + (eqb < kk ? eqb : kk); const int row = b * SEQ + 16 * tid + i; IDX[pos] = row; WSEL[pos] = __builtin_bit_cast(float, key[i]); INV[(size_t)row * 16 + e] = (int)pos; }
        gtb += gt ? 1u : 0u; eqb += eq ? 1u : 0u; }
    __syncthreads();
}
__device__ __forceinline__ void phase9(LAS unsigned char* lds, const Args& a, int vcu, int G, int tid, int lane, int wave) {
    const int ntk = (G > 64) ? 32 : 0;
    if (vcu < ntk || ntk == 0) for (int be = (ntk ? vcu : vcu); be < NB * NE; be += (ntk ? ntk : G)) topk_unit(lds, a, be, tid, lane, wave);
    if (vcu >= ntk) { const int gw = (vcu - ntk) * NWAVES + wave, NGW = (G - ntk) * NWAVES; convert_items<2>((LAS float*)(lds + 8192 + wave * 8448), a, gw, NGW, 8192, lane); }
}

__device__ __forceinline__ void phase12(const Args& a, int vcu, int G, int lane, int wave) {
    unsigned char* ws = a.ws;
    const int gw = vcu * NWAVES + wave, NGW = G * NWAVES;
    f32x4 gv[4];
#pragma unroll
    for (int j = 0; j < 4; ++j) gv[j] = *(const f32x4*)(a.in[I_FNG] + 256 * j + 4 * lane);
    f32x4 nx[4]; int ninv = -1;
    if (gw < M) {
#pragma unroll
        for (int j = 0; j < 4; ++j) { const size_t o_ = (size_t)gw * 1024 + 256 * j + 4 * lane; const u32x2 d_ = __builtin_nontemporal_load((const u32x2*)((const bf16*)(ws + WS_YD) + o_));
            nx[j] = (f32x4){bflo(d_.x), bfhi(d_.x), bflo(d_.y), bfhi(d_.y)}; }
        ninv = (lane < 16) ? ((const int*)(ws + WS_INV))[(size_t)gw * 16 + lane] : -1; }
    for (int m = gw; m < M; m += NGW) {
        const int b = m >> 13; float* row = a.out + (size_t)m * 1024;
        f32x4 v[4];
#pragma unroll
        for (int j = 0; j < 4; ++j) v[j] = nx[j];
        const int myinv = ninv;
        if (m + NGW < M) {
#pragma unroll
            for (int j = 0; j < 4; ++j) { const size_t o_ = (size_t)(m + NGW) * 1024 + 256 * j + 4 * lane; const u32x2 d_ = __builtin_nontemporal_load((const u32x2*)((const bf16*)(ws + WS_YD) + o_));
                nx[j] = (f32x4){bflo(d_.x), bfhi(d_.x), bflo(d_.y), bfhi(d_.y)}; }
            ninv = (lane < 16) ? ((const int*)(ws + WS_INV))[(size_t)(m + NGW) * 16 + lane] : -1; }
        unsigned long long mask = __ballot(myinv >= 0);
        const bf16* yb = (const bf16*)(ws + WS_YB) + (size_t)(b * 16) * CAP * 1024;
        while (mask) {
            u32x2 w[4][4]; float sc[4];
#pragma unroll
            for (int q = 0; q < 4; ++q) { const bool on = mask != 0ull; const int e = on ? (int)__builtin_ctzll(mask) : 0; mask = on ? (mask & (mask - 1ull)) : 0ull;
                const int sl = __shfl(myinv, e); const size_t ro = on ? ((size_t)e * CAP + (size_t)sl) * 1024 : 0; sc[q] = on ? 1.f : 0.f;
#pragma unroll
                for (int j = 0; j < 4; ++j) w[q][j] = __builtin_nontemporal_load((const u32x2*)(yb + ro + 256 * j + 4 * lane)); }
#pragma unroll
            for (int q = 0; q < 4; ++q)
#pragma unroll
                for (int j = 0; j < 4; ++j) { v[j][0] += sc[q] * bflo(w[q][j].x); v[j][1] += sc[q] * bfhi(w[q][j].x); v[j][2] += sc[q] * bflo(w[q][j].y); v[j][3] += sc[q] * bfhi(w[q][j].y); }
        }
        float ss = 0.f;
#pragma unroll
        for (int j = 0; j < 4; ++j) ss += v[j][0] * v[j][0] + v[j][1] * v[j][1] + v[j][2] * v[j][2] + v[j][3] * v[j][3];
        const float rstd = rsqrtf(wave_sum(ss) * (1.f / 1024.f) + EPS);
#pragma unroll
        for (int j = 0; j < 4; ++j) __builtin_nontemporal_store(v[j] * rstd * gv[j], (f32x4*)(row + 256 * j + 4 * lane));
    }
}

__global__ void __launch_bounds__(NT, 2) fwd_kernel(Args args) {
    extern __shared__ __attribute__((aligned(16))) unsigned char lds_raw[];
    LAS unsigned char* lds = (LAS unsigned char*)lds_raw;
    volatile LAS unsigned* MISC = (volatile LAS unsigned*)(lds + MISC_OFF);
    const int tid0 = threadIdx.x, tid = tid0, wave = __builtin_amdgcn_readfirstlane(tid >> 6);
    const int G = gridDim.x, bx = blockIdx.x, vcu = (G % 8 == 0) ? (bx % 8) * (G / 8) + bx / 8 : bx;
    unsigned char* ws = args.ws;
    if (tid < 128) MISC[tid] = 0u;
    __syncthreads();
    XcdBarrier bar; bar.bar = (unsigned*)(ws + WS_CTL) + CW_BAR; bar.x = 0; bar.st = nullptr;
    if (!MK_MULTI) bar = xcd_barrier_post((unsigned*)(ws + WS_CTL) + CW_BAR, MISC + 8);
    const int lo = args.ph_lo, hi = args.ph_hi;
#define IN(k) (lo <= (k) && (k) < hi)
#define SEAM(k) do { if (IN(k) && IN((k) + 1)) xcd_barrier(bar); } while (0)
#define RUN(k, CODE) do { if (IN(k)) { int tid = tid0, lane; asm volatile("" : "+v"(tid)); lane = tid & 63; (void)lane; CODE; if (REP_PHASE == (k)) for (int _r = 0; _r < REP_COUNT; ++_r) { xcd_barrier(bar); CODE; } } SEAM(k); } while (0)
#define PH0 phase0(lds, args, vcu, G, tid, lane, wave)
#define PH1 phase1(lds, args, vcu, G, tid, lane, wave)
#define PH2 do { const int qs = vcu % 3;     \
        EpiInproj E{(bf16*)(ws + WS_KB), (bf16*)(ws + WS_VB), (bf16*)(ws + WS_QB), (bf16*)(ws + WS_SG), (bf16*)(ws + WS_PI), ws + WS_SM, 0, 1.f}; \
        EpiGates E8{(bf16*)(ws + WS_KB), (bf16*)(ws + WS_VB), (bf16*)(ws + WS_QB), (bf16*)(ws + WS_SG), (bf16*)(ws + WS_PI), ws + WS_SM, 8, 0.0625f}; \
        if (qs == 0) for (int r_ = 0; r_ < args.rep[6]; ++r_) convert_all<1>(lds, args, vcu, G, lane, wave); \
        for (int r_ = 0; r_ < args.rep[0]; ++r_) { SchedDense S{G, bx, 1024, 64, 8, (const char*)(ws + WS_H1), (const char*)(ws + WS_WIN), 0, 1 << 20, 2}; pg8::gemm_phase<EpiInproj, SchedDense, false, false>(lds, S, E); }     \
        if (qs == 1) for (int r_ = 0; r_ < args.rep[6]; ++r_) convert_all<1>(lds, args, vcu, G, lane, wave); \
        for (int r_ = 0; r_ < args.rep[1]; ++r_) { SchedDense S{G, bx, 1024, 64, 8, (const char*)(ws + WS_H1F), (const char*)(ws + WS_WINM), 0, 1 << 20, 1}; pg8::gemm_phase<EpiGates, SchedDense, false, true>(lds, S, E8); }     \
        if (qs == 2) for (int r_ = 0; r_ < args.rep[6]; ++r_) convert_all<1>(lds, args, vcu, G, lane, wave); } while (0)
#define PH3 chunk_units(lds, args, vcu, G, tid, lane, wave)
#define PH4 do { pool_units(args, vcu, G, lane, wave, 8); phase4(args, G, tid, NT); } while (0)
#define PH5 phase5(lds, args, vcu, G, tid, lane, wave)
#define PH6 do { SchedPair S{G, bx, 512, (const char*)(ws + WS_AG), (const char*)(ws + WS_PO), (const char*)(ws + WS_WG), (const char*)(ws + WS_WC)}; \
        EpiMerge E{ws + WS_SM, (bf16*)(ws + WS_MG)}; for (int r_ = 0; r_ < args.rep[4]; ++r_) pg8::gemm_phase<EpiMerge, SchedPair, false>(lds, S, E); } while (0)
#define PH7 do { SchedDense S{G, bx, 1024, 64, 4, (const char*)(ws + WS_MG), (const char*)(ws + WS_WO), 0, 1 << 20, 2}; \
        EpiOut E{(const float*)(ws + WS_MOD), (bf16*)(ws + WS_YD)}; for (int r_ = 0; r_ < args.rep[5]; ++r_) pg8::gemm_phase<EpiOut, SchedDense, false>(lds, S, E); } while (0)
#define NITEM_HALF ((NE * 3 * 512 + 2 * G * NWAVES - 1) / (2 * G * NWAVES))
#define PH6C do { if (vcu & 1) convert_experts(lds, args, vcu, G, lane, wave, 0, NITEM_HALF); PH6; if (!(vcu & 1)) convert_experts(lds, args, vcu, G, lane, wave, 0, NITEM_HALF); } while (0)
#define PH7C do { if (vcu & 1) convert_experts(lds, args, vcu, G, lane, wave, NITEM_HALF, 2 * NITEM_HALF); PH7; if (!(vcu & 1)) convert_experts(lds, args, vcu, G, lane, wave, NITEM_HALF, 2 * NITEM_HALF); } while (0)
#define PH8 phase8(lds, args, vcu, G, tid, lane, wave)
#define PH9 phase9(lds, args, vcu, G, tid, lane, wave)
#define PH9B do { const int gw_ = vcu * NWAVES + wave, NGW_ = G * NWAVES;     \
        for (int r0_ = gw_ * 16; r0_ < NB * NE * CAP; r0_ += NGW_ * 16) { u32x4 t_[16]; \
            _Pragma("unroll") for (int q = 0; q < 16; ++q) { const int src_ = ((const int*)(ws + WS_IDX))[r0_ + q]; t_[q] = *(const u32x4*)(ws + WS_H2 + (size_t)src_ * 1024 + lane * 16); } \
            _Pragma("unroll") for (int q = 0; q < 16; ++q) *(u32x4*)(ws + WS_XS + (size_t)(r0_ + q) * 1024 + lane * 16) = t_[q]; } } while (0)
#define PH10 do { EpiMoe1 E{ws + WS_ACT}; SchedMoe1 S{G, bx, 1024, (const char*)(ws + WS_XS), (const char*)(ws + WS_WGU), 0, 1 << 20}; for (int r_ = 0; r_ < args.rep[2]; ++r_) pg8::gemm_phase<EpiMoe1, SchedMoe1, false, true>(lds, S, E); } while (0)
#define PH11 do { SchedMoe2 S{G, bx, 1024, (const char*)(ws + WS_ACT), (const char*)(ws + WS_WD)}; \
        EpiMoe2 E{(bf16*)(ws + WS_YB), (const float*)(ws + WS_WSEL), (const float*)(ws + WS_MOD)}; for (int r_ = 0; r_ < args.rep[3]; ++r_) pg8::gemm_phase<EpiMoe2, SchedMoe2, false, true>(lds, S, E); } while (0)
#define PH12 phase12(args, vcu, G, lane, wave)
    RUN(0, PH0); RUN(1, PH1); RUN(2, PH2); RUN(3, PH3);
#define PH3A chunk_units(lds, args, vcu, G, tid, lane, wave)
#define PH3B pool_units(args, vcu, G, lane, wave, 8)
    if (REP_PHASE == 40) { xcd_barrier(bar); if (wave < 4) phase4(args, G, tid, 256); xcd_barrier(bar); }
    if (REP_PHASE == 41) { const int lane = tid & 63; xcd_barrier(bar); if (wave >= 4) pool_units(args, vcu, G, lane, wave - 4, 4); xcd_barrier(bar); }
    if (REP_PHASE == 30) { const int lane = tid & 63; xcd_barrier(bar); PH3A; xcd_barrier(bar); }
    if (REP_PHASE == 31) { const int lane = tid & 63; xcd_barrier(bar); PH3B; xcd_barrier(bar); } RUN(4, PH4); RUN(5, PH5); RUN(6, PH6); RUN(7, PH7); RUN(8, PH8); RUN(9, PH9); RUN(10, PH9B); RUN(11, PH10); RUN(12, PH11);
    if (REP_PHASE == 20) for (int _r = 0; _r < REP_COUNT; ++_r) xcd_barrier(bar);
    RUN(13, PH12);
#undef IN
#undef SEAM
#undef RUN
}

#ifndef MK_CHECK
#define MK_CHECK 0
#endif
#ifndef CHK_SKIP
#define CHK_SKIP -1
#endif
#if MK_CHECK
constexpr size_t WS_CHK = 299 * MiB;
__device__ __forceinline__ unsigned hashu(unsigned x) { x ^= x >> 16; x *= 0x7feb352dU; x ^= x >> 15; x *= 0x846ca68bU; x ^= x >> 16; return x; }
__device__ __forceinline__ float bfr(float f) { return bf2f(f2bf(f)); }
__device__ float f8d(unsigned char x) { const int sg = x >> 7, e = (x >> 3) & 15, m = x & 7; const float v = e ? ldexpf(1.f + m / 8.f, e - 7) : ldexpf(m / 8.f, -6); return sg ? -v : v; }
__device__ float f8r(float f) { return f8d((unsigned char)(pk4_fp8(f, 0.f, 0.f, 0.f) & 255u)); }
__device__ float x1_at(const Args& a, int m, int k) { return bf2f(((const bf16*)(a.ws + WS_YD))[(size_t)m * 1024 + k]); }
__device__ float naive_rstd_x1(const Args& a, int m) { float ss = 0.f; for (int k = 0; k < 1024; ++k) { const float v = x1_at(a, m, k); ss += v * v; } return rsqrtf(ss / 1024.f + EPS); }
__device__ float gate_at(const Args& a, int m, int n) {
    const int pm = m >> 8, r = m & 255, ai = r >> 7, wr = (r >> 6) & 1, mm = (r >> 4) & 3, fr = r & 15, pg = n >> 8, c = n & 255, bj = c >> 7, wc = (c >> 5) & 3, fq = (c >> 3) & 3, j8 = c & 7;
    return (float)(a.ws + WS_SM)[gate_off(pm, pg, ai, mm, bj, wr, wc, fr, fq) + j8] * (1.f / 255.f); }
__device__ float naive_rstd(const float* row) { float ss = 0.f; for (int k = 0; k < 1024; ++k) ss += row[k] * row[k]; return rsqrtf(ss / 1024.f + EPS); }
__device__ float naive_la(const Args& a, int row, int dir, int col) {
    const float* RB = (const float*)(a.ws + WS_RB) + (size_t)row * 32 + dir * 16; float z = a.in[I_BDEC][dir * 256 + col];
    for (int j = 0; j < 16; ++j) z += RB[j] * a.in[I_WDU][(size_t)(dir * 16 + j) * 256 + col];
    return logsig_f(z) / 16.f;
}
__global__ void chk_kernel(Args a, int stage) {
    __shared__ float sh[256];
    const unsigned gid = blockIdx.x * blockDim.x + threadIdx.x; unsigned h = hashu(gid * 2654435761u + (unsigned)stage * 97u + 12345u); const unsigned h2 = hashu(h + 777u);
    unsigned char* ws = a.ws; float ref = 0.f, got = 0.f, atol = 1e-3f; bool active = true;
    const float* MOD = (const float*)(ws + WS_MOD);
    switch (stage) {
    case 0: { const int v = h % 3, n = (h >> 2) % 6144; ref = a.in[I_ADAB][n]; for (int k = 0; k < 1024; ++k) { const float c = (v < 2) ? a.in[I_C][v * 1024 + k] : a.in[I_CCTX][k]; ref += c / (1.f + expf(-c)) * a.in[I_ADAW][(size_t)k * 6144 + n]; } got = MOD[v * 6144 + n]; atol = 0.01f; } break;
    case 1: { const int sel = (h >> 28) & 3, n = h % 4096, k = (h >> 12) % 1024;
        if (sel < 2) { if (n < 2048) { ref = bfr(a.in[I_WIN][(size_t)k * DIN + n + (n >= 768 ? 32 : 0)]); got = bf2f(((const bf16*)(ws + WS_WIN))[(size_t)n * 1024 + k]); } else { ref = f8r(16.f * a.in[I_WIN][(size_t)k * DIN + n + 32]); got = f8d((ws + WS_WINM)[(size_t)(n - 2048) * 1024 + k]); } }
        else if (sel == 2) { ref = bfr(a.in[I_WOUT][(size_t)k * 1024 + (n & 1023)]); got = bf2f(((const bf16*)(ws + WS_WO))[(size_t)(n & 1023) * 1024 + k]); }
        else { ref = bfr(a.in[I_WGLA][(size_t)(k & 511) * 1024 + (n & 1023)]); got = bf2f(((const bf16*)(ws + WS_WG))[(size_t)(n & 1023) * 512 + (k & 511)]); } atol = 1e-4f; } break;
    case 2: { const int n = h % 1024, kk = (h >> 10) % 512, g = kk >> 7, c = kk & 127; for (int d = 0; d < 128; ++d) ref += a.in[I_POOLW][(size_t)(g * 128 + c) * 128 + d] * a.in[I_POOLS][g * 128 + d] * a.in[I_WPOOL][(size_t)(g * 128 + d) * 1024 + n];
        got = bf2f(((const bf16*)(ws + WS_WC))[(size_t)n * 512 + kk]); atol = 0.002f; } break;
    case 3: { const int m = h % M, k = (h >> 14) % 1024, b = m >> 13; const float* row = a.in[I_X] + (size_t)m * 1024; const float rstd = naive_rstd(row);
        ref = row[k] * rstd * a.in[I_N1G][k] * (1.f + MOD[b * 6144 + 1024 + k]) + MOD[b * 6144 + k]; got = bf2f(((const bf16*)(ws + WS_H1))[(size_t)m * 1024 + k]); atol = 0.01f; } break;
    case 4: { const int m = h % MT, c = (h >> 15) % 32, mi = (m < M) ? (m >> 13) : 2; const float* row = (m < M) ? a.in[I_X] + (size_t)m * 1024 : a.in[I_CTX] + (size_t)(m - M) * 1024; const float rstd = naive_rstd(row);
        for (int k = 0; k < 1024; ++k) ref += (row[k] * rstd * a.in[I_N1G][k] * (1.f + MOD[mi * 6144 + 1024 + k]) + MOD[mi * 6144 + k]) * a.in[I_WIN][(size_t)k * DIN + 768 + c];
        got = ((const float*)(ws + WS_RB))[(size_t)m * 32 + c]; atol = 0.01f; } break;
    case 5: { const int r = h % 512, n = (h >> 9) % 768; const float* row = a.in[I_CTX] + (size_t)r * 1024; const float rstd = naive_rstd(row);
        for (int k = 0; k < 1024; ++k) ref += bfr(row[k] * rstd * a.in[I_N1G][k] * (1.f + MOD[2 * 6144 + 1024 + k]) + MOD[2 * 6144 + k]) * bf2f(((const bf16*)(ws + WS_WIN))[(size_t)n * 1024 + k]);
        got = (n < 256) ? bf2f(((const bf16*)(ws + WS_KB))[(size_t)(M + r) * 256 + n]) : bf2f(((const bf16*)(ws + WS_VB))[(size_t)(M + r) * 512 + n - 256]); atol = 0.03f; } break;
    case 6: { const int m = h % M, n = (h >> 14) % 4096; const bf16* hr = (const bf16*)(ws + WS_H1) + (size_t)m * 1024; const bf16* wr_ = (const bf16*)(ws + WS_WIN) + (size_t)n * 1024; float d = 0.f;
        if (n < 2048) { for (int k = 0; k < 1024; ++k) d += bf2f(hr[k]) * bf2f(wr_[k]); }
        else { for (int k = 0; k < 1024; ++k) d += f8d((ws + WS_H1F)[(size_t)m * 1024 + k]) * f8d((ws + WS_WINM)[(size_t)(n - 2048) * 1024 + k]); d *= 0.0625f; }
        if (n < 256) { ref = d; got = bf2f(((const bf16*)(ws + WS_KB))[(size_t)m * 256 + n]); }
        else if (n < 768) { ref = d; got = bf2f(((const bf16*)(ws + WS_VB))[(size_t)m * 512 + n - 256]); }
        else if (n < 1024) { ref = d * 0.125f; got = bf2f(((const bf16*)(ws + WS_QB))[(size_t)m * 256 + n - 768]); }
        else if (n < 1536) { ref = d / (1.f + expf(-d)); got = bf2f(((const bf16*)(ws + WS_SG))[(size_t)m * 512 + n - 1024]); }
        else if (n < 2048) { ref = d; got = bf2f(((const bf16*)(ws + WS_PI))[(size_t)m * 512 + n - 1536]); }
        else { ref = 1.f / (1.f + expf(-d)); got = gate_at(a, m, n - 2048); } atol = 0.02f; } break;
    case 7: { const int m = h % M, col = (h >> 14) % 256, dir = (h >> 22) & 1, t = m & 63, m0 = m - t;
        for (int s = 0; s < 64; ++s) if (dir ? (s >= t) : (s <= t)) ref += naive_la(a, m0 + s, dir, col);
        got = (dir ? a.out + (size_t)M * 256 : a.out)[(size_t)m * 256 + col]; atol = 0.003f; } break;
    case 8: case 9: { const int dir = h & 1, bh = (h >> 1) & 7, slot = (stage == 9) ? 128 + ((h >> 4) & 3) : ((h >> 4) & 127), dv = (h >> 11) & 127, dk = (h >> 18) & 63, b = bh >> 2, hh = bh & 3;
        const int row0 = (slot < 128) ? b * SEQ + slot * 64 : M + b * LC + (slot - 128) * 64; float la[64]; float tot = 0.f;
        for (int s = 0; s < 64; ++s) tot += naive_la(a, row0 + s, dir, hh * 64 + dk);
        float run = 0.f;
        if (!dir) { for (int s = 0; s < 64; ++s) { run += naive_la(a, row0 + s, 0, hh * 64 + dk); ref += bf2f(((const bf16*)(ws + WS_VB))[(size_t)(row0 + s) * 512 + hh * 128 + dv]) * bfr(bf2f(((const bf16*)(ws + WS_KB))[(size_t)(row0 + s) * 256 + hh * 64 + dk]) * expf(tot - run)); } }
        else { for (int s = 63; s >= 0; --s) { run += naive_la(a, row0 + s, 1, hh * 64 + dk); ref += bf2f(((const bf16*)(ws + WS_VB))[(size_t)(row0 + s) * 512 + hh * 128 + dv]) * bfr(bf2f(((const bf16*)(ws + WS_KB))[(size_t)(row0 + s) * 256 + hh * 64 + dk]) * expf(tot - run)); } }
        (void)la;
        if ((h >> 30) & 1) { ref = expf(tot); got = ((const float*)(ws + WS_DEC))[((size_t)(dir * 8 + bh) * NSLOT + slot) * 64 + dk]; atol = 1e-3f; }
        else { got = bf2f(((const bf16*)(ws + WS_KV))[((size_t)(dir * 8 + bh) * NSLOT + slot) * 8192 + dv * 64 + dk]); atol = 0.1f; } } break;
    case 10: { const int m = h % M, col = (h >> 14) % 512, g = col >> 7, half = 1 << g, b = m >> 13, l = m & 8191, r = l >> 6, c = l & 63; const bf16* PI = (const bf16*)(ws + WS_PI);
        const int lo_r = max(r - half, 0), hi_r = min(r + half, 128), lo_c = max(c - half, 0), hi_c = min(c + half, 64); float sm = 0.f;
        for (int rr = lo_r; rr < hi_r; ++rr) for (int cc = lo_c; cc < hi_c; ++cc) sm += bf2f(PI[(size_t)(b * SEQ + rr * 64 + cc) * 512 + col]);
        ref = sm / (float)((hi_r - lo_r) * (hi_c - lo_c)) - bf2f(PI[(size_t)m * 512 + col]); got = bf2f(((const bf16*)(ws + WS_PO))[(size_t)m * 512 + col]); atol = 0.02f; } break;
    case 11: { const int dir = h & 1, bh = (h >> 1) & 7, n = (h >> 4) & 127, e8 = (h >> 11) & 8191, dk = e8 & 63; float s = 0.f;
        const bf16* kvp = (const bf16*)(ws + WS_KV) + (size_t)((dir * 8 + bh) * NSLOT) * 8192 + e8; const float* dp = (const float*)(ws + WS_DEC) + (size_t)((dir * 8 + bh) * NSLOT) * 64 + dk;
        if (!dir) { for (int j = 128; j < 132; ++j) s = dp[j * 64] * s + bf2f(kvp[(size_t)j * 8192]); for (int j = 0; j < n; ++j) s = dp[j * 64] * s + bf2f(kvp[(size_t)j * 8192]); }
        else { for (int j = 131; j >= 128; --j) s = dp[j * 64] * s + bf2f(kvp[(size_t)j * 8192]); for (int j = 127; j > n; --j) s = dp[j * 64] * s + bf2f(kvp[(size_t)j * 8192]); }
        ref = s; got = bf2f(((const bf16*)(ws + WS_ST))[(size_t)((dir * 8 + bh) * NCH + n) * 8192 + e8]); atol = 0.1f; } break;
    case 12: {
        const unsigned hb = hashu(blockIdx.x * 7919u + 5u); const int m = hb % M, hh = (hb >> 14) & 3, b = m >> 13, l = m & 8191, n = l >> 6, t = l & 63, row0 = m - t, bh = b * 4 + hh, dv = threadIdx.x & 127;
        const float* BF = a.out; const float* CB = a.out + (size_t)M * 256; const bf16* QB = (const bf16*)(ws + WS_QB); const bf16* KB = (const bf16*)(ws + WS_KB); const bf16* VB = (const bf16*)(ws + WS_VB); const bf16* ST = (const bf16*)(ws + WS_ST);
        if (threadIdx.x < 128) { const int j = threadIdx.x & 63, dir = threadIdx.x >> 6; float sc = 0.f;
            const bool keep = dir ? (j >= t) : (j <= t);
            if (keep) for (int d = 0; d < 64; ++d) { const size_t gq = (size_t)m * 256 + hh * 64 + d, gk = (size_t)(row0 + j) * 256 + hh * 64 + d; const float* P = dir ? CB : BF; sc += bf2f(QB[gq]) * bf2f(KB[gk]) * expf(P[gq] - P[gk]); }
            sh[threadIdx.x] = sc; }
        __syncthreads();
        float o = 0.f;
        for (int d = 0; d < 64; ++d) { const size_t gq = (size_t)m * 256 + hh * 64 + d; const float q = bf2f(QB[gq]);
            o += q * expf(BF[gq]) * bf2f(ST[((size_t)((0 * 8 + bh) * NCH + n) * 128 + dv) * 64 + d]) + q * expf(CB[gq]) * bf2f(ST[((size_t)((1 * 8 + bh) * NCH + n) * 128 + dv) * 64 + d]); }
        for (int j = 0; j < 64; ++j) o += (sh[j] + sh[64 + j]) * bf2f(VB[(size_t)(row0 + j) * 512 + hh * 128 + dv]);
        __syncthreads(); sh[128 + dv] = o * o; __syncthreads();
        float ss = 0.f; for (int d = 0; d < 128; ++d) ss += sh[128 + d];
        const size_t gi = (size_t)m * 512 + hh * 128 + dv;
        ref = o * rsqrtf(ss / 128.f + EPS) * a.in[I_GNG][dv] * bf2f(((const bf16*)(ws + WS_SG))[gi]); got = bf2f(((const bf16*)(ws + WS_AG))[gi]); atol = 0.03f; } break;
    case 13: { const int m = h % M, n = (h >> 14) % 1024; float g = 0.f, p = 0.f; const bf16* AG = (const bf16*)(ws + WS_AG) + (size_t)m * 512; const bf16* PO = (const bf16*)(ws + WS_PO) + (size_t)m * 512;
        for (int k = 0; k < 512; ++k) { g += bf2f(AG[k]) * bf2f(((const bf16*)(ws + WS_WG))[(size_t)n * 512 + k]); p += bf2f(PO[k]) * bf2f(((const bf16*)(ws + WS_WC))[(size_t)n * 512 + k]); }
        ref = gate_at(a, m, n) * g + gate_at(a, m, 1024 + n) * p; got = bf2f(((const bf16*)(ws + WS_MG))[(size_t)m * 1024 + n]); atol = 0.03f; } break;
    case 14: { const int m = h % M, n = (h >> 14) % 1024, b = m >> 13; float d = 0.f; for (int k = 0; k < 1024; ++k) d += bf2f(((const bf16*)(ws + WS_MG))[(size_t)m * 1024 + k]) * bf2f(((const bf16*)(ws + WS_WO))[(size_t)n * 1024 + k]);
        ref = bfr(MOD[b * 6144 + 2048 + n] * d); got = bf2f(((const bf16*)(ws + WS_YD))[(size_t)m * 1024 + n]); atol = 0.005f; } break;
    case 15: { const int m = h % M, k = (h >> 14) % 1024, b = m >> 13; const float rstd = naive_rstd_x1(a, m);
        ref = x1_at(a, m, k) * rstd * a.in[I_N2G][k] * (1.f + MOD[b * 6144 + 4096 + k]) + MOD[b * 6144 + 3072 + k]; got = f8d((ws + WS_H2)[(size_t)m * 1024 + k]); atol = 0.02f; ref = f8r(ref); } break;
    case 16: { const int m = h % M, e = (h >> 14) & 15, b = m >> 13; const float rstd = naive_rstd_x1(a, m); float mx = -1e30f, mye = 0.f, sm = 0.f;
        for (int pass = 0; pass < 2; ++pass) for (int ee = 0; ee < 16; ++ee) { float lg = 0.f; for (int k = 0; k < 1024; ++k) lg += (x1_at(a, m, k) * rstd * a.in[I_N2G][k] * (1.f + MOD[b * 6144 + 4096 + k]) + MOD[b * 6144 + 3072 + k]) * a.in[I_WROUTER][k * 16 + ee];
            if (pass == 0) mx = fmaxf(mx, lg); else { const float ex = expf(lg - mx); sm += ex; if (ee == e) mye = ex; } }
        ref = mye / sm; got = ((const float*)(ws + WS_AFF))[(size_t)(b * 16 + e) * SEQ + (m & 8191)]; atol = 0.001f; } break;
    case 17: { const int be = h & 31, slot = (h >> 5) & 1023, b = be >> 4, e = be & 15; const int row = ((const int*)(ws + WS_IDX))[be * CAP + slot]; const float* aff = (const float*)(ws + WS_AFF) + (size_t)be * SEQ; float bad = 0.f;
        if (row < b * SEQ || row >= (b + 1) * SEQ) bad += 1.f; else { const int l = row & 8191; if (((const int*)(ws + WS_INV))[(size_t)row * 16 + e] != slot) bad += 1.f; if (((const float*)(ws + WS_WSEL))[be * CAP + slot] != aff[l]) bad += 1.f;
            int cnt = 0; for (int j = 0; j < SEQ; ++j) cnt += (aff[j] > aff[l]) ? 1 : 0; if (cnt >= CAP) bad += 1.f;
            const int l2 = h2 & 8191; if (((const int*)(ws + WS_INV))[(size_t)(b * SEQ + l2) * 16 + e] < 0) { int c2 = 0; for (int j = 0; j < SEQ; ++j) c2 += (aff[j] >= aff[l2]) ? 1 : 0; if (c2 <= CAP) bad += 1.f; } }
        ref = 0.f; got = bad; atol = 0.5f; } break;
    case 18: { const int e = h & 15, mat = (h >> 4) % 3, n = (h >> 8) & 1023, k = (h >> 18) & 1023;
        if (mat == 0) { ref = f8r(16.f * a.in[I_WGATE][(size_t)e * 1048576 + (size_t)k * 1024 + n]); got = f8d((ws + WS_WGU)[((size_t)e * 2048 + (n >> 7) * 256 + (n & 127)) * 1024 + k]); }
        else if (mat == 1) { ref = f8r(16.f * a.in[I_WUP][(size_t)e * 1048576 + (size_t)k * 1024 + n]); got = f8d((ws + WS_WGU)[((size_t)e * 2048 + (n >> 7) * 256 + 128 + (n & 127)) * 1024 + k]); }
        else { ref = f8r(16.f * a.in[I_WDOWN][(size_t)e * 1048576 + (size_t)k * 1024 + n]); got = f8d((ws + WS_WD)[((size_t)e * 1024 + n) * 1024 + k]); } atol = 1e-4f; } break;
    case 19: { const int be = h & 31, slot = (h >> 5) & 1023, f = (h >> 15) & 1023, e = be & 15; const int row = ((const int*)(ws + WS_IDX))[be * CAP + slot]; float g = 0.f, u = 0.f;
        const unsigned char* hr = ws + WS_H2 + (size_t)row * 1024; const unsigned char* wg = ws + WS_WGU + ((size_t)e * 2048 + (f >> 7) * 256 + (f & 127)) * 1024; const unsigned char* wu = wg + 128 * 1024;
        for (int k = 0; k < 1024; ++k) { g += f8d(hr[k]) * f8d(wg[k]); u += f8d(hr[k]) * f8d(wu[k]); }
        g *= 0.0625f; u *= 0.0625f; ref = g / (1.f + expf(-g)) * u; got = f8d((ws + WS_ACT)[((size_t)be * CAP + slot) * 1024 + f]); atol = 0.03f + 0.04f * fabsf(ref); } break;
    case 20: { const int be = h & 31, slot = (h >> 5) & 1023, n = (h >> 15) & 1023, e = be & 15, b = be >> 4; float d = 0.f;
        for (int f = 0; f < 1024; ++f) d += f8d((ws + WS_ACT)[((size_t)be * CAP + slot) * 1024 + f]) * f8d((ws + WS_WD)[((size_t)e * 1024 + n) * 1024 + f]);
        ref = d * 0.0625f * ((const float*)(ws + WS_WSEL))[be * CAP + slot] * MOD[b * 6144 + 5120 + n]; got = bf2f(((const bf16*)(ws + WS_YB))[((size_t)be * CAP + slot) * 1024 + n]); atol = 0.002f; } break;
    default: active = false;
    }
    if (active) { float e = fabsf(got - ref) / (atol + 0.03f * fabsf(ref)); if (!(e == e)) e = 1e9f; atomicMax((unsigned*)(ws + WS_CHK) + stage, __float_as_uint(e)); }
}
__global__ void chk_final(Args a) {
    __shared__ int code;
    if (threadIdx.x == 0) { int c = 0; for (int s = 20; s >= 0; --s) if (s > CHK_SKIP && __uint_as_float(((const unsigned*)(a.ws + WS_CHK))[s]) > 1.f) c = s + 1; code = c; }
    __syncthreads();
    const float sc = 1.f + 0.1f * (float)code;
    for (size_t i = (size_t)blockIdx.x * blockDim.x + threadIdx.x; i < (size_t)M * D; i += (size_t)gridDim.x * blockDim.x) a.out[i] *= sc;
}
#endif

extern "C" void kernel_launch(void* const* d_in, const int* in_sizes, int n_in, void* d_out, int out_size, void* d_ws, size_t ws_size, hipStream_t stream) {
    static int grid = 0;
    if (grid == 0) {
        if (n_in != 22 || out_size != M * D || ws_size < WS_END) { fprintf(stderr, "kernel_launch: unexpected shapes (n_in %d, out %d, ws %zu < %zu)\n", n_in, out_size, ws_size, (size_t)WS_END); grid = -1; return; }
        int dev = 0, cus = 0, per_cu = 0;
        if (hipGetDevice(&dev) != hipSuccess || hipDeviceGetAttribute(&cus, hipDeviceAttributeMultiprocessorCount, dev) != hipSuccess) { grid = -1; return; }
        if (hipFuncSetAttribute((const void*)fwd_kernel, hipFuncAttributeMaxDynamicSharedMemorySize, LDS_BYTES) != hipSuccess) { fprintf(stderr, "kernel_launch: hipFuncSetAttribute failed\n"); grid = -1; return; }
        if (hipOccupancyMaxActiveBlocksPerMultiprocessor(&per_cu, (const void*)fwd_kernel, NT, LDS_BYTES) != hipSuccess || per_cu < 1) { fprintf(stderr, "kernel_launch: occupancy query says %d\n", per_cu); per_cu = 1; }
        (void)hipGetLastError();
        grid = cus;
    }
    if (grid < 0) return;
    (void)hipMemsetAsync((char*)d_ws + WS_CTL, 0, CTL_ZERO_BYTES, stream);
    Args a{};
    for (int i = 0; i < 22; ++i) a.in[i] = (const float*)d_in[i];
    a.out = (float*)d_out; a.ws = (unsigned char*)d_ws;
    { static const int reps[8] = {PROBE_REPS}; for (int i = 0; i < 8; ++i) a.rep[i] = reps[i]; }
#if MK_MULTI
    for (int p = 0; p < NPHASE; ++p) { a.ph_lo = p; a.ph_hi = p + 1; hipLaunchKernelGGL(fwd_kernel, dim3(grid), dim3(NT), LDS_BYTES, stream, a);
#if MK_CHECK
        if (p == 0) (void)hipMemsetAsync((char*)d_ws + WS_CHK, 0, 4096, stream);
        static const int after[21] = {0, 0, 0, 1, 1, 1, 2, 3, 3, 3, 4, 4, 5, 6, 7, 8, 8, 9, 10, 11, 12};
        for (int st = 0; st < 21; ++st) if (after[st] == p) hipLaunchKernelGGL(chk_kernel, dim3(st == 12 ? 1024 : 32), dim3(128), 0, stream, a, st);
        if (p == NPHASE - 1) hipLaunchKernelGGL(chk_final, dim3(1024), dim3(256), 0, stream, a);
#endif
    }
#else
    a.ph_lo = 0; a.ph_hi = NPHASE;
#if MK_COOP
    void* kargs[] = {&a};
    hipError_t e = hipLaunchCooperativeKernel((const void*)fwd_kernel, dim3(grid), dim3(NT), kargs, LDS_BYTES, stream);
    if (e != hipSuccess) fprintf(stderr, "kernel_launch: cooperative launch failed: %s (grid %d)\n", hipGetErrorString(e), grid);
#else
    hipLaunchKernelGGL(fwd_kernel, dim3(grid), dim3(NT), LDS_BYTES, stream, a);
#endif
#endif
}
```

```cpp
#include <hip/hip_runtime.h>
#include <cstdio>
#include <cstdint>

#define LAS __attribute__((address_space(3)))
#define GAS __attribute__((address_space(1)))
typedef unsigned short bf16;
typedef short bf16x8 __attribute__((ext_vector_type(8)));
typedef float f32x4 __attribute__((ext_vector_type(4)));
typedef float f32x2 __attribute__((ext_vector_type(2)));
typedef unsigned u32x4 __attribute__((ext_vector_type(4)));
typedef unsigned u32x2 __attribute__((ext_vector_type(2)));

#ifndef ABL_NOMOE
#define ABL_NOMOE 0
#endif
#ifndef REP_PHASE
#define REP_PHASE -1
#endif
#ifndef PROBE_REPS
#define PROBE_REPS 1, 1, 1, 1, 1, 1, 1, 1, 1, 1, 1, 1
#endif
#ifndef REP_COUNT
#define REP_COUNT 1
#endif
#ifndef MK_COOP
#define MK_COOP 1
#endif
#ifndef MK_MULTI
#define MK_MULTI 0
#endif

constexpr int D = 1024, NB = 2, SEQ = 8192, M = NB * SEQ, LC = 256, MC = NB * LC, MT = M + MC;
constexpr int DIN = 4128;
constexpr int NCH = SEQ / 64, NCHC = LC / 64, NSLOT = NCH + NCHC;
constexpr int NE = 16, CAP = 1024;
constexpr float EPS = 1e-6f;
constexpr int NWAVES = 8, NT = 512;
constexpr int NPHASE = 13;

constexpr size_t MiB = 1u << 20;
constexpr size_t WS_CTL = 0, CTL_ZERO_BYTES = 64 * 1024;
constexpr size_t WS_MOD = 1 * MiB;
constexpr size_t WS_DEC = 1 * MiB + 128 * 1024;
constexpr size_t WS_WIN = 2 * MiB, WS_WO = 10 * MiB, WS_WG = 12 * MiB, WS_WC = 13 * MiB;
constexpr size_t WS_AFF = 14 * MiB, WS_INV = 15 * MiB, WS_IDX = 16 * MiB, WS_WSEL = 16 * MiB + 256 * 1024;
constexpr size_t WS_H1 = 20 * MiB;
constexpr size_t WS_ST = 20 * MiB, WS_H2 = 217 * MiB;
constexpr size_t WS_KB = 52 * MiB, WS_VB = 61 * MiB, WS_QB = 78 * MiB, WS_SG = 86 * MiB, WS_PI = 102 * MiB, WS_RB = 118 * MiB;
constexpr size_t WS_AG = 102 * MiB;
constexpr size_t WS_SM = 121 * MiB;
constexpr size_t WS_KV = 249 * MiB;
constexpr size_t WS_PO = 282 * MiB;
constexpr size_t WS_MG = 249 * MiB;
constexpr size_t WS_WGU = 185 * MiB, WS_WD = 52 * MiB, WS_ACT = 121 * MiB, WS_YB = 185 * MiB;
constexpr size_t WS_H1F = 153 * MiB;
constexpr size_t WS_WINM = 169 * MiB;
constexpr size_t WS_YD = 153 * MiB;
constexpr size_t WS_XS = 68 * MiB;
constexpr size_t WS_END = 300 * MiB;
constexpr int CW_BAR = 1024;

constexpr int LDS_BYTES = 155648;
constexpr int MISC_OFF = 153600;

#define LDS_WAIT() asm volatile("s_waitcnt lgkmcnt(0)" ::: "memory")
#define VM_WAIT() asm volatile("s_waitcnt vmcnt(0)" ::: "memory")
__device__ __forceinline__ unsigned f2bf(float f) { unsigned u = __builtin_bit_cast(unsigned, f); return (u + 0x7fffu + ((u >> 16) & 1u)) >> 16; }
__device__ __forceinline__ unsigned pk2(float lo, float hi) { return f2bf(lo) | (f2bf(hi) << 16); }
__device__ __forceinline__ float bf2f(unsigned h) { return __builtin_bit_cast(float, h << 16); }
__device__ __forceinline__ float bflo(unsigned w) { return __builtin_bit_cast(float, w << 16); }
__device__ __forceinline__ float bfhi(unsigned w) { return __builtin_bit_cast(float, w & 0xffff0000u); }
__device__ __forceinline__ unsigned cvt_pk_bf16(float lo, float hi) { unsigned r; asm volatile("v_cvt_pk_bf16_f32 %0, %1, %2" : "=v"(r) : "v"(lo), "v"(hi)); return r; }
__device__ __forceinline__ unsigned pk4_fp8(float a, float b, float c, float d) { int w = 0; w = __builtin_amdgcn_cvt_pk_fp8_f32(a, b, w, false); w = __builtin_amdgcn_cvt_pk_fp8_f32(c, d, w, true); return (unsigned)w; }
__device__ __forceinline__ float wave_sum(float v) {
#pragma unroll
    for (int o = 1; o < 64; o <<= 1) v += __shfl_xor(v, o);
    return v;
}
typedef _Float16 h16x2 __attribute__((ext_vector_type(2)));
__device__ __forceinline__ float hlo(unsigned w) { return (float)__builtin_bit_cast(h16x2, w)[0]; }
__device__ __forceinline__ float hhi(unsigned w) { return (float)__builtin_bit_cast(h16x2, w)[1]; }
__device__ __forceinline__ float silu_f(float x) { return x * __builtin_amdgcn_rcpf(1.f + __expf(-x)); }
__device__ __forceinline__ float sigmoid_f(float x) { return __builtin_amdgcn_rcpf(1.f + __expf(-x)); }
__device__ __forceinline__ float logsig_f(float z) { return fminf(z, 0.f) - log1pf(expf(-fabsf(z))); }

#define XB_TMO      128
#define XB_XCNT(j)  (256  + 64 * (j))
#define XB_XSUB(j)  (1280 + 64 * (j))
#define XB_XGEN(j)  (2304 + 64 * (j))
#define XB_TOP      3328
#define XB_TOPGEN   3392
#define XCD_BAR_WORDS 3456
#define XB_SPIN_CAP (1u << 20)
__device__ __forceinline__ unsigned xb_ld(unsigned* p)              { return __hip_atomic_load(p, __ATOMIC_RELAXED, __HIP_MEMORY_SCOPE_AGENT); }
__device__ __forceinline__ unsigned xb_add(unsigned* p, unsigned v) { return __hip_atomic_fetch_add(p, v, __ATOMIC_RELAXED, __HIP_MEMORY_SCOPE_AGENT); }
__device__ __forceinline__ unsigned xb_xcc_id() { return (unsigned)__builtin_amdgcn_s_getreg((3 << 11) | 20) & 0xFu; }
#define XB_SPIN(cond, bar) do { unsigned _sp = 0; while (cond) { __builtin_amdgcn_s_sleep(1); \
    if ((++_sp & 255u) == 0u) { if (xb_ld(&(bar)[XB_TMO])) break; if (_sp > XB_SPIN_CAP) { atomicAdd(&(bar)[XB_TMO], 1u); break; } } } } while (0)
struct XcdBarrier { unsigned* bar; unsigned x; volatile LAS unsigned* st; };
__device__ __forceinline__ XcdBarrier xcd_barrier_post(unsigned* bar, volatile LAS unsigned* st) {
    XcdBarrier b; b.bar = bar; b.x = xb_xcc_id(); b.st = st;
    if (threadIdx.x == 0) (void)xb_add(&bar[XB_XCNT(b.x)], 1u);
    return b;
}
__device__ __forceinline__ void xcd_barrier_complete(unsigned* bar, unsigned x, unsigned& nloc, unsigned& nx) {
    const unsigned G = gridDim.x * gridDim.y * gridDim.z;
    unsigned sum, cnt, mine, sp = 0u;
    for (;;) {
        sum = 0u; cnt = 0u; mine = 0u;
#pragma unroll
        for (unsigned j = 0; j < 16; ++j) { const unsigned c = xb_ld(&bar[XB_XCNT(j)]); sum += c; cnt += (c > 0u) ? 1u : 0u; mine = (j == x) ? c : mine; }
        if (sum == G) break;
        __builtin_amdgcn_s_sleep(1);
        if ((++sp & 255u) == 0u) { if (xb_ld(&bar[XB_TMO])) break; if (sp > XB_SPIN_CAP) { atomicAdd(&bar[XB_TMO], 1u); break; } }
    }
    nloc = mine > 0u ? mine : 1u; nx = cnt > 0u ? cnt : 1u;
}
__device__ __forceinline__ void xcd_barrier(const XcdBarrier& b) {
    asm volatile("s_waitcnt vmcnt(0)" ::: "memory");
    __syncthreads();
    if (threadIdx.x == 0) {
        unsigned* bar = b.bar;
        __builtin_amdgcn_s_waitcnt(0);
        unsigned nloc = b.st[0], nx = b.st[1];
        if (nloc == 0u) { xcd_barrier_complete(bar, b.x, nloc, nx); b.st[0] = nloc; b.st[1] = nx; }
        const unsigned old = xb_add(&bar[XB_XSUB(b.x)], 1u);
        const unsigned gen = old / nloc;
        if (old + 1u == (gen + 1u) * nloc) {
            __builtin_amdgcn_fence(__ATOMIC_RELEASE, "agent");
            asm volatile("s_waitcnt vmcnt(0)" ::: "memory");
            const unsigned og = xb_add(&bar[XB_TOP], 1u);
            const unsigned tg = og / nx;
            if (og + 1u == (tg + 1u) * nx) xb_add(&bar[XB_TOPGEN], 1u);
            else XB_SPIN(xb_ld(&bar[XB_TOPGEN]) == tg, bar);
            __builtin_amdgcn_fence(__ATOMIC_ACQUIRE, "agent");
            xb_add(&bar[XB_XGEN(b.x)], 1u);
            asm volatile("s_waitcnt vmcnt(0)" ::: "memory");
        } else {
            XB_SPIN(xb_ld(&bar[XB_XGEN(b.x)]) == gen, bar);
            __builtin_amdgcn_fence(__ATOMIC_ACQUIRE, "agent");
            asm volatile("s_waitcnt vmcnt(0)" ::: "memory");
        }
    }
    __syncthreads();
}

struct XbTicket { unsigned gen, tg, role; };
__device__ __forceinline__ XbTicket xcd_barrier_arrive(const XcdBarrier& b) {
    asm volatile("s_waitcnt vmcnt(0)" ::: "memory");
    __syncthreads();
    XbTicket t; t.gen = 0u; t.tg = 0u; t.role = 0u;
    if (threadIdx.x == 0) {
        unsigned* bar = b.bar;
        __builtin_amdgcn_s_waitcnt(0);
        unsigned nloc = b.st[0], nx = b.st[1];
        if (nloc == 0u) { xcd_barrier_complete(bar, b.x, nloc, nx); b.st[0] = nloc; b.st[1] = nx; }
        const unsigned old = xb_add(&bar[XB_XSUB(b.x)], 1u);
        t.gen = old / nloc;
        if (old + 1u == (t.gen + 1u) * nloc) {
            __builtin_amdgcn_fence(__ATOMIC_RELEASE, "agent");
            asm volatile("s_waitcnt vmcnt(0)" ::: "memory");
            const unsigned og = xb_add(&bar[XB_TOP], 1u);
            t.tg = og / nx;
            if (og + 1u == (t.tg + 1u) * nx) { xb_add(&bar[XB_TOPGEN], 1u); t.role = 2u; } else t.role = 1u;
        }
    }
    return t;
}
__device__ __forceinline__ void xcd_barrier_wait(const XcdBarrier& b, const XbTicket& t) {
    if (threadIdx.x == 0) {
        unsigned* bar = b.bar;
        if (t.role) {
            if (t.role == 1u) XB_SPIN(xb_ld(&bar[XB_TOPGEN]) == t.tg, bar);
            __builtin_amdgcn_fence(__ATOMIC_ACQUIRE, "agent");
            xb_add(&bar[XB_XGEN(b.x)], 1u);
            asm volatile("s_waitcnt vmcnt(0)" ::: "memory");
        } else {
            XB_SPIN(xb_ld(&bar[XB_XGEN(b.x)]) == t.gen, bar);
            __builtin_amdgcn_fence(__ATOMIC_ACQUIRE, "agent");
            asm volatile("s_waitcnt vmcnt(0)" ::: "memory");
        }
    }
    __syncthreads();
}

constexpr int CW_INPROJ = 11072, CW_PANEL5 = 11264, CW_PANEL6 = 12288, CW_PANEL7 = 13312;
__device__ __forceinline__ void panel_arrive(unsigned* ctl, int word) {
    if (threadIdx.x == 0) (void)__hip_atomic_fetch_add(ctl + word, 1u, __ATOMIC_RELAXED, __HIP_MEMORY_SCOPE_AGENT);
}
__device__ __forceinline__ void panel_wait(unsigned* ctl, int word, unsigned target) {
    if (threadIdx.x == 0) { unsigned* bar = ctl + CW_BAR; XB_SPIN(xb_ld(ctl + word) < target, bar); __builtin_amdgcn_fence(__ATOMIC_ACQUIRE, "agent"); asm volatile("s_waitcnt vmcnt(0)" ::: "memory"); }
    __syncthreads();
}

namespace pg8 {
constexpr int BM = 256, BK = 64, HALF = 128, HTB = HALF * BK * 2, STAGE_BYTES = 8 * HTB;
__device__ __forceinline__ int lds_byte(int r, int c) { const int st = (r >> 4) * 2 + (c >> 5), rr = r & 15, cc = c & 31, ob = rr * 64 + cc * 2; return st * 1024 + (ob ^ (((ob >> 9) & 1) << 5)); }
__device__ __forceinline__ void stage_rc(int b, int& R, int& C) { const int st = b / 1024, sb = b % 1024, swz = sb ^ (((sb >> 9) & 1) << 5); R = (st >> 1) * 16 + swz / 64; C = (st & 1) * 32 + (swz % 64) / 2; }
__device__ __forceinline__ int perm32(int rho) { const int n = rho >> 4, i = rho & 15; return 8 * (i >> 2) + 4 * n + (i & 3); }
struct Unit { int pm, pn, aux, keep; };
typedef int v8i __attribute__((ext_vector_type(8)));
typedef int v4i __attribute__((ext_vector_type(4)));
__device__ __forceinline__ void xcd_tile(int L, int nM, int nN, int& pm, int& pn) {
    const int nwg = nM * nN; int wgid = L;
    { const int q = nwg / 8, r = nwg % 8, xcd = wgid % 8, off = wgid / 8; wgid = (xcd < r ? xcd * (q + 1) : r * (q + 1) + (xcd - r) * q) + off; }
    const int nig = 8 * nN, gid = wgid / nig, fm = gid * 8, gsz = (nM - fm) < 8 ? (nM - fm) : 8;
    pm = fm + ((wgid % nig) % gsz); pn = (wgid % nig) / gsz;
}

template <class Epi, class Sched, bool GATHER, bool FP8 = false>
__device__ __forceinline__ void gemm_phase(LAS unsigned char* lds, const Sched& S, const Epi& E) {
    int tid = threadIdx.x; asm volatile("" : "+v"(tid));
    const int wid = __builtin_amdgcn_readfirstlane(tid >> 6), lane = tid & 63, wr = wid >> 2, wc = wid & 3, fr = lane & 15, fq = lane >> 4;
    const int K = S.K, KB = FP8 ? K : 2 * K, nt = KB / (2 * BK);
    unsigned voffA[2], voffB[2]; int Rs[2], Cb[2];
#pragma unroll
    for (int i = 0; i < 2; ++i) { int R, C; stage_rc(tid * 16 + i * 8192, R, C); const int Rb = Epi::PERM ? ((R & ~31) + perm32(R & 31)) : R;
        Rs[i] = R; Cb[i] = C * 2; voffA[i] = (unsigned)(R * KB + C * 2); voffB[i] = (unsigned)(Rb * KB + C * 2); }
    const size_t kstep = (size_t)(BK * 2);
    const size_t hstep = (size_t)HALF * KB;
    const size_t hstepA = GATHER ? 0 : hstep;
    const unsigned ldsw = (unsigned)wid * 1024u;
    const int aoff = FP8 ? lds_byte(wr * 64 + fr, fq * 16) : lds_byte(wr * 64 + fr, fq * 8), boff = FP8 ? lds_byte(wc * 32 + fr, fq * 16) : lds_byte(wc * 32 + fr, fq * 8);
#define PG8_SA(b, h) (((b) * 2 + (h)) * HTB)
#define PG8_SB(b, h) ((4 + (b) * 2 + (h)) * HTB)
#define PG8_STAGE(bufoff, gbase, voff, W) do { _Pragma("unroll") for (int _i = 0; _i < 2; ++_i) { \
        if constexpr (FP8) __builtin_amdgcn_raw_ptr_buffer_load_lds(rsrc##W, (LAS unsigned*)(lds + (bufoff) + ldsw + _i * 8192), 16, (int)(voff)[_i], (int)(unsigned)((const char*)(gbase) - base##W), 0, 0); \
        else __builtin_amdgcn_global_load_lds((const unsigned*)((const char*)(gbase) + (voff)[_i]), (LAS unsigned*)(lds + (bufoff) + ldsw + _i * 8192), 16, 0, 0); } } while (0)
#define PG8_LDA(dst, b, h) do { _Pragma("unroll") for (int m = 0; m < 4; ++m) { \
        if constexpr (FP8) { const v4i _lo = *(const LAS v4i*)(lds + PG8_SA(b, h) + aoff + m * 2048), _hi = *(const LAS v4i*)(lds + PG8_SA(b, h) + aoff + m * 2048 + 16); dst##8[m] = __builtin_shufflevector(_lo, _hi, 0, 1, 2, 3, 4, 5, 6, 7); } \
        else { _Pragma("unroll") for (int k = 0; k < 2; ++k) dst[m][k] = *(const LAS bf16x8*)(lds + PG8_SA(b, h) + aoff + m * 2048 + k * 1024); } } } while (0)
#define PG8_LDB(dst, b, h) do { _Pragma("unroll") for (int n = 0; n < 2; ++n) { \
        if constexpr (FP8) { const v4i _lo = *(const LAS v4i*)(lds + PG8_SB(b, h) + boff + n * 2048), _hi = *(const LAS v4i*)(lds + PG8_SB(b, h) + boff + n * 2048 + 16); dst##8[n] = __builtin_shufflevector(_lo, _hi, 0, 1, 2, 3, 4, 5, 6, 7); } \
        else { _Pragma("unroll") for (int k = 0; k < 2; ++k) dst[n][k] = *(const LAS bf16x8*)(lds + PG8_SB(b, h) + boff + n * 2048 + k * 1024); } } } while (0)
#define PG8_MMA(ai, bj, At, Bt) do { __builtin_amdgcn_s_setprio(1); \
        if constexpr (FP8) { _Pragma("unroll") for (int m = 0; m < 4; ++m) _Pragma("unroll") for (int n = 0; n < 2; ++n) \
            acc[ai][bj][m][n] = __builtin_amdgcn_mfma_scale_f32_16x16x128_f8f6f4(Bt##8[n], At##8[m], acc[ai][bj][m][n], 0, 0, 0, 0, 0, 0); } \
        else { _Pragma("unroll") for (int m = 0; m < 4; ++m) _Pragma("unroll") for (int n = 0; n < 2; ++n) _Pragma("unroll") for (int k = 0; k < 2; ++k) \
            acc[ai][bj][m][n] = __builtin_amdgcn_mfma_f32_16x16x32_bf16(Bt[n][k], At[m][k], acc[ai][bj][m][n], 0, 0, 0); } \
        __builtin_amdgcn_s_setprio(0); } while (0)
#define PG8_WAIT_V(n) asm volatile("s_waitcnt vmcnt(" #n ")" ::: "memory")
#define PG8_WAIT_L(n) asm volatile("s_waitcnt lgkmcnt(" #n ")" ::: "memory")
#define PG8_BAR __builtin_amdgcn_s_barrier()
#define PG8_SCHED __builtin_amdgcn_sched_barrier(0)
    Unit cur, nxt; int ui = 0;
    if (!S.next(0, cur)) return;
    const char* baseA = S.base_a(); const char* baseB = S.base_b();
    const __amdgpu_buffer_rsrc_t rsrcA = __builtin_amdgcn_make_buffer_rsrc((void*)baseA, 0, 0x7fffffff, 0x00020000), rsrcB = __builtin_amdgcn_make_buffer_rsrc((void*)baseB, 0, 0x7fffffff, 0x00020000);
    f32x4 acc[2][2][4][2];
#pragma unroll
    for (int a = 0; a < 2; ++a)
#pragma unroll
        for (int b = 0; b < 2; ++b)
#pragma unroll
            for (int m = 0; m < 4; ++m)
#pragma unroll
                for (int n = 0; n < 2; ++n) acc[a][b][m][n] = (f32x4){0.f, 0.f, 0.f, 0.f};
    bf16x8 At[4][2], B0[2][2], B1[2][2]; v8i At8[4], B08[2], B18[2];
    const char* cA = S.a_base(cur); const char* cB = S.b_base(cur);
    unsigned cv0[2], cv1[2], nv0[2], nv1[2]; unsigned cvp[2] = {0u, 0u}, nvp[2] = {0u, 0u};
#define PG8_GROWS(dst, u_) do { int t_ = threadIdx.x; asm volatile("" : "+v"(t_)); _Pragma("unroll") for (int i = 0; i < 2; ++i) { int R_, C_; stage_rc(t_ * 16 + i * 8192, R_, C_); \
        dst[i] = (unsigned)S.a_row(u_, R_) | ((unsigned)S.a_row(u_, HALF + R_) << 16); } } while (0)
#define PG8_GOFF(o, pk, h) do { _Pragma("unroll") for (int i = 0; i < 2; ++i) o[i] = (((pk)[i] >> (16 * (h))) & 0xffffu) * (unsigned)KB + (unsigned)Cb[i]; } while (0)
    if constexpr (GATHER) { PG8_GROWS(cvp, cur); nvp[0] = cvp[0]; nvp[1] = cvp[1]; PG8_GOFF(cv0, cvp, 0); PG8_GOFF(cv1, cvp, 1); }
    else {
#pragma unroll
        for (int i = 0; i < 2; ++i) { cv0[i] = voffA[i]; cv1[i] = voffA[i]; nv0[i] = cv0[i]; nv1[i] = cv1[i]; }
    }
    PG8_STAGE(PG8_SB(0, 0), cB, voffB, B); PG8_STAGE(PG8_SB(0, 1), cB + hstep, voffB, B); PG8_STAGE(PG8_SA(0, 0), cA, cv0, A); PG8_STAGE(PG8_SA(0, 1), cA + hstepA, cv1, A);
    if (wr == 1) PG8_BAR;
    PG8_WAIT_V(2); PG8_BAR;
    PG8_STAGE(PG8_SB(1, 0), cB + kstep, voffB, B); PG8_STAGE(PG8_SA(1, 0), cA + kstep, cv0, A); PG8_STAGE(PG8_SB(1, 1), cB + hstep + kstep, voffB, B);
    PG8_WAIT_V(6); PG8_BAR;
    for (;;) {
        const bool has_next = S.next(ui + 1, nxt);
        const char* nA = has_next ? S.a_base(nxt) : cA; const char* nB = has_next ? S.b_base(nxt) : cB;
        if constexpr (GATHER) { if (has_next) PG8_GROWS(nvp, nxt); }
        for (int t = 0; t < nt; t += 2) {
            const bool last = (t == nt - 2);
            const char* a1 = cA + (size_t)(t + 1) * kstep;
            const char* a2 = last ? nA : cA + (size_t)(t + 2) * kstep; const char* b2 = last ? nB : cB + (size_t)(t + 2) * kstep;
            const char* a3 = a2 + kstep; const char* b3 = b2 + kstep;
            unsigned s0[2], s1[2];
            if constexpr (!GATHER) {
#pragma unroll
                for (int i = 0; i < 2; ++i) { s0[i] = cv0[i]; s1[i] = cv1[i]; }
            }
            PG8_LDB(B0, 0, 0); PG8_LDB(B1, 0, 1); PG8_SCHED; PG8_LDA(At, 0, 0); if constexpr (GATHER) { PG8_GOFF(s1, cvp, 1); PG8_STAGE(PG8_SA(1, 1), a1, s1, A); } else PG8_STAGE(PG8_SA(1, 1), a1 + hstepA, cv1, A);
            PG8_WAIT_V(8); PG8_WAIT_L(0); PG8_BAR; PG8_MMA(0, 0, At, B0); PG8_MMA(0, 1, At, B1); PG8_BAR; PG8_SCHED;
            PG8_LDA(At, 0, 1); PG8_STAGE(PG8_SB(0, 0), b2, voffB, B); PG8_STAGE(PG8_SB(0, 1), b2 + hstep, voffB, B); if constexpr (GATHER) { if (last) { cvp[0] = nvp[0]; cvp[1] = nvp[1]; } PG8_GOFF(s0, cvp, 0); } PG8_STAGE(PG8_SA(0, 0), a2, s0, A);
            PG8_WAIT_V(8); PG8_WAIT_L(0); PG8_BAR; PG8_MMA(1, 0, At, B0); PG8_MMA(1, 1, At, B1); PG8_BAR; PG8_SCHED;
            PG8_LDB(B0, 1, 0); PG8_LDB(B1, 1, 1); PG8_SCHED; PG8_LDA(At, 1, 0); if constexpr (GATHER) PG8_GOFF(s1, cvp, 1); PG8_STAGE(PG8_SA(0, 1), a2 + hstepA, s1, A);
            PG8_WAIT_V(8); PG8_WAIT_L(0); PG8_BAR; PG8_MMA(0, 0, At, B0); PG8_MMA(0, 1, At, B1); PG8_BAR; PG8_SCHED;
            PG8_LDA(At, 1, 1); PG8_STAGE(PG8_SB(1, 0), b3, voffB, B); PG8_STAGE(PG8_SB(1, 1), b3 + hstep, voffB, B); if constexpr (GATHER) PG8_GOFF(s0, cvp, 0); PG8_STAGE(PG8_SA(1, 0), a3, s0, A);
            PG8_WAIT_V(8); PG8_WAIT_L(0); PG8_BAR; PG8_MMA(1, 0, At, B0); PG8_MMA(1, 1, At, B1); PG8_BAR; PG8_SCHED;
        }
        if (wr == 0) PG8_BAR;
        E(acc, cur, wr, wc, fr, fq);
        if (!has_next) break;
        E.post(acc, cur, wr, wc, fr, fq);
        cur = nxt; cA = nA; cB = nB; ++ui;
#pragma unroll
        for (int i = 0; i < 2; ++i) { if constexpr (!GATHER) { cv0[i] = nv0[i]; cv1[i] = nv1[i]; } }
        if (wr == 1) PG8_BAR;
    }
    PG8_WAIT_V(0);
    PG8_BAR;
#undef PG8_SA
#undef PG8_SB
#undef PG8_STAGE
#undef PG8_LDA
#undef PG8_LDB
#undef PG8_MMA
#undef PG8_WAIT_V
#undef PG8_WAIT_L
#undef PG8_BAR
#undef PG8_SCHED
#undef PG8_GROWS
#undef PG8_GOFF
}
}

using pg8::Unit;
struct SchedDense {
    int G, c, K, nM, nN; const char* A; const char* B; int i0, i1, eb;
    __device__ __forceinline__ bool next(int i, Unit& u) const { const int L = (i + i0) * G + c; if (i + i0 >= i1 || L >= nM * nN) return false; pg8::xcd_tile(L, nM, nN, u.pm, u.pn); u.aux = 0; u.keep = 0; return true; }
    __device__ __forceinline__ const char* a_base(const Unit& u) const { return A + (size_t)u.pm * 256 * K * eb; }
    __device__ __forceinline__ const char* b_base(const Unit& u) const { return B + (size_t)u.pn * 256 * K * eb; }
    __device__ __forceinline__ int a_row(const Unit&, int) const { return 0; }
    __device__ __forceinline__ const char* base_a() const { return A; }
    __device__ __forceinline__ const char* base_b() const { return B; }
};
struct SchedPair {
    int G, c, K; const char *A0, *A1, *B0, *B1;
    __device__ __forceinline__ bool next(int i, Unit& u) const { const int p = (i >> 1) * G + c; if (p >= 256) return false; pg8::xcd_tile(p, 64, 4, u.pm, u.pn); u.aux = i & 1; u.keep = 0; return true; }
    __device__ __forceinline__ const char* a_base(const Unit& u) const { return (u.aux ? A1 : A0) + (size_t)u.pm * 256 * K * 2; }
    __device__ __forceinline__ const char* b_base(const Unit& u) const { return (u.aux ? B1 : B0) + (size_t)u.pn * 256 * K * 2; }
    __device__ __forceinline__ int a_row(const Unit&, int) const { return 0; }
    __device__ __forceinline__ const char* base_a() const { return A0; }
    __device__ __forceinline__ const char* base_b() const { return B0; }
};
struct SchedMoe1 {
    int G, c, K; const char* A; const char* B; int i0, i1;
    __device__ __forceinline__ bool next(int i, Unit& u) const { const int L = (i + i0) * G + c; if (i + i0 >= i1 || L >= 1024) return false;
        const int xcd = L & 7, q = L >> 3, round = q >> 5, slot = q & 31, e = xcd + 8 * (round >> 1), u64 = (round & 1) * 32 + slot, mrow = u64 & 7;
        u.pn = u64 >> 3; u.pm = mrow & 3; u.aux = (mrow >> 2) * 16 + e; u.keep = 0; return true; }
    __device__ __forceinline__ const char* a_base(const Unit& u) const { return A + ((size_t)u.aux * 1024 + (size_t)u.pm * 256) * K; }
    __device__ __forceinline__ const char* b_base(const Unit& u) const { return B + ((size_t)(u.aux & 15) * 2048 + (size_t)u.pn * 256) * K; }
    __device__ __forceinline__ int a_row(const Unit&, int) const { return 0; }
    __device__ __forceinline__ const char* base_a() const { return A; }
    __device__ __forceinline__ const char* base_b() const { return B; }
};
struct SchedMoe1G {
    int G, c, K; const char* A; const char* B; const int* idx;
    __device__ __forceinline__ bool next(int i, Unit& u) const { const int L = i * G + c; if (L >= 1024) return false;
        const int xcd = L & 7, q = L >> 3, round = q >> 5, slot = q & 31, e = xcd + 8 * (round >> 1), u64 = (round & 1) * 32 + slot, mrow = u64 & 7;
        u.pn = u64 >> 3; u.pm = mrow & 3; u.aux = (mrow >> 2) * 16 + e; u.keep = 0; return true; }
    __device__ __forceinline__ const char* a_base(const Unit&) const { return A; }
    __device__ __forceinline__ const char* b_base(const Unit& u) const { return B + ((size_t)(u.aux & 15) * 2048 + (size_t)u.pn * 256) * K; }
    __device__ __forceinline__ int a_row(const Unit& u, int r) const { return idx[u.aux * 1024 + u.pm * 256 + r]; }
    __device__ __forceinline__ const char* base_a() const { return A; }
    __device__ __forceinline__ const char* base_b() const { return B; }
};
struct SchedMoe2 {
    int G, c, K; const char* A; const char* B;
    __device__ __forceinline__ bool next(int i, Unit& u) const { const int L = i * G + c; if (L >= 512) return false;
        const int xcd = L & 7, q = L >> 3, round = q >> 5, slot = q & 31, e = xcd + 8 * round, mrow = slot & 7;
        u.pn = slot >> 3; u.pm = mrow & 3; u.aux = (mrow >> 2) * 16 + e; u.keep = 0; return true; }
    __device__ __forceinline__ const char* a_base(const Unit& u) const { return A + ((size_t)u.aux * 1024 + (size_t)u.pm * 256) * K; }
    __device__ __forceinline__ const char* b_base(const Unit& u) const { return B + ((size_t)(u.aux & 15) * 1024 + (size_t)u.pn * 256) * K; }
    __device__ __forceinline__ int a_row(const Unit&, int) const { return 0; }
    __device__ __forceinline__ const char* base_a() const { return A; }
    __device__ __forceinline__ const char* base_b() const { return B; }
};

typedef f32x4 AccT[2][2][4][2];
__device__ __forceinline__ size_t gate_off(int pm, int pg, int ai, int m, int bj, int wr, int wc, int fr, int fq) { return ((size_t)(pm * 8 + pg) << 16) + (size_t)((((ai * 4 + m) * 2 + bj) * 8 + wr * 4 + wc) * 512 + (fq * 16 + fr) * 8); }
__device__ __forceinline__ unsigned pk4_u8(float a, float b, float c, float d) { return (unsigned)__builtin_amdgcn_cvt_pk_u8_f32(d, 3, __builtin_amdgcn_cvt_pk_u8_f32(c, 2, __builtin_amdgcn_cvt_pk_u8_f32(b, 1, __builtin_amdgcn_cvt_pk_u8_f32(a, 0, 0u)))); }
template <bool GATES> struct EpiInprojT {
    static constexpr bool PERM = true;
    bf16 *KBp, *VBp, *QBp, *SGp, *PIp; unsigned char* SMp; int pn_off; float sc;
    __device__ __forceinline__ void post(AccT& acc, const Unit&, int, int, int, int) const {
#pragma unroll
        for (int a = 0; a < 2; ++a)
#pragma unroll
            for (int b = 0; b < 2; ++b)
#pragma unroll
                for (int m = 0; m < 4; ++m)
#pragma unroll
                    for (int n = 0; n < 2; ++n) acc[a][b][m][n] = (f32x4){0.f, 0.f, 0.f, 0.f};
    }
    __device__ __forceinline__ void operator()(const AccT& acc, const Unit& u, int wr, int wc, int fr, int fq) const {
        const int pn = u.pn + pn_off;
        if constexpr (GATES) {
            unsigned lb = (unsigned)((wr * 4 + wc) * 512 + (fq * 16 + fr) * 8); asm volatile("" : "+v"(lb));
            unsigned char* tp = SMp + ((size_t)(u.pm * 8 + pn - 8) << 16) + lb;
            const float ksc = -1.4426950408889634f * sc, c255 = -7.994353436858858f, r255 = 1.f / 255.f;
#define EPG(v_) __builtin_amdgcn_rcpf(r255 + __builtin_amdgcn_exp2f(__builtin_fmaf((v_), ksc, c255)))
#pragma unroll
            for (int ai = 0; ai < 2; ++ai)
#pragma unroll
                for (int m = 0; m < 4; ++m) {
#pragma unroll
                    for (int bj = 0; bj < 2; ++bj) { const f32x4 v0 = acc[ai][bj][m][0], v1 = acc[ai][bj][m][1];
                        u32x2 w; w.x = pk4_u8(EPG(v0[0]), EPG(v0[1]), EPG(v0[2]), EPG(v0[3])); w.y = pk4_u8(EPG(v1[0]), EPG(v1[1]), EPG(v1[2]), EPG(v1[3]));
                        *(u32x2*)(tp + (((ai * 4 + m) * 2 + bj) * 4096)) = w; }
                    asm volatile("" ::: "memory"); }
#undef EPG
        } else {
        bf16* base; int ld, colt, act;
        if (pn == 0) { base = KBp; ld = 256; colt = 0; act = 0; }
        else if (pn < 3) { base = VBp; ld = 512; colt = (pn - 1) * 256; act = 0; }
        else if (pn == 3) { base = QBp; ld = 256; colt = 0; act = 3; }
        else if (pn < 6) { base = SGp; ld = 512; colt = (pn - 4) * 256; act = 1; }
        else { base = PIp; ld = 512; colt = (pn - 6) * 256; act = 0; }
        const int row0 = u.pm * 256 + wr * 64 + fr, col0 = colt + wc * 32 + 8 * fq;
        const __amdgpu_buffer_rsrc_t rsO = __builtin_amdgcn_make_buffer_rsrc((void*)base, 0, 0x7fffffff, 0x00020000);
#pragma unroll
        for (int ai = 0; ai < 2; ++ai)
#pragma unroll
            for (int m = 0; m < 4; ++m) { const unsigned rowo = (unsigned)(((size_t)(row0 + ai * 128 + m * 16) * ld + col0) * 2);
#pragma unroll
                for (int bj = 0; bj < 2; ++bj) { f32x4 v0 = acc[ai][bj][m][0], v1 = acc[ai][bj][m][1];
                    if (act == 1) {
#pragma unroll
                        for (int j = 0; j < 4; ++j) { v0[j] = silu_f(v0[j]); v1[j] = silu_f(v1[j]); } }
                    else if (act == 3) { v0 = v0 * 0.125f; v1 = v1 * 0.125f; }
                    u32x4 w; w.x = cvt_pk_bf16(v0[0], v0[1]); w.y = cvt_pk_bf16(v0[2], v0[3]); w.z = cvt_pk_bf16(v1[0], v1[1]); w.w = cvt_pk_bf16(v1[2], v1[3]);
                    __builtin_amdgcn_raw_buffer_store_b128(w, rsO, rowo + bj * 256, 0,   16); } }
        }
    }
};
typedef EpiInprojT<false> EpiInproj; typedef EpiInprojT<true> EpiGates;
struct EpiMerge {
    static constexpr bool PERM = true;
    const unsigned char* SMp; bf16* MGp;
    __device__ __forceinline__ void post(AccT& acc, const Unit& u, int wr, int wc, int fr, int fq) const {
        const unsigned msk = u.aux ? 0u : 0xffffffffu;
        u32x2 ga[2][2], gb[2][2];
#define EPM_LOADR(buf, g) do { _Pragma("unroll") for (int bj = 0; bj < 2; ++bj) { ga[buf][bj] = *(const u32x2*)(SMp + gate_off(u.pm, u.pn, (g) >> 2, (g) & 3, bj, wr, wc, fr, fq)); \
            gb[buf][bj] = *(const u32x2*)(SMp + gate_off(u.pm, u.pn + 4, (g) >> 2, (g) & 3, bj, wr, wc, fr, fq)); } } while (0)
#define EPM_RATIO(a_, b_, sh) ((float)(((a_) >> (sh)) & 255u) * __builtin_amdgcn_rcpf((float)max(((b_) >> (sh)) & 255u, 1u)))
        EPM_LOADR(0, 0);
#pragma unroll
        for (int g = 0; g < 8; ++g) {
            if (g + 1 < 8) EPM_LOADR((g + 1) & 1, g + 1);
            asm volatile("" ::: "memory");
#pragma unroll
            for (int bj = 0; bj < 2; ++bj) { u32x2 p = ga[g & 1][bj]; const u32x2 q = gb[g & 1][bj]; p.x &= msk; p.y &= msk; f32x4 v0 = acc[g >> 2][bj][g & 3][0], v1 = acc[g >> 2][bj][g & 3][1];
                v0[0] *= EPM_RATIO(p.x, q.x, 0); v0[1] *= EPM_RATIO(p.x, q.x, 8); v0[2] *= EPM_RATIO(p.x, q.x, 16); v0[3] *= EPM_RATIO(p.x, q.x, 24);
                v1[0] *= EPM_RATIO(p.y, q.y, 0); v1[1] *= EPM_RATIO(p.y, q.y, 8); v1[2] *= EPM_RATIO(p.y, q.y, 16); v1[3] *= EPM_RATIO(p.y, q.y, 24);
                acc[g >> 2][bj][g & 3][0] = v0; acc[g >> 2][bj][g & 3][1] = v1; }
            asm volatile("" ::: "memory"); }
#undef EPM_LOADR
#undef EPM_RATIO
    }
    __device__ __forceinline__ void operator()(const AccT& acc, const Unit& u, int wr, int wc, int fr, int fq) const {
        if (!u.aux) return;
        const int row0 = u.pm * 256 + wr * 64 + fr, col0 = u.pn * 256 + wc * 32 + 8 * fq;
        u32x2 gb[2][2];
        const __amdgpu_buffer_rsrc_t rsMG = __builtin_amdgcn_make_buffer_rsrc((void*)MGp, 0, 0x7fffffff, 0x00020000);
#define EPM_ROW(g) ((size_t)(row0 + ((g) >> 2) * 128 + ((g) & 3) * 16))
#define EPM_LOAD(buf, g) do { _Pragma("unroll") for (int bj = 0; bj < 2; ++bj) gb[buf][bj] = *(const u32x2*)(SMp + gate_off(u.pm, u.pn + 4, (g) >> 2, (g) & 3, bj, wr, wc, fr, fq)); } while (0)
        EPM_LOAD(0, 0);
#pragma unroll
        for (int g = 0; g < 8; ++g) {
            if (g + 1 < 8) EPM_LOAD((g + 1) & 1, g + 1);
            asm volatile("" ::: "memory");
#pragma unroll
            for (int bj = 0; bj < 2; ++bj) { const u32x2 gq = gb[g & 1][bj]; const f32x4 v0 = acc[g >> 2][bj][g & 3][0], v1 = acc[g >> 2][bj][g & 3][1];
                const float k = 1.f / 255.f;
                const float g0 = k * (float)max(gq.x & 255u, 1u), g1 = k * (float)max((gq.x >> 8) & 255u, 1u), g2 = k * (float)max((gq.x >> 16) & 255u, 1u), g3 = k * (float)max(gq.x >> 24, 1u);
                const float g4 = k * (float)max(gq.y & 255u, 1u), g5 = k * (float)max((gq.y >> 8) & 255u, 1u), g6 = k * (float)max((gq.y >> 16) & 255u, 1u), g7 = k * (float)max(gq.y >> 24, 1u);
                u32x4 w; w.x = cvt_pk_bf16(v0[0] * g0, v0[1] * g1); w.y = cvt_pk_bf16(v0[2] * g2, v0[3] * g3);
                w.z = cvt_pk_bf16(v1[0] * g4, v1[1] * g5); w.w = cvt_pk_bf16(v1[2] * g6, v1[3] * g7);
                __builtin_amdgcn_raw_buffer_store_b128(w, rsMG, (unsigned)((EPM_ROW(g) * 1024 + col0 + bj * 128) * 2), 0,   16); }
            asm volatile("" ::: "memory"); }
#undef EPM_ROW
#undef EPM_LOAD
    }
};
struct EpiOut {
    static constexpr bool PERM = true;
    const float* MODp; bf16* YDp;
    __device__ __forceinline__ void post(AccT& acc, const Unit&, int, int, int, int) const {
#pragma unroll
        for (int a = 0; a < 2; ++a)
#pragma unroll
            for (int b = 0; b < 2; ++b)
#pragma unroll
                for (int m = 0; m < 4; ++m)
#pragma unroll
                    for (int n = 0; n < 2; ++n) acc[a][b][m][n] = (f32x4){0.f, 0.f, 0.f, 0.f};
    }
    __device__ __forceinline__ void operator()(const AccT& acc, const Unit& u, int wr, int wc, int fr, int fq) const {
        const int row0 = u.pm * 256 + wr * 64 + fr, col0 = u.pn * 256 + wc * 32 + 8 * fq;
        const float* gt = MODp + (size_t)(u.pm >> 5) * 6144 + 2048 + col0;
        f32x4 gv[2][2];
        const __amdgpu_buffer_rsrc_t rsYD = __builtin_amdgcn_make_buffer_rsrc((void*)YDp, 0, 0x7fffffff, 0x00020000);
#pragma unroll
        for (int bj = 0; bj < 2; ++bj)
#pragma unroll
            for (int n = 0; n < 2; ++n) gv[bj][n] = *(const f32x4*)(gt + bj * 128 + n * 4);
#pragma unroll
        for (int ai = 0; ai < 2; ++ai)
#pragma unroll
            for (int m = 0; m < 4; ++m) { const unsigned rowo = (unsigned)(((size_t)(row0 + ai * 128 + m * 16) * 1024 + col0) * 2);
#pragma unroll
                for (int bj = 0; bj < 2; ++bj) { const f32x4 v0 = acc[ai][bj][m][0] * gv[bj][0], v1 = acc[ai][bj][m][1] * gv[bj][1];
                    u32x4 w; w.x = cvt_pk_bf16(v0[0], v0[1]); w.y = cvt_pk_bf16(v0[2], v0[3]); w.z = cvt_pk_bf16(v1[0], v1[1]); w.w = cvt_pk_bf16(v1[2], v1[3]);
                    __builtin_amdgcn_raw_buffer_store_b128(w, rsYD, rowo + bj * 256, 0,   16); } }
    }
};
struct EpiMoe1 {
    static constexpr bool PERM = true;
    unsigned char* ACTp;
    __device__ __forceinline__ void post(AccT& acc, const Unit&, int, int, int, int) const {
#pragma unroll
        for (int a = 0; a < 2; ++a)
#pragma unroll
            for (int b = 0; b < 2; ++b)
#pragma unroll
                for (int m = 0; m < 4; ++m)
#pragma unroll
                    for (int n = 0; n < 2; ++n) acc[a][b][m][n] = (f32x4){0.f, 0.f, 0.f, 0.f};
    }
    __device__ __forceinline__ void operator()(const AccT& acc, const Unit& u, int wr, int wc, int fr, int fq) const {
        const int row0 = u.aux * 1024 + u.pm * 256 + wr * 64 + fr, col0 = u.pn * 128 + wc * 32 + 8 * fq;
#pragma unroll
        for (int ai = 0; ai < 2; ++ai)
#pragma unroll
            for (int m = 0; m < 4; ++m) { unsigned char* rowp = ACTp + (size_t)(row0 + ai * 128 + m * 16) * 1024 + col0;
                f32x4 a0, a1;
#pragma unroll
                for (int j = 0; j < 4; ++j) {
                    const float g0 = acc[ai][0][m][0][j], g1 = acc[ai][0][m][1][j];
                    a0[j] = g0 * acc[ai][1][m][0][j] * __builtin_amdgcn_rcpf(256.f + __builtin_amdgcn_exp2f(__builtin_fmaf(g0, -0.09016844005556021f, 8.f)));
                    a1[j] = g1 * acc[ai][1][m][1][j] * __builtin_amdgcn_rcpf(256.f + __builtin_amdgcn_exp2f(__builtin_fmaf(g1, -0.09016844005556021f, 8.f))); }
                *(u32x2*)rowp = (u32x2){pk4_fp8(a0[0], a0[1], a0[2], a0[3]), pk4_fp8(a1[0], a1[1], a1[2], a1[3])}; }
    }
};
struct EpiMoe2 {
    static constexpr bool PERM = true;
    bf16* YBp; const float* WSELp; const float* MODp;
    __device__ __forceinline__ void post(AccT& acc, const Unit&, int, int, int, int) const {
#pragma unroll
        for (int a = 0; a < 2; ++a)
#pragma unroll
            for (int b = 0; b < 2; ++b)
#pragma unroll
                for (int m = 0; m < 4; ++m)
#pragma unroll
                    for (int n = 0; n < 2; ++n) acc[a][b][m][n] = (f32x4){0.f, 0.f, 0.f, 0.f};
    }
    __device__ __forceinline__ void operator()(const AccT& acc, const Unit& u, int wr, int wc, int fr, int fq) const {
        const int row0 = u.aux * 1024 + u.pm * 256 + wr * 64 + fr, col0 = u.pn * 256 + wc * 32 + 8 * fq;
        const float* gt = MODp + (size_t)(u.aux >> 4) * 6144 + 5120 + col0;
        f32x4 gv[2][2];
#pragma unroll
        for (int bj = 0; bj < 2; ++bj)
#pragma unroll
            for (int n = 0; n < 2; ++n) gv[bj][n] = *(const f32x4*)(gt + bj * 128 + n * 4);
#pragma unroll
        for (int ai = 0; ai < 2; ++ai)
#pragma unroll
            for (int m = 0; m < 4; ++m) { const int r = row0 + ai * 128 + m * 16; const float ws = WSELp[r]; unsigned char* rowp = (unsigned char*)YBp + (size_t)r * 1024 + col0;
#pragma unroll
                for (int bj = 0; bj < 2; ++bj) { const f32x4 v0 = acc[ai][bj][m][0] * gv[bj][0] * ws, v1 = acc[ai][bj][m][1] * gv[bj][1] * ws;
                    *(u32x2*)(rowp + bj * 128) = (u32x2){pk4_fp8(v0[0], v0[1], v0[2], v0[3]), pk4_fp8(v1[0], v1[1], v1[2], v1[3])}; } }
    }
};

struct Args { const float* in[22]; float* out; unsigned char* ws; int ph_lo, ph_hi; int rep[12]; };
enum { I_X = 0, I_C, I_CTX, I_CCTX, I_ADAW, I_ADAB, I_N1G, I_N2G, I_WIN, I_WDU, I_BDEC, I_GNG, I_WGLA, I_POOLW, I_POOLS, I_WPOOL, I_WOUT, I_WROUTER, I_WGATE, I_WUP, I_WDOWN, I_FNG };

__device__ __forceinline__ bf16x8 ldfrag(const LAS bf16* base, int stride, int row0, int k0, int lane) { return *(const LAS bf16x8*)(base + (row0 + (lane & 15)) * stride + k0 + 8 * (lane >> 4)); }
#define MFMA16(a, b, c) __builtin_amdgcn_mfma_f32_16x16x32_bf16(a, b, c, 0, 0, 0)

__device__ __forceinline__ void transpose_item(const float* W, int ldw, int k0, int nsrc0, bf16* WT, int Kd, int dst_row0, LAS float* scr, int lane) {
#pragma unroll 8
    for (int i = 0; i < 32; ++i) { const int kk = 2 * i + (lane >> 5); scr[kk * 33 + (lane & 31)] = W[(size_t)(k0 + kk) * ldw + nsrc0 + (lane & 31)]; }
    LDS_WAIT(); asm volatile("" ::: "memory");
    const int c = lane & 7;
#pragma unroll
    for (int j = 0; j < 4; ++j) { const int n = (lane >> 3) + 8 * j; const LAS float* s = scr + (8 * c) * 33 + n;
        u32x4 o; o.x = pk2(s[0 * 33], s[1 * 33]); o.y = pk2(s[2 * 33], s[3 * 33]); o.z = pk2(s[4 * 33], s[5 * 33]); o.w = pk2(s[6 * 33], s[7 * 33]);
        *(u32x4*)(WT + (size_t)(dst_row0 + n) * Kd + k0 + 8 * c) = o; }
    LDS_WAIT(); asm volatile("" ::: "memory");
}

struct CvtItem { const float* src; bf16* dst; int ld2, drow8, f8; };
#define CVT_LOAD(v, c) do { _Pragma("unroll") for (int _j = 0; _j < 32; ++_j) v[_j] = __builtin_nontemporal_load((c).src + (size_t)_j * (c).ld2); } while (0)
#define CVT_STORE(v, c) do { _Pragma("unroll") for (int _j = 0; _j < 32; ++_j) scr[(2 * _j + (lane >> 5)) * 33 + (lane & 31)] = v[_j]; \
        LDS_WAIT(); asm volatile("" ::: "memory"); \
        _Pragma("unroll") for (int _q = 0; _q < 4; ++_q) { const LAS float* _s = scr + (8 * (lane & 7)) * 33 + (lane >> 3) + 8 * _q; u32x4 _o; \
            _o.x = pk2(_s[0 * 33], _s[1 * 33]); _o.y = pk2(_s[2 * 33], _s[3 * 33]); _o.z = pk2(_s[4 * 33], _s[5 * 33]); _o.w = pk2(_s[6 * 33], _s[7 * 33]); *(u32x4*)((c).dst + (size_t)_q * (c).drow8) = _o; } \
        LDS_WAIT(); asm volatile("" ::: "memory"); } while (0)
__device__ __forceinline__ CvtItem cvt_item_gu(const Args& a, int it, int lane) {
    const int e = it >> 10, mat = (it >> 9) & 1, q = it & 511, kb = q >> 5, nb = q & 31, n0 = nb * 32, k0 = kb * 64, nrow = n0 + (lane >> 3);
    CvtItem c; c.ld2 = 2048; c.drow8 = 8192; c.f8 = 1;
    c.src = a.in[mat ? I_WUP : I_WGATE] + (size_t)e * 1048576 + (size_t)(k0 + (lane >> 5)) * 1024 + n0 + (lane & 31);
    c.dst = (bf16*)(a.ws + WS_WGU + ((size_t)e * 2048 + (nrow >> 7) * 256 + mat * 128 + (nrow & 127)) * 1024 + k0 + 8 * (lane & 7));
    return c;
}
__device__ __forceinline__ CvtItem cvt_item_dn(const Args& a, int it, int lane) {
    const int e = it >> 9, q = it & 511, kb = q >> 5, nb = q & 31, n0 = nb * 32, k0 = kb * 64;
    CvtItem c; c.ld2 = 2048; c.drow8 = 8192; c.f8 = 1;
    c.src = a.in[I_WDOWN] + (size_t)e * 1048576 + (size_t)(k0 + (lane >> 5)) * 1024 + n0 + (lane & 31);
    c.dst = (bf16*)(a.ws + WS_WD + ((size_t)e * 1024 + n0 + (lane >> 3)) * 1024 + k0 + 8 * (lane & 7));
    return c;
}
#define CVT_STORE8(v, c) do { _Pragma("unroll") for (int _j = 0; _j < 32; ++_j) scr[(2 * _j + (lane >> 5)) * 33 + (lane & 31)] = v[_j]; \
        LDS_WAIT(); asm volatile("" ::: "memory"); \
        _Pragma("unroll") for (int _q = 0; _q < 4; ++_q) { const LAS float* _s = scr + (8 * (lane & 7)) * 33 + (lane >> 3) + 8 * _q; \
            *(u32x2*)((unsigned char*)(c).dst + (size_t)_q * (c).drow8) = (u32x2){pk4_fp8(16.f * _s[0 * 33], 16.f * _s[1 * 33], 16.f * _s[2 * 33], 16.f * _s[3 * 33]), pk4_fp8(16.f * _s[4 * 33], 16.f * _s[5 * 33], 16.f * _s[6 * 33], 16.f * _s[7 * 33])}; } \
        LDS_WAIT(); asm volatile("" ::: "memory"); } while (0)
__device__ __forceinline__ CvtItem cvt_item_small(const Args& a, int it, int lane) {
    CvtItem c; int r = it;
    c.f8 = 0;
    if (r < 2048) { const int kb = r >> 7, nb = r & 127, n0 = nb * 32, k0 = kb * 64; c.ld2 = 2 * DIN; c.drow8 = 8192;
        c.src = a.in[I_WIN] + (size_t)(k0 + (lane >> 5)) * DIN + n0 + (n0 >= 768 ? 32 : 0) + (lane & 31);
        if (n0 < 2048) c.dst = (bf16*)(a.ws + WS_WIN) + (size_t)(n0 + (lane >> 3)) * 1024 + k0 + 8 * (lane & 7);
        else { c.f8 = 1; c.dst = (bf16*)(a.ws + WS_WINM + (size_t)(n0 - 2048 + (lane >> 3)) * 1024 + k0 + 8 * (lane & 7)); }
        return c; }
    r -= 2048;
    if (r < 512) { const int kb = r >> 5, nb = r & 31, n0 = nb * 32, k0 = kb * 64; c.ld2 = 2048; c.drow8 = 8192;
        c.src = a.in[I_WOUT] + (size_t)(k0 + (lane >> 5)) * 1024 + n0 + (lane & 31); c.dst = (bf16*)(a.ws + WS_WO) + (size_t)(n0 + (lane >> 3)) * 1024 + k0 + 8 * (lane & 7); return c; }
    r -= 512;
    { const int kb = r >> 5, nb = r & 31, n0 = nb * 32, k0 = kb * 64; c.ld2 = 2048; c.drow8 = 4096;
      c.src = a.in[I_WGLA] + (size_t)(k0 + (lane >> 5)) * 1024 + n0 + (lane & 31); c.dst = (bf16*)(a.ws + WS_WG) + (size_t)(n0 + (lane >> 3)) * 512 + k0 + 8 * (lane & 7); return c; }
}
template <int KIND> __device__ __forceinline__ CvtItem cvt_item(const Args& a, int it, int lane) { if constexpr (KIND == 0) return cvt_item_small(a, it, lane);
    else if constexpr (KIND == 3) return cvt_item_small(a, (it / 24) * 128 + it % 24, lane);
    else if constexpr (KIND == 4) return cvt_item_small(a, it < 1664 ? (it / 104) * 128 + 24 + it % 104 : 2048 + (it - 1664), lane);
    else if constexpr (KIND == 1) return cvt_item_gu(a, it, lane); else return cvt_item_dn(a, it, lane); }
template <int KIND>
__device__ __forceinline__ void convert_items(LAS float* scr, const Args& a, int first, int step, int end, int lane) {
    float va[32], vb[32]; CvtItem ca, cb;
    int it = first;
    if (it < end) { ca = cvt_item<KIND>(a, it, lane); CVT_LOAD(va, ca); }
    for (; it < end; it += 2 * step) {
        const bool hb = (it + step < end), ha = (it + 2 * step < end);
        if (hb) { cb = cvt_item<KIND>(a, it + step, lane); CVT_LOAD(vb, cb); }
        if ((KIND == 0 || KIND >= 3) && !ca.f8) CVT_STORE(va, ca); else CVT_STORE8(va, ca);
        if (ha) { ca = cvt_item<KIND>(a, it + 2 * step, lane); CVT_LOAD(va, ca); }
        if (hb) { if ((KIND == 0 || KIND >= 3) && !cb.f8) CVT_STORE(vb, cb); else CVT_STORE8(vb, cb); }
    }
}
template <int KIND>
__device__ __forceinline__ void convert_items4(LAS float* scr, const Args& a, int first, int step, int end, int lane) {
    float v0[32], v1[32], v2[32]; CvtItem c0, c1, c2;
    int it = first;
    if (it < end) { c0 = cvt_item<KIND>(a, it, lane); CVT_LOAD(v0, c0); }
    if (it + step < end) { c1 = cvt_item<KIND>(a, it + step, lane); CVT_LOAD(v1, c1); }
    for (; it < end; it += 3 * step) {
        if (it + 2 * step < end) { c2 = cvt_item<KIND>(a, it + 2 * step, lane); CVT_LOAD(v2, c2); }
        CVT_STORE8(v0, c0);
        if (it + 3 * step < end) { c0 = cvt_item<KIND>(a, it + 3 * step, lane); CVT_LOAD(v0, c0); }
        if (it + step < end) CVT_STORE8(v1, c1);
        if (it + 4 * step < end) { c1 = cvt_item<KIND>(a, it + 4 * step, lane); CVT_LOAD(v1, c1); }
        if (it + 2 * step < end) CVT_STORE8(v2, c2);
    }
}
template <int KIND>
__device__ __forceinline__ void convert_all(LAS unsigned char* lds, const Args& a, int vcu, int G, int lane, int wave) {
    const int gw = vcu * NWAVES + wave, NGW = G * NWAVES;
    if constexpr (KIND == 1) convert_items4<KIND>((LAS float*)(lds + wave * 8448), a, gw, NGW, 16384, lane);
    else convert_items<KIND>((LAS float*)(lds + wave * 8448), a, gw, NGW, 8192, lane);
    __syncthreads();
}

__device__ __forceinline__ void phase0(LAS unsigned char* lds, const Args& a, int vcu, int G, int tid, int lane, int wave, int part) {
    unsigned char* ws = a.ws;
    const bool split = (G == 256);
    if (part == 1 && !split) return;
    if (vcu < 96) { if (part == 0) {
        LAS float* sv = (LAS float*)(lds + 69632); LAS float* part = sv + 3072;
        for (int idx = tid; idx < 3072; idx += NT) { const int v = idx >> 10, k = idx & 1023; const float s = (v < 2) ? a.in[I_C][v * 1024 + k] : a.in[I_CCTX][k]; sv[idx] = s / (1.f + expf(-s)); }
        __syncthreads();
        const int n0 = 64 * vcu, colq = lane & 15, kr = lane >> 4;
        f32x4 a0 = {0.f, 0.f, 0.f, 0.f}, a1 = a0, a2 = a0;
        const float* aw = a.in[I_ADAW] + (size_t)(128 * wave + kr) * 6144 + n0 + 4 * colq;
#pragma unroll
        for (int hb = 0; hb < 2; ++hb) { f32x4 w4[16];
#pragma unroll
            for (int it = 0; it < 16; ++it) w4[it] = __builtin_nontemporal_load((const f32x4*)(aw + (size_t)(4 * (16 * hb + it)) * 6144));
#pragma unroll
            for (int it = 0; it < 16; ++it) { const int k = 128 * wave + 4 * (16 * hb + it) + kr; a0 += w4[it] * sv[k]; a1 += w4[it] * sv[1024 + k]; a2 += w4[it] * sv[2048 + k]; } }
#pragma unroll
        for (int j = 0; j < 4; ++j) { a0[j] += __shfl_xor(a0[j], 16); a0[j] += __shfl_xor(a0[j], 32); a1[j] += __shfl_xor(a1[j], 16); a1[j] += __shfl_xor(a1[j], 32); a2[j] += __shfl_xor(a2[j], 16); a2[j] += __shfl_xor(a2[j], 32); }
        if (kr == 0) {
#pragma unroll
            for (int j = 0; j < 4; ++j) { part[(wave * 3 + 0) * 64 + 4 * colq + j] = a0[j]; part[(wave * 3 + 1) * 64 + 4 * colq + j] = a1[j]; part[(wave * 3 + 2) * 64 + 4 * colq + j] = a2[j]; } }
        __syncthreads();
        if (tid < 192) { const int v = tid >> 6, col = tid & 63; float s = a.in[I_ADAB][n0 + col];
#pragma unroll
            for (int w = 0; w < 8; ++w) s += part[(w * 3 + v) * 64 + col];
            ((float*)(ws + WS_MOD))[v * 6144 + n0 + col] = s; } }
    } else if (vcu < 96 + 128 && part == (split ? 1 : 0)) {
        const int it = vcu - 96, g = it >> 5, cb = (it >> 1) & 15, nb = it & 1, n = nb * 512 + tid;
        LAS float* pwt = (LAS float*)(lds + 69632);
        if (tid < 256) { const int d = tid >> 1, hf = tid & 1; const float sc = a.in[I_POOLS][g * 128 + d]; f32x4 v;
#pragma unroll
            for (int q = 0; q < 4; ++q) v[q] = a.in[I_POOLW][(size_t)(g * 128 + cb * 8 + hf * 4 + q) * 128 + d] * sc;
            *(LAS f32x4*)(pwt + d * 8 + hf * 4) = v; }
        __syncthreads();
        const float* wp = a.in[I_WPOOL] + (size_t)(g * 128) * 1024 + n;
        f32x4 acc0 = {0.f, 0.f, 0.f, 0.f}, acc1 = acc0;
        for (int d0 = 0; d0 < 128; d0 += 32) { float w[32];
#pragma unroll
            for (int d = 0; d < 32; ++d) w[d] = wp[(size_t)(d0 + d) * 1024];
#pragma unroll
            for (int d = 0; d < 32; ++d) { const f32x4 p0 = *(const LAS f32x4*)(pwt + (d0 + d) * 8), p1 = *(const LAS f32x4*)(pwt + (d0 + d) * 8 + 4); acc0 += p0 * w[d]; acc1 += p1 * w[d]; } }
        bf16* dst = (bf16*)(ws + WS_WC) + (size_t)n * 512 + g * 128 + cb * 8;
        *(u32x4*)dst = (u32x4){pk2(acc0[0], acc0[1]), pk2(acc0[2], acc0[3]), pk2(acc1[0], acc1[1]), pk2(acc1[2], acc1[3])};
    }
    if (!split) { const int gw = vcu * NWAVES + wave, NGW = G * NWAVES; convert_items<0>((LAS float*)(lds + wave * 8448), a, gw, NGW, 2048 + 512 + 256, lane); }
    else if (vcu >= 96) { const int gw = (vcu - 96) * NWAVES + wave, NGW = (G - 96) * NWAVES;
        if (part == 0) convert_items<3>((LAS float*)(lds + wave * 8448), a, gw, NGW, 384, lane);
        else { __syncthreads(); convert_items<4>((LAS float*)(lds + wave * 8448), a, gw, NGW, 2432, lane); __syncthreads(); } }
}

constexpr int P1_WP = 1032;
__device__ __forceinline__ void p1_stage_wr(LAS unsigned char* lds, const Args& a, int tid) {
    LAS bf16* WT = (LAS bf16*)lds;
#pragma unroll 4
    for (int it = 0; it < 16; ++it) { const int k = (tid >> 3) + 64 * it, c4 = tid & 7; const f32x4 v = *(const f32x4*)(a.in[I_WIN] + (size_t)k * DIN + 768 + 4 * c4);
#pragma unroll
        for (int q = 0; q < 4; ++q) WT[(4 * c4 + q) * P1_WP + k] = (bf16)f2bf(v[q]); }
}
#define RSTEP(N, S) do { _Pragma("unroll") for (int _i = 0; _i < (N) / 2; ++_i) { const float _send = (lane & (S)) ? racc[_i] : racc[_i + (N) / 2]; const float _keep = (lane & (S)) ? racc[_i + (N) / 2] : racc[_i]; racc[_i] = _keep + __shfl_xor(_send, (S)); } } while (0)
__device__ __forceinline__ void phase1(LAS unsigned char* lds, const Args& a, int vcu, int G, int tid, int lane, int wave, bool wr_staged) {
    unsigned char* ws = a.ws;
    const float* MOD = (const float*)(ws + WS_MOD);
    const float* g1 = a.in[I_N1G];
    for (int r_ = 0; r_ < a.rep[9]; ++r_) for (int u = vcu; u < 96; u += G) {
        const int mt = u / 12, ntile = u % 12, r0 = mt * 64;
        LAS bf16* As = (LAS bf16*)lds; LAS bf16* Bs = As + 64 * 72; LAS float* rs = (LAS float*)(lds + 18432);
        const float* ctx = a.in[I_CTX];
        { f32x4 rv[8][4];
#pragma unroll
          for (int rr = 0; rr < 8; ++rr)
#pragma unroll
              for (int j = 0; j < 4; ++j) rv[rr][j] = *(const f32x4*)(ctx + (size_t)(r0 + 8 * wave + rr) * 1024 + 256 * j + 4 * lane);
#pragma unroll
          for (int rr = 0; rr < 8; ++rr) { float ss = 0.f;
#pragma unroll
              for (int j = 0; j < 4; ++j) ss += rv[rr][j][0] * rv[rr][j][0] + rv[rr][j][1] * rv[rr][j][1] + rv[rr][j][2] * rv[rr][j][2] + rv[rr][j][3] * rv[rr][j][3];
              ss = wave_sum(ss); if (lane == 0) rs[8 * wave + rr] = rsqrtf(ss * (1.f / 1024.f) + EPS); } }
        __syncthreads();
        f32x4 acc[2] = {{0.f, 0.f, 0.f, 0.f}, {0.f, 0.f, 0.f, 0.f}};
        const int m16 = wave & 3, nh = wave >> 2, srow = tid >> 3, kq = (tid & 7) * 8;
        const float rstd = rs[srow];
        const float* xp = ctx + (size_t)(r0 + srow) * 1024 + kq; const bf16* wpB = (const bf16*)(ws + WS_WIN) + (size_t)(ntile * 64 + srow) * 1024 + kq;
        f32x4 xv[2], gq[2], scq[2], shq[2]; u32x4 wB;
#define CTX_LOAD(kc) do { const int _k0 = (kc) * 64; _Pragma("unroll") for (int q = 0; q < 2; ++q) { xv[q] = *(const f32x4*)(xp + _k0 + 4 * q); gq[q] = *(const f32x4*)(g1 + _k0 + kq + 4 * q); \
            scq[q] = *(const f32x4*)(MOD + 2 * 6144 + 1024 + _k0 + kq + 4 * q); shq[q] = *(const f32x4*)(MOD + 2 * 6144 + _k0 + kq + 4 * q); } wB = *(const u32x4*)(wpB + _k0); } while (0)
        CTX_LOAD(0);
        for (int kc = 0; kc < 16; ++kc) {
            { unsigned o[4];
#pragma unroll
              for (int q = 0; q < 2; ++q) { const f32x4 h = xv[q] * rstd * gq[q] * (scq[q] + 1.f) + shq[q]; o[2 * q] = pk2(h[0], h[1]); o[2 * q + 1] = pk2(h[2], h[3]); }
              *(LAS u32x4*)(As + srow * 72 + kq) = (u32x4){o[0], o[1], o[2], o[3]};
              *(LAS u32x4*)(Bs + srow * 72 + kq) = wB; }
            __syncthreads();
            if (kc + 1 < 16) CTX_LOAD(kc + 1);
#pragma unroll
            for (int ks = 0; ks < 2; ++ks) { const bf16x8 af = ldfrag(As, 72, m16 * 16, ks * 32, lane);
#pragma unroll
                for (int tt = 0; tt < 2; ++tt) { const bf16x8 bfr = ldfrag(Bs, 72, nh * 32 + tt * 16, ks * 32, lane); acc[tt] = MFMA16(af, bfr, acc[tt]); } }
            __syncthreads();
        }
#undef CTX_LOAD
#pragma unroll
        for (int tt = 0; tt < 2; ++tt)
#pragma unroll
            for (int r = 0; r < 4; ++r) { const int row = M + r0 + m16 * 16 + 4 * (lane >> 4) + r, n = ntile * 64 + nh * 32 + tt * 16 + (lane & 15); const bf16 v = (bf16)f2bf(acc[tt][r]);
                if (n < 256) ((bf16*)(ws + WS_KB))[(size_t)row * 256 + n] = v; else ((bf16*)(ws + WS_VB))[(size_t)row * 512 + n - 256] = v; }
        __syncthreads();
    }
    LAS bf16* WT = (LAS bf16*)lds;
    LAS bf16* HS = (LAS bf16*)(lds + 32 * P1_WP * 2) + wave * (2 * P1_WP);
    if (!wr_staged) p1_stage_wr(lds, a, tid);
    __syncthreads();
    f32x4 gv[4];
#pragma unroll
    for (int j = 0; j < 4; ++j) gv[j] = *(const f32x4*)(g1 + 256 * j + 4 * lane);
    constexpr int NPAIR = MT / 2;
    const int nctx = (G > 96) ? 96 : 0, PA = 3;
    int p_lo, p_n, p_stride;
    if (vcu < nctx) { p_lo = (vcu * NWAVES + wave) * PA; p_n = PA; p_stride = 1; }
    else { p_lo = nctx * NWAVES * PA + (vcu - nctx) * NWAVES + wave; p_n = 1 << 30; p_stride = (G - nctx) * NWAVES; }
    for (int r_ = 0; r_ < a.rep[10]; ++r_) {
    f32x4 nx[2][4];
    if (p_n > 0 && p_lo < NPAIR) {
#pragma unroll
        for (int r = 0; r < 2; ++r) { const int m = 2 * p_lo + r; const float* src = (m < M) ? a.in[I_X] + (size_t)m * 1024 : a.in[I_CTX] + (size_t)(m - M) * 1024;
#pragma unroll
            for (int j = 0; j < 4; ++j) nx[r][j] = *(const f32x4*)(src + 256 * j + 4 * lane); } }
    for (int pi = 0, pr = p_lo; pi < p_n && pr < NPAIR; ++pi, pr += p_stride) {
        const int m0 = 2 * pr;
        f32x4 v[2][4]; float rstd[2];
#pragma unroll
        for (int r = 0; r < 2; ++r) { float ss = 0.f;
#pragma unroll
            for (int j = 0; j < 4; ++j) { v[r][j] = nx[r][j]; ss += v[r][j][0] * v[r][j][0] + v[r][j][1] * v[r][j][1] + v[r][j][2] * v[r][j][2] + v[r][j][3] * v[r][j][3]; }
            rstd[r] = ss; }
        if (pi + 1 < p_n && pr + p_stride < NPAIR) {
#pragma unroll
            for (int r = 0; r < 2; ++r) { const int m = 2 * (pr + p_stride) + r; const float* src = (m < M) ? a.in[I_X] + (size_t)m * 1024 : a.in[I_CTX] + (size_t)(m - M) * 1024;
#pragma unroll
                for (int j = 0; j < 4; ++j) nx[r][j] = *(const f32x4*)(src + 256 * j + 4 * lane); } }
#pragma unroll
        for (int r = 0; r < 2; ++r) { const int m = m0 + r; rstd[r] = rsqrtf(wave_sum(rstd[r]) * (1.f / 1024.f) + EPS); const float* mod = MOD + (size_t)((m < M) ? (m >> 13) : 2) * 6144;
#pragma unroll
            for (int j = 0; j < 4; ++j) { const f32x4 sc = *(const f32x4*)(mod + 1024 + 256 * j + 4 * lane), sh = *(const f32x4*)(mod + 256 * j + 4 * lane); v[r][j] = v[r][j] * rstd[r] * gv[j] * (sc + 1.f) + sh; }
            if (m < M) { bf16* hp = (bf16*)(ws + WS_H1) + (size_t)m * 1024;
#pragma unroll
                for (int j = 0; j < 4; ++j) { *(u32x2*)(hp + 256 * j + 4 * lane) = (u32x2){pk2(v[r][j][0], v[r][j][1]), pk2(v[r][j][2], v[r][j][3])};
                    *(unsigned*)(ws + WS_H1F + (size_t)m * 1024 + 256 * j + 4 * lane) = pk4_fp8(v[r][j][0], v[r][j][1], v[r][j][2], v[r][j][3]); } } }
#pragma unroll
        for (int r = 0; r < 2; ++r)
#pragma unroll
            for (int j = 0; j < 4; ++j) *(LAS u32x2*)(HS + r * P1_WP + 256 * j + 4 * lane) = (u32x2){pk2(v[r][j][0], v[r][j][1]), pk2(v[r][j][2], v[r][j][3])};
        LDS_WAIT(); asm volatile("" ::: "memory");
        f32x4 rc0 = {0.f, 0.f, 0.f, 0.f}, rc1 = rc0;
        const LAS bf16* hsl = HS + (lane & 1) * P1_WP + 8 * (lane >> 4);
#pragma unroll 8
        for (int ks = 0; ks < 32; ++ks) { const bf16x8 hb = *(const LAS bf16x8*)(hsl + 32 * ks);
            rc0 = MFMA16(ldfrag(WT, P1_WP, 0, 32 * ks, lane), hb, rc0); rc1 = MFMA16(ldfrag(WT, P1_WP, 16, 32 * ks, lane), hb, rc1); }
        LDS_WAIT(); asm volatile("" ::: "memory");
        if ((lane & 15) < 2) { float* rp = (float*)(ws + WS_RB) + (size_t)(m0 + (lane & 15)) * 32 + 4 * (lane >> 4); *(f32x4*)rp = rc0; *(f32x4*)(rp + 16) = rc1; }
    }
    }
}

typedef short s16x4 __attribute__((ext_vector_type(4)));
__device__ __forceinline__ s16x4 lds_tr16(const LAS bf16* p) { return __builtin_bit_cast(s16x4, __builtin_amdgcn_ds_read_tr16_b64_v4i16((LAS s16x4*)p)); }
__device__ __forceinline__ bf16x8 ldfrag_tr(const LAS bf16* base, int stride, int k0, int n0, int lane) {
    const int g = lane >> 4, i = lane & 15; const LAS bf16* p = base + (k0 + 8 * g + (i >> 2)) * stride + n0 + 4 * (i & 3);
    const s16x4 lo = lds_tr16(p), hi = lds_tr16(p + 4 * stride);
    return (bf16x8){lo[0], lo[1], lo[2], lo[3], hi[0], hi[1], hi[2], hi[3]};
}
__device__ __forceinline__ float logsig_fast(float z) { return fminf(z, 0.f) - __logf(1.f + __expf(-fabsf(z))); }
struct ChkPre { f32x4 r, w; float bias_f, bias_b; float kf[8]; u32x4 v[2]; };
__device__ __forceinline__ void chunk_decode(int u, int& b, int& h, int& row0, int& slot, bool& isx) {
    if (u < 1024) { b = u >> 9; h = (u >> 7) & 3; const int n = u & 127; row0 = b * SEQ + n * 64; slot = n; isx = true; }
    else { const int v = u - 1024; b = v >> 4; h = (v >> 2) & 3; const int n = v & 3; row0 = M + b * LC + n * 64; slot = NCH + n; isx = false; }
}
__device__ __forceinline__ void chunk_load(ChkPre& P, const Args& a, int u, int tid) {
    unsigned char* ws = a.ws; int b, h, row0, slot; bool isx; chunk_decode(u, b, h, row0, slot, isx);
    P.r = *(const f32x4*)((const float*)(ws + WS_RB) + (size_t)(row0 + (tid >> 3)) * 32 + (tid & 7) * 4);
    P.w = *(const f32x4*)(a.in[I_WDU] + (size_t)(tid >> 4) * 256 + h * 64 + (tid & 15) * 4);
    const int dk = tid & 63, tq = tid >> 6;
    P.bias_f = a.in[I_BDEC][h * 64 + dk]; P.bias_b = a.in[I_BDEC][256 + h * 64 + dk];
    const bf16* KBp = (const bf16*)(ws + WS_KB) + (size_t)(row0 + tq * 8) * 256 + h * 64 + dk;
#pragma unroll
    for (int tt = 0; tt < 8; ++tt) P.kf[tt] = bf2f(KBp[(size_t)tt * 256]);
#pragma unroll
    for (int i = 0; i < 2; ++i) { const int p = tid + NT * i, jj = p >> 4, ch = p & 15; P.v[i] = *(const u32x4*)((const bf16*)(ws + WS_VB) + (size_t)(row0 + jj) * 512 + h * 128 + 8 * ch); }
}
__device__ __forceinline__ void chunk_units(LAS unsigned char* lds, const Args& a, int vcu, int G, int tid, int lane, int wave) {
    unsigned char* ws = a.ws;
    LAS float* r_s = (LAS float*)lds;
    LAS float* wup = (LAS float*)(lds + 8192);
    LAS float* seg = (LAS float*)(lds + 16384);
    LAS bf16* Ks = (LAS bf16*)(lds + 20480);
    LAS bf16* Vs = (LAS bf16*)(lds + 38912);
    const int dk = tid & 63, tq = tid >> 6;
    ChkPre P;
    unsigned* qctr = (unsigned*)(ws + WS_CTL) + 512; LAS int* qnext = (LAS int*)(lds + 57344);
    if (tid == 0) qnext[0] = (int)__hip_atomic_fetch_add(qctr, 1u, __ATOMIC_RELAXED, __HIP_MEMORY_SCOPE_AGENT);
    __syncthreads();
    int u = qnext[0];
    __syncthreads();
    if (u < 1024 + 32) chunk_load(P, a, u, tid);
    for (; u < 1024 + 32; ) {
        int b, h, row0, slot; bool isx; chunk_decode(u, b, h, row0, slot, isx);
        const int bh = b * 4 + h;
        if (tid == 0) qnext[0] = (int)__hip_atomic_fetch_add(qctr, 1u, __ATOMIC_RELAXED, __HIP_MEMORY_SCOPE_AGENT);
        *(LAS f32x4*)(r_s + tid * 4) = P.r; *(LAS f32x4*)(wup + (tid >> 4) * 64 + (tid & 15) * 4) = P.w;
#pragma unroll
        for (int i = 0; i < 2; ++i) { const int p = tid + NT * i, jj = p >> 4, ch = p & 15; *(LAS u32x4*)(Vs + jj * 136 + 8 * ch) = P.v[i]; }
        float kf[8];
#pragma unroll
        for (int tt = 0; tt < 8; ++tt) kf[tt] = P.kf[tt];
        const float bias_f = P.bias_f, bias_b = P.bias_b;
        __syncthreads();
        const int un = qnext[0];
        if (un < 1024 + 32) chunk_load(P, a, un, tid);
        float pf[8], sb[8];
        { float wf[16], wb[16];
#pragma unroll
          for (int j = 0; j < 16; ++j) { wf[j] = wup[j * 64 + dk]; wb[j] = wup[(16 + j) * 64 + dk]; }
#pragma unroll
          for (int tt = 0; tt < 8; ++tt) { const LAS float* rp = r_s + (tq * 8 + tt) * 32; float zf = bias_f, zb = bias_b;
#pragma unroll
              for (int j4 = 0; j4 < 4; ++j4) { const f32x4 rf = *(const LAS f32x4*)(rp + 4 * j4), rb = *(const LAS f32x4*)(rp + 16 + 4 * j4);
#pragma unroll
                  for (int e = 0; e < 4; ++e) { zf += rf[e] * wf[4 * j4 + e]; zb += rb[e] * wb[4 * j4 + e]; } }
              pf[tt] = logsig_fast(zf) * (1.f / 16.f); sb[tt] = logsig_fast(zb) * (1.f / 16.f); }
#pragma unroll
          for (int tt = 1; tt < 8; ++tt) pf[tt] += pf[tt - 1];
#pragma unroll
          for (int tt = 6; tt >= 0; --tt) sb[tt] += sb[tt + 1];
          seg[tq * 64 + dk] = pf[7]; seg[(8 + tq) * 64 + dk] = sb[0]; }
        __syncthreads();
        { float offf = 0.f, totf = 0.f, offb = 0.f, totb = 0.f;
#pragma unroll
          for (int q = 0; q < 8; ++q) { const float sf = seg[q * 64 + dk], sbv = seg[(8 + q) * 64 + dk]; totf += sf; totb += sbv; if (q < tq) offf += sf; if (q > tq) offb += sbv; }
#pragma unroll
          for (int tt = 0; tt < 8; ++tt) { const int t = tq * 8 + tt; const float bb = pf[tt] + offf, cc = sb[tt] + offb;
              if (isx) { const size_t gi = (size_t)(row0 + t) * 256 + h * 64 + dk; ((_Float16*)a.out)[gi] = (_Float16)bb; ((_Float16*)a.out)[(size_t)M * 256 + gi] = (_Float16)cc; }
              Ks[t * 72 + dk] = (bf16)f2bf(kf[tt] * __expf(totf - bb)); Ks[(64 + t) * 72 + dk] = (bf16)f2bf(kf[tt] * __expf(totb - cc)); }
          if (tq == 0) { float* DEC = (float*)(ws + WS_DEC); DEC[((size_t)(0 * 8 + bh) * NSLOT + slot) * 64 + dk] = __expf(totf); DEC[((size_t)(1 * 8 + bh) * NSLOT + slot) * 64 + dk] = __expf(totb); } }
        __syncthreads();
        { const int dir = wave >> 2, dkt = wave & 3; const LAS bf16* Kd = Ks + dir * 64 * 72;
          const bf16x8 k0f = ldfrag_tr(Kd, 72, 0, dkt * 16, lane), k1f = ldfrag_tr(Kd, 72, 32, dkt * 16, lane);
          bf16* KV = (bf16*)(ws + WS_KV) + ((size_t)(dir * 8 + bh) * NSLOT + slot) * 8192;
#pragma unroll
          for (int dvt = 0; dvt < 8; ++dvt) { f32x4 c = {0.f, 0.f, 0.f, 0.f}; c = MFMA16(k0f, ldfrag_tr(Vs, 136, 0, dvt * 16, lane), c); c = MFMA16(k1f, ldfrag_tr(Vs, 136, 32, dvt * 16, lane), c);
              *(u32x2*)(KV + (size_t)(dvt * 16 + (lane & 15)) * 64 + dkt * 16 + 4 * (lane >> 4)) = (u32x2){pk2(c[0], c[1]), pk2(c[2], c[3])}; } }
        __syncthreads();
        u = un;
    }
}
constexpr int PB = 4, NPOOLW = NB * 4 * 8 * (128 / PB);
__device__ __forceinline__ void ld16bf(const bf16* p, float (&f)[16]) { const u32x4 w0 = *(const u32x4*)p, w1 = *(const u32x4*)(p + 8);
#pragma unroll
    for (int q = 0; q < 4; ++q) { f[2 * q] = bflo(w0[q]); f[2 * q + 1] = bfhi(w0[q]); f[8 + 2 * q] = bflo(w1[q]); f[8 + 2 * q + 1] = bfhi(w1[q]); } }
template <int CTRL, int ROWMASK> __device__ __forceinline__ float dpp_f(float v) { return __builtin_bit_cast(float, __builtin_amdgcn_update_dpp(0, __builtin_bit_cast(int, v), CTRL, ROWMASK, 0xf, true)); }
__device__ __forceinline__ float wave_prefix(float v) {
    v += dpp_f<0x111, 0xf>(v); v += dpp_f<0x112, 0xf>(v); v += dpp_f<0x114, 0xf>(v); v += dpp_f<0x118, 0xf>(v);
    v += dpp_f<0x142, 0xa>(v);
    v += dpp_f<0x143, 0xc>(v);
    return v;
}
template <int HALF>
__device__ __forceinline__ void pool_band(const bf16* PI, bf16* PO, int r0, int c) {
    float run[16];
#pragma unroll
    for (int e = 0; e < 16; ++e) run[e] = 0.f;
    { constexpr int NW = 2 * HALF, BT = NW < 8 ? NW : 8;
#pragma unroll
      for (int i0 = 0; i0 < NW; i0 += BT) { float f[BT][16];
#pragma unroll
          for (int i = 0; i < BT; ++i) { int rr = r0 - HALF + i0 + i; rr = rr < 0 ? 0 : (rr > 127 ? 127 : rr); ld16bf(PI + (size_t)rr * 64 * 512, f[i]); }
#pragma unroll
          for (int i = 0; i < BT; ++i) { const int rr = r0 - HALF + i0 + i; const bool ok = rr >= 0 && rr < 128;
#pragma unroll
              for (int e = 0; e < 16; ++e) run[e] += ok ? f[i][e] : 0.f; }
          asm volatile("" ::: "memory"); } }
    const int lo_c = (c - HALF) < 0 ? 0 : (c - HALF), hi_c = (c + HALF) > 64 ? 64 : (c + HALF);
    float cen[16], fi[16], fo[16];
    ld16bf(PI + (size_t)r0 * 64 * 512, cen);
#pragma unroll
    for (int k = 0; k < PB; ++k) {
        const int r = r0 + k;
        float ncen[16];
        if (k + 1 < PB) { const int rin = r + HALF, rout = r - HALF;
            ld16bf(PI + (size_t)(rin > 127 ? 127 : rin) * 64 * 512, fi); ld16bf(PI + (size_t)(rout < 0 ? 0 : rout) * 64 * 512, fo); ld16bf(PI + (size_t)(r + 1) * 64 * 512, ncen); }
        const int lo_r = (r - HALF) < 0 ? 0 : (r - HALF), hi_r = (r + HALF) > 128 ? 128 : (r + HALF);
        const float inv = __builtin_amdgcn_rcpf((float)((hi_r - lo_r) * (hi_c - lo_c)));
        float o[16];
#pragma unroll
        for (int e = 0; e < 16; ++e) { const float p = wave_prefix(run[e]);
            const float hi = __shfl(p, hi_c - 1), lo = __shfl(p, lo_c > 0 ? lo_c - 1 : 0);
            o[e] = (hi - (lo_c > 0 ? lo : 0.f)) * inv - cen[e]; }
        bf16* po = PO + (size_t)r * 64 * 512;
        *(u32x4*)po = (u32x4){pk2(o[0], o[1]), pk2(o[2], o[3]), pk2(o[4], o[5]), pk2(o[6], o[7])}; *(u32x4*)(po + 8) = (u32x4){pk2(o[8], o[9]), pk2(o[10], o[11]), pk2(o[12], o[13]), pk2(o[14], o[15])};
        if (k + 1 < PB) { const int rin = r + HALF, rout = r - HALF;
#pragma unroll
            for (int e = 0; e < 16; ++e) { run[e] += (rin < 128 ? fi[e] : 0.f) - (rout >= 0 ? fo[e] : 0.f); cen[e] = ncen[e]; } }
    }
}
__device__ __forceinline__ void pool_units(const Args& a, int vcu, int G, int lane, int wave, int nw) {
    unsigned char* ws = a.ws;
    constexpr int NBAND = 128 / PB, PER_G = NB * 8 * NBAND;
    for (int wu = vcu * nw + wave; wu < NPOOLW; wu += G * nw) {
        const int g = 3 - (wu & 3), rem = wu >> 2, b = rem / (8 * NBAND), rem2 = rem % (8 * NBAND), chk = rem2 & 7, r0 = (rem2 >> 3) * PB;
        const size_t off = ((size_t)b * SEQ + lane) * 512 + g * 128 + chk * 16;
        const bf16* PI = (const bf16*)(ws + WS_PI) + off; bf16* PO = (bf16*)(ws + WS_PO) + off;
        if (g == 0) pool_band<1>(PI, PO, r0, lane); else if (g == 1) pool_band<2>(PI, PO, r0, lane); else if (g == 2) pool_band<4>(PI, PO, r0, lane); else pool_band<8>(PI, PO, r0, lane);
    }
}

__device__ __forceinline__ void phase4(const Args& a, int G, int tid, int nthr) {
    unsigned char* ws = a.ws;
    if (tid >= nthr) return;
    for (int p = blockIdx.x * nthr + tid; p < 8 * 8192; p += G * nthr) {
        const int e = 2 * p, dir = e >> 16, bh = (e >> 13) & 7, e8 = e & 8191, dk = e8 & 63;
        const bf16* kvp = (const bf16*)(ws + WS_KV) + (size_t)((dir * 8 + bh) * NSLOT) * 8192 + e8;
        const float* decp = (const float*)(ws + WS_DEC) + (size_t)((dir * 8 + bh) * NSLOT) * 64 + dk;
        bf16* stp = (bf16*)(ws + WS_ST) + (size_t)((dir * 8 + bh) * NCH) * 8192 + e8;
        float s0 = 0.f, s1 = 0.f;
        unsigned kv[12], kv1[12], kv2[12]; f32x2 dc[12], dc1[12], dc2[12];
#define SCAN_SLOT(j) (dir ? (NSLOT - 1 - (j)) : ((j) < 4 ? NCH + (j) : (j) - 4))
#define SCAN_LOAD(KVD, DCD, J0) do { _Pragma("unroll") for (int q = 0; q < 12; ++q) { const int slot = SCAN_SLOT((J0) + q); KVD[q] = *(const unsigned*)(kvp + (size_t)slot * 8192); DCD[q] = *(const f32x2*)(decp + slot * 64); } } while (0)
        SCAN_LOAD(kv1, dc1, 0); SCAN_LOAD(kv2, dc2, 12);
        for (int j0 = 0; j0 < NSLOT; j0 += 12) {
#pragma unroll
            for (int q = 0; q < 12; ++q) { kv[q] = kv1[q]; dc[q] = dc1[q]; kv1[q] = kv2[q]; dc1[q] = dc2[q]; }
            if (j0 + 24 < NSLOT) SCAN_LOAD(kv2, dc2, j0 + 24);
#pragma unroll
            for (int q = 0; q < 12; ++q) { const int slot = SCAN_SLOT(j0 + q);
                if (slot < NCH) *(unsigned*)(stp + (size_t)slot * 8192) = pk2(s0, s1);
                s0 = dc[q][0] * s0 + bflo(kv[q]); s1 = dc[q][1] * s1 + bfhi(kv[q]); }
        }
#undef SCAN_LOAD
#undef SCAN_SLOT
    }
}

struct GlaPre { u32x4 q, k; u32x4 hb, hc, hmf, hmb; u32x4 v[2]; u32x4 st[4]; u32x4 sg[2]; };
__device__ __forceinline__ void gla_load(GlaPre& P, const Args& a, int u, int tid) {
    unsigned char* ws = a.ws;
    const int b = u >> 9, h = (u >> 7) & 3, n = u & 127, row0 = b * SEQ + n * 64, bh = b * 4 + h, t = tid >> 3, c8 = tid & 7;
    const size_t gi = (size_t)(row0 + t) * 256 + h * 64 + 8 * c8, gmf = (size_t)(row0 + 31) * 256 + h * 64 + 8 * c8, gmb = (size_t)(row0 + 32) * 256 + h * 64 + 8 * c8;
    const _Float16* BF = (const _Float16*)a.out; const _Float16* CB = BF + (size_t)M * 256;
    P.q = *(const u32x4*)((const bf16*)(ws + WS_QB) + gi); P.k = *(const u32x4*)((const bf16*)(ws + WS_KB) + gi);
    P.hb = *(const u32x4*)(BF + gi); P.hc = *(const u32x4*)(CB + gi); P.hmf = *(const u32x4*)(BF + gmf); P.hmb = *(const u32x4*)(CB + gmb);
#pragma unroll
    for (int i = 0; i < 2; ++i) { const int p = tid + NT * i, jj = p >> 4, ch = p & 15; P.v[i] = *(const u32x4*)((const bf16*)(ws + WS_VB) + (size_t)(row0 + jj) * 512 + h * 128 + 8 * ch); }
#pragma unroll
    for (int i = 0; i < 4; ++i) { const int p = tid + NT * i, dir = p >> 10, rem = p & 1023, dv = rem >> 3, c = rem & 7;
        P.st[i] = *(const u32x4*)((const bf16*)(ws + WS_ST) + ((size_t)((dir * 8 + bh) * NCH + n) * 128 + dv) * 64 + 8 * c); }
    const bf16* sgp = (const bf16*)(ws + WS_SG) + (size_t)(row0 + t) * 512 + h * 128 + 16 * c8;
    P.sg[0] = *(const u32x4*)sgp; P.sg[1] = *(const u32x4*)(sgp + 8);
}
__device__ __forceinline__ void phase5(LAS unsigned char* lds, const Args& a, int vcu, int G, int tid, int lane, int wave) {
    unsigned char* ws = a.ws;
    LAS bf16* Aop = (LAS bf16*)lds;
    LAS bf16* Bop = (LAS bf16*)(lds + 25600);
    LAS bf16* Vs = (LAS bf16*)(lds + 60416);
    LAS bf16* qsf = (LAS bf16*)(lds + 77824); LAS bf16* ksf = qsf + 64 * 72; LAS bf16* qsb = ksf + 64 * 72; LAS bf16* ksb = qsb + 64 * 72;
    LAS float* Os = (LAS float*)(lds + 77824);
    const int t8 = tid >> 3, c8 = tid & 7;
    f32x4 gn[4];
#pragma unroll
    for (int q = 0; q < 4; ++q) gn[q] = *(const f32x4*)(a.in[I_GNG] + 16 * c8 + 4 * q);
    GlaPre P; int pend = -1;
    const __amdgpu_buffer_rsrc_t rsAG = __builtin_amdgcn_make_buffer_rsrc((void*)(ws + WS_AG), 0, 0x7fffffff, 0x00020000);
    int u = vcu;
    if (u < 1024) gla_load(P, a, u, tid);
    for (; u < 1024; u += G) {
        const int b = u >> 9, h = (u >> 7) & 3, n = u & 127, row0 = b * SEQ + n * 64;
        { float qf[8], kf[8], bb[8], cc[8], mf[8], mb[8];
#pragma unroll
          for (int e = 0; e < 4; ++e) { qf[2 * e] = bflo(P.q[e]); qf[2 * e + 1] = bfhi(P.q[e]); kf[2 * e] = bflo(P.k[e]); kf[2 * e + 1] = bfhi(P.k[e]);
              bb[2 * e] = hlo(P.hb[e]); bb[2 * e + 1] = hhi(P.hb[e]); cc[2 * e] = hlo(P.hc[e]); cc[2 * e + 1] = hhi(P.hc[e]); mf[2 * e] = hlo(P.hmf[e]); mf[2 * e + 1] = hhi(P.hmf[e]); mb[2 * e] = hlo(P.hmb[e]); mb[2 * e + 1] = hhi(P.hmb[e]); }
          float o0[8], o1[8], o2[8], o3[8], o4[8], o5[8];
#pragma unroll
          for (int e = 0; e < 8; ++e) { const float eb = __expf(bb[e]), ec = __expf(cc[e]), x = __expf(bb[e] - mf[e]), y = __expf(cc[e] - mb[e]);
              o0[e] = qf[e] * eb; o1[e] = qf[e] * ec; o2[e] = qf[e] * x; o3[e] = kf[e] * __builtin_amdgcn_rcpf(x); o4[e] = qf[e] * y; o5[e] = kf[e] * __builtin_amdgcn_rcpf(y); }
#define PK8(o) (u32x4){pk2(o[0], o[1]), pk2(o[2], o[3]), pk2(o[4], o[5]), pk2(o[6], o[7])}
          *(LAS u32x4*)(Aop + t8 * 200 + 8 * c8) = PK8(o0); *(LAS u32x4*)(Aop + t8 * 200 + 64 + 8 * c8) = PK8(o1);
          *(LAS u32x4*)(qsf + t8 * 72 + 8 * c8) = PK8(o2); *(LAS u32x4*)(ksf + t8 * 72 + 8 * c8) = PK8(o3); *(LAS u32x4*)(qsb + t8 * 72 + 8 * c8) = PK8(o4); *(LAS u32x4*)(ksb + t8 * 72 + 8 * c8) = PK8(o5);
#undef PK8
        }
#pragma unroll
        for (int i = 0; i < 2; ++i) { const int p = tid + NT * i, jj = p >> 4, ch = p & 15; *(LAS u32x4*)(Vs + jj * 136 + 8 * ch) = P.v[i]; }
#pragma unroll
        for (int i = 0; i < 4; ++i) { const int p = tid + NT * i, dir = p >> 10, rem = p & 1023, dv = rem >> 3, c = rem & 7; *(LAS u32x4*)(Bop + dv * 136 + dir * 64 + 8 * c) = P.st[i]; }
        const u32x4 sg0 = P.sg[0], sg1 = P.sg[1];
        __syncthreads();
        if (u + G < 1024) gla_load(P, a, u + G, tid);
        { const int tt = wave >> 1, jh = wave & 1; f32x4 pa[2] = {{0.f, 0.f, 0.f, 0.f}, {0.f, 0.f, 0.f, 0.f}};
#pragma unroll
          for (int dir = 0; dir < 2; ++dir) { const LAS bf16* qs = dir ? qsb : qsf; const LAS bf16* ks = dir ? ksb : ksf;
              const bf16x8 a0 = ldfrag(qs, 72, tt * 16, 0, lane), a1 = ldfrag(qs, 72, tt * 16, 32, lane);
#pragma unroll
              for (int jj = 0; jj < 2; ++jj) { const int jt = jh * 2 + jj; f32x4 sc = {0.f, 0.f, 0.f, 0.f}; sc = MFMA16(a0, ldfrag(ks, 72, jt * 16, 0, lane), sc); sc = MFMA16(a1, ldfrag(ks, 72, jt * 16, 32, lane), sc);
#pragma unroll
                  for (int r = 0; r < 4; ++r) { const int t = tt * 16 + 4 * (lane >> 4) + r, jx = jt * 16 + (lane & 15); const bool keep = dir ? (jx >= t) : (jx <= t); pa[jj][r] += keep ? sc[r] : 0.f; } } }
#pragma unroll
          for (int jj = 0; jj < 2; ++jj)
#pragma unroll
              for (int r = 0; r < 4; ++r) Aop[(tt * 16 + 4 * (lane >> 4) + r) * 200 + 128 + (jh * 2 + jj) * 16 + (lane & 15)] = (bf16)f2bf(pa[jj][r]); }
        __syncthreads();
        const int tt = wave >> 1, dvh = wave & 1;
        f32x4 acc[4] = {{0.f, 0.f, 0.f, 0.f}, {0.f, 0.f, 0.f, 0.f}, {0.f, 0.f, 0.f, 0.f}, {0.f, 0.f, 0.f, 0.f}};
#pragma unroll
        for (int ks = 0; ks < 4; ++ks) { const bf16x8 af = ldfrag(Aop, 200, tt * 16, ks * 32, lane);
#pragma unroll
            for (int i = 0; i < 4; ++i) acc[i] = MFMA16(af, ldfrag(Bop, 136, (dvh * 4 + i) * 16, ks * 32, lane), acc[i]); }
#pragma unroll
        for (int ks = 0; ks < 2; ++ks) { const bf16x8 af = ldfrag(Aop, 200, tt * 16, 128 + ks * 32, lane);
#pragma unroll
            for (int i = 0; i < 4; ++i) acc[i] = MFMA16(af, ldfrag_tr(Vs, 136, ks * 32, (dvh * 4 + i) * 16, lane), acc[i]); }
#pragma unroll
        for (int i = 0; i < 4; ++i)
#pragma unroll
            for (int r = 0; r < 4; ++r) Os[(tt * 16 + 4 * (lane >> 4) + r) * 132 + (dvh * 4 + i) * 16 + (lane & 15)] = acc[i][r];
        if (pend >= 0) asm volatile("s_waitcnt vmcnt(0)" ::: "memory");
        __syncthreads();
        if (pend >= 0) panel_arrive((unsigned*)(ws + WS_CTL), CW_PANEL5 + 16 * pend);
        { f32x4 ov[4]; float ss = 0.f;
#pragma unroll
          for (int q = 0; q < 4; ++q) { ov[q] = *(const LAS f32x4*)(Os + t8 * 132 + 16 * c8 + 4 * q); ss += ov[q][0] * ov[q][0] + ov[q][1] * ov[q][1] + ov[q][2] * ov[q][2] + ov[q][3] * ov[q][3]; }
          ss += __shfl_xor(ss, 1); ss += __shfl_xor(ss, 2); ss += __shfl_xor(ss, 4);
          const float rstd = rsqrtf(ss * (1.f / 128.f) + EPS);
          unsigned sgw[8] = {sg0[0], sg0[1], sg0[2], sg0[3], sg1[0], sg1[1], sg1[2], sg1[3]}, ow[8];
#pragma unroll
          for (int q = 0; q < 4; ++q) { const f32x4 o = ov[q] * rstd * gn[q]; ow[2 * q] = pk2(o[0] * bflo(sgw[2 * q]), o[1] * bfhi(sgw[2 * q])); ow[2 * q + 1] = pk2(o[2] * bflo(sgw[2 * q + 1]), o[3] * bfhi(sgw[2 * q + 1])); }
          const unsigned ago = (unsigned)(((size_t)(row0 + t8) * 512 + h * 128 + 16 * c8) * 2);
          __builtin_amdgcn_raw_buffer_store_b128((u32x4){ow[0], ow[1], ow[2], ow[3]}, rsAG, ago, 0,   16); __builtin_amdgcn_raw_buffer_store_b128((u32x4){ow[4], ow[5], ow[6], ow[7]}, rsAG, ago + 16, 0, 16); }
        __syncthreads();
        pend = row0 >> 8;
    }
    if (pend >= 0) { asm volatile("s_waitcnt vmcnt(0)" ::: "memory"); __syncthreads(); panel_arrive((unsigned*)(ws + WS_CTL), CW_PANEL5 + 16 * pend); }
}

__device__ __forceinline__ void phase8(LAS unsigned char* lds, const Args& a, int gw, int NGW, int p_lo, int p_hi, int wait_word, int tid, int lane, int wave) {
    unsigned char* ws = a.ws;
    const float* MOD = (const float*)(ws + WS_MOD);
    LAS float* WRT = (LAS float*)lds;
#pragma unroll
    for (int it = 0; it < 8; ++it) { const int idx = tid + NT * it, k = idx >> 2, c4 = idx & 3; const f32x4 v = *(const f32x4*)(a.in[I_WROUTER] + (size_t)k * 16 + 4 * c4);
        const int row = ((k >> 8) * 4 + (k & 3)) * 64 + ((k & 255) >> 2); *(LAS f32x4*)(WRT + row * 20 + 4 * c4) = v; }
    __syncthreads();
    f32x4 gv[4];
#pragma unroll
    for (int j = 0; j < 4; ++j) gv[j] = *(const f32x4*)(a.in[I_N2G] + 256 * j + 4 * lane);
    f32x4 nx[2][4];
    if (p_lo + gw < p_hi) {
#pragma unroll
        for (int r = 0; r < 2; ++r)
#pragma unroll
            for (int j = 0; j < 4; ++j) nx[r][j] = *(const f32x4*)(a.in[I_X] + (size_t)(2 * (p_lo + gw) + r) * 1024 + 256 * j + 4 * lane); }
    if (wait_word >= 0) panel_wait((unsigned*)(ws + WS_CTL), wait_word, 4u);
    if (p_lo + gw < p_hi) {
#pragma unroll
        for (int r = 0; r < 2; ++r)
#pragma unroll
            for (int j = 0; j < 4; ++j) { const size_t o_ = (size_t)(2 * (p_lo + gw) + r) * 1024 + 256 * j + 4 * lane; const u32x2 d_ = *(const u32x2*)((const bf16*)(ws + WS_YD) + o_);
                nx[r][j] = nx[r][j] + (f32x4){bflo(d_.x), bfhi(d_.x), bflo(d_.y), bfhi(d_.y)}; } }
    for (int pr = p_lo + gw; pr < p_hi; pr += NGW) {
        const int m0 = 2 * pr, b = m0 >> 13; const float* mod = MOD + (size_t)b * 6144;
        f32x4 v[2][4]; float ss[2];
#pragma unroll
        for (int r = 0; r < 2; ++r) { float q = 0.f;
#pragma unroll
            for (int j = 0; j < 4; ++j) { u32x2 w_; w_.x = cvt_pk_bf16(nx[r][j][0], nx[r][j][1]); w_.y = cvt_pk_bf16(nx[r][j][2], nx[r][j][3]);
                *(u32x2*)((bf16*)(ws + WS_YD) + (size_t)(m0 + r) * 1024 + 256 * j + 4 * lane) = w_;
                v[r][j] = (f32x4){bflo(w_.x), bfhi(w_.x), bflo(w_.y), bfhi(w_.y)}; q += v[r][j][0] * v[r][j][0] + v[r][j][1] * v[r][j][1] + v[r][j][2] * v[r][j][2] + v[r][j][3] * v[r][j][3]; }
            ss[r] = q; }
        if (pr + NGW < p_hi) {
#pragma unroll
            for (int r = 0; r < 2; ++r)
#pragma unroll
                for (int j = 0; j < 4; ++j) { const size_t o_ = (size_t)(2 * (pr + NGW) + r) * 1024 + 256 * j + 4 * lane; const u32x2 d_ = *(const u32x2*)((const bf16*)(ws + WS_YD) + o_);
                    nx[r][j] = *(const f32x4*)(a.in[I_X] + o_) + (f32x4){bflo(d_.x), bfhi(d_.x), bflo(d_.y), bfhi(d_.y)}; } }
#pragma unroll
        for (int r = 0; r < 2; ++r) { const float rstd = rsqrtf(wave_sum(ss[r]) * (1.f / 1024.f) + EPS);
#pragma unroll
            for (int j = 0; j < 4; ++j) { const f32x4 sc = *(const f32x4*)(mod + 4096 + 256 * j + 4 * lane), sh = *(const f32x4*)(mod + 3072 + 256 * j + 4 * lane); v[r][j] = v[r][j] * rstd * gv[j] * (sc + 1.f) + sh; }
            unsigned char* hp = ws + WS_H2 + (size_t)(m0 + r) * 1024;
#pragma unroll
            for (int j = 0; j < 4; ++j) *(unsigned*)(hp + 256 * j + 4 * lane) = pk4_fp8(v[r][j][0], v[r][j][1], v[r][j][2], v[r][j][3]); }
        f32x2 r2[16];
#pragma unroll
        for (int i = 0; i < 16; ++i) r2[i] = (f32x2){0.f, 0.f};
#pragma unroll
        for (int j = 0; j < 4; ++j)
#pragma unroll
            for (int i = 0; i < 4; ++i) { const f32x2 hab = {v[0][j][i], v[1][j][i]}; const LAS float* rp = WRT + ((j * 4 + i) * 64 + lane) * 20;
#pragma unroll
                for (int c4 = 0; c4 < 4; ++c4) { const f32x4 w = *(const LAS f32x4*)(rp + 4 * c4); r2[4 * c4 + 0] += hab * w[0]; r2[4 * c4 + 1] += hab * w[1]; r2[4 * c4 + 2] += hab * w[2]; r2[4 * c4 + 3] += hab * w[3]; }
                if (i & 1) asm volatile("" ::: "memory"); }
#pragma unroll
        for (int r = 0; r < 2; ++r) {
            float racc[16];
#pragma unroll
            for (int i = 0; i < 16; ++i) racc[i] = r2[i][r];
            RSTEP(16, 32); RSTEP(8, 16); RSTEP(4, 8); RSTEP(2, 4); racc[0] += __shfl_xor(racc[0], 2); racc[0] += __shfl_xor(racc[0], 1);
            const float lg = racc[0];
            float mx = lg; mx = fmaxf(mx, __shfl_xor(mx, 4)); mx = fmaxf(mx, __shfl_xor(mx, 8)); mx = fmaxf(mx, __shfl_xor(mx, 16)); mx = fmaxf(mx, __shfl_xor(mx, 32));
            const float ex = expf(lg - mx); float sm = ex; sm += __shfl_xor(sm, 4); sm += __shfl_xor(sm, 8); sm += __shfl_xor(sm, 16); sm += __shfl_xor(sm, 32);
            const int m = m0 + r;
            if ((lane & 3) == 0) ((float*)(ws + WS_AFF))[(size_t)(b * 16 + (lane >> 2)) * SEQ + (m & (SEQ - 1))] = ex / sm;
            if (lane < 16) ((int*)(ws + WS_INV))[(size_t)m * 16 + lane] = -1;
        }
    }
}

__device__ __forceinline__ void topk_unit(LAS unsigned char* lds, const Args& a, int be, int tid, int lane, int wave) {
    unsigned char* ws = a.ws;
    LAS unsigned* hist = (LAS unsigned*)lds;
    LAS unsigned* sel = hist + 256;
    LAS unsigned* wtot = hist + 264;
    const float* aff = (const float*)(ws + WS_AFF) + (size_t)be * SEQ + 16 * tid;
    unsigned key[16];
#pragma unroll
    for (int q = 0; q < 4; ++q) { const u32x4 v = *(const u32x4*)(aff + 4 * q); key[4 * q] = v[0]; key[4 * q + 1] = v[1]; key[4 * q + 2] = v[2]; key[4 * q + 3] = v[3]; }
    unsigned prefix = 0u, mask = 0u, kk = CAP;
    for (int pass = 0; pass < 4; ++pass) {
        const int shift = 24 - 8 * pass;
        if (tid < 256) hist[tid] = 0u;
        __syncthreads();
#pragma unroll
        for (int i = 0; i < 16; ++i) if ((key[i] & mask) == prefix) __hip_atomic_fetch_add(hist + ((key[i] >> shift) & 255u), 1u, __ATOMIC_RELAXED, __HIP_MEMORY_SCOPE_WORKGROUP);
        __syncthreads();
        if (wave == 0) {
            const unsigned h0 = hist[4 * lane], h1 = hist[4 * lane + 1], h2 = hist[4 * lane + 2], h3 = hist[4 * lane + 3], loc = h0 + h1 + h2 + h3;
            unsigned suf = loc;
#pragma unroll
            for (int o = 1; o < 64; o <<= 1) { const unsigned t = __shfl_down(suf, o); if (lane + o < 64) suf += t; }
            const unsigned above = suf - loc;
            const unsigned s3 = above + h3, s2 = s3 + h2, s1 = s2 + h1, s0 = s1 + h0;
            if (s3 >= kk && above < kk) { sel[0] = 4 * lane + 3; sel[1] = kk - above; }
            if (s2 >= kk && s3 < kk) { sel[0] = 4 * lane + 2; sel[1] = kk - s3; }
            if (s1 >= kk && s2 < kk) { sel[0] = 4 * lane + 1; sel[1] = kk - s2; }
            if (s0 >= kk && s1 < kk) { sel[0] = 4 * lane + 0; sel[1] = kk - s1; }
        }
        __syncthreads();
        prefix |= sel[0] << shift; mask |= 255u << shift; kk = sel[1];
        __syncthreads();
    }
    unsigned cgt = 0u, ceq = 0u;
#pragma unroll
    for (int i = 0; i < 16; ++i) { cgt += (key[i] > prefix) ? 1u : 0u; ceq += (key[i] == prefix) ? 1u : 0u; }
    const unsigned val = cgt | (ceq << 16); unsigned inc = val;
#pragma unroll
    for (int o = 1; o < 64; o <<= 1) { const unsigned t = __shfl_up(inc, o); if (lane >= o) inc += t; }
    if (lane == 63) wtot[wave] = inc;
    __syncthreads();
    unsigned base = 0u;
    for (int w = 0; w < wave; ++w) base += wtot[w];
    const unsigned excl = base + inc - val; unsigned gtb = excl & 0xffffu, eqb = excl >> 16;
    const int b = be >> 4, e = be & 15;
    int* IDX = (int*)(ws + WS_IDX) + be * CAP; float* WSEL = (float*)(ws + WS_WSEL) + be * CAP; int* INV = (int*)(ws + WS_INV);
#pragma unroll
    for (int i = 0; i < 16; ++i) { const bool gt = key[i] > prefix, eq = key[i] == prefix; const bool take = gt || (eq && eqb < kk);
        if (take) { const unsigned pos = gtb + (eqb < kk ? eqb : kk); const int row = b * SEQ + 16 * tid + i; IDX[pos] = row; WSEL[pos] = __builtin_bit_cast(float, key[i]); INV[(size_t)row * 16 + e] = (int)pos; }
        gtb += gt ? 1u : 0u; eqb += eq ? 1u : 0u; }
    __syncthreads();
}
__device__ __forceinline__ void phase9(LAS unsigned char* lds, const Args& a, int vcu, int G, int tid, int lane, int wave) {
    const int ntk = (G > 64) ? 32 : 0;
    if (vcu < ntk || ntk == 0) for (int r_ = 0; r_ < a.rep[7]; ++r_) for (int be = (ntk ? vcu : vcu); be < NB * NE; be += (ntk ? ntk : G)) topk_unit(lds, a, be, tid, lane, wave);
    if (vcu >= ntk) for (int r_ = 0; r_ < a.rep[8]; ++r_) { const int gw = (vcu - ntk) * NWAVES + wave, NGW = (G - ntk) * NWAVES; convert_items<2>((LAS float*)(lds + 8192 + wave * 8448), a, gw, NGW, 8192, lane); }
}

struct P12Pre { u32x2 d[4]; int ninv; };
__device__ __forceinline__ void p12_prefetch(P12Pre& pre, const Args& a, int vcu, int G, int lane, int wave) {
    unsigned char* ws = a.ws; const int gw = vcu * NWAVES + wave;
    pre.ninv = -1;
#pragma unroll
    for (int j = 0; j < 4; ++j) pre.d[j] = (u32x2){0u, 0u};
    if (gw < M) {
#pragma unroll
        for (int j = 0; j < 4; ++j) pre.d[j] = __builtin_nontemporal_load((const u32x2*)((const bf16*)(ws + WS_YD) + (size_t)gw * 1024 + 256 * j + 4 * lane));
        pre.ninv = (lane < 16) ? ((const int*)(ws + WS_INV))[(size_t)gw * 16 + lane] : -1; }
}
__device__ __forceinline__ void phase12(const Args& a, int vcu, int G, int lane, int wave, const P12Pre& pre) {
    unsigned char* ws = a.ws;
    const int gw = vcu * NWAVES + wave, NGW = G * NWAVES;
    f32x4 gv[4];
#pragma unroll
    for (int j = 0; j < 4; ++j) gv[j] = *(const f32x4*)(a.in[I_FNG] + 256 * j + 4 * lane);
    f32x4 nx[4]; int ninv = pre.ninv;
#pragma unroll
    for (int j = 0; j < 4; ++j) nx[j] = (f32x4){bflo(pre.d[j].x), bfhi(pre.d[j].x), bflo(pre.d[j].y), bfhi(pre.d[j].y)};
    for (int m = gw; m < M; m += NGW) {
        const int b = m >> 13; float* row = a.out + (size_t)m * 1024;
        f32x4 v[4];
#pragma unroll
        for (int j = 0; j < 4; ++j) v[j] = nx[j];
        const int myinv = ninv;
        if (m + NGW < M) {
#pragma unroll
            for (int j = 0; j < 4; ++j) { const size_t o_ = (size_t)(m + NGW) * 1024 + 256 * j + 4 * lane; const u32x2 d_ = __builtin_nontemporal_load((const u32x2*)((const bf16*)(ws + WS_YD) + o_));
                nx[j] = (f32x4){bflo(d_.x), bfhi(d_.x), bflo(d_.y), bfhi(d_.y)}; }
            ninv = (lane < 16) ? ((const int*)(ws + WS_INV))[(size_t)(m + NGW) * 16 + lane] : -1; }
        unsigned long long mask = __ballot(myinv >= 0);
        const unsigned char* yb = ws + WS_YB + (size_t)(b * 16) * CAP * 1024;
        while (mask) {
            unsigned w[4][4]; float sc[4];
#pragma unroll
            for (int q = 0; q < 4; ++q) { const bool on = mask != 0ull; const int e = on ? (int)__builtin_ctzll(mask) : 0; mask = on ? (mask & (mask - 1ull)) : 0ull;
                const int sl = __shfl(myinv, e); const size_t ro = on ? ((size_t)e * CAP + (size_t)sl) * 1024 : 0; sc[q] = on ? 0.0625f : 0.f;
#pragma unroll
                for (int j = 0; j < 4; ++j) w[q][j] = __builtin_nontemporal_load((const unsigned*)(yb + ro + 256 * j + 4 * lane)); }
#pragma unroll
            for (int q = 0; q < 4; ++q)
#pragma unroll
                for (int j = 0; j < 4; ++j) { const f32x2 lo_ = __builtin_amdgcn_cvt_pk_f32_fp8((int)w[q][j], false), hi_ = __builtin_amdgcn_cvt_pk_f32_fp8((int)w[q][j], true);
                    v[j][0] += sc[q] * lo_[0]; v[j][1] += sc[q] * lo_[1]; v[j][2] += sc[q] * hi_[0]; v[j][3] += sc[q] * hi_[1]; }
        }
        float ss = 0.f;
#pragma unroll
        for (int j = 0; j < 4; ++j) ss += v[j][0] * v[j][0] + v[j][1] * v[j][1] + v[j][2] * v[j][2] + v[j][3] * v[j][3];
        const float rstd = rsqrtf(wave_sum(ss) * (1.f / 1024.f) + EPS);
#pragma unroll
        for (int j = 0; j < 4; ++j) __builtin_nontemporal_store(v[j] * rstd * gv[j], (f32x4*)(row + 256 * j + 4 * lane));
    }
}

__global__ void __launch_bounds__(NT, 2) fwd_kernel(Args args) {
    extern __shared__ __attribute__((aligned(16))) unsigned char lds_raw[];
    LAS unsigned char* lds = (LAS unsigned char*)lds_raw;
    volatile LAS unsigned* MISC = (volatile LAS unsigned*)(lds + MISC_OFF);
    const int tid0 = threadIdx.x, tid = tid0, wave = __builtin_amdgcn_readfirstlane(tid >> 6);
    const int G = gridDim.x, bx = blockIdx.x, vcu = (G % 8 == 0) ? (bx % 8) * (G / 8) + bx / 8 : bx;
    unsigned char* ws = args.ws;
    if (tid < 128) MISC[tid] = 0u;
    __syncthreads();
    XcdBarrier bar; bar.bar = (unsigned*)(ws + WS_CTL) + CW_BAR; bar.x = 0; bar.st = nullptr;
    if (!MK_MULTI) bar = xcd_barrier_post((unsigned*)(ws + WS_CTL) + CW_BAR, MISC + 8);
    const int lo = args.ph_lo, hi = args.ph_hi;
#define IN(k) (lo <= (k) && (k) < hi)
#define SEAM(k) do { if (IN(k) && IN((k) + 1)) xcd_barrier(bar); } while (0)
#define RUN(k, CODE) do { if (IN(k)) { int tid = tid0, lane; asm volatile("" : "+v"(tid)); lane = tid & 63; (void)lane; CODE; if (REP_PHASE == (k)) for (int _r = 0; _r < REP_COUNT; ++_r) { xcd_barrier(bar); CODE; } } SEAM(k); } while (0)
#define PH0 phase0(lds, args, vcu, G, tid, lane, wave, 0)
#define PH1 phase1(lds, args, vcu, G, tid, lane, wave, false)
#define PH2 do { const int qs = (vcu & 1) ? 1 : 0;     \
        EpiInproj E{(bf16*)(ws + WS_KB), (bf16*)(ws + WS_VB), (bf16*)(ws + WS_QB), (bf16*)(ws + WS_SG), (bf16*)(ws + WS_PI), ws + WS_SM, 0, 1.f}; \
        EpiGates E8{(bf16*)(ws + WS_KB), (bf16*)(ws + WS_VB), (bf16*)(ws + WS_QB), (bf16*)(ws + WS_SG), (bf16*)(ws + WS_PI), ws + WS_SM, 8, 0.0625f}; \
        if (qs == 0) for (int r_ = 0; r_ < args.rep[6]; ++r_) { int t_ = threadIdx.x; asm volatile("" : "+v"(t_)); convert_all<1>(lds, args, vcu, G, t_ & 63, wave); } \
        for (int r_ = 0; r_ < args.rep[0]; ++r_) { SchedDense S{G, bx, 1024, 64, 8, (const char*)(ws + WS_H1), (const char*)(ws + WS_WIN), 0, 1 << 20, 2}; pg8::gemm_phase<EpiInproj, SchedDense, false, false>(lds, S, E); }     \
        panel_arrive((unsigned*)(ws + WS_CTL), CW_INPROJ);     \
        if (qs == 1) for (int r_ = 0; r_ < args.rep[6]; ++r_) { int t_ = threadIdx.x; asm volatile("" : "+v"(t_)); convert_all<1>(lds, args, vcu, G, t_ & 63, wave); } \
        for (int r_ = 0; r_ < args.rep[1]; ++r_) { SchedDense S{G, bx, 1024, 64, 8, (const char*)(ws + WS_H1F), (const char*)(ws + WS_WINM), 0, 1 << 20, 1}; pg8::gemm_phase<EpiGates, SchedDense, false, true>(lds, S, E8); }     \
        if (qs == 2) for (int r_ = 0; r_ < args.rep[6]; ++r_) { int t_ = threadIdx.x; asm volatile("" : "+v"(t_)); convert_all<1>(lds, args, vcu, G, t_ & 63, wave); } } while (0)
#define PH3 chunk_units(lds, args, vcu, G, tid, lane, wave)
#define PH4 do { pool_units(args, vcu, G, lane, wave, 8); phase4(args, G, tid, NT / 2); } while (0)
#define PH5 phase5(lds, args, vcu, G, tid, lane, wave)
#define PH6 do { SchedPair S{G, bx, 512, (const char*)(ws + WS_AG), (const char*)(ws + WS_PO), (const char*)(ws + WS_WG), (const char*)(ws + WS_WC)}; \
        EpiMerge E{ws + WS_SM, (bf16*)(ws + WS_MG)}; for (int r_ = 0; r_ < args.rep[4]; ++r_) pg8::gemm_phase<EpiMerge, SchedPair, false>(lds, S, E); } while (0)
#define PH7 do { SchedDense S{G, bx, 1024, 64, 4, (const char*)(ws + WS_MG), (const char*)(ws + WS_WO), 0, 1 << 20, 2}; \
        EpiOut E{(const float*)(ws + WS_MOD), (bf16*)(ws + WS_YD)}; for (int r_ = 0; r_ < args.rep[5]; ++r_) pg8::gemm_phase<EpiOut, SchedDense, false>(lds, S, E); } while (0)
#define NITEM_HALF ((NE * 3 * 512 + 2 * G * NWAVES - 1) / (2 * G * NWAVES))
#define PH6C do { if (vcu & 1) convert_experts(lds, args, vcu, G, lane, wave, 0, NITEM_HALF); PH6; if (!(vcu & 1)) convert_experts(lds, args, vcu, G, lane, wave, 0, NITEM_HALF); } while (0)
#define PH7C do { if (vcu & 1) convert_experts(lds, args, vcu, G, lane, wave, NITEM_HALF, 2 * NITEM_HALF); PH7; if (!(vcu & 1)) convert_experts(lds, args, vcu, G, lane, wave, NITEM_HALF, 2 * NITEM_HALF); } while (0)
#define PH8 phase8(lds, args, vcu * NWAVES + wave, G * NWAVES, 0, M / 2, -1, tid, lane, wave)
#define PH9 phase9(lds, args, vcu, G, tid, lane, wave)
#define PH9B do { const int gw_ = vcu * NWAVES + wave, NGW_ = G * NWAVES;     \
        for (int r0_ = gw_ * 16; r0_ < NB * NE * CAP; r0_ += NGW_ * 16) { u32x4 t_[16]; \
            _Pragma("unroll") for (int q = 0; q < 16; ++q) { const int src_ = ((const int*)(ws + WS_IDX))[r0_ + q]; t_[q] = *(const u32x4*)(ws + WS_H2 + (size_t)src_ * 1024 + lane * 16); } \
            _Pragma("unroll") for (int q = 0; q < 16; ++q) *(u32x4*)(ws + WS_XS + (size_t)(r0_ + q) * 1024 + lane * 16) = t_[q]; } } while (0)
#define PH10 do { EpiMoe1 E{ws + WS_ACT}; SchedMoe1G S{G, bx, 1024, (const char*)(ws + WS_H2), (const char*)(ws + WS_WGU), (const int*)(ws + WS_IDX)}; for (int r_ = 0; r_ < args.rep[2]; ++r_) pg8::gemm_phase<EpiMoe1, SchedMoe1G, true, true>(lds, S, E); } while (0)
#define PH11 do { SchedMoe2 S{G, bx, 1024, (const char*)(ws + WS_ACT), (const char*)(ws + WS_WD)}; \
        EpiMoe2 E{(bf16*)(ws + WS_YB), (const float*)(ws + WS_WSEL), (const float*)(ws + WS_MOD)}; for (int r_ = 0; r_ < args.rep[3]; ++r_) pg8::gemm_phase<EpiMoe2, SchedMoe2, false, true>(lds, S, E); } while (0)
    if (IN(0)) { int tid = tid0, lane; asm volatile("" : "+v"(tid)); lane = tid & 63; PH0; }
    {
        XbTicket t_; t_.gen = 0u; t_.tg = 0u; t_.role = 0u; const bool sb_ = IN(0) && IN(1), pre_ = IN(1) && (G > 96) && (vcu >= 96);
        if (sb_) t_ = xcd_barrier_arrive(bar);
        if (IN(0)) { int tid = tid0, lane; asm volatile("" : "+v"(tid)); lane = tid & 63; phase0(lds, args, vcu, G, tid, lane, wave, 1); }
        if (pre_) { int tid = tid0; asm volatile("" : "+v"(tid)); p1_stage_wr(lds, args, tid); }
        if (sb_) xcd_barrier_wait(bar, t_);
        if (IN(1)) { int tid = tid0, lane; asm volatile("" : "+v"(tid)); lane = tid & 63; phase1(lds, args, vcu, G, tid, lane, wave, pre_); }
        SEAM(1);
    }
    if (G == 256) { if (IN(2)) { int tid = tid0, lane; asm volatile("" : "+v"(tid)); lane = tid & 63; (void)lane; PH2; } }
    else RUN(2, PH2);
    if (IN(3)) { int tid = tid0, lane; asm volatile("" : "+v"(tid)); lane = tid & 63; if (G == 256) panel_wait((unsigned*)(ws + WS_CTL), CW_INPROJ, (unsigned)G); PH3; }
    {
        XbTicket t_; t_.gen = 0u; t_.tg = 0u; t_.role = 0u; const bool sb_ = IN(3) && IN(4);
        if (sb_) t_ = xcd_barrier_arrive(bar);
        int tid = tid0, lane; asm volatile("" : "+v"(tid)); lane = tid & 63;
        if (IN(4)) pool_units(args, vcu, G, lane, wave, 8);
        if (sb_) xcd_barrier_wait(bar, t_);
        if (IN(4)) phase4(args, G, tid, NT / 2);
        SEAM(4);
    }
#define PH3A chunk_units(lds, args, vcu, G, tid, lane, wave)
#define PH3B pool_units(args, vcu, G, lane, wave, 8)
    if (REP_PHASE == 40) { xcd_barrier(bar); if (wave < 4) phase4(args, G, tid, 256); xcd_barrier(bar); }
    if (REP_PHASE == 41) { const int lane = tid & 63; xcd_barrier(bar); if (wave >= 4) pool_units(args, vcu, G, lane, wave - 4, 4); xcd_barrier(bar); }
    if (REP_PHASE == 30) { const int lane = tid & 63; xcd_barrier(bar); PH3A; xcd_barrier(bar); }
    if (REP_PHASE == 31) { const int lane = tid & 63; xcd_barrier(bar); PH3B; xcd_barrier(bar); }
    if (G != 256) RUN(5, PH5);
    if (G == 256) {
        int cpm, cpn; pg8::xcd_tile(bx, 64, 4, cpm, cpn); unsigned* ctl_ = (unsigned*)(ws + WS_CTL);
        if (IN(5)) { int tid = tid0, lane; asm volatile("" : "+v"(tid)); lane = tid & 63; PH5; }
        if (IN(6)) { int tid = tid0, lane; asm volatile("" : "+v"(tid)); lane = tid & 63; (void)lane; panel_wait(ctl_, CW_PANEL5 + 16 * cpm, 16u); PH6; panel_arrive(ctl_, CW_PANEL6 + 16 * cpm); }
        if (IN(7)) { int tid = tid0, lane; asm volatile("" : "+v"(tid)); lane = tid & 63; (void)lane; panel_wait(ctl_, CW_PANEL6 + 16 * cpm, 4u); PH7; panel_arrive(ctl_, CW_PANEL7 + 16 * cpm); }
        if (IN(8)) { int tid = tid0, lane; asm volatile("" : "+v"(tid)); lane = tid & 63; phase8(lds, args, wave, NWAVES, cpm * 128 + cpn * 32, cpm * 128 + cpn * 32 + 32, CW_PANEL7 + 16 * cpm, tid, lane, wave); }
        SEAM(8);
    } else { RUN(6, PH6); RUN(7, PH7); RUN(8, PH8); }
    RUN(9, PH9); RUN(10, PH10);
    if (IN(11)) { int tid = tid0, lane; asm volatile("" : "+v"(tid)); lane = tid & 63; (void)lane; PH11; }
    if (REP_PHASE == 20) for (int _r = 0; _r < REP_COUNT; ++_r) xcd_barrier(bar);
    {
        XbTicket t_; t_.gen = 0u; t_.tg = 0u; t_.role = 0u; const bool sb_ = IN(11) && IN(12);
        if (sb_) t_ = xcd_barrier_arrive(bar);
        P12Pre pre_; int tid = tid0, lane; asm volatile("" : "+v"(tid)); lane = tid & 63;
        if (IN(12)) p12_prefetch(pre_, args, vcu, G, lane, wave);
        if (sb_) xcd_barrier_wait(bar, t_);
        if (IN(12)) phase12(args, vcu, G, lane, wave, pre_);
    }
#undef IN
#undef SEAM
#undef RUN
}

#ifndef MK_CHECK
#define MK_CHECK 0
#endif
#ifndef CHK_SKIP
#define CHK_SKIP -1
#endif
#if MK_CHECK
constexpr size_t WS_CHK = 299 * MiB;
__device__ __forceinline__ unsigned hashu(unsigned x) { x ^= x >> 16; x *= 0x7feb352dU; x ^= x >> 15; x *= 0x846ca68bU; x ^= x >> 16; return x; }
__device__ __forceinline__ float bfr(float f) { return bf2f(f2bf(f)); }
__device__ float f8d(unsigned char x) { const int sg = x >> 7, e = (x >> 3) & 15, m = x & 7; const float v = e ? ldexpf(1.f + m / 8.f, e - 7) : ldexpf(m / 8.f, -6); return sg ? -v : v; }
__device__ float f8r(float f) { return f8d((unsigned char)(pk4_fp8(f, 0.f, 0.f, 0.f) & 255u)); }
__device__ float x1_at(const Args& a, int m, int k) { return bf2f(((const bf16*)(a.ws + WS_YD))[(size_t)m * 1024 + k]); }
__device__ float naive_rstd_x1(const Args& a, int m) { float ss = 0.f; for (int k = 0; k < 1024; ++k) { const float v = x1_at(a, m, k); ss += v * v; } return rsqrtf(ss / 1024.f + EPS); }
__device__ float gate_at(const Args& a, int m, int n) {
    const int pm = m >> 8, r = m & 255, ai = r >> 7, wr = (r >> 6) & 1, mm = (r >> 4) & 3, fr = r & 15, pg = n >> 8, c = n & 255, bj = c >> 7, wc = (c >> 5) & 3, fq = (c >> 3) & 3, j8 = c & 7;
    return (float)(a.ws + WS_SM)[gate_off(pm, pg, ai, mm, bj, wr, wc, fr, fq) + j8] * (1.f / 255.f); }
__device__ float naive_rstd(const float* row) { float ss = 0.f; for (int k = 0; k < 1024; ++k) ss += row[k] * row[k]; return rsqrtf(ss / 1024.f + EPS); }
__device__ float naive_la(const Args& a, int row, int dir, int col) {
    const float* RB = (const float*)(a.ws + WS_RB) + (size_t)row * 32 + dir * 16; float z = a.in[I_BDEC][dir * 256 + col];
    for (int j = 0; j < 16; ++j) z += RB[j] * a.in[I_WDU][(size_t)(dir * 16 + j) * 256 + col];
    return logsig_f(z) / 16.f;
}
__global__ void chk_kernel(Args a, int stage) {
    __shared__ float sh[256];
    const unsigned gid = blockIdx.x * blockDim.x + threadIdx.x; unsigned h = hashu(gid * 2654435761u + (unsigned)stage * 97u + 12345u); const unsigned h2 = hashu(h + 777u);
    unsigned char* ws = a.ws; float ref = 0.f, got = 0.f, atol = 1e-3f; bool active = true;
    const float* MOD = (const float*)(ws + WS_MOD);
    switch (stage) {
    case 0: { const int v = h % 3, n = (h >> 2) % 6144; ref = a.in[I_ADAB][n]; for (int k = 0; k < 1024; ++k) { const float c = (v < 2) ? a.in[I_C][v * 1024 + k] : a.in[I_CCTX][k]; ref += c / (1.f + expf(-c)) * a.in[I_ADAW][(size_t)k * 6144 + n]; } got = MOD[v * 6144 + n]; atol = 0.01f; } break;
    case 1: { const int sel = (h >> 28) & 3, n = h % 4096, k = (h >> 12) % 1024;
        if (sel < 2) { if (n < 2048) { ref = bfr(a.in[I_WIN][(size_t)k * DIN + n + (n >= 768 ? 32 : 0)]); got = bf2f(((const bf16*)(ws + WS_WIN))[(size_t)n * 1024 + k]); } else { ref = f8r(16.f * a.in[I_WIN][(size_t)k * DIN + n + 32]); got = f8d((ws + WS_WINM)[(size_t)(n - 2048) * 1024 + k]); } }
        else if (sel == 2) { ref = bfr(a.in[I_WOUT][(size_t)k * 1024 + (n & 1023)]); got = bf2f(((const bf16*)(ws + WS_WO))[(size_t)(n & 1023) * 1024 + k]); }
        else { ref = bfr(a.in[I_WGLA][(size_t)(k & 511) * 1024 + (n & 1023)]); got = bf2f(((const bf16*)(ws + WS_WG))[(size_t)(n & 1023) * 512 + (k & 511)]); } atol = 1e-4f; } break;
    case 2: { const int n = h % 1024, kk = (h >> 10) % 512, g = kk >> 7, c = kk & 127; for (int d = 0; d < 128; ++d) ref += a.in[I_POOLW][(size_t)(g * 128 + c) * 128 + d] * a.in[I_POOLS][g * 128 + d] * a.in[I_WPOOL][(size_t)(g * 128 + d) * 1024 + n];
        got = bf2f(((const bf16*)(ws + WS_WC))[(size_t)n * 512 + kk]); atol = 0.002f; } break;
    case 3: { const int m = h % M, k = (h >> 14) % 1024, b = m >> 13; const float* row = a.in[I_X] + (size_t)m * 1024; const float rstd = naive_rstd(row);
        ref = row[k] * rstd * a.in[I_N1G][k] * (1.f + MOD[b * 6144 + 1024 + k]) + MOD[b * 6144 + k]; got = bf2f(((const bf16*)(ws + WS_H1))[(size_t)m * 1024 + k]); atol = 0.01f; } break;
    case 4: { const int m = h % MT, c = (h >> 15) % 32, mi = (m < M) ? (m >> 13) : 2; const float* row = (m < M) ? a.in[I_X] + (size_t)m * 1024 : a.in[I_CTX] + (size_t)(m - M) * 1024; const float rstd = naive_rstd(row);
        for (int k = 0; k < 1024; ++k) ref += (row[k] * rstd * a.in[I_N1G][k] * (1.f + MOD[mi * 6144 + 1024 + k]) + MOD[mi * 6144 + k]) * a.in[I_WIN][(size_t)k * DIN + 768 + c];
        got = ((const float*)(ws + WS_RB))[(size_t)m * 32 + c]; atol = 0.01f; } break;
    case 5: { const int r = h % 512, n = (h >> 9) % 768; const float* row = a.in[I_CTX] + (size_t)r * 1024; const float rstd = naive_rstd(row);
        for (int k = 0; k < 1024; ++k) ref += bfr(row[k] * rstd * a.in[I_N1G][k] * (1.f + MOD[2 * 6144 + 1024 + k]) + MOD[2 * 6144 + k]) * bf2f(((const bf16*)(ws + WS_WIN))[(size_t)n * 1024 + k]);
        got = (n < 256) ? bf2f(((const bf16*)(ws + WS_KB))[(size_t)(M + r) * 256 + n]) : bf2f(((const bf16*)(ws + WS_VB))[(size_t)(M + r) * 512 + n - 256]); atol = 0.03f; } break;
    case 6: { const int m = h % M, n = (h >> 14) % 4096; const bf16* hr = (const bf16*)(ws + WS_H1) + (size_t)m * 1024; const bf16* wr_ = (const bf16*)(ws + WS_WIN) + (size_t)n * 1024; float d = 0.f;
        if (n < 2048) { for (int k = 0; k < 1024; ++k) d += bf2f(hr[k]) * bf2f(wr_[k]); }
        else { for (int k = 0; k < 1024; ++k) d += f8d((ws + WS_H1F)[(size_t)m * 1024 + k]) * f8d((ws + WS_WINM)[(size_t)(n - 2048) * 1024 + k]); d *= 0.0625f; }
        if (n < 256) { ref = d; got = bf2f(((const bf16*)(ws + WS_KB))[(size_t)m * 256 + n]); }
        else if (n < 768) { ref = d; got = bf2f(((const bf16*)(ws + WS_VB))[(size_t)m * 512 + n - 256]); }
        else if (n < 1024) { ref = d * 0.125f; got = bf2f(((const bf16*)(ws + WS_QB))[(size_t)m * 256 + n - 768]); }
        else if (n < 1536) { ref = d / (1.f + expf(-d)); got = bf2f(((const bf16*)(ws + WS_SG))[(size_t)m * 512 + n - 1024]); }
        else if (n < 2048) { ref = d; got = bf2f(((const bf16*)(ws + WS_PI))[(size_t)m * 512 + n - 1536]); }
        else { ref = 1.f / (1.f + expf(-d)); got = gate_at(a, m, n - 2048); } atol = 0.02f; } break;
    case 7: { const int m = h % M, col = (h >> 14) % 256, dir = (h >> 22) & 1, t = m & 63, m0 = m - t;
        for (int s = 0; s < 64; ++s) if (dir ? (s >= t) : (s <= t)) ref += naive_la(a, m0 + s, dir, col);
        got = (float)((const _Float16*)a.out)[(size_t)dir * M * 256 + (size_t)m * 256 + col]; atol = 0.006f; } break;
    case 8: case 9: { const int dir = h & 1, bh = (h >> 1) & 7, slot = (stage == 9) ? 128 + ((h >> 4) & 3) : ((h >> 4) & 127), dv = (h >> 11) & 127, dk = (h >> 18) & 63, b = bh >> 2, hh = bh & 3;
        const int row0 = (slot < 128) ? b * SEQ + slot * 64 : M + b * LC + (slot - 128) * 64; float la[64]; float tot = 0.f;
        for (int s = 0; s < 64; ++s) tot += naive_la(a, row0 + s, dir, hh * 64 + dk);
        float run = 0.f;
        if (!dir) { for (int s = 0; s < 64; ++s) { run += naive_la(a, row0 + s, 0, hh * 64 + dk); ref += bf2f(((const bf16*)(ws + WS_VB))[(size_t)(row0 + s) * 512 + hh * 128 + dv]) * bfr(bf2f(((const bf16*)(ws + WS_KB))[(size_t)(row0 + s) * 256 + hh * 64 + dk]) * expf(tot - run)); } }
        else { for (int s = 63; s >= 0; --s) { run += naive_la(a, row0 + s, 1, hh * 64 + dk); ref += bf2f(((const bf16*)(ws + WS_VB))[(size_t)(row0 + s) * 512 + hh * 128 + dv]) * bfr(bf2f(((const bf16*)(ws + WS_KB))[(size_t)(row0 + s) * 256 + hh * 64 + dk]) * expf(tot - run)); } }
        (void)la;
        if ((h >> 30) & 1) { ref = expf(tot); got = ((const float*)(ws + WS_DEC))[((size_t)(dir * 8 + bh) * NSLOT + slot) * 64 + dk]; atol = 1e-3f; }
        else { got = bf2f(((const bf16*)(ws + WS_KV))[((size_t)(dir * 8 + bh) * NSLOT + slot) * 8192 + dv * 64 + dk]); atol = 0.1f; } } break;
    case 10: { const int m = h % M, col = (h >> 14) % 512, g = col >> 7, half = 1 << g, b = m >> 13, l = m & 8191, r = l >> 6, c = l & 63; const bf16* PI = (const bf16*)(ws + WS_PI);
        const int lo_r = max(r - half, 0), hi_r = min(r + half, 128), lo_c = max(c - half, 0), hi_c = min(c + half, 64); float sm = 0.f;
        for (int rr = lo_r; rr < hi_r; ++rr) for (int cc = lo_c; cc < hi_c; ++cc) sm += bf2f(PI[(size_t)(b * SEQ + rr * 64 + cc) * 512 + col]);
        ref = sm / (float)((hi_r - lo_r) * (hi_c - lo_c)) - bf2f(PI[(size_t)m * 512 + col]); got = bf2f(((const bf16*)(ws + WS_PO))[(size_t)m * 512 + col]); atol = 0.02f; } break;
    case 11: { const int dir = h & 1, bh = (h >> 1) & 7, n = (h >> 4) & 127, e8 = (h >> 11) & 8191, dk = e8 & 63; float s = 0.f;
        const bf16* kvp = (const bf16*)(ws + WS_KV) + (size_t)((dir * 8 + bh) * NSLOT) * 8192 + e8; const float* dp = (const float*)(ws + WS_DEC) + (size_t)((dir * 8 + bh) * NSLOT) * 64 + dk;
        if (!dir) { for (int j = 128; j < 132; ++j) s = dp[j * 64] * s + bf2f(kvp[(size_t)j * 8192]); for (int j = 0; j < n; ++j) s = dp[j * 64] * s + bf2f(kvp[(size_t)j * 8192]); }
        else { for (int j = 131; j >= 128; --j) s = dp[j * 64] * s + bf2f(kvp[(size_t)j * 8192]); for (int j = 127; j > n; --j) s = dp[j * 64] * s + bf2f(kvp[(size_t)j * 8192]); }
        ref = s; got = bf2f(((const bf16*)(ws + WS_ST))[(size_t)((dir * 8 + bh) * NCH + n) * 8192 + e8]); atol = 0.1f; } break;
    case 12: {
        const unsigned hb = hashu(blockIdx.x * 7919u + 5u); const int m = hb % M, hh = (hb >> 14) & 3, b = m >> 13, l = m & 8191, n = l >> 6, t = l & 63, row0 = m - t, bh = b * 4 + hh, dv = threadIdx.x & 127;
        const _Float16* BF = (const _Float16*)a.out; const _Float16* CB = BF + (size_t)M * 256; const bf16* QB = (const bf16*)(ws + WS_QB); const bf16* KB = (const bf16*)(ws + WS_KB); const bf16* VB = (const bf16*)(ws + WS_VB); const bf16* ST = (const bf16*)(ws + WS_ST);
        if (threadIdx.x < 128) { const int j = threadIdx.x & 63, dir = threadIdx.x >> 6; float sc = 0.f;
            const bool keep = dir ? (j >= t) : (j <= t);
            if (keep) for (int d = 0; d < 64; ++d) { const size_t gq = (size_t)m * 256 + hh * 64 + d, gk = (size_t)(row0 + j) * 256 + hh * 64 + d; const _Float16* P = dir ? CB : BF; sc += bf2f(QB[gq]) * bf2f(KB[gk]) * expf((float)P[gq] - (float)P[gk]); }
            sh[threadIdx.x] = sc; }
        __syncthreads();
        float o = 0.f;
        for (int d = 0; d < 64; ++d) { const size_t gq = (size_t)m * 256 + hh * 64 + d; const float q = bf2f(QB[gq]);
            o += q * expf(BF[gq]) * bf2f(ST[((size_t)((0 * 8 + bh) * NCH + n) * 128 + dv) * 64 + d]) + q * expf(CB[gq]) * bf2f(ST[((size_t)((1 * 8 + bh) * NCH + n) * 128 + dv) * 64 + d]); }
        for (int j = 0; j < 64; ++j) o += (sh[j] + sh[64 + j]) * bf2f(VB[(size_t)(row0 + j) * 512 + hh * 128 + dv]);
        __syncthreads(); sh[128 + dv] = o * o; __syncthreads();
        float ss = 0.f; for (int d = 0; d < 128; ++d) ss += sh[128 + d];
        const size_t gi = (size_t)m * 512 + hh * 128 + dv;
        ref = o * rsqrtf(ss / 128.f + EPS) * a.in[I_GNG][dv] * bf2f(((const bf16*)(ws + WS_SG))[gi]); got = bf2f(((const bf16*)(ws + WS_AG))[gi]); atol = 0.03f; } break;
    case 13: { const int m = h % M, n = (h >> 14) % 1024; float g = 0.f, p = 0.f; const bf16* AG = (const bf16*)(ws + WS_AG) + (size_t)m * 512; const bf16* PO = (const bf16*)(ws + WS_PO) + (size_t)m * 512;
        for (int k = 0; k < 512; ++k) { g += bf2f(AG[k]) * bf2f(((const bf16*)(ws + WS_WG))[(size_t)n * 512 + k]); p += bf2f(PO[k]) * bf2f(((const bf16*)(ws + WS_WC))[(size_t)n * 512 + k]); }
        ref = gate_at(a, m, n) * g + gate_at(a, m, 1024 + n) * p; got = bf2f(((const bf16*)(ws + WS_MG))[(size_t)m * 1024 + n]); atol = 0.03f; } break;
    case 14: { const int m = h % M, n = (h >> 14) % 1024, b = m >> 13; float d = 0.f; for (int k = 0; k < 1024; ++k) d += bf2f(((const bf16*)(ws + WS_MG))[(size_t)m * 1024 + k]) * bf2f(((const bf16*)(ws + WS_WO))[(size_t)n * 1024 + k]);
        ref = bfr(MOD[b * 6144 + 2048 + n] * d); got = bf2f(((const bf16*)(ws + WS_YD))[(size_t)m * 1024 + n]); atol = 0.005f; } break;
    case 15: { const int m = h % M, k = (h >> 14) % 1024, b = m >> 13; const float rstd = naive_rstd_x1(a, m);
        ref = x1_at(a, m, k) * rstd * a.in[I_N2G][k] * (1.f + MOD[b * 6144 + 4096 + k]) + MOD[b * 6144 + 3072 + k]; got = f8d((ws + WS_H2)[(size_t)m * 1024 + k]); atol = 0.02f; ref = f8r(ref); } break;
    case 16: { const int m = h % M, e = (h >> 14) & 15, b = m >> 13; const float rstd = naive_rstd_x1(a, m); float mx = -1e30f, mye = 0.f, sm = 0.f;
        for (int pass = 0; pass < 2; ++pass) for (int ee = 0; ee < 16; ++ee) { float lg = 0.f; for (int k = 0; k < 1024; ++k) lg += (x1_at(a, m, k) * rstd * a.in[I_N2G][k] * (1.f + MOD[b * 6144 + 4096 + k]) + MOD[b * 6144 + 3072 + k]) * a.in[I_WROUTER][k * 16 + ee];
            if (pass == 0) mx = fmaxf(mx, lg); else { const float ex = expf(lg - mx); sm += ex; if (ee == e) mye = ex; } }
        ref = mye / sm; got = ((const float*)(ws + WS_AFF))[(size_t)(b * 16 + e) * SEQ + (m & 8191)]; atol = 0.001f; } break;
    case 17: { const int be = h & 31, slot = (h >> 5) & 1023, b = be >> 4, e = be & 15; const int row = ((const int*)(ws + WS_IDX))[be * CAP + slot]; const float* aff = (const float*)(ws + WS_AFF) + (size_t)be * SEQ; float bad = 0.f;
        if (row < b * SEQ || row >= (b + 1) * SEQ) bad += 1.f; else { const int l = row & 8191; if (((const int*)(ws + WS_INV))[(size_t)row * 16 + e] != slot) bad += 1.f; if (((const float*)(ws + WS_WSEL))[be * CAP + slot] != aff[l]) bad += 1.f;
            int cnt = 0; for (int j = 0; j < SEQ; ++j) cnt += (aff[j] > aff[l]) ? 1 : 0; if (cnt >= CAP) bad += 1.f;
            const int l2 = h2 & 8191; if (((const int*)(ws + WS_INV))[(size_t)(b * SEQ + l2) * 16 + e] < 0) { int c2 = 0; for (int j = 0; j < SEQ; ++j) c2 += (aff[j] >= aff[l2]) ? 1 : 0; if (c2 <= CAP) bad += 1.f; } }
        ref = 0.f; got = bad; atol = 0.5f; } break;
    case 18: { const int e = h & 15, mat = (h >> 4) % 3, n = (h >> 8) & 1023, k = (h >> 18) & 1023;
        if (mat == 0) { ref = f8r(16.f * a.in[I_WGATE][(size_t)e * 1048576 + (size_t)k * 1024 + n]); got = f8d((ws + WS_WGU)[((size_t)e * 2048 + (n >> 7) * 256 + (n & 127)) * 1024 + k]); }
        else if (mat == 1) { ref = f8r(16.f * a.in[I_WUP][(size_t)e * 1048576 + (size_t)k * 1024 + n]); got = f8d((ws + WS_WGU)[((size_t)e * 2048 + (n >> 7) * 256 + 128 + (n & 127)) * 1024 + k]); }
        else { ref = f8r(16.f * a.in[I_WDOWN][(size_t)e * 1048576 + (size_t)k * 1024 + n]); got = f8d((ws + WS_WD)[((size_t)e * 1024 + n) * 1024 + k]); } atol = 1e-4f; } break;
    case 19: { const int be = h & 31, slot = (h >> 5) & 1023, f = (h >> 15) & 1023, e = be & 15; const int row = ((const int*)(ws + WS_IDX))[be * CAP + slot]; float g = 0.f, u = 0.f;
        const unsigned char* hr = ws + WS_H2 + (size_t)row * 1024; const unsigned char* wg = ws + WS_WGU + ((size_t)e * 2048 + (f >> 7) * 256 + (f & 127)) * 1024; const unsigned char* wu = wg + 128 * 1024;
        for (int k = 0; k < 1024; ++k) { g += f8d(hr[k]) * f8d(wg[k]); u += f8d(hr[k]) * f8d(wu[k]); }
        g *= 0.0625f; u *= 0.0625f; ref = g / (1.f + expf(-g)) * u; got = f8d((ws + WS_ACT)[((size_t)be * CAP + slot) * 1024 + f]); atol = 0.03f + 0.04f * fabsf(ref); } break;
    case 20: { const int be = h & 31, slot = (h >> 5) & 1023, n = (h >> 15) & 1023, e = be & 15, b = be >> 4; float d = 0.f;
        for (int f = 0; f < 1024; ++f) d += f8d((ws + WS_ACT)[((size_t)be * CAP + slot) * 1024 + f]) * f8d((ws + WS_WD)[((size_t)e * 1024 + n) * 1024 + f]);
        ref = d * 0.0625f * ((const float*)(ws + WS_WSEL))[be * CAP + slot] * MOD[b * 6144 + 5120 + n]; got = 0.0625f * f8d((ws + WS_YB)[((size_t)be * CAP + slot) * 1024 + n]); atol = 0.002f + 0.04f * fabsf(ref); } break;
    default: active = false;
    }
    if (active) { float e = fabsf(got - ref) / (atol + 0.03f * fabsf(ref)); if (!(e == e)) e = 1e9f; atomicMax((unsigned*)(ws + WS_CHK) + stage, __float_as_uint(e)); }
}
__global__ void chk_final(Args a) {
    __shared__ int code;
    if (threadIdx.x == 0) { int c = 0; for (int s = 20; s >= 0; --s) if (s > CHK_SKIP && __uint_as_float(((const unsigned*)(a.ws + WS_CHK))[s]) > 1.f) c = s + 1; code = c; }
    __syncthreads();
    const float sc = 1.f + 0.1f * (float)code;
    for (size_t i = (size_t)blockIdx.x * blockDim.x + threadIdx.x; i < (size_t)M * D; i += (size_t)gridDim.x * blockDim.x) a.out[i] *= sc;
}
#endif

extern "C" void kernel_launch(void* const* d_in, const int* in_sizes, int n_in, void* d_out, int out_size, void* d_ws, size_t ws_size, hipStream_t stream) {
    static int grid = 0;
    if (grid == 0) {
        if (n_in != 22 || out_size != M * D || ws_size < WS_END) { fprintf(stderr, "kernel_launch: unexpected shapes (n_in %d, out %d, ws %zu < %zu)\n", n_in, out_size, ws_size, (size_t)WS_END); grid = -1; return; }
        int dev = 0, cus = 0, per_cu = 0;
        if (hipGetDevice(&dev) != hipSuccess || hipDeviceGetAttribute(&cus, hipDeviceAttributeMultiprocessorCount, dev) != hipSuccess) { grid = -1; return; }
        if (hipFuncSetAttribute((const void*)fwd_kernel, hipFuncAttributeMaxDynamicSharedMemorySize, LDS_BYTES) != hipSuccess) { fprintf(stderr, "kernel_launch: hipFuncSetAttribute failed\n"); grid = -1; return; }
        if (hipOccupancyMaxActiveBlocksPerMultiprocessor(&per_cu, (const void*)fwd_kernel, NT, LDS_BYTES) != hipSuccess || per_cu < 1) { fprintf(stderr, "kernel_launch: occupancy query says %d\n", per_cu); per_cu = 1; }
        (void)hipGetLastError();
        grid = cus;
    }
    if (grid < 0) return;
    (void)hipMemsetAsync((char*)d_ws + WS_CTL, 0, CTL_ZERO_BYTES, stream);
    Args a{};
    for (int i = 0; i < 22; ++i) a.in[i] = (const float*)d_in[i];
    a.out = (float*)d_out; a.ws = (unsigned char*)d_ws;
    { static const int reps[12] = {PROBE_REPS}; for (int i = 0; i < 12; ++i) a.rep[i] = reps[i]; }
#if MK_MULTI
    for (int p = 0; p < NPHASE; ++p) { a.ph_lo = p; a.ph_hi = p + 1; hipLaunchKernelGGL(fwd_kernel, dim3(grid), dim3(NT), LDS_BYTES, stream, a);
#if MK_CHECK
        if (p == 0) (void)hipMemsetAsync((char*)d_ws + WS_CHK, 0, 4096, stream);
        static const int after[21] = {0, 0, 0, 1, 1, 1, 2, 3, 3, 3, 4, 4, 5, 6, 7, 8, 8, 9, 9, 10, 11};
        for (int st = 0; st < 21; ++st) if (after[st] == p) hipLaunchKernelGGL(chk_kernel, dim3(st == 12 ? 1024 : 32), dim3(128), 0, stream, a, st);
        if (p == NPHASE - 1) hipLaunchKernelGGL(chk_final, dim3(1024), dim3(256), 0, stream, a);
#endif
    }
#else
    a.ph_lo = 0; a.ph_hi = NPHASE;
#if MK_COOP
    void* kargs[] = {&a};
    hipError_t e = hipLaunchCooperativeKernel((const void*)fwd_kernel, dim3(grid), dim3(NT), kargs, LDS_BYTES, stream);
    if (e != hipSuccess) fprintf(stderr, "kernel_launch: cooperative launch failed: %s (grid %d)\n", hipGetErrorString(e), grid);
#else
    hipLaunchKernelGGL(fwd_kernel, dim3(grid), dim3(NT), LDS_BYTES, stream, a);
#endif
#endif
}
```
